# Optimizing an MI355X kernel written in HIP

```python
import math
import jax, jax.numpy as jnp
from jax import lax
import numpy as np

D_MODEL = 1024
BATCH = 2
SEQ = 8192
DEPTH = 2

N_MIXERS = 2
N_HEADS = 8
HEAD_DIM = D_MODEL // N_HEADS
DIFF_HALF = HEAD_DIM // 2
MOBA_BLOCK = 256
MOBA_TOPK = 3
Q_BLOCK = 128
D_FF = -(-8 * D_MODEL // (3 * 256)) * 256
N_BUCKETS = 32
MAX_EXACT = N_BUCKETS // 2
MAX_DISTANCE = 2048
N_MOBA_LAYERS = (DEPTH + 1) // 2
N_DIFF_LAYERS = DEPTH // 2
RMS_EPS = 1e-6
NEG_INF = -1e30

kernel_name = "hybrid_moba_diffattn_sandwich_adaln"


def rms_norm(x, g):
    x32 = x.astype(jnp.float32)
    y = x32 * lax.rsqrt(jnp.mean(x32 * x32, axis=-1, keepdims=True) + RMS_EPS)
    return (y * g.astype(jnp.float32)).astype(x.dtype)


def t5_bucket(rel):
    n = jnp.maximum(rel, 0)
    nf = jnp.maximum(n, 1).astype(jnp.float32)
    large = MAX_EXACT + (jnp.log(nf / MAX_EXACT) / math.log(MAX_DISTANCE / MAX_EXACT)
                         * (N_BUCKETS - MAX_EXACT)).astype(jnp.int32)
    large = jnp.minimum(large, N_BUCKETS - 1)
    return jnp.where(n < MAX_EXACT, n, large)


def moba_attention(h, w_qkv, w_o, rel_table):
    B, S, _ = h.shape
    pad = (-S) % MOBA_BLOCK
    s_pad = S + pad
    nb = s_pad // MOBA_BLOCK
    nq = s_pad // Q_BLOCK
    k_sel_n = min(MOBA_TOPK, nb)
    q, k, v = jnp.split(h @ w_qkv, 3, axis=-1)

    def heads(t):
        t = t.reshape(B, S, N_HEADS, HEAD_DIM).transpose(0, 2, 1, 3)
        return jnp.pad(t, ((0, 0), (0, 0), (0, pad), (0, 0)))

    q = heads(q) * (HEAD_DIM ** -0.5)
    k, v = heads(k), heads(v)
    k_blk = k.reshape(B, N_HEADS, nb, MOBA_BLOCK, HEAD_DIM)
    v_blk = v.reshape(B, N_HEADS, nb, MOBA_BLOCK, HEAD_DIM)
    k_mean = jnp.mean(k_blk, axis=3)
    q_blocks = q.reshape(B, N_HEADS, nq, Q_BLOCK, HEAD_DIM).transpose(2, 0, 1, 3, 4)
    b_idx = jnp.arange(B)[:, None, None, None]
    h_idx = jnp.arange(N_HEADS)[None, :, None, None]
    table_t = rel_table.T

    def one_block(args):
        qb, qi = args
        q_pos = qi * Q_BLOCK + jnp.arange(Q_BLOCK)
        own = qi // (MOBA_BLOCK // Q_BLOCK)
        gate = jnp.einsum('bhqd,bhnd->bhqn', qb, k_mean).astype(jnp.float32)
        gate = jnp.where(jnp.arange(nb) < own, gate, NEG_INF)
        _, sel = lax.top_k(gate, k_sel_n)
        slot_valid = jnp.repeat(jnp.arange(k_sel_n) < own, MOBA_BLOCK)
        k_sel = k_blk[b_idx, h_idx, sel].reshape(B, N_HEADS, Q_BLOCK, k_sel_n * MOBA_BLOCK, HEAD_DIM)
        v_sel = v_blk[b_idx, h_idx, sel].reshape(B, N_HEADS, Q_BLOCK, k_sel_n * MOBA_BLOCK, HEAD_DIM)
        k_pos_sel = (sel[..., None] * MOBA_BLOCK + jnp.arange(MOBA_BLOCK)).reshape(
            B, N_HEADS, Q_BLOCK, k_sel_n * MOBA_BLOCK)
        bias_sel = table_t[h_idx, t5_bucket(q_pos[None, None, :, None] - k_pos_sel)]
        s_sel = jnp.einsum('bhqd,bhqkd->bhqk', qb, k_sel).astype(jnp.float32) + bias_sel.astype(jnp.float32)
        s_sel = jnp.where(slot_valid, s_sel, NEG_INF)
        k_own = lax.dynamic_slice_in_dim(k, own * MOBA_BLOCK, MOBA_BLOCK, axis=2)
        v_own = lax.dynamic_slice_in_dim(v, own * MOBA_BLOCK, MOBA_BLOCK, axis=2)
        k_pos_own = own * MOBA_BLOCK + jnp.arange(MOBA_BLOCK)
        rel_own = q_pos[:, None] - k_pos_own[None, :]
        bias_own = jnp.moveaxis(rel_table[t5_bucket(rel_own)], -1, 0)
        s_own = jnp.einsum('bhqd,bhkd->bhqk', qb, k_own).astype(jnp.float32) + bias_own[None].astype(jnp.float32)
        s_own = jnp.where(rel_own >= 0, s_own, NEG_INF)
        p = jax.nn.softmax(jnp.concatenate([s_sel, s_own], axis=-1), axis=-1).astype(v.dtype)
        n_sel = k_sel_n * MOBA_BLOCK
        return (jnp.einsum('bhqk,bhqkd->bhqd', p[..., :n_sel], v_sel)
                + jnp.einsum('bhqk,bhkd->bhqd', p[..., n_sel:], v_own))

    o = lax.map(one_block, (q_blocks, jnp.arange(nq)))
    o = o.transpose(1, 0, 3, 2, 4).reshape(B, s_pad, D_MODEL)[:, :S]
    return o @ w_o


def diff_attention(h, w_qkv, w_o, lam, subln_g, rel_table, layer_idx):
    B, S, _ = h.shape
    nq = S // Q_BLOCK
    lambda_init = 0.8 - 0.6 * math.exp(-0.3 * layer_idx)
    q, k, v = jnp.split(h @ w_qkv, 3, axis=-1)
    q = q.reshape(B, S, N_HEADS, 2, DIFF_HALF).transpose(0, 2, 3, 1, 4) * (DIFF_HALF ** -0.5)
    k = k.reshape(B, S, N_HEADS, 2, DIFF_HALF).transpose(0, 2, 3, 1, 4)
    v = v.reshape(B, S, N_HEADS, HEAD_DIM).transpose(0, 2, 1, 3)
    lam32 = lam.astype(jnp.float32)
    lam_full = (jnp.exp(jnp.sum(lam32[0] * lam32[1])) - jnp.exp(jnp.sum(lam32[2] * lam32[3]))
                + lambda_init)
    q_blocks = q.reshape(B, N_HEADS, 2, nq, Q_BLOCK, DIFF_HALF).transpose(3, 0, 1, 2, 4, 5)
    k_pos = jnp.arange(S)

    def one_block(args):
        qb, qi = args
        q_pos = qi * Q_BLOCK + jnp.arange(Q_BLOCK)
        rel = q_pos[:, None] - k_pos[None, :]
        bias = jnp.moveaxis(rel_table[t5_bucket(rel)], -1, 0)
        s = jnp.einsum('bhcqd,bhckd->bhcqk', qb, k).astype(jnp.float32) + bias[None, :, None].astype(jnp.float32)
        s = jnp.where(rel >= 0, s, NEG_INF)
        p = jax.nn.softmax(s, axis=-1)
        a = p[:, :, 0] - lam_full * p[:, :, 1]
        return jnp.einsum('bhqk,bhkd->bhqd', a.astype(v.dtype), v)

    o = lax.map(one_block, (q_blocks, jnp.arange(nq)))
    o = o.transpose(1, 2, 0, 3, 4).reshape(B, N_HEADS, S, HEAD_DIM)
    o = rms_norm(o, subln_g) * (1.0 - lambda_init)
    o = o.transpose(0, 2, 1, 3).reshape(B, S, D_MODEL)
    return o @ w_o


def swiglu(h, w_in, w_out):
    g, u = jnp.split(h @ w_in, 2, axis=-1)
    return (jax.nn.silu(g) * u) @ w_out


def setup_inputs(seed: int = 0) -> dict:
    key = jax.random.key(seed)
    ks = jax.random.split(key, 16)
    f32 = jnp.float32
    D = D_MODEL
    return {
        "x": jax.random.normal(ks[0], (BATCH, SEQ, D), f32),
        "c": jax.random.normal(ks[1], (BATCH, D), f32),
        "rel_bias": 0.5 * jax.random.normal(ks[2], (N_BUCKETS, N_HEADS), f32),
        "ada_w": jax.random.normal(ks[3], (DEPTH, D, 6 * D), f32) * D ** -0.5,
        "ada_b": 0.01 * jax.random.normal(ks[4], (DEPTH, 6 * D), f32),
        "norm_g": 1.0 + 0.1 * jax.random.normal(ks[5], (DEPTH, 4, D), f32),
        "moba_w_qkv": jax.random.normal(ks[6], (N_MOBA_LAYERS, D, 3 * D), f32) * D ** -0.5,
        "moba_w_o": jax.random.normal(ks[7], (N_MOBA_LAYERS, D, D), f32) * D ** -0.5,
        "diff_w_qkv": jax.random.normal(ks[8], (N_DIFF_LAYERS, D, 3 * D), f32) * D ** -0.5,
        "diff_w_o": jax.random.normal(ks[9], (N_DIFF_LAYERS, D, D), f32) * D ** -0.5,
        "diff_lambda": 0.1 * jax.random.normal(ks[10], (N_DIFF_LAYERS, 4, DIFF_HALF), f32),
        "diff_subln_g": 1.0 + 0.1 * jax.random.normal(ks[11], (N_DIFF_LAYERS, HEAD_DIM), f32),
        "ffn_w_in": jax.random.normal(ks[12], (DEPTH, D, 2 * D_FF), f32) * D ** -0.5,
        "ffn_w_out": jax.random.normal(ks[13], (DEPTH, D_FF, D), f32) * D_FF ** -0.5,
    }


def reference(x, c, rel_bias, ada_w, ada_b, norm_g, moba_w_qkv, moba_w_o, diff_w_qkv, diff_w_o,
              diff_lambda, diff_subln_g, ffn_w_in, ffn_w_out):
    c_act = jax.nn.silu(c)
    for i in range(DEPTH):
        mod = (c_act @ ada_w[i] + ada_b[i])[:, None, :]
        sh_a, sc_a, g_a, sh_f, sc_f, g_f = jnp.split(mod, 6, axis=-1)
        h = rms_norm(x, norm_g[i, 0]) * (1.0 + sc_a) + sh_a
        if i % N_MIXERS == 0:
            y = moba_attention(h, moba_w_qkv[i // 2], moba_w_o[i // 2], rel_bias)
        else:
            y = diff_attention(h, diff_w_qkv[i // 2], diff_w_o[i // 2], diff_lambda[i // 2],
                               diff_subln_g[i // 2], rel_bias, i)
        x = x + g_a * rms_norm(y, norm_g[i, 1])
        h = rms_norm(x, norm_g[i, 2]) * (1.0 + sc_f) + sh_f
        x = x + g_f * rms_norm(swiglu(h, ffn_w_in[i], ffn_w_out[i]), norm_g[i, 3])
    return x
```

```cpp
#include <hip/hip_runtime.h>
#include <cstdio>
#include <cstdint>

#define GAS __attribute__((address_space(1)))
#define LAS __attribute__((address_space(3)))
typedef unsigned short bf16;
typedef float f32x4 __attribute__((ext_vector_type(4)));
typedef float f32x2 __attribute__((ext_vector_type(2)));
typedef unsigned u32x4 __attribute__((ext_vector_type(4)));
typedef unsigned u32x2 __attribute__((ext_vector_type(2)));

constexpr int BATCH = 2, SEQ = 8192, D = 1024, NH = 8, HD = 128, DFF = 2816, NBKT = 32;
constexpr int M = BATCH * SEQ;
constexpr int NWAVES = 8, NTHR = 512;
constexpr float RMS_EPS = 1e-6f;
constexpr float LOG2E = 1.4426950408889634f;
constexpr float LAMBDA_INIT = 0.35550906759096926f;

constexpr size_t MiB = 1u << 20;
constexpr size_t WS_CTL = 0, CTL_ZERO_BYTES = 1 * MiB;
constexpr size_t WS_MOD = 1 * MiB;
constexpr size_t WS_BLUT = WS_MOD + 128 * 1024;
constexpr size_t WS_KMEAN = WS_BLUT + 16 * 1024;
constexpr size_t WS_SEL = WS_KMEAN + 256 * 1024;
constexpr size_t WS_H = 52 * MiB;
constexpr size_t WS_Q = 84 * MiB, WS_K = 116 * MiB, WS_V = 148 * MiB;
constexpr size_t WS_HH = 84 * MiB;
constexpr size_t WS_O = 180 * MiB;
constexpr size_t WS_Y = 212 * MiB;
constexpr size_t WS_END = 244 * MiB;
constexpr int CW_BAR = 4096;

constexpr int LDS_BYTES = 147456;
constexpr int MISC_OFF = 131072 + 320;

#define RLX_AGENT __ATOMIC_RELAXED, __HIP_MEMORY_SCOPE_AGENT
__device__ __forceinline__ unsigned f2bf(float f) { unsigned u = __builtin_bit_cast(unsigned, f); return (u + 0x7fffu + ((u >> 16) & 1u)) >> 16; }
__device__ __forceinline__ unsigned pk2(float lo, float hi) { return f2bf(lo) | (f2bf(hi) << 16); }
__device__ __forceinline__ float bf2f(unsigned short b) { return __builtin_bit_cast(float, (unsigned)b << 16); }
__device__ __forceinline__ float bflo(unsigned w) { return __builtin_bit_cast(float, w << 16); }
__device__ __forceinline__ float bfhi(unsigned w) { return __builtin_bit_cast(float, w & 0xffff0000u); }

#define XB_TMO      128
#define XB_XCNT(j)  (256  + 64 * (j))
#define XB_XSUB(j)  (1280 + 64 * (j))
#define XB_XGEN(j)  (2304 + 64 * (j))
#define XB_TOP      3328
#define XB_TOPGEN   3392
#define XCD_BAR_WORDS 3456
#define XB_SPIN_CAP (1u << 25)
__device__ __forceinline__ unsigned xb_ld(unsigned* p)              { return __hip_atomic_load(p, __ATOMIC_RELAXED, __HIP_MEMORY_SCOPE_AGENT); }
__device__ __forceinline__ unsigned xb_add(unsigned* p, unsigned v) { return __hip_atomic_fetch_add(p, v, __ATOMIC_RELAXED, __HIP_MEMORY_SCOPE_AGENT); }
__device__ __forceinline__ unsigned xb_xcc_id() { return (unsigned)__builtin_amdgcn_s_getreg((3 << 11) | 20) & 0xFu; }
#define XB_SPIN(cond, bar) do { unsigned _sp = 0; while (cond) { __builtin_amdgcn_s_sleep(1); \
    if ((++_sp & 255u) == 0u) { if (xb_ld(&(bar)[XB_TMO])) break; if (_sp > XB_SPIN_CAP) { atomicAdd(&(bar)[XB_TMO], 1u); break; } } } } while (0)
struct XcdBarrier { unsigned* bar; unsigned x; volatile LAS unsigned* st; };
__device__ __forceinline__ XcdBarrier xcd_barrier_post(unsigned* bar, volatile LAS unsigned* st) {
    XcdBarrier b; b.bar = bar; b.x = xb_xcc_id(); b.st = st;
    if (threadIdx.x == 0) (void)xb_add(&bar[XB_XCNT(b.x)], 1u);
    return b;
}
__device__ __forceinline__ void xcd_barrier_complete(unsigned* bar, unsigned x, unsigned& nloc, unsigned& nx) {
    const unsigned G = gridDim.x * gridDim.y * gridDim.z;
    unsigned sum, cnt, mine, sp = 0u;
    for (;;) {
        sum = 0u; cnt = 0u; mine = 0u;
#pragma unroll
        for (unsigned j = 0; j < 16; ++j) { const unsigned c = xb_ld(&bar[XB_XCNT(j)]); sum += c; cnt += (c > 0u) ? 1u : 0u; mine = (j == x) ? c : mine; }
        if (sum == G) break;
        __builtin_amdgcn_s_sleep(1);
        if ((++sp & 255u) == 0u) { if (xb_ld(&bar[XB_TMO])) break; if (sp > XB_SPIN_CAP) { atomicAdd(&bar[XB_TMO], 1u); break; } }
    }
    nloc = mine > 0u ? mine : 1u; nx = cnt > 0u ? cnt : 1u;
}
__device__ __forceinline__ void xcd_barrier(const XcdBarrier& b) {
    asm volatile("s_waitcnt vmcnt(0)" ::: "memory");
    __syncthreads();
    if (threadIdx.x == 0) {
        unsigned* bar = b.bar;
        __builtin_amdgcn_s_waitcnt(0);
        unsigned nloc = b.st[0], nx = b.st[1];
        if (nloc == 0u) { xcd_barrier_complete(bar, b.x, nloc, nx); b.st[0] = nloc; b.st[1] = nx; }
        const unsigned old = xb_add(&bar[XB_XSUB(b.x)], 1u);
        const unsigned gen = old / nloc;
        if (old + 1u == (gen + 1u) * nloc) {
            __builtin_amdgcn_fence(__ATOMIC_RELEASE, "agent");
            asm volatile("s_waitcnt vmcnt(0)" ::: "memory");
            const unsigned og = xb_add(&bar[XB_TOP], 1u);
            const unsigned tg = og / nx;
            if (og + 1u == (tg + 1u) * nx) xb_add(&bar[XB_TOPGEN], 1u);
            else XB_SPIN(xb_ld(&bar[XB_TOPGEN]) == tg, bar);
            __builtin_amdgcn_fence(__ATOMIC_ACQUIRE, "agent");
            xb_add(&bar[XB_XGEN(b.x)], 1u);
            asm volatile("s_waitcnt vmcnt(0)" ::: "memory");
        } else {
            XB_SPIN(xb_ld(&bar[XB_XGEN(b.x)]) == gen, bar);
            __builtin_amdgcn_fence(__ATOMIC_ACQUIRE, "agent");
            asm volatile("s_waitcnt vmcnt(0)" ::: "memory");
        }
    }
    __syncthreads();
}

__device__ __forceinline__ float wave_sum(float v) {
#pragma unroll
    for (int o = 1; o < 64; o <<= 1) v += __shfl_xor(v, o);
    return v;
}
__device__ __forceinline__ float wave_max(float v) {
#pragma unroll
    for (int o = 1; o < 64; o <<= 1) v = fmaxf(v, __shfl_xor(v, o));
    return v;
}
__device__ __forceinline__ float silu_f(float v) { return v / (1.f + __expf(-v)); }

struct Args {
    const float* x; const float* c; const float* rel_bias; const float* ada_w; const float* ada_b; const float* norm_g;
    const float* moba_w_qkv; const float* moba_w_o; const float* diff_w_qkv; const float* diff_w_o;
    const float* diff_lambda; const float* diff_subln_g; const float* ffn_w_in; const float* ffn_w_out;
    float* out; unsigned char* ws;
};

__device__ __forceinline__ int t5_bucket(int rel) {
    const int n = rel < 0 ? 0 : rel;
    const float nf = (float)(n < 1 ? 1 : n);
    int large = 16 + (int)(logf(nf / 16.0f) / 4.852030263919617f * 16.0f);
    large = large < 31 ? large : 31;
    return n < 16 ? n : large;
}

__device__ __forceinline__ void p_mod(const Args& a, int gtid, int gthreads) {
    float* mod = (float*)(a.ws + WS_MOD);
    for (int idx = gtid; idx < 2 * 6144; idx += gthreads) {
        const int l = idx / 6144, j = idx % 6144;
        const float* w = a.ada_w + (size_t)l * D * 6144 + j;
        float s0 = 0.f, s1 = 0.f;
        for (int k = 0; k < D; ++k) { const float wv = w[(size_t)k * 6144]; s0 += silu_f(a.c[k]) * wv; s1 += silu_f(a.c[D + k]) * wv; }
        const float bb = a.ada_b[l * 6144 + j];
        mod[(l * 2 + 0) * 6144 + j] = s0 + bb; mod[(l * 2 + 1) * 6144 + j] = s1 + bb;
    }
    int* blut = (int*)(a.ws + WS_BLUT);
    for (int r = gtid; r < 2048; r += gthreads) blut[r] = t5_bucket(r);
}

__device__ __forceinline__ void p_norm_in(const float* X, const float* g, const float* sh, const float* sc, bf16* H, int gw, int ngw, int lane) {
    for (int m = gw; m < M; m += ngw) {
        const int b = m / SEQ;
        const f32x4* xr = (const f32x4*)(X + (size_t)m * D) + lane;
        f32x4 v[4]; float s = 0.f;
#pragma unroll
        for (int j = 0; j < 4; ++j) { v[j] = xr[64 * j]; s += (v[j].x * v[j].x + v[j].y * v[j].y) + (v[j].z * v[j].z + v[j].w * v[j].w); }
        const float r = 1.0f / sqrtf(wave_sum(s) * (1.f / D) + RMS_EPS);
        u32x2* o = (u32x2*)(H + (size_t)m * D) + lane;
#pragma unroll
        for (int j = 0; j < 4; ++j) {
            const f32x4 gg = ((const f32x4*)g)[lane + 64 * j], s1 = ((const f32x4*)(sc + b * 6144))[lane + 64 * j], s0 = ((const f32x4*)(sh + b * 6144))[lane + 64 * j];
            const f32x4 h = v[j] * r * gg * (1.0f + s1) + s0;
            u32x2 w; w.x = pk2(h.x, h.y); w.y = pk2(h.z, h.w); o[64 * j] = w;
        }
    }
}
__device__ __forceinline__ void p_post(const float* Xin, const bf16* Y, const float* g1, const float* gate, float* Xout,
                                       const float* g2, const float* sh, const float* sc, bf16* H, int gw, int ngw, int lane) {
    for (int m = gw; m < M; m += ngw) {
        const int b = m / SEQ;
        const u32x2* yr = (const u32x2*)(Y + (size_t)m * D) + lane;
        const f32x4* xr = (const f32x4*)(Xin + (size_t)m * D) + lane;
        f32x4 y[4], xv[4]; float s = 0.f;
#pragma unroll
        for (int j = 0; j < 4; ++j) { const u32x2 w = yr[64 * j]; y[j] = (f32x4){bflo(w.x), bfhi(w.x), bflo(w.y), bfhi(w.y)}; xv[j] = xr[64 * j];
            s += (y[j].x * y[j].x + y[j].y * y[j].y) + (y[j].z * y[j].z + y[j].w * y[j].w); }
        const float r = 1.0f / sqrtf(wave_sum(s) * (1.f / D) + RMS_EPS);
        float s2 = 0.f;
#pragma unroll
        for (int j = 0; j < 4; ++j) {
            const f32x4 gg = ((const f32x4*)g1)[lane + 64 * j], gt = ((const f32x4*)(gate + b * 6144))[lane + 64 * j];
            xv[j] = xv[j] + gt * (y[j] * r * gg);
            s2 += (xv[j].x * xv[j].x + xv[j].y * xv[j].y) + (xv[j].z * xv[j].z + xv[j].w * xv[j].w);
            ((f32x4*)(Xout + (size_t)m * D))[lane + 64 * j] = xv[j];
        }
        if (H) {
            const float r2 = 1.0f / sqrtf(wave_sum(s2) * (1.f / D) + RMS_EPS);
            u32x2* o = (u32x2*)(H + (size_t)m * D) + lane;
#pragma unroll
            for (int j = 0; j < 4; ++j) {
                const f32x4 gg = ((const f32x4*)g2)[lane + 64 * j], s1 = ((const f32x4*)(sc + b * 6144))[lane + 64 * j], s0 = ((const f32x4*)(sh + b * 6144))[lane + 64 * j];
                const f32x4 h = xv[j] * r2 * gg * (1.0f + s1) + s0;
                u32x2 w; w.x = pk2(h.x, h.y); w.y = pk2(h.z, h.w); o[64 * j] = w;
            }
        }
    }
}

template <int MODE>
__device__ __forceinline__ void naive_gemm(LAS unsigned char* lds, const bf16* A, int K, const float* W, int ldw, int Nout, bf16* C, int ldc, float qscale, int blk, int nblk, int tid) {
    LAS float* As = (LAS float*)lds;
    LAS float* Ws = As + 16 * 132;
    LAS float* Wu = Ws + 16 * 132;
    const int ty = tid >> 4, tx = tid & 15;
    const int ntn = Nout / 128, ntiles = (M / 128) * ntn;
    for (int t = blk; t < ntiles; t += nblk) {
        const int tm = t / ntn, tn = t % ntn, row0 = tm * 128, col0 = tn * 128;
        float acc[4][8], acu[4][8];
#pragma unroll
        for (int i = 0; i < 4; ++i)
#pragma unroll
            for (int j = 0; j < 8; ++j) { acc[i][j] = 0.f; acu[i][j] = 0.f; }
        for (int k0 = 0; k0 < K; k0 += 16) {
            __syncthreads();
            { const int r = tid >> 2, kk = (tid & 3) * 4; const u32x2 w = *(const u32x2*)(A + (size_t)(row0 + r) * K + k0 + kk);
              As[(kk + 0) * 132 + r] = bflo(w.x); As[(kk + 1) * 132 + r] = bfhi(w.x); As[(kk + 2) * 132 + r] = bflo(w.y); As[(kk + 3) * 132 + r] = bfhi(w.y); }
            { const int kk = tid >> 5, cc = (tid & 31) * 4; const f32x4 w = *(const f32x4*)(W + (size_t)(k0 + kk) * ldw + col0 + cc);
              *(LAS f32x4*)(Ws + kk * 132 + cc) = w;
              if (MODE == 2) { const f32x4 u = *(const f32x4*)(W + (size_t)(k0 + kk) * ldw + DFF + col0 + cc); *(LAS f32x4*)(Wu + kk * 132 + cc) = u; } }
            __syncthreads();
#pragma unroll 2
            for (int kk = 0; kk < 16; ++kk) {
                const f32x4 av = *(LAS f32x4*)(As + kk * 132 + ty * 4);
                const f32x4 b0 = *(LAS f32x4*)(Ws + kk * 132 + tx * 8), b1 = *(LAS f32x4*)(Ws + kk * 132 + tx * 8 + 4);
                const float aa[4] = {av.x, av.y, av.z, av.w}; const float bb[8] = {b0.x, b0.y, b0.z, b0.w, b1.x, b1.y, b1.z, b1.w};
#pragma unroll
                for (int i = 0; i < 4; ++i)
#pragma unroll
                    for (int j = 0; j < 8; ++j) acc[i][j] += aa[i] * bb[j];
                if (MODE == 2) {
                    const f32x4 u0 = *(LAS f32x4*)(Wu + kk * 132 + tx * 8), u1 = *(LAS f32x4*)(Wu + kk * 132 + tx * 8 + 4);
                    const float uu[8] = {u0.x, u0.y, u0.z, u0.w, u1.x, u1.y, u1.z, u1.w};
#pragma unroll
                    for (int i = 0; i < 4; ++i)
#pragma unroll
                        for (int j = 0; j < 8; ++j) acu[i][j] += aa[i] * uu[j];
                }
            }
        }
#pragma unroll
        for (int i = 0; i < 4; ++i) {
            const int row = row0 + ty * 4 + i; int col = col0 + tx * 8; bf16* base = C; float sc = 1.f;
            if (MODE == 1) { const int tt = col / 1024; base = C + (size_t)tt * ((WS_K - WS_Q) / 2); col -= tt * 1024; if (tt == 0) sc = qscale; }
            float v[8];
#pragma unroll
            for (int j = 0; j < 8; ++j) { v[j] = acc[i][j] * sc; if (MODE == 2) v[j] = silu_f(acc[i][j]) * acu[i][j]; }
            u32x4 w; w.x = pk2(v[0], v[1]); w.y = pk2(v[2], v[3]); w.z = pk2(v[4], v[5]); w.w = pk2(v[6], v[7]);
            *(u32x4*)(base + (size_t)row * ldc + col) = w;
        }
    }
    __syncthreads();
}

__device__ __forceinline__ void p_kmean(const bf16* Kb, float* kmean, int gtid, int gthreads) {
    for (int idx = gtid; idx < BATCH * NH * 32 * HD; idx += gthreads) {
        const int d = idx % HD, blk = (idx / HD) % 32, h = (idx / (HD * 32)) % NH, b = idx / (HD * 32 * NH);
        const bf16* p = Kb + ((size_t)b * SEQ + blk * 256) * D + h * HD + d;
        float s = 0.f;
        for (int r = 0; r < 256; ++r) s += bf2f(p[(size_t)r * D]);
        kmean[idx] = s * (1.0f / 256.0f);
    }
}
__device__ __forceinline__ void p_gate(const bf16* Qb, const float* kmean, unsigned* sel, int gtid, int gthreads) {
    for (int idx = gtid; idx < BATCH * NH * SEQ; idx += gthreads) {
        const int q = idx % SEQ, h = (idx / SEQ) % NH, b = idx / (SEQ * NH);
        const int own = q >> 8;
        unsigned mask;
        if (own <= 3) mask = (1u << own) - 1u;
        else {
            const bf16* qp = Qb + ((size_t)b * SEQ + q) * D + h * HD;
            const float* km = kmean + (size_t)(b * NH + h) * 32 * HD;
            float b0 = -3e38f, b1 = -3e38f, b2 = -3e38f; int i0 = 0, i1 = 0, i2 = 0;
            for (int n = 0; n < own; ++n) {
                float g = 0.f;
                for (int d = 0; d < HD; d += 2) { const unsigned w = *(const unsigned*)(qp + d); g += bflo(w) * km[n * HD + d] + bfhi(w) * km[n * HD + d + 1]; }
                if (g > b0) { b2 = b1; i2 = i1; b1 = b0; i1 = i0; b0 = g; i0 = n; }
                else if (g > b1) { b2 = b1; i2 = i1; b1 = g; i1 = n; }
                else if (g > b2) { b2 = g; i2 = n; }
            }
            mask = (1u << i0) | (1u << i1) | (1u << i2);
        }
        sel[idx] = mask;
    }
}

template <int QKD>
__device__ __forceinline__ void naive_attn_row(const bf16* Qrow, const bf16* Kc, const bf16* Vc, int qpos, unsigned bmask, const float* relb, int h, const int* blut,
                                               LAS float* wq, LAS float* wp, int lane, float& o0, float& o1) {
    if (lane < QKD / 2) { const unsigned w = *(const unsigned*)(Qrow + 2 * lane); wq[2 * lane] = bflo(w); wq[2 * lane + 1] = bfhi(w); }
    asm volatile("s_waitcnt lgkmcnt(0)" ::: "memory");
    float m = -1e30f, l = 0.f; o0 = 0.f; o1 = 0.f;
    const int own = qpos >> 8;
    for (int j = 0; j <= own; ++j) {
        if (!((bmask >> j) & 1u)) continue;
        for (int c = 0; c < 4; ++c) {
            const int k0 = j * 256 + c * 64;
            if (k0 > qpos) break;
            const int key = k0 + lane;
            const bf16* kp = Kc + (size_t)key * D;
            float s = 0.f;
#pragma unroll
            for (int d = 0; d < QKD; d += 8) {
                const u32x4 w = *(const u32x4*)(kp + d);
                const f32x4 q0 = *(LAS f32x4*)(wq + d), q1 = *(LAS f32x4*)(wq + d + 4);
                s += bflo(w.x) * q0.x + bfhi(w.x) * q0.y + bflo(w.y) * q0.z + bfhi(w.y) * q0.w + bflo(w.z) * q1.x + bfhi(w.z) * q1.y + bflo(w.w) * q1.z + bfhi(w.w) * q1.w;
            }
            const int rel = qpos - key;
            const int bk = rel < 0 ? 0 : (rel < 2048 ? blut[rel] : 31);
            s += relb[bk * NH + h] * LOG2E;
            if (key > qpos) s = -__builtin_inff();
            const float cm = wave_max(s), mn = fmaxf(m, cm), alpha = exp2f(m - mn), p = exp2f(s - mn);
            l = l * alpha + wave_sum(p); o0 *= alpha; o1 *= alpha; m = mn;
            wp[lane] = p;
            asm volatile("s_waitcnt lgkmcnt(0)" ::: "memory");
            const bf16* vp = Vc + (size_t)k0 * D + 2 * lane;
#pragma unroll 8
            for (int jj = 0; jj < 64; ++jj) { const float pj = wp[jj]; const unsigned w = *(const unsigned*)(vp + (size_t)jj * D); o0 += pj * bflo(w); o1 += pj * bfhi(w); }
            asm volatile("s_waitcnt lgkmcnt(0)" ::: "memory");
        }
    }
    const float rl = 1.0f / l; o0 *= rl; o1 *= rl;
}

__device__ __forceinline__ void p_moba_attn(const Args& a, LAS unsigned char* lds, int gw, int ngw, int wave, int lane) {
    const bf16* Qb = (const bf16*)(a.ws + WS_Q); const bf16* Kb = (const bf16*)(a.ws + WS_K); const bf16* Vb = (const bf16*)(a.ws + WS_V);
    bf16* Ob = (bf16*)(a.ws + WS_O); const unsigned* sel = (const unsigned*)(a.ws + WS_SEL); const int* blut = (const int*)(a.ws + WS_BLUT);
    LAS float* wq = (LAS float*)lds + wave * 256; LAS float* wp = wq + 128;
    for (int idx = gw; idx < BATCH * NH * SEQ; idx += ngw) {
        const int q = idx % SEQ, h = (idx / SEQ) % NH, b = idx / (SEQ * NH);
        const size_t rb = (size_t)b * SEQ;
        const unsigned bm = sel[idx] | (1u << (q >> 8));
        float o0, o1;
        naive_attn_row<128>(Qb + (rb + q) * D + h * HD, Kb + rb * D + h * HD, Vb + rb * D + h * HD, q, bm, a.rel_bias, h, blut, wq, wp, lane, o0, o1);
        *(unsigned*)(Ob + (rb + q) * D + h * HD + 2 * lane) = pk2(o0, o1);
    }
}
__device__ __forceinline__ void p_diff_attn(const Args& a, LAS unsigned char* lds, int gw, int ngw, int wave, int lane) {
    const bf16* Qb = (const bf16*)(a.ws + WS_Q); const bf16* Kb = (const bf16*)(a.ws + WS_K); const bf16* Vb = (const bf16*)(a.ws + WS_V);
    bf16* Ob = (bf16*)(a.ws + WS_O); const int* blut = (const int*)(a.ws + WS_BLUT);
    LAS float* wq = (LAS float*)lds + wave * 256; LAS float* wp = wq + 128;
    float lam_full;
    { const float* lm = a.diff_lambda; const float p01 = wave_sum(lm[lane] * lm[64 + lane]), p23 = wave_sum(lm[128 + lane] * lm[192 + lane]); lam_full = __expf(p01) - __expf(p23) + LAMBDA_INIT; }
    for (int idx = gw; idx < BATCH * NH * SEQ; idx += ngw) {
        const int q = idx % SEQ, h = (idx / SEQ) % NH, b = idx / (SEQ * NH);
        const size_t rb = (size_t)b * SEQ;
        const int own = q >> 8; const unsigned bm = own >= 31 ? 0xffffffffu : ((1u << (own + 1)) - 1u);
        float a0, a1, b0, b1;
        naive_attn_row<64>(Qb + (rb + q) * D + h * HD, Kb + rb * D + h * HD, Vb + rb * D + h * HD, q, bm, a.rel_bias, h, blut, wq, wp, lane, a0, a1);
        naive_attn_row<64>(Qb + (rb + q) * D + h * HD + 64, Kb + rb * D + h * HD + 64, Vb + rb * D + h * HD, q, bm, a.rel_bias, h, blut, wq, wp, lane, b0, b1);
        float o0 = a0 - lam_full * b0, o1 = a1 - lam_full * b1;
        const float ss = wave_sum(o0 * o0 + o1 * o1);
        const float r = 1.0f / sqrtf(ss * (1.0f / HD) + RMS_EPS) * (1.0f - LAMBDA_INIT);
        o0 = o0 * r * a.diff_subln_g[2 * lane]; o1 = o1 * r * a.diff_subln_g[2 * lane + 1];
        *(unsigned*)(Ob + (rb + q) * D + h * HD + 2 * lane) = pk2(o0, o1);
    }
}

__global__ void __launch_bounds__(NTHR, 2) fwd(Args a) {
    extern __shared__ __attribute__((aligned(16))) unsigned char lds_raw[];
    LAS unsigned char* lds = (LAS unsigned char*)lds_raw;
    volatile LAS unsigned* MISC = (volatile LAS unsigned*)(lds + MISC_OFF);
    const int tid = threadIdx.x, lane = tid & 63, wave = __builtin_amdgcn_readfirstlane(tid >> 6);
    const int G = gridDim.x, blk = blockIdx.x;
    const int gtid = blk * NTHR + tid, gthreads = G * NTHR, gw = blk * NWAVES + wave, ngw = G * NWAVES;
    for (int u = tid; u < 64; u += NTHR) MISC[u] = 0u;
    __syncthreads();
    unsigned* ctl = (unsigned*)(a.ws + WS_CTL);
    XcdBarrier bar = xcd_barrier_post(ctl + CW_BAR, MISC + 8);
    const float* mod = (const float*)(a.ws + WS_MOD);
    bf16* Hb = (bf16*)(a.ws + WS_H); bf16* Qb = (bf16*)(a.ws + WS_Q); bf16* Kb = (bf16*)(a.ws + WS_K);
    bf16* Ob = (bf16*)(a.ws + WS_O); bf16* Yb = (bf16*)(a.ws + WS_Y); bf16* HHb = (bf16*)(a.ws + WS_HH);

    p_mod(a, gtid, gthreads);
    xcd_barrier(bar);
    {
        const float* md = mod; const float* ng = a.norm_g;
        p_norm_in(a.x, ng, md, md + 1024, Hb, gw, ngw, lane); xcd_barrier(bar);
        naive_gemm<1>(lds, Hb, D, a.moba_w_qkv, 3 * D, 3 * D, Qb, D, 0.08838834764831845f * LOG2E, blk, G, tid);
        xcd_barrier(bar);
        p_kmean(Kb, (float*)(a.ws + WS_KMEAN), gtid, gthreads); xcd_barrier(bar);
        p_gate(Qb, (const float*)(a.ws + WS_KMEAN), (unsigned*)(a.ws + WS_SEL), gtid, gthreads); xcd_barrier(bar);
        p_moba_attn(a, lds, gw, ngw, wave, lane);
        xcd_barrier(bar);
        naive_gemm<0>(lds, Ob, D, a.moba_w_o, D, D, Yb, D, 1.f, blk, G, tid);
        xcd_barrier(bar);
        p_post(a.x, Yb, ng + D, md + 2048, a.out, ng + 2 * D, md + 3072, md + 4096, Hb, gw, ngw, lane);
        xcd_barrier(bar);
        naive_gemm<2>(lds, Hb, D, a.ffn_w_in, 2 * DFF, DFF, HHb, DFF, 1.f, blk, G, tid);
        xcd_barrier(bar);
        naive_gemm<0>(lds, HHb, DFF, a.ffn_w_out, D, D, Yb, D, 1.f, blk, G, tid);
        xcd_barrier(bar);
        const float* md1 = mod + (size_t)2 * 6144; const float* ng1 = a.norm_g + (size_t)4 * D;
        p_post(a.out, Yb, ng + 3 * D, md + 5120, a.out, ng1, md1, md1 + 1024, Hb, gw, ngw, lane); xcd_barrier(bar);
    }
    {
        const float* md = mod + (size_t)2 * 6144; const float* ng = a.norm_g + (size_t)4 * D;
        naive_gemm<1>(lds, Hb, D, a.diff_w_qkv, 3 * D, 3 * D, Qb, D, 0.125f * LOG2E, blk, G, tid);
        xcd_barrier(bar);
        p_diff_attn(a, lds, gw, ngw, wave, lane);
        xcd_barrier(bar);
        naive_gemm<0>(lds, Ob, D, a.diff_w_o, D, D, Yb, D, 1.f, blk, G, tid);
        xcd_barrier(bar);
        p_post(a.out, Yb, ng + D, md + 2048, a.out, ng + 2 * D, md + 3072, md + 4096, Hb, gw, ngw, lane);
        xcd_barrier(bar);
        naive_gemm<2>(lds, Hb, D, a.ffn_w_in + (size_t)D * 2 * DFF, 2 * DFF, DFF, HHb, DFF, 1.f, blk, G, tid);
        xcd_barrier(bar);
        naive_gemm<0>(lds, HHb, DFF, a.ffn_w_out + (size_t)DFF * D, D, D, Yb, D, 1.f, blk, G, tid);
        xcd_barrier(bar);
        p_post(a.out, Yb, ng + 3 * D, md + 5120, a.out, nullptr, nullptr, nullptr, nullptr, gw, ngw, lane);
    }
}

extern "C" void kernel_launch(void* const* d_in, const int* in_sizes, int n_in, void* d_out, int out_size, void* d_ws, size_t ws_size, hipStream_t stream) {
    static int grid = 0;
    if (grid == 0) {
        if (n_in != 14 || out_size != M * D || ws_size < WS_END) { fprintf(stderr, "kernel_launch: unexpected shapes n_in %d out %d ws %zu\n", n_in, out_size, ws_size); grid = -1; return; }
        int dev = 0, cus = 0;
        if (hipGetDevice(&dev) != hipSuccess || hipDeviceGetAttribute(&cus, hipDeviceAttributeMultiprocessorCount, dev) != hipSuccess) { grid = -1; return; }
        if (hipFuncSetAttribute((const void*)fwd, hipFuncAttributeMaxDynamicSharedMemorySize, LDS_BYTES) != hipSuccess) { fprintf(stderr, "hipFuncSetAttribute failed\n"); grid = -1; return; }
        grid = cus;
    }
    if (grid < 0) return;
    (void)hipMemsetAsync((char*)d_ws + WS_CTL, 0, CTL_ZERO_BYTES, stream);
    Args a{};
    a.x = (const float*)d_in[0]; a.c = (const float*)d_in[1]; a.rel_bias = (const float*)d_in[2]; a.ada_w = (const float*)d_in[3]; a.ada_b = (const float*)d_in[4];
    a.norm_g = (const float*)d_in[5]; a.moba_w_qkv = (const float*)d_in[6]; a.moba_w_o = (const float*)d_in[7]; a.diff_w_qkv = (const float*)d_in[8]; a.diff_w_o = (const float*)d_in[9];
    a.diff_lambda = (const float*)d_in[10]; a.diff_subln_g = (const float*)d_in[11]; a.ffn_w_in = (const float*)d_in[12]; a.ffn_w_out = (const float*)d_in[13];
    a.out = (float*)d_out; a.ws = (unsigned char*)d_ws;
    hipLaunchKernelGGL(fwd, dim3(grid), dim3(NTHR), LDS_BYTES, stream, a);
}
```

```cpp
#include <hip/hip_runtime.h>
#include <cstdio>
#include <cstdint>

#define GAS __attribute__((address_space(1)))
#define LAS __attribute__((address_space(3)))
typedef unsigned short bf16;
typedef float f32x4 __attribute__((ext_vector_type(4)));
typedef float f32x2 __attribute__((ext_vector_type(2)));
typedef unsigned u32x4 __attribute__((ext_vector_type(4)));
typedef unsigned u32x2 __attribute__((ext_vector_type(2)));

constexpr int BATCH = 2, SEQ = 8192, D = 1024, NH = 8, HD = 128, DFF = 2816, NBKT = 32;
constexpr int M = BATCH * SEQ;
constexpr int NWAVES = 8, NTHR = 512;
constexpr float RMS_EPS = 1e-6f;
constexpr float LOG2E = 1.4426950408889634f;
constexpr float LAMBDA_INIT = 0.35550906759096926f;

constexpr size_t MiB = 1u << 20;
constexpr size_t WS_CTL = 0, CTL_ZERO_BYTES = 1 * MiB;
constexpr size_t WS_MOD = 1 * MiB;
constexpr size_t WS_BLUT = WS_MOD + 128 * 1024;
constexpr size_t WS_KMEAN = WS_BLUT + 16 * 1024;
constexpr size_t WS_SEL = WS_KMEAN + 256 * 1024;
constexpr size_t WS_W = 2 * MiB, WL_STRIDE = 25 * MiB;
constexpr size_t WO_QKV = 0, WO_O = 6 * MiB, WO_IN = 8 * MiB, WO_OUT = 19 * MiB;
constexpr size_t WS_H = 52 * MiB;
constexpr size_t WS_Q = 84 * MiB, WS_K = 116 * MiB, WS_V = 148 * MiB;
constexpr size_t WS_HH = 84 * MiB;
constexpr size_t WS_O = 180 * MiB;
constexpr size_t WS_Y = 212 * MiB;
constexpr size_t WS_END = 244 * MiB;
constexpr int CW_BAR = 4096;

constexpr int LDS_BYTES = 147456;
constexpr int MISC_OFF = 131072 + 320;

#define RLX_AGENT __ATOMIC_RELAXED, __HIP_MEMORY_SCOPE_AGENT
__device__ __forceinline__ unsigned f2bf(float f) { unsigned u = __builtin_bit_cast(unsigned, f); return (u + 0x7fffu + ((u >> 16) & 1u)) >> 16; }
__device__ __forceinline__ unsigned pk2(float lo, float hi) { return f2bf(lo) | (f2bf(hi) << 16); }
__device__ __forceinline__ float bf2f(unsigned short b) { return __builtin_bit_cast(float, (unsigned)b << 16); }
__device__ __forceinline__ float bflo(unsigned w) { return __builtin_bit_cast(float, w << 16); }
__device__ __forceinline__ float bfhi(unsigned w) { return __builtin_bit_cast(float, w & 0xffff0000u); }

#define XB_TMO      128
#define XB_XCNT(j)  (256  + 64 * (j))
#define XB_XSUB(j)  (1280 + 64 * (j))
#define XB_XGEN(j)  (2304 + 64 * (j))
#define XB_TOP      3328
#define XB_TOPGEN   3392
#define XCD_BAR_WORDS 3456
#define XB_SPIN_CAP (1u << 25)
__device__ __forceinline__ unsigned xb_ld(unsigned* p)              { return __hip_atomic_load(p, __ATOMIC_RELAXED, __HIP_MEMORY_SCOPE_AGENT); }
__device__ __forceinline__ unsigned xb_add(unsigned* p, unsigned v) { return __hip_atomic_fetch_add(p, v, __ATOMIC_RELAXED, __HIP_MEMORY_SCOPE_AGENT); }
__device__ __forceinline__ unsigned xb_xcc_id() { return (unsigned)__builtin_amdgcn_s_getreg((3 << 11) | 20) & 0xFu; }
#define XB_SPIN(cond, bar) do { unsigned _sp = 0; while (cond) { __builtin_amdgcn_s_sleep(1); \
    if ((++_sp & 255u) == 0u) { if (xb_ld(&(bar)[XB_TMO])) break; if (_sp > XB_SPIN_CAP) { atomicAdd(&(bar)[XB_TMO], 1u); break; } } } } while (0)
struct XcdBarrier { unsigned* bar; unsigned x; volatile LAS unsigned* st; };
__device__ __forceinline__ XcdBarrier xcd_barrier_post(unsigned* bar, volatile LAS unsigned* st) {
    XcdBarrier b; b.bar = bar; b.x = xb_xcc_id(); b.st = st;
    if (threadIdx.x == 0) (void)xb_add(&bar[XB_XCNT(b.x)], 1u);
    return b;
}
__device__ __forceinline__ void xcd_barrier_complete(unsigned* bar, unsigned x, unsigned& nloc, unsigned& nx) {
    const unsigned G = gridDim.x * gridDim.y * gridDim.z;
    unsigned sum, cnt, mine, sp = 0u;
    for (;;) {
        sum = 0u; cnt = 0u; mine = 0u;
#pragma unroll
        for (unsigned j = 0; j < 16; ++j) { const unsigned c = xb_ld(&bar[XB_XCNT(j)]); sum += c; cnt += (c > 0u) ? 1u : 0u; mine = (j == x) ? c : mine; }
        if (sum == G) break;
        __builtin_amdgcn_s_sleep(1);
        if ((++sp & 255u) == 0u) { if (xb_ld(&bar[XB_TMO])) break; if (sp > XB_SPIN_CAP) { atomicAdd(&bar[XB_TMO], 1u); break; } }
    }
    nloc = mine > 0u ? mine : 1u; nx = cnt > 0u ? cnt : 1u;
}
__device__ __forceinline__ void xcd_barrier(const XcdBarrier& b) {
    asm volatile("s_waitcnt vmcnt(0)" ::: "memory");
    __syncthreads();
    if (threadIdx.x == 0) {
        unsigned* bar = b.bar;
        __builtin_amdgcn_s_waitcnt(0);
        unsigned nloc = b.st[0], nx = b.st[1];
        if (nloc == 0u) { xcd_barrier_complete(bar, b.x, nloc, nx); b.st[0] = nloc; b.st[1] = nx; }
        const unsigned old = xb_add(&bar[XB_XSUB(b.x)], 1u);
        const unsigned gen = old / nloc;
        if (old + 1u == (gen + 1u) * nloc) {
            __builtin_amdgcn_fence(__ATOMIC_RELEASE, "agent");
            asm volatile("s_waitcnt vmcnt(0)" ::: "memory");
            const unsigned og = xb_add(&bar[XB_TOP], 1u);
            const unsigned tg = og / nx;
            if (og + 1u == (tg + 1u) * nx) xb_add(&bar[XB_TOPGEN], 1u);
            else XB_SPIN(xb_ld(&bar[XB_TOPGEN]) == tg, bar);
            __builtin_amdgcn_fence(__ATOMIC_ACQUIRE, "agent");
            xb_add(&bar[XB_XGEN(b.x)], 1u);
            asm volatile("s_waitcnt vmcnt(0)" ::: "memory");
        } else {
            XB_SPIN(xb_ld(&bar[XB_XGEN(b.x)]) == gen, bar);
            __builtin_amdgcn_fence(__ATOMIC_ACQUIRE, "agent");
            asm volatile("s_waitcnt vmcnt(0)" ::: "memory");
        }
    }
    __syncthreads();
}

namespace pg8 {
#define PG8_LAS __attribute__((address_space(3)))
typedef unsigned short bf16_t;
typedef short bf16x8 __attribute__((ext_vector_type(8)));
typedef float f32x4 __attribute__((ext_vector_type(4)));
typedef unsigned u32x4 __attribute__((ext_vector_type(4)));
constexpr int BM = 256, BK = 64, HALF = 128, HTB = HALF * BK * 2  , STAGE_BYTES = 8 * HTB, NXCD = 8, WGM = 8;

__host__ __device__ __forceinline__ int lds_byte(int r, int c) { const int st = (r >> 4) * 2 + (c >> 5), rr = r & 15, cc = c & 31, ob = rr * 64 + cc * 2; return st * 1024 + (ob ^ (((ob >> 9) & 1) << 5)); }
__host__ __device__ __forceinline__ void stage_rc(int b, int& R, int& C) { const int st = b / 1024, sb = b % 1024, swz = sb ^ (((sb >> 9) & 1) << 5); R = (st >> 1) * 16 + swz / 64; C = (st & 1) * 32 + (swz % 64) / 2; }
__host__ __device__ __forceinline__ int perm32(int rho) { const int n = rho >> 4, i = rho & 15; return 8 * (i >> 2) + 4 * n + (i & 3); }

struct Unit { int pm, pn; };
struct Gemm { const bf16_t* A; const bf16_t* Bt; int M, N, K; };

struct StaticOrder {
    int nM, nN, nwg, G, c;
    __host__ __device__ void init(int M, int N, int G_, int c_) { nM = M / BM; nN = N / BM; nwg = nM * nN; G = G_; c = c_; }
    __host__ __device__ bool next(int i, Unit& u) const {
        const long L = (long)i * G + c; if (L >= nwg) return false;
        int wgid = (int)L; { const int q = nwg / NXCD, r = nwg % NXCD, xcd = wgid % NXCD, off = wgid / NXCD; wgid = (xcd < r ? xcd * (q + 1) : r * (q + 1) + (xcd - r) * q) + off; }
        const int nig = WGM * nN, gid = wgid / nig, fm = gid * WGM, gsz = (nM - fm) < WGM ? (nM - fm) : WGM;
        u.pm = fm + ((wgid % nig) % gsz); u.pn = (wgid % nig) / gsz; return true;
    }
    __device__ __forceinline__ void a_ready(const Unit&) const {}
    __device__ __forceinline__ void done(const Unit&) const {}
};

__device__ __forceinline__ unsigned cvt_pk_bf16(float lo, float hi) { unsigned r; asm volatile("v_cvt_pk_bf16_f32 %0, %1, %2" : "=v"(r) : "v"(lo), "v"(hi)); return r; }
typedef float f32x2 __attribute__((ext_vector_type(2)));
__device__ __forceinline__ f32x2 gelu_pk(f32x2 v) {
    const f32x2 av = __builtin_elementwise_abs(v), d = av * 0.2316418882f + 1.0f;
    f32x2 t; t.x = __builtin_amdgcn_rcpf(d.x); t.y = __builtin_amdgcn_rcpf(d.y);
    f32x2 q = t * 0.5307027145f + (-0.7265760135f); q = q * t + 0.7107068705f; q = q * t + (-0.142248368f); q = q * t + 0.127414796f; q = q * t;
    const f32x2 s = (v * v) * (-0.72134752044f);
    f32x2 e; e.x = __builtin_amdgcn_exp2f(s.x); e.y = __builtin_amdgcn_exp2f(s.y);
    const f32x2 m = v * (q * e), r = v - m;
    f32x2 o; o.x = v.x < 0.f ? m.x : r.x; o.y = v.y < 0.f ? m.y : r.y; return o;
}

template <int ACT  > struct EpiBf16 {
    static constexpr bool PERM = true, AFTER_DRAIN = false; static_assert(ACT == 0 || ACT == 1, "EpiBf16: ACT is 0 (none) or 1 (gelu_pk)");
    bf16_t* O; int ldc; const float* bias; int split_cols; size_t split_stride; float scale0;
    __device__ __forceinline__ void operator()(const f32x4 (&acc)[2][2][4][2], const Unit& u, int wr, int wc, int fr, int fq) const {
        const int row0 = u.pm * BM + wr * 64 + fr; int colt = u.pn * BM; bf16_t* base = O;
        float sc = 1.f; if (split_cols) { const int t = colt / split_cols; base += (size_t)t * split_stride; colt -= t * split_cols; if (t == 0) sc = scale0; }
        const int col0 = colt + wc * 32 + 8 * fq, bcol0 = u.pn * BM + wc * 32 + 8 * fq;
        f32x4 bv[2][2];
#pragma unroll
        for (int bj = 0; bj < 2; ++bj)
#pragma unroll
            for (int n = 0; n < 2; ++n) bv[bj][n] = bias ? *(const f32x4*)(bias + bcol0 + bj * HALF + 4 * n) : (f32x4){0.f, 0.f, 0.f, 0.f};
#pragma unroll
        for (int ai = 0; ai < 2; ++ai)
#pragma unroll
            for (int m = 0; m < 4; ++m) { bf16_t* rowp = base + (size_t)(row0 + ai * HALF + m * 16) * ldc + col0;
#pragma unroll
                for (int bj = 0; bj < 2; ++bj) { f32x4 v0 = acc[ai][bj][m][0] + bv[bj][0], v1 = acc[ai][bj][m][1] + bv[bj][1];
                    if (ACT == 1) { f32x2 a = gelu_pk((f32x2){v0[0], v0[1]}), b = gelu_pk((f32x2){v0[2], v0[3]}), c = gelu_pk((f32x2){v1[0], v1[1]}), d = gelu_pk((f32x2){v1[2], v1[3]});
                        v0 = (f32x4){a.x, a.y, b.x, b.y}; v1 = (f32x4){c.x, c.y, d.x, d.y}; }
                    v0 = v0 * sc; v1 = v1 * sc; u32x4 w; w.x = cvt_pk_bf16(v0[0], v0[1]); w.y = cvt_pk_bf16(v0[2], v0[3]); w.z = cvt_pk_bf16(v1[0], v1[1]); w.w = cvt_pk_bf16(v1[2], v1[3]);
                    *(u32x4*)(rowp + bj * HALF) = w; } }
    }
};

struct EpiSwiglu {
    static constexpr bool PERM = true, AFTER_DRAIN = false;
    bf16_t* O; int ldc;
    __device__ __forceinline__ void operator()(const f32x4 (&acc)[2][2][4][2], const Unit& u, int wr, int wc, int fr, int fq) const {
        const int row0 = u.pm * BM + wr * 64 + fr, col0 = u.pn * HALF + wc * 32 + 8 * fq;
#pragma unroll
        for (int ai = 0; ai < 2; ++ai)
#pragma unroll
            for (int m = 0; m < 4; ++m) { bf16_t* rowp = O + (size_t)(row0 + ai * HALF + m * 16) * ldc + col0;
                float v[8];
#pragma unroll
                for (int n = 0; n < 2; ++n)
#pragma unroll
                    for (int e = 0; e < 4; ++e) { const float g = acc[ai][0][m][n][e], uu = acc[ai][1][m][n][e];
                        v[n * 4 + e] = g * __builtin_amdgcn_rcpf(1.0f + __builtin_amdgcn_exp2f(-1.4426950408889634f * g)) * uu; }
                u32x4 w; w.x = cvt_pk_bf16(v[0], v[1]); w.y = cvt_pk_bf16(v[2], v[3]); w.z = cvt_pk_bf16(v[4], v[5]); w.w = cvt_pk_bf16(v[6], v[7]);
                *(u32x4*)rowp = w; }
    }
};
template <class Epi, class Sched, bool ALIGN_EPI = false, bool SP2 = false>
__device__ __forceinline__ void gemm_phase(PG8_LAS unsigned char* lds, const Gemm g, const Sched& S, const Epi& E) {
    const int tid = threadIdx.x, wid = __builtin_amdgcn_readfirstlane(tid >> 6), lane = tid & 63, wr = wid >> 2, wc = wid & 3, fr = lane & 15, fq = lane >> 4;
    const int K = g.K, nt = K / BK;
    unsigned voffA[2], voffB[2];
#pragma unroll
    for (int i = 0; i < 2; ++i) { int R, C; stage_rc(tid * 16 + i * 8192, R, C); const int Rb = Epi::PERM ? ((R & ~31) + perm32(R & 31)) : R;
        voffA[i] = (unsigned)(R * K + C) * 2u; voffB[i] = (unsigned)(Rb * K + C) * 2u; }
    const size_t kstep = (size_t)(BK * 2);
    const size_t hstep = (size_t)HALF * K * 2;
    const size_t tstep = 2 * hstep;
    const unsigned ldsw = (unsigned)wid * 1024u;
    const int aoff = lds_byte(wr * 64 + fr, fq * 8), boff = lds_byte(wc * 32 + fr, fq * 8);
#define PG8_SA(b, h) (((b) * 2 + (h)) * HTB)
#define PG8_SB(b, h) ((4 + (b) * 2 + (h)) * HTB)
#define PG8_STAGE(bufoff, gbase, voff) do { _Pragma("unroll") for (int _i = 0; _i < 2; ++_i) \
        __builtin_amdgcn_global_load_lds((const unsigned*)((const char*)(gbase) + (voff)[_i]), (PG8_LAS unsigned*)(lds + (bufoff) + ldsw + _i * 8192), 16, 0, 0); } while (0)
#define PG8_LDA(dst, b, h) do { _Pragma("unroll") for (int m = 0; m < 4; ++m) _Pragma("unroll") for (int k = 0; k < 2; ++k) dst[m][k] = *(const PG8_LAS bf16x8*)(lds + PG8_SA(b, h) + aoff + m * 2048 + k * 1024); } while (0)
#define PG8_LDB(dst, b, h) do { _Pragma("unroll") for (int n = 0; n < 2; ++n) _Pragma("unroll") for (int k = 0; k < 2; ++k) dst[n][k] = *(const PG8_LAS bf16x8*)(lds + PG8_SB(b, h) + boff + n * 2048 + k * 1024); } while (0)
#define PG8_MMA(ai, bj, At, Bt) do { __builtin_amdgcn_s_setprio(1); _Pragma("unroll") for (int m = 0; m < 4; ++m) _Pragma("unroll") for (int n = 0; n < 2; ++n) _Pragma("unroll") for (int k = 0; k < 2; ++k) \
        acc[ai][bj][m][n] = __builtin_amdgcn_mfma_f32_16x16x32_bf16(Bt[n][k], At[m][k], acc[ai][bj][m][n], 0, 0, 0); __builtin_amdgcn_s_setprio(0); } while (0)
#define PG8_WAIT_V(n) asm volatile("s_waitcnt vmcnt(" #n ")" ::: "memory")
#define PG8_WAIT_L(n) asm volatile("s_waitcnt lgkmcnt(" #n ")" ::: "memory")
#define PG8_BAR __builtin_amdgcn_s_barrier()
#define PG8_SCHED __builtin_amdgcn_sched_barrier(0)
    Unit cur, nxt; int ui = 0;
    if (!S.next(0, cur)) return;
    f32x4 acc[2][2][4][2];
#pragma unroll
    for (int a = 0; a < 2; ++a)
#pragma unroll
        for (int b = 0; b < 2; ++b)
#pragma unroll
            for (int m = 0; m < 4; ++m)
#pragma unroll
                for (int n = 0; n < 2; ++n) acc[a][b][m][n] = (f32x4){0.f, 0.f, 0.f, 0.f};
    bf16x8 At[4][2], B0[2][2], B1[2][2];
    const char* cA = (const char*)g.A + (size_t)cur.pm * tstep; const char* cB = (const char*)g.Bt + (size_t)cur.pn * tstep;
    S.a_ready(cur);
    if constexpr (SP2) {
        PG8_STAGE(PG8_SB(0, 0), cB, voffB); PG8_STAGE(PG8_SB(0, 1), cB + hstep, voffB); PG8_STAGE(PG8_SA(0, 0), cA, voffA); PG8_STAGE(PG8_SA(0, 1), cA + hstep, voffA);
        if (wr == 1) PG8_BAR;
        PG8_WAIT_V(2); PG8_BAR;
        PG8_STAGE(PG8_SB(1, 0), cB + kstep, voffB); PG8_STAGE(PG8_SA(1, 0), cA + kstep, voffA); PG8_STAGE(PG8_SB(1, 1), cB + hstep + kstep, voffB);
        PG8_WAIT_V(6); PG8_BAR;
    } else {
        PG8_STAGE(PG8_SB(0, 0), cB, voffB); PG8_STAGE(PG8_SA(0, 0), cA, voffA); PG8_STAGE(PG8_SB(0, 1), cB + hstep, voffB); PG8_STAGE(PG8_SA(0, 1), cA + hstep, voffA);
        if (wr == 1) PG8_BAR;
        PG8_WAIT_V(4); PG8_BAR;
        PG8_STAGE(PG8_SB(1, 0), cB + kstep, voffB); PG8_STAGE(PG8_SA(1, 0), cA + kstep, voffA); PG8_STAGE(PG8_SB(1, 1), cB + hstep + kstep, voffB);
        PG8_WAIT_V(6); PG8_BAR;
    }
    for (;;) {
        const bool has_next = S.next(ui + 1, nxt);
        const char* nA = has_next ? (const char*)g.A + (size_t)nxt.pm * tstep : cA; const char* nB = has_next ? (const char*)g.Bt + (size_t)nxt.pn * tstep : cB;
        for (int t = 0; t < nt; t += 2) {
            const bool last = (t == nt - 2);
            const char* a1 = cA + (size_t)(t + 1) * kstep;
            const char* a2 = last ? nA : cA + (size_t)(t + 2) * kstep; const char* b2 = last ? nB : cB + (size_t)(t + 2) * kstep;
            const char* a3 = a2 + kstep; const char* b3 = b2 + kstep;
            if (last && has_next) S.a_ready(nxt);
            if constexpr (SP2) {
            PG8_LDB(B0, 0, 0); PG8_LDB(B1, 0, 1); PG8_SCHED; PG8_LDA(At, 0, 0); PG8_STAGE(PG8_SA(1, 1), a1 + hstep, voffA);
            PG8_WAIT_V(8); PG8_WAIT_L(0); PG8_BAR; PG8_MMA(0, 0, At, B0); PG8_MMA(0, 1, At, B1); PG8_BAR; PG8_SCHED;
            PG8_LDA(At, 0, 1); PG8_STAGE(PG8_SB(0, 0), b2, voffB); PG8_STAGE(PG8_SB(0, 1), b2 + hstep, voffB); PG8_STAGE(PG8_SA(0, 0), a2, voffA);
            PG8_WAIT_V(8); PG8_WAIT_L(0); PG8_BAR; PG8_MMA(1, 0, At, B0); PG8_MMA(1, 1, At, B1); PG8_BAR; PG8_SCHED;
            PG8_LDB(B0, 1, 0); PG8_LDB(B1, 1, 1); PG8_SCHED; PG8_LDA(At, 1, 0); PG8_STAGE(PG8_SA(0, 1), a2 + hstep, voffA);
            PG8_WAIT_V(8); PG8_WAIT_L(0); PG8_BAR; PG8_MMA(0, 0, At, B0); PG8_MMA(0, 1, At, B1); PG8_BAR; PG8_SCHED;
            PG8_LDA(At, 1, 1); PG8_STAGE(PG8_SB(1, 0), b3, voffB); PG8_STAGE(PG8_SB(1, 1), b3 + hstep, voffB); PG8_STAGE(PG8_SA(1, 0), a3, voffA);
            PG8_WAIT_V(8); PG8_WAIT_L(0); PG8_BAR; PG8_MMA(1, 0, At, B0); PG8_MMA(1, 1, At, B1); PG8_BAR; PG8_SCHED;
            } else {
            PG8_LDB(B0, 0, 0); PG8_SCHED; PG8_LDA(At, 0, 0); PG8_STAGE(PG8_SA(1, 1), a1 + hstep, voffA);
            PG8_WAIT_L(8); PG8_BAR; PG8_WAIT_L(0); PG8_MMA(0, 0, At, B0); PG8_BAR; PG8_SCHED;
            PG8_LDB(B1, 0, 1); PG8_STAGE(PG8_SB(0, 0), b2, voffB);
            PG8_BAR; PG8_WAIT_L(0); PG8_MMA(0, 1, At, B1); PG8_BAR;
            PG8_LDA(At, 0, 1); PG8_STAGE(PG8_SA(0, 0), a2, voffA);
            PG8_BAR; PG8_WAIT_L(0); PG8_MMA(1, 0, At, B0); PG8_BAR; PG8_SCHED;
            PG8_STAGE(PG8_SB(0, 1), b2 + hstep, voffB);
            PG8_WAIT_V(6); PG8_BAR; PG8_MMA(1, 1, At, B1); PG8_BAR;
            PG8_LDB(B0, 1, 0); PG8_SCHED; PG8_LDA(At, 1, 0); PG8_STAGE(PG8_SA(0, 1), a2 + hstep, voffA);
            PG8_WAIT_L(8); PG8_BAR; PG8_WAIT_L(0); PG8_MMA(0, 0, At, B0); PG8_BAR; PG8_SCHED;
            PG8_LDB(B1, 1, 1); PG8_STAGE(PG8_SB(1, 0), b3, voffB);
            PG8_BAR; PG8_WAIT_L(0); PG8_MMA(0, 1, At, B1); PG8_BAR;
            PG8_LDA(At, 1, 1); PG8_STAGE(PG8_SA(1, 0), a3, voffA);
            PG8_BAR; PG8_WAIT_L(0); PG8_MMA(1, 0, At, B0); PG8_BAR; PG8_SCHED;
            PG8_STAGE(PG8_SB(1, 1), b3 + hstep, voffB);
            PG8_WAIT_V(6); PG8_BAR; PG8_MMA(1, 1, At, B1); PG8_BAR;
            }
        }
        if constexpr (ALIGN_EPI) { if (wr == 0) PG8_BAR; }
        if constexpr (!Epi::AFTER_DRAIN) { E(acc, cur, wr, wc, fr, fq); S.done(cur); }
        if (!has_next) break;
#pragma unroll
        for (int a = 0; a < 2; ++a)
#pragma unroll
            for (int b = 0; b < 2; ++b)
#pragma unroll
                for (int m = 0; m < 4; ++m)
#pragma unroll
                    for (int n = 0; n < 2; ++n) acc[a][b][m][n] = (f32x4){0.f, 0.f, 0.f, 0.f};
        cur = nxt; cA = nA; cB = nB; ++ui;
        if constexpr (ALIGN_EPI) { if (wr == 1) PG8_BAR; }
    }
    PG8_WAIT_V(0);
    if constexpr (!ALIGN_EPI) { if (wr == 0) PG8_BAR; }
    PG8_BAR;
    if constexpr (Epi::AFTER_DRAIN) { E.fused(acc, cur, wr, wc, fr, fq, lds, wid, lane); S.done(cur); }
#undef PG8_SA
#undef PG8_SB
#undef PG8_STAGE
#undef PG8_LDA
#undef PG8_LDB
#undef PG8_MMA
#undef PG8_WAIT_V
#undef PG8_WAIT_L
#undef PG8_BAR
#undef PG8_SCHED
}
}

__device__ __forceinline__ float wave_sum(float v) {
#pragma unroll
    for (int o = 1; o < 64; o <<= 1) v += __shfl_xor(v, o);
    return v;
}
__device__ __forceinline__ float wave_max(float v) {
#pragma unroll
    for (int o = 1; o < 64; o <<= 1) v = fmaxf(v, __shfl_xor(v, o));
    return v;
}
__device__ __forceinline__ float silu_f(float v) { return v / (1.f + __expf(-v)); }

struct Args {
    const float* x; const float* c; const float* rel_bias; const float* ada_w; const float* ada_b; const float* norm_g;
    const float* moba_w_qkv; const float* moba_w_o; const float* diff_w_qkv; const float* diff_w_o;
    const float* diff_lambda; const float* diff_subln_g; const float* ffn_w_in; const float* ffn_w_out;
    float* out; unsigned char* ws;
};

__device__ __forceinline__ int t5_bucket(int rel) {
    const int n = rel < 0 ? 0 : rel;
    const float nf = (float)(n < 1 ? 1 : n);
    int large = 16 + (int)(logf(nf / 16.0f) / 4.852030263919617f * 16.0f);
    large = large < 31 ? large : 31;
    return n < 16 ? n : large;
}

__device__ __forceinline__ void p_mod(const Args& a, int gtid, int gthreads) {
    float* mod = (float*)(a.ws + WS_MOD);
    for (int idx = gtid; idx < 2 * 6144; idx += gthreads) {
        const int l = idx / 6144, j = idx % 6144;
        const float* w = a.ada_w + (size_t)l * D * 6144 + j;
        float s0 = 0.f, s1 = 0.f;
        for (int k = 0; k < D; ++k) { const float wv = w[(size_t)k * 6144]; s0 += silu_f(a.c[k]) * wv; s1 += silu_f(a.c[D + k]) * wv; }
        const float bb = a.ada_b[l * 6144 + j];
        mod[(l * 2 + 0) * 6144 + j] = s0 + bb; mod[(l * 2 + 1) * 6144 + j] = s1 + bb;
    }
    int* blut = (int*)(a.ws + WS_BLUT);
    for (int r = gtid; r < 2048; r += gthreads) blut[r] = t5_bucket(r);
}


__device__ __forceinline__ void transpose_item(const float* W, int K, int N, int k0, int n0, bf16* WT, int dst_row0, LAS float* scr, int lane) {
#pragma unroll 8
    for (int i = 0; i < 32; ++i) { const int kk = 2 * i + (lane >> 5); scr[kk * 33 + (lane & 31)] = W[(size_t)(k0 + kk) * N + n0 + (lane & 31)]; }
    asm volatile("s_waitcnt lgkmcnt(0)" ::: "memory");
    const int c = lane & 7;
#pragma unroll
    for (int j = 0; j < 4; ++j) { const int n = (lane >> 3) + 8 * j; const LAS float* sp = scr + (8 * c) * 33 + n;
        u32x4 o; o.x = pk2(sp[0 * 33], sp[1 * 33]); o.y = pk2(sp[2 * 33], sp[3 * 33]); o.z = pk2(sp[4 * 33], sp[5 * 33]); o.w = pk2(sp[6 * 33], sp[7 * 33]);
        *(u32x4*)(WT + (size_t)(dst_row0 + n) * K + k0 + 8 * c) = o; }
    asm volatile("s_waitcnt lgkmcnt(0)" ::: "memory");
}
__device__ __forceinline__ void p_weights(const Args& a, LAS unsigned char* lds, int gw, int ngw, int wave, int lane) {
    LAS float* scr = (LAS float*)(lds + wave * 16384);
    constexpr int I_QKV = (D / 64) * (3 * D / 32), I_O = (D / 64) * (D / 32), I_IN = (D / 64) * (2 * DFF / 32), I_OUT = (DFF / 64) * (D / 32);
    constexpr int PER_L = I_QKV + I_O + I_IN + I_OUT;
    for (int it = gw; it < 2 * PER_L; it += ngw) {
        const int l = it / PER_L; int r = it % PER_L;
        unsigned char* wl = a.ws + WS_W + (size_t)l * WL_STRIDE;
        if (r < I_QKV) { const int nb = 3 * D / 32, kb = r / nb, n0 = (r % nb) * 32; transpose_item(l == 0 ? a.moba_w_qkv : a.diff_w_qkv, D, 3 * D, kb * 64, n0, (bf16*)(wl + WO_QKV), n0, scr, lane); continue; } r -= I_QKV;
        if (r < I_O) { const int nb = D / 32, kb = r / nb, n0 = (r % nb) * 32; transpose_item(l == 0 ? a.moba_w_o : a.diff_w_o, D, D, kb * 64, n0, (bf16*)(wl + WO_O), n0, scr, lane); continue; } r -= I_O;
        if (r < I_IN) { const int nb = 2 * DFF / 32, kb = r / nb, n0 = (r % nb) * 32;
            const int isu = n0 >= DFF ? 1 : 0, nn = n0 - isu * DFF, dst = 256 * (nn / 128) + 128 * isu + (nn % 128);
            transpose_item(a.ffn_w_in + (size_t)l * D * 2 * DFF, D, 2 * DFF, kb * 64, n0, (bf16*)(wl + WO_IN), dst, scr, lane); continue; } r -= I_IN;
        { const int nb = D / 32, kb = r / nb, n0 = (r % nb) * 32; transpose_item(a.ffn_w_out + (size_t)l * DFF * D, DFF, D, kb * 64, n0, (bf16*)(wl + WO_OUT), n0, scr, lane); }
    }
}

__device__ __forceinline__ void p_norm_in(const float* X, const float* g, const float* sh, const float* sc, bf16* H, int gw, int ngw, int lane) {
    for (int m = gw; m < M; m += ngw) {
        const int b = m / SEQ;
        const f32x4* xr = (const f32x4*)(X + (size_t)m * D) + lane;
        f32x4 v[4]; float s = 0.f;
#pragma unroll
        for (int j = 0; j < 4; ++j) { v[j] = xr[64 * j]; s += (v[j].x * v[j].x + v[j].y * v[j].y) + (v[j].z * v[j].z + v[j].w * v[j].w); }
        const float r = 1.0f / sqrtf(wave_sum(s) * (1.f / D) + RMS_EPS);
        u32x2* o = (u32x2*)(H + (size_t)m * D) + lane;
#pragma unroll
        for (int j = 0; j < 4; ++j) {
            const f32x4 gg = ((const f32x4*)g)[lane + 64 * j], s1 = ((const f32x4*)(sc + b * 6144))[lane + 64 * j], s0 = ((const f32x4*)(sh + b * 6144))[lane + 64 * j];
            const f32x4 h = v[j] * r * gg * (1.0f + s1) + s0;
            u32x2 w; w.x = pk2(h.x, h.y); w.y = pk2(h.z, h.w); o[64 * j] = w;
        }
    }
}
__device__ __forceinline__ void p_post(const float* Xin, const bf16* Y, const float* g1, const float* gate, float* Xout,
                                       const float* g2, const float* sh, const float* sc, bf16* H, int gw, int ngw, int lane) {
    for (int m = gw; m < M; m += ngw) {
        const int b = m / SEQ;
        const u32x2* yr = (const u32x2*)(Y + (size_t)m * D) + lane;
        const f32x4* xr = (const f32x4*)(Xin + (size_t)m * D) + lane;
        f32x4 y[4], xv[4]; float s = 0.f;
#pragma unroll
        for (int j = 0; j < 4; ++j) { const u32x2 w = yr[64 * j]; y[j] = (f32x4){bflo(w.x), bfhi(w.x), bflo(w.y), bfhi(w.y)}; xv[j] = xr[64 * j];
            s += (y[j].x * y[j].x + y[j].y * y[j].y) + (y[j].z * y[j].z + y[j].w * y[j].w); }
        const float r = 1.0f / sqrtf(wave_sum(s) * (1.f / D) + RMS_EPS);
        float s2 = 0.f;
#pragma unroll
        for (int j = 0; j < 4; ++j) {
            const f32x4 gg = ((const f32x4*)g1)[lane + 64 * j], gt = ((const f32x4*)(gate + b * 6144))[lane + 64 * j];
            xv[j] = xv[j] + gt * (y[j] * r * gg);
            s2 += (xv[j].x * xv[j].x + xv[j].y * xv[j].y) + (xv[j].z * xv[j].z + xv[j].w * xv[j].w);
            ((f32x4*)(Xout + (size_t)m * D))[lane + 64 * j] = xv[j];
        }
        if (H) {
            const float r2 = 1.0f / sqrtf(wave_sum(s2) * (1.f / D) + RMS_EPS);
            u32x2* o = (u32x2*)(H + (size_t)m * D) + lane;
#pragma unroll
            for (int j = 0; j < 4; ++j) {
                const f32x4 gg = ((const f32x4*)g2)[lane + 64 * j], s1 = ((const f32x4*)(sc + b * 6144))[lane + 64 * j], s0 = ((const f32x4*)(sh + b * 6144))[lane + 64 * j];
                const f32x4 h = xv[j] * r2 * gg * (1.0f + s1) + s0;
                u32x2 w; w.x = pk2(h.x, h.y); w.y = pk2(h.z, h.w); o[64 * j] = w;
            }
        }
    }
}

template <int MODE>
__device__ __forceinline__ void naive_gemm(LAS unsigned char* lds, const bf16* A, int K, const float* W, int ldw, int Nout, bf16* C, int ldc, float qscale, int blk, int nblk, int tid) {
    LAS float* As = (LAS float*)lds;
    LAS float* Ws = As + 16 * 132;
    LAS float* Wu = Ws + 16 * 132;
    const int ty = tid >> 4, tx = tid & 15;
    const int ntn = Nout / 128, ntiles = (M / 128) * ntn;
    for (int t = blk; t < ntiles; t += nblk) {
        const int tm = t / ntn, tn = t % ntn, row0 = tm * 128, col0 = tn * 128;
        float acc[4][8], acu[4][8];
#pragma unroll
        for (int i = 0; i < 4; ++i)
#pragma unroll
            for (int j = 0; j < 8; ++j) { acc[i][j] = 0.f; acu[i][j] = 0.f; }
        for (int k0 = 0; k0 < K; k0 += 16) {
            __syncthreads();
            { const int r = tid >> 2, kk = (tid & 3) * 4; const u32x2 w = *(const u32x2*)(A + (size_t)(row0 + r) * K + k0 + kk);
              As[(kk + 0) * 132 + r] = bflo(w.x); As[(kk + 1) * 132 + r] = bfhi(w.x); As[(kk + 2) * 132 + r] = bflo(w.y); As[(kk + 3) * 132 + r] = bfhi(w.y); }
            { const int kk = tid >> 5, cc = (tid & 31) * 4; const f32x4 w = *(const f32x4*)(W + (size_t)(k0 + kk) * ldw + col0 + cc);
              *(LAS f32x4*)(Ws + kk * 132 + cc) = w;
              if (MODE == 2) { const f32x4 u = *(const f32x4*)(W + (size_t)(k0 + kk) * ldw + DFF + col0 + cc); *(LAS f32x4*)(Wu + kk * 132 + cc) = u; } }
            __syncthreads();
#pragma unroll 2
            for (int kk = 0; kk < 16; ++kk) {
                const f32x4 av = *(LAS f32x4*)(As + kk * 132 + ty * 4);
                const f32x4 b0 = *(LAS f32x4*)(Ws + kk * 132 + tx * 8), b1 = *(LAS f32x4*)(Ws + kk * 132 + tx * 8 + 4);
                const float aa[4] = {av.x, av.y, av.z, av.w}; const float bb[8] = {b0.x, b0.y, b0.z, b0.w, b1.x, b1.y, b1.z, b1.w};
#pragma unroll
                for (int i = 0; i < 4; ++i)
#pragma unroll
                    for (int j = 0; j < 8; ++j) acc[i][j] += aa[i] * bb[j];
                if (MODE == 2) {
                    const f32x4 u0 = *(LAS f32x4*)(Wu + kk * 132 + tx * 8), u1 = *(LAS f32x4*)(Wu + kk * 132 + tx * 8 + 4);
                    const float uu[8] = {u0.x, u0.y, u0.z, u0.w, u1.x, u1.y, u1.z, u1.w};
#pragma unroll
                    for (int i = 0; i < 4; ++i)
#pragma unroll
                        for (int j = 0; j < 8; ++j) acu[i][j] += aa[i] * uu[j];
                }
            }
        }
#pragma unroll
        for (int i = 0; i < 4; ++i) {
            const int row = row0 + ty * 4 + i; int col = col0 + tx * 8; bf16* base = C; float sc = 1.f;
            if (MODE == 1) { const int tt = col / 1024; base = C + (size_t)tt * ((WS_K - WS_Q) / 2); col -= tt * 1024; if (tt == 0) sc = qscale; }
            float v[8];
#pragma unroll
            for (int j = 0; j < 8; ++j) { v[j] = acc[i][j] * sc; if (MODE == 2) v[j] = silu_f(acc[i][j]) * acu[i][j]; }
            u32x4 w; w.x = pk2(v[0], v[1]); w.y = pk2(v[2], v[3]); w.z = pk2(v[4], v[5]); w.w = pk2(v[6], v[7]);
            *(u32x4*)(base + (size_t)row * ldc + col) = w;
        }
    }
    __syncthreads();
}

__device__ __forceinline__ void p_kmean(const bf16* Kb, float* kmean, int gtid, int gthreads) {
    for (int idx = gtid; idx < BATCH * NH * 32 * HD; idx += gthreads) {
        const int d = idx % HD, blk = (idx / HD) % 32, h = (idx / (HD * 32)) % NH, b = idx / (HD * 32 * NH);
        const bf16* p = Kb + ((size_t)b * SEQ + blk * 256) * D + h * HD + d;
        float s = 0.f;
        for (int r = 0; r < 256; ++r) s += bf2f(p[(size_t)r * D]);
        kmean[idx] = s * (1.0f / 256.0f);
    }
}
__device__ __forceinline__ void p_gate(const bf16* Qb, const float* kmean, unsigned* sel, int gtid, int gthreads) {
    for (int idx = gtid; idx < BATCH * NH * SEQ; idx += gthreads) {
        const int q = idx % SEQ, h = (idx / SEQ) % NH, b = idx / (SEQ * NH);
        const int own = q >> 8;
        unsigned mask;
        if (own <= 3) mask = (1u << own) - 1u;
        else {
            const bf16* qp = Qb + ((size_t)b * SEQ + q) * D + h * HD;
            const float* km = kmean + (size_t)(b * NH + h) * 32 * HD;
            float b0 = -3e38f, b1 = -3e38f, b2 = -3e38f; int i0 = 0, i1 = 0, i2 = 0;
            for (int n = 0; n < own; ++n) {
                float g = 0.f;
                for (int d = 0; d < HD; d += 2) { const unsigned w = *(const unsigned*)(qp + d); g += bflo(w) * km[n * HD + d] + bfhi(w) * km[n * HD + d + 1]; }
                if (g > b0) { b2 = b1; i2 = i1; b1 = b0; i1 = i0; b0 = g; i0 = n; }
                else if (g > b1) { b2 = b1; i2 = i1; b1 = g; i1 = n; }
                else if (g > b2) { b2 = g; i2 = n; }
            }
            mask = (1u << i0) | (1u << i1) | (1u << i2);
        }
        sel[idx] = mask;
    }
}

template <int QKD>
__device__ __forceinline__ void naive_attn_row(const bf16* Qrow, const bf16* Kc, const bf16* Vc, int qpos, unsigned bmask, const float* relb, int h, const int* blut,
                                               LAS float* wq, LAS float* wp, int lane, float& o0, float& o1) {
    if (lane < QKD / 2) { const unsigned w = *(const unsigned*)(Qrow + 2 * lane); wq[2 * lane] = bflo(w); wq[2 * lane + 1] = bfhi(w); }
    asm volatile("s_waitcnt lgkmcnt(0)" ::: "memory");
    float m = -1e30f, l = 0.f; o0 = 0.f; o1 = 0.f;
    const int own = qpos >> 8;
    for (int j = 0; j <= own; ++j) {
        if (!((bmask >> j) & 1u)) continue;
        for (int c = 0; c < 4; ++c) {
            const int k0 = j * 256 + c * 64;
            if (k0 > qpos) break;
            const int key = k0 + lane;
            const bf16* kp = Kc + (size_t)key * D;
            float s = 0.f;
#pragma unroll
            for (int d = 0; d < QKD; d += 8) {
                const u32x4 w = *(const u32x4*)(kp + d);
                const f32x4 q0 = *(LAS f32x4*)(wq + d), q1 = *(LAS f32x4*)(wq + d + 4);
                s += bflo(w.x) * q0.x + bfhi(w.x) * q0.y + bflo(w.y) * q0.z + bfhi(w.y) * q0.w + bflo(w.z) * q1.x + bfhi(w.z) * q1.y + bflo(w.w) * q1.z + bfhi(w.w) * q1.w;
            }
            const int rel = qpos - key;
            const int bk = rel < 0 ? 0 : (rel < 2048 ? blut[rel] : 31);
            s += relb[bk * NH + h] * LOG2E;
            if (key > qpos) s = -__builtin_inff();
            const float cm = wave_max(s), mn = fmaxf(m, cm), alpha = exp2f(m - mn), p = exp2f(s - mn);
            l = l * alpha + wave_sum(p); o0 *= alpha; o1 *= alpha; m = mn;
            wp[lane] = p;
            asm volatile("s_waitcnt lgkmcnt(0)" ::: "memory");
            const bf16* vp = Vc + (size_t)k0 * D + 2 * lane;
#pragma unroll 8
            for (int jj = 0; jj < 64; ++jj) { const float pj = wp[jj]; const unsigned w = *(const unsigned*)(vp + (size_t)jj * D); o0 += pj * bflo(w); o1 += pj * bfhi(w); }
            asm volatile("s_waitcnt lgkmcnt(0)" ::: "memory");
        }
    }
    const float rl = 1.0f / l; o0 *= rl; o1 *= rl;
}

__device__ __forceinline__ void p_moba_attn(const Args& a, LAS unsigned char* lds, int gw, int ngw, int wave, int lane) {
    const bf16* Qb = (const bf16*)(a.ws + WS_Q); const bf16* Kb = (const bf16*)(a.ws + WS_K); const bf16* Vb = (const bf16*)(a.ws + WS_V);
    bf16* Ob = (bf16*)(a.ws + WS_O); const unsigned* sel = (const unsigned*)(a.ws + WS_SEL); const int* blut = (const int*)(a.ws + WS_BLUT);
    LAS float* wq = (LAS float*)lds + wave * 256; LAS float* wp = wq + 128;
    for (int idx = gw; idx < BATCH * NH * SEQ; idx += ngw) {
        const int q = idx % SEQ, h = (idx / SEQ) % NH, b = idx / (SEQ * NH);
        const size_t rb = (size_t)b * SEQ;
        const unsigned bm = sel[idx] | (1u << (q >> 8));
        float o0, o1;
        naive_attn_row<128>(Qb + (rb + q) * D + h * HD, Kb + rb * D + h * HD, Vb + rb * D + h * HD, q, bm, a.rel_bias, h, blut, wq, wp, lane, o0, o1);
        *(unsigned*)(Ob + (rb + q) * D + h * HD + 2 * lane) = pk2(o0, o1);
    }
}
__device__ __forceinline__ void p_diff_attn(const Args& a, LAS unsigned char* lds, int gw, int ngw, int wave, int lane) {
    const bf16* Qb = (const bf16*)(a.ws + WS_Q); const bf16* Kb = (const bf16*)(a.ws + WS_K); const bf16* Vb = (const bf16*)(a.ws + WS_V);
    bf16* Ob = (bf16*)(a.ws + WS_O); const int* blut = (const int*)(a.ws + WS_BLUT);
    LAS float* wq = (LAS float*)lds + wave * 256; LAS float* wp = wq + 128;
    float lam_full;
    { const float* lm = a.diff_lambda; const float p01 = wave_sum(lm[lane] * lm[64 + lane]), p23 = wave_sum(lm[128 + lane] * lm[192 + lane]); lam_full = __expf(p01) - __expf(p23) + LAMBDA_INIT; }
    for (int idx = gw; idx < BATCH * NH * SEQ; idx += ngw) {
        const int q = idx % SEQ, h = (idx / SEQ) % NH, b = idx / (SEQ * NH);
        const size_t rb = (size_t)b * SEQ;
        const int own = q >> 8; const unsigned bm = own >= 31 ? 0xffffffffu : ((1u << (own + 1)) - 1u);
        float a0, a1, b0, b1;
        naive_attn_row<64>(Qb + (rb + q) * D + h * HD, Kb + rb * D + h * HD, Vb + rb * D + h * HD, q, bm, a.rel_bias, h, blut, wq, wp, lane, a0, a1);
        naive_attn_row<64>(Qb + (rb + q) * D + h * HD + 64, Kb + rb * D + h * HD + 64, Vb + rb * D + h * HD, q, bm, a.rel_bias, h, blut, wq, wp, lane, b0, b1);
        float o0 = a0 - lam_full * b0, o1 = a1 - lam_full * b1;
        const float ss = wave_sum(o0 * o0 + o1 * o1);
        const float r = 1.0f / sqrtf(ss * (1.0f / HD) + RMS_EPS) * (1.0f - LAMBDA_INIT);
        o0 = o0 * r * a.diff_subln_g[2 * lane]; o1 = o1 * r * a.diff_subln_g[2 * lane + 1];
        *(unsigned*)(Ob + (rb + q) * D + h * HD + 2 * lane) = pk2(o0, o1);
    }
}

__global__ void __launch_bounds__(NTHR, 2) fwd(Args a) {
    extern __shared__ __attribute__((aligned(16))) unsigned char lds_raw[];
    LAS unsigned char* lds = (LAS unsigned char*)lds_raw;
    volatile LAS unsigned* MISC = (volatile LAS unsigned*)(lds + MISC_OFF);
    const int tid = threadIdx.x, lane = tid & 63, wave = __builtin_amdgcn_readfirstlane(tid >> 6);
    const int G = gridDim.x, blk = blockIdx.x;
    const int gtid = blk * NTHR + tid, gthreads = G * NTHR, gw = blk * NWAVES + wave, ngw = G * NWAVES;
    for (int u = tid; u < 64; u += NTHR) MISC[u] = 0u;
    __syncthreads();
    unsigned* ctl = (unsigned*)(a.ws + WS_CTL);
    XcdBarrier bar = xcd_barrier_post(ctl + CW_BAR, MISC + 8);
    const float* mod = (const float*)(a.ws + WS_MOD);
    bf16* Hb = (bf16*)(a.ws + WS_H); bf16* Qb = (bf16*)(a.ws + WS_Q); bf16* Kb = (bf16*)(a.ws + WS_K);
    bf16* Ob = (bf16*)(a.ws + WS_O); bf16* Yb = (bf16*)(a.ws + WS_Y); bf16* HHb = (bf16*)(a.ws + WS_HH);

    p_weights(a, lds, gw, ngw, wave, lane);
    p_mod(a, gtid, gthreads);
    xcd_barrier(bar);
    {
        const float* md = mod; const float* ng = a.norm_g;
        p_norm_in(a.x, ng, md, md + 1024, Hb, gw, ngw, lane); xcd_barrier(bar);
        { pg8::Gemm g{Hb, (const bf16*)(a.ws + WS_W + WO_QKV), M, 3 * D, D}; pg8::StaticOrder S; S.init(M, 3 * D, G, blk);
          pg8::EpiBf16<0> E{Qb, D, nullptr, D, (size_t)(WS_K - WS_Q) / 2, 0.08838834764831845f * LOG2E};
          pg8::gemm_phase<pg8::EpiBf16<0>, pg8::StaticOrder, true, true>(lds, g, S, E); }
        xcd_barrier(bar);
        p_kmean(Kb, (float*)(a.ws + WS_KMEAN), gtid, gthreads); xcd_barrier(bar);
        p_gate(Qb, (const float*)(a.ws + WS_KMEAN), (unsigned*)(a.ws + WS_SEL), gtid, gthreads); xcd_barrier(bar);
        p_moba_attn(a, lds, gw, ngw, wave, lane);
        xcd_barrier(bar);
        { pg8::Gemm g{Ob, (const bf16*)(a.ws + WS_W + WO_O), M, D, D}; pg8::StaticOrder S; S.init(M, D, G, blk);
          pg8::EpiBf16<0> E{Yb, D, nullptr, 0, 0, 1.f};
          pg8::gemm_phase<pg8::EpiBf16<0>, pg8::StaticOrder, true, true>(lds, g, S, E); }
        xcd_barrier(bar);
        p_post(a.x, Yb, ng + D, md + 2048, a.out, ng + 2 * D, md + 3072, md + 4096, Hb, gw, ngw, lane);
        xcd_barrier(bar);
        { pg8::Gemm g{Hb, (const bf16*)(a.ws + WS_W + WO_IN), M, 2 * DFF, D}; pg8::StaticOrder S; S.init(M, 2 * DFF, G, blk);
          pg8::EpiSwiglu E{HHb, DFF};
          pg8::gemm_phase<pg8::EpiSwiglu, pg8::StaticOrder, true, true>(lds, g, S, E); }
        xcd_barrier(bar);
        { pg8::Gemm g{HHb, (const bf16*)(a.ws + WS_W + WO_OUT), M, D, DFF}; pg8::StaticOrder S; S.init(M, D, G, blk);
          pg8::EpiBf16<0> E{Yb, D, nullptr, 0, 0, 1.f};
          pg8::gemm_phase<pg8::EpiBf16<0>, pg8::StaticOrder, true, true>(lds, g, S, E); }
        xcd_barrier(bar);
        const float* md1 = mod + (size_t)2 * 6144; const float* ng1 = a.norm_g + (size_t)4 * D;
        p_post(a.out, Yb, ng + 3 * D, md + 5120, a.out, ng1, md1, md1 + 1024, Hb, gw, ngw, lane); xcd_barrier(bar);
    }
    {
        const float* md = mod + (size_t)2 * 6144; const float* ng = a.norm_g + (size_t)4 * D;
        { pg8::Gemm g{Hb, (const bf16*)(a.ws + WS_W + WL_STRIDE + WO_QKV), M, 3 * D, D}; pg8::StaticOrder S; S.init(M, 3 * D, G, blk);
          pg8::EpiBf16<0> E{Qb, D, nullptr, D, (size_t)(WS_K - WS_Q) / 2, 0.125f * LOG2E};
          pg8::gemm_phase<pg8::EpiBf16<0>, pg8::StaticOrder, true, true>(lds, g, S, E); }
        xcd_barrier(bar);
        p_diff_attn(a, lds, gw, ngw, wave, lane);
        xcd_barrier(bar);
        { pg8::Gemm g{Ob, (const bf16*)(a.ws + WS_W + WL_STRIDE + WO_O), M, D, D}; pg8::StaticOrder S; S.init(M, D, G, blk);
          pg8::EpiBf16<0> E{Yb, D, nullptr, 0, 0, 1.f};
          pg8::gemm_phase<pg8::EpiBf16<0>, pg8::StaticOrder, true, true>(lds, g, S, E); }
        xcd_barrier(bar);
        p_post(a.out, Yb, ng + D, md + 2048, a.out, ng + 2 * D, md + 3072, md + 4096, Hb, gw, ngw, lane);
        xcd_barrier(bar);
        { pg8::Gemm g{Hb, (const bf16*)(a.ws + WS_W + WL_STRIDE + WO_IN), M, 2 * DFF, D}; pg8::StaticOrder S; S.init(M, 2 * DFF, G, blk);
          pg8::EpiSwiglu E{HHb, DFF};
          pg8::gemm_phase<pg8::EpiSwiglu, pg8::StaticOrder, true, true>(lds, g, S, E); }
        xcd_barrier(bar);
        { pg8::Gemm g{HHb, (const bf16*)(a.ws + WS_W + WL_STRIDE + WO_OUT), M, D, DFF}; pg8::StaticOrder S; S.init(M, D, G, blk);
          pg8::EpiBf16<0> E{Yb, D, nullptr, 0, 0, 1.f};
          pg8::gemm_phase<pg8::EpiBf16<0>, pg8::StaticOrder, true, true>(lds, g, S, E); }
        xcd_barrier(bar);
        p_post(a.out, Yb, ng + 3 * D, md + 5120, a.out, nullptr, nullptr, nullptr, nullptr, gw, ngw, lane);
    }
}

extern "C" void kernel_launch(void* const* d_in, const int* in_sizes, int n_in, void* d_out, int out_size, void* d_ws, size_t ws_size, hipStream_t stream) {
    static int grid = 0;
    if (grid == 0) {
        if (n_in != 14 || out_size != M * D || ws_size < WS_END) { fprintf(stderr, "kernel_launch: unexpected shapes n_in %d out %d ws %zu\n", n_in, out_size, ws_size); grid = -1; return; }
        int dev = 0, cus = 0;
        if (hipGetDevice(&dev) != hipSuccess || hipDeviceGetAttribute(&cus, hipDeviceAttributeMultiprocessorCount, dev) != hipSuccess) { grid = -1; return; }
        if (hipFuncSetAttribute((const void*)fwd, hipFuncAttributeMaxDynamicSharedMemorySize, LDS_BYTES) != hipSuccess) { fprintf(stderr, "hipFuncSetAttribute failed\n"); grid = -1; return; }
        grid = cus;
    }
    if (grid < 0) return;
    (void)hipMemsetAsync((char*)d_ws + WS_CTL, 0, CTL_ZERO_BYTES, stream);
    Args a{};
    a.x = (const float*)d_in[0]; a.c = (const float*)d_in[1]; a.rel_bias = (const float*)d_in[2]; a.ada_w = (const float*)d_in[3]; a.ada_b = (const float*)d_in[4];
    a.norm_g = (const float*)d_in[5]; a.moba_w_qkv = (const float*)d_in[6]; a.moba_w_o = (const float*)d_in[7]; a.diff_w_qkv = (const float*)d_in[8]; a.diff_w_o = (const float*)d_in[9];
    a.diff_lambda = (const float*)d_in[10]; a.diff_subln_g = (const float*)d_in[11]; a.ffn_w_in = (const float*)d_in[12]; a.ffn_w_out = (const float*)d_in[13];
    a.out = (float*)d_out; a.ws = (unsigned char*)d_ws;
    hipLaunchKernelGGL(fwd, dim3(grid), dim3(NTHR), LDS_BYTES, stream, a);
}
```

```cpp
#include <hip/hip_runtime.h>
#include <cstdio>
#include <cstdint>

#define GAS __attribute__((address_space(1)))
#define LAS __attribute__((address_space(3)))
typedef unsigned short bf16;
typedef float f32x4 __attribute__((ext_vector_type(4)));
typedef float f32x2 __attribute__((ext_vector_type(2)));
typedef unsigned u32x4 __attribute__((ext_vector_type(4)));
typedef unsigned u32x2 __attribute__((ext_vector_type(2)));

constexpr int BATCH = 2, SEQ = 8192, D = 1024, NH = 8, HD = 128, DFF = 2816, NBKT = 32;
constexpr int M = BATCH * SEQ;
constexpr int NWAVES = 8, NTHR = 512;
constexpr float RMS_EPS = 1e-6f;
constexpr float LOG2E = 1.4426950408889634f;
constexpr float LAMBDA_INIT = 0.35550906759096926f;

constexpr size_t MiB = 1u << 20;
constexpr size_t WS_CTL = 0, CTL_ZERO_BYTES = 1 * MiB;
constexpr size_t WS_MOD = 1 * MiB;
constexpr size_t WS_BLUT = WS_MOD + 128 * 1024;
constexpr size_t WS_KMEAN = WS_BLUT + 16 * 1024;
constexpr size_t WS_SEL = WS_KMEAN + 256 * 1024;
constexpr size_t WS_W = 2 * MiB, WL_STRIDE = 25 * MiB;
constexpr size_t WO_QKV = 0, WO_O = 6 * MiB, WO_IN = 8 * MiB, WO_OUT = 19 * MiB;
constexpr size_t WS_H = 52 * MiB;
constexpr size_t WS_Q = 84 * MiB, WS_K = 116 * MiB, WS_V = 148 * MiB;
constexpr size_t WS_HH = 84 * MiB;
constexpr size_t WS_O = 180 * MiB;
constexpr size_t WS_Y = 212 * MiB;
constexpr size_t WS_END = 244 * MiB;
constexpr int CW_BAR = 4096;

constexpr int LDS_BYTES = 147456;
constexpr int MISC_OFF = 131072 + 320;

#define RLX_AGENT __ATOMIC_RELAXED, __HIP_MEMORY_SCOPE_AGENT
__device__ __forceinline__ unsigned f2bf(float f) { unsigned u = __builtin_bit_cast(unsigned, f); return (u + 0x7fffu + ((u >> 16) & 1u)) >> 16; }
__device__ __forceinline__ unsigned pk2(float lo, float hi) { return f2bf(lo) | (f2bf(hi) << 16); }
__device__ __forceinline__ float bf2f(unsigned short b) { return __builtin_bit_cast(float, (unsigned)b << 16); }
__device__ __forceinline__ float bflo(unsigned w) { return __builtin_bit_cast(float, w << 16); }
__device__ __forceinline__ float bfhi(unsigned w) { return __builtin_bit_cast(float, w & 0xffff0000u); }

#define XB_TMO      128
#define XB_XCNT(j)  (256  + 64 * (j))
#define XB_XSUB(j)  (1280 + 64 * (j))
#define XB_XGEN(j)  (2304 + 64 * (j))
#define XB_TOP      3328
#define XB_TOPGEN   3392
#define XCD_BAR_WORDS 3456
#define XB_SPIN_CAP (1u << 25)
__device__ __forceinline__ unsigned xb_ld(unsigned* p)              { return __hip_atomic_load(p, __ATOMIC_RELAXED, __HIP_MEMORY_SCOPE_AGENT); }
__device__ __forceinline__ unsigned xb_add(unsigned* p, unsigned v) { return __hip_atomic_fetch_add(p, v, __ATOMIC_RELAXED, __HIP_MEMORY_SCOPE_AGENT); }
__device__ __forceinline__ unsigned xb_xcc_id() { return (unsigned)__builtin_amdgcn_s_getreg((3 << 11) | 20) & 0xFu; }
#define XB_SPIN(cond, bar) do { unsigned _sp = 0; while (cond) { __builtin_amdgcn_s_sleep(1); \
    if ((++_sp & 255u) == 0u) { if (xb_ld(&(bar)[XB_TMO])) break; if (_sp > XB_SPIN_CAP) { atomicAdd(&(bar)[XB_TMO], 1u); break; } } } } while (0)
struct XcdBarrier { unsigned* bar; unsigned x; volatile LAS unsigned* st; };
__device__ __forceinline__ XcdBarrier xcd_barrier_post(unsigned* bar, volatile LAS unsigned* st) {
    XcdBarrier b; b.bar = bar; b.x = xb_xcc_id(); b.st = st;
    if (threadIdx.x == 0) (void)xb_add(&bar[XB_XCNT(b.x)], 1u);
    return b;
}
__device__ __forceinline__ void xcd_barrier_complete(unsigned* bar, unsigned x, unsigned& nloc, unsigned& nx) {
    const unsigned G = gridDim.x * gridDim.y * gridDim.z;
    unsigned sum, cnt, mine, sp = 0u;
    for (;;) {
        sum = 0u; cnt = 0u; mine = 0u;
#pragma unroll
        for (unsigned j = 0; j < 16; ++j) { const unsigned c = xb_ld(&bar[XB_XCNT(j)]); sum += c; cnt += (c > 0u) ? 1u : 0u; mine = (j == x) ? c : mine; }
        if (sum == G) break;
        __builtin_amdgcn_s_sleep(1);
        if ((++sp & 255u) == 0u) { if (xb_ld(&bar[XB_TMO])) break; if (sp > XB_SPIN_CAP) { atomicAdd(&bar[XB_TMO], 1u); break; } }
    }
    nloc = mine > 0u ? mine : 1u; nx = cnt > 0u ? cnt : 1u;
}
__device__ __forceinline__ void xcd_barrier(const XcdBarrier& b) {
    asm volatile("s_waitcnt vmcnt(0)" ::: "memory");
    __syncthreads();
    if (threadIdx.x == 0) {
        unsigned* bar = b.bar;
        __builtin_amdgcn_s_waitcnt(0);
        unsigned nloc = b.st[0], nx = b.st[1];
        if (nloc == 0u) { xcd_barrier_complete(bar, b.x, nloc, nx); b.st[0] = nloc; b.st[1] = nx; }
        const unsigned old = xb_add(&bar[XB_XSUB(b.x)], 1u);
        const unsigned gen = old / nloc;
        if (old + 1u == (gen + 1u) * nloc) {
            __builtin_amdgcn_fence(__ATOMIC_RELEASE, "agent");
            asm volatile("s_waitcnt vmcnt(0)" ::: "memory");
            const unsigned og = xb_add(&bar[XB_TOP], 1u);
            const unsigned tg = og / nx;
            if (og + 1u == (tg + 1u) * nx) xb_add(&bar[XB_TOPGEN], 1u);
            else XB_SPIN(xb_ld(&bar[XB_TOPGEN]) == tg, bar);
            __builtin_amdgcn_fence(__ATOMIC_ACQUIRE, "agent");
            xb_add(&bar[XB_XGEN(b.x)], 1u);
            asm volatile("s_waitcnt vmcnt(0)" ::: "memory");
        } else {
            XB_SPIN(xb_ld(&bar[XB_XGEN(b.x)]) == gen, bar);
            __builtin_amdgcn_fence(__ATOMIC_ACQUIRE, "agent");
            asm volatile("s_waitcnt vmcnt(0)" ::: "memory");
        }
    }
    __syncthreads();
}

namespace pg8 {
#define PG8_LAS __attribute__((address_space(3)))
typedef unsigned short bf16_t;
typedef short bf16x8 __attribute__((ext_vector_type(8)));
typedef float f32x4 __attribute__((ext_vector_type(4)));
typedef unsigned u32x4 __attribute__((ext_vector_type(4)));
constexpr int BM = 256, BK = 64, HALF = 128, HTB = HALF * BK * 2  , STAGE_BYTES = 8 * HTB, NXCD = 8, WGM = 8;

__host__ __device__ __forceinline__ int lds_byte(int r, int c) { const int st = (r >> 4) * 2 + (c >> 5), rr = r & 15, cc = c & 31, ob = rr * 64 + cc * 2; return st * 1024 + (ob ^ (((ob >> 9) & 1) << 5)); }
__host__ __device__ __forceinline__ void stage_rc(int b, int& R, int& C) { const int st = b / 1024, sb = b % 1024, swz = sb ^ (((sb >> 9) & 1) << 5); R = (st >> 1) * 16 + swz / 64; C = (st & 1) * 32 + (swz % 64) / 2; }
__host__ __device__ __forceinline__ int perm32(int rho) { const int n = rho >> 4, i = rho & 15; return 8 * (i >> 2) + 4 * n + (i & 3); }

struct Unit { int pm, pn; };
struct Gemm { const bf16_t* A; const bf16_t* Bt; int M, N, K; };

struct StaticOrder {
    int nM, nN, nwg, G, c;
    __host__ __device__ void init(int M, int N, int G_, int c_) { nM = M / BM; nN = N / BM; nwg = nM * nN; G = G_; c = c_; }
    __host__ __device__ bool next(int i, Unit& u) const {
        const long L = (long)i * G + c; if (L >= nwg) return false;
        int wgid = (int)L; { const int q = nwg / NXCD, r = nwg % NXCD, xcd = wgid % NXCD, off = wgid / NXCD; wgid = (xcd < r ? xcd * (q + 1) : r * (q + 1) + (xcd - r) * q) + off; }
        const int nig = WGM * nN, gid = wgid / nig, fm = gid * WGM, gsz = (nM - fm) < WGM ? (nM - fm) : WGM;
        u.pm = fm + ((wgid % nig) % gsz); u.pn = (wgid % nig) / gsz; return true;
    }
    __device__ __forceinline__ void a_ready(const Unit&) const {}
    __device__ __forceinline__ void done(const Unit&) const {}
};

__device__ __forceinline__ unsigned cvt_pk_bf16(float lo, float hi) { unsigned r; asm volatile("v_cvt_pk_bf16_f32 %0, %1, %2" : "=v"(r) : "v"(lo), "v"(hi)); return r; }
typedef float f32x2 __attribute__((ext_vector_type(2)));
__device__ __forceinline__ f32x2 gelu_pk(f32x2 v) {
    const f32x2 av = __builtin_elementwise_abs(v), d = av * 0.2316418882f + 1.0f;
    f32x2 t; t.x = __builtin_amdgcn_rcpf(d.x); t.y = __builtin_amdgcn_rcpf(d.y);
    f32x2 q = t * 0.5307027145f + (-0.7265760135f); q = q * t + 0.7107068705f; q = q * t + (-0.142248368f); q = q * t + 0.127414796f; q = q * t;
    const f32x2 s = (v * v) * (-0.72134752044f);
    f32x2 e; e.x = __builtin_amdgcn_exp2f(s.x); e.y = __builtin_amdgcn_exp2f(s.y);
    const f32x2 m = v * (q * e), r = v - m;
    f32x2 o; o.x = v.x < 0.f ? m.x : r.x; o.y = v.y < 0.f ? m.y : r.y; return o;
}

template <int ACT  > struct EpiBf16 {
    static constexpr bool PERM = true, AFTER_DRAIN = false; static_assert(ACT == 0 || ACT == 1, "EpiBf16: ACT is 0 (none) or 1 (gelu_pk)");
    bf16_t* O; int ldc; const float* bias; int split_cols; size_t split_stride; float scale0;
    __device__ __forceinline__ void operator()(const f32x4 (&acc)[2][2][4][2], const Unit& u, int wr, int wc, int fr, int fq) const {
        const int row0 = u.pm * BM + wr * 64 + fr; int colt = u.pn * BM; bf16_t* base = O;
        float sc = 1.f; if (split_cols) { const int t = colt / split_cols; base += (size_t)t * split_stride; colt -= t * split_cols; if (t == 0) sc = scale0; }
        const int col0 = colt + wc * 32 + 8 * fq, bcol0 = u.pn * BM + wc * 32 + 8 * fq;
        f32x4 bv[2][2];
#pragma unroll
        for (int bj = 0; bj < 2; ++bj)
#pragma unroll
            for (int n = 0; n < 2; ++n) bv[bj][n] = bias ? *(const f32x4*)(bias + bcol0 + bj * HALF + 4 * n) : (f32x4){0.f, 0.f, 0.f, 0.f};
#pragma unroll
        for (int ai = 0; ai < 2; ++ai)
#pragma unroll
            for (int m = 0; m < 4; ++m) { bf16_t* rowp = base + (size_t)(row0 + ai * HALF + m * 16) * ldc + col0;
#pragma unroll
                for (int bj = 0; bj < 2; ++bj) { f32x4 v0 = acc[ai][bj][m][0] + bv[bj][0], v1 = acc[ai][bj][m][1] + bv[bj][1];
                    if (ACT == 1) { f32x2 a = gelu_pk((f32x2){v0[0], v0[1]}), b = gelu_pk((f32x2){v0[2], v0[3]}), c = gelu_pk((f32x2){v1[0], v1[1]}), d = gelu_pk((f32x2){v1[2], v1[3]});
                        v0 = (f32x4){a.x, a.y, b.x, b.y}; v1 = (f32x4){c.x, c.y, d.x, d.y}; }
                    v0 = v0 * sc; v1 = v1 * sc; u32x4 w; w.x = cvt_pk_bf16(v0[0], v0[1]); w.y = cvt_pk_bf16(v0[2], v0[3]); w.z = cvt_pk_bf16(v1[0], v1[1]); w.w = cvt_pk_bf16(v1[2], v1[3]);
                    *(u32x4*)(rowp + bj * HALF) = w; } }
    }
};

struct EpiSwiglu {
    static constexpr bool PERM = true, AFTER_DRAIN = false;
    bf16_t* O; int ldc;
    __device__ __forceinline__ void operator()(const f32x4 (&acc)[2][2][4][2], const Unit& u, int wr, int wc, int fr, int fq) const {
        const int row0 = u.pm * BM + wr * 64 + fr, col0 = u.pn * HALF + wc * 32 + 8 * fq;
#pragma unroll
        for (int ai = 0; ai < 2; ++ai)
#pragma unroll
            for (int m = 0; m < 4; ++m) { bf16_t* rowp = O + (size_t)(row0 + ai * HALF + m * 16) * ldc + col0;
                float v[8];
#pragma unroll
                for (int n = 0; n < 2; ++n)
#pragma unroll
                    for (int e = 0; e < 4; ++e) { const float g = acc[ai][0][m][n][e], uu = acc[ai][1][m][n][e];
                        v[n * 4 + e] = g * __builtin_amdgcn_rcpf(1.0f + __builtin_amdgcn_exp2f(-1.4426950408889634f * g)) * uu; }
                u32x4 w; w.x = cvt_pk_bf16(v[0], v[1]); w.y = cvt_pk_bf16(v[2], v[3]); w.z = cvt_pk_bf16(v[4], v[5]); w.w = cvt_pk_bf16(v[6], v[7]);
                *(u32x4*)rowp = w; }
    }
};
template <class Epi, class Sched, bool ALIGN_EPI = false, bool SP2 = false>
__device__ __forceinline__ void gemm_phase(PG8_LAS unsigned char* lds, const Gemm g, const Sched& S, const Epi& E) {
    const int tid = threadIdx.x, wid = __builtin_amdgcn_readfirstlane(tid >> 6), lane = tid & 63, wr = wid >> 2, wc = wid & 3, fr = lane & 15, fq = lane >> 4;
    const int K = g.K, nt = K / BK;
    unsigned voffA[2], voffB[2];
#pragma unroll
    for (int i = 0; i < 2; ++i) { int R, C; stage_rc(tid * 16 + i * 8192, R, C); const int Rb = Epi::PERM ? ((R & ~31) + perm32(R & 31)) : R;
        voffA[i] = (unsigned)(R * K + C) * 2u; voffB[i] = (unsigned)(Rb * K + C) * 2u; }
    const size_t kstep = (size_t)(BK * 2);
    const size_t hstep = (size_t)HALF * K * 2;
    const size_t tstep = 2 * hstep;
    const unsigned ldsw = (unsigned)wid * 1024u;
    const int aoff = lds_byte(wr * 64 + fr, fq * 8), boff = lds_byte(wc * 32 + fr, fq * 8);
#define PG8_SA(b, h) (((b) * 2 + (h)) * HTB)
#define PG8_SB(b, h) ((4 + (b) * 2 + (h)) * HTB)
#define PG8_STAGE(bufoff, gbase, voff) do { _Pragma("unroll") for (int _i = 0; _i < 2; ++_i) \
        __builtin_amdgcn_global_load_lds((const unsigned*)((const char*)(gbase) + (voff)[_i]), (PG8_LAS unsigned*)(lds + (bufoff) + ldsw + _i * 8192), 16, 0, 0); } while (0)
#define PG8_LDA(dst, b, h) do { _Pragma("unroll") for (int m = 0; m < 4; ++m) _Pragma("unroll") for (int k = 0; k < 2; ++k) dst[m][k] = *(const PG8_LAS bf16x8*)(lds + PG8_SA(b, h) + aoff + m * 2048 + k * 1024); } while (0)
#define PG8_LDB(dst, b, h) do { _Pragma("unroll") for (int n = 0; n < 2; ++n) _Pragma("unroll") for (int k = 0; k < 2; ++k) dst[n][k] = *(const PG8_LAS bf16x8*)(lds + PG8_SB(b, h) + boff + n * 2048 + k * 1024); } while (0)
#define PG8_MMA(ai, bj, At, Bt) do { __builtin_amdgcn_s_setprio(1); _Pragma("unroll") for (int m = 0; m < 4; ++m) _Pragma("unroll") for (int n = 0; n < 2; ++n) _Pragma("unroll") for (int k = 0; k < 2; ++k) \
        acc[ai][bj][m][n] = __builtin_amdgcn_mfma_f32_16x16x32_bf16(Bt[n][k], At[m][k], acc[ai][bj][m][n], 0, 0, 0); __builtin_amdgcn_s_setprio(0); } while (0)
#define PG8_WAIT_V(n) asm volatile("s_waitcnt vmcnt(" #n ")" ::: "memory")
#define PG8_WAIT_L(n) asm volatile("s_waitcnt lgkmcnt(" #n ")" ::: "memory")
#define PG8_BAR __builtin_amdgcn_s_barrier()
#define PG8_SCHED __builtin_amdgcn_sched_barrier(0)
    Unit cur, nxt; int ui = 0;
    if (!S.next(0, cur)) return;
    f32x4 acc[2][2][4][2];
#pragma unroll
    for (int a = 0; a < 2; ++a)
#pragma unroll
        for (int b = 0; b < 2; ++b)
#pragma unroll
            for (int m = 0; m < 4; ++m)
#pragma unroll
                for (int n = 0; n < 2; ++n) acc[a][b][m][n] = (f32x4){0.f, 0.f, 0.f, 0.f};
    bf16x8 At[4][2], B0[2][2], B1[2][2];
    const char* cA = (const char*)g.A + (size_t)cur.pm * tstep; const char* cB = (const char*)g.Bt + (size_t)cur.pn * tstep;
    S.a_ready(cur);
    if constexpr (SP2) {
        PG8_STAGE(PG8_SB(0, 0), cB, voffB); PG8_STAGE(PG8_SB(0, 1), cB + hstep, voffB); PG8_STAGE(PG8_SA(0, 0), cA, voffA); PG8_STAGE(PG8_SA(0, 1), cA + hstep, voffA);
        if (wr == 1) PG8_BAR;
        PG8_WAIT_V(2); PG8_BAR;
        PG8_STAGE(PG8_SB(1, 0), cB + kstep, voffB); PG8_STAGE(PG8_SA(1, 0), cA + kstep, voffA); PG8_STAGE(PG8_SB(1, 1), cB + hstep + kstep, voffB);
        PG8_WAIT_V(6); PG8_BAR;
    } else {
        PG8_STAGE(PG8_SB(0, 0), cB, voffB); PG8_STAGE(PG8_SA(0, 0), cA, voffA); PG8_STAGE(PG8_SB(0, 1), cB + hstep, voffB); PG8_STAGE(PG8_SA(0, 1), cA + hstep, voffA);
        if (wr == 1) PG8_BAR;
        PG8_WAIT_V(4); PG8_BAR;
        PG8_STAGE(PG8_SB(1, 0), cB + kstep, voffB); PG8_STAGE(PG8_SA(1, 0), cA + kstep, voffA); PG8_STAGE(PG8_SB(1, 1), cB + hstep + kstep, voffB);
        PG8_WAIT_V(6); PG8_BAR;
    }
    for (;;) {
        const bool has_next = S.next(ui + 1, nxt);
        const char* nA = has_next ? (const char*)g.A + (size_t)nxt.pm * tstep : cA; const char* nB = has_next ? (const char*)g.Bt + (size_t)nxt.pn * tstep : cB;
        for (int t = 0; t < nt; t += 2) {
            const bool last = (t == nt - 2);
            const char* a1 = cA + (size_t)(t + 1) * kstep;
            const char* a2 = last ? nA : cA + (size_t)(t + 2) * kstep; const char* b2 = last ? nB : cB + (size_t)(t + 2) * kstep;
            const char* a3 = a2 + kstep; const char* b3 = b2 + kstep;
            if (last && has_next) S.a_ready(nxt);
            if constexpr (SP2) {
            PG8_LDB(B0, 0, 0); PG8_LDB(B1, 0, 1); PG8_SCHED; PG8_LDA(At, 0, 0); PG8_STAGE(PG8_SA(1, 1), a1 + hstep, voffA);
            PG8_WAIT_V(8); PG8_WAIT_L(0); PG8_BAR; PG8_MMA(0, 0, At, B0); PG8_MMA(0, 1, At, B1); PG8_BAR; PG8_SCHED;
            PG8_LDA(At, 0, 1); PG8_STAGE(PG8_SB(0, 0), b2, voffB); PG8_STAGE(PG8_SB(0, 1), b2 + hstep, voffB); PG8_STAGE(PG8_SA(0, 0), a2, voffA);
            PG8_WAIT_V(8); PG8_WAIT_L(0); PG8_BAR; PG8_MMA(1, 0, At, B0); PG8_MMA(1, 1, At, B1); PG8_BAR; PG8_SCHED;
            PG8_LDB(B0, 1, 0); PG8_LDB(B1, 1, 1); PG8_SCHED; PG8_LDA(At, 1, 0); PG8_STAGE(PG8_SA(0, 1), a2 + hstep, voffA);
            PG8_WAIT_V(8); PG8_WAIT_L(0); PG8_BAR; PG8_MMA(0, 0, At, B0); PG8_MMA(0, 1, At, B1); PG8_BAR; PG8_SCHED;
            PG8_LDA(At, 1, 1); PG8_STAGE(PG8_SB(1, 0), b3, voffB); PG8_STAGE(PG8_SB(1, 1), b3 + hstep, voffB); PG8_STAGE(PG8_SA(1, 0), a3, voffA);
            PG8_WAIT_V(8); PG8_WAIT_L(0); PG8_BAR; PG8_MMA(1, 0, At, B0); PG8_MMA(1, 1, At, B1); PG8_BAR; PG8_SCHED;
            } else {
            PG8_LDB(B0, 0, 0); PG8_SCHED; PG8_LDA(At, 0, 0); PG8_STAGE(PG8_SA(1, 1), a1 + hstep, voffA);
            PG8_WAIT_L(8); PG8_BAR; PG8_WAIT_L(0); PG8_MMA(0, 0, At, B0); PG8_BAR; PG8_SCHED;
            PG8_LDB(B1, 0, 1); PG8_STAGE(PG8_SB(0, 0), b2, voffB);
            PG8_BAR; PG8_WAIT_L(0); PG8_MMA(0, 1, At, B1); PG8_BAR;
            PG8_LDA(At, 0, 1); PG8_STAGE(PG8_SA(0, 0), a2, voffA);
            PG8_BAR; PG8_WAIT_L(0); PG8_MMA(1, 0, At, B0); PG8_BAR; PG8_SCHED;
            PG8_STAGE(PG8_SB(0, 1), b2 + hstep, voffB);
            PG8_WAIT_V(6); PG8_BAR; PG8_MMA(1, 1, At, B1); PG8_BAR;
            PG8_LDB(B0, 1, 0); PG8_SCHED; PG8_LDA(At, 1, 0); PG8_STAGE(PG8_SA(0, 1), a2 + hstep, voffA);
            PG8_WAIT_L(8); PG8_BAR; PG8_WAIT_L(0); PG8_MMA(0, 0, At, B0); PG8_BAR; PG8_SCHED;
            PG8_LDB(B1, 1, 1); PG8_STAGE(PG8_SB(1, 0), b3, voffB);
            PG8_BAR; PG8_WAIT_L(0); PG8_MMA(0, 1, At, B1); PG8_BAR;
            PG8_LDA(At, 1, 1); PG8_STAGE(PG8_SA(1, 0), a3, voffA);
            PG8_BAR; PG8_WAIT_L(0); PG8_MMA(1, 0, At, B0); PG8_BAR; PG8_SCHED;
            PG8_STAGE(PG8_SB(1, 1), b3 + hstep, voffB);
            PG8_WAIT_V(6); PG8_BAR; PG8_MMA(1, 1, At, B1); PG8_BAR;
            }
        }
        if constexpr (ALIGN_EPI) { if (wr == 0) PG8_BAR; }
        if constexpr (!Epi::AFTER_DRAIN) { E(acc, cur, wr, wc, fr, fq); S.done(cur); }
        if (!has_next) break;
#pragma unroll
        for (int a = 0; a < 2; ++a)
#pragma unroll
            for (int b = 0; b < 2; ++b)
#pragma unroll
                for (int m = 0; m < 4; ++m)
#pragma unroll
                    for (int n = 0; n < 2; ++n) acc[a][b][m][n] = (f32x4){0.f, 0.f, 0.f, 0.f};
        cur = nxt; cA = nA; cB = nB; ++ui;
        if constexpr (ALIGN_EPI) { if (wr == 1) PG8_BAR; }
    }
    PG8_WAIT_V(0);
    if constexpr (!ALIGN_EPI) { if (wr == 0) PG8_BAR; }
    PG8_BAR;
    if constexpr (Epi::AFTER_DRAIN) { E.fused(acc, cur, wr, wc, fr, fq, lds, wid, lane); S.done(cur); }
#undef PG8_SA
#undef PG8_SB
#undef PG8_STAGE
#undef PG8_LDA
#undef PG8_LDB
#undef PG8_MMA
#undef PG8_WAIT_V
#undef PG8_WAIT_L
#undef PG8_BAR
#undef PG8_SCHED
}
}

__device__ __forceinline__ float wave_sum(float v) {
#pragma unroll
    for (int o = 1; o < 64; o <<= 1) v += __shfl_xor(v, o);
    return v;
}
__device__ __forceinline__ float wave_max(float v) {
#pragma unroll
    for (int o = 1; o < 64; o <<= 1) v = fmaxf(v, __shfl_xor(v, o));
    return v;
}
__device__ __forceinline__ float silu_f(float v) { return v / (1.f + __expf(-v)); }

struct Args {
    const float* x; const float* c; const float* rel_bias; const float* ada_w; const float* ada_b; const float* norm_g;
    const float* moba_w_qkv; const float* moba_w_o; const float* diff_w_qkv; const float* diff_w_o;
    const float* diff_lambda; const float* diff_subln_g; const float* ffn_w_in; const float* ffn_w_out;
    float* out; unsigned char* ws;
};

__device__ __forceinline__ int t5_bucket(int rel) {
    const int n = rel < 0 ? 0 : rel;
    const float nf = (float)(n < 1 ? 1 : n);
    int large = 16 + (int)(logf(nf / 16.0f) / 4.852030263919617f * 16.0f);
    large = large < 31 ? large : 31;
    return n < 16 ? n : large;
}

__device__ __forceinline__ void p_mod(const Args& a, int gtid, int gthreads) {
    float* mod = (float*)(a.ws + WS_MOD);
    for (int idx = gtid; idx < 2 * 6144; idx += gthreads) {
        const int l = idx / 6144, j = idx % 6144;
        const float* w = a.ada_w + (size_t)l * D * 6144 + j;
        float s0 = 0.f, s1 = 0.f;
        for (int k = 0; k < D; ++k) { const float wv = w[(size_t)k * 6144]; s0 += silu_f(a.c[k]) * wv; s1 += silu_f(a.c[D + k]) * wv; }
        const float bb = a.ada_b[l * 6144 + j];
        mod[(l * 2 + 0) * 6144 + j] = s0 + bb; mod[(l * 2 + 1) * 6144 + j] = s1 + bb;
    }
    int* blut = (int*)(a.ws + WS_BLUT);
    for (int r = gtid; r < 2048; r += gthreads) blut[r] = t5_bucket(r);
}


__device__ __forceinline__ void transpose_item(const float* W, int K, int N, int k0, int n0, bf16* WT, int dst_row0, LAS float* scr, int lane) {
#pragma unroll 8
    for (int i = 0; i < 32; ++i) { const int kk = 2 * i + (lane >> 5); scr[kk * 33 + (lane & 31)] = W[(size_t)(k0 + kk) * N + n0 + (lane & 31)]; }
    asm volatile("s_waitcnt lgkmcnt(0)" ::: "memory");
    const int c = lane & 7;
#pragma unroll
    for (int j = 0; j < 4; ++j) { const int n = (lane >> 3) + 8 * j; const LAS float* sp = scr + (8 * c) * 33 + n;
        u32x4 o; o.x = pk2(sp[0 * 33], sp[1 * 33]); o.y = pk2(sp[2 * 33], sp[3 * 33]); o.z = pk2(sp[4 * 33], sp[5 * 33]); o.w = pk2(sp[6 * 33], sp[7 * 33]);
        *(u32x4*)(WT + (size_t)(dst_row0 + n) * K + k0 + 8 * c) = o; }
    asm volatile("s_waitcnt lgkmcnt(0)" ::: "memory");
}
__device__ __forceinline__ void p_weights(const Args& a, LAS unsigned char* lds, int gw, int ngw, int wave, int lane) {
    LAS float* scr = (LAS float*)(lds + wave * 16384);
    constexpr int I_QKV = (D / 64) * (3 * D / 32), I_O = (D / 64) * (D / 32), I_IN = (D / 64) * (2 * DFF / 32), I_OUT = (DFF / 64) * (D / 32);
    constexpr int PER_L = I_QKV + I_O + I_IN + I_OUT;
    for (int it = gw; it < 2 * PER_L; it += ngw) {
        const int l = it / PER_L; int r = it % PER_L;
        unsigned char* wl = a.ws + WS_W + (size_t)l * WL_STRIDE;
        if (r < I_QKV) { const int nb = 3 * D / 32, kb = r / nb, n0 = (r % nb) * 32; transpose_item(l == 0 ? a.moba_w_qkv : a.diff_w_qkv, D, 3 * D, kb * 64, n0, (bf16*)(wl + WO_QKV), n0, scr, lane); continue; } r -= I_QKV;
        if (r < I_O) { const int nb = D / 32, kb = r / nb, n0 = (r % nb) * 32; transpose_item(l == 0 ? a.moba_w_o : a.diff_w_o, D, D, kb * 64, n0, (bf16*)(wl + WO_O), n0, scr, lane); continue; } r -= I_O;
        if (r < I_IN) { const int nb = 2 * DFF / 32, kb = r / nb, n0 = (r % nb) * 32;
            const int isu = n0 >= DFF ? 1 : 0, nn = n0 - isu * DFF, dst = 256 * (nn / 128) + 128 * isu + (nn % 128);
            transpose_item(a.ffn_w_in + (size_t)l * D * 2 * DFF, D, 2 * DFF, kb * 64, n0, (bf16*)(wl + WO_IN), dst, scr, lane); continue; } r -= I_IN;
        { const int nb = D / 32, kb = r / nb, n0 = (r % nb) * 32; transpose_item(a.ffn_w_out + (size_t)l * DFF * D, DFF, D, kb * 64, n0, (bf16*)(wl + WO_OUT), n0, scr, lane); }
    }
}

__device__ __forceinline__ void p_norm_in(const float* X, const float* g, const float* sh, const float* sc, bf16* H, int gw, int ngw, int lane) {
    for (int m = gw; m < M; m += ngw) {
        const int b = m / SEQ;
        const f32x4* xr = (const f32x4*)(X + (size_t)m * D) + lane;
        f32x4 v[4]; float s = 0.f;
#pragma unroll
        for (int j = 0; j < 4; ++j) { v[j] = xr[64 * j]; s += (v[j].x * v[j].x + v[j].y * v[j].y) + (v[j].z * v[j].z + v[j].w * v[j].w); }
        const float r = 1.0f / sqrtf(wave_sum(s) * (1.f / D) + RMS_EPS);
        u32x2* o = (u32x2*)(H + (size_t)m * D) + lane;
#pragma unroll
        for (int j = 0; j < 4; ++j) {
            const f32x4 gg = ((const f32x4*)g)[lane + 64 * j], s1 = ((const f32x4*)(sc + b * 6144))[lane + 64 * j], s0 = ((const f32x4*)(sh + b * 6144))[lane + 64 * j];
            const f32x4 h = v[j] * r * gg * (1.0f + s1) + s0;
            u32x2 w; w.x = pk2(h.x, h.y); w.y = pk2(h.z, h.w); o[64 * j] = w;
        }
    }
}
__device__ __forceinline__ void p_post(const float* Xin, const bf16* Y, const float* g1, const float* gate, float* Xout,
                                       const float* g2, const float* sh, const float* sc, bf16* H, int gw, int ngw, int lane) {
    for (int m = gw; m < M; m += ngw) {
        const int b = m / SEQ;
        const u32x2* yr = (const u32x2*)(Y + (size_t)m * D) + lane;
        const f32x4* xr = (const f32x4*)(Xin + (size_t)m * D) + lane;
        f32x4 y[4], xv[4]; float s = 0.f;
#pragma unroll
        for (int j = 0; j < 4; ++j) { const u32x2 w = yr[64 * j]; y[j] = (f32x4){bflo(w.x), bfhi(w.x), bflo(w.y), bfhi(w.y)}; xv[j] = xr[64 * j];
            s += (y[j].x * y[j].x + y[j].y * y[j].y) + (y[j].z * y[j].z + y[j].w * y[j].w); }
        const float r = 1.0f / sqrtf(wave_sum(s) * (1.f / D) + RMS_EPS);
        float s2 = 0.f;
#pragma unroll
        for (int j = 0; j < 4; ++j) {
            const f32x4 gg = ((const f32x4*)g1)[lane + 64 * j], gt = ((const f32x4*)(gate + b * 6144))[lane + 64 * j];
            xv[j] = xv[j] + gt * (y[j] * r * gg);
            s2 += (xv[j].x * xv[j].x + xv[j].y * xv[j].y) + (xv[j].z * xv[j].z + xv[j].w * xv[j].w);
            ((f32x4*)(Xout + (size_t)m * D))[lane + 64 * j] = xv[j];
        }
        if (H) {
            const float r2 = 1.0f / sqrtf(wave_sum(s2) * (1.f / D) + RMS_EPS);
            u32x2* o = (u32x2*)(H + (size_t)m * D) + lane;
#pragma unroll
            for (int j = 0; j < 4; ++j) {
                const f32x4 gg = ((const f32x4*)g2)[lane + 64 * j], s1 = ((const f32x4*)(sc + b * 6144))[lane + 64 * j], s0 = ((const f32x4*)(sh + b * 6144))[lane + 64 * j];
                const f32x4 h = xv[j] * r2 * gg * (1.0f + s1) + s0;
                u32x2 w; w.x = pk2(h.x, h.y); w.y = pk2(h.z, h.w); o[64 * j] = w;
            }
        }
    }
}

template <int MODE>
__device__ __forceinline__ void naive_gemm(LAS unsigned char* lds, const bf16* A, int K, const float* W, int ldw, int Nout, bf16* C, int ldc, float qscale, int blk, int nblk, int tid) {
    LAS float* As = (LAS float*)lds;
    LAS float* Ws = As + 16 * 132;
    LAS float* Wu = Ws + 16 * 132;
    const int ty = tid >> 4, tx = tid & 15;
    const int ntn = Nout / 128, ntiles = (M / 128) * ntn;
    for (int t = blk; t < ntiles; t += nblk) {
        const int tm = t / ntn, tn = t % ntn, row0 = tm * 128, col0 = tn * 128;
        float acc[4][8], acu[4][8];
#pragma unroll
        for (int i = 0; i < 4; ++i)
#pragma unroll
            for (int j = 0; j < 8; ++j) { acc[i][j] = 0.f; acu[i][j] = 0.f; }
        for (int k0 = 0; k0 < K; k0 += 16) {
            __syncthreads();
            { const int r = tid >> 2, kk = (tid & 3) * 4; const u32x2 w = *(const u32x2*)(A + (size_t)(row0 + r) * K + k0 + kk);
              As[(kk + 0) * 132 + r] = bflo(w.x); As[(kk + 1) * 132 + r] = bfhi(w.x); As[(kk + 2) * 132 + r] = bflo(w.y); As[(kk + 3) * 132 + r] = bfhi(w.y); }
            { const int kk = tid >> 5, cc = (tid & 31) * 4; const f32x4 w = *(const f32x4*)(W + (size_t)(k0 + kk) * ldw + col0 + cc);
              *(LAS f32x4*)(Ws + kk * 132 + cc) = w;
              if (MODE == 2) { const f32x4 u = *(const f32x4*)(W + (size_t)(k0 + kk) * ldw + DFF + col0 + cc); *(LAS f32x4*)(Wu + kk * 132 + cc) = u; } }
            __syncthreads();
#pragma unroll 2
            for (int kk = 0; kk < 16; ++kk) {
                const f32x4 av = *(LAS f32x4*)(As + kk * 132 + ty * 4);
                const f32x4 b0 = *(LAS f32x4*)(Ws + kk * 132 + tx * 8), b1 = *(LAS f32x4*)(Ws + kk * 132 + tx * 8 + 4);
                const float aa[4] = {av.x, av.y, av.z, av.w}; const float bb[8] = {b0.x, b0.y, b0.z, b0.w, b1.x, b1.y, b1.z, b1.w};
#pragma unroll
                for (int i = 0; i < 4; ++i)
#pragma unroll
                    for (int j = 0; j < 8; ++j) acc[i][j] += aa[i] * bb[j];
                if (MODE == 2) {
                    const f32x4 u0 = *(LAS f32x4*)(Wu + kk * 132 + tx * 8), u1 = *(LAS f32x4*)(Wu + kk * 132 + tx * 8 + 4);
                    const float uu[8] = {u0.x, u0.y, u0.z, u0.w, u1.x, u1.y, u1.z, u1.w};
#pragma unroll
                    for (int i = 0; i < 4; ++i)
#pragma unroll
                        for (int j = 0; j < 8; ++j) acu[i][j] += aa[i] * uu[j];
                }
            }
        }
#pragma unroll
        for (int i = 0; i < 4; ++i) {
            const int row = row0 + ty * 4 + i; int col = col0 + tx * 8; bf16* base = C; float sc = 1.f;
            if (MODE == 1) { const int tt = col / 1024; base = C + (size_t)tt * ((WS_K - WS_Q) / 2); col -= tt * 1024; if (tt == 0) sc = qscale; }
            float v[8];
#pragma unroll
            for (int j = 0; j < 8; ++j) { v[j] = acc[i][j] * sc; if (MODE == 2) v[j] = silu_f(acc[i][j]) * acu[i][j]; }
            u32x4 w; w.x = pk2(v[0], v[1]); w.y = pk2(v[2], v[3]); w.z = pk2(v[4], v[5]); w.w = pk2(v[6], v[7]);
            *(u32x4*)(base + (size_t)row * ldc + col) = w;
        }
    }
    __syncthreads();
}

__device__ __forceinline__ void p_kmean(const bf16* Kb, float* kmean, int gtid, int gthreads) {
    for (int idx = gtid; idx < BATCH * NH * 32 * HD; idx += gthreads) {
        const int d = idx % HD, blk = (idx / HD) % 32, h = (idx / (HD * 32)) % NH, b = idx / (HD * 32 * NH);
        const bf16* p = Kb + ((size_t)b * SEQ + blk * 256) * D + h * HD + d;
        float s = 0.f;
        for (int r = 0; r < 256; ++r) s += bf2f(p[(size_t)r * D]);
        kmean[idx] = s * (1.0f / 256.0f);
    }
}
__device__ __forceinline__ void p_gate(const bf16* Qb, const float* kmean, unsigned* sel, int gtid, int gthreads) {
    for (int idx = gtid; idx < BATCH * NH * SEQ; idx += gthreads) {
        const int q = idx % SEQ, h = (idx / SEQ) % NH, b = idx / (SEQ * NH);
        const int own = q >> 8;
        unsigned mask;
        if (own <= 3) mask = (1u << own) - 1u;
        else {
            const bf16* qp = Qb + ((size_t)b * SEQ + q) * D + h * HD;
            const float* km = kmean + (size_t)(b * NH + h) * 32 * HD;
            float b0 = -3e38f, b1 = -3e38f, b2 = -3e38f; int i0 = 0, i1 = 0, i2 = 0;
            for (int n = 0; n < own; ++n) {
                float g = 0.f;
                for (int d = 0; d < HD; d += 2) { const unsigned w = *(const unsigned*)(qp + d); g += bflo(w) * km[n * HD + d] + bfhi(w) * km[n * HD + d + 1]; }
                if (g > b0) { b2 = b1; i2 = i1; b1 = b0; i1 = i0; b0 = g; i0 = n; }
                else if (g > b1) { b2 = b1; i2 = i1; b1 = g; i1 = n; }
                else if (g > b2) { b2 = g; i2 = n; }
            }
            mask = (1u << i0) | (1u << i1) | (1u << i2);
        }
        sel[idx] = mask;
    }
}

template <int QKD>
__device__ __forceinline__ void naive_attn_row(const bf16* Qrow, const bf16* Kc, const bf16* Vc, int qpos, unsigned bmask, const float* relb, int h, const int* blut,
                                               LAS float* wq, LAS float* wp, int lane, float& o0, float& o1) {
    if (lane < QKD / 2) { const unsigned w = *(const unsigned*)(Qrow + 2 * lane); wq[2 * lane] = bflo(w); wq[2 * lane + 1] = bfhi(w); }
    asm volatile("s_waitcnt lgkmcnt(0)" ::: "memory");
    float m = -1e30f, l = 0.f; o0 = 0.f; o1 = 0.f;
    const int own = qpos >> 8;
    for (int j = 0; j <= own; ++j) {
        if (!((bmask >> j) & 1u)) continue;
        for (int c = 0; c < 4; ++c) {
            const int k0 = j * 256 + c * 64;
            if (k0 > qpos) break;
            const int key = k0 + lane;
            const bf16* kp = Kc + (size_t)key * D;
            float s = 0.f;
#pragma unroll
            for (int d = 0; d < QKD; d += 8) {
                const u32x4 w = *(const u32x4*)(kp + d);
                const f32x4 q0 = *(LAS f32x4*)(wq + d), q1 = *(LAS f32x4*)(wq + d + 4);
                s += bflo(w.x) * q0.x + bfhi(w.x) * q0.y + bflo(w.y) * q0.z + bfhi(w.y) * q0.w + bflo(w.z) * q1.x + bfhi(w.z) * q1.y + bflo(w.w) * q1.z + bfhi(w.w) * q1.w;
            }
            const int rel = qpos - key;
            const int bk = rel < 0 ? 0 : (rel < 2048 ? blut[rel] : 31);
            s += relb[bk * NH + h] * LOG2E;
            if (key > qpos) s = -__builtin_inff();
            const float cm = wave_max(s), mn = fmaxf(m, cm), alpha = exp2f(m - mn), p = exp2f(s - mn);
            l = l * alpha + wave_sum(p); o0 *= alpha; o1 *= alpha; m = mn;
            wp[lane] = p;
            asm volatile("s_waitcnt lgkmcnt(0)" ::: "memory");
            const bf16* vp = Vc + (size_t)k0 * D + 2 * lane;
#pragma unroll 8
            for (int jj = 0; jj < 64; ++jj) { const float pj = wp[jj]; const unsigned w = *(const unsigned*)(vp + (size_t)jj * D); o0 += pj * bflo(w); o1 += pj * bfhi(w); }
            asm volatile("s_waitcnt lgkmcnt(0)" ::: "memory");
        }
    }
    const float rl = 1.0f / l; o0 *= rl; o1 *= rl;
}

__device__ __forceinline__ void p_moba_attn(const Args& a, LAS unsigned char* lds, int gw, int ngw, int wave, int lane) {
    const bf16* Qb = (const bf16*)(a.ws + WS_Q); const bf16* Kb = (const bf16*)(a.ws + WS_K); const bf16* Vb = (const bf16*)(a.ws + WS_V);
    bf16* Ob = (bf16*)(a.ws + WS_O); const unsigned* sel = (const unsigned*)(a.ws + WS_SEL); const int* blut = (const int*)(a.ws + WS_BLUT);
    LAS float* wq = (LAS float*)lds + wave * 256; LAS float* wp = wq + 128;
    for (int idx = gw; idx < BATCH * NH * SEQ; idx += ngw) {
        const int q = idx % SEQ, h = (idx / SEQ) % NH, b = idx / (SEQ * NH);
        const size_t rb = (size_t)b * SEQ;
        const unsigned bm = sel[idx] | (1u << (q >> 8));
        float o0, o1;
        naive_attn_row<128>(Qb + (rb + q) * D + h * HD, Kb + rb * D + h * HD, Vb + rb * D + h * HD, q, bm, a.rel_bias, h, blut, wq, wp, lane, o0, o1);
        *(unsigned*)(Ob + (rb + q) * D + h * HD + 2 * lane) = pk2(o0, o1);
    }
}
__device__ __forceinline__ void p_diff_attn(const Args& a, LAS unsigned char* lds, int gw, int ngw, int wave, int lane) {
    const bf16* Qb = (const bf16*)(a.ws + WS_Q); const bf16* Kb = (const bf16*)(a.ws + WS_K); const bf16* Vb = (const bf16*)(a.ws + WS_V);
    bf16* Ob = (bf16*)(a.ws + WS_O); const int* blut = (const int*)(a.ws + WS_BLUT);
    LAS float* wq = (LAS float*)lds + wave * 256; LAS float* wp = wq + 128;
    float lam_full;
    { const float* lm = a.diff_lambda; const float p01 = wave_sum(lm[lane] * lm[64 + lane]), p23 = wave_sum(lm[128 + lane] * lm[192 + lane]); lam_full = __expf(p01) - __expf(p23) + LAMBDA_INIT; }
    for (int idx = gw; idx < BATCH * NH * SEQ; idx += ngw) {
        const int q = idx % SEQ, h = (idx / SEQ) % NH, b = idx / (SEQ * NH);
        const size_t rb = (size_t)b * SEQ;
        const int own = q >> 8; const unsigned bm = own >= 31 ? 0xffffffffu : ((1u << (own + 1)) - 1u);
        float a0, a1, b0, b1;
        naive_attn_row<64>(Qb + (rb + q) * D + h * HD, Kb + rb * D + h * HD, Vb + rb * D + h * HD, q, bm, a.rel_bias, h, blut, wq, wp, lane, a0, a1);
        naive_attn_row<64>(Qb + (rb + q) * D + h * HD + 64, Kb + rb * D + h * HD + 64, Vb + rb * D + h * HD, q, bm, a.rel_bias, h, blut, wq, wp, lane, b0, b1);
        float o0 = a0 - lam_full * b0, o1 = a1 - lam_full * b1;
        const float ss = wave_sum(o0 * o0 + o1 * o1);
        const float r = 1.0f / sqrtf(ss * (1.0f / HD) + RMS_EPS) * (1.0f - LAMBDA_INIT);
        o0 = o0 * r * a.diff_subln_g[2 * lane]; o1 = o1 * r * a.diff_subln_g[2 * lane + 1];
        *(unsigned*)(Ob + (rb + q) * D + h * HD + 2 * lane) = pk2(o0, o1);
    }
}


namespace att {
typedef short bf16x8 __attribute__((ext_vector_type(8)));
typedef short s16x4 __attribute__((ext_vector_type(4)));
typedef float f32x16 __attribute__((ext_vector_type(16)));
typedef LAS const char* lcp;
constexpr int PITCH = 1024;
constexpr int SHM_V = 16384, SHM_K = 16384;
constexpr int L_V = 0, L_K = 32768, L_WS = 65536, L_LUT = 67584;
constexpr int LUTN = 2304, RMAXL = 2047, RFAR = 1536;
#define KSWZ(row, colB) ((row) * 256 + ((colB) ^ (((row) & 7) << 4)))
#define SBAR() __builtin_amdgcn_sched_barrier(0)
__device__ __forceinline__ int v_st(int k, int c) { const int kk = (k & ~0xC) | ((k & 4) << 1) | ((k & 8) >> 1); return ((kk >> 3) * 4 + (c >> 5)) * 512 + ((kk & 7) * 32 + (c & 31)) * 2; }
__device__ __forceinline__ int v_rd_base(int lane) { return ((lane & 3) << 3) | (((lane >> 2) & 3) << 6) | (((lane >> 4) & 1) << 5) | (((lane >> 5) & 1) << 8); }
constexpr int v_rd_off(int d0, int ks, int half) { return d0 * 512 + ks * 4096 + half * 2048; }
__device__ __forceinline__ int crow(int r, int hi) { return (r & 3) + 8 * (r >> 2) + 4 * hi; }
__device__ __forceinline__ unsigned cvtpk(float lo, float hi) { unsigned r; asm volatile("v_cvt_pk_bf16_f32 %0, %1, %2" : "=v"(r) : "v"(lo), "v"(hi)); return r; }

template <int KB, int NDS>
__device__ __forceinline__ void qkt(f32x16& p0, f32x16& p1, lcp K_lds, int r32, int hi, int coff, const bf16x8* qr) {
    p0 = f32x16{}; p1 = f32x16{};
    lcp kb[4];
#pragma unroll
    for (int dd = 0; dd < 4; ++dd) kb[dd] = K_lds + KB * SHM_K + KSWZ(r32, (dd * 16 + hi * 8) * 2) + coff;
#pragma unroll
    for (int d0 = 0; d0 < NDS; ++d0) { lcp a = kb[d0 & 3] + (d0 >> 2) * 128;
        const bf16x8 b0 = *(LAS const bf16x8*)a;
        const bf16x8 b1 = *(LAS const bf16x8*)(a + 32 * 256);
        p0 = __builtin_amdgcn_mfma_f32_32x32x16_bf16(b0, qr[d0], p0, 0, 0, 0);
        p1 = __builtin_amdgcn_mfma_f32_32x32x16_bf16(b1, qr[d0], p1, 0, 0, 0); }
}
template <int VB>
__device__ __forceinline__ void pv_tile(f32x16* o, int vb0, bf16x8 pa0, bf16x8 pa1, bf16x8 pa2, bf16x8 pa3) {
#define TRRD(dst, off) asm volatile("ds_read_b64_tr_b16 %0, %1 offset:%2" : "=&v"(dst) : "v"(vb0), "i"(off) : "memory")
#define PV_D0(d0) do { s16x4 l0, l1, l2, l3, h0, h1, h2, h3; constexpr int b_ = VB * SHM_V + v_rd_off(d0, 0, 0); \
        TRRD(l0, b_); TRRD(h0, b_ + 2048); TRRD(l1, b_ + 4096); TRRD(h1, b_ + 6144); TRRD(l2, b_ + 8192); TRRD(h2, b_ + 10240); TRRD(l3, b_ + 12288); TRRD(h3, b_ + 14336); \
        asm volatile("s_waitcnt lgkmcnt(0)" ::: "memory"); SBAR(); \
        o[d0] = __builtin_amdgcn_mfma_f32_32x32x16_bf16(pa0, (bf16x8){l0[0], l0[1], l0[2], l0[3], h0[0], h0[1], h0[2], h0[3]}, o[d0], 0, 0, 0); \
        o[d0] = __builtin_amdgcn_mfma_f32_32x32x16_bf16(pa1, (bf16x8){l1[0], l1[1], l1[2], l1[3], h1[0], h1[1], h1[2], h1[3]}, o[d0], 0, 0, 0); \
        o[d0] = __builtin_amdgcn_mfma_f32_32x32x16_bf16(pa2, (bf16x8){l2[0], l2[1], l2[2], l2[3], h2[0], h2[1], h2[2], h2[3]}, o[d0], 0, 0, 0); \
        o[d0] = __builtin_amdgcn_mfma_f32_32x32x16_bf16(pa3, (bf16x8){l3[0], l3[1], l3[2], l3[3], h3[0], h3[1], h3[2], h3[3]}, o[d0], 0, 0, 0); } while (0)
    PV_D0(0); PV_D0(1); PV_D0(2); PV_D0(3);
#undef PV_D0
#undef TRRD
}
constexpr float THR2 = 8.0f;
__device__ __forceinline__ void softmax_tile(f32x16& p0, f32x16& p1, float sh, float& m_reg, float& l_reg, float& alpha, bf16x8& pa0, bf16x8& pa1, bf16x8& pa2, bf16x8& pa3) {
    float pmax = p0[0];
#pragma unroll
    for (int r = 1; r < 16; ++r) pmax = fmaxf(pmax, p0[r]);
#pragma unroll
    for (int r = 0; r < 16; ++r) pmax = fmaxf(pmax, p1[r]);
    { auto rr = __builtin_amdgcn_permlane32_swap(__float_as_uint(pmax), __float_as_uint(pmax), false, false);
      pmax = fmaxf(__uint_as_float(rr[0]), __uint_as_float(rr[1])); }
    pmax += sh;
    float mn;
    if (__builtin_expect(__all((pmax - m_reg) <= THR2), 1)) { mn = m_reg; alpha = 1.f; }
    else { mn = fmaxf(m_reg, pmax); alpha = __builtin_amdgcn_exp2f(m_reg - mn); m_reg = mn; }
    const float off = mn - sh;
#pragma unroll
    for (int r = 0; r < 16; ++r) p0[r] = __builtin_amdgcn_exp2f(p0[r] - off);
#pragma unroll
    for (int r = 0; r < 16; ++r) p1[r] = __builtin_amdgcn_exp2f(p1[r] - off);
    float ps = 0.f;
#pragma unroll
    for (int r = 0; r < 16; ++r) ps += p0[r];
#pragma unroll
    for (int r = 0; r < 16; ++r) ps += p1[r];
    { auto rr = __builtin_amdgcn_permlane32_swap(__float_as_uint(ps), __float_as_uint(ps), false, false);
      ps = __uint_as_float(rr[0]) + __uint_as_float(rr[1]); }
    l_reg = l_reg * alpha + ps;
#define PK4(P, B_, OUT) do { unsigned a0 = cvtpk(P[B_+0], P[B_+1]), a1 = cvtpk(P[B_+2], P[B_+3]); \
        unsigned b0 = cvtpk(P[B_+4], P[B_+5]), b1 = cvtpk(P[B_+6], P[B_+7]); \
        auto r0 = __builtin_amdgcn_permlane32_swap(a0, b0, false, false); auto r1 = __builtin_amdgcn_permlane32_swap(a1, b1, false, false); \
        u32x4 w = {r0[0], r1[0], r0[1], r1[1]}; OUT = __builtin_bit_cast(bf16x8, w); } while (0)
    PK4(p0, 0, pa0); PK4(p0, 8, pa1); PK4(p1, 0, pa2); PK4(p1, 8, pa3);
#undef PK4
}
__device__ __forceinline__ void add_bias_lut(f32x16& p0, f32x16& p1, LAS const float* lut, int dq) {
    LAS const float* bp = lut + (RMAXL - dq);
#pragma unroll
    for (int r = 0; r < 16; ++r) { const int c = (r & 3) + 8 * (r >> 2); p0[r] += bp[c]; p1[r] += bp[c + 32]; }
}
__device__ __forceinline__ void causal_mask(f32x16& p0, f32x16& p1, int dq) {
    const float NEG = -__builtin_inff();
#pragma unroll
    for (int r = 0; r < 16; ++r) { const int c = (r & 3) + 8 * (r >> 2); if (dq - c < 0) p0[r] = NEG; if (dq - c - 32 < 0) p1[r] = NEG; }
}
struct Stage { bf16x8 v0, v1, k0, k1; };
__device__ __forceinline__ void sload(Stage& S, const bf16* Kc, const bf16* Vc, int k0, int sr, int sc) {
    S.v0 = *(const bf16x8*)(Vc + (size_t)(k0 + sr) * PITCH + sc); S.v1 = *(const bf16x8*)(Vc + (size_t)(k0 + 32 + sr) * PITCH + sc);
    S.k0 = *(const bf16x8*)(Kc + (size_t)(k0 + sr) * PITCH + sc); S.k1 = *(const bf16x8*)(Kc + (size_t)(k0 + 32 + sr) * PITCH + sc);
}
__device__ __forceinline__ void swrite(const Stage& S, LAS char* lds, int bf, int kws, int vst0, int vst1) {
    *(LAS bf16x8*)(lds + L_V + bf * SHM_V + vst0) = S.v0; *(LAS bf16x8*)(lds + L_V + bf * SHM_V + vst1) = S.v1;
    *(LAS bf16x8*)(lds + L_K + bf * SHM_K + kws) = S.k0; *(LAS bf16x8*)(lds + L_K + bf * SHM_K + kws + 32 * 256) = S.k1;
}
__device__ __forceinline__ void build_lut(LAS char* lds, const float* relb, const int* blut, int h, int tid) {
    LAS float* lut = (LAS float*)(lds + L_LUT);
    for (int i = tid; i < LUTN; i += 512) { const int rel = RMAXL - i; lut[i] = rel >= 0 ? relb[blut[rel] * 8 + h] * 1.4426950408889634f : 0.f; }
}

__device__ __forceinline__ void diff_unit(LAS char* lds, int b, int h, int qb, const bf16* Q, const bf16* K, const bf16* V, bf16* O, const float* relb, const int* blut,
                                          float lam_full, const float* subg, int tid, int wid, int lane) {
    const int r32 = lane & 31, hi = lane >> 5, cm = wid >> 2, w4 = wid & 3;
    const size_t rowbase = (size_t)b * SEQ;
    const int q0 = qb * 128, qw0 = q0 + w4 * 32, qpos = qw0 + r32;
    const bf16* Kc = K + rowbase * PITCH + h * HD; const bf16* Vc = V + rowbase * PITCH + h * HD;
    const int NT = (q0 + 128) / 64;
    const int sr = tid >> 4, sc = (tid & 15) * 8, vst0 = v_st(sr, sc), vst1 = v_st(32 + sr, sc), kws = KSWZ(sr, sc * 2);
    const int vb0 = (int)(unsigned)(uintptr_t)(lds + L_V) + v_rd_base(lane);
    LAS float* ws = (LAS float*)(lds + L_WS) + wid * 64;
    LAS const float* lut = (LAS const float*)(lds + L_LUT);
    lcp K_lds = (lcp)(lds + L_K);
    const float b31 = relb[31 * 8 + h] * 1.4426950408889634f;
    build_lut(lds, relb, blut, h, tid);
    bf16x8 qr[4];
#pragma unroll
    for (int d0 = 0; d0 < 4; ++d0) qr[d0] = *(const bf16x8*)(Q + (rowbase + qpos) * PITCH + h * HD + cm * 64 + d0 * 16 + hi * 8);
    Stage S; sload(S, Kc, Vc, 0, sr, sc);
    asm volatile("s_waitcnt vmcnt(0)" ::: "memory");
    swrite(S, lds, 0, kws, vst0, vst1);
    __syncthreads();
    float m_reg = -1e30f, l_reg = 0.f; f32x16 o[4] = {};
#define DIFF_STEP(t, BF) do { const int k0_ = (t) * 64; \
        if ((t) + 1 < NT) sload(S, Kc, Vc, k0_ + 64, sr, sc); \
        if (k0_ <= qw0 + 31) { f32x16 p0, p1; bf16x8 pa0, pa1, pa2, pa3; float alpha, sh = 0.f; \
            qkt<BF, 4>(p0, p1, K_lds, r32, hi, cm * 128, qr); \
            const int dq_ = qpos - k0_ - 4 * hi; \
            if (qw0 - (k0_ + 63) >= RFAR) sh = b31; else add_bias_lut(p0, p1, lut, dq_); \
            if (k0_ + 63 > qw0) causal_mask(p0, p1, dq_); \
            softmax_tile(p0, p1, sh, m_reg, l_reg, alpha, pa0, pa1, pa2, pa3); \
            if (__any(alpha < 1.f)) { if (hi == 0) ws[r32] = alpha; asm volatile("s_waitcnt lgkmcnt(0)" ::: "memory"); \
                _Pragma("unroll") for (int d_ = 0; d_ < 4; ++d_) _Pragma("unroll") for (int r = 0; r < 16; ++r) o[d_][r] *= ws[crow(r, hi)]; } \
            pv_tile<BF>(o, vb0, pa0, pa1, pa2, pa3); } \
        if ((t) + 1 < NT) { asm volatile("s_waitcnt vmcnt(0)" ::: "memory"); swrite(S, lds, (BF) ^ 1, kws, vst0, vst1); } \
        __syncthreads(); } while (0)
    for (int t = 0; t < NT; t += 2) { DIFF_STEP(t, 0); DIFF_STEP(t + 1, 1); }
#undef DIFF_STEP
    if (hi == 0) ws[32 + r32] = l_reg; asm volatile("s_waitcnt lgkmcnt(0)" ::: "memory");
#pragma unroll
    for (int r = 0; r < 16; ++r) { const float rl = __builtin_amdgcn_rcpf(ws[32 + crow(r, hi)]);
#pragma unroll
        for (int d0 = 0; d0 < 4; ++d0) o[d0][r] *= rl; }
    LAS float* xch = (LAS float*)lds + (size_t)w4 * 64 * 64;
    if (cm == 1) {
#pragma unroll
        for (int d0 = 0; d0 < 4; ++d0)
#pragma unroll
            for (int r = 0; r < 16; ++r) xch[(d0 * 16 + r) * 64 + lane] = o[d0][r];
    }
    __syncthreads();
    if (cm == 0) {
        float ss[16];
#pragma unroll
        for (int r = 0; r < 16; ++r) { float a = 0.f;
#pragma unroll
            for (int d0 = 0; d0 < 4; ++d0) { o[d0][r] -= lam_full * xch[(d0 * 16 + r) * 64 + lane]; a += o[d0][r] * o[d0][r]; }
            ss[r] = a; }
#pragma unroll
        for (int r = 0; r < 16; ++r) {
#pragma unroll
            for (int sft = 1; sft < 32; sft <<= 1) ss[r] += __shfl_xor(ss[r], sft); }
        float gg[4];
#pragma unroll
        for (int d0 = 0; d0 < 4; ++d0) gg[d0] = subg[d0 * 32 + r32] * (1.0f - LAMBDA_INIT);
        bf16* Ow = O + (rowbase + qw0) * PITCH + h * HD;
#pragma unroll
        for (int r = 0; r < 16; ++r) { const int orow = crow(r, hi); const float rs = 1.0f / sqrtf(ss[r] * (1.0f / HD) + RMS_EPS);
#pragma unroll
            for (int d0 = 0; d0 < 4; ++d0) { const float v = o[d0][r] * rs * gg[d0]; const float vn = __shfl_xor(v, 1);
                if ((r32 & 1) == 0) *(unsigned*)(Ow + (size_t)orow * PITCH + d0 * 32 + r32) = cvtpk(v, vn); } }
    }
    __syncthreads();
}
#undef KSWZ
#undef SBAR
}


__device__ __forceinline__ void p_diff_attn_mfma(const Args& a, LAS unsigned char* lds, int vcu, int tid, int wave, int lane) {
    const bf16* Qb = (const bf16*)(a.ws + WS_Q); const bf16* Kb = (const bf16*)(a.ws + WS_K); const bf16* Vb = (const bf16*)(a.ws + WS_V);
    bf16* Ob = (bf16*)(a.ws + WS_O); const int* blut = (const int*)(a.ws + WS_BLUT);
    float lam_full;
    { const float* lm = a.diff_lambda; const float p01 = wave_sum(lm[lane] * lm[64 + lane]), p23 = wave_sum(lm[128 + lane] * lm[192 + lane]); lam_full = __expf(p01) - __expf(p23) + LAMBDA_INIT; }
    const int G = gridDim.x;
    for (int pr = 2 * vcu; pr < 512; pr += 2 * G) {
#pragma unroll 1
        for (int k = 0; k < 4; ++k) {
            const int pp = pr + (k >> 1); if (pp >= 512) break;
            const int bh = pp >> 5, p = pp & 31, qb = (k & 1) ? 63 - p : p;
            att::diff_unit((LAS char*)lds, bh >> 3, bh & 7, qb, Qb, Kb, Vb, Ob, a.rel_bias, blut, lam_full, a.diff_subln_g, tid, wave, lane);
        }
    }
}

__global__ void __launch_bounds__(NTHR, 2) fwd(Args a) {
    extern __shared__ __attribute__((aligned(16))) unsigned char lds_raw[];
    LAS unsigned char* lds = (LAS unsigned char*)lds_raw;
    volatile LAS unsigned* MISC = (volatile LAS unsigned*)(lds + MISC_OFF);
    const int tid = threadIdx.x, lane = tid & 63, wave = __builtin_amdgcn_readfirstlane(tid >> 6);
    const int G = gridDim.x, blk = blockIdx.x;
    const int vcu = (G % 8 == 0) ? (blk % 8) * (G / 8) + blk / 8 : blk;
    const int gtid = blk * NTHR + tid, gthreads = G * NTHR, gw = blk * NWAVES + wave, ngw = G * NWAVES;
    for (int u = tid; u < 64; u += NTHR) MISC[u] = 0u;
    __syncthreads();
    unsigned* ctl = (unsigned*)(a.ws + WS_CTL);
    XcdBarrier bar = xcd_barrier_post(ctl + CW_BAR, MISC + 8);
    const float* mod = (const float*)(a.ws + WS_MOD);
    bf16* Hb = (bf16*)(a.ws + WS_H); bf16* Qb = (bf16*)(a.ws + WS_Q); bf16* Kb = (bf16*)(a.ws + WS_K);
    bf16* Ob = (bf16*)(a.ws + WS_O); bf16* Yb = (bf16*)(a.ws + WS_Y); bf16* HHb = (bf16*)(a.ws + WS_HH);

    p_weights(a, lds, gw, ngw, wave, lane);
    p_mod(a, gtid, gthreads);
    xcd_barrier(bar);
    {
        const float* md = mod; const float* ng = a.norm_g;
        p_norm_in(a.x, ng, md, md + 1024, Hb, gw, ngw, lane); xcd_barrier(bar);
        { pg8::Gemm g{Hb, (const bf16*)(a.ws + WS_W + WO_QKV), M, 3 * D, D}; pg8::StaticOrder S; S.init(M, 3 * D, G, blk);
          pg8::EpiBf16<0> E{Qb, D, nullptr, D, (size_t)(WS_K - WS_Q) / 2, 0.08838834764831845f * LOG2E};
          pg8::gemm_phase<pg8::EpiBf16<0>, pg8::StaticOrder, true, true>(lds, g, S, E); }
        xcd_barrier(bar);
        p_kmean(Kb, (float*)(a.ws + WS_KMEAN), gtid, gthreads); xcd_barrier(bar);
        p_gate(Qb, (const float*)(a.ws + WS_KMEAN), (unsigned*)(a.ws + WS_SEL), gtid, gthreads); xcd_barrier(bar);
        p_moba_attn(a, lds, gw, ngw, wave, lane);
        xcd_barrier(bar);
        { pg8::Gemm g{Ob, (const bf16*)(a.ws + WS_W + WO_O), M, D, D}; pg8::StaticOrder S; S.init(M, D, G, blk);
          pg8::EpiBf16<0> E{Yb, D, nullptr, 0, 0, 1.f};
          pg8::gemm_phase<pg8::EpiBf16<0>, pg8::StaticOrder, true, true>(lds, g, S, E); }
        xcd_barrier(bar);
        p_post(a.x, Yb, ng + D, md + 2048, a.out, ng + 2 * D, md + 3072, md + 4096, Hb, gw, ngw, lane);
        xcd_barrier(bar);
        { pg8::Gemm g{Hb, (const bf16*)(a.ws + WS_W + WO_IN), M, 2 * DFF, D}; pg8::StaticOrder S; S.init(M, 2 * DFF, G, blk);
          pg8::EpiSwiglu E{HHb, DFF};
          pg8::gemm_phase<pg8::EpiSwiglu, pg8::StaticOrder, true, true>(lds, g, S, E); }
        xcd_barrier(bar);
        { pg8::Gemm g{HHb, (const bf16*)(a.ws + WS_W + WO_OUT), M, D, DFF}; pg8::StaticOrder S; S.init(M, D, G, blk);
          pg8::EpiBf16<0> E{Yb, D, nullptr, 0, 0, 1.f};
          pg8::gemm_phase<pg8::EpiBf16<0>, pg8::StaticOrder, true, true>(lds, g, S, E); }
        xcd_barrier(bar);
        const float* md1 = mod + (size_t)2 * 6144; const float* ng1 = a.norm_g + (size_t)4 * D;
        p_post(a.out, Yb, ng + 3 * D, md + 5120, a.out, ng1, md1, md1 + 1024, Hb, gw, ngw, lane); xcd_barrier(bar);
    }
    {
        const float* md = mod + (size_t)2 * 6144; const float* ng = a.norm_g + (size_t)4 * D;
        { pg8::Gemm g{Hb, (const bf16*)(a.ws + WS_W + WL_STRIDE + WO_QKV), M, 3 * D, D}; pg8::StaticOrder S; S.init(M, 3 * D, G, blk);
          pg8::EpiBf16<0> E{Qb, D, nullptr, D, (size_t)(WS_K - WS_Q) / 2, 0.125f * LOG2E};
          pg8::gemm_phase<pg8::EpiBf16<0>, pg8::StaticOrder, true, true>(lds, g, S, E); }
        xcd_barrier(bar);
        p_diff_attn_mfma(a, lds, vcu, tid, wave, lane);
        xcd_barrier(bar);
        { pg8::Gemm g{Ob, (const bf16*)(a.ws + WS_W + WL_STRIDE + WO_O), M, D, D}; pg8::StaticOrder S; S.init(M, D, G, blk);
          pg8::EpiBf16<0> E{Yb, D, nullptr, 0, 0, 1.f};
          pg8::gemm_phase<pg8::EpiBf16<0>, pg8::StaticOrder, true, true>(lds, g, S, E); }
        xcd_barrier(bar);
        p_post(a.out, Yb, ng + D, md + 2048, a.out, ng + 2 * D, md + 3072, md + 4096, Hb, gw, ngw, lane);
        xcd_barrier(bar);
        { pg8::Gemm g{Hb, (const bf16*)(a.ws + WS_W + WL_STRIDE + WO_IN), M, 2 * DFF, D}; pg8::StaticOrder S; S.init(M, 2 * DFF, G, blk);
          pg8::EpiSwiglu E{HHb, DFF};
          pg8::gemm_phase<pg8::EpiSwiglu, pg8::StaticOrder, true, true>(lds, g, S, E); }
        xcd_barrier(bar);
        { pg8::Gemm g{HHb, (const bf16*)(a.ws + WS_W + WL_STRIDE + WO_OUT), M, D, DFF}; pg8::StaticOrder S; S.init(M, D, G, blk);
          pg8::EpiBf16<0> E{Yb, D, nullptr, 0, 0, 1.f};
          pg8::gemm_phase<pg8::EpiBf16<0>, pg8::StaticOrder, true, true>(lds, g, S, E); }
        xcd_barrier(bar);
        p_post(a.out, Yb, ng + 3 * D, md + 5120, a.out, nullptr, nullptr, nullptr, nullptr, gw, ngw, lane);
    }
}

extern "C" void kernel_launch(void* const* d_in, const int* in_sizes, int n_in, void* d_out, int out_size, void* d_ws, size_t ws_size, hipStream_t stream) {
    static int grid = 0;
    if (grid == 0) {
        if (n_in != 14 || out_size != M * D || ws_size < WS_END) { fprintf(stderr, "kernel_launch: unexpected shapes n_in %d out %d ws %zu\n", n_in, out_size, ws_size); grid = -1; return; }
        int dev = 0, cus = 0;
        if (hipGetDevice(&dev) != hipSuccess || hipDeviceGetAttribute(&cus, hipDeviceAttributeMultiprocessorCount, dev) != hipSuccess) { grid = -1; return; }
        if (hipFuncSetAttribute((const void*)fwd, hipFuncAttributeMaxDynamicSharedMemorySize, LDS_BYTES) != hipSuccess) { fprintf(stderr, "hipFuncSetAttribute failed\n"); grid = -1; return; }
        grid = cus;
    }
    if (grid < 0) return;
    (void)hipMemsetAsync((char*)d_ws + WS_CTL, 0, CTL_ZERO_BYTES, stream);
    Args a{};
    a.x = (const float*)d_in[0]; a.c = (const float*)d_in[1]; a.rel_bias = (const float*)d_in[2]; a.ada_w = (const float*)d_in[3]; a.ada_b = (const float*)d_in[4];
    a.norm_g = (const float*)d_in[5]; a.moba_w_qkv = (const float*)d_in[6]; a.moba_w_o = (const float*)d_in[7]; a.diff_w_qkv = (const float*)d_in[8]; a.diff_w_o = (const float*)d_in[9];
    a.diff_lambda = (const float*)d_in[10]; a.diff_subln_g = (const float*)d_in[11]; a.ffn_w_in = (const float*)d_in[12]; a.ffn_w_out = (const float*)d_in[13];
    a.out = (float*)d_out; a.ws = (unsigned char*)d_ws;
    hipLaunchKernelGGL(fwd, dim3(grid), dim3(NTHR), LDS_BYTES, stream, a);
}
```

```cpp
#include <hip/hip_runtime.h>
#include <cstdio>
#include <cstdint>

#define GAS __attribute__((address_space(1)))
#define LAS __attribute__((address_space(3)))
typedef unsigned short bf16;
typedef float f32x4 __attribute__((ext_vector_type(4)));
typedef float f32x2 __attribute__((ext_vector_type(2)));
typedef unsigned u32x4 __attribute__((ext_vector_type(4)));
typedef unsigned u32x2 __attribute__((ext_vector_type(2)));

constexpr int BATCH = 2, SEQ = 8192, D = 1024, NH = 8, HD = 128, DFF = 2816, NBKT = 32;
constexpr int M = BATCH * SEQ;
constexpr int NWAVES = 8, NTHR = 512;
constexpr float RMS_EPS = 1e-6f;
constexpr float LOG2E = 1.4426950408889634f;
constexpr float LAMBDA_INIT = 0.35550906759096926f;

constexpr size_t MiB = 1u << 20;
constexpr size_t WS_CTL = 0, CTL_ZERO_BYTES = 1 * MiB;
constexpr size_t WS_MOD = 1 * MiB;
constexpr size_t WS_BLUT = WS_MOD + 128 * 1024;
constexpr size_t WS_KMEAN = WS_BLUT + 16 * 1024;
constexpr size_t WS_SEL = WS_KMEAN + 256 * 1024;
constexpr size_t WS_W = 2 * MiB, WL_STRIDE = 25 * MiB;
constexpr size_t WO_QKV = 0, WO_O = 6 * MiB, WO_IN = 8 * MiB, WO_OUT = 19 * MiB;
constexpr size_t WS_H = 52 * MiB;
constexpr size_t WS_Q = 84 * MiB, WS_K = 116 * MiB, WS_V = 148 * MiB;
constexpr size_t WS_HH = 84 * MiB;
constexpr size_t WS_O = 180 * MiB;
constexpr size_t WS_Y = 212 * MiB;
constexpr size_t WS_END = 244 * MiB;
constexpr int CW_BAR = 4096;

constexpr int LDS_BYTES = 147456;
constexpr int MISC_OFF = 131072 + 320;

#define RLX_AGENT __ATOMIC_RELAXED, __HIP_MEMORY_SCOPE_AGENT
__device__ __forceinline__ unsigned f2bf(float f) { unsigned u = __builtin_bit_cast(unsigned, f); return (u + 0x7fffu + ((u >> 16) & 1u)) >> 16; }
__device__ __forceinline__ unsigned pk2(float lo, float hi) { return f2bf(lo) | (f2bf(hi) << 16); }
__device__ __forceinline__ float bf2f(unsigned short b) { return __builtin_bit_cast(float, (unsigned)b << 16); }
__device__ __forceinline__ float bflo(unsigned w) { return __builtin_bit_cast(float, w << 16); }
__device__ __forceinline__ float bfhi(unsigned w) { return __builtin_bit_cast(float, w & 0xffff0000u); }

#define XB_TMO      128
#define XB_XCNT(j)  (256  + 64 * (j))
#define XB_XSUB(j)  (1280 + 64 * (j))
#define XB_XGEN(j)  (2304 + 64 * (j))
#define XB_TOP      3328
#define XB_TOPGEN   3392
#define XCD_BAR_WORDS 3456
#define XB_SPIN_CAP (1u << 25)
__device__ __forceinline__ unsigned xb_ld(unsigned* p)              { return __hip_atomic_load(p, __ATOMIC_RELAXED, __HIP_MEMORY_SCOPE_AGENT); }
__device__ __forceinline__ unsigned xb_add(unsigned* p, unsigned v) { return __hip_atomic_fetch_add(p, v, __ATOMIC_RELAXED, __HIP_MEMORY_SCOPE_AGENT); }
__device__ __forceinline__ unsigned xb_xcc_id() { return (unsigned)__builtin_amdgcn_s_getreg((3 << 11) | 20) & 0xFu; }
#define XB_SPIN(cond, bar) do { unsigned _sp = 0; while (cond) { __builtin_amdgcn_s_sleep(1); \
    if ((++_sp & 255u) == 0u) { if (xb_ld(&(bar)[XB_TMO])) break; if (_sp > XB_SPIN_CAP) { atomicAdd(&(bar)[XB_TMO], 1u); break; } } } } while (0)
struct XcdBarrier { unsigned* bar; unsigned x; volatile LAS unsigned* st; };
__device__ __forceinline__ XcdBarrier xcd_barrier_post(unsigned* bar, volatile LAS unsigned* st) {
    XcdBarrier b; b.bar = bar; b.x = xb_xcc_id(); b.st = st;
    if (threadIdx.x == 0) (void)xb_add(&bar[XB_XCNT(b.x)], 1u);
    return b;
}
__device__ __forceinline__ void xcd_barrier_complete(unsigned* bar, unsigned x, unsigned& nloc, unsigned& nx) {
    const unsigned G = gridDim.x * gridDim.y * gridDim.z;
    unsigned sum, cnt, mine, sp = 0u;
    for (;;) {
        sum = 0u; cnt = 0u; mine = 0u;
#pragma unroll
        for (unsigned j = 0; j < 16; ++j) { const unsigned c = xb_ld(&bar[XB_XCNT(j)]); sum += c; cnt += (c > 0u) ? 1u : 0u; mine = (j == x) ? c : mine; }
        if (sum == G) break;
        __builtin_amdgcn_s_sleep(1);
        if ((++sp & 255u) == 0u) { if (xb_ld(&bar[XB_TMO])) break; if (sp > XB_SPIN_CAP) { atomicAdd(&bar[XB_TMO], 1u); break; } }
    }
    nloc = mine > 0u ? mine : 1u; nx = cnt > 0u ? cnt : 1u;
}
__device__ __forceinline__ void xcd_barrier(const XcdBarrier& b) {
    asm volatile("s_waitcnt vmcnt(0)" ::: "memory");
    __syncthreads();
    if (threadIdx.x == 0) {
        unsigned* bar = b.bar;
        __builtin_amdgcn_s_waitcnt(0);
        unsigned nloc = b.st[0], nx = b.st[1];
        if (nloc == 0u) { xcd_barrier_complete(bar, b.x, nloc, nx); b.st[0] = nloc; b.st[1] = nx; }
        const unsigned old = xb_add(&bar[XB_XSUB(b.x)], 1u);
        const unsigned gen = old / nloc;
        if (old + 1u == (gen + 1u) * nloc) {
            __builtin_amdgcn_fence(__ATOMIC_RELEASE, "agent");
            asm volatile("s_waitcnt vmcnt(0)" ::: "memory");
            const unsigned og = xb_add(&bar[XB_TOP], 1u);
            const unsigned tg = og / nx;
            if (og + 1u == (tg + 1u) * nx) xb_add(&bar[XB_TOPGEN], 1u);
            else XB_SPIN(xb_ld(&bar[XB_TOPGEN]) == tg, bar);
            __builtin_amdgcn_fence(__ATOMIC_ACQUIRE, "agent");
            xb_add(&bar[XB_XGEN(b.x)], 1u);
            asm volatile("s_waitcnt vmcnt(0)" ::: "memory");
        } else {
            XB_SPIN(xb_ld(&bar[XB_XGEN(b.x)]) == gen, bar);
            __builtin_amdgcn_fence(__ATOMIC_ACQUIRE, "agent");
            asm volatile("s_waitcnt vmcnt(0)" ::: "memory");
        }
    }
    __syncthreads();
}

namespace pg8 {
#define PG8_LAS __attribute__((address_space(3)))
typedef unsigned short bf16_t;
typedef short bf16x8 __attribute__((ext_vector_type(8)));
typedef float f32x4 __attribute__((ext_vector_type(4)));
typedef unsigned u32x4 __attribute__((ext_vector_type(4)));
constexpr int BM = 256, BK = 64, HALF = 128, HTB = HALF * BK * 2  , STAGE_BYTES = 8 * HTB, NXCD = 8, WGM = 8;

__host__ __device__ __forceinline__ int lds_byte(int r, int c) { const int st = (r >> 4) * 2 + (c >> 5), rr = r & 15, cc = c & 31, ob = rr * 64 + cc * 2; return st * 1024 + (ob ^ (((ob >> 9) & 1) << 5)); }
__host__ __device__ __forceinline__ void stage_rc(int b, int& R, int& C) { const int st = b / 1024, sb = b % 1024, swz = sb ^ (((sb >> 9) & 1) << 5); R = (st >> 1) * 16 + swz / 64; C = (st & 1) * 32 + (swz % 64) / 2; }
__host__ __device__ __forceinline__ int perm32(int rho) { const int n = rho >> 4, i = rho & 15; return 8 * (i >> 2) + 4 * n + (i & 3); }

struct Unit { int pm, pn; };
struct Gemm { const bf16_t* A; const bf16_t* Bt; int M, N, K; };

struct StaticOrder {
    int nM, nN, nwg, G, c;
    __host__ __device__ void init(int M, int N, int G_, int c_) { nM = M / BM; nN = N / BM; nwg = nM * nN; G = G_; c = c_; }
    __host__ __device__ bool next(int i, Unit& u) const {
        const long L = (long)i * G + c; if (L >= nwg) return false;
        int wgid = (int)L; { const int q = nwg / NXCD, r = nwg % NXCD, xcd = wgid % NXCD, off = wgid / NXCD; wgid = (xcd < r ? xcd * (q + 1) : r * (q + 1) + (xcd - r) * q) + off; }
        const int nig = WGM * nN, gid = wgid / nig, fm = gid * WGM, gsz = (nM - fm) < WGM ? (nM - fm) : WGM;
        u.pm = fm + ((wgid % nig) % gsz); u.pn = (wgid % nig) / gsz; return true;
    }
    __device__ __forceinline__ void a_ready(const Unit&) const {}
    __device__ __forceinline__ void done(const Unit&) const {}
};

__device__ __forceinline__ unsigned cvt_pk_bf16(float lo, float hi) { unsigned r; asm volatile("v_cvt_pk_bf16_f32 %0, %1, %2" : "=v"(r) : "v"(lo), "v"(hi)); return r; }
typedef float f32x2 __attribute__((ext_vector_type(2)));
__device__ __forceinline__ f32x2 gelu_pk(f32x2 v) {
    const f32x2 av = __builtin_elementwise_abs(v), d = av * 0.2316418882f + 1.0f;
    f32x2 t; t.x = __builtin_amdgcn_rcpf(d.x); t.y = __builtin_amdgcn_rcpf(d.y);
    f32x2 q = t * 0.5307027145f + (-0.7265760135f); q = q * t + 0.7107068705f; q = q * t + (-0.142248368f); q = q * t + 0.127414796f; q = q * t;
    const f32x2 s = (v * v) * (-0.72134752044f);
    f32x2 e; e.x = __builtin_amdgcn_exp2f(s.x); e.y = __builtin_amdgcn_exp2f(s.y);
    const f32x2 m = v * (q * e), r = v - m;
    f32x2 o; o.x = v.x < 0.f ? m.x : r.x; o.y = v.y < 0.f ? m.y : r.y; return o;
}

template <int ACT  > struct EpiBf16 {
    static constexpr bool PERM = true, AFTER_DRAIN = false; static_assert(ACT == 0 || ACT == 1, "EpiBf16: ACT is 0 (none) or 1 (gelu_pk)");
    bf16_t* O; int ldc; const float* bias; int split_cols; size_t split_stride; float scale0;
    __device__ __forceinline__ void operator()(const f32x4 (&acc)[2][2][4][2], const Unit& u, int wr, int wc, int fr, int fq) const {
        const int row0 = u.pm * BM + wr * 64 + fr; int colt = u.pn * BM; bf16_t* base = O;
        float sc = 1.f; if (split_cols) { const int t = colt / split_cols; base += (size_t)t * split_stride; colt -= t * split_cols; if (t == 0) sc = scale0; }
        const int col0 = colt + wc * 32 + 8 * fq, bcol0 = u.pn * BM + wc * 32 + 8 * fq;
        f32x4 bv[2][2];
#pragma unroll
        for (int bj = 0; bj < 2; ++bj)
#pragma unroll
            for (int n = 0; n < 2; ++n) bv[bj][n] = bias ? *(const f32x4*)(bias + bcol0 + bj * HALF + 4 * n) : (f32x4){0.f, 0.f, 0.f, 0.f};
#pragma unroll
        for (int ai = 0; ai < 2; ++ai)
#pragma unroll
            for (int m = 0; m < 4; ++m) { bf16_t* rowp = base + (size_t)(row0 + ai * HALF + m * 16) * ldc + col0;
#pragma unroll
                for (int bj = 0; bj < 2; ++bj) { f32x4 v0 = acc[ai][bj][m][0] + bv[bj][0], v1 = acc[ai][bj][m][1] + bv[bj][1];
                    if (ACT == 1) { f32x2 a = gelu_pk((f32x2){v0[0], v0[1]}), b = gelu_pk((f32x2){v0[2], v0[3]}), c = gelu_pk((f32x2){v1[0], v1[1]}), d = gelu_pk((f32x2){v1[2], v1[3]});
                        v0 = (f32x4){a.x, a.y, b.x, b.y}; v1 = (f32x4){c.x, c.y, d.x, d.y}; }
                    v0 = v0 * sc; v1 = v1 * sc; u32x4 w; w.x = cvt_pk_bf16(v0[0], v0[1]); w.y = cvt_pk_bf16(v0[2], v0[3]); w.z = cvt_pk_bf16(v1[0], v1[1]); w.w = cvt_pk_bf16(v1[2], v1[3]);
                    *(u32x4*)(rowp + bj * HALF) = w; } }
    }
};

struct EpiSwiglu {
    static constexpr bool PERM = true, AFTER_DRAIN = false;
    bf16_t* O; int ldc;
    __device__ __forceinline__ void operator()(const f32x4 (&acc)[2][2][4][2], const Unit& u, int wr, int wc, int fr, int fq) const {
        const int row0 = u.pm * BM + wr * 64 + fr, col0 = u.pn * HALF + wc * 32 + 8 * fq;
#pragma unroll
        for (int ai = 0; ai < 2; ++ai)
#pragma unroll
            for (int m = 0; m < 4; ++m) { bf16_t* rowp = O + (size_t)(row0 + ai * HALF + m * 16) * ldc + col0;
                float v[8];
#pragma unroll
                for (int n = 0; n < 2; ++n)
#pragma unroll
                    for (int e = 0; e < 4; ++e) { const float g = acc[ai][0][m][n][e], uu = acc[ai][1][m][n][e];
                        v[n * 4 + e] = g * __builtin_amdgcn_rcpf(1.0f + __builtin_amdgcn_exp2f(-1.4426950408889634f * g)) * uu; }
                u32x4 w; w.x = cvt_pk_bf16(v[0], v[1]); w.y = cvt_pk_bf16(v[2], v[3]); w.z = cvt_pk_bf16(v[4], v[5]); w.w = cvt_pk_bf16(v[6], v[7]);
                *(u32x4*)rowp = w; }
    }
};
template <class Epi, class Sched, bool ALIGN_EPI = false, bool SP2 = false>
__device__ __forceinline__ void gemm_phase(PG8_LAS unsigned char* lds, const Gemm g, const Sched& S, const Epi& E) {
    int tid_ = threadIdx.x; asm volatile("" : "+v"(tid_));
    const int tid = tid_, wid = __builtin_amdgcn_readfirstlane(tid >> 6), lane = tid & 63, wr = wid >> 2, wc = wid & 3, fr = lane & 15, fq = lane >> 4;
    const int K = g.K, nt = K / BK;
    unsigned voffA[2], voffB[2];
#pragma unroll
    for (int i = 0; i < 2; ++i) { int R, C; stage_rc(tid * 16 + i * 8192, R, C); const int Rb = Epi::PERM ? ((R & ~31) + perm32(R & 31)) : R;
        voffA[i] = (unsigned)(R * K + C) * 2u; voffB[i] = (unsigned)(Rb * K + C) * 2u; }
    const size_t kstep = (size_t)(BK * 2);
    const size_t hstep = (size_t)HALF * K * 2;
    const size_t tstep = 2 * hstep;
    const unsigned ldsw = (unsigned)wid * 1024u;
    const int aoff = lds_byte(wr * 64 + fr, fq * 8), boff = lds_byte(wc * 32 + fr, fq * 8);
#define PG8_SA(b, h) (((b) * 2 + (h)) * HTB)
#define PG8_SB(b, h) ((4 + (b) * 2 + (h)) * HTB)
#define PG8_STAGE(bufoff, gbase, voff) do { _Pragma("unroll") for (int _i = 0; _i < 2; ++_i) \
        __builtin_amdgcn_global_load_lds((const unsigned*)((const char*)(gbase) + (voff)[_i]), (PG8_LAS unsigned*)(lds + (bufoff) + ldsw + _i * 8192), 16, 0, 0); } while (0)
#define PG8_LDA(dst, b, h) do { _Pragma("unroll") for (int m = 0; m < 4; ++m) _Pragma("unroll") for (int k = 0; k < 2; ++k) dst[m][k] = *(const PG8_LAS bf16x8*)(lds + PG8_SA(b, h) + aoff + m * 2048 + k * 1024); } while (0)
#define PG8_LDB(dst, b, h) do { _Pragma("unroll") for (int n = 0; n < 2; ++n) _Pragma("unroll") for (int k = 0; k < 2; ++k) dst[n][k] = *(const PG8_LAS bf16x8*)(lds + PG8_SB(b, h) + boff + n * 2048 + k * 1024); } while (0)
#define PG8_MMA(ai, bj, At, Bt) do { __builtin_amdgcn_s_setprio(1); _Pragma("unroll") for (int m = 0; m < 4; ++m) _Pragma("unroll") for (int n = 0; n < 2; ++n) _Pragma("unroll") for (int k = 0; k < 2; ++k) \
        acc[ai][bj][m][n] = __builtin_amdgcn_mfma_f32_16x16x32_bf16(Bt[n][k], At[m][k], acc[ai][bj][m][n], 0, 0, 0); __builtin_amdgcn_s_setprio(0); } while (0)
#define PG8_WAIT_V(n) asm volatile("s_waitcnt vmcnt(" #n ")" ::: "memory")
#define PG8_WAIT_L(n) asm volatile("s_waitcnt lgkmcnt(" #n ")" ::: "memory")
#define PG8_BAR __builtin_amdgcn_s_barrier()
#define PG8_SCHED __builtin_amdgcn_sched_barrier(0)
    Unit cur, nxt; int ui = 0;
    if (!S.next(0, cur)) return;
    f32x4 acc[2][2][4][2];
#pragma unroll
    for (int a = 0; a < 2; ++a)
#pragma unroll
        for (int b = 0; b < 2; ++b)
#pragma unroll
            for (int m = 0; m < 4; ++m)
#pragma unroll
                for (int n = 0; n < 2; ++n) acc[a][b][m][n] = (f32x4){0.f, 0.f, 0.f, 0.f};
    bf16x8 At[4][2], B0[2][2], B1[2][2];
    const char* cA = (const char*)g.A + (size_t)cur.pm * tstep; const char* cB = (const char*)g.Bt + (size_t)cur.pn * tstep;
    S.a_ready(cur);
    if constexpr (SP2) {
        PG8_STAGE(PG8_SB(0, 0), cB, voffB); PG8_STAGE(PG8_SB(0, 1), cB + hstep, voffB); PG8_STAGE(PG8_SA(0, 0), cA, voffA); PG8_STAGE(PG8_SA(0, 1), cA + hstep, voffA);
        if (wr == 1) PG8_BAR;
        PG8_WAIT_V(2); PG8_BAR;
        PG8_STAGE(PG8_SB(1, 0), cB + kstep, voffB); PG8_STAGE(PG8_SA(1, 0), cA + kstep, voffA); PG8_STAGE(PG8_SB(1, 1), cB + hstep + kstep, voffB);
        PG8_WAIT_V(6); PG8_BAR;
    } else {
        PG8_STAGE(PG8_SB(0, 0), cB, voffB); PG8_STAGE(PG8_SA(0, 0), cA, voffA); PG8_STAGE(PG8_SB(0, 1), cB + hstep, voffB); PG8_STAGE(PG8_SA(0, 1), cA + hstep, voffA);
        if (wr == 1) PG8_BAR;
        PG8_WAIT_V(4); PG8_BAR;
        PG8_STAGE(PG8_SB(1, 0), cB + kstep, voffB); PG8_STAGE(PG8_SA(1, 0), cA + kstep, voffA); PG8_STAGE(PG8_SB(1, 1), cB + hstep + kstep, voffB);
        PG8_WAIT_V(6); PG8_BAR;
    }
    for (;;) {
        const bool has_next = S.next(ui + 1, nxt);
        const char* nA = has_next ? (const char*)g.A + (size_t)nxt.pm * tstep : cA; const char* nB = has_next ? (const char*)g.Bt + (size_t)nxt.pn * tstep : cB;
        for (int t = 0; t < nt; t += 2) {
            const bool last = (t == nt - 2);
            const char* a1 = cA + (size_t)(t + 1) * kstep;
            const char* a2 = last ? nA : cA + (size_t)(t + 2) * kstep; const char* b2 = last ? nB : cB + (size_t)(t + 2) * kstep;
            const char* a3 = a2 + kstep; const char* b3 = b2 + kstep;
            if (last && has_next) S.a_ready(nxt);
            if constexpr (SP2) {
            PG8_LDB(B0, 0, 0); PG8_LDB(B1, 0, 1); PG8_SCHED; PG8_LDA(At, 0, 0); PG8_STAGE(PG8_SA(1, 1), a1 + hstep, voffA);
            PG8_WAIT_V(8); PG8_WAIT_L(0); PG8_BAR; PG8_MMA(0, 0, At, B0); PG8_MMA(0, 1, At, B1); PG8_BAR; PG8_SCHED;
            PG8_LDA(At, 0, 1); PG8_STAGE(PG8_SB(0, 0), b2, voffB); PG8_STAGE(PG8_SB(0, 1), b2 + hstep, voffB); PG8_STAGE(PG8_SA(0, 0), a2, voffA);
            PG8_WAIT_V(8); PG8_WAIT_L(0); PG8_BAR; PG8_MMA(1, 0, At, B0); PG8_MMA(1, 1, At, B1); PG8_BAR; PG8_SCHED;
            PG8_LDB(B0, 1, 0); PG8_LDB(B1, 1, 1); PG8_SCHED; PG8_LDA(At, 1, 0); PG8_STAGE(PG8_SA(0, 1), a2 + hstep, voffA);
            PG8_WAIT_V(8); PG8_WAIT_L(0); PG8_BAR; PG8_MMA(0, 0, At, B0); PG8_MMA(0, 1, At, B1); PG8_BAR; PG8_SCHED;
            PG8_LDA(At, 1, 1); PG8_STAGE(PG8_SB(1, 0), b3, voffB); PG8_STAGE(PG8_SB(1, 1), b3 + hstep, voffB); PG8_STAGE(PG8_SA(1, 0), a3, voffA);
            PG8_WAIT_V(8); PG8_WAIT_L(0); PG8_BAR; PG8_MMA(1, 0, At, B0); PG8_MMA(1, 1, At, B1); PG8_BAR; PG8_SCHED;
            } else {
            PG8_LDB(B0, 0, 0); PG8_SCHED; PG8_LDA(At, 0, 0); PG8_STAGE(PG8_SA(1, 1), a1 + hstep, voffA);
            PG8_WAIT_L(8); PG8_BAR; PG8_WAIT_L(0); PG8_MMA(0, 0, At, B0); PG8_BAR; PG8_SCHED;
            PG8_LDB(B1, 0, 1); PG8_STAGE(PG8_SB(0, 0), b2, voffB);
            PG8_BAR; PG8_WAIT_L(0); PG8_MMA(0, 1, At, B1); PG8_BAR;
            PG8_LDA(At, 0, 1); PG8_STAGE(PG8_SA(0, 0), a2, voffA);
            PG8_BAR; PG8_WAIT_L(0); PG8_MMA(1, 0, At, B0); PG8_BAR; PG8_SCHED;
            PG8_STAGE(PG8_SB(0, 1), b2 + hstep, voffB);
            PG8_WAIT_V(6); PG8_BAR; PG8_MMA(1, 1, At, B1); PG8_BAR;
            PG8_LDB(B0, 1, 0); PG8_SCHED; PG8_LDA(At, 1, 0); PG8_STAGE(PG8_SA(0, 1), a2 + hstep, voffA);
            PG8_WAIT_L(8); PG8_BAR; PG8_WAIT_L(0); PG8_MMA(0, 0, At, B0); PG8_BAR; PG8_SCHED;
            PG8_LDB(B1, 1, 1); PG8_STAGE(PG8_SB(1, 0), b3, voffB);
            PG8_BAR; PG8_WAIT_L(0); PG8_MMA(0, 1, At, B1); PG8_BAR;
            PG8_LDA(At, 1, 1); PG8_STAGE(PG8_SA(1, 0), a3, voffA);
            PG8_BAR; PG8_WAIT_L(0); PG8_MMA(1, 0, At, B0); PG8_BAR; PG8_SCHED;
            PG8_STAGE(PG8_SB(1, 1), b3 + hstep, voffB);
            PG8_WAIT_V(6); PG8_BAR; PG8_MMA(1, 1, At, B1); PG8_BAR;
            }
        }
        if constexpr (ALIGN_EPI) { if (wr == 0) PG8_BAR; }
        if constexpr (!Epi::AFTER_DRAIN) { E(acc, cur, wr, wc, fr, fq); S.done(cur); }
        if (!has_next) break;
#pragma unroll
        for (int a = 0; a < 2; ++a)
#pragma unroll
            for (int b = 0; b < 2; ++b)
#pragma unroll
                for (int m = 0; m < 4; ++m)
#pragma unroll
                    for (int n = 0; n < 2; ++n) acc[a][b][m][n] = (f32x4){0.f, 0.f, 0.f, 0.f};
        cur = nxt; cA = nA; cB = nB; ++ui;
        if constexpr (ALIGN_EPI) { if (wr == 1) PG8_BAR; }
    }
    PG8_WAIT_V(0);
    if constexpr (!ALIGN_EPI) { if (wr == 0) PG8_BAR; }
    PG8_BAR;
    if constexpr (Epi::AFTER_DRAIN) { E.fused(acc, cur, wr, wc, fr, fq, lds, wid, lane); S.done(cur); }
#undef PG8_SA
#undef PG8_SB
#undef PG8_STAGE
#undef PG8_LDA
#undef PG8_LDB
#undef PG8_MMA
#undef PG8_WAIT_V
#undef PG8_WAIT_L
#undef PG8_BAR
#undef PG8_SCHED
}
}

__device__ __forceinline__ float wave_sum(float v) {
#pragma unroll
    for (int o = 1; o < 64; o <<= 1) v += __shfl_xor(v, o);
    return v;
}
__device__ __forceinline__ float wave_max(float v) {
#pragma unroll
    for (int o = 1; o < 64; o <<= 1) v = fmaxf(v, __shfl_xor(v, o));
    return v;
}
__device__ __forceinline__ float silu_f(float v) { return v / (1.f + __expf(-v)); }

struct Args {
    const float* x; const float* c; const float* rel_bias; const float* ada_w; const float* ada_b; const float* norm_g;
    const float* moba_w_qkv; const float* moba_w_o; const float* diff_w_qkv; const float* diff_w_o;
    const float* diff_lambda; const float* diff_subln_g; const float* ffn_w_in; const float* ffn_w_out;
    float* out; unsigned char* ws;
};

__device__ __forceinline__ int t5_bucket(int rel) {
    const int n = rel < 0 ? 0 : rel;
    const float nf = (float)(n < 1 ? 1 : n);
    int large = 16 + (int)(logf(nf / 16.0f) / 4.852030263919617f * 16.0f);
    large = large < 31 ? large : 31;
    return n < 16 ? n : large;
}

__device__ __forceinline__ void p_mod(const Args& a, int gtid, int gthreads) {
    float* mod = (float*)(a.ws + WS_MOD);
    for (int idx = gtid; idx < 2 * 6144; idx += gthreads) {
        const int l = idx / 6144, j = idx % 6144;
        const float* w = a.ada_w + (size_t)l * D * 6144 + j;
        float s0 = 0.f, s1 = 0.f;
        for (int k = 0; k < D; ++k) { const float wv = w[(size_t)k * 6144]; s0 += silu_f(a.c[k]) * wv; s1 += silu_f(a.c[D + k]) * wv; }
        const float bb = a.ada_b[l * 6144 + j];
        mod[(l * 2 + 0) * 6144 + j] = s0 + bb; mod[(l * 2 + 1) * 6144 + j] = s1 + bb;
    }
    int* blut = (int*)(a.ws + WS_BLUT);
    for (int r = gtid; r < 2048; r += gthreads) blut[r] = t5_bucket(r);
}


__device__ __forceinline__ void transpose_item(const float* W, int K, int N, int k0, int n0, bf16* WT, int dst_row0, LAS float* scr, int lane) {
#pragma unroll 8
    for (int i = 0; i < 32; ++i) { const int kk = 2 * i + (lane >> 5); scr[kk * 33 + (lane & 31)] = W[(size_t)(k0 + kk) * N + n0 + (lane & 31)]; }
    asm volatile("s_waitcnt lgkmcnt(0)" ::: "memory");
    const int c = lane & 7;
#pragma unroll
    for (int j = 0; j < 4; ++j) { const int n = (lane >> 3) + 8 * j; const LAS float* sp = scr + (8 * c) * 33 + n;
        u32x4 o; o.x = pk2(sp[0 * 33], sp[1 * 33]); o.y = pk2(sp[2 * 33], sp[3 * 33]); o.z = pk2(sp[4 * 33], sp[5 * 33]); o.w = pk2(sp[6 * 33], sp[7 * 33]);
        *(u32x4*)(WT + (size_t)(dst_row0 + n) * K + k0 + 8 * c) = o; }
    asm volatile("s_waitcnt lgkmcnt(0)" ::: "memory");
}
__device__ __forceinline__ void p_weights(const Args& a, LAS unsigned char* lds, int gw, int ngw, int wave, int lane) {
    LAS float* scr = (LAS float*)(lds + wave * 16384);
    constexpr int I_QKV = (D / 64) * (3 * D / 32), I_O = (D / 64) * (D / 32), I_IN = (D / 64) * (2 * DFF / 32), I_OUT = (DFF / 64) * (D / 32);
    constexpr int PER_L = I_QKV + I_O + I_IN + I_OUT;
    for (int it = gw; it < 2 * PER_L; it += ngw) {
        const int l = it / PER_L; int r = it % PER_L;
        unsigned char* wl = a.ws + WS_W + (size_t)l * WL_STRIDE;
        if (r < I_QKV) { const int nb = 3 * D / 32, kb = r / nb, n0 = (r % nb) * 32; transpose_item(l == 0 ? a.moba_w_qkv : a.diff_w_qkv, D, 3 * D, kb * 64, n0, (bf16*)(wl + WO_QKV), n0, scr, lane); continue; } r -= I_QKV;
        if (r < I_O) { const int nb = D / 32, kb = r / nb, n0 = (r % nb) * 32; transpose_item(l == 0 ? a.moba_w_o : a.diff_w_o, D, D, kb * 64, n0, (bf16*)(wl + WO_O), n0, scr, lane); continue; } r -= I_O;
        if (r < I_IN) { const int nb = 2 * DFF / 32, kb = r / nb, n0 = (r % nb) * 32;
            const int isu = n0 >= DFF ? 1 : 0, nn = n0 - isu * DFF, dst = 256 * (nn / 128) + 128 * isu + (nn % 128);
            transpose_item(a.ffn_w_in + (size_t)l * D * 2 * DFF, D, 2 * DFF, kb * 64, n0, (bf16*)(wl + WO_IN), dst, scr, lane); continue; } r -= I_IN;
        { const int nb = D / 32, kb = r / nb, n0 = (r % nb) * 32; transpose_item(a.ffn_w_out + (size_t)l * DFF * D, DFF, D, kb * 64, n0, (bf16*)(wl + WO_OUT), n0, scr, lane); }
    }
}

__device__ __forceinline__ void p_norm_in(const float* X, const float* g, const float* sh, const float* sc, bf16* H, int gw, int ngw, int lane) {
    for (int m = gw; m < M; m += ngw) {
        const int b = m / SEQ;
        const f32x4* xr = (const f32x4*)(X + (size_t)m * D) + lane;
        f32x4 v[4]; float s = 0.f;
#pragma unroll
        for (int j = 0; j < 4; ++j) { v[j] = xr[64 * j]; s += (v[j].x * v[j].x + v[j].y * v[j].y) + (v[j].z * v[j].z + v[j].w * v[j].w); }
        const float r = 1.0f / sqrtf(wave_sum(s) * (1.f / D) + RMS_EPS);
        u32x2* o = (u32x2*)(H + (size_t)m * D) + lane;
#pragma unroll
        for (int j = 0; j < 4; ++j) {
            const f32x4 gg = ((const f32x4*)g)[lane + 64 * j], s1 = ((const f32x4*)(sc + b * 6144))[lane + 64 * j], s0 = ((const f32x4*)(sh + b * 6144))[lane + 64 * j];
            const f32x4 h = v[j] * r * gg * (1.0f + s1) + s0;
            u32x2 w; w.x = pk2(h.x, h.y); w.y = pk2(h.z, h.w); o[64 * j] = w;
        }
    }
}
__device__ __forceinline__ void p_post(const float* Xin, const bf16* Y, const float* g1, const float* gate, float* Xout,
                                       const float* g2, const float* sh, const float* sc, bf16* H, int gw, int ngw, int lane) {
    for (int m = gw; m < M; m += ngw) {
        const int b = m / SEQ;
        const u32x2* yr = (const u32x2*)(Y + (size_t)m * D) + lane;
        const f32x4* xr = (const f32x4*)(Xin + (size_t)m * D) + lane;
        f32x4 y[4], xv[4]; float s = 0.f;
#pragma unroll
        for (int j = 0; j < 4; ++j) { const u32x2 w = yr[64 * j]; y[j] = (f32x4){bflo(w.x), bfhi(w.x), bflo(w.y), bfhi(w.y)}; xv[j] = xr[64 * j];
            s += (y[j].x * y[j].x + y[j].y * y[j].y) + (y[j].z * y[j].z + y[j].w * y[j].w); }
        const float r = 1.0f / sqrtf(wave_sum(s) * (1.f / D) + RMS_EPS);
        float s2 = 0.f;
#pragma unroll
        for (int j = 0; j < 4; ++j) {
            const f32x4 gg = ((const f32x4*)g1)[lane + 64 * j], gt = ((const f32x4*)(gate + b * 6144))[lane + 64 * j];
            xv[j] = xv[j] + gt * (y[j] * r * gg);
            s2 += (xv[j].x * xv[j].x + xv[j].y * xv[j].y) + (xv[j].z * xv[j].z + xv[j].w * xv[j].w);
            ((f32x4*)(Xout + (size_t)m * D))[lane + 64 * j] = xv[j];
        }
        if (H) {
            const float r2 = 1.0f / sqrtf(wave_sum(s2) * (1.f / D) + RMS_EPS);
            u32x2* o = (u32x2*)(H + (size_t)m * D) + lane;
#pragma unroll
            for (int j = 0; j < 4; ++j) {
                const f32x4 gg = ((const f32x4*)g2)[lane + 64 * j], s1 = ((const f32x4*)(sc + b * 6144))[lane + 64 * j], s0 = ((const f32x4*)(sh + b * 6144))[lane + 64 * j];
                const f32x4 h = xv[j] * r2 * gg * (1.0f + s1) + s0;
                u32x2 w; w.x = pk2(h.x, h.y); w.y = pk2(h.z, h.w); o[64 * j] = w;
            }
        }
    }
}

template <int MODE>
__device__ __forceinline__ void naive_gemm(LAS unsigned char* lds, const bf16* A, int K, const float* W, int ldw, int Nout, bf16* C, int ldc, float qscale, int blk, int nblk, int tid) {
    LAS float* As = (LAS float*)lds;
    LAS float* Ws = As + 16 * 132;
    LAS float* Wu = Ws + 16 * 132;
    const int ty = tid >> 4, tx = tid & 15;
    const int ntn = Nout / 128, ntiles = (M / 128) * ntn;
    for (int t = blk; t < ntiles; t += nblk) {
        const int tm = t / ntn, tn = t % ntn, row0 = tm * 128, col0 = tn * 128;
        float acc[4][8], acu[4][8];
#pragma unroll
        for (int i = 0; i < 4; ++i)
#pragma unroll
            for (int j = 0; j < 8; ++j) { acc[i][j] = 0.f; acu[i][j] = 0.f; }
        for (int k0 = 0; k0 < K; k0 += 16) {
            __syncthreads();
            { const int r = tid >> 2, kk = (tid & 3) * 4; const u32x2 w = *(const u32x2*)(A + (size_t)(row0 + r) * K + k0 + kk);
              As[(kk + 0) * 132 + r] = bflo(w.x); As[(kk + 1) * 132 + r] = bfhi(w.x); As[(kk + 2) * 132 + r] = bflo(w.y); As[(kk + 3) * 132 + r] = bfhi(w.y); }
            { const int kk = tid >> 5, cc = (tid & 31) * 4; const f32x4 w = *(const f32x4*)(W + (size_t)(k0 + kk) * ldw + col0 + cc);
              *(LAS f32x4*)(Ws + kk * 132 + cc) = w;
              if (MODE == 2) { const f32x4 u = *(const f32x4*)(W + (size_t)(k0 + kk) * ldw + DFF + col0 + cc); *(LAS f32x4*)(Wu + kk * 132 + cc) = u; } }
            __syncthreads();
#pragma unroll 2
            for (int kk = 0; kk < 16; ++kk) {
                const f32x4 av = *(LAS f32x4*)(As + kk * 132 + ty * 4);
                const f32x4 b0 = *(LAS f32x4*)(Ws + kk * 132 + tx * 8), b1 = *(LAS f32x4*)(Ws + kk * 132 + tx * 8 + 4);
                const float aa[4] = {av.x, av.y, av.z, av.w}; const float bb[8] = {b0.x, b0.y, b0.z, b0.w, b1.x, b1.y, b1.z, b1.w};
#pragma unroll
                for (int i = 0; i < 4; ++i)
#pragma unroll
                    for (int j = 0; j < 8; ++j) acc[i][j] += aa[i] * bb[j];
                if (MODE == 2) {
                    const f32x4 u0 = *(LAS f32x4*)(Wu + kk * 132 + tx * 8), u1 = *(LAS f32x4*)(Wu + kk * 132 + tx * 8 + 4);
                    const float uu[8] = {u0.x, u0.y, u0.z, u0.w, u1.x, u1.y, u1.z, u1.w};
#pragma unroll
                    for (int i = 0; i < 4; ++i)
#pragma unroll
                        for (int j = 0; j < 8; ++j) acu[i][j] += aa[i] * uu[j];
                }
            }
        }
#pragma unroll
        for (int i = 0; i < 4; ++i) {
            const int row = row0 + ty * 4 + i; int col = col0 + tx * 8; bf16* base = C; float sc = 1.f;
            if (MODE == 1) { const int tt = col / 1024; base = C + (size_t)tt * ((WS_K - WS_Q) / 2); col -= tt * 1024; if (tt == 0) sc = qscale; }
            float v[8];
#pragma unroll
            for (int j = 0; j < 8; ++j) { v[j] = acc[i][j] * sc; if (MODE == 2) v[j] = silu_f(acc[i][j]) * acu[i][j]; }
            u32x4 w; w.x = pk2(v[0], v[1]); w.y = pk2(v[2], v[3]); w.z = pk2(v[4], v[5]); w.w = pk2(v[6], v[7]);
            *(u32x4*)(base + (size_t)row * ldc + col) = w;
        }
    }
    __syncthreads();
}

__device__ __forceinline__ void p_kmean(const bf16* Kb, float* kmean, int gtid, int gthreads) {
    for (int idx = gtid; idx < BATCH * NH * 32 * HD; idx += gthreads) {
        const int d = idx % HD, blk = (idx / HD) % 32, h = (idx / (HD * 32)) % NH, b = idx / (HD * 32 * NH);
        const bf16* p = Kb + ((size_t)b * SEQ + blk * 256) * D + h * HD + d;
        float s = 0.f;
        for (int r = 0; r < 256; ++r) s += bf2f(p[(size_t)r * D]);
        kmean[idx] = s * (1.0f / 256.0f);
    }
}
__device__ __forceinline__ void p_gate(const bf16* Qb, const float* kmean, unsigned* sel, int gtid, int gthreads) {
    for (int idx = gtid; idx < BATCH * NH * SEQ; idx += gthreads) {
        const int q = idx % SEQ, h = (idx / SEQ) % NH, b = idx / (SEQ * NH);
        const int own = q >> 8;
        unsigned mask;
        if (own <= 3) mask = (1u << own) - 1u;
        else {
            const bf16* qp = Qb + ((size_t)b * SEQ + q) * D + h * HD;
            const float* km = kmean + (size_t)(b * NH + h) * 32 * HD;
            float b0 = -3e38f, b1 = -3e38f, b2 = -3e38f; int i0 = 0, i1 = 0, i2 = 0;
            for (int n = 0; n < own; ++n) {
                float g = 0.f;
                for (int d = 0; d < HD; d += 2) { const unsigned w = *(const unsigned*)(qp + d); g += bflo(w) * km[n * HD + d] + bfhi(w) * km[n * HD + d + 1]; }
                if (g > b0) { b2 = b1; i2 = i1; b1 = b0; i1 = i0; b0 = g; i0 = n; }
                else if (g > b1) { b2 = b1; i2 = i1; b1 = g; i1 = n; }
                else if (g > b2) { b2 = g; i2 = n; }
            }
            mask = (1u << i0) | (1u << i1) | (1u << i2);
        }
        sel[idx] = mask;
    }
}

template <int QKD>
__device__ __forceinline__ void naive_attn_row(const bf16* Qrow, const bf16* Kc, const bf16* Vc, int qpos, unsigned bmask, const float* relb, int h, const int* blut,
                                               LAS float* wq, LAS float* wp, int lane, float& o0, float& o1) {
    if (lane < QKD / 2) { const unsigned w = *(const unsigned*)(Qrow + 2 * lane); wq[2 * lane] = bflo(w); wq[2 * lane + 1] = bfhi(w); }
    asm volatile("s_waitcnt lgkmcnt(0)" ::: "memory");
    float m = -1e30f, l = 0.f; o0 = 0.f; o1 = 0.f;
    const int own = qpos >> 8;
    for (int j = 0; j <= own; ++j) {
        if (!((bmask >> j) & 1u)) continue;
        for (int c = 0; c < 4; ++c) {
            const int k0 = j * 256 + c * 64;
            if (k0 > qpos) break;
            const int key = k0 + lane;
            const bf16* kp = Kc + (size_t)key * D;
            float s = 0.f;
#pragma unroll
            for (int d = 0; d < QKD; d += 8) {
                const u32x4 w = *(const u32x4*)(kp + d);
                const f32x4 q0 = *(LAS f32x4*)(wq + d), q1 = *(LAS f32x4*)(wq + d + 4);
                s += bflo(w.x) * q0.x + bfhi(w.x) * q0.y + bflo(w.y) * q0.z + bfhi(w.y) * q0.w + bflo(w.z) * q1.x + bfhi(w.z) * q1.y + bflo(w.w) * q1.z + bfhi(w.w) * q1.w;
            }
            const int rel = qpos - key;
            const int bk = rel < 0 ? 0 : (rel < 2048 ? blut[rel] : 31);
            s += relb[bk * NH + h] * LOG2E;
            if (key > qpos) s = -__builtin_inff();
            const float cm = wave_max(s), mn = fmaxf(m, cm), alpha = exp2f(m - mn), p = exp2f(s - mn);
            l = l * alpha + wave_sum(p); o0 *= alpha; o1 *= alpha; m = mn;
            wp[lane] = p;
            asm volatile("s_waitcnt lgkmcnt(0)" ::: "memory");
            const bf16* vp = Vc + (size_t)k0 * D + 2 * lane;
#pragma unroll 8
            for (int jj = 0; jj < 64; ++jj) { const float pj = wp[jj]; const unsigned w = *(const unsigned*)(vp + (size_t)jj * D); o0 += pj * bflo(w); o1 += pj * bfhi(w); }
            asm volatile("s_waitcnt lgkmcnt(0)" ::: "memory");
        }
    }
    const float rl = 1.0f / l; o0 *= rl; o1 *= rl;
}

__device__ __forceinline__ void p_moba_attn(const Args& a, LAS unsigned char* lds, int gw, int ngw, int wave, int lane) {
    const bf16* Qb = (const bf16*)(a.ws + WS_Q); const bf16* Kb = (const bf16*)(a.ws + WS_K); const bf16* Vb = (const bf16*)(a.ws + WS_V);
    bf16* Ob = (bf16*)(a.ws + WS_O); const unsigned* sel = (const unsigned*)(a.ws + WS_SEL); const int* blut = (const int*)(a.ws + WS_BLUT);
    LAS float* wq = (LAS float*)lds + wave * 256; LAS float* wp = wq + 128;
    for (int idx = gw; idx < BATCH * NH * SEQ; idx += ngw) {
        const int q = idx % SEQ, h = (idx / SEQ) % NH, b = idx / (SEQ * NH);
        const size_t rb = (size_t)b * SEQ;
        const unsigned bm = sel[idx] | (1u << (q >> 8));
        float o0, o1;
        naive_attn_row<128>(Qb + (rb + q) * D + h * HD, Kb + rb * D + h * HD, Vb + rb * D + h * HD, q, bm, a.rel_bias, h, blut, wq, wp, lane, o0, o1);
        *(unsigned*)(Ob + (rb + q) * D + h * HD + 2 * lane) = pk2(o0, o1);
    }
}
__device__ __forceinline__ void p_diff_attn(const Args& a, LAS unsigned char* lds, int gw, int ngw, int wave, int lane) {
    const bf16* Qb = (const bf16*)(a.ws + WS_Q); const bf16* Kb = (const bf16*)(a.ws + WS_K); const bf16* Vb = (const bf16*)(a.ws + WS_V);
    bf16* Ob = (bf16*)(a.ws + WS_O); const int* blut = (const int*)(a.ws + WS_BLUT);
    LAS float* wq = (LAS float*)lds + wave * 256; LAS float* wp = wq + 128;
    float lam_full;
    { const float* lm = a.diff_lambda; const float p01 = wave_sum(lm[lane] * lm[64 + lane]), p23 = wave_sum(lm[128 + lane] * lm[192 + lane]); lam_full = __expf(p01) - __expf(p23) + LAMBDA_INIT; }
    for (int idx = gw; idx < BATCH * NH * SEQ; idx += ngw) {
        const int q = idx % SEQ, h = (idx / SEQ) % NH, b = idx / (SEQ * NH);
        const size_t rb = (size_t)b * SEQ;
        const int own = q >> 8; const unsigned bm = own >= 31 ? 0xffffffffu : ((1u << (own + 1)) - 1u);
        float a0, a1, b0, b1;
        naive_attn_row<64>(Qb + (rb + q) * D + h * HD, Kb + rb * D + h * HD, Vb + rb * D + h * HD, q, bm, a.rel_bias, h, blut, wq, wp, lane, a0, a1);
        naive_attn_row<64>(Qb + (rb + q) * D + h * HD + 64, Kb + rb * D + h * HD + 64, Vb + rb * D + h * HD, q, bm, a.rel_bias, h, blut, wq, wp, lane, b0, b1);
        float o0 = a0 - lam_full * b0, o1 = a1 - lam_full * b1;
        const float ss = wave_sum(o0 * o0 + o1 * o1);
        const float r = 1.0f / sqrtf(ss * (1.0f / HD) + RMS_EPS) * (1.0f - LAMBDA_INIT);
        o0 = o0 * r * a.diff_subln_g[2 * lane]; o1 = o1 * r * a.diff_subln_g[2 * lane + 1];
        *(unsigned*)(Ob + (rb + q) * D + h * HD + 2 * lane) = pk2(o0, o1);
    }
}


namespace att {
typedef short bf16x8 __attribute__((ext_vector_type(8)));
typedef short s16x4 __attribute__((ext_vector_type(4)));
typedef float f32x16 __attribute__((ext_vector_type(16)));
typedef LAS const char* lcp;
constexpr int PITCH = 1024;
constexpr int SHM_V = 16384, SHM_K = 16384;
constexpr int L_V = 0, L_K = 32768, L_WS = 65536, L_LUT = 67584;
constexpr int LUTN = 2304, RMAXL = 2047, RFAR = 1536;
#define KSWZ(row, colB) ((row) * 256 + ((colB) ^ (((row) & 7) << 4)))
#define SBAR() __builtin_amdgcn_sched_barrier(0)
__device__ __forceinline__ int v_st(int k, int c) { const int kk = (k & ~0xC) | ((k & 4) << 1) | ((k & 8) >> 1); return ((kk >> 3) * 4 + (c >> 5)) * 512 + ((kk & 7) * 32 + (c & 31)) * 2; }
__device__ __forceinline__ int v_rd_base(int lane) { return ((lane & 3) << 3) | (((lane >> 2) & 3) << 6) | (((lane >> 4) & 1) << 5) | (((lane >> 5) & 1) << 8); }
constexpr int v_rd_off(int d0, int ks, int half) { return d0 * 512 + ks * 4096 + half * 2048; }
__device__ __forceinline__ int crow(int r, int hi) { return (r & 3) + 8 * (r >> 2) + 4 * hi; }
__device__ __forceinline__ unsigned cvtpk(float lo, float hi) { unsigned r; asm volatile("v_cvt_pk_bf16_f32 %0, %1, %2" : "=v"(r) : "v"(lo), "v"(hi)); return r; }

template <int KB, int NDS>
__device__ __forceinline__ void qkt(f32x16& p0, f32x16& p1, lcp K_lds, int r32, int hi, int coff, const bf16x8* qr) {
    p0 = f32x16{}; p1 = f32x16{};
    lcp kb[4];
#pragma unroll
    for (int dd = 0; dd < 4; ++dd) kb[dd] = K_lds + KB * SHM_K + KSWZ(r32, (dd * 16 + hi * 8) * 2) + coff;
#pragma unroll
    for (int d0 = 0; d0 < NDS; ++d0) { lcp a = kb[d0 & 3] + (d0 >> 2) * 128;
        const bf16x8 b0 = *(LAS const bf16x8*)a;
        const bf16x8 b1 = *(LAS const bf16x8*)(a + 32 * 256);
        p0 = __builtin_amdgcn_mfma_f32_32x32x16_bf16(b0, qr[d0], p0, 0, 0, 0);
        p1 = __builtin_amdgcn_mfma_f32_32x32x16_bf16(b1, qr[d0], p1, 0, 0, 0);
        if (NDS == 8 && (d0 & 1) == 1) SBAR(); }
}
template <int VB>
__device__ __forceinline__ void pv_tile(f32x16* o, int vb0, bf16x8 pa0, bf16x8 pa1, bf16x8 pa2, bf16x8 pa3) {
#define TRRD(dst, off) asm volatile("ds_read_b64_tr_b16 %0, %1 offset:%2" : "=&v"(dst) : "v"(vb0), "i"(off) : "memory")
#define PV_D0(d0) do { s16x4 l0, l1, l2, l3, h0, h1, h2, h3; constexpr int b_ = VB * SHM_V + v_rd_off(d0, 0, 0); \
        TRRD(l0, b_); TRRD(h0, b_ + 2048); TRRD(l1, b_ + 4096); TRRD(h1, b_ + 6144); TRRD(l2, b_ + 8192); TRRD(h2, b_ + 10240); TRRD(l3, b_ + 12288); TRRD(h3, b_ + 14336); \
        asm volatile("s_waitcnt lgkmcnt(0)" ::: "memory"); SBAR(); \
        o[d0] = __builtin_amdgcn_mfma_f32_32x32x16_bf16(pa0, (bf16x8){l0[0], l0[1], l0[2], l0[3], h0[0], h0[1], h0[2], h0[3]}, o[d0], 0, 0, 0); \
        o[d0] = __builtin_amdgcn_mfma_f32_32x32x16_bf16(pa1, (bf16x8){l1[0], l1[1], l1[2], l1[3], h1[0], h1[1], h1[2], h1[3]}, o[d0], 0, 0, 0); \
        o[d0] = __builtin_amdgcn_mfma_f32_32x32x16_bf16(pa2, (bf16x8){l2[0], l2[1], l2[2], l2[3], h2[0], h2[1], h2[2], h2[3]}, o[d0], 0, 0, 0); \
        o[d0] = __builtin_amdgcn_mfma_f32_32x32x16_bf16(pa3, (bf16x8){l3[0], l3[1], l3[2], l3[3], h3[0], h3[1], h3[2], h3[3]}, o[d0], 0, 0, 0); } while (0)
    PV_D0(0); PV_D0(1); PV_D0(2); PV_D0(3);
#undef PV_D0
#undef TRRD
}
constexpr float THR2 = 8.0f;
__device__ __forceinline__ void softmax_tile(f32x16& p0, f32x16& p1, float sh, float& m_reg, float& l_reg, float& alpha, bf16x8& pa0, bf16x8& pa1, bf16x8& pa2, bf16x8& pa3) {
    float pmax = p0[0];
#pragma unroll
    for (int r = 1; r < 16; ++r) pmax = fmaxf(pmax, p0[r]);
#pragma unroll
    for (int r = 0; r < 16; ++r) pmax = fmaxf(pmax, p1[r]);
    { auto rr = __builtin_amdgcn_permlane32_swap(__float_as_uint(pmax), __float_as_uint(pmax), false, false);
      pmax = fmaxf(__uint_as_float(rr[0]), __uint_as_float(rr[1])); }
    pmax += sh;
    float mn;
    if (__builtin_expect(__all((pmax - m_reg) <= THR2), 1)) { mn = m_reg; alpha = 1.f; }
    else { mn = fmaxf(m_reg, pmax); alpha = __builtin_amdgcn_exp2f(m_reg - mn); m_reg = mn; }
    const float off = mn - sh;
#pragma unroll
    for (int r = 0; r < 16; ++r) p0[r] = __builtin_amdgcn_exp2f(p0[r] - off);
#pragma unroll
    for (int r = 0; r < 16; ++r) p1[r] = __builtin_amdgcn_exp2f(p1[r] - off);
    float ps = 0.f;
#pragma unroll
    for (int r = 0; r < 16; ++r) ps += p0[r];
#pragma unroll
    for (int r = 0; r < 16; ++r) ps += p1[r];
    { auto rr = __builtin_amdgcn_permlane32_swap(__float_as_uint(ps), __float_as_uint(ps), false, false);
      ps = __uint_as_float(rr[0]) + __uint_as_float(rr[1]); }
    l_reg = l_reg * alpha + ps;
#define PK4(P, B_, OUT) do { unsigned a0 = cvtpk(P[B_+0], P[B_+1]), a1 = cvtpk(P[B_+2], P[B_+3]); \
        unsigned b0 = cvtpk(P[B_+4], P[B_+5]), b1 = cvtpk(P[B_+6], P[B_+7]); \
        auto r0 = __builtin_amdgcn_permlane32_swap(a0, b0, false, false); auto r1 = __builtin_amdgcn_permlane32_swap(a1, b1, false, false); \
        u32x4 w = {r0[0], r1[0], r0[1], r1[1]}; OUT = __builtin_bit_cast(bf16x8, w); } while (0)
    PK4(p0, 0, pa0); PK4(p0, 8, pa1); PK4(p1, 0, pa2); PK4(p1, 8, pa3);
#undef PK4
}
__device__ __forceinline__ void add_bias_lut(f32x16& p0, f32x16& p1, LAS const float* lut, int dq) {
    LAS const float* bp = lut + (RMAXL - dq);
#pragma unroll
    for (int r = 0; r < 16; ++r) { const int c = (r & 3) + 8 * (r >> 2); p0[r] += bp[c]; p1[r] += bp[c + 32]; if ((r & 3) == 3) asm volatile("" ::: "memory"); }
}
__device__ __forceinline__ void causal_mask(f32x16& p0, f32x16& p1, int dq) {
    const float NEG = -__builtin_inff();
#pragma unroll
    for (int r = 0; r < 16; ++r) { const int c = (r & 3) + 8 * (r >> 2); if (dq - c < 0) p0[r] = NEG; if (dq - c - 32 < 0) p1[r] = NEG; }
}
struct DmaOff { unsigned k[2], v[2]; };
__device__ __forceinline__ DmaOff dma_offsets(int wid, int lane) {
    DmaOff d;
#pragma unroll
    for (int i = 0; i < 2; ++i) { const int p = wid * 2 + i;
        { const int row = 4 * p + (lane >> 4), c = (lane & 15) ^ (row & 7); d.k[i] = (unsigned)(row * PITCH * 2 + c * 16); }
        { const int sub = 2 * p + (lane >> 5), kkhi = sub >> 2, cblk = sub & 3, kklo = (lane & 31) >> 2, kk = kkhi * 8 + kklo;
          const int k = (kk & ~0xC) | ((kk & 4) << 1) | ((kk & 8) >> 1), c = cblk * 32 + (lane & 3) * 8; d.v[i] = (unsigned)(k * PITCH * 2 + c * 2); } }
    return d;
}
__device__ __forceinline__ void dma_tile(LAS char* lds, int bf, const bf16* Kc, const bf16* Vc, int k0, const DmaOff& d, int wid) {
    const char* kt = (const char*)Kc + (size_t)k0 * (PITCH * 2); const char* vt = (const char*)Vc + (size_t)k0 * (PITCH * 2);
#pragma unroll
    for (int i = 0; i < 2; ++i) {
        __builtin_amdgcn_global_load_lds((const unsigned*)(kt + d.k[i]), (LAS unsigned*)(lds + L_K + bf * SHM_K + (wid * 2 + i) * 1024), 16, 0, 0);
        __builtin_amdgcn_global_load_lds((const unsigned*)(vt + d.v[i]), (LAS unsigned*)(lds + L_V + bf * SHM_V + (wid * 2 + i) * 1024), 16, 0, 0); }
}
__device__ __forceinline__ void build_lut(LAS char* lds, const float* relb, const int* blut, int h, int tid) {
    LAS float* lut = (LAS float*)(lds + L_LUT);
    for (int i = tid; i < LUTN; i += 512) { const int rel = RMAXL - i; lut[i] = rel >= 0 ? relb[blut[rel] * 8 + h] * 1.4426950408889634f : 0.f; }
}

__device__ __forceinline__ void diff_unit(LAS char* lds, int b, int h, int qb, const bf16* Q, const bf16* K, const bf16* V, bf16* O, const float* relb, const int* blut,
                                          float lam_full, const float* subg, int tid, int wid, int lane) {
    const int r32 = lane & 31, hi = lane >> 5, cm = wid >> 2, w4 = wid & 3;
    const size_t rowbase = (size_t)b * SEQ;
    const int q0 = qb * 128, qw0 = q0 + w4 * 32, qpos = qw0 + r32;
    const bf16* Kc = K + rowbase * PITCH + h * HD; const bf16* Vc = V + rowbase * PITCH + h * HD;
    const int NT = (q0 + 128) / 64;
    const DmaOff dmo = dma_offsets(wid, lane);
    const int vb0 = (int)(unsigned)(uintptr_t)(lds + L_V) + v_rd_base(lane);
    LAS float* ws = (LAS float*)(lds + L_WS) + wid * 64;
    LAS const float* lut = (LAS const float*)(lds + L_LUT);
    lcp K_lds = (lcp)(lds + L_K);
    const float b31 = relb[31 * 8 + h] * 1.4426950408889634f;
    build_lut(lds, relb, blut, h, tid);
    bf16x8 qr[4];
#pragma unroll
    for (int d0 = 0; d0 < 4; ++d0) qr[d0] = *(const bf16x8*)(Q + (rowbase + qpos) * PITCH + h * HD + cm * 64 + d0 * 16 + hi * 8);
    dma_tile(lds, 0, Kc, Vc, 0, dmo, wid);
    asm volatile("s_waitcnt vmcnt(0)" ::: "memory");
    __syncthreads();
    float m_reg = -1e30f, l_reg = 0.f; f32x16 o[4] = {};
#define DIFF_STEP(t, BF) do { const int k0_ = (t) * 64; \
        if ((t) + 1 < NT) dma_tile(lds, (BF) ^ 1, Kc, Vc, k0_ + 64, dmo, wid); \
        if (k0_ <= qw0 + 31) { f32x16 p0, p1; bf16x8 pa0, pa1, pa2, pa3; float alpha, sh = 0.f; \
            qkt<BF, 4>(p0, p1, K_lds, r32, hi, cm * 128, qr); \
            const int dq_ = qpos - k0_ - 4 * hi; \
            if (qw0 - (k0_ + 63) >= RFAR) sh = b31; else add_bias_lut(p0, p1, lut, dq_); \
            if (k0_ + 63 > qw0) causal_mask(p0, p1, dq_); \
            softmax_tile(p0, p1, sh, m_reg, l_reg, alpha, pa0, pa1, pa2, pa3); \
            if (__any(alpha < 1.f)) { if (hi == 0) ws[r32] = alpha; asm volatile("s_waitcnt lgkmcnt(0)" ::: "memory"); \
                _Pragma("unroll") for (int d_ = 0; d_ < 4; ++d_) _Pragma("unroll") for (int r = 0; r < 16; ++r) o[d_][r] *= ws[crow(r, hi)]; } \
            pv_tile<BF>(o, vb0, pa0, pa1, pa2, pa3); } \
        asm volatile("s_waitcnt vmcnt(0)" ::: "memory"); \
        __syncthreads(); } while (0)
    for (int t = 0; t < NT; t += 2) { DIFF_STEP(t, 0); DIFF_STEP(t + 1, 1); }
#undef DIFF_STEP
    if (hi == 0) ws[32 + r32] = l_reg; asm volatile("s_waitcnt lgkmcnt(0)" ::: "memory");
#pragma unroll
    for (int r = 0; r < 16; ++r) { const float rl = __builtin_amdgcn_rcpf(ws[32 + crow(r, hi)]);
#pragma unroll
        for (int d0 = 0; d0 < 4; ++d0) o[d0][r] *= rl; }
    LAS float* xch = (LAS float*)lds + (size_t)w4 * 64 * 64;
    if (cm == 1) {
#pragma unroll
        for (int d0 = 0; d0 < 4; ++d0)
#pragma unroll
            for (int r = 0; r < 16; ++r) xch[(d0 * 16 + r) * 64 + lane] = o[d0][r];
    }
    __syncthreads();
    if (cm == 0) {
        float ss[16];
#pragma unroll
        for (int r = 0; r < 16; ++r) { float a = 0.f;
#pragma unroll
            for (int d0 = 0; d0 < 4; ++d0) { o[d0][r] -= lam_full * xch[(d0 * 16 + r) * 64 + lane]; a += o[d0][r] * o[d0][r]; }
            ss[r] = a; }
#pragma unroll
        for (int r = 0; r < 16; ++r) {
#pragma unroll
            for (int sft = 1; sft < 32; sft <<= 1) ss[r] += __shfl_xor(ss[r], sft); }
        float gg[4];
#pragma unroll
        for (int d0 = 0; d0 < 4; ++d0) gg[d0] = subg[d0 * 32 + r32] * (1.0f - LAMBDA_INIT);
        bf16* Ow = O + (rowbase + qw0) * PITCH + h * HD;
#pragma unroll
        for (int r = 0; r < 16; ++r) { const int orow = crow(r, hi); const float rs = 1.0f / sqrtf(ss[r] * (1.0f / HD) + RMS_EPS);
#pragma unroll
            for (int d0 = 0; d0 < 4; ++d0) { const float v = o[d0][r] * rs * gg[d0]; const float vn = __shfl_xor(v, 1);
                if ((r32 & 1) == 0) *(unsigned*)(Ow + (size_t)orow * PITCH + d0 * 32 + r32) = cvtpk(v, vn); } }
    }
    __syncthreads();
}

__device__ __forceinline__ void moba_unit(LAS char* lds, int b, int h, int qb, const bf16* Q, const bf16* K, const bf16* V, bf16* O, const unsigned* sel, const float* relb, const int* blut,
                                          int tid, int wid, int lane) {
    const int r32 = lane & 31, hi = lane >> 5;
    const size_t rowbase = (size_t)b * SEQ;
    const int q0 = qb * 256, qw0 = q0 + wid * 32, qpos = qw0 + r32;
    const bf16* Kc = K + rowbase * PITCH + h * HD; const bf16* Vc = V + rowbase * PITCH + h * HD;
    const int NT = (q0 + 256) / 64;
    const DmaOff dmo = dma_offsets(wid, lane);
    const int vb0 = (int)(unsigned)(uintptr_t)(lds + L_V) + v_rd_base(lane);
    LAS float* ws = (LAS float*)(lds + L_WS) + wid * 64;
    LAS const float* lut = (LAS const float*)(lds + L_LUT);
    lcp K_lds = (lcp)(lds + L_K);
    const float b31 = relb[31 * 8 + h] * 1.4426950408889634f;
    const unsigned smask = sel[((size_t)(b * NH + h)) * SEQ + qpos] | (1u << qb);
    build_lut(lds, relb, blut, h, tid);
    bf16x8 qr[8];
#pragma unroll
    for (int d0 = 0; d0 < 8; ++d0) qr[d0] = *(const bf16x8*)(Q + (rowbase + qpos) * PITCH + h * HD + d0 * 16 + hi * 8);
    dma_tile(lds, 0, Kc, Vc, 0, dmo, wid);
    asm volatile("s_waitcnt vmcnt(0)" ::: "memory");
    __syncthreads();
    float m_reg = -1e30f, l_reg = 0.f; f32x16 o[4] = {};
#define MOBA_STEP(t, BF) do { const int k0_ = (t) * 64; \
        if ((t) + 1 < NT) dma_tile(lds, (BF) ^ 1, Kc, Vc, k0_ + 64, dmo, wid); \
        if (k0_ <= qw0 + 31) { f32x16 p0, p1; bf16x8 pa0, pa1, pa2, pa3; float alpha, sh = 0.f; \
            qkt<BF, 8>(p0, p1, K_lds, r32, hi, 0, qr); \
            const int dq_ = qpos - k0_ - 4 * hi; \
            if (qw0 - (k0_ + 63) >= RFAR) sh = b31; else add_bias_lut(p0, p1, lut, dq_); \
            if (k0_ + 63 > qw0) causal_mask(p0, p1, dq_); \
            if (!((smask >> (k0_ >> 8)) & 1u)) { const float NEG_ = -__builtin_inff(); _Pragma("unroll") for (int r = 0; r < 16; ++r) { p0[r] = NEG_; p1[r] = NEG_; } } \
            softmax_tile(p0, p1, sh, m_reg, l_reg, alpha, pa0, pa1, pa2, pa3); \
            if (__any(alpha < 1.f)) { if (hi == 0) ws[r32] = alpha; asm volatile("s_waitcnt lgkmcnt(0)" ::: "memory"); \
                _Pragma("unroll") for (int d_ = 0; d_ < 4; ++d_) _Pragma("unroll") for (int r = 0; r < 16; ++r) o[d_][r] *= ws[crow(r, hi)]; } \
            pv_tile<BF>(o, vb0, pa0, pa1, pa2, pa3); } \
        asm volatile("s_waitcnt vmcnt(0)" ::: "memory"); \
        __syncthreads(); } while (0)
    for (int t = 0; t < NT; t += 2) { MOBA_STEP(t, 0); MOBA_STEP(t + 1, 1); }
#undef MOBA_STEP
    if (hi == 0) ws[32 + r32] = l_reg; asm volatile("s_waitcnt lgkmcnt(0)" ::: "memory");
    bf16* Ow = O + (rowbase + qw0) * PITCH + h * HD;
#pragma unroll
    for (int r = 0; r < 16; ++r) { const int orow = crow(r, hi); const float rl = __builtin_amdgcn_rcpf(ws[32 + orow]);
#pragma unroll
        for (int d0 = 0; d0 < 4; ++d0) { const float v = o[d0][r] * rl; const float vn = __shfl_xor(v, 1);
            if ((r32 & 1) == 0) *(unsigned*)(Ow + (size_t)orow * PITCH + d0 * 32 + r32) = cvtpk(v, vn); } }
    __syncthreads();
}
#undef KSWZ
#undef SBAR
}


__device__ __forceinline__ void p_diff_attn_mfma(const Args& a, LAS unsigned char* lds, int vcu, int tid, int wave, int lane) {
    const bf16* Qb = (const bf16*)(a.ws + WS_Q); const bf16* Kb = (const bf16*)(a.ws + WS_K); const bf16* Vb = (const bf16*)(a.ws + WS_V);
    bf16* Ob = (bf16*)(a.ws + WS_O); const int* blut = (const int*)(a.ws + WS_BLUT);
    float lam_full;
    { const float* lm = a.diff_lambda; const float p01 = wave_sum(lm[lane] * lm[64 + lane]), p23 = wave_sum(lm[128 + lane] * lm[192 + lane]); lam_full = __expf(p01) - __expf(p23) + LAMBDA_INIT; }
    const int G = gridDim.x;
    for (int pr = 2 * vcu; pr < 512; pr += 2 * G) {
#pragma unroll 1
        for (int k = 0; k < 4; ++k) {
            const int pp = pr + (k >> 1); if (pp >= 512) break;
            const int bh = pp >> 5, p = pp & 31, qb = (k & 1) ? 63 - p : p;
            att::diff_unit((LAS char*)lds, bh >> 3, bh & 7, qb, Qb, Kb, Vb, Ob, a.rel_bias, blut, lam_full, a.diff_subln_g, tid, wave, lane);
        }
    }
}


__device__ __forceinline__ void p_moba_attn_mfma(const Args& a, LAS unsigned char* lds, int vcu, int tid, int wave, int lane) {
    const bf16* Qb = (const bf16*)(a.ws + WS_Q); const bf16* Kb = (const bf16*)(a.ws + WS_K); const bf16* Vb = (const bf16*)(a.ws + WS_V);
    bf16* Ob = (bf16*)(a.ws + WS_O); const int* blut = (const int*)(a.ws + WS_BLUT); const unsigned* sel = (const unsigned*)(a.ws + WS_SEL);
    const int G = gridDim.x;
    for (int pp = vcu; pp < 256; pp += G) {
#pragma unroll 1
        for (int k = 0; k < 2; ++k) {
            const int bh = pp >> 4, p = pp & 15, qb = k ? 31 - p : p;
            att::moba_unit((LAS char*)lds, bh >> 3, bh & 7, qb, Qb, Kb, Vb, Ob, sel, a.rel_bias, blut, tid, wave, lane);
        }
    }
}


struct TI { int tid, lane, wave, gtid, gw; };
__device__ __forceinline__ TI mk_ti() { int t = threadIdx.x; asm volatile("" : "+v"(t)); TI r; r.tid = t; r.lane = t & 63; r.wave = __builtin_amdgcn_readfirstlane(t >> 6);
    r.gtid = blockIdx.x * NTHR + t; r.gw = blockIdx.x * NWAVES + r.wave; return r; }

typedef const __attribute__((address_space(4))) Args* CArgs;
__device__ __forceinline__ Args load_args() {
#if defined(__HIP_DEVICE_COMPILE__)
    auto p = __builtin_amdgcn_kernarg_segment_ptr(); asm volatile("" : "+s"(p));
    typedef const __attribute__((address_space(4))) unsigned long long* cu64; cu64 q = (cu64)p;
    Args r; r.x = (const float*)q[0]; r.c = (const float*)q[1]; r.rel_bias = (const float*)q[2]; r.ada_w = (const float*)q[3]; r.ada_b = (const float*)q[4]; r.norm_g = (const float*)q[5];
    r.moba_w_qkv = (const float*)q[6]; r.moba_w_o = (const float*)q[7]; r.diff_w_qkv = (const float*)q[8]; r.diff_w_o = (const float*)q[9];
    r.diff_lambda = (const float*)q[10]; r.diff_subln_g = (const float*)q[11]; r.ffn_w_in = (const float*)q[12]; r.ffn_w_out = (const float*)q[13];
    r.out = (float*)q[14]; r.ws = (unsigned char*)q[15]; return r;
#else
    return Args{};
#endif
}
#define WSP(T, off) ((T*)(a.ws + (off)))
#define GEMM_PHASE(EPI, Aptr, Wptr, N_, K_, ...) do { const Args a = load_args(); const int G_ = gridDim.x; \
        pg8::Gemm g{Aptr, (const bf16*)(Wptr), M, N_, K_}; pg8::StaticOrder S; S.init(M, N_, G_, (int)blockIdx.x); \
        EPI E{__VA_ARGS__}; pg8::gemm_phase<EPI, pg8::StaticOrder, true, true>(lds, g, S, E); } while (0)
__global__ void __launch_bounds__(NTHR, 2) fwd(Args a_unused) {
    extern __shared__ __attribute__((aligned(16))) unsigned char lds_raw[];
    LAS unsigned char* lds = (LAS unsigned char*)lds_raw;
    volatile LAS unsigned* MISC = (volatile LAS unsigned*)(lds + MISC_OFF);
    for (int u = threadIdx.x; u < 64; u += NTHR) MISC[u] = 0u;
    __syncthreads();
    XcdBarrier bar;
    { const Args a = load_args(); bar = xcd_barrier_post(WSP(unsigned, WS_CTL) + CW_BAR, MISC + 8); }
#define VCU() ((gridDim.x % 8 == 0) ? (int)((blockIdx.x % 8) * (gridDim.x / 8) + blockIdx.x / 8) : (int)blockIdx.x)
#define NGW() ((int)gridDim.x * NWAVES)
#define NGT() ((int)gridDim.x * NTHR)
    constexpr float QS0 = 0.08838834764831845f * LOG2E, QS1 = 0.125f * LOG2E;
    constexpr size_t QKVS = (size_t)(WS_K - WS_Q) / 2;

    { const Args a = load_args(); const TI t = mk_ti(); p_weights(a, lds, t.gw, NGW(), t.wave, t.lane); p_mod(a, t.gtid, NGT()); }
    xcd_barrier(bar);
    { const Args a = load_args(); const TI t = mk_ti(); const float* md = WSP(const float, WS_MOD); p_norm_in(a.x, a.norm_g, md, md + 1024, WSP(bf16, WS_H), t.gw, NGW(), t.lane); }
    xcd_barrier(bar);
    GEMM_PHASE(pg8::EpiBf16<0>, WSP(bf16, WS_H), a.ws + WS_W + WO_QKV, 3 * D, D, WSP(bf16, WS_Q), D, nullptr, D, QKVS, QS0);
    xcd_barrier(bar);
    { const Args a = load_args(); const TI t = mk_ti(); p_kmean(WSP(bf16, WS_K), WSP(float, WS_KMEAN), t.gtid, NGT()); }
    xcd_barrier(bar);
    { const Args a = load_args(); const TI t = mk_ti(); p_gate(WSP(bf16, WS_Q), WSP(const float, WS_KMEAN), WSP(unsigned, WS_SEL), t.gtid, NGT()); }
    xcd_barrier(bar);
    { const Args a = load_args(); const TI t = mk_ti(); p_moba_attn_mfma(a, lds, VCU(), t.tid, t.wave, t.lane); }
    xcd_barrier(bar);
    GEMM_PHASE(pg8::EpiBf16<0>, WSP(bf16, WS_O), a.ws + WS_W + WO_O, D, D, WSP(bf16, WS_Y), D, nullptr, 0, 0, 1.f);
    xcd_barrier(bar);
    { const Args a = load_args(); const TI t = mk_ti(); const float* md = WSP(const float, WS_MOD); const float* ng = a.norm_g;
      p_post(a.x, WSP(bf16, WS_Y), ng + D, md + 2048, a.out, ng + 2 * D, md + 3072, md + 4096, WSP(bf16, WS_H), t.gw, NGW(), t.lane); }
    xcd_barrier(bar);
    GEMM_PHASE(pg8::EpiSwiglu, WSP(bf16, WS_H), a.ws + WS_W + WO_IN, 2 * DFF, D, WSP(bf16, WS_HH), DFF);
    xcd_barrier(bar);
    GEMM_PHASE(pg8::EpiBf16<0>, WSP(bf16, WS_HH), a.ws + WS_W + WO_OUT, D, DFF, WSP(bf16, WS_Y), D, nullptr, 0, 0, 1.f);
    xcd_barrier(bar);
    { const Args a = load_args(); const TI t = mk_ti(); const float* md = WSP(const float, WS_MOD); const float* ng = a.norm_g; const float* md1 = md + 2 * 6144; const float* ng1 = ng + 4 * D;
      p_post(a.out, WSP(bf16, WS_Y), ng + 3 * D, md + 5120, a.out, ng1, md1, md1 + 1024, WSP(bf16, WS_H), t.gw, NGW(), t.lane); }
    xcd_barrier(bar);
    GEMM_PHASE(pg8::EpiBf16<0>, WSP(bf16, WS_H), a.ws + WS_W + WL_STRIDE + WO_QKV, 3 * D, D, WSP(bf16, WS_Q), D, nullptr, D, QKVS, QS1);
    xcd_barrier(bar);
    { const Args a = load_args(); const TI t = mk_ti(); p_diff_attn_mfma(a, lds, VCU(), t.tid, t.wave, t.lane); }
    xcd_barrier(bar);
    GEMM_PHASE(pg8::EpiBf16<0>, WSP(bf16, WS_O), a.ws + WS_W + WL_STRIDE + WO_O, D, D, WSP(bf16, WS_Y), D, nullptr, 0, 0, 1.f);
    xcd_barrier(bar);
    { const Args a = load_args(); const TI t = mk_ti(); const float* md = WSP(const float, WS_MOD) + 2 * 6144; const float* ng = a.norm_g + 4 * D;
      p_post(a.out, WSP(bf16, WS_Y), ng + D, md + 2048, a.out, ng + 2 * D, md + 3072, md + 4096, WSP(bf16, WS_H), t.gw, NGW(), t.lane); }
    xcd_barrier(bar);
    GEMM_PHASE(pg8::EpiSwiglu, WSP(bf16, WS_H), a.ws + WS_W + WL_STRIDE + WO_IN, 2 * DFF, D, WSP(bf16, WS_HH), DFF);
    xcd_barrier(bar);
    GEMM_PHASE(pg8::EpiBf16<0>, WSP(bf16, WS_HH), a.ws + WS_W + WL_STRIDE + WO_OUT, D, DFF, WSP(bf16, WS_Y), D, nullptr, 0, 0, 1.f);
    xcd_barrier(bar);
    { const Args a = load_args(); const TI t = mk_ti(); const float* md = WSP(const float, WS_MOD) + 2 * 6144; const float* ng = a.norm_g + 4 * D;
      p_post(a.out, WSP(bf16, WS_Y), ng + 3 * D, md + 5120, a.out, nullptr, nullptr, nullptr, nullptr, t.gw, NGW(), t.lane); }
}

extern "C" void kernel_launch(void* const* d_in, const int* in_sizes, int n_in, void* d_out, int out_size, void* d_ws, size_t ws_size, hipStream_t stream) {
    static int grid = 0;
    if (grid == 0) {
        if (n_in != 14 || out_size != M * D || ws_size < WS_END) { fprintf(stderr, "kernel_launch: unexpected shapes n_in %d out %d ws %zu\n", n_in, out_size, ws_size); grid = -1; return; }
        int dev = 0, cus = 0;
        if (hipGetDevice(&dev) != hipSuccess || hipDeviceGetAttribute(&cus, hipDeviceAttributeMultiprocessorCount, dev) != hipSuccess) { grid = -1; return; }
        if (hipFuncSetAttribute((const void*)fwd, hipFuncAttributeMaxDynamicSharedMemorySize, LDS_BYTES) != hipSuccess) { fprintf(stderr, "hipFuncSetAttribute failed\n"); grid = -1; return; }
        grid = cus;
    }
    if (grid < 0) return;
    (void)hipMemsetAsync((char*)d_ws + WS_CTL, 0, CTL_ZERO_BYTES, stream);
    Args a{};
    a.x = (const float*)d_in[0]; a.c = (const float*)d_in[1]; a.rel_bias = (const float*)d_in[2]; a.ada_w = (const float*)d_in[3]; a.ada_b = (const float*)d_in[4];
    a.norm_g = (const float*)d_in[5]; a.moba_w_qkv = (const float*)d_in[6]; a.moba_w_o = (const float*)d_in[7]; a.diff_w_qkv = (const float*)d_in[8]; a.diff_w_o = (const float*)d_in[9];
    a.diff_lambda = (const float*)d_in[10]; a.diff_subln_g = (const float*)d_in[11]; a.ffn_w_in = (const float*)d_in[12]; a.ffn_w_out = (const float*)d_in[13];
    a.out = (float*)d_out; a.ws = (unsigned char*)d_ws;
    hipLaunchKernelGGL(fwd, dim3(grid), dim3(NTHR), LDS_BYTES, stream, a);
}
```

```cpp
#include <hip/hip_runtime.h>
#include <cstdio>
#include <cstdint>

#define GAS __attribute__((address_space(1)))
#define LAS __attribute__((address_space(3)))
typedef unsigned short bf16;
typedef float f32x4 __attribute__((ext_vector_type(4)));
typedef float f32x2 __attribute__((ext_vector_type(2)));
typedef unsigned u32x4 __attribute__((ext_vector_type(4)));
typedef unsigned u32x2 __attribute__((ext_vector_type(2)));

constexpr int BATCH = 2, SEQ = 8192, D = 1024, NH = 8, HD = 128, DFF = 2816, NBKT = 32;
constexpr int M = BATCH * SEQ;
constexpr int NWAVES = 8, NTHR = 512;
constexpr float RMS_EPS = 1e-6f;
constexpr float LOG2E = 1.4426950408889634f;
constexpr float LAMBDA_INIT = 0.35550906759096926f;

constexpr size_t MiB = 1u << 20;
constexpr size_t WS_CTL = 0, CTL_ZERO_BYTES = 1 * MiB;
constexpr size_t WS_MOD = 1 * MiB;
constexpr size_t WS_BLUT = WS_MOD + 128 * 1024;
constexpr size_t WS_KMEAN = WS_BLUT + 16 * 1024;
constexpr size_t WS_SEL = WS_KMEAN + 256 * 1024;
constexpr size_t WS_BIAST = WS_SEL + 512 * 1024;
constexpr size_t WS_LIST = 244 * MiB;
constexpr size_t WS_ML = 32 * MiB;
constexpr int CW_CNT = 8192;
constexpr size_t WS_W = 2 * MiB, WL_STRIDE = 25 * MiB;
constexpr size_t WO_QKV = 0, WO_O = 6 * MiB, WO_IN = 8 * MiB, WO_OUT = 19 * MiB;
constexpr size_t WS_H = 52 * MiB;
constexpr size_t WS_Q = 84 * MiB, WS_K = 116 * MiB, WS_V = 148 * MiB;
constexpr size_t WS_HH = 84 * MiB;
constexpr size_t WS_O = 180 * MiB;
constexpr size_t WS_Y = 212 * MiB;
constexpr size_t WS_END = 252 * MiB;
constexpr int CW_BAR = 4096;

constexpr int LDS_BYTES = 147456;
constexpr int MISC_OFF = 131072 + 320;

#define RLX_AGENT __ATOMIC_RELAXED, __HIP_MEMORY_SCOPE_AGENT
__device__ __forceinline__ unsigned f2bf(float f) { unsigned u = __builtin_bit_cast(unsigned, f); return (u + 0x7fffu + ((u >> 16) & 1u)) >> 16; }
__device__ __forceinline__ unsigned pk2(float lo, float hi) { return f2bf(lo) | (f2bf(hi) << 16); }
__device__ __forceinline__ float bf2f(unsigned short b) { return __builtin_bit_cast(float, (unsigned)b << 16); }
__device__ __forceinline__ float bflo(unsigned w) { return __builtin_bit_cast(float, w << 16); }
__device__ __forceinline__ float bfhi(unsigned w) { return __builtin_bit_cast(float, w & 0xffff0000u); }

#define XB_TMO      128
#define XB_XCNT(j)  (256  + 64 * (j))
#define XB_XSUB(j)  (1280 + 64 * (j))
#define XB_XGEN(j)  (2304 + 64 * (j))
#define XB_TOP      3328
#define XB_TOPGEN   3392
#define XCD_BAR_WORDS 3456
#define XB_SPIN_CAP (1u << 25)
__device__ __forceinline__ unsigned xb_ld(unsigned* p)              { return __hip_atomic_load(p, __ATOMIC_RELAXED, __HIP_MEMORY_SCOPE_AGENT); }
__device__ __forceinline__ unsigned xb_add(unsigned* p, unsigned v) { return __hip_atomic_fetch_add(p, v, __ATOMIC_RELAXED, __HIP_MEMORY_SCOPE_AGENT); }
__device__ __forceinline__ unsigned xb_xcc_id() { return (unsigned)__builtin_amdgcn_s_getreg((3 << 11) | 20) & 0xFu; }
#define XB_SPIN(cond, bar) do { unsigned _sp = 0; while (cond) { __builtin_amdgcn_s_sleep(1); \
    if ((++_sp & 255u) == 0u) { if (xb_ld(&(bar)[XB_TMO])) break; if (_sp > XB_SPIN_CAP) { atomicAdd(&(bar)[XB_TMO], 1u); break; } } } } while (0)
struct XcdBarrier { unsigned* bar; unsigned x; volatile LAS unsigned* st; };
__device__ __forceinline__ XcdBarrier xcd_barrier_post(unsigned* bar, volatile LAS unsigned* st) {
    XcdBarrier b; b.bar = bar; b.x = xb_xcc_id(); b.st = st;
    if (threadIdx.x == 0) (void)xb_add(&bar[XB_XCNT(b.x)], 1u);
    return b;
}
__device__ __forceinline__ void xcd_barrier_complete(unsigned* bar, unsigned x, unsigned& nloc, unsigned& nx) {
    const unsigned G = gridDim.x * gridDim.y * gridDim.z;
    unsigned sum, cnt, mine, sp = 0u;
    for (;;) {
        sum = 0u; cnt = 0u; mine = 0u;
#pragma unroll
        for (unsigned j = 0; j < 16; ++j) { const unsigned c = xb_ld(&bar[XB_XCNT(j)]); sum += c; cnt += (c > 0u) ? 1u : 0u; mine = (j == x) ? c : mine; }
        if (sum == G) break;
        __builtin_amdgcn_s_sleep(1);
        if ((++sp & 255u) == 0u) { if (xb_ld(&bar[XB_TMO])) break; if (sp > XB_SPIN_CAP) { atomicAdd(&bar[XB_TMO], 1u); break; } }
    }
    nloc = mine > 0u ? mine : 1u; nx = cnt > 0u ? cnt : 1u;
}
__device__ __forceinline__ void xcd_barrier(const XcdBarrier& b) {
    asm volatile("s_waitcnt vmcnt(0)" ::: "memory");
    __syncthreads();
    if (threadIdx.x == 0) {
        unsigned* bar = b.bar;
        __builtin_amdgcn_s_waitcnt(0);
        unsigned nloc = b.st[0], nx = b.st[1];
        if (nloc == 0u) { xcd_barrier_complete(bar, b.x, nloc, nx); b.st[0] = nloc; b.st[1] = nx; }
        const unsigned old = xb_add(&bar[XB_XSUB(b.x)], 1u);
        const unsigned gen = old / nloc;
        if (old + 1u == (gen + 1u) * nloc) {
            __builtin_amdgcn_fence(__ATOMIC_RELEASE, "agent");
            asm volatile("s_waitcnt vmcnt(0)" ::: "memory");
            const unsigned og = xb_add(&bar[XB_TOP], 1u);
            const unsigned tg = og / nx;
            if (og + 1u == (tg + 1u) * nx) xb_add(&bar[XB_TOPGEN], 1u);
            else XB_SPIN(xb_ld(&bar[XB_TOPGEN]) == tg, bar);
            __builtin_amdgcn_fence(__ATOMIC_ACQUIRE, "agent");
            xb_add(&bar[XB_XGEN(b.x)], 1u);
            asm volatile("s_waitcnt vmcnt(0)" ::: "memory");
        } else {
            XB_SPIN(xb_ld(&bar[XB_XGEN(b.x)]) == gen, bar);
            __builtin_amdgcn_fence(__ATOMIC_ACQUIRE, "agent");
            asm volatile("s_waitcnt vmcnt(0)" ::: "memory");
        }
    }
    __syncthreads();
}

namespace pg8 {
#define PG8_LAS __attribute__((address_space(3)))
typedef unsigned short bf16_t;
typedef short bf16x8 __attribute__((ext_vector_type(8)));
typedef float f32x4 __attribute__((ext_vector_type(4)));
typedef unsigned u32x4 __attribute__((ext_vector_type(4)));
constexpr int BM = 256, BK = 64, HALF = 128, HTB = HALF * BK * 2  , STAGE_BYTES = 8 * HTB, NXCD = 8, WGM = 8;

__host__ __device__ __forceinline__ int lds_byte(int r, int c) { const int st = (r >> 4) * 2 + (c >> 5), rr = r & 15, cc = c & 31, ob = rr * 64 + cc * 2; return st * 1024 + (ob ^ (((ob >> 9) & 1) << 5)); }
__host__ __device__ __forceinline__ void stage_rc(int b, int& R, int& C) { const int st = b / 1024, sb = b % 1024, swz = sb ^ (((sb >> 9) & 1) << 5); R = (st >> 1) * 16 + swz / 64; C = (st & 1) * 32 + (swz % 64) / 2; }
__host__ __device__ __forceinline__ int perm32(int rho) { const int n = rho >> 4, i = rho & 15; return 8 * (i >> 2) + 4 * n + (i & 3); }

struct Unit { int pm, pn; };
struct Gemm { const bf16_t* A; const bf16_t* Bt; int M, N, K; };

struct StaticOrder {
    int nM, nN, nwg, G, c;
    __host__ __device__ void init(int M, int N, int G_, int c_) { nM = M / BM; nN = N / BM; nwg = nM * nN; G = G_; c = c_; }
    __host__ __device__ bool next(int i, Unit& u) const {
        const long L = (long)i * G + c; if (L >= nwg) return false;
        int wgid = (int)L; { const int q = nwg / NXCD, r = nwg % NXCD, xcd = wgid % NXCD, off = wgid / NXCD; wgid = (xcd < r ? xcd * (q + 1) : r * (q + 1) + (xcd - r) * q) + off; }
        const int nig = WGM * nN, gid = wgid / nig, fm = gid * WGM, gsz = (nM - fm) < WGM ? (nM - fm) : WGM;
        u.pm = fm + ((wgid % nig) % gsz); u.pn = (wgid % nig) / gsz; return true;
    }
    __device__ __forceinline__ void a_ready(const Unit&) const {}
    __device__ __forceinline__ void done(const Unit&) const {}
};

__device__ __forceinline__ unsigned cvt_pk_bf16(float lo, float hi) { unsigned r; asm volatile("v_cvt_pk_bf16_f32 %0, %1, %2" : "=v"(r) : "v"(lo), "v"(hi)); return r; }
typedef float f32x2 __attribute__((ext_vector_type(2)));
__device__ __forceinline__ f32x2 gelu_pk(f32x2 v) {
    const f32x2 av = __builtin_elementwise_abs(v), d = av * 0.2316418882f + 1.0f;
    f32x2 t; t.x = __builtin_amdgcn_rcpf(d.x); t.y = __builtin_amdgcn_rcpf(d.y);
    f32x2 q = t * 0.5307027145f + (-0.7265760135f); q = q * t + 0.7107068705f; q = q * t + (-0.142248368f); q = q * t + 0.127414796f; q = q * t;
    const f32x2 s = (v * v) * (-0.72134752044f);
    f32x2 e; e.x = __builtin_amdgcn_exp2f(s.x); e.y = __builtin_amdgcn_exp2f(s.y);
    const f32x2 m = v * (q * e), r = v - m;
    f32x2 o; o.x = v.x < 0.f ? m.x : r.x; o.y = v.y < 0.f ? m.y : r.y; return o;
}

template <int ACT  > struct EpiBf16 {
    static constexpr bool PERM = true, AFTER_DRAIN = false; static_assert(ACT == 0 || ACT == 1, "EpiBf16: ACT is 0 (none) or 1 (gelu_pk)");
    bf16_t* O; int ldc; const float* bias; int split_cols; size_t split_stride; float scale0;
    __device__ __forceinline__ void operator()(const f32x4 (&acc)[2][2][4][2], const Unit& u, int wr, int wc, int fr, int fq) const {
        const int row0 = u.pm * BM + wr * 64 + fr; int colt = u.pn * BM; bf16_t* base = O;
        float sc = 1.f; if (split_cols) { const int t = colt / split_cols; base += (size_t)t * split_stride; colt -= t * split_cols; if (t == 0) sc = scale0; }
        const int col0 = colt + wc * 32 + 8 * fq, bcol0 = u.pn * BM + wc * 32 + 8 * fq;
        f32x4 bv[2][2];
#pragma unroll
        for (int bj = 0; bj < 2; ++bj)
#pragma unroll
            for (int n = 0; n < 2; ++n) bv[bj][n] = bias ? *(const f32x4*)(bias + bcol0 + bj * HALF + 4 * n) : (f32x4){0.f, 0.f, 0.f, 0.f};
#pragma unroll
        for (int ai = 0; ai < 2; ++ai)
#pragma unroll
            for (int m = 0; m < 4; ++m) { bf16_t* rowp = base + (size_t)(row0 + ai * HALF + m * 16) * ldc + col0;
#pragma unroll
                for (int bj = 0; bj < 2; ++bj) { f32x4 v0 = acc[ai][bj][m][0] + bv[bj][0], v1 = acc[ai][bj][m][1] + bv[bj][1];
                    if (ACT == 1) { f32x2 a = gelu_pk((f32x2){v0[0], v0[1]}), b = gelu_pk((f32x2){v0[2], v0[3]}), c = gelu_pk((f32x2){v1[0], v1[1]}), d = gelu_pk((f32x2){v1[2], v1[3]});
                        v0 = (f32x4){a.x, a.y, b.x, b.y}; v1 = (f32x4){c.x, c.y, d.x, d.y}; }
                    v0 = v0 * sc; v1 = v1 * sc; u32x4 w; w.x = cvt_pk_bf16(v0[0], v0[1]); w.y = cvt_pk_bf16(v0[2], v0[3]); w.z = cvt_pk_bf16(v1[0], v1[1]); w.w = cvt_pk_bf16(v1[2], v1[3]);
                    *(u32x4*)(rowp + bj * HALF) = w; } }
    }
};

struct EpiSwiglu {
    static constexpr bool PERM = true, AFTER_DRAIN = false;
    bf16_t* O; int ldc;
    __device__ __forceinline__ void operator()(const f32x4 (&acc)[2][2][4][2], const Unit& u, int wr, int wc, int fr, int fq) const {
        const int row0 = u.pm * BM + wr * 64 + fr, col0 = u.pn * HALF + wc * 32 + 8 * fq;
#pragma unroll
        for (int ai = 0; ai < 2; ++ai)
#pragma unroll
            for (int m = 0; m < 4; ++m) { bf16_t* rowp = O + (size_t)(row0 + ai * HALF + m * 16) * ldc + col0;
                float v[8];
#pragma unroll
                for (int n = 0; n < 2; ++n)
#pragma unroll
                    for (int e = 0; e < 4; ++e) { const float g = acc[ai][0][m][n][e], uu = acc[ai][1][m][n][e];
                        v[n * 4 + e] = g * __builtin_amdgcn_rcpf(1.0f + __builtin_amdgcn_exp2f(-1.4426950408889634f * g)) * uu; }
                u32x4 w; w.x = cvt_pk_bf16(v[0], v[1]); w.y = cvt_pk_bf16(v[2], v[3]); w.z = cvt_pk_bf16(v[4], v[5]); w.w = cvt_pk_bf16(v[6], v[7]);
                *(u32x4*)rowp = w; }
    }
};
template <class Epi, class Sched, bool ALIGN_EPI = false, bool SP2 = false>
__device__ __forceinline__ void gemm_phase(PG8_LAS unsigned char* lds, const Gemm g, const Sched& S, const Epi& E) {
    int tid_ = threadIdx.x; asm volatile("" : "+v"(tid_));
    const int tid = tid_, wid = __builtin_amdgcn_readfirstlane(tid >> 6), lane = tid & 63, wr = wid >> 2, wc = wid & 3, fr = lane & 15, fq = lane >> 4;
    const int K = g.K, nt = K / BK;
    unsigned voffA[2], voffB[2];
#pragma unroll
    for (int i = 0; i < 2; ++i) { int R, C; stage_rc(tid * 16 + i * 8192, R, C); const int Rb = Epi::PERM ? ((R & ~31) + perm32(R & 31)) : R;
        voffA[i] = (unsigned)(R * K + C) * 2u; voffB[i] = (unsigned)(Rb * K + C) * 2u; }
    const size_t kstep = (size_t)(BK * 2);
    const size_t hstep = (size_t)HALF * K * 2;
    const size_t tstep = 2 * hstep;
    const unsigned ldsw = (unsigned)wid * 1024u;
    const int aoff = lds_byte(wr * 64 + fr, fq * 8), boff = lds_byte(wc * 32 + fr, fq * 8);
#define PG8_SA(b, h) (((b) * 2 + (h)) * HTB)
#define PG8_SB(b, h) ((4 + (b) * 2 + (h)) * HTB)
#define PG8_STAGE(bufoff, gbase, voff) do { _Pragma("unroll") for (int _i = 0; _i < 2; ++_i) \
        __builtin_amdgcn_global_load_lds((const unsigned*)((const char*)(gbase) + (voff)[_i]), (PG8_LAS unsigned*)(lds + (bufoff) + ldsw + _i * 8192), 16, 0, 0); } while (0)
#define PG8_LDA(dst, b, h) do { _Pragma("unroll") for (int m = 0; m < 4; ++m) _Pragma("unroll") for (int k = 0; k < 2; ++k) dst[m][k] = *(const PG8_LAS bf16x8*)(lds + PG8_SA(b, h) + aoff + m * 2048 + k * 1024); } while (0)
#define PG8_LDB(dst, b, h) do { _Pragma("unroll") for (int n = 0; n < 2; ++n) _Pragma("unroll") for (int k = 0; k < 2; ++k) dst[n][k] = *(const PG8_LAS bf16x8*)(lds + PG8_SB(b, h) + boff + n * 2048 + k * 1024); } while (0)
#define PG8_MMA(ai, bj, At, Bt) do { __builtin_amdgcn_s_setprio(1); _Pragma("unroll") for (int m = 0; m < 4; ++m) _Pragma("unroll") for (int n = 0; n < 2; ++n) _Pragma("unroll") for (int k = 0; k < 2; ++k) \
        acc[ai][bj][m][n] = __builtin_amdgcn_mfma_f32_16x16x32_bf16(Bt[n][k], At[m][k], acc[ai][bj][m][n], 0, 0, 0); __builtin_amdgcn_s_setprio(0); } while (0)
#define PG8_WAIT_V(n) asm volatile("s_waitcnt vmcnt(" #n ")" ::: "memory")
#define PG8_WAIT_L(n) asm volatile("s_waitcnt lgkmcnt(" #n ")" ::: "memory")
#define PG8_BAR __builtin_amdgcn_s_barrier()
#define PG8_SCHED __builtin_amdgcn_sched_barrier(0)
    Unit cur, nxt; int ui = 0;
    if (!S.next(0, cur)) return;
    f32x4 acc[2][2][4][2];
#pragma unroll
    for (int a = 0; a < 2; ++a)
#pragma unroll
        for (int b = 0; b < 2; ++b)
#pragma unroll
            for (int m = 0; m < 4; ++m)
#pragma unroll
                for (int n = 0; n < 2; ++n) acc[a][b][m][n] = (f32x4){0.f, 0.f, 0.f, 0.f};
    bf16x8 At[4][2], B0[2][2], B1[2][2];
    const char* cA = (const char*)g.A + (size_t)cur.pm * tstep; const char* cB = (const char*)g.Bt + (size_t)cur.pn * tstep;
    S.a_ready(cur);
    if constexpr (SP2) {
        PG8_STAGE(PG8_SB(0, 0), cB, voffB); PG8_STAGE(PG8_SB(0, 1), cB + hstep, voffB); PG8_STAGE(PG8_SA(0, 0), cA, voffA); PG8_STAGE(PG8_SA(0, 1), cA + hstep, voffA);
        if (wr == 1) PG8_BAR;
        PG8_WAIT_V(2); PG8_BAR;
        PG8_STAGE(PG8_SB(1, 0), cB + kstep, voffB); PG8_STAGE(PG8_SA(1, 0), cA + kstep, voffA); PG8_STAGE(PG8_SB(1, 1), cB + hstep + kstep, voffB);
        PG8_WAIT_V(6); PG8_BAR;
    } else {
        PG8_STAGE(PG8_SB(0, 0), cB, voffB); PG8_STAGE(PG8_SA(0, 0), cA, voffA); PG8_STAGE(PG8_SB(0, 1), cB + hstep, voffB); PG8_STAGE(PG8_SA(0, 1), cA + hstep, voffA);
        if (wr == 1) PG8_BAR;
        PG8_WAIT_V(4); PG8_BAR;
        PG8_STAGE(PG8_SB(1, 0), cB + kstep, voffB); PG8_STAGE(PG8_SA(1, 0), cA + kstep, voffA); PG8_STAGE(PG8_SB(1, 1), cB + hstep + kstep, voffB);
        PG8_WAIT_V(6); PG8_BAR;
    }
    for (;;) {
        const bool has_next = S.next(ui + 1, nxt);
        const char* nA = has_next ? (const char*)g.A + (size_t)nxt.pm * tstep : cA; const char* nB = has_next ? (const char*)g.Bt + (size_t)nxt.pn * tstep : cB;
        for (int t = 0; t < nt; t += 2) {
            const bool last = (t == nt - 2);
            const char* a1 = cA + (size_t)(t + 1) * kstep;
            const char* a2 = last ? nA : cA + (size_t)(t + 2) * kstep; const char* b2 = last ? nB : cB + (size_t)(t + 2) * kstep;
            const char* a3 = a2 + kstep; const char* b3 = b2 + kstep;
            if (last && has_next) S.a_ready(nxt);
            if constexpr (SP2) {
            PG8_LDB(B0, 0, 0); PG8_LDB(B1, 0, 1); PG8_SCHED; PG8_LDA(At, 0, 0); PG8_STAGE(PG8_SA(1, 1), a1 + hstep, voffA);
            PG8_WAIT_V(8); PG8_WAIT_L(0); PG8_BAR; PG8_MMA(0, 0, At, B0); PG8_MMA(0, 1, At, B1); PG8_BAR; PG8_SCHED;
            PG8_LDA(At, 0, 1); PG8_STAGE(PG8_SB(0, 0), b2, voffB); PG8_STAGE(PG8_SB(0, 1), b2 + hstep, voffB); PG8_STAGE(PG8_SA(0, 0), a2, voffA);
            PG8_WAIT_V(8); PG8_WAIT_L(0); PG8_BAR; PG8_MMA(1, 0, At, B0); PG8_MMA(1, 1, At, B1); PG8_BAR; PG8_SCHED;
            PG8_LDB(B0, 1, 0); PG8_LDB(B1, 1, 1); PG8_SCHED; PG8_LDA(At, 1, 0); PG8_STAGE(PG8_SA(0, 1), a2 + hstep, voffA);
            PG8_WAIT_V(8); PG8_WAIT_L(0); PG8_BAR; PG8_MMA(0, 0, At, B0); PG8_MMA(0, 1, At, B1); PG8_BAR; PG8_SCHED;
            PG8_LDA(At, 1, 1); PG8_STAGE(PG8_SB(1, 0), b3, voffB); PG8_STAGE(PG8_SB(1, 1), b3 + hstep, voffB); PG8_STAGE(PG8_SA(1, 0), a3, voffA);
            PG8_WAIT_V(8); PG8_WAIT_L(0); PG8_BAR; PG8_MMA(1, 0, At, B0); PG8_MMA(1, 1, At, B1); PG8_BAR; PG8_SCHED;
            } else {
            PG8_LDB(B0, 0, 0); PG8_SCHED; PG8_LDA(At, 0, 0); PG8_STAGE(PG8_SA(1, 1), a1 + hstep, voffA);
            PG8_WAIT_L(8); PG8_BAR; PG8_WAIT_L(0); PG8_MMA(0, 0, At, B0); PG8_BAR; PG8_SCHED;
            PG8_LDB(B1, 0, 1); PG8_STAGE(PG8_SB(0, 0), b2, voffB);
            PG8_BAR; PG8_WAIT_L(0); PG8_MMA(0, 1, At, B1); PG8_BAR;
            PG8_LDA(At, 0, 1); PG8_STAGE(PG8_SA(0, 0), a2, voffA);
            PG8_BAR; PG8_WAIT_L(0); PG8_MMA(1, 0, At, B0); PG8_BAR; PG8_SCHED;
            PG8_STAGE(PG8_SB(0, 1), b2 + hstep, voffB);
            PG8_WAIT_V(6); PG8_BAR; PG8_MMA(1, 1, At, B1); PG8_BAR;
            PG8_LDB(B0, 1, 0); PG8_SCHED; PG8_LDA(At, 1, 0); PG8_STAGE(PG8_SA(0, 1), a2 + hstep, voffA);
            PG8_WAIT_L(8); PG8_BAR; PG8_WAIT_L(0); PG8_MMA(0, 0, At, B0); PG8_BAR; PG8_SCHED;
            PG8_LDB(B1, 1, 1); PG8_STAGE(PG8_SB(1, 0), b3, voffB);
            PG8_BAR; PG8_WAIT_L(0); PG8_MMA(0, 1, At, B1); PG8_BAR;
            PG8_LDA(At, 1, 1); PG8_STAGE(PG8_SA(1, 0), a3, voffA);
            PG8_BAR; PG8_WAIT_L(0); PG8_MMA(1, 0, At, B0); PG8_BAR; PG8_SCHED;
            PG8_STAGE(PG8_SB(1, 1), b3 + hstep, voffB);
            PG8_WAIT_V(6); PG8_BAR; PG8_MMA(1, 1, At, B1); PG8_BAR;
            }
        }
        if constexpr (ALIGN_EPI) { if (wr == 0) PG8_BAR; }
        if constexpr (!Epi::AFTER_DRAIN) { E(acc, cur, wr, wc, fr, fq); S.done(cur); }
        if (!has_next) break;
#pragma unroll
        for (int a = 0; a < 2; ++a)
#pragma unroll
            for (int b = 0; b < 2; ++b)
#pragma unroll
                for (int m = 0; m < 4; ++m)
#pragma unroll
                    for (int n = 0; n < 2; ++n) acc[a][b][m][n] = (f32x4){0.f, 0.f, 0.f, 0.f};
        cur = nxt; cA = nA; cB = nB; ++ui;
        if constexpr (ALIGN_EPI) { if (wr == 1) PG8_BAR; }
    }
    PG8_WAIT_V(0);
    if constexpr (!ALIGN_EPI) { if (wr == 0) PG8_BAR; }
    PG8_BAR;
    if constexpr (Epi::AFTER_DRAIN) { E.fused(acc, cur, wr, wc, fr, fq, lds, wid, lane); S.done(cur); }
#undef PG8_SA
#undef PG8_SB
#undef PG8_STAGE
#undef PG8_LDA
#undef PG8_LDB
#undef PG8_MMA
#undef PG8_WAIT_V
#undef PG8_WAIT_L
#undef PG8_BAR
#undef PG8_SCHED
}
}

__device__ __forceinline__ float wave_sum(float v) {
#pragma unroll
    for (int o = 1; o < 64; o <<= 1) v += __shfl_xor(v, o);
    return v;
}
__device__ __forceinline__ float wave_max(float v) {
#pragma unroll
    for (int o = 1; o < 64; o <<= 1) v = fmaxf(v, __shfl_xor(v, o));
    return v;
}
__device__ __forceinline__ float silu_f(float v) { return v / (1.f + __expf(-v)); }

struct Args {
    const float* x; const float* c; const float* rel_bias; const float* ada_w; const float* ada_b; const float* norm_g;
    const float* moba_w_qkv; const float* moba_w_o; const float* diff_w_qkv; const float* diff_w_o;
    const float* diff_lambda; const float* diff_subln_g; const float* ffn_w_in; const float* ffn_w_out;
    float* out; unsigned char* ws;
};

__device__ __forceinline__ int t5_bucket(int rel) {
    const int n = rel < 0 ? 0 : rel;
    const float nf = (float)(n < 1 ? 1 : n);
    int large = 16 + (int)(logf(nf / 16.0f) / 4.852030263919617f * 16.0f);
    large = large < 31 ? large : 31;
    return n < 16 ? n : large;
}

__device__ __forceinline__ void p_mod(const Args& a, LAS unsigned char* lds, int blk, int G, int tid, int wave, int lane) {
    LAS float* sc = (LAS float*)lds;
    LAS float* red = sc + 2048;
    for (int i = tid; i < 2048; i += NTHR) sc[i] = silu_f(a.c[i]);
    __syncthreads();
    float* mod = (float*)(a.ws + WS_MOD);
    for (int it = blk; it < 192; it += G) {
        const int l = it / 96, j0 = (it % 96) * 64;
        const float* w = a.ada_w + (size_t)l * D * 6144 + j0 + lane;
        float s0 = 0.f, s1 = 0.f;
#pragma unroll 8
        for (int k = wave * 128; k < wave * 128 + 128; ++k) { const float wv = w[(size_t)k * 6144]; s0 += sc[k] * wv; s1 += sc[1024 + k] * wv; }
        red[(wave * 2 + 0) * 64 + lane] = s0; red[(wave * 2 + 1) * 64 + lane] = s1;
        __syncthreads();
        if (tid < 128) { const int bb = tid >> 6, cl = tid & 63; float sum = 0.f;
#pragma unroll
            for (int w8 = 0; w8 < 8; ++w8) sum += red[(w8 * 2 + bb) * 64 + cl];
            mod[(l * 2 + bb) * 6144 + j0 + cl] = sum + a.ada_b[l * 6144 + j0 + cl]; }
        __syncthreads();
    }
    float* bt = (float*)(a.ws + WS_BIAST);
    for (int i = blk * NTHR + tid; i < 8 * 2304; i += G * NTHR) { const int h = i / 2304, rel = 2047 - (i % 2304); bt[i] = rel >= 0 ? a.rel_bias[t5_bucket(rel) * NH + h] * LOG2E : 0.f; }
}

__device__ __forceinline__ void transpose_item(const float* W, int K, int N, int k0, int n0, bf16* WT, int dst_row0, LAS float* scr, int lane) {
#pragma unroll 8
    for (int i = 0; i < 32; ++i) { const int kk = 2 * i + (lane >> 5); scr[kk * 33 + (lane & 31)] = W[(size_t)(k0 + kk) * N + n0 + (lane & 31)]; }
    asm volatile("s_waitcnt lgkmcnt(0)" ::: "memory");
    const int c = lane & 7;
#pragma unroll
    for (int j = 0; j < 4; ++j) { const int n = (lane >> 3) + 8 * j; const LAS float* sp = scr + (8 * c) * 33 + n;
        u32x4 o; o.x = pk2(sp[0 * 33], sp[1 * 33]); o.y = pk2(sp[2 * 33], sp[3 * 33]); o.z = pk2(sp[4 * 33], sp[5 * 33]); o.w = pk2(sp[6 * 33], sp[7 * 33]);
        *(u32x4*)(WT + (size_t)(dst_row0 + n) * K + k0 + 8 * c) = o; }
    asm volatile("s_waitcnt lgkmcnt(0)" ::: "memory");
}
__device__ __forceinline__ void p_weights(const Args& a, LAS unsigned char* lds, int gw, int ngw, int wave, int lane) {
    LAS float* scr = (LAS float*)(lds + wave * 16384);
    constexpr int I_QKV = (D / 64) * (3 * D / 32), I_O = (D / 64) * (D / 32), I_IN = (D / 64) * (2 * DFF / 32), I_OUT = (DFF / 64) * (D / 32);
    constexpr int PER_L = I_QKV + I_O + I_IN + I_OUT;
    for (int it = gw; it < 2 * PER_L; it += ngw) {
        const int l = it / PER_L; int r = it % PER_L;
        unsigned char* wl = a.ws + WS_W + (size_t)l * WL_STRIDE;
        if (r < I_QKV) { const int nb = 3 * D / 32, kb = r / nb, n0 = (r % nb) * 32; transpose_item(l == 0 ? a.moba_w_qkv : a.diff_w_qkv, D, 3 * D, kb * 64, n0, (bf16*)(wl + WO_QKV), n0, scr, lane); continue; } r -= I_QKV;
        if (r < I_O) { const int nb = D / 32, kb = r / nb, n0 = (r % nb) * 32; transpose_item(l == 0 ? a.moba_w_o : a.diff_w_o, D, D, kb * 64, n0, (bf16*)(wl + WO_O), n0, scr, lane); continue; } r -= I_O;
        if (r < I_IN) { const int nb = 2 * DFF / 32, kb = r / nb, n0 = (r % nb) * 32;
            const int isu = n0 >= DFF ? 1 : 0, nn = n0 - isu * DFF, dst = 256 * (nn / 128) + 128 * isu + (nn % 128);
            transpose_item(a.ffn_w_in + (size_t)l * D * 2 * DFF, D, 2 * DFF, kb * 64, n0, (bf16*)(wl + WO_IN), dst, scr, lane); continue; } r -= I_IN;
        { const int nb = D / 32, kb = r / nb, n0 = (r % nb) * 32; transpose_item(a.ffn_w_out + (size_t)l * DFF * D, DFF, D, kb * 64, n0, (bf16*)(wl + WO_OUT), n0, scr, lane); }
    }
}

__device__ __forceinline__ void p_norm_in(const float* X, const float* g, const float* sh, const float* sc, bf16* H, int gw, int ngw, int lane) {
    for (int m = gw; m < M; m += ngw) {
        const int b = m / SEQ;
        const f32x4* xr = (const f32x4*)(X + (size_t)m * D) + lane;
        f32x4 v[4]; float s = 0.f;
#pragma unroll
        for (int j = 0; j < 4; ++j) { v[j] = xr[64 * j]; s += (v[j].x * v[j].x + v[j].y * v[j].y) + (v[j].z * v[j].z + v[j].w * v[j].w); }
        const float r = 1.0f / sqrtf(wave_sum(s) * (1.f / D) + RMS_EPS);
        u32x2* o = (u32x2*)(H + (size_t)m * D) + lane;
#pragma unroll
        for (int j = 0; j < 4; ++j) {
            const f32x4 gg = ((const f32x4*)g)[lane + 64 * j], s1 = ((const f32x4*)(sc + b * 6144))[lane + 64 * j], s0 = ((const f32x4*)(sh + b * 6144))[lane + 64 * j];
            const f32x4 h = v[j] * r * gg * (1.0f + s1) + s0;
            u32x2 w; w.x = pk2(h.x, h.y); w.y = pk2(h.z, h.w); o[64 * j] = w;
        }
    }
}
__device__ __forceinline__ void p_post(const float* Xin, const bf16* Y, const float* g1, const float* gate, float* Xout,
                                       const float* g2, const float* sh, const float* sc, bf16* H, int gw, int ngw, int lane) {
    for (int m = gw; m < M; m += ngw) {
        const int b = m / SEQ;
        const u32x2* yr = (const u32x2*)(Y + (size_t)m * D) + lane;
        const f32x4* xr = (const f32x4*)(Xin + (size_t)m * D) + lane;
        f32x4 y[4], xv[4]; float s = 0.f;
#pragma unroll
        for (int j = 0; j < 4; ++j) { const u32x2 w = yr[64 * j]; y[j] = (f32x4){bflo(w.x), bfhi(w.x), bflo(w.y), bfhi(w.y)}; xv[j] = xr[64 * j];
            s += (y[j].x * y[j].x + y[j].y * y[j].y) + (y[j].z * y[j].z + y[j].w * y[j].w); }
        const float r = 1.0f / sqrtf(wave_sum(s) * (1.f / D) + RMS_EPS);
        float s2 = 0.f;
#pragma unroll
        for (int j = 0; j < 4; ++j) {
            const f32x4 gg = ((const f32x4*)g1)[lane + 64 * j], gt = ((const f32x4*)(gate + b * 6144))[lane + 64 * j];
            xv[j] = xv[j] + gt * (y[j] * r * gg);
            s2 += (xv[j].x * xv[j].x + xv[j].y * xv[j].y) + (xv[j].z * xv[j].z + xv[j].w * xv[j].w);
            ((f32x4*)(Xout + (size_t)m * D))[lane + 64 * j] = xv[j];
        }
        if (H) {
            const float r2 = 1.0f / sqrtf(wave_sum(s2) * (1.f / D) + RMS_EPS);
            u32x2* o = (u32x2*)(H + (size_t)m * D) + lane;
#pragma unroll
            for (int j = 0; j < 4; ++j) {
                const f32x4 gg = ((const f32x4*)g2)[lane + 64 * j], s1 = ((const f32x4*)(sc + b * 6144))[lane + 64 * j], s0 = ((const f32x4*)(sh + b * 6144))[lane + 64 * j];
                const f32x4 h = xv[j] * r2 * gg * (1.0f + s1) + s0;
                u32x2 w; w.x = pk2(h.x, h.y); w.y = pk2(h.z, h.w); o[64 * j] = w;
            }
        }
    }
}

__device__ __forceinline__ void p_kmean(const bf16* Kb, float* kmean, LAS unsigned char* lds, int blk, int G, int tid, int wave, int lane) {
    LAS float* red = (LAS float*)lds;
    for (int it = blk; it < BATCH * NH * 32; it += G) {
        const int b = it >> 8, h = (it >> 5) & 7, kb = it & 31;
        const bf16* p = Kb + ((size_t)b * SEQ + kb * 256 + wave * 32) * D + h * HD + 2 * lane;
        float s0 = 0.f, s1 = 0.f;
#pragma unroll 8
        for (int r = 0; r < 32; ++r) { const unsigned w = *(const unsigned*)(p + (size_t)r * D); s0 += bflo(w); s1 += bfhi(w); }
        red[wave * 128 + 2 * lane] = s0; red[wave * 128 + 2 * lane + 1] = s1;
        __syncthreads();
        if (tid < 128) { float sum = 0.f;
#pragma unroll
            for (int w8 = 0; w8 < 8; ++w8) sum += red[w8 * 128 + tid];
            kmean[(size_t)it * 128 + tid] = sum * (1.0f / 256.0f); }
        __syncthreads();
    }
}
__device__ __forceinline__ void p_gate(const bf16* Qb, const float* kmean, unsigned* sel, unsigned* cnt, unsigned short* lists, LAS unsigned char* lds, int blk, int G, int tid, int wave, int lane) {
    LAS float* km = (LAS float*)lds;
    for (int it = blk; it < 256; it += G) {
        const int bh = it >> 4, span = it & 15, b = bh >> 3, h = bh & 7;
        __syncthreads();
        for (int i = tid; i < 1024; i += NTHR) ((LAS f32x4*)km)[i] = ((const f32x4*)(kmean + (size_t)bh * 4096))[i];
        __syncthreads();
        const int q = span * 512 + wave * 64 + lane, own = (span * 512 + wave * 64) >> 8;
        unsigned mask;
        if (own <= 3) mask = (1u << own) - 1u;
        else {
            float qf[128];
            const u32x4* qp = (const u32x4*)(Qb + ((size_t)b * SEQ + q) * D + h * HD);
#pragma unroll
            for (int c = 0; c < 16; ++c) { const u32x4 w = qp[c]; qf[c * 8 + 0] = bflo(w.x); qf[c * 8 + 1] = bfhi(w.x); qf[c * 8 + 2] = bflo(w.y); qf[c * 8 + 3] = bfhi(w.y);
                qf[c * 8 + 4] = bflo(w.z); qf[c * 8 + 5] = bfhi(w.z); qf[c * 8 + 6] = bflo(w.w); qf[c * 8 + 7] = bfhi(w.w); }
            float b0 = -3e38f, b1 = -3e38f, b2 = -3e38f; int i0 = 0, i1 = 0, i2 = 0;
#pragma unroll 1
            for (int n = 0; n < own; ++n) {
                float g0 = 0.f, g1 = 0.f, g2 = 0.f, g3 = 0.f;
#pragma unroll
                for (int d = 0; d < 128; d += 4) { const f32x4 kv = *(LAS f32x4*)(km + n * 128 + d); g0 += qf[d] * kv.x; g1 += qf[d + 1] * kv.y; g2 += qf[d + 2] * kv.z; g3 += qf[d + 3] * kv.w; }
                const float g = (g0 + g1) + (g2 + g3);
                if (g > b0) { b2 = b1; i2 = i1; b1 = b0; i1 = i0; b0 = g; i0 = n; }
                else if (g > b1) { b2 = b1; i2 = i1; b1 = g; i1 = n; }
                else if (g > b2) { b2 = g; i2 = n; }
            }
            mask = (1u << i0) | (1u << i1) | (1u << i2);
        }
        sel[(size_t)bh * SEQ + q] = mask;
        unsigned mycnt = 0u;
        for (int j = 0; j < own; ++j) { const unsigned long long bl = __ballot((mask >> j) & 1u); if (lane == j) mycnt = (unsigned)__popcll(bl); }
        unsigned base = 0u;
        if (lane < own && mycnt) base = __hip_atomic_fetch_add(cnt + bh * 32 + lane, mycnt, __ATOMIC_RELAXED, __HIP_MEMORY_SCOPE_AGENT);
        for (int j = 0; j < own; ++j) { const unsigned long long bl = __ballot((mask >> j) & 1u); const unsigned bj = (unsigned)__shfl((int)base, j);
            if ((mask >> j) & 1u) lists[((size_t)bh * 32 + j) * 8192 + bj + (unsigned)__popcll(bl & ((1ull << lane) - 1ull))] = (unsigned short)q; }
    }
}

namespace att {
typedef short bf16x8 __attribute__((ext_vector_type(8)));
typedef short s16x4 __attribute__((ext_vector_type(4)));
typedef float f32x16 __attribute__((ext_vector_type(16)));
typedef LAS const char* lcp;
constexpr int PITCH = 1024;
constexpr int SHM_V = 16384, SHM_K = 16384;
constexpr int L_V = 0, L_K = 32768, L_WS = 65536, L_LUT = 67584;
constexpr int LUTN = 2304, RMAXL = 2047, RFAR = 1536;
#define KSWZ(row, colB) ((row) * 256 + ((colB) ^ (((row) & 7) << 4)))
#define SBAR() __builtin_amdgcn_sched_barrier(0)
__device__ __forceinline__ int v_st(int k, int c) { const int kk = (k & ~0xC) | ((k & 4) << 1) | ((k & 8) >> 1); return ((kk >> 3) * 4 + (c >> 5)) * 512 + ((kk & 7) * 32 + (c & 31)) * 2; }
__device__ __forceinline__ int v_rd_base(int lane) { return ((lane & 3) << 3) | (((lane >> 2) & 3) << 6) | (((lane >> 4) & 1) << 5) | (((lane >> 5) & 1) << 8); }
constexpr int v_rd_off(int d0, int ks, int half) { return d0 * 512 + ks * 4096 + half * 2048; }
__device__ __forceinline__ int crow(int r, int hi) { return (r & 3) + 8 * (r >> 2) + 4 * hi; }
__device__ __forceinline__ unsigned cvtpk(float lo, float hi) { unsigned r; asm volatile("v_cvt_pk_bf16_f32 %0, %1, %2" : "=v"(r) : "v"(lo), "v"(hi)); return r; }

template <int KB, int NDS>
__device__ __forceinline__ void qkt(f32x16& p0, f32x16& p1, lcp K_lds, int r32, int hi, int coff, const bf16x8* qr) {
    p0 = f32x16{}; p1 = f32x16{};
    lcp kb[4];
#pragma unroll
    for (int dd = 0; dd < 4; ++dd) kb[dd] = K_lds + KB * SHM_K + KSWZ(r32, (dd * 16 + hi * 8) * 2) + coff;
#pragma unroll
    for (int d0 = 0; d0 < NDS; ++d0) { lcp a = kb[d0 & 3] + (d0 >> 2) * 128;
        const bf16x8 b0 = *(LAS const bf16x8*)a;
        const bf16x8 b1 = *(LAS const bf16x8*)(a + 32 * 256);
        p0 = __builtin_amdgcn_mfma_f32_32x32x16_bf16(b0, qr[d0], p0, 0, 0, 0);
        p1 = __builtin_amdgcn_mfma_f32_32x32x16_bf16(b1, qr[d0], p1, 0, 0, 0);
        if (NDS == 8 && (d0 & 1) == 1) SBAR(); }
}
template <int VB>
__device__ __forceinline__ void pv_tile(f32x16* o, int vb0, bf16x8 pa0, bf16x8 pa1, bf16x8 pa2, bf16x8 pa3) {
#define TRRD(dst, off) asm volatile("ds_read_b64_tr_b16 %0, %1 offset:%2" : "=&v"(dst) : "v"(vb0), "i"(off) : "memory")
#define PV_D0(d0) do { s16x4 l0, l1, l2, l3, h0, h1, h2, h3; constexpr int b_ = VB * SHM_V + v_rd_off(d0, 0, 0); \
        TRRD(l0, b_); TRRD(h0, b_ + 2048); TRRD(l1, b_ + 4096); TRRD(h1, b_ + 6144); TRRD(l2, b_ + 8192); TRRD(h2, b_ + 10240); TRRD(l3, b_ + 12288); TRRD(h3, b_ + 14336); \
        asm volatile("s_waitcnt lgkmcnt(0)" ::: "memory"); SBAR(); \
        o[d0] = __builtin_amdgcn_mfma_f32_32x32x16_bf16(pa0, (bf16x8){l0[0], l0[1], l0[2], l0[3], h0[0], h0[1], h0[2], h0[3]}, o[d0], 0, 0, 0); \
        o[d0] = __builtin_amdgcn_mfma_f32_32x32x16_bf16(pa1, (bf16x8){l1[0], l1[1], l1[2], l1[3], h1[0], h1[1], h1[2], h1[3]}, o[d0], 0, 0, 0); \
        o[d0] = __builtin_amdgcn_mfma_f32_32x32x16_bf16(pa2, (bf16x8){l2[0], l2[1], l2[2], l2[3], h2[0], h2[1], h2[2], h2[3]}, o[d0], 0, 0, 0); \
        o[d0] = __builtin_amdgcn_mfma_f32_32x32x16_bf16(pa3, (bf16x8){l3[0], l3[1], l3[2], l3[3], h3[0], h3[1], h3[2], h3[3]}, o[d0], 0, 0, 0); } while (0)
    PV_D0(0); PV_D0(1); PV_D0(2); PV_D0(3);
#undef PV_D0
#undef TRRD
}
constexpr float THR2 = 8.0f;
__device__ __forceinline__ void softmax_tile(f32x16& p0, f32x16& p1, float sh, float& m_reg, float& l_reg, float& alpha, bf16x8& pa0, bf16x8& pa1, bf16x8& pa2, bf16x8& pa3) {
    float pmax = p0[0];
#pragma unroll
    for (int r = 1; r < 16; ++r) pmax = fmaxf(pmax, p0[r]);
#pragma unroll
    for (int r = 0; r < 16; ++r) pmax = fmaxf(pmax, p1[r]);
    { auto rr = __builtin_amdgcn_permlane32_swap(__float_as_uint(pmax), __float_as_uint(pmax), false, false);
      pmax = fmaxf(__uint_as_float(rr[0]), __uint_as_float(rr[1])); }
    pmax += sh;
    float mn;
    if (__builtin_expect(__all((pmax - m_reg) <= THR2), 1)) { mn = m_reg; alpha = 1.f; }
    else { mn = fmaxf(m_reg, pmax); alpha = __builtin_amdgcn_exp2f(m_reg - mn); m_reg = mn; }
    const float off = mn - sh;
#pragma unroll
    for (int r = 0; r < 16; ++r) p0[r] = __builtin_amdgcn_exp2f(p0[r] - off);
#pragma unroll
    for (int r = 0; r < 16; ++r) p1[r] = __builtin_amdgcn_exp2f(p1[r] - off);
    float ps = 0.f;
#pragma unroll
    for (int r = 0; r < 16; ++r) ps += p0[r];
#pragma unroll
    for (int r = 0; r < 16; ++r) ps += p1[r];
    { auto rr = __builtin_amdgcn_permlane32_swap(__float_as_uint(ps), __float_as_uint(ps), false, false);
      ps = __uint_as_float(rr[0]) + __uint_as_float(rr[1]); }
    l_reg = l_reg * alpha + ps;
#define PK4(P, B_, OUT) do { unsigned a0 = cvtpk(P[B_+0], P[B_+1]), a1 = cvtpk(P[B_+2], P[B_+3]); \
        unsigned b0 = cvtpk(P[B_+4], P[B_+5]), b1 = cvtpk(P[B_+6], P[B_+7]); \
        auto r0 = __builtin_amdgcn_permlane32_swap(a0, b0, false, false); auto r1 = __builtin_amdgcn_permlane32_swap(a1, b1, false, false); \
        u32x4 w = {r0[0], r1[0], r0[1], r1[1]}; OUT = __builtin_bit_cast(bf16x8, w); } while (0)
    PK4(p0, 0, pa0); PK4(p0, 8, pa1); PK4(p1, 0, pa2); PK4(p1, 8, pa3);
#undef PK4
}
__device__ __forceinline__ void add_bias_lut(f32x16& p0, f32x16& p1, LAS const float* lut, int dq) {
    LAS const float* bp = lut + (RMAXL - dq);
#pragma unroll
    for (int r = 0; r < 16; ++r) { const int c = (r & 3) + 8 * (r >> 2); p0[r] += bp[c]; p1[r] += bp[c + 32]; if ((r & 3) == 3) asm volatile("" ::: "memory"); }
}
__device__ __forceinline__ void causal_mask(f32x16& p0, f32x16& p1, int dq) {
    const float NEG = -__builtin_inff();
#pragma unroll
    for (int r = 0; r < 16; ++r) { const int c = (r & 3) + 8 * (r >> 2); if (dq - c < 0) p0[r] = NEG; if (dq - c - 32 < 0) p1[r] = NEG; }
}
struct DmaOff { unsigned k[2], v[2]; };
__device__ __forceinline__ DmaOff dma_offsets(int wid, int lane) {
    DmaOff d;
#pragma unroll
    for (int i = 0; i < 2; ++i) { const int p = wid * 2 + i;
        { const int row = 4 * p + (lane >> 4), c = (lane & 15) ^ (row & 7); d.k[i] = (unsigned)(row * PITCH * 2 + c * 16); }
        { const int sub = 2 * p + (lane >> 5), kkhi = sub >> 2, cblk = sub & 3, kklo = (lane & 31) >> 2, kk = kkhi * 8 + kklo;
          const int k = (kk & ~0xC) | ((kk & 4) << 1) | ((kk & 8) >> 1), c = cblk * 32 + (lane & 3) * 8; d.v[i] = (unsigned)(k * PITCH * 2 + c * 2); } }
    return d;
}
__device__ __forceinline__ void dma_tile(LAS char* lds, int bf, const bf16* Kc, const bf16* Vc, int k0, const DmaOff& d, int wid) {
    const char* kt = (const char*)Kc + (size_t)k0 * (PITCH * 2); const char* vt = (const char*)Vc + (size_t)k0 * (PITCH * 2);
#pragma unroll
    for (int i = 0; i < 2; ++i) {
        __builtin_amdgcn_global_load_lds((const unsigned*)(kt + d.k[i]), (LAS unsigned*)(lds + L_K + bf * SHM_K + (wid * 2 + i) * 1024), 16, 0, 0);
        __builtin_amdgcn_global_load_lds((const unsigned*)(vt + d.v[i]), (LAS unsigned*)(lds + L_V + bf * SHM_V + (wid * 2 + i) * 1024), 16, 0, 0); }
}
constexpr int L_CF = 76800, L_TAB = 80896, L_FOUND = 83008;
__device__ __forceinline__ void build_lut(LAS char* lds, const float* biasT, int h, int tid) {
    LAS float* lut = (LAS float*)(lds + L_LUT);
    for (int i = tid; i < LUTN; i += 512) lut[i] = biasT[h * LUTN + i];
}

__device__ __forceinline__ void diff_unit(LAS char* lds, int b, int h, int qb, const bf16* Q, const bf16* K, const bf16* V, bf16* O, const float* relb, const float* biasT,
                                          float lam_full, const float* subg, int tid, int wid, int lane) {
    asm volatile("" : "+v"(lane), "+v"(tid));
    const int r32 = lane & 31, hi = lane >> 5, cm = wid >> 2, w4 = wid & 3;
    const size_t rowbase = (size_t)b * SEQ;
    const int q0 = qb * 128, qw0 = q0 + w4 * 32, qpos = qw0 + r32;
    const bf16* Kc = K + rowbase * PITCH + h * HD; const bf16* Vc = V + rowbase * PITCH + h * HD;
    const int NT = (q0 + 128) / 64;
    const DmaOff dmo = dma_offsets(wid, lane);
    const int vb0 = (int)(unsigned)(uintptr_t)(lds + L_V) + v_rd_base(lane);
    LAS float* ws = (LAS float*)(lds + L_WS) + wid * 64;
    LAS const float* lut = (LAS const float*)(lds + L_LUT);
    lcp K_lds = (lcp)(lds + L_K);
    const float b31 = relb[31 * 8 + h] * 1.4426950408889634f;
    build_lut(lds, biasT, h, tid);
    bf16x8 qr[4];
#pragma unroll
    for (int d0 = 0; d0 < 4; ++d0) qr[d0] = *(const bf16x8*)(Q + (rowbase + qpos) * PITCH + h * HD + cm * 64 + d0 * 16 + hi * 8);
    dma_tile(lds, 0, Kc, Vc, 0, dmo, wid);
    asm volatile("s_waitcnt vmcnt(0)" ::: "memory");
    __syncthreads();
    float m_reg = -1e30f, l_reg = 0.f; f32x16 o[4] = {};
#define DIFF_STEP(t, BF) do { const int k0_ = (t) * 64; \
        if ((t) + 1 < NT) dma_tile(lds, (BF) ^ 1, Kc, Vc, k0_ + 64, dmo, wid); \
        if (k0_ <= qw0 + 31) { f32x16 p0, p1; bf16x8 pa0, pa1, pa2, pa3; float alpha, sh = 0.f; \
            qkt<BF, 4>(p0, p1, K_lds, r32, hi, cm * 128, qr); \
            const int dq_ = qpos - k0_ - 4 * hi; \
            if (qw0 - (k0_ + 63) >= RFAR) sh = b31; else add_bias_lut(p0, p1, lut, dq_); \
            if (k0_ + 63 > qw0) causal_mask(p0, p1, dq_); \
            softmax_tile(p0, p1, sh, m_reg, l_reg, alpha, pa0, pa1, pa2, pa3); \
            if (__any(alpha < 1.f)) { if (hi == 0) ws[r32] = alpha; asm volatile("s_waitcnt lgkmcnt(0)" ::: "memory"); \
                _Pragma("unroll") for (int d_ = 0; d_ < 4; ++d_) _Pragma("unroll") for (int r = 0; r < 16; ++r) o[d_][r] *= ws[crow(r, hi)]; } \
            pv_tile<BF>(o, vb0, pa0, pa1, pa2, pa3); } \
        asm volatile("s_waitcnt vmcnt(0)" ::: "memory"); \
        __syncthreads(); } while (0)
    for (int t = 0; t < NT; t += 2) { DIFF_STEP(t, 0); DIFF_STEP(t + 1, 1); }
#undef DIFF_STEP
    if (hi == 0) ws[32 + r32] = l_reg; asm volatile("s_waitcnt lgkmcnt(0)" ::: "memory");
#pragma unroll
    for (int r = 0; r < 16; ++r) { const float rl = __builtin_amdgcn_rcpf(ws[32 + crow(r, hi)]);
#pragma unroll
        for (int d0 = 0; d0 < 4; ++d0) o[d0][r] *= rl; }
    LAS float* xch = (LAS float*)lds + (size_t)w4 * 64 * 64;
    if (cm == 1) {
#pragma unroll
        for (int d0 = 0; d0 < 4; ++d0)
#pragma unroll
            for (int r = 0; r < 16; ++r) xch[(d0 * 16 + r) * 64 + lane] = o[d0][r];
    }
    __syncthreads();
    if (cm == 0) {
        float ss[16];
#pragma unroll
        for (int r = 0; r < 16; ++r) { float a = 0.f;
#pragma unroll
            for (int d0 = 0; d0 < 4; ++d0) { o[d0][r] -= lam_full * xch[(d0 * 16 + r) * 64 + lane]; a += o[d0][r] * o[d0][r]; }
            ss[r] = a; }
#pragma unroll
        for (int r = 0; r < 16; ++r) {
#pragma unroll
            for (int sft = 1; sft < 32; sft <<= 1) ss[r] += __shfl_xor(ss[r], sft); }
        float gg[4];
#pragma unroll
        for (int d0 = 0; d0 < 4; ++d0) gg[d0] = subg[d0 * 32 + r32] * (1.0f - LAMBDA_INIT);
        bf16* Ow = O + (rowbase + qw0) * PITCH + h * HD;
#pragma unroll
        for (int r = 0; r < 16; ++r) { const int orow = crow(r, hi); const float rs = 1.0f / sqrtf(ss[r] * (1.0f / HD) + RMS_EPS);
#pragma unroll
            for (int d0 = 0; d0 < 4; ++d0) { const float v = o[d0][r] * rs * gg[d0]; const float vn = __shfl_xor(v, 1);
                if ((r32 & 1) == 0) *(unsigned*)(Ow + (size_t)orow * PITCH + d0 * 32 + r32) = cvtpk(v, vn); } }
    }
    __syncthreads();
}


__device__ __forceinline__ void moba_part_item(LAS char* lds, int bh, int j, int chunk, int cntj, const bf16* Q, const bf16* K, const bf16* V, const unsigned short* lists, const unsigned* sel,
                                               bf16* P0, bf16* P1, bf16* P2, f32x2* ml, const float* relb, int tid, int wid, int lane) {
    asm volatile("" : "+v"(lane), "+v"(tid));
    const int r32 = lane & 31, hi = lane >> 5, b = bh >> 3, h = bh & 7;
    const size_t rowbase = (size_t)b * SEQ;
    const int idx = chunk * 256 + wid * 32 + r32; const bool valid = idx < cntj;
    const int qpos = (int)lists[((size_t)bh * 32 + j) * 8192 + (valid ? idx : cntj - 1)];
    const unsigned smask = sel[(size_t)bh * SEQ + qpos]; const int slot = __popc(smask & ((1u << j) - 1u));
    const bf16* Kc = K + (rowbase + j * 256) * PITCH + h * HD; const bf16* Vc = V + (rowbase + j * 256) * PITCH + h * HD;
    const DmaOff dmo = dma_offsets(wid, lane);
    const int vb0 = (int)(unsigned)(uintptr_t)(lds + L_V) + v_rd_base(lane);
    LAS float* ws = (LAS float*)(lds + L_WS) + wid * 64;
    LAS const float* lut = (LAS const float*)(lds + L_LUT);
    lcp K_lds = (lcp)(lds + L_K);
    const float b31 = relb[31 * 8 + h] * 1.4426950408889634f;
    dma_tile(lds, 0, Kc, Vc, 0, dmo, wid);
    bf16x8 qr[8];
#pragma unroll
    for (int d0 = 0; d0 < 8; ++d0) qr[d0] = *(const bf16x8*)(Q + (rowbase + qpos) * PITCH + h * HD + d0 * 16 + hi * 8);
    if (hi == 0) ((LAS int*)ws)[32 + r32] = valid ? (int)((unsigned)(rowbase + qpos) | ((unsigned)slot << 24)) : -1;
    asm volatile("s_waitcnt vmcnt(0)" ::: "memory");
    __syncthreads();
    float m_reg = -1e30f, l_reg = 0.f; f32x16 o[4] = {};
#define PART_STEP(t, BF) do { const int k0_ = j * 256 + (t) * 64; \
        if ((t) + 1 < 4) dma_tile(lds, (BF) ^ 1, Kc, Vc, (t) * 64 + 64, dmo, wid); \
        { f32x16 p0, p1; bf16x8 pa0, pa1, pa2, pa3; float alpha, sh = 0.f; \
            qkt<BF, 8>(p0, p1, K_lds, r32, hi, 0, qr); \
            const int dq_ = qpos - k0_ - 4 * hi; \
            if (__all(qpos - (k0_ + 63) >= RFAR)) sh = b31; else add_bias_lut(p0, p1, lut, dq_ < RFAR + 63 ? dq_ : RFAR + 63); \
            softmax_tile(p0, p1, sh, m_reg, l_reg, alpha, pa0, pa1, pa2, pa3); \
            if (__any(alpha < 1.f)) { if (hi == 0) ws[r32] = alpha; asm volatile("s_waitcnt lgkmcnt(0)" ::: "memory"); \
                _Pragma("unroll") for (int d_ = 0; d_ < 4; ++d_) _Pragma("unroll") for (int r = 0; r < 16; ++r) o[d_][r] *= ws[crow(r, hi)]; } \
            pv_tile<BF>(o, vb0, pa0, pa1, pa2, pa3); } \
        asm volatile("s_waitcnt vmcnt(0)" ::: "memory"); \
        __syncthreads(); } while (0)
    PART_STEP(0, 0); PART_STEP(1, 1); PART_STEP(2, 0); PART_STEP(3, 1);
#undef PART_STEP
    if (hi == 0) { ws[r32] = l_reg; if (valid) ml[((size_t)slot * M + rowbase + qpos) * NH + h] = (f32x2){m_reg, l_reg}; }
    asm volatile("s_waitcnt lgkmcnt(0)" ::: "memory");
#pragma unroll
    for (int r = 0; r < 16; ++r) { const int orow = crow(r, hi); const float rl = __builtin_amdgcn_rcpf(ws[orow]); const int info = ((LAS const int*)ws)[32 + orow];
        const int sl = info >> 24; bf16* Pb = sl == 0 ? P0 : (sl == 1 ? P1 : P2); bf16* Ow = Pb + (size_t)(info & 0xffffff) * PITCH + h * HD;
#pragma unroll
        for (int d0 = 0; d0 < 4; ++d0) { const float v = o[d0][r] * rl; const float vn = __shfl_xor(v, 1);
            if (info >= 0 && (r32 & 1) == 0) *(unsigned*)(Ow + d0 * 32 + r32) = cvtpk(v, vn); } }
    __syncthreads();
}
__device__ __forceinline__ void moba_own_unit(LAS char* lds, int b, int h, int qb, const bf16* Q, const bf16* K, const bf16* V, bf16* O, const bf16* P0, const bf16* P1, const bf16* P2, const f32x2* ml,
                                              int tid, int wid, int lane) {
    asm volatile("" : "+v"(lane), "+v"(tid));
    const int r32 = lane & 31, hi = lane >> 5;
    const size_t rowbase = (size_t)b * SEQ;
    const int q0 = qb * 256, qw0 = q0 + wid * 32, qpos = qw0 + r32;
    const bf16* Kc = K + (rowbase + q0) * PITCH + h * HD; const bf16* Vc = V + (rowbase + q0) * PITCH + h * HD;
    const DmaOff dmo = dma_offsets(wid, lane);
    const int vb0 = (int)(unsigned)(uintptr_t)(lds + L_V) + v_rd_base(lane);
    LAS float* ws = (LAS float*)(lds + L_WS) + wid * 64;
    LAS const float* lut = (LAS const float*)(lds + L_LUT);
    lcp K_lds = (lcp)(lds + L_K);
    dma_tile(lds, 0, Kc, Vc, 0, dmo, wid);
    bf16x8 qr[8];
#pragma unroll
    for (int d0 = 0; d0 < 8; ++d0) qr[d0] = *(const bf16x8*)(Q + (rowbase + qpos) * PITCH + h * HD + d0 * 16 + hi * 8);
    asm volatile("s_waitcnt vmcnt(0)" ::: "memory");
    __syncthreads();
    float m_reg = -1e30f, l_reg = 0.f; f32x16 o[4] = {};
#define OWN_STEP(t, BF) do { const int k0_ = q0 + (t) * 64; \
        if ((t) + 1 < 4) dma_tile(lds, (BF) ^ 1, Kc, Vc, (t) * 64 + 64, dmo, wid); \
        if (k0_ <= qw0 + 31) { f32x16 p0, p1; bf16x8 pa0, pa1, pa2, pa3; float alpha; \
            qkt<BF, 8>(p0, p1, K_lds, r32, hi, 0, qr); \
            const int dq_ = qpos - k0_ - 4 * hi; \
            add_bias_lut(p0, p1, lut, dq_); \
            if (k0_ + 63 > qw0) causal_mask(p0, p1, dq_); \
            softmax_tile(p0, p1, 0.f, m_reg, l_reg, alpha, pa0, pa1, pa2, pa3); \
            if (__any(alpha < 1.f)) { if (hi == 0) ws[r32] = alpha; asm volatile("s_waitcnt lgkmcnt(0)" ::: "memory"); \
                _Pragma("unroll") for (int d_ = 0; d_ < 4; ++d_) _Pragma("unroll") for (int r = 0; r < 16; ++r) o[d_][r] *= ws[crow(r, hi)]; } \
            pv_tile<BF>(o, vb0, pa0, pa1, pa2, pa3); } \
        asm volatile("s_waitcnt vmcnt(0)" ::: "memory"); \
        __syncthreads(); } while (0)
    OWN_STEP(0, 0); OWN_STEP(1, 1); OWN_STEP(2, 0); OWN_STEP(3, 1);
#undef OWN_STEP
    const int nsel = qb < 3 ? qb : 3;
    {
        float ms[3], ls[3]; float mx = m_reg;
#pragma unroll
        for (int s_ = 0; s_ < 3; ++s_) { ms[s_] = -1e30f; ls[s_] = 0.f;
            if (s_ < nsel) { const f32x2 v = ml[((size_t)s_ * M + rowbase + qpos) * NH + h]; ms[s_] = v.x; ls[s_] = v.y; mx = fmaxf(mx, v.x); } }
        const float w0 = __builtin_amdgcn_exp2f(m_reg - mx);
        float wv[3]; float den = l_reg * w0;
#pragma unroll
        for (int s_ = 0; s_ < 3; ++s_) { wv[s_] = ls[s_] * __builtin_amdgcn_exp2f(ms[s_] - mx); den += wv[s_]; }
        const float rd = 1.0f / den;
        if (hi == 0) *(LAS f32x4*)(lds + L_CF + wid * 512 + r32 * 16) = (f32x4){w0 * rd, wv[0] * rd, wv[1] * rd, wv[2] * rd};
    }
    asm volatile("s_waitcnt lgkmcnt(0)" ::: "memory");
    bf16* Ow = O + (rowbase + qw0) * PITCH + h * HD;
#pragma unroll
    for (int r = 0; r < 16; ++r) { const int orow = crow(r, hi); const f32x4 cf = *(LAS const f32x4*)(lds + L_CF + wid * 512 + orow * 16);
        const size_t ro = (rowbase + qw0 + orow) * PITCH + h * HD + r32;
#pragma unroll
        for (int d0 = 0; d0 < 4; ++d0) { float v = o[d0][r] * cf.x;
            if (nsel > 0) v += cf.y * bf2f(P0[ro + d0 * 32]);
            if (nsel > 1) v += cf.z * bf2f(P1[ro + d0 * 32]);
            if (nsel > 2) v += cf.w * bf2f(P2[ro + d0 * 32]);
            const float vn = __shfl_xor(v, 1);
            if ((r32 & 1) == 0) *(unsigned*)(Ow + (size_t)orow * PITCH + d0 * 32 + r32) = cvtpk(v, vn); } }
    __syncthreads();
}
#undef KSWZ
#undef SBAR
}


__device__ __forceinline__ void p_diff_attn_mfma(const Args& a, LAS unsigned char* lds, int vcu, int tid, int wave, int lane) {
    const bf16* Qb = (const bf16*)(a.ws + WS_Q); const bf16* Kb = (const bf16*)(a.ws + WS_K); const bf16* Vb = (const bf16*)(a.ws + WS_V);
    bf16* Ob = (bf16*)(a.ws + WS_O); const float* biasT = (const float*)(a.ws + WS_BIAST);
    float lam_full;
    { const float* lm = a.diff_lambda; const float p01 = wave_sum(lm[lane] * lm[64 + lane]), p23 = wave_sum(lm[128 + lane] * lm[192 + lane]); lam_full = __expf(p01) - __expf(p23) + LAMBDA_INIT; }
    const int G = gridDim.x;
    for (int pr = 2 * vcu; pr < 512; pr += 2 * G) {
#pragma unroll 1
        for (int k = 0; k < 4; ++k) {
            const int pp = pr + (k >> 1); if (pp >= 512) break;
            const int bh = pp >> 5, p = pp & 31, qb = (k & 1) ? 63 - p : p;
            att::diff_unit((LAS char*)lds, bh >> 3, bh & 7, qb, Qb, Kb, Vb, Ob, a.rel_bias, biasT, lam_full, a.diff_subln_g, tid, wave, lane);
        }
    }
}


__device__ __forceinline__ void p_moba_part(const Args& a, LAS unsigned char* lds, int vcu, int tid, int wave, int lane) {
    const bf16* Qb = (const bf16*)(a.ws + WS_Q); const bf16* Kb = (const bf16*)(a.ws + WS_K); const bf16* Vb = (const bf16*)(a.ws + WS_V);
    const unsigned* cnt = (const unsigned*)(a.ws + WS_CTL) + CW_CNT; const unsigned short* lists = (const unsigned short*)(a.ws + WS_LIST); const unsigned* sel = (const unsigned*)(a.ws + WS_SEL);
    bf16* P0 = (bf16*)(a.ws + WS_H); bf16* P1 = (bf16*)(a.ws + WS_Y); bf16* P2 = (bf16*)a.out; f32x2* ml = (f32x2*)((unsigned char*)a.out + WS_ML);
    LAS int* pre = (LAS int*)(lds + att::L_TAB); LAS int* found = (LAS int*)(lds + att::L_FOUND);
    const int c = (int)cnt[tid], nch = (c + 255) >> 8;
    int incl = nch;
#pragma unroll
    for (int o = 1; o < 64; o <<= 1) { const int v = __shfl_up(incl, o); if (lane >= o) incl += v; }
    if (lane == 63) pre[513 + wave] = incl;
    __syncthreads();
    int woff = 0;
#pragma unroll
    for (int w8 = 0; w8 < 8; ++w8) woff += (w8 < wave) ? pre[513 + w8] : 0;
    pre[tid + 1] = woff + incl; if (tid == 0) pre[0] = 0;
    __syncthreads();
    const int T = pre[512], G = gridDim.x;
    const int lo = (int)(((long long)T * vcu) / G), hi_ = (int)(((long long)T * (vcu + 1)) / G);
    int last_h = -1;
    for (int it = lo; it < hi_; ++it) {
        if (pre[tid] <= it && it < pre[tid + 1]) found[0] = tid;
        __syncthreads();
        const int f = __builtin_amdgcn_readfirstlane(found[0]);
        const int bh = f >> 5, j = f & 31, chunk = it - pre[f];
        const int cntj = (int)cnt[f];
        if ((bh & 7) != last_h) { last_h = bh & 7; att::build_lut((LAS char*)lds, (const float*)(a.ws + WS_BIAST), last_h, tid); }
        att::moba_part_item((LAS char*)lds, bh, j, chunk, cntj, Qb, Kb, Vb, lists, sel, P0, P1, P2, ml, a.rel_bias, tid, wave, lane);
    }
}
__device__ __forceinline__ void p_moba_own(const Args& a, LAS unsigned char* lds, int vcu, int tid, int wave, int lane) {
    const bf16* Qb = (const bf16*)(a.ws + WS_Q); const bf16* Kb = (const bf16*)(a.ws + WS_K); const bf16* Vb = (const bf16*)(a.ws + WS_V); bf16* Ob = (bf16*)(a.ws + WS_O);
    const bf16* P0 = (const bf16*)(a.ws + WS_H); const bf16* P1 = (const bf16*)(a.ws + WS_Y); const bf16* P2 = (const bf16*)a.out; const f32x2* ml = (const f32x2*)((const unsigned char*)a.out + WS_ML);
    const int G = gridDim.x;
    for (int u0 = 2 * vcu; u0 < 512; u0 += 2 * G) {
#pragma unroll 1
        for (int k = 0; k < 2; ++k) { const int u = u0 + k; if (u >= 512) break; const int bh = u >> 5, qb = u & 31;
            if (k == 0 || (u & 31) == 0) att::build_lut((LAS char*)lds, (const float*)(a.ws + WS_BIAST), bh & 7, tid);
            att::moba_own_unit((LAS char*)lds, bh >> 3, bh & 7, qb, Qb, Kb, Vb, Ob, P0, P1, P2, ml, tid, wave, lane); }
    }
}

struct TI { int tid, lane, wave, gtid, gw; };
__device__ __forceinline__ TI mk_ti() { int t = threadIdx.x; asm volatile("" : "+v"(t)); TI r; r.tid = t; r.lane = t & 63; r.wave = __builtin_amdgcn_readfirstlane(t >> 6);
    r.gtid = blockIdx.x * NTHR + t; r.gw = blockIdx.x * NWAVES + r.wave; return r; }

typedef const __attribute__((address_space(4))) Args* CArgs;
__device__ __forceinline__ Args load_args() {
#if defined(__HIP_DEVICE_COMPILE__)
    auto p = __builtin_amdgcn_kernarg_segment_ptr(); asm volatile("" : "+s"(p));
    typedef const __attribute__((address_space(4))) unsigned long long* cu64; cu64 q = (cu64)p;
    Args r; r.x = (const float*)q[0]; r.c = (const float*)q[1]; r.rel_bias = (const float*)q[2]; r.ada_w = (const float*)q[3]; r.ada_b = (const float*)q[4]; r.norm_g = (const float*)q[5];
    r.moba_w_qkv = (const float*)q[6]; r.moba_w_o = (const float*)q[7]; r.diff_w_qkv = (const float*)q[8]; r.diff_w_o = (const float*)q[9];
    r.diff_lambda = (const float*)q[10]; r.diff_subln_g = (const float*)q[11]; r.ffn_w_in = (const float*)q[12]; r.ffn_w_out = (const float*)q[13];
    r.out = (float*)q[14]; r.ws = (unsigned char*)q[15]; return r;
#else
    return Args{};
#endif
}
#define WSP(T, off) ((T*)(a.ws + (off)))
#define GEMM_PHASE(EPI, Aptr, Wptr, N_, K_, ...) do { const Args a = load_args(); const int G_ = gridDim.x; \
        pg8::Gemm g{Aptr, (const bf16*)(Wptr), M, N_, K_}; pg8::StaticOrder S; S.init(M, N_, G_, (int)blockIdx.x); \
        EPI E{__VA_ARGS__}; pg8::gemm_phase<EPI, pg8::StaticOrder, true, true>(lds, g, S, E); } while (0)
__global__ void __launch_bounds__(NTHR, 2) fwd(Args a_unused) {
    extern __shared__ __attribute__((aligned(16))) unsigned char lds_raw[];
    LAS unsigned char* lds = (LAS unsigned char*)lds_raw;
    volatile LAS unsigned* MISC = (volatile LAS unsigned*)(lds + MISC_OFF);
    for (int u = threadIdx.x; u < 64; u += NTHR) MISC[u] = 0u;
    __syncthreads();
    XcdBarrier bar;
    { const Args a = load_args(); bar = xcd_barrier_post(WSP(unsigned, WS_CTL) + CW_BAR, MISC + 8); }
#define VCU() ((gridDim.x % 8 == 0) ? (int)((blockIdx.x % 8) * (gridDim.x / 8) + blockIdx.x / 8) : (int)blockIdx.x)
#define NGW() ((int)gridDim.x * NWAVES)
#define NGT() ((int)gridDim.x * NTHR)
    constexpr float QS0 = 0.08838834764831845f * LOG2E, QS1 = 0.125f * LOG2E;
    constexpr size_t QKVS = (size_t)(WS_K - WS_Q) / 2;

    { const Args a = load_args(); const TI t = mk_ti(); p_weights(a, lds, t.gw, NGW(), t.wave, t.lane); __syncthreads(); p_mod(a, lds, (int)blockIdx.x, (int)gridDim.x, t.tid, t.wave, t.lane); }
    xcd_barrier(bar);
    { const Args a = load_args(); const TI t = mk_ti(); const float* md = WSP(const float, WS_MOD); p_norm_in(a.x, a.norm_g, md, md + 1024, WSP(bf16, WS_H), t.gw, NGW(), t.lane); }
    xcd_barrier(bar);
    GEMM_PHASE(pg8::EpiBf16<0>, WSP(bf16, WS_H), a.ws + WS_W + WO_QKV, 3 * D, D, WSP(bf16, WS_Q), D, nullptr, D, QKVS, QS0);
    xcd_barrier(bar);
    { const Args a = load_args(); const TI t = mk_ti(); p_kmean(WSP(bf16, WS_K), WSP(float, WS_KMEAN), lds, (int)blockIdx.x, (int)gridDim.x, t.tid, t.wave, t.lane); }
    xcd_barrier(bar);
    { const Args a = load_args(); const TI t = mk_ti(); p_gate(WSP(bf16, WS_Q), WSP(const float, WS_KMEAN), WSP(unsigned, WS_SEL), WSP(unsigned, WS_CTL) + CW_CNT, WSP(unsigned short, WS_LIST), lds, (int)blockIdx.x, (int)gridDim.x, t.tid, t.wave, t.lane); }
    xcd_barrier(bar);
    { const Args a = load_args(); const TI t = mk_ti(); p_moba_part(a, lds, VCU(), t.tid, t.wave, t.lane); }
    xcd_barrier(bar);
    { const Args a = load_args(); const TI t = mk_ti(); p_moba_own(a, lds, VCU(), t.tid, t.wave, t.lane); }
    xcd_barrier(bar);
    GEMM_PHASE(pg8::EpiBf16<0>, WSP(bf16, WS_O), a.ws + WS_W + WO_O, D, D, WSP(bf16, WS_Y), D, nullptr, 0, 0, 1.f);
    xcd_barrier(bar);
    { const Args a = load_args(); const TI t = mk_ti(); const float* md = WSP(const float, WS_MOD); const float* ng = a.norm_g;
      p_post(a.x, WSP(bf16, WS_Y), ng + D, md + 2048, a.out, ng + 2 * D, md + 3072, md + 4096, WSP(bf16, WS_H), t.gw, NGW(), t.lane); }
    xcd_barrier(bar);
    GEMM_PHASE(pg8::EpiSwiglu, WSP(bf16, WS_H), a.ws + WS_W + WO_IN, 2 * DFF, D, WSP(bf16, WS_HH), DFF);
    xcd_barrier(bar);
    GEMM_PHASE(pg8::EpiBf16<0>, WSP(bf16, WS_HH), a.ws + WS_W + WO_OUT, D, DFF, WSP(bf16, WS_Y), D, nullptr, 0, 0, 1.f);
    xcd_barrier(bar);
    { const Args a = load_args(); const TI t = mk_ti(); const float* md = WSP(const float, WS_MOD); const float* ng = a.norm_g; const float* md1 = md + 2 * 6144; const float* ng1 = ng + 4 * D;
      p_post(a.out, WSP(bf16, WS_Y), ng + 3 * D, md + 5120, a.out, ng1, md1, md1 + 1024, WSP(bf16, WS_H), t.gw, NGW(), t.lane); }
    xcd_barrier(bar);
    GEMM_PHASE(pg8::EpiBf16<0>, WSP(bf16, WS_H), a.ws + WS_W + WL_STRIDE + WO_QKV, 3 * D, D, WSP(bf16, WS_Q), D, nullptr, D, QKVS, QS1);
    xcd_barrier(bar);
    { const Args a = load_args(); const TI t = mk_ti(); p_diff_attn_mfma(a, lds, VCU(), t.tid, t.wave, t.lane); }
    xcd_barrier(bar);
    GEMM_PHASE(pg8::EpiBf16<0>, WSP(bf16, WS_O), a.ws + WS_W + WL_STRIDE + WO_O, D, D, WSP(bf16, WS_Y), D, nullptr, 0, 0, 1.f);
    xcd_barrier(bar);
    { const Args a = load_args(); const TI t = mk_ti(); const float* md = WSP(const float, WS_MOD) + 2 * 6144; const float* ng = a.norm_g + 4 * D;
      p_post(a.out, WSP(bf16, WS_Y), ng + D, md + 2048, a.out, ng + 2 * D, md + 3072, md + 4096, WSP(bf16, WS_H), t.gw, NGW(), t.lane); }
    xcd_barrier(bar);
    GEMM_PHASE(pg8::EpiSwiglu, WSP(bf16, WS_H), a.ws + WS_W + WL_STRIDE + WO_IN, 2 * DFF, D, WSP(bf16, WS_HH), DFF);
    xcd_barrier(bar);
    GEMM_PHASE(pg8::EpiBf16<0>, WSP(bf16, WS_HH), a.ws + WS_W + WL_STRIDE + WO_OUT, D, DFF, WSP(bf16, WS_Y), D, nullptr, 0, 0, 1.f);
    xcd_barrier(bar);
    { const Args a = load_args(); const TI t = mk_ti(); const float* md = WSP(const float, WS_MOD) + 2 * 6144; const float* ng = a.norm_g + 4 * D;
      p_post(a.out, WSP(bf16, WS_Y), ng + 3 * D, md + 5120, a.out, nullptr, nullptr, nullptr, nullptr, t.gw, NGW(), t.lane); }
}

extern "C" void kernel_launch(void* const* d_in, const int* in_sizes, int n_in, void* d_out, int out_size, void* d_ws, size_t ws_size, hipStream_t stream) {
    static int grid = 0;
    if (grid == 0) {
        if (n_in != 14 || out_size != M * D || ws_size < WS_END) { fprintf(stderr, "kernel_launch: unexpected shapes n_in %d out %d ws %zu\n", n_in, out_size, ws_size); grid = -1; return; }
        int dev = 0, cus = 0;
        if (hipGetDevice(&dev) != hipSuccess || hipDeviceGetAttribute(&cus, hipDeviceAttributeMultiprocessorCount, dev) != hipSuccess) { grid = -1; return; }
        if (hipFuncSetAttribute((const void*)fwd, hipFuncAttributeMaxDynamicSharedMemorySize, LDS_BYTES) != hipSuccess) { fprintf(stderr, "hipFuncSetAttribute failed\n"); grid = -1; return; }
        grid = cus;
    }
    if (grid < 0) return;
    (void)hipMemsetAsync((char*)d_ws + WS_CTL, 0, CTL_ZERO_BYTES, stream);
    Args a{};
    a.x = (const float*)d_in[0]; a.c = (const float*)d_in[1]; a.rel_bias = (const float*)d_in[2]; a.ada_w = (const float*)d_in[3]; a.ada_b = (const float*)d_in[4];
    a.norm_g = (const float*)d_in[5]; a.moba_w_qkv = (const float*)d_in[6]; a.moba_w_o = (const float*)d_in[7]; a.diff_w_qkv = (const float*)d_in[8]; a.diff_w_o = (const float*)d_in[9];
    a.diff_lambda = (const float*)d_in[10]; a.diff_subln_g = (const float*)d_in[11]; a.ffn_w_in = (const float*)d_in[12]; a.ffn_w_out = (const float*)d_in[13];
    a.out = (float*)d_out; a.ws = (unsigned char*)d_ws;
    hipLaunchKernelGGL(fwd, dim3(grid), dim3(NTHR), LDS_BYTES, stream, a);
}
```

```cpp
#include <hip/hip_runtime.h>
#include <cstdio>
#include <cstdint>

#define GAS __attribute__((address_space(1)))
#define LAS __attribute__((address_space(3)))
typedef unsigned short bf16;
typedef float f32x4 __attribute__((ext_vector_type(4)));
typedef float f32x2 __attribute__((ext_vector_type(2)));
typedef unsigned u32x4 __attribute__((ext_vector_type(4)));
typedef unsigned u32x2 __attribute__((ext_vector_type(2)));

constexpr int BATCH = 2, SEQ = 8192, D = 1024, NH = 8, HD = 128, DFF = 2816, NBKT = 32;
constexpr int M = BATCH * SEQ;
constexpr int NWAVES = 8, NTHR = 512;
constexpr float RMS_EPS = 1e-6f;
constexpr float LOG2E = 1.4426950408889634f;
constexpr float LAMBDA_INIT = 0.35550906759096926f;

constexpr size_t MiB = 1u << 20;
constexpr size_t WS_CTL = 0, CTL_ZERO_BYTES = 1 * MiB;
constexpr size_t WS_MOD = 1 * MiB;
constexpr size_t WS_BLUT = WS_MOD + 128 * 1024;
constexpr size_t WS_KMEAN = WS_BLUT + 16 * 1024;
constexpr size_t WS_SEL = WS_KMEAN + 256 * 1024;
constexpr size_t WS_BIAST = WS_SEL + 512 * 1024;
constexpr size_t WS_LIST = 244 * MiB;
constexpr size_t WS_ML = 32 * MiB;
constexpr size_t WS_KSUM = 256 * 1024;
constexpr int CW_CNT = 8192;
constexpr size_t WS_W = 2 * MiB, WL_STRIDE = 25 * MiB;
constexpr size_t WO_QKV = 0, WO_O = 6 * MiB, WO_IN = 8 * MiB, WO_OUT = 19 * MiB;
constexpr size_t WS_H = 52 * MiB;
constexpr size_t WS_Q = 84 * MiB, WS_K = 116 * MiB, WS_V = 148 * MiB;
constexpr size_t WS_HH = 84 * MiB;
constexpr size_t WS_O = 180 * MiB;
constexpr size_t WS_Y = 212 * MiB;
constexpr size_t WS_END = 252 * MiB;
constexpr int CW_BAR = 4096;

constexpr int LDS_BYTES = 147456;
constexpr int MISC_OFF = 131072 + 320;

#define RLX_AGENT __ATOMIC_RELAXED, __HIP_MEMORY_SCOPE_AGENT
__device__ __forceinline__ unsigned f2bf(float f) { unsigned u = __builtin_bit_cast(unsigned, f); return (u + 0x7fffu + ((u >> 16) & 1u)) >> 16; }
__device__ __forceinline__ unsigned pk2(float lo, float hi) { return f2bf(lo) | (f2bf(hi) << 16); }
__device__ __forceinline__ float bf2f(unsigned short b) { return __builtin_bit_cast(float, (unsigned)b << 16); }
__device__ __forceinline__ float bflo(unsigned w) { return __builtin_bit_cast(float, w << 16); }
__device__ __forceinline__ float bfhi(unsigned w) { return __builtin_bit_cast(float, w & 0xffff0000u); }

#define XB_TMO      128
#define XB_XCNT(j)  (256  + 64 * (j))
#define XB_XSUB(j)  (1280 + 64 * (j))
#define XB_XGEN(j)  (2304 + 64 * (j))
#define XB_TOP      3328
#define XB_TOPGEN   3392
#define XCD_BAR_WORDS 3456
#define XB_SPIN_CAP (1u << 25)
__device__ __forceinline__ unsigned xb_ld(unsigned* p)              { return __hip_atomic_load(p, __ATOMIC_RELAXED, __HIP_MEMORY_SCOPE_AGENT); }
__device__ __forceinline__ unsigned xb_add(unsigned* p, unsigned v) { return __hip_atomic_fetch_add(p, v, __ATOMIC_RELAXED, __HIP_MEMORY_SCOPE_AGENT); }
__device__ __forceinline__ unsigned xb_xcc_id() { return (unsigned)__builtin_amdgcn_s_getreg((3 << 11) | 20) & 0xFu; }
#define XB_SPIN(cond, bar) do { unsigned _sp = 0; while (cond) { __builtin_amdgcn_s_sleep(1); \
    if ((++_sp & 255u) == 0u) { if (xb_ld(&(bar)[XB_TMO])) break; if (_sp > XB_SPIN_CAP) { atomicAdd(&(bar)[XB_TMO], 1u); break; } } } } while (0)
struct XcdBarrier { unsigned* bar; unsigned x; volatile LAS unsigned* st; };
__device__ __forceinline__ XcdBarrier xcd_barrier_post(unsigned* bar, volatile LAS unsigned* st) {
    XcdBarrier b; b.bar = bar; b.x = xb_xcc_id(); b.st = st;
    if (threadIdx.x == 0) (void)xb_add(&bar[XB_XCNT(b.x)], 1u);
    return b;
}
__device__ __forceinline__ void xcd_barrier_complete(unsigned* bar, unsigned x, unsigned& nloc, unsigned& nx) {
    const unsigned G = gridDim.x * gridDim.y * gridDim.z;
    unsigned sum, cnt, mine, sp = 0u;
    for (;;) {
        sum = 0u; cnt = 0u; mine = 0u;
#pragma unroll
        for (unsigned j = 0; j < 16; ++j) { const unsigned c = xb_ld(&bar[XB_XCNT(j)]); sum += c; cnt += (c > 0u) ? 1u : 0u; mine = (j == x) ? c : mine; }
        if (sum == G) break;
        __builtin_amdgcn_s_sleep(1);
        if ((++sp & 255u) == 0u) { if (xb_ld(&bar[XB_TMO])) break; if (sp > XB_SPIN_CAP) { atomicAdd(&bar[XB_TMO], 1u); break; } }
    }
    nloc = mine > 0u ? mine : 1u; nx = cnt > 0u ? cnt : 1u;
}
__device__ __forceinline__ void xcd_barrier(const XcdBarrier& b) {
    asm volatile("s_waitcnt vmcnt(0)" ::: "memory");
    __syncthreads();
    if (threadIdx.x == 0) {
        unsigned* bar = b.bar;
        __builtin_amdgcn_s_waitcnt(0);
        unsigned nloc = b.st[0], nx = b.st[1];
        if (nloc == 0u) { xcd_barrier_complete(bar, b.x, nloc, nx); b.st[0] = nloc; b.st[1] = nx; }
        const unsigned old = xb_add(&bar[XB_XSUB(b.x)], 1u);
        const unsigned gen = old / nloc;
        if (old + 1u == (gen + 1u) * nloc) {
            __builtin_amdgcn_fence(__ATOMIC_RELEASE, "agent");
            asm volatile("s_waitcnt vmcnt(0)" ::: "memory");
            const unsigned og = xb_add(&bar[XB_TOP], 1u);
            const unsigned tg = og / nx;
            if (og + 1u == (tg + 1u) * nx) xb_add(&bar[XB_TOPGEN], 1u);
            else XB_SPIN(xb_ld(&bar[XB_TOPGEN]) == tg, bar);
            __builtin_amdgcn_fence(__ATOMIC_ACQUIRE, "agent");
            xb_add(&bar[XB_XGEN(b.x)], 1u);
            asm volatile("s_waitcnt vmcnt(0)" ::: "memory");
        } else {
            XB_SPIN(xb_ld(&bar[XB_XGEN(b.x)]) == gen, bar);
            __builtin_amdgcn_fence(__ATOMIC_ACQUIRE, "agent");
            asm volatile("s_waitcnt vmcnt(0)" ::: "memory");
        }
    }
    __syncthreads();
}

namespace pg8 {
#define PG8_LAS __attribute__((address_space(3)))
typedef unsigned short bf16_t;
typedef short bf16x8 __attribute__((ext_vector_type(8)));
typedef float f32x4 __attribute__((ext_vector_type(4)));
typedef unsigned u32x4 __attribute__((ext_vector_type(4)));
constexpr int BM = 256, BK = 64, HALF = 128, HTB = HALF * BK * 2  , STAGE_BYTES = 8 * HTB, NXCD = 8, WGM = 8;

__host__ __device__ __forceinline__ int lds_byte(int r, int c) { const int st = (r >> 4) * 2 + (c >> 5), rr = r & 15, cc = c & 31, ob = rr * 64 + cc * 2; return st * 1024 + (ob ^ (((ob >> 9) & 1) << 5)); }
__host__ __device__ __forceinline__ void stage_rc(int b, int& R, int& C) { const int st = b / 1024, sb = b % 1024, swz = sb ^ (((sb >> 9) & 1) << 5); R = (st >> 1) * 16 + swz / 64; C = (st & 1) * 32 + (swz % 64) / 2; }
__host__ __device__ __forceinline__ int perm32(int rho) { const int n = rho >> 4, i = rho & 15; return 8 * (i >> 2) + 4 * n + (i & 3); }

struct Unit { int pm, pn; };
struct Gemm { const bf16_t* A; const bf16_t* Bt; int M, N, K; };

struct StaticOrder {
    int nM, nN, nwg, G, c;
    __host__ __device__ void init(int M, int N, int G_, int c_) { nM = M / BM; nN = N / BM; nwg = nM * nN; G = G_; c = c_; }
    __host__ __device__ bool next(int i, Unit& u) const {
        const long L = (long)i * G + c; if (L >= nwg) return false;
        int wgid = (int)L; { const int q = nwg / NXCD, r = nwg % NXCD, xcd = wgid % NXCD, off = wgid / NXCD; wgid = (xcd < r ? xcd * (q + 1) : r * (q + 1) + (xcd - r) * q) + off; }
        const int nig = WGM * nN, gid = wgid / nig, fm = gid * WGM, gsz = (nM - fm) < WGM ? (nM - fm) : WGM;
        u.pm = fm + ((wgid % nig) % gsz); u.pn = (wgid % nig) / gsz; return true;
    }
    __device__ __forceinline__ void a_ready(const Unit&) const {}
    __device__ __forceinline__ void done(const Unit&) const {}
};

__device__ __forceinline__ unsigned cvt_pk_bf16(float lo, float hi) { unsigned r; asm volatile("v_cvt_pk_bf16_f32 %0, %1, %2" : "=v"(r) : "v"(lo), "v"(hi)); return r; }
typedef float f32x2 __attribute__((ext_vector_type(2)));
__device__ __forceinline__ f32x2 gelu_pk(f32x2 v) {
    const f32x2 av = __builtin_elementwise_abs(v), d = av * 0.2316418882f + 1.0f;
    f32x2 t; t.x = __builtin_amdgcn_rcpf(d.x); t.y = __builtin_amdgcn_rcpf(d.y);
    f32x2 q = t * 0.5307027145f + (-0.7265760135f); q = q * t + 0.7107068705f; q = q * t + (-0.142248368f); q = q * t + 0.127414796f; q = q * t;
    const f32x2 s = (v * v) * (-0.72134752044f);
    f32x2 e; e.x = __builtin_amdgcn_exp2f(s.x); e.y = __builtin_amdgcn_exp2f(s.y);
    const f32x2 m = v * (q * e), r = v - m;
    f32x2 o; o.x = v.x < 0.f ? m.x : r.x; o.y = v.y < 0.f ? m.y : r.y; return o;
}

template <int ACT  > struct EpiBf16 {
    static constexpr bool PERM = true, AFTER_DRAIN = false; static_assert(ACT == 0 || ACT == 1, "EpiBf16: ACT is 0 (none) or 1 (gelu_pk)");
    bf16_t* O; int ldc; const float* bias; int split_cols; size_t split_stride; float scale0;
    __device__ __forceinline__ void operator()(const f32x4 (&acc)[2][2][4][2], const Unit& u, int wr, int wc, int fr, int fq) const {
        const int row0 = u.pm * BM + wr * 64 + fr; int colt = u.pn * BM; bf16_t* base = O;
        float sc = 1.f; if (split_cols) { const int t = colt / split_cols; base += (size_t)t * split_stride; colt -= t * split_cols; if (t == 0) sc = scale0; }
        const int col0 = colt + wc * 32 + 8 * fq, bcol0 = u.pn * BM + wc * 32 + 8 * fq;
        f32x4 bv[2][2];
#pragma unroll
        for (int bj = 0; bj < 2; ++bj)
#pragma unroll
            for (int n = 0; n < 2; ++n) bv[bj][n] = bias ? *(const f32x4*)(bias + bcol0 + bj * HALF + 4 * n) : (f32x4){0.f, 0.f, 0.f, 0.f};
#pragma unroll
        for (int ai = 0; ai < 2; ++ai)
#pragma unroll
            for (int m = 0; m < 4; ++m) { bf16_t* rowp = base + (size_t)(row0 + ai * HALF + m * 16) * ldc + col0;
#pragma unroll
                for (int bj = 0; bj < 2; ++bj) { f32x4 v0 = acc[ai][bj][m][0] + bv[bj][0], v1 = acc[ai][bj][m][1] + bv[bj][1];
                    if (ACT == 1) { f32x2 a = gelu_pk((f32x2){v0[0], v0[1]}), b = gelu_pk((f32x2){v0[2], v0[3]}), c = gelu_pk((f32x2){v1[0], v1[1]}), d = gelu_pk((f32x2){v1[2], v1[3]});
                        v0 = (f32x4){a.x, a.y, b.x, b.y}; v1 = (f32x4){c.x, c.y, d.x, d.y}; }
                    v0 = v0 * sc; v1 = v1 * sc; u32x4 w; w.x = cvt_pk_bf16(v0[0], v0[1]); w.y = cvt_pk_bf16(v0[2], v0[3]); w.z = cvt_pk_bf16(v1[0], v1[1]); w.w = cvt_pk_bf16(v1[2], v1[3]);
                    *(u32x4*)(rowp + bj * HALF) = w; } }
    }
};

struct EpiQKV {
    static constexpr bool PERM = true, AFTER_DRAIN = false;
    bf16_t* O; int ldc; size_t split_stride; float scale0; float* ksum;
    __device__ __forceinline__ void operator()(const f32x4 (&acc)[2][2][4][2], const Unit& u, int wr, int wc, int fr, int fq) const {
        const int row0 = u.pm * BM + wr * 64 + fr; const int t = (u.pn * BM) / ldc; const int colt = u.pn * BM - t * ldc; bf16_t* base = O + (size_t)t * split_stride;
        const float sc = t == 0 ? scale0 : 1.f;
        const int col0 = colt + wc * 32 + 8 * fq;
#pragma unroll
        for (int ai = 0; ai < 2; ++ai)
#pragma unroll
            for (int m = 0; m < 4; ++m) { bf16_t* rowp = base + (size_t)(row0 + ai * HALF + m * 16) * ldc + col0;
#pragma unroll
                for (int bj = 0; bj < 2; ++bj) { const f32x4 v0 = acc[ai][bj][m][0] * sc, v1 = acc[ai][bj][m][1] * sc;
                    u32x4 w; w.x = cvt_pk_bf16(v0[0], v0[1]); w.y = cvt_pk_bf16(v0[2], v0[3]); w.z = cvt_pk_bf16(v1[0], v1[1]); w.w = cvt_pk_bf16(v1[2], v1[3]);
                    *(u32x4*)(rowp + bj * HALF) = w; } }
        if (ksum != nullptr && t == 1) {
            const int b = u.pm >> 5, blk = u.pm & 31;
#pragma unroll
            for (int bj = 0; bj < 2; ++bj) { const int h = (colt >> 7) + bj;
                float* dst = ksum + ((size_t)((b * 8 + h) * 32 + blk)) * 128 + wc * 32 + 8 * fq;
#pragma unroll
                for (int n = 0; n < 2; ++n) { f32x4 sacc = (f32x4){0.f, 0.f, 0.f, 0.f};
#pragma unroll
                    for (int ai = 0; ai < 2; ++ai)
#pragma unroll
                        for (int m = 0; m < 4; ++m) sacc += acc[ai][bj][m][n];
#pragma unroll
                    for (int e = 0; e < 4; ++e) { float v = sacc[e];
                        v += __shfl_xor(v, 1); v += __shfl_xor(v, 2); v += __shfl_xor(v, 4); v += __shfl_xor(v, 8);
                        if (fr == 0) atomicAdd(dst + 4 * n + e, v); } } }
        }
    }
};

struct EpiSwiglu {
    static constexpr bool PERM = true, AFTER_DRAIN = false;
    bf16_t* O; int ldc;
    __device__ __forceinline__ void operator()(const f32x4 (&acc)[2][2][4][2], const Unit& u, int wr, int wc, int fr, int fq) const {
        const int row0 = u.pm * BM + wr * 64 + fr, col0 = u.pn * HALF + wc * 32 + 8 * fq;
#pragma unroll
        for (int ai = 0; ai < 2; ++ai)
#pragma unroll
            for (int m = 0; m < 4; ++m) { bf16_t* rowp = O + (size_t)(row0 + ai * HALF + m * 16) * ldc + col0;
                float v[8];
#pragma unroll
                for (int n = 0; n < 2; ++n)
#pragma unroll
                    for (int e = 0; e < 4; ++e) { const float g = acc[ai][0][m][n][e], uu = acc[ai][1][m][n][e];
                        v[n * 4 + e] = g * __builtin_amdgcn_rcpf(1.0f + __builtin_amdgcn_exp2f(-1.4426950408889634f * g)) * uu; }
                u32x4 w; w.x = cvt_pk_bf16(v[0], v[1]); w.y = cvt_pk_bf16(v[2], v[3]); w.z = cvt_pk_bf16(v[4], v[5]); w.w = cvt_pk_bf16(v[6], v[7]);
                *(u32x4*)rowp = w; }
    }
};
template <class Epi, class Sched, bool ALIGN_EPI = false, bool SP2 = false>
__device__ __forceinline__ void gemm_phase(PG8_LAS unsigned char* lds, const Gemm g, const Sched& S, const Epi& E) {
    int tid_ = threadIdx.x; asm volatile("" : "+v"(tid_));
    const int tid = tid_, wid = __builtin_amdgcn_readfirstlane(tid >> 6), lane = tid & 63, wr = wid >> 2, wc = wid & 3, fr = lane & 15, fq = lane >> 4;
    const int K = g.K, nt = K / BK;
    unsigned voffA[2], voffB[2];
#pragma unroll
    for (int i = 0; i < 2; ++i) { int R, C; stage_rc(tid * 16 + i * 8192, R, C); const int Rb = Epi::PERM ? ((R & ~31) + perm32(R & 31)) : R;
        voffA[i] = (unsigned)(R * K + C) * 2u; voffB[i] = (unsigned)(Rb * K + C) * 2u; }
    const size_t kstep = (size_t)(BK * 2);
    const size_t hstep = (size_t)HALF * K * 2;
    const size_t tstep = 2 * hstep;
    const unsigned ldsw = (unsigned)wid * 1024u;
    const int aoff = lds_byte(wr * 64 + fr, fq * 8), boff = lds_byte(wc * 32 + fr, fq * 8);
#define PG8_SA(b, h) (((b) * 2 + (h)) * HTB)
#define PG8_SB(b, h) ((4 + (b) * 2 + (h)) * HTB)
#define PG8_STAGE(bufoff, gbase, voff) do { _Pragma("unroll") for (int _i = 0; _i < 2; ++_i) \
        __builtin_amdgcn_global_load_lds((const unsigned*)((const char*)(gbase) + (voff)[_i]), (PG8_LAS unsigned*)(lds + (bufoff) + ldsw + _i * 8192), 16, 0, 0); } while (0)
#define PG8_LDA(dst, b, h) do { _Pragma("unroll") for (int m = 0; m < 4; ++m) _Pragma("unroll") for (int k = 0; k < 2; ++k) dst[m][k] = *(const PG8_LAS bf16x8*)(lds + PG8_SA(b, h) + aoff + m * 2048 + k * 1024); } while (0)
#define PG8_LDB(dst, b, h) do { _Pragma("unroll") for (int n = 0; n < 2; ++n) _Pragma("unroll") for (int k = 0; k < 2; ++k) dst[n][k] = *(const PG8_LAS bf16x8*)(lds + PG8_SB(b, h) + boff + n * 2048 + k * 1024); } while (0)
#define PG8_MMA(ai, bj, At, Bt) do { __builtin_amdgcn_s_setprio(1); _Pragma("unroll") for (int m = 0; m < 4; ++m) _Pragma("unroll") for (int n = 0; n < 2; ++n) _Pragma("unroll") for (int k = 0; k < 2; ++k) \
        acc[ai][bj][m][n] = __builtin_amdgcn_mfma_f32_16x16x32_bf16(Bt[n][k], At[m][k], acc[ai][bj][m][n], 0, 0, 0); __builtin_amdgcn_s_setprio(0); } while (0)
#define PG8_WAIT_V(n) asm volatile("s_waitcnt vmcnt(" #n ")" ::: "memory")
#define PG8_WAIT_L(n) asm volatile("s_waitcnt lgkmcnt(" #n ")" ::: "memory")
#define PG8_BAR __builtin_amdgcn_s_barrier()
#define PG8_SCHED __builtin_amdgcn_sched_barrier(0)
    Unit cur, nxt; int ui = 0;
    if (!S.next(0, cur)) return;
    f32x4 acc[2][2][4][2];
#pragma unroll
    for (int a = 0; a < 2; ++a)
#pragma unroll
        for (int b = 0; b < 2; ++b)
#pragma unroll
            for (int m = 0; m < 4; ++m)
#pragma unroll
                for (int n = 0; n < 2; ++n) acc[a][b][m][n] = (f32x4){0.f, 0.f, 0.f, 0.f};
    bf16x8 At[4][2], B0[2][2], B1[2][2];
    const char* cA = (const char*)g.A + (size_t)cur.pm * tstep; const char* cB = (const char*)g.Bt + (size_t)cur.pn * tstep;
    S.a_ready(cur);
    if constexpr (SP2) {
        PG8_STAGE(PG8_SB(0, 0), cB, voffB); PG8_STAGE(PG8_SB(0, 1), cB + hstep, voffB); PG8_STAGE(PG8_SA(0, 0), cA, voffA); PG8_STAGE(PG8_SA(0, 1), cA + hstep, voffA);
        if (wr == 1) PG8_BAR;
        PG8_WAIT_V(2); PG8_BAR;
        PG8_STAGE(PG8_SB(1, 0), cB + kstep, voffB); PG8_STAGE(PG8_SA(1, 0), cA + kstep, voffA); PG8_STAGE(PG8_SB(1, 1), cB + hstep + kstep, voffB);
        PG8_WAIT_V(6); PG8_BAR;
    } else {
        PG8_STAGE(PG8_SB(0, 0), cB, voffB); PG8_STAGE(PG8_SA(0, 0), cA, voffA); PG8_STAGE(PG8_SB(0, 1), cB + hstep, voffB); PG8_STAGE(PG8_SA(0, 1), cA + hstep, voffA);
        if (wr == 1) PG8_BAR;
        PG8_WAIT_V(4); PG8_BAR;
        PG8_STAGE(PG8_SB(1, 0), cB + kstep, voffB); PG8_STAGE(PG8_SA(1, 0), cA + kstep, voffA); PG8_STAGE(PG8_SB(1, 1), cB + hstep + kstep, voffB);
        PG8_WAIT_V(6); PG8_BAR;
    }
    for (;;) {
        const bool has_next = S.next(ui + 1, nxt);
        const char* nA = has_next ? (const char*)g.A + (size_t)nxt.pm * tstep : cA; const char* nB = has_next ? (const char*)g.Bt + (size_t)nxt.pn * tstep : cB;
        for (int t = 0; t < nt; t += 2) {
            const bool last = (t == nt - 2);
            const char* a1 = cA + (size_t)(t + 1) * kstep;
            const char* a2 = last ? nA : cA + (size_t)(t + 2) * kstep; const char* b2 = last ? nB : cB + (size_t)(t + 2) * kstep;
            const char* a3 = a2 + kstep; const char* b3 = b2 + kstep;
            if (last && has_next) S.a_ready(nxt);
            if constexpr (SP2) {
            PG8_LDB(B0, 0, 0); PG8_LDB(B1, 0, 1); PG8_SCHED; PG8_LDA(At, 0, 0); PG8_STAGE(PG8_SA(1, 1), a1 + hstep, voffA);
            PG8_WAIT_V(8); PG8_WAIT_L(0); PG8_BAR; PG8_MMA(0, 0, At, B0); PG8_MMA(0, 1, At, B1); PG8_BAR; PG8_SCHED;
            PG8_LDA(At, 0, 1); PG8_STAGE(PG8_SB(0, 0), b2, voffB); PG8_STAGE(PG8_SB(0, 1), b2 + hstep, voffB); PG8_STAGE(PG8_SA(0, 0), a2, voffA);
            PG8_WAIT_V(8); PG8_WAIT_L(0); PG8_BAR; PG8_MMA(1, 0, At, B0); PG8_MMA(1, 1, At, B1); PG8_BAR; PG8_SCHED;
            PG8_LDB(B0, 1, 0); PG8_LDB(B1, 1, 1); PG8_SCHED; PG8_LDA(At, 1, 0); PG8_STAGE(PG8_SA(0, 1), a2 + hstep, voffA);
            PG8_WAIT_V(8); PG8_WAIT_L(0); PG8_BAR; PG8_MMA(0, 0, At, B0); PG8_MMA(0, 1, At, B1); PG8_BAR; PG8_SCHED;
            PG8_LDA(At, 1, 1); PG8_STAGE(PG8_SB(1, 0), b3, voffB); PG8_STAGE(PG8_SB(1, 1), b3 + hstep, voffB); PG8_STAGE(PG8_SA(1, 0), a3, voffA);
            PG8_WAIT_V(8); PG8_WAIT_L(0); PG8_BAR; PG8_MMA(1, 0, At, B0); PG8_MMA(1, 1, At, B1); PG8_BAR; PG8_SCHED;
            } else {
            PG8_LDB(B0, 0, 0); PG8_SCHED; PG8_LDA(At, 0, 0); PG8_STAGE(PG8_SA(1, 1), a1 + hstep, voffA);
            PG8_WAIT_L(8); PG8_BAR; PG8_WAIT_L(0); PG8_MMA(0, 0, At, B0); PG8_BAR; PG8_SCHED;
            PG8_LDB(B1, 0, 1); PG8_STAGE(PG8_SB(0, 0), b2, voffB);
            PG8_BAR; PG8_WAIT_L(0); PG8_MMA(0, 1, At, B1); PG8_BAR;
            PG8_LDA(At, 0, 1); PG8_STAGE(PG8_SA(0, 0), a2, voffA);
            PG8_BAR; PG8_WAIT_L(0); PG8_MMA(1, 0, At, B0); PG8_BAR; PG8_SCHED;
            PG8_STAGE(PG8_SB(0, 1), b2 + hstep, voffB);
            PG8_WAIT_V(6); PG8_BAR; PG8_MMA(1, 1, At, B1); PG8_BAR;
            PG8_LDB(B0, 1, 0); PG8_SCHED; PG8_LDA(At, 1, 0); PG8_STAGE(PG8_SA(0, 1), a2 + hstep, voffA);
            PG8_WAIT_L(8); PG8_BAR; PG8_WAIT_L(0); PG8_MMA(0, 0, At, B0); PG8_BAR; PG8_SCHED;
            PG8_LDB(B1, 1, 1); PG8_STAGE(PG8_SB(1, 0), b3, voffB);
            PG8_BAR; PG8_WAIT_L(0); PG8_MMA(0, 1, At, B1); PG8_BAR;
            PG8_LDA(At, 1, 1); PG8_STAGE(PG8_SA(1, 0), a3, voffA);
            PG8_BAR; PG8_WAIT_L(0); PG8_MMA(1, 0, At, B0); PG8_BAR; PG8_SCHED;
            PG8_STAGE(PG8_SB(1, 1), b3 + hstep, voffB);
            PG8_WAIT_V(6); PG8_BAR; PG8_MMA(1, 1, At, B1); PG8_BAR;
            }
        }
        if constexpr (ALIGN_EPI) { if (wr == 0) PG8_BAR; }
        if constexpr (!Epi::AFTER_DRAIN) { E(acc, cur, wr, wc, fr, fq); S.done(cur); }
        if (!has_next) break;
#pragma unroll
        for (int a = 0; a < 2; ++a)
#pragma unroll
            for (int b = 0; b < 2; ++b)
#pragma unroll
                for (int m = 0; m < 4; ++m)
#pragma unroll
                    for (int n = 0; n < 2; ++n) acc[a][b][m][n] = (f32x4){0.f, 0.f, 0.f, 0.f};
        cur = nxt; cA = nA; cB = nB; ++ui;
        if constexpr (ALIGN_EPI) { if (wr == 1) PG8_BAR; }
    }
    PG8_WAIT_V(0);
    if constexpr (!ALIGN_EPI) { if (wr == 0) PG8_BAR; }
    PG8_BAR;
    if constexpr (Epi::AFTER_DRAIN) { E.fused(acc, cur, wr, wc, fr, fq, lds, wid, lane); S.done(cur); }
#undef PG8_SA
#undef PG8_SB
#undef PG8_STAGE
#undef PG8_LDA
#undef PG8_LDB
#undef PG8_MMA
#undef PG8_WAIT_V
#undef PG8_WAIT_L
#undef PG8_BAR
#undef PG8_SCHED
}
}

__device__ __forceinline__ float wave_sum(float v) {
#pragma unroll
    for (int o = 1; o < 64; o <<= 1) v += __shfl_xor(v, o);
    return v;
}
__device__ __forceinline__ float wave_max(float v) {
#pragma unroll
    for (int o = 1; o < 64; o <<= 1) v = fmaxf(v, __shfl_xor(v, o));
    return v;
}
__device__ __forceinline__ float silu_f(float v) { return v / (1.f + __expf(-v)); }

struct Args {
    const float* x; const float* c; const float* rel_bias; const float* ada_w; const float* ada_b; const float* norm_g;
    const float* moba_w_qkv; const float* moba_w_o; const float* diff_w_qkv; const float* diff_w_o;
    const float* diff_lambda; const float* diff_subln_g; const float* ffn_w_in; const float* ffn_w_out;
    float* out; unsigned char* ws;
};

__device__ __forceinline__ int t5_bucket(int rel) {
    const int n = rel < 0 ? 0 : rel;
    const float nf = (float)(n < 1 ? 1 : n);
    int large = 16 + (int)(logf(nf / 16.0f) / 4.852030263919617f * 16.0f);
    large = large < 31 ? large : 31;
    return n < 16 ? n : large;
}

__device__ __forceinline__ void p_mod(const Args& a, LAS unsigned char* lds, int blk, int G, int tid, int wave, int lane) {
    LAS float* sc = (LAS float*)lds;
    LAS float* red = sc + 2048;
    for (int i = tid; i < 2048; i += NTHR) sc[i] = silu_f(a.c[i]);
    __syncthreads();
    float* mod = (float*)(a.ws + WS_MOD);
    for (int it = blk; it < 192; it += G) {
        const int l = it / 96, j0 = (it % 96) * 64;
        const float* w = a.ada_w + (size_t)l * D * 6144 + j0 + lane;
        float s0 = 0.f, s1 = 0.f;
#pragma unroll 1
        for (int kb = wave * 128; kb < wave * 128 + 128; kb += 32) { float wv[32];
#pragma unroll
            for (int k = 0; k < 32; ++k) wv[k] = w[(size_t)(kb + k) * 6144];
#pragma unroll
            for (int k = 0; k < 32; ++k) { s0 += sc[kb + k] * wv[k]; s1 += sc[1024 + kb + k] * wv[k]; } }
        red[(wave * 2 + 0) * 64 + lane] = s0; red[(wave * 2 + 1) * 64 + lane] = s1;
        __syncthreads();
        if (tid < 128) { const int bb = tid >> 6, cl = tid & 63; float sum = 0.f;
#pragma unroll
            for (int w8 = 0; w8 < 8; ++w8) sum += red[(w8 * 2 + bb) * 64 + cl];
            mod[(l * 2 + bb) * 6144 + j0 + cl] = sum + a.ada_b[l * 6144 + j0 + cl]; }
        __syncthreads();
    }
    float* bt = (float*)(a.ws + WS_BIAST);
    for (int i = blk * NTHR + tid; i < 8 * 2304; i += G * NTHR) { const int h = i / 2304, rel = 2047 - (i % 2304); bt[i] = rel >= 0 ? a.rel_bias[t5_bucket(rel) * NH + h] * LOG2E : 0.f; }
}

__device__ __forceinline__ void transpose_item(const float* W, int K, int N, int k0, int n0, bf16* WT, int dst_row0, LAS float* scr, int lane) {
    float tv[32];
#pragma unroll
    for (int i = 0; i < 32; ++i) tv[i] = W[(size_t)(k0 + 2 * i + (lane >> 5)) * N + n0 + (lane & 31)];
#pragma unroll
    for (int i = 0; i < 32; ++i) scr[(2 * i + (lane >> 5)) * 33 + (lane & 31)] = tv[i];
    asm volatile("s_waitcnt lgkmcnt(0)" ::: "memory");
    const int c = lane & 7;
#pragma unroll
    for (int j = 0; j < 4; ++j) { const int n = (lane >> 3) + 8 * j; const LAS float* sp = scr + (8 * c) * 33 + n;
        u32x4 o; o.x = pk2(sp[0 * 33], sp[1 * 33]); o.y = pk2(sp[2 * 33], sp[3 * 33]); o.z = pk2(sp[4 * 33], sp[5 * 33]); o.w = pk2(sp[6 * 33], sp[7 * 33]);
        *(u32x4*)(WT + (size_t)(dst_row0 + n) * K + k0 + 8 * c) = o; }
    asm volatile("s_waitcnt lgkmcnt(0)" ::: "memory");
}
__device__ __forceinline__ void p_weights(const Args& a, LAS unsigned char* lds, int gw, int ngw, int wave, int lane) {
    LAS float* scr = (LAS float*)(lds + wave * 16384);
    constexpr int I_QKV = (D / 64) * (3 * D / 32), I_O = (D / 64) * (D / 32), I_IN = (D / 64) * (2 * DFF / 32), I_OUT = (DFF / 64) * (D / 32);
    constexpr int PER_L = I_QKV + I_O + I_IN + I_OUT;
    for (int it = gw; it < 2 * PER_L; it += ngw) {
        const int l = it / PER_L; int r = it % PER_L;
        unsigned char* wl = a.ws + WS_W + (size_t)l * WL_STRIDE;
        if (r < I_QKV) { const int nb = 3 * D / 32, kb = r / nb, n0 = (r % nb) * 32; transpose_item(l == 0 ? a.moba_w_qkv : a.diff_w_qkv, D, 3 * D, kb * 64, n0, (bf16*)(wl + WO_QKV), n0, scr, lane); continue; } r -= I_QKV;
        if (r < I_O) { const int nb = D / 32, kb = r / nb, n0 = (r % nb) * 32; transpose_item(l == 0 ? a.moba_w_o : a.diff_w_o, D, D, kb * 64, n0, (bf16*)(wl + WO_O), n0, scr, lane); continue; } r -= I_O;
        if (r < I_IN) { const int nb = 2 * DFF / 32, kb = r / nb, n0 = (r % nb) * 32;
            const int isu = n0 >= DFF ? 1 : 0, nn = n0 - isu * DFF, dst = 256 * (nn / 128) + 128 * isu + (nn % 128);
            transpose_item(a.ffn_w_in + (size_t)l * D * 2 * DFF, D, 2 * DFF, kb * 64, n0, (bf16*)(wl + WO_IN), dst, scr, lane); continue; } r -= I_IN;
        { const int nb = D / 32, kb = r / nb, n0 = (r % nb) * 32; transpose_item(a.ffn_w_out + (size_t)l * DFF * D, DFF, D, kb * 64, n0, (bf16*)(wl + WO_OUT), n0, scr, lane); }
    }
}

__device__ __forceinline__ void p_norm_in(const float* X, const float* g, const float* sh, const float* sc, bf16* H, int gw, int ngw, int lane) {
    for (int m = gw; m < M; m += ngw) {
        const int b = m / SEQ;
        const f32x4* xr = (const f32x4*)(X + (size_t)m * D) + lane;
        f32x4 v[4]; float s = 0.f;
#pragma unroll
        for (int j = 0; j < 4; ++j) { v[j] = xr[64 * j]; s += (v[j].x * v[j].x + v[j].y * v[j].y) + (v[j].z * v[j].z + v[j].w * v[j].w); }
        const float r = 1.0f / sqrtf(wave_sum(s) * (1.f / D) + RMS_EPS);
        u32x2* o = (u32x2*)(H + (size_t)m * D) + lane;
#pragma unroll
        for (int j = 0; j < 4; ++j) {
            const f32x4 gg = ((const f32x4*)g)[lane + 64 * j], s1 = ((const f32x4*)(sc + b * 6144))[lane + 64 * j], s0 = ((const f32x4*)(sh + b * 6144))[lane + 64 * j];
            const f32x4 h = v[j] * r * gg * (1.0f + s1) + s0;
            u32x2 w; w.x = pk2(h.x, h.y); w.y = pk2(h.z, h.w); o[64 * j] = w;
        }
    }
}
__device__ __forceinline__ void p_post(const float* Xin, const bf16* Y, const float* g1, const float* gate, float* Xout,
                                       const float* g2, const float* sh, const float* sc, bf16* H, int gw, int ngw, int lane) {
    for (int m = gw; m < M; m += ngw) {
        const int b = m / SEQ;
        const u32x2* yr = (const u32x2*)(Y + (size_t)m * D) + lane;
        const f32x4* xr = (const f32x4*)(Xin + (size_t)m * D) + lane;
        f32x4 y[4], xv[4]; float s = 0.f;
#pragma unroll
        for (int j = 0; j < 4; ++j) { const u32x2 w = yr[64 * j]; y[j] = (f32x4){bflo(w.x), bfhi(w.x), bflo(w.y), bfhi(w.y)}; xv[j] = xr[64 * j];
            s += (y[j].x * y[j].x + y[j].y * y[j].y) + (y[j].z * y[j].z + y[j].w * y[j].w); }
        const float r = 1.0f / sqrtf(wave_sum(s) * (1.f / D) + RMS_EPS);
        float s2 = 0.f;
#pragma unroll
        for (int j = 0; j < 4; ++j) {
            const f32x4 gg = ((const f32x4*)g1)[lane + 64 * j], gt = ((const f32x4*)(gate + b * 6144))[lane + 64 * j];
            xv[j] = xv[j] + gt * (y[j] * r * gg);
            s2 += (xv[j].x * xv[j].x + xv[j].y * xv[j].y) + (xv[j].z * xv[j].z + xv[j].w * xv[j].w);
            ((f32x4*)(Xout + (size_t)m * D))[lane + 64 * j] = xv[j];
        }
        if (H) {
            const float r2 = 1.0f / sqrtf(wave_sum(s2) * (1.f / D) + RMS_EPS);
            u32x2* o = (u32x2*)(H + (size_t)m * D) + lane;
#pragma unroll
            for (int j = 0; j < 4; ++j) {
                const f32x4 gg = ((const f32x4*)g2)[lane + 64 * j], s1 = ((const f32x4*)(sc + b * 6144))[lane + 64 * j], s0 = ((const f32x4*)(sh + b * 6144))[lane + 64 * j];
                const f32x4 h = xv[j] * r2 * gg * (1.0f + s1) + s0;
                u32x2 w; w.x = pk2(h.x, h.y); w.y = pk2(h.z, h.w); o[64 * j] = w;
            }
        }
    }
}

__device__ __forceinline__ void p_kmean(const bf16* Kb, float* kmean, LAS unsigned char* lds, int blk, int G, int tid, int wave, int lane) {
    LAS float* red = (LAS float*)lds;
    for (int it = blk; it < BATCH * NH * 32; it += G) {
        const int b = it >> 8, h = (it >> 5) & 7, kb = it & 31;
        const bf16* p = Kb + ((size_t)b * SEQ + kb * 256 + wave * 32) * D + h * HD + 2 * lane;
        float s0 = 0.f, s1 = 0.f;
#pragma unroll 8
        for (int r = 0; r < 32; ++r) { const unsigned w = *(const unsigned*)(p + (size_t)r * D); s0 += bflo(w); s1 += bfhi(w); }
        red[wave * 128 + 2 * lane] = s0; red[wave * 128 + 2 * lane + 1] = s1;
        __syncthreads();
        if (tid < 128) { float sum = 0.f;
#pragma unroll
            for (int w8 = 0; w8 < 8; ++w8) sum += red[w8 * 128 + tid];
            kmean[(size_t)it * 128 + tid] = sum * (1.0f / 256.0f); }
        __syncthreads();
    }
}
__device__ __forceinline__ void p_gate(const bf16* Qb, const float* kmean, unsigned* sel, unsigned* cnt, unsigned short* lists, LAS unsigned char* lds, int blk, int G, int tid, int wave, int lane) {
    LAS float* km = (LAS float*)lds;
    for (int it = blk; it < 256; it += G) {
        const int bh = it >> 4, span = it & 15, b = bh >> 3, h = bh & 7;
        __syncthreads();
        for (int i = tid; i < 1024; i += NTHR) ((LAS f32x4*)km)[i] = ((const f32x4*)(kmean + (size_t)bh * 4096))[i];
        __syncthreads();
        const int q = span * 512 + wave * 64 + lane, own = (span * 512 + wave * 64) >> 8;
        unsigned mask;
        if (own <= 3) mask = (1u << own) - 1u;
        else {
            float qf[128];
            const u32x4* qp = (const u32x4*)(Qb + ((size_t)b * SEQ + q) * D + h * HD);
#pragma unroll
            for (int c = 0; c < 16; ++c) { const u32x4 w = qp[c]; qf[c * 8 + 0] = bflo(w.x); qf[c * 8 + 1] = bfhi(w.x); qf[c * 8 + 2] = bflo(w.y); qf[c * 8 + 3] = bfhi(w.y);
                qf[c * 8 + 4] = bflo(w.z); qf[c * 8 + 5] = bfhi(w.z); qf[c * 8 + 6] = bflo(w.w); qf[c * 8 + 7] = bfhi(w.w); }
            float b0 = -3e38f, b1 = -3e38f, b2 = -3e38f; int i0 = 0, i1 = 0, i2 = 0;
#pragma unroll 1
            for (int n = 0; n < own; ++n) {
                float g0 = 0.f, g1 = 0.f, g2 = 0.f, g3 = 0.f;
#pragma unroll
                for (int d = 0; d < 128; d += 4) { const f32x4 kv = *(LAS f32x4*)(km + n * 128 + d); g0 += qf[d] * kv.x; g1 += qf[d + 1] * kv.y; g2 += qf[d + 2] * kv.z; g3 += qf[d + 3] * kv.w; }
                const float g = (g0 + g1) + (g2 + g3);
                if (g > b0) { b2 = b1; i2 = i1; b1 = b0; i1 = i0; b0 = g; i0 = n; }
                else if (g > b1) { b2 = b1; i2 = i1; b1 = g; i1 = n; }
                else if (g > b2) { b2 = g; i2 = n; }
            }
            mask = (1u << i0) | (1u << i1) | (1u << i2);
        }
        sel[(size_t)bh * SEQ + q] = mask;
        unsigned mycnt = 0u;
        for (int j = 0; j < own; ++j) { const unsigned long long bl = __ballot((mask >> j) & 1u); if (lane == j) mycnt = (unsigned)__popcll(bl); }
        unsigned base = 0u;
        if (lane < own && mycnt) base = __hip_atomic_fetch_add(cnt + bh * 32 + lane, mycnt, __ATOMIC_RELAXED, __HIP_MEMORY_SCOPE_AGENT);
        for (int j = 0; j < own; ++j) { const unsigned long long bl = __ballot((mask >> j) & 1u); const unsigned bj = (unsigned)__shfl((int)base, j);
            if ((mask >> j) & 1u) lists[((size_t)bh * 32 + j) * 8192 + bj + (unsigned)__popcll(bl & ((1ull << lane) - 1ull))] = (unsigned short)q; }
    }
}

namespace att {
typedef short bf16x8 __attribute__((ext_vector_type(8)));
typedef short s16x4 __attribute__((ext_vector_type(4)));
typedef float f32x16 __attribute__((ext_vector_type(16)));
typedef LAS const char* lcp;
constexpr int PITCH = 1024;
constexpr int SHM_V = 16384, SHM_K = 16384;
constexpr int L_K = 0, L_V = 49152, L_WS = 98304, L_LUT = 100352;
constexpr int LUTN = 2304, RMAXL = 2047, RFAR = 1536;
#define KSWZ(row, colB) ((row) * 256 + ((colB) ^ (((row) & 7) << 4)))
#define SBAR() __builtin_amdgcn_sched_barrier(0)
__device__ __forceinline__ int v_st(int k, int c) { const int kk = (k & ~0xC) | ((k & 4) << 1) | ((k & 8) >> 1); return ((kk >> 3) * 4 + (c >> 5)) * 512 + ((kk & 7) * 32 + (c & 31)) * 2; }
__device__ __forceinline__ int v_rd_base(int lane) { return ((lane & 3) << 3) | (((lane >> 2) & 3) << 6) | (((lane >> 4) & 1) << 5) | (((lane >> 5) & 1) << 8); }
constexpr int v_rd_off(int d0, int ks, int half) { return d0 * 512 + ks * 4096 + half * 2048; }
__device__ __forceinline__ int crow(int r, int hi) { return (r & 3) + 8 * (r >> 2) + 4 * hi; }
__device__ __forceinline__ unsigned cvtpk(float lo, float hi) { unsigned r; asm volatile("v_cvt_pk_bf16_f32 %0, %1, %2" : "=v"(r) : "v"(lo), "v"(hi)); return r; }

template <int KB, int NDS>
__device__ __forceinline__ void qkt(f32x16& p0, f32x16& p1, lcp K_lds, int r32, int hi, int coff, const bf16x8* qr) {
    p0 = f32x16{}; p1 = f32x16{};
    lcp kb[4];
#pragma unroll
    for (int dd = 0; dd < 4; ++dd) kb[dd] = K_lds + KB * SHM_K + KSWZ(r32, (dd * 16 + hi * 8) * 2) + coff;
#pragma unroll
    for (int d0 = 0; d0 < NDS; ++d0) { lcp a = kb[d0 & 3] + (d0 >> 2) * 128;
        const bf16x8 b0 = *(LAS const bf16x8*)a;
        const bf16x8 b1 = *(LAS const bf16x8*)(a + 32 * 256);
        p0 = __builtin_amdgcn_mfma_f32_32x32x16_bf16(b0, qr[d0], p0, 0, 0, 0);
        p1 = __builtin_amdgcn_mfma_f32_32x32x16_bf16(b1, qr[d0], p1, 0, 0, 0);
        if (NDS == 8 && (d0 & 1) == 1) SBAR(); }
}
template <int VB>
__device__ __forceinline__ void pv_tile(f32x16* o, int vb0, bf16x8 pa0, bf16x8 pa1, bf16x8 pa2, bf16x8 pa3) {
#define TRRD(dst, off) asm volatile("ds_read_b64_tr_b16 %0, %1 offset:%2" : "=&v"(dst) : "v"(vb0), "i"(off) : "memory")
#define PV_D0(d0) do { s16x4 l0, l1, l2, l3, h0, h1, h2, h3; constexpr int b_ = VB * SHM_V + v_rd_off(d0, 0, 0); \
        TRRD(l0, b_); TRRD(h0, b_ + 2048); TRRD(l1, b_ + 4096); TRRD(h1, b_ + 6144); TRRD(l2, b_ + 8192); TRRD(h2, b_ + 10240); TRRD(l3, b_ + 12288); TRRD(h3, b_ + 14336); \
        asm volatile("s_waitcnt lgkmcnt(0)" ::: "memory"); SBAR(); \
        o[d0] = __builtin_amdgcn_mfma_f32_32x32x16_bf16(pa0, (bf16x8){l0[0], l0[1], l0[2], l0[3], h0[0], h0[1], h0[2], h0[3]}, o[d0], 0, 0, 0); \
        o[d0] = __builtin_amdgcn_mfma_f32_32x32x16_bf16(pa1, (bf16x8){l1[0], l1[1], l1[2], l1[3], h1[0], h1[1], h1[2], h1[3]}, o[d0], 0, 0, 0); \
        o[d0] = __builtin_amdgcn_mfma_f32_32x32x16_bf16(pa2, (bf16x8){l2[0], l2[1], l2[2], l2[3], h2[0], h2[1], h2[2], h2[3]}, o[d0], 0, 0, 0); \
        o[d0] = __builtin_amdgcn_mfma_f32_32x32x16_bf16(pa3, (bf16x8){l3[0], l3[1], l3[2], l3[3], h3[0], h3[1], h3[2], h3[3]}, o[d0], 0, 0, 0); } while (0)
    PV_D0(0); PV_D0(1); PV_D0(2); PV_D0(3);
#undef PV_D0
#undef TRRD
}
constexpr float THR2 = 8.0f;
__device__ __forceinline__ void partial_sm(f32x16& p0, f32x16& p1, float sh, float& m_reg, float& alpha) {
    float pmax = p0[0];
#pragma unroll
    for (int r = 1; r < 16; ++r) pmax = fmaxf(pmax, p0[r]);
#pragma unroll
    for (int r = 0; r < 16; ++r) pmax = fmaxf(pmax, p1[r]);
    { auto rr = __builtin_amdgcn_permlane32_swap(__float_as_uint(pmax), __float_as_uint(pmax), false, false);
      pmax = fmaxf(__uint_as_float(rr[0]), __uint_as_float(rr[1])); }
    pmax += sh;
    float mn;
    if (__builtin_expect(__all((pmax - m_reg) <= THR2), 1)) { mn = m_reg; alpha = 1.f; }
    else { mn = fmaxf(m_reg, pmax); alpha = __builtin_amdgcn_exp2f(m_reg - mn); m_reg = mn; }
    const float off = mn - sh;
#pragma unroll
    for (int r = 0; r < 16; ++r) p0[r] = __builtin_amdgcn_exp2f(p0[r] - off);
#pragma unroll
    for (int r = 0; r < 16; ++r) p1[r] = p1[r] - off;
}
__device__ __forceinline__ void finish_sm(f32x16& p0, f32x16& p1, float alpha, float& l_reg, bf16x8& pa0, bf16x8& pa1, bf16x8& pa2, bf16x8& pa3) {
#pragma unroll
    for (int r = 0; r < 16; ++r) p1[r] = __builtin_amdgcn_exp2f(p1[r]);
    float ps = 0.f;
#pragma unroll
    for (int r = 0; r < 16; ++r) ps += p0[r];
#pragma unroll
    for (int r = 0; r < 16; ++r) ps += p1[r];
    { auto rr = __builtin_amdgcn_permlane32_swap(__float_as_uint(ps), __float_as_uint(ps), false, false);
      ps = __uint_as_float(rr[0]) + __uint_as_float(rr[1]); }
    l_reg = l_reg * alpha + ps;
#define PK4(P, B_, OUT) do { unsigned a0 = cvtpk(P[B_+0], P[B_+1]), a1 = cvtpk(P[B_+2], P[B_+3]); \
        unsigned b0 = cvtpk(P[B_+4], P[B_+5]), b1 = cvtpk(P[B_+6], P[B_+7]); \
        auto r0 = __builtin_amdgcn_permlane32_swap(a0, b0, false, false); auto r1 = __builtin_amdgcn_permlane32_swap(a1, b1, false, false); \
        u32x4 w = {r0[0], r1[0], r0[1], r1[1]}; OUT = __builtin_bit_cast(bf16x8, w); } while (0)
    PK4(p0, 0, pa0); PK4(p0, 8, pa1); PK4(p1, 0, pa2); PK4(p1, 8, pa3);
#undef PK4
}
__device__ __forceinline__ void softmax_tile(f32x16& p0, f32x16& p1, float sh, float& m_reg, float& l_reg, float& alpha, bf16x8& pa0, bf16x8& pa1, bf16x8& pa2, bf16x8& pa3) {
    partial_sm(p0, p1, sh, m_reg, alpha); finish_sm(p0, p1, alpha, l_reg, pa0, pa1, pa2, pa3);
}
__device__ __forceinline__ void add_bias_lut(f32x16& p0, f32x16& p1, LAS const float* lut, int dq) {
    LAS const float* bp = lut + (RMAXL - dq);
#pragma unroll
    for (int r = 0; r < 16; ++r) { const int c = (r & 3) + 8 * (r >> 2); p0[r] += bp[c]; p1[r] += bp[c + 32]; if ((r & 3) == 3) asm volatile("" ::: "memory"); }
}
__device__ __forceinline__ void causal_mask(f32x16& p0, f32x16& p1, int dq) {
    const float NEG = -__builtin_inff();
#pragma unroll
    for (int r = 0; r < 16; ++r) { const int c = (r & 3) + 8 * (r >> 2); if (dq - c < 0) p0[r] = NEG; if (dq - c - 32 < 0) p1[r] = NEG; }
}
struct DmaOff { unsigned k[2], v[2]; };
__device__ __forceinline__ DmaOff dma_offsets(int wid, int lane) {
    DmaOff d;
#pragma unroll
    for (int i = 0; i < 2; ++i) { const int p = wid * 2 + i;
        { const int row = 4 * p + (lane >> 4), c = (lane & 15) ^ (row & 7); d.k[i] = (unsigned)(row * PITCH * 2 + c * 16); }
        { const int sub = 2 * p + (lane >> 5), kkhi = sub >> 2, cblk = sub & 3, kklo = (lane & 31) >> 2, kk = kkhi * 8 + kklo;
          const int k = (kk & ~0xC) | ((kk & 4) << 1) | ((kk & 8) >> 1), c = cblk * 32 + (lane & 3) * 8; d.v[i] = (unsigned)(k * PITCH * 2 + c * 2); } }
    return d;
}
__device__ __forceinline__ void dma_tile(LAS char* lds, int bf, const bf16* Kc, const bf16* Vc, int k0, const DmaOff& d, int wid) {
    const char* kt = (const char*)Kc + (size_t)k0 * (PITCH * 2); const char* vt = (const char*)Vc + (size_t)k0 * (PITCH * 2);
#pragma unroll
    for (int i = 0; i < 2; ++i) {
        __builtin_amdgcn_global_load_lds((const unsigned*)(kt + d.k[i]), (LAS unsigned*)(lds + L_K + bf * SHM_K + (wid * 2 + i) * 1024), 16, 0, 0);
        __builtin_amdgcn_global_load_lds((const unsigned*)(vt + d.v[i]), (LAS unsigned*)(lds + L_V + bf * SHM_V + (wid * 2 + i) * 1024), 16, 0, 0); }
}
constexpr int L_CF = 109568, L_TAB = 113664, L_FOUND = 115776;
__device__ __forceinline__ void build_lut(LAS char* lds, const float* biasT, int h, int tid) {
    LAS float* lut = (LAS float*)(lds + L_LUT);
    for (int i = tid; i < LUTN; i += 512) lut[i] = biasT[h * LUTN + i];
}

__device__ __forceinline__ void diff_unit(LAS char* lds, int b, int h, int qb, const bf16* Q, const bf16* K, const bf16* V, bf16* O, const float* relb, const float* biasT,
                                          float lam_full, const float* subg, int tid, int wid, int lane) {
    asm volatile("" : "+v"(lane), "+v"(tid));
    const int r32 = lane & 31, hi = lane >> 5, cm = wid >> 2, w4 = wid & 3;
    const size_t rowbase = (size_t)b * SEQ;
    const int q0 = qb * 128, qw0 = q0 + w4 * 32, qpos = qw0 + r32;
    const bf16* Kc = K + rowbase * PITCH + h * HD; const bf16* Vc = V + rowbase * PITCH + h * HD;
    const int NT = (q0 + 128) / 64;
    const DmaOff dmo = dma_offsets(wid, lane);
    const int vb0 = (int)(unsigned)(uintptr_t)(lds + L_V) + v_rd_base(lane);
    LAS float* ws = (LAS float*)(lds + L_WS) + wid * 64;
    LAS const float* lut = (LAS const float*)(lds + L_LUT);
    lcp K_lds = (lcp)(lds + L_K);
    const float b31 = relb[31 * 8 + h] * 1.4426950408889634f;
    build_lut(lds, biasT, h, tid);
    bf16x8 qr[4];
#pragma unroll
    for (int d0 = 0; d0 < 4; ++d0) qr[d0] = *(const bf16x8*)(Q + (rowbase + qpos) * PITCH + h * HD + cm * 64 + d0 * 16 + hi * 8);
    dma_tile(lds, 0, Kc, Vc, 0, dmo, wid);
    dma_tile(lds, 1, Kc, Vc, 64, dmo, wid);
    asm volatile("s_waitcnt vmcnt(0)" ::: "memory");
    __syncthreads();
    float m_reg = -1e30f, l_reg = 0.f; f32x16 o[4] = {};
    f32x16 pA0, pA1, pB0, pB1; float alA, alB; bf16x8 pa0, pa1, pa2, pa3;
#define SCORE_FIX(P0_, P1_, t_, alX) do { const int k0_ = (t_) * 64; float sh_ = 0.f; const int dq_ = qpos - k0_ - 4 * hi; \
        if (qw0 - (k0_ + 63) >= RFAR) sh_ = b31; else add_bias_lut(P0_, P1_, lut, dq_); \
        if (k0_ + 63 > qw0) causal_mask(P0_, P1_, dq_); \
        partial_sm(P0_, P1_, sh_, m_reg, alX); } while (0)
#define RESC(alX) do { if (__any(alX < 1.f)) { if (hi == 0) ws[r32] = alX; asm volatile("s_waitcnt lgkmcnt(0)" ::: "memory"); \
        _Pragma("unroll") for (int d_ = 0; d_ < 4; ++d_) _Pragma("unroll") for (int r = 0; r < 16; ++r) o[d_][r] *= ws[crow(r, hi)]; } } while (0)
    int rk = 1, rv = 0, rn = 2;
#define DIFF_STEP(PX0, PX1, alX, PY0, PY1, alY, t) do { \
        if ((t) + 1 < NT) dma_tile(lds, rn, Kc, Vc, ((t) + 1) * 64, dmo, wid); \
        SBAR(); qkt<0, 4>(PX0, PX1, K_lds + rk * SHM_K, r32, hi, cm * 128, qr); \
        finish_sm(PY0, PY1, alY, l_reg, pa0, pa1, pa2, pa3); SBAR(); \
        pv_tile<0>(o, vb0 + rv * SHM_V, pa0, pa1, pa2, pa3); \
        SCORE_FIX(PX0, PX1, t, alX); \
        asm volatile("s_waitcnt vmcnt(0)" ::: "memory"); __syncthreads(); \
        RESC(alX); \
        rv = rk; rk = rn; rn = (rn == 2) ? 0 : rn + 1; } while (0)
    qkt<0, 4>(pA0, pA1, K_lds, r32, hi, cm * 128, qr);
    SCORE_FIX(pA0, pA1, 0, alA);
    for (int t = 1; t + 1 < NT; t += 2) { DIFF_STEP(pB0, pB1, alB, pA0, pA1, alA, t); DIFF_STEP(pA0, pA1, alA, pB0, pB1, alB, t + 1); }
    DIFF_STEP(pB0, pB1, alB, pA0, pA1, alA, NT - 1);
    finish_sm(pB0, pB1, alB, l_reg, pa0, pa1, pa2, pa3); SBAR();
    pv_tile<0>(o, vb0 + rv * SHM_V, pa0, pa1, pa2, pa3);
    __syncthreads();
#undef DIFF_STEP
#undef RESC
#undef SCORE_FIX
    if (hi == 0) ws[32 + r32] = l_reg; asm volatile("s_waitcnt lgkmcnt(0)" ::: "memory");
#pragma unroll
    for (int r = 0; r < 16; ++r) { const float rl = __builtin_amdgcn_rcpf(ws[32 + crow(r, hi)]);
#pragma unroll
        for (int d0 = 0; d0 < 4; ++d0) o[d0][r] *= rl; }
    LAS float* xch = (LAS float*)lds + (size_t)w4 * 64 * 64;
    if (cm == 1) {
#pragma unroll
        for (int d0 = 0; d0 < 4; ++d0)
#pragma unroll
            for (int r = 0; r < 16; ++r) xch[(d0 * 16 + r) * 64 + lane] = o[d0][r];
    }
    __syncthreads();
    if (cm == 0) {
        float ss[16];
#pragma unroll
        for (int r = 0; r < 16; ++r) { float a = 0.f;
#pragma unroll
            for (int d0 = 0; d0 < 4; ++d0) { o[d0][r] -= lam_full * xch[(d0 * 16 + r) * 64 + lane]; a += o[d0][r] * o[d0][r]; }
            ss[r] = a; }
#pragma unroll
        for (int r = 0; r < 16; ++r) {
#pragma unroll
            for (int sft = 1; sft < 32; sft <<= 1) ss[r] += __shfl_xor(ss[r], sft); }
        float gg[4];
#pragma unroll
        for (int d0 = 0; d0 < 4; ++d0) gg[d0] = subg[d0 * 32 + r32] * (1.0f - LAMBDA_INIT);
        bf16* Ow = O + (rowbase + qw0) * PITCH + h * HD;
#pragma unroll
        for (int r = 0; r < 16; ++r) { const int orow = crow(r, hi); const float rs = 1.0f / sqrtf(ss[r] * (1.0f / HD) + RMS_EPS);
#pragma unroll
            for (int d0 = 0; d0 < 4; ++d0) { const float v = o[d0][r] * rs * gg[d0]; const float vn = __shfl_xor(v, 1);
                if ((r32 & 1) == 0) *(unsigned*)(Ow + (size_t)orow * PITCH + d0 * 32 + r32) = cvtpk(v, vn); } }
    }
    __syncthreads();
}


__device__ __forceinline__ void moba_part_item(LAS char* lds, int bh, int j, int chunk, int cntj, const bf16* Q, const bf16* K, const bf16* V, const unsigned short* lists, const unsigned* sel,
                                               bf16* P0, bf16* P1, bf16* P2, f32x2* ml, const float* relb, int tid, int wid, int lane) {
    asm volatile("" : "+v"(lane), "+v"(tid));
    const int r32 = lane & 31, hi = lane >> 5, b = bh >> 3, h = bh & 7;
    const size_t rowbase = (size_t)b * SEQ;
    const int idx = chunk * 256 + wid * 32 + r32; const bool valid = idx < cntj;
    const int qpos = (int)lists[((size_t)bh * 32 + j) * 8192 + (valid ? idx : cntj - 1)];
    const unsigned smask = sel[(size_t)bh * SEQ + qpos]; const int slot = __popc(smask & ((1u << j) - 1u));
    const bf16* Kc = K + (rowbase + j * 256) * PITCH + h * HD; const bf16* Vc = V + (rowbase + j * 256) * PITCH + h * HD;
    const DmaOff dmo = dma_offsets(wid, lane);
    const int vb0 = (int)(unsigned)(uintptr_t)(lds + L_V) + v_rd_base(lane);
    LAS float* ws = (LAS float*)(lds + L_WS) + wid * 64;
    LAS const float* lut = (LAS const float*)(lds + L_LUT);
    lcp K_lds = (lcp)(lds + L_K);
    const float b31 = relb[31 * 8 + h] * 1.4426950408889634f;
    dma_tile(lds, 0, Kc, Vc, 0, dmo, wid);
    bf16x8 qr[8];
#pragma unroll
    for (int d0 = 0; d0 < 8; ++d0) qr[d0] = *(const bf16x8*)(Q + (rowbase + qpos) * PITCH + h * HD + d0 * 16 + hi * 8);
    if (hi == 0) ((LAS int*)ws)[32 + r32] = valid ? (int)((unsigned)(rowbase + qpos) | ((unsigned)slot << 24)) : -1;
    asm volatile("s_waitcnt vmcnt(0)" ::: "memory");
    __syncthreads();
    float m_reg = -1e30f, l_reg = 0.f; f32x16 o[4] = {};
#define PART_STEP(t, BF) do { const int k0_ = j * 256 + (t) * 64; \
        if ((t) + 1 < 4) dma_tile(lds, (BF) ^ 1, Kc, Vc, (t) * 64 + 64, dmo, wid); \
        { f32x16 p0, p1; bf16x8 pa0, pa1, pa2, pa3; float alpha, sh = 0.f; \
            qkt<BF, 8>(p0, p1, K_lds, r32, hi, 0, qr); \
            const int dq_ = qpos - k0_ - 4 * hi; \
            if (__all(qpos - (k0_ + 63) >= RFAR)) sh = b31; else add_bias_lut(p0, p1, lut, dq_ < RFAR + 63 ? dq_ : RFAR + 63); \
            softmax_tile(p0, p1, sh, m_reg, l_reg, alpha, pa0, pa1, pa2, pa3); \
            if (__any(alpha < 1.f)) { if (hi == 0) ws[r32] = alpha; asm volatile("s_waitcnt lgkmcnt(0)" ::: "memory"); \
                _Pragma("unroll") for (int d_ = 0; d_ < 4; ++d_) _Pragma("unroll") for (int r = 0; r < 16; ++r) o[d_][r] *= ws[crow(r, hi)]; } \
            pv_tile<BF>(o, vb0, pa0, pa1, pa2, pa3); } \
        asm volatile("s_waitcnt vmcnt(0)" ::: "memory"); \
        __syncthreads(); } while (0)
    PART_STEP(0, 0); PART_STEP(1, 1); PART_STEP(2, 0); PART_STEP(3, 1);
#undef PART_STEP
    if (hi == 0) { ws[r32] = l_reg; if (valid) ml[((size_t)slot * M + rowbase + qpos) * NH + h] = (f32x2){m_reg, l_reg}; }
    asm volatile("s_waitcnt lgkmcnt(0)" ::: "memory");
#pragma unroll
    for (int r = 0; r < 16; ++r) { const int orow = crow(r, hi); const float rl = __builtin_amdgcn_rcpf(ws[orow]); const int info = ((LAS const int*)ws)[32 + orow];
        const int sl = info >> 24; bf16* Pb = sl == 0 ? P0 : (sl == 1 ? P1 : P2); bf16* Ow = Pb + (size_t)(info & 0xffffff) * PITCH + h * HD;
#pragma unroll
        for (int d0 = 0; d0 < 4; ++d0) { const float v = o[d0][r] * rl; const float vn = __shfl_xor(v, 1);
            if (info >= 0 && (r32 & 1) == 0) *(unsigned*)(Ow + d0 * 32 + r32) = cvtpk(v, vn); } }
    __syncthreads();
}
__device__ __forceinline__ void moba_own_unit(LAS char* lds, int b, int h, int qb, const bf16* Q, const bf16* K, const bf16* V, bf16* O, const bf16* P0, const bf16* P1, const bf16* P2, const f32x2* ml,
                                              int tid, int wid, int lane) {
    asm volatile("" : "+v"(lane), "+v"(tid));
    const int r32 = lane & 31, hi = lane >> 5;
    const size_t rowbase = (size_t)b * SEQ;
    const int q0 = qb * 256, qw0 = q0 + wid * 32, qpos = qw0 + r32;
    const bf16* Kc = K + (rowbase + q0) * PITCH + h * HD; const bf16* Vc = V + (rowbase + q0) * PITCH + h * HD;
    const DmaOff dmo = dma_offsets(wid, lane);
    const int vb0 = (int)(unsigned)(uintptr_t)(lds + L_V) + v_rd_base(lane);
    LAS float* ws = (LAS float*)(lds + L_WS) + wid * 64;
    LAS const float* lut = (LAS const float*)(lds + L_LUT);
    lcp K_lds = (lcp)(lds + L_K);
    dma_tile(lds, 0, Kc, Vc, 0, dmo, wid);
    bf16x8 qr[8];
#pragma unroll
    for (int d0 = 0; d0 < 8; ++d0) qr[d0] = *(const bf16x8*)(Q + (rowbase + qpos) * PITCH + h * HD + d0 * 16 + hi * 8);
    asm volatile("s_waitcnt vmcnt(0)" ::: "memory");
    __syncthreads();
    float m_reg = -1e30f, l_reg = 0.f; f32x16 o[4] = {};
#define OWN_STEP(t, BF) do { const int k0_ = q0 + (t) * 64; \
        if ((t) + 1 < 4) dma_tile(lds, (BF) ^ 1, Kc, Vc, (t) * 64 + 64, dmo, wid); \
        if (k0_ <= qw0 + 31) { f32x16 p0, p1; bf16x8 pa0, pa1, pa2, pa3; float alpha; \
            qkt<BF, 8>(p0, p1, K_lds, r32, hi, 0, qr); \
            const int dq_ = qpos - k0_ - 4 * hi; \
            add_bias_lut(p0, p1, lut, dq_); \
            if (k0_ + 63 > qw0) causal_mask(p0, p1, dq_); \
            softmax_tile(p0, p1, 0.f, m_reg, l_reg, alpha, pa0, pa1, pa2, pa3); \
            if (__any(alpha < 1.f)) { if (hi == 0) ws[r32] = alpha; asm volatile("s_waitcnt lgkmcnt(0)" ::: "memory"); \
                _Pragma("unroll") for (int d_ = 0; d_ < 4; ++d_) _Pragma("unroll") for (int r = 0; r < 16; ++r) o[d_][r] *= ws[crow(r, hi)]; } \
            pv_tile<BF>(o, vb0, pa0, pa1, pa2, pa3); } \
        asm volatile("s_waitcnt vmcnt(0)" ::: "memory"); \
        __syncthreads(); } while (0)
    OWN_STEP(0, 0); OWN_STEP(1, 1); OWN_STEP(2, 0); OWN_STEP(3, 1);
#undef OWN_STEP
    const int nsel = qb < 3 ? qb : 3;
    {
        float ms[3], ls[3]; float mx = m_reg;
#pragma unroll
        for (int s_ = 0; s_ < 3; ++s_) { ms[s_] = -1e30f; ls[s_] = 0.f;
            if (s_ < nsel) { const f32x2 v = ml[((size_t)s_ * M + rowbase + qpos) * NH + h]; ms[s_] = v.x; ls[s_] = v.y; mx = fmaxf(mx, v.x); } }
        const float w0 = __builtin_amdgcn_exp2f(m_reg - mx);
        float wv[3]; float den = l_reg * w0;
#pragma unroll
        for (int s_ = 0; s_ < 3; ++s_) { wv[s_] = ls[s_] * __builtin_amdgcn_exp2f(ms[s_] - mx); den += wv[s_]; }
        const float rd = 1.0f / den;
        if (hi == 0) *(LAS f32x4*)(lds + L_CF + wid * 512 + r32 * 16) = (f32x4){w0 * rd, wv[0] * rd, wv[1] * rd, wv[2] * rd};
    }
    asm volatile("s_waitcnt lgkmcnt(0)" ::: "memory");
    bf16* Ow = O + (rowbase + qw0) * PITCH + h * HD;
#pragma unroll
    for (int r = 0; r < 16; ++r) { const int orow = crow(r, hi); const f32x4 cf = *(LAS const f32x4*)(lds + L_CF + wid * 512 + orow * 16);
        const size_t ro = (rowbase + qw0 + orow) * PITCH + h * HD + r32;
#pragma unroll
        for (int d0 = 0; d0 < 4; ++d0) { float v = o[d0][r] * cf.x;
            if (nsel > 0) v += cf.y * bf2f(P0[ro + d0 * 32]);
            if (nsel > 1) v += cf.z * bf2f(P1[ro + d0 * 32]);
            if (nsel > 2) v += cf.w * bf2f(P2[ro + d0 * 32]);
            const float vn = __shfl_xor(v, 1);
            if ((r32 & 1) == 0) *(unsigned*)(Ow + (size_t)orow * PITCH + d0 * 32 + r32) = cvtpk(v, vn); } }
    __syncthreads();
}
#undef KSWZ
#undef SBAR
}


__device__ __forceinline__ void p_diff_attn_mfma(const Args& a, LAS unsigned char* lds, int vcu, int tid, int wave, int lane) {
    const bf16* Qb = (const bf16*)(a.ws + WS_Q); const bf16* Kb = (const bf16*)(a.ws + WS_K); const bf16* Vb = (const bf16*)(a.ws + WS_V);
    bf16* Ob = (bf16*)(a.ws + WS_O); const float* biasT = (const float*)(a.ws + WS_BIAST);
    float lam_full;
    { const float* lm = a.diff_lambda; const float p01 = wave_sum(lm[lane] * lm[64 + lane]), p23 = wave_sum(lm[128 + lane] * lm[192 + lane]); lam_full = __expf(p01) - __expf(p23) + LAMBDA_INIT; }
    const int G = gridDim.x;
    for (int pr = 2 * vcu; pr < 512; pr += 2 * G) {
#pragma unroll 1
        for (int k = 0; k < 4; ++k) {
            const int pp = pr + (k >> 1); if (pp >= 512) break;
            const int bh = pp >> 5, p = pp & 31, qb = (k & 1) ? 63 - p : p;
            att::diff_unit((LAS char*)lds, bh >> 3, bh & 7, qb, Qb, Kb, Vb, Ob, a.rel_bias, biasT, lam_full, a.diff_subln_g, tid, wave, lane);
        }
    }
}


__device__ __forceinline__ void p_moba_part(const Args& a, LAS unsigned char* lds, int vcu, int tid, int wave, int lane) {
    const bf16* Qb = (const bf16*)(a.ws + WS_Q); const bf16* Kb = (const bf16*)(a.ws + WS_K); const bf16* Vb = (const bf16*)(a.ws + WS_V);
    const unsigned* cnt = (const unsigned*)(a.ws + WS_CTL) + CW_CNT; const unsigned short* lists = (const unsigned short*)(a.ws + WS_LIST); const unsigned* sel = (const unsigned*)(a.ws + WS_SEL);
    bf16* P0 = (bf16*)(a.ws + WS_H); bf16* P1 = (bf16*)(a.ws + WS_Y); bf16* P2 = (bf16*)a.out; f32x2* ml = (f32x2*)((unsigned char*)a.out + WS_ML);
    LAS int* pre = (LAS int*)(lds + att::L_TAB); LAS int* found = (LAS int*)(lds + att::L_FOUND);
    const int c = (int)cnt[tid], nch = (c + 255) >> 8;
    int incl = nch;
#pragma unroll
    for (int o = 1; o < 64; o <<= 1) { const int v = __shfl_up(incl, o); if (lane >= o) incl += v; }
    if (lane == 63) pre[513 + wave] = incl;
    __syncthreads();
    int woff = 0;
#pragma unroll
    for (int w8 = 0; w8 < 8; ++w8) woff += (w8 < wave) ? pre[513 + w8] : 0;
    pre[tid + 1] = woff + incl; if (tid == 0) pre[0] = 0;
    __syncthreads();
    const int T = pre[512], G = gridDim.x;
    const int lo = (int)(((long long)T * vcu) / G), hi_ = (int)(((long long)T * (vcu + 1)) / G);
    int last_h = -1;
    for (int it = lo; it < hi_; ++it) {
        if (pre[tid] <= it && it < pre[tid + 1]) found[0] = tid;
        __syncthreads();
        const int f = __builtin_amdgcn_readfirstlane(found[0]);
        const int bh = f >> 5, j = f & 31, chunk = it - pre[f];
        const int cntj = (int)cnt[f];
        if ((bh & 7) != last_h) { last_h = bh & 7; att::build_lut((LAS char*)lds, (const float*)(a.ws + WS_BIAST), last_h, tid); }
        att::moba_part_item((LAS char*)lds, bh, j, chunk, cntj, Qb, Kb, Vb, lists, sel, P0, P1, P2, ml, a.rel_bias, tid, wave, lane);
    }
}
__device__ __forceinline__ void p_moba_own(const Args& a, LAS unsigned char* lds, int vcu, int tid, int wave, int lane) {
    const bf16* Qb = (const bf16*)(a.ws + WS_Q); const bf16* Kb = (const bf16*)(a.ws + WS_K); const bf16* Vb = (const bf16*)(a.ws + WS_V); bf16* Ob = (bf16*)(a.ws + WS_O);
    const bf16* P0 = (const bf16*)(a.ws + WS_H); const bf16* P1 = (const bf16*)(a.ws + WS_Y); const bf16* P2 = (const bf16*)a.out; const f32x2* ml = (const f32x2*)((const unsigned char*)a.out + WS_ML);
    const int G = gridDim.x;
    for (int u0 = 2 * vcu; u0 < 512; u0 += 2 * G) {
#pragma unroll 1
        for (int k = 0; k < 2; ++k) { const int u = u0 + k; if (u >= 512) break; const int bh = u >> 5, qb = u & 31;
            if (k == 0 || (u & 31) == 0) att::build_lut((LAS char*)lds, (const float*)(a.ws + WS_BIAST), bh & 7, tid);
            att::moba_own_unit((LAS char*)lds, bh >> 3, bh & 7, qb, Qb, Kb, Vb, Ob, P0, P1, P2, ml, tid, wave, lane); }
    }
}

struct TI { int tid, lane, wave, gtid, gw; };
__device__ __forceinline__ TI mk_ti() { int t = threadIdx.x; asm volatile("" : "+v"(t)); TI r; r.tid = t; r.lane = t & 63; r.wave = __builtin_amdgcn_readfirstlane(t >> 6);
    r.gtid = blockIdx.x * NTHR + t; r.gw = blockIdx.x * NWAVES + r.wave; return r; }

typedef const __attribute__((address_space(4))) Args* CArgs;
__device__ __forceinline__ Args load_args() {
#if defined(__HIP_DEVICE_COMPILE__)
    auto p = __builtin_amdgcn_kernarg_segment_ptr(); asm volatile("" : "+s"(p));
    typedef const __attribute__((address_space(4))) unsigned long long* cu64; cu64 q = (cu64)p;
    Args r; r.x = (const float*)q[0]; r.c = (const float*)q[1]; r.rel_bias = (const float*)q[2]; r.ada_w = (const float*)q[3]; r.ada_b = (const float*)q[4]; r.norm_g = (const float*)q[5];
    r.moba_w_qkv = (const float*)q[6]; r.moba_w_o = (const float*)q[7]; r.diff_w_qkv = (const float*)q[8]; r.diff_w_o = (const float*)q[9];
    r.diff_lambda = (const float*)q[10]; r.diff_subln_g = (const float*)q[11]; r.ffn_w_in = (const float*)q[12]; r.ffn_w_out = (const float*)q[13];
    r.out = (float*)q[14]; r.ws = (unsigned char*)q[15]; return r;
#else
    return Args{};
#endif
}
#define WSP(T, off) ((T*)(a.ws + (off)))
#define GEMM_PHASE(EPI, Aptr, Wptr, N_, K_, ...) do { const Args a = load_args(); const int G_ = gridDim.x; \
        pg8::Gemm g{Aptr, (const bf16*)(Wptr), M, N_, K_}; pg8::StaticOrder S; S.init(M, N_, G_, (int)blockIdx.x); \
        EPI E{__VA_ARGS__}; pg8::gemm_phase<EPI, pg8::StaticOrder, true, true>(lds, g, S, E); } while (0)
__global__ void __launch_bounds__(NTHR, 2) fwd(Args a_unused) {
    extern __shared__ __attribute__((aligned(16))) unsigned char lds_raw[];
    LAS unsigned char* lds = (LAS unsigned char*)lds_raw;
    volatile LAS unsigned* MISC = (volatile LAS unsigned*)(lds + MISC_OFF);
    for (int u = threadIdx.x; u < 64; u += NTHR) MISC[u] = 0u;
    __syncthreads();
    XcdBarrier bar;
    { const Args a = load_args(); bar = xcd_barrier_post(WSP(unsigned, WS_CTL) + CW_BAR, MISC + 8); }
#define VCU() ((gridDim.x % 8 == 0) ? (int)((blockIdx.x % 8) * (gridDim.x / 8) + blockIdx.x / 8) : (int)blockIdx.x)
#define NGW() ((int)gridDim.x * NWAVES)
#define NGT() ((int)gridDim.x * NTHR)
    constexpr float QS0 = 0.08838834764831845f * LOG2E, QS1 = 0.125f * LOG2E;
    constexpr size_t QKVS = (size_t)(WS_K - WS_Q) / 2;

    { const Args a = load_args(); const TI t = mk_ti(); p_weights(a, lds, t.gw, NGW(), t.wave, t.lane); __syncthreads(); p_mod(a, lds, (int)blockIdx.x, (int)gridDim.x, t.tid, t.wave, t.lane); }
    xcd_barrier(bar);
    { const Args a = load_args(); const TI t = mk_ti(); const float* md = WSP(const float, WS_MOD); p_norm_in(a.x, a.norm_g, md, md + 1024, WSP(bf16, WS_H), t.gw, NGW(), t.lane); }
    xcd_barrier(bar);
    GEMM_PHASE(pg8::EpiQKV, WSP(bf16, WS_H), a.ws + WS_W + WO_QKV, 3 * D, D, WSP(bf16, WS_Q), D, QKVS, QS0, WSP(float, WS_KSUM));
    xcd_barrier(bar);
    { const Args a = load_args(); const TI t = mk_ti(); p_gate(WSP(bf16, WS_Q), WSP(const float, WS_KSUM), WSP(unsigned, WS_SEL), WSP(unsigned, WS_CTL) + CW_CNT, WSP(unsigned short, WS_LIST), lds, (int)blockIdx.x, (int)gridDim.x, t.tid, t.wave, t.lane); }
    xcd_barrier(bar);
    { const Args a = load_args(); const TI t = mk_ti(); p_moba_part(a, lds, VCU(), t.tid, t.wave, t.lane); }
    xcd_barrier(bar);
    { const Args a = load_args(); const TI t = mk_ti(); p_moba_own(a, lds, VCU(), t.tid, t.wave, t.lane); }
    xcd_barrier(bar);
    GEMM_PHASE(pg8::EpiBf16<0>, WSP(bf16, WS_O), a.ws + WS_W + WO_O, D, D, WSP(bf16, WS_Y), D, nullptr, 0, 0, 1.f);
    xcd_barrier(bar);
    { const Args a = load_args(); const TI t = mk_ti(); const float* md = WSP(const float, WS_MOD); const float* ng = a.norm_g;
      p_post(a.x, WSP(bf16, WS_Y), ng + D, md + 2048, a.out, ng + 2 * D, md + 3072, md + 4096, WSP(bf16, WS_H), t.gw, NGW(), t.lane); }
    xcd_barrier(bar);
    GEMM_PHASE(pg8::EpiSwiglu, WSP(bf16, WS_H), a.ws + WS_W + WO_IN, 2 * DFF, D, WSP(bf16, WS_HH), DFF);
    xcd_barrier(bar);
    GEMM_PHASE(pg8::EpiBf16<0>, WSP(bf16, WS_HH), a.ws + WS_W + WO_OUT, D, DFF, WSP(bf16, WS_Y), D, nullptr, 0, 0, 1.f);
    xcd_barrier(bar);
    { const Args a = load_args(); const TI t = mk_ti(); const float* md = WSP(const float, WS_MOD); const float* ng = a.norm_g; const float* md1 = md + 2 * 6144; const float* ng1 = ng + 4 * D;
      p_post(a.out, WSP(bf16, WS_Y), ng + 3 * D, md + 5120, a.out, ng1, md1, md1 + 1024, WSP(bf16, WS_H), t.gw, NGW(), t.lane); }
    xcd_barrier(bar);
    GEMM_PHASE(pg8::EpiQKV, WSP(bf16, WS_H), a.ws + WS_W + WL_STRIDE + WO_QKV, 3 * D, D, WSP(bf16, WS_Q), D, QKVS, QS1, nullptr);
    xcd_barrier(bar);
    { const Args a = load_args(); const TI t = mk_ti(); p_diff_attn_mfma(a, lds, VCU(), t.tid, t.wave, t.lane); }
    xcd_barrier(bar);
    GEMM_PHASE(pg8::EpiBf16<0>, WSP(bf16, WS_O), a.ws + WS_W + WL_STRIDE + WO_O, D, D, WSP(bf16, WS_Y), D, nullptr, 0, 0, 1.f);
    xcd_barrier(bar);
    { const Args a = load_args(); const TI t = mk_ti(); const float* md = WSP(const float, WS_MOD) + 2 * 6144; const float* ng = a.norm_g + 4 * D;
      p_post(a.out, WSP(bf16, WS_Y), ng + D, md + 2048, a.out, ng + 2 * D, md + 3072, md + 4096, WSP(bf16, WS_H), t.gw, NGW(), t.lane); }
    xcd_barrier(bar);
    GEMM_PHASE(pg8::EpiSwiglu, WSP(bf16, WS_H), a.ws + WS_W + WL_STRIDE + WO_IN, 2 * DFF, D, WSP(bf16, WS_HH), DFF);
    xcd_barrier(bar);
    GEMM_PHASE(pg8::EpiBf16<0>, WSP(bf16, WS_HH), a.ws + WS_W + WL_STRIDE + WO_OUT, D, DFF, WSP(bf16, WS_Y), D, nullptr, 0, 0, 1.f);
    xcd_barrier(bar);
    { const Args a = load_args(); const TI t = mk_ti(); const float* md = WSP(const float, WS_MOD) + 2 * 6144; const float* ng = a.norm_g + 4 * D;
      p_post(a.out, WSP(bf16, WS_Y), ng + 3 * D, md + 5120, a.out, nullptr, nullptr, nullptr, nullptr, t.gw, NGW(), t.lane); }
}

extern "C" void kernel_launch(void* const* d_in, const int* in_sizes, int n_in, void* d_out, int out_size, void* d_ws, size_t ws_size, hipStream_t stream) {
    static int grid = 0;
    if (grid == 0) {
        if (n_in != 14 || out_size != M * D || ws_size < WS_END) { fprintf(stderr, "kernel_launch: unexpected shapes n_in %d out %d ws %zu\n", n_in, out_size, ws_size); grid = -1; return; }
        int dev = 0, cus = 0;
        if (hipGetDevice(&dev) != hipSuccess || hipDeviceGetAttribute(&cus, hipDeviceAttributeMultiprocessorCount, dev) != hipSuccess) { grid = -1; return; }
        if (hipFuncSetAttribute((const void*)fwd, hipFuncAttributeMaxDynamicSharedMemorySize, LDS_BYTES) != hipSuccess) { fprintf(stderr, "hipFuncSetAttribute failed\n"); grid = -1; return; }
        grid = cus;
    }
    if (grid < 0) return;
    (void)hipMemsetAsync((char*)d_ws + WS_CTL, 0, CTL_ZERO_BYTES, stream);
    Args a{};
    a.x = (const float*)d_in[0]; a.c = (const float*)d_in[1]; a.rel_bias = (const float*)d_in[2]; a.ada_w = (const float*)d_in[3]; a.ada_b = (const float*)d_in[4];
    a.norm_g = (const float*)d_in[5]; a.moba_w_qkv = (const float*)d_in[6]; a.moba_w_o = (const float*)d_in[7]; a.diff_w_qkv = (const float*)d_in[8]; a.diff_w_o = (const float*)d_in[9];
    a.diff_lambda = (const float*)d_in[10]; a.diff_subln_g = (const float*)d_in[11]; a.ffn_w_in = (const float*)d_in[12]; a.ffn_w_out = (const float*)d_in[13];
    a.out = (float*)d_out; a.ws = (unsigned char*)d_ws;
    hipLaunchKernelGGL(fwd, dim3(grid), dim3(NTHR), LDS_BYTES, stream, a);
}
```

```cpp
#include <hip/hip_runtime.h>
#include <cstdio>
#include <cstdint>

#define GAS __attribute__((address_space(1)))
#define LAS __attribute__((address_space(3)))
typedef unsigned short bf16;
typedef float f32x4 __attribute__((ext_vector_type(4)));
typedef float f32x2 __attribute__((ext_vector_type(2)));
typedef unsigned u32x4 __attribute__((ext_vector_type(4)));
typedef unsigned u32x2 __attribute__((ext_vector_type(2)));

constexpr int BATCH = 2, SEQ = 8192, D = 1024, NH = 8, HD = 128, DFF = 2816, NBKT = 32;
constexpr int M = BATCH * SEQ;
constexpr int NWAVES = 8, NTHR = 512;
constexpr float RMS_EPS = 1e-6f;
constexpr float LOG2E = 1.4426950408889634f;
constexpr float LAMBDA_INIT = 0.35550906759096926f;

constexpr size_t MiB = 1u << 20;
constexpr size_t WS_CTL = 0, CTL_ZERO_BYTES = 1 * MiB;
constexpr size_t WS_MOD = 1 * MiB;
constexpr size_t WS_BLUT = WS_MOD + 128 * 1024;
constexpr size_t WS_KMEAN = WS_BLUT + 16 * 1024;
constexpr size_t WS_SEL = WS_KMEAN + 256 * 1024;
constexpr size_t WS_BIAST = WS_SEL + 512 * 1024;
constexpr size_t WS_LIST = 244 * MiB;
constexpr size_t WS_ML = 32 * MiB;
constexpr size_t WS_KSUM = 256 * 1024;
constexpr int CW_CNT = 8192;
constexpr size_t WS_W = 2 * MiB, WL_STRIDE = 25 * MiB;
constexpr size_t WO_QKV = 0, WO_O = 6 * MiB, WO_IN = 8 * MiB, WO_OUT = 19 * MiB;
constexpr size_t WS_H = 52 * MiB;
constexpr size_t WS_Q = 84 * MiB, WS_K = 116 * MiB, WS_V = 148 * MiB;
constexpr size_t WS_HH = 84 * MiB;
constexpr size_t WS_O = 180 * MiB;
constexpr size_t WS_Y = 212 * MiB;
constexpr size_t WS_END = 252 * MiB;
constexpr int CW_BAR = 4096;

constexpr int LDS_BYTES = 155648;
constexpr int MISC_OFF = 150016;

#define RLX_AGENT __ATOMIC_RELAXED, __HIP_MEMORY_SCOPE_AGENT
__device__ __forceinline__ unsigned f2bf(float f) { unsigned u = __builtin_bit_cast(unsigned, f); return (u + 0x7fffu + ((u >> 16) & 1u)) >> 16; }
__device__ __forceinline__ unsigned pk2(float lo, float hi) { return f2bf(lo) | (f2bf(hi) << 16); }
__device__ __forceinline__ float bf2f(unsigned short b) { return __builtin_bit_cast(float, (unsigned)b << 16); }
__device__ __forceinline__ float bflo(unsigned w) { return __builtin_bit_cast(float, w << 16); }
__device__ __forceinline__ float bfhi(unsigned w) { return __builtin_bit_cast(float, w & 0xffff0000u); }

#define XB_TMO      128
#define XB_XCNT(j)  (256  + 64 * (j))
#define XB_XSUB(j)  (1280 + 64 * (j))
#define XB_XGEN(j)  (2304 + 64 * (j))
#define XB_TOP      3328
#define XB_TOPGEN   3392
#define XCD_BAR_WORDS 3456
#define XB_SPIN_CAP (1u << 25)
__device__ __forceinline__ unsigned xb_ld(unsigned* p)              { return __hip_atomic_load(p, __ATOMIC_RELAXED, __HIP_MEMORY_SCOPE_AGENT); }
__device__ __forceinline__ unsigned xb_add(unsigned* p, unsigned v) { return __hip_atomic_fetch_add(p, v, __ATOMIC_RELAXED, __HIP_MEMORY_SCOPE_AGENT); }
__device__ __forceinline__ unsigned xb_xcc_id() { return (unsigned)__builtin_amdgcn_s_getreg((3 << 11) | 20) & 0xFu; }
#define XB_SPIN(cond, bar) do { unsigned _sp = 0; while (cond) { __builtin_amdgcn_s_sleep(1); \
    if ((++_sp & 255u) == 0u) { if (xb_ld(&(bar)[XB_TMO])) break; if (_sp > XB_SPIN_CAP) { atomicAdd(&(bar)[XB_TMO], 1u); break; } } } } while (0)
struct XcdBarrier { unsigned* bar; unsigned x; volatile LAS unsigned* st; };
__device__ __forceinline__ XcdBarrier xcd_barrier_post(unsigned* bar, volatile LAS unsigned* st) {
    XcdBarrier b; b.bar = bar; b.x = xb_xcc_id(); b.st = st;
    if (threadIdx.x == 0) (void)xb_add(&bar[XB_XCNT(b.x)], 1u);
    return b;
}
__device__ __forceinline__ void xcd_barrier_complete(unsigned* bar, unsigned x, unsigned& nloc, unsigned& nx) {
    const unsigned G = gridDim.x * gridDim.y * gridDim.z;
    unsigned sum, cnt, mine, sp = 0u;
    for (;;) {
        sum = 0u; cnt = 0u; mine = 0u;
#pragma unroll
        for (unsigned j = 0; j < 16; ++j) { const unsigned c = xb_ld(&bar[XB_XCNT(j)]); sum += c; cnt += (c > 0u) ? 1u : 0u; mine = (j == x) ? c : mine; }
        if (sum == G) break;
        __builtin_amdgcn_s_sleep(1);
        if ((++sp & 255u) == 0u) { if (xb_ld(&bar[XB_TMO])) break; if (sp > XB_SPIN_CAP) { atomicAdd(&bar[XB_TMO], 1u); break; } }
    }
    nloc = mine > 0u ? mine : 1u; nx = cnt > 0u ? cnt : 1u;
}
__device__ __forceinline__ void xcd_barrier(const XcdBarrier& b) {
    asm volatile("s_waitcnt vmcnt(0)" ::: "memory");
    __syncthreads();
    if (threadIdx.x == 0) {
        unsigned* bar = b.bar;
        __builtin_amdgcn_s_waitcnt(0);
        unsigned nloc = b.st[0], nx = b.st[1];
        if (nloc == 0u) { xcd_barrier_complete(bar, b.x, nloc, nx); b.st[0] = nloc; b.st[1] = nx; }
        const unsigned old = xb_add(&bar[XB_XSUB(b.x)], 1u);
        const unsigned gen = old / nloc;
        if (old + 1u == (gen + 1u) * nloc) {
            __builtin_amdgcn_fence(__ATOMIC_RELEASE, "agent");
            asm volatile("s_waitcnt vmcnt(0)" ::: "memory");
            const unsigned og = xb_add(&bar[XB_TOP], 1u);
            const unsigned tg = og / nx;
            if (og + 1u == (tg + 1u) * nx) xb_add(&bar[XB_TOPGEN], 1u);
            else XB_SPIN(xb_ld(&bar[XB_TOPGEN]) == tg, bar);
            __builtin_amdgcn_fence(__ATOMIC_ACQUIRE, "agent");
            xb_add(&bar[XB_XGEN(b.x)], 1u);
            asm volatile("s_waitcnt vmcnt(0)" ::: "memory");
        } else {
            XB_SPIN(xb_ld(&bar[XB_XGEN(b.x)]) == gen, bar);
            __builtin_amdgcn_fence(__ATOMIC_ACQUIRE, "agent");
            asm volatile("s_waitcnt vmcnt(0)" ::: "memory");
        }
    }
    __syncthreads();
}

namespace pg8 {
#define PG8_LAS __attribute__((address_space(3)))
typedef unsigned short bf16_t;
typedef short bf16x8 __attribute__((ext_vector_type(8)));
typedef float f32x4 __attribute__((ext_vector_type(4)));
typedef unsigned u32x4 __attribute__((ext_vector_type(4)));
constexpr int BM = 256, BK = 64, HALF = 128, HTB = HALF * BK * 2  , STAGE_BYTES = 8 * HTB, NXCD = 8, WGM = 8;

__host__ __device__ __forceinline__ int lds_byte(int r, int c) { const int st = (r >> 4) * 2 + (c >> 5), rr = r & 15, cc = c & 31, ob = rr * 64 + cc * 2; return st * 1024 + (ob ^ (((ob >> 9) & 1) << 5)); }
__host__ __device__ __forceinline__ void stage_rc(int b, int& R, int& C) { const int st = b / 1024, sb = b % 1024, swz = sb ^ (((sb >> 9) & 1) << 5); R = (st >> 1) * 16 + swz / 64; C = (st & 1) * 32 + (swz % 64) / 2; }
__host__ __device__ __forceinline__ int perm32(int rho) { const int n = rho >> 4, i = rho & 15; return 8 * (i >> 2) + 4 * n + (i & 3); }

struct Unit { int pm, pn; };
struct Gemm { const bf16_t* A; const bf16_t* Bt; int M, N, K; };

struct StaticOrder {
    int nM, nN, nwg, G, c;
    __host__ __device__ void init(int M, int N, int G_, int c_) { nM = M / BM; nN = N / BM; nwg = nM * nN; G = G_; c = c_; }
    __host__ __device__ bool next(int i, Unit& u) const {
        const long L = (long)i * G + c; if (L >= nwg) return false;
        int wgid = (int)L; { const int q = nwg / NXCD, r = nwg % NXCD, xcd = wgid % NXCD, off = wgid / NXCD; wgid = (xcd < r ? xcd * (q + 1) : r * (q + 1) + (xcd - r) * q) + off; }
        const int nig = WGM * nN, gid = wgid / nig, fm = gid * WGM, gsz = (nM - fm) < WGM ? (nM - fm) : WGM;
        u.pm = fm + ((wgid % nig) % gsz); u.pn = (wgid % nig) / gsz; return true;
    }
    __device__ __forceinline__ void a_ready(const Unit&) const {}
    __device__ __forceinline__ void done(const Unit&) const {}
};

__device__ __forceinline__ unsigned cvt_pk_bf16(float lo, float hi) { unsigned r; asm volatile("v_cvt_pk_bf16_f32 %0, %1, %2" : "=v"(r) : "v"(lo), "v"(hi)); return r; }
typedef float f32x2 __attribute__((ext_vector_type(2)));
__device__ __forceinline__ f32x2 gelu_pk(f32x2 v) {
    const f32x2 av = __builtin_elementwise_abs(v), d = av * 0.2316418882f + 1.0f;
    f32x2 t; t.x = __builtin_amdgcn_rcpf(d.x); t.y = __builtin_amdgcn_rcpf(d.y);
    f32x2 q = t * 0.5307027145f + (-0.7265760135f); q = q * t + 0.7107068705f; q = q * t + (-0.142248368f); q = q * t + 0.127414796f; q = q * t;
    const f32x2 s = (v * v) * (-0.72134752044f);
    f32x2 e; e.x = __builtin_amdgcn_exp2f(s.x); e.y = __builtin_amdgcn_exp2f(s.y);
    const f32x2 m = v * (q * e), r = v - m;
    f32x2 o; o.x = v.x < 0.f ? m.x : r.x; o.y = v.y < 0.f ? m.y : r.y; return o;
}

template <int ACT  > struct EpiBf16 {
    static constexpr bool PERM = true, AFTER_DRAIN = false; static_assert(ACT == 0 || ACT == 1, "EpiBf16: ACT is 0 (none) or 1 (gelu_pk)");
    bf16_t* O; int ldc; const float* bias; int split_cols; size_t split_stride; float scale0;
    __device__ __forceinline__ void operator()(const f32x4 (&acc)[2][2][4][2], const Unit& u, int wr, int wc, int fr, int fq) const {
        const int row0 = u.pm * BM + wr * 64 + fr; int colt = u.pn * BM; bf16_t* base = O;
        float sc = 1.f; if (split_cols) { const int t = colt / split_cols; base += (size_t)t * split_stride; colt -= t * split_cols; if (t == 0) sc = scale0; }
        const int col0 = colt + wc * 32 + 8 * fq, bcol0 = u.pn * BM + wc * 32 + 8 * fq;
        f32x4 bv[2][2];
#pragma unroll
        for (int bj = 0; bj < 2; ++bj)
#pragma unroll
            for (int n = 0; n < 2; ++n) bv[bj][n] = bias ? *(const f32x4*)(bias + bcol0 + bj * HALF + 4 * n) : (f32x4){0.f, 0.f, 0.f, 0.f};
#pragma unroll
        for (int ai = 0; ai < 2; ++ai)
#pragma unroll
            for (int m = 0; m < 4; ++m) { bf16_t* rowp = base + (size_t)(row0 + ai * HALF + m * 16) * ldc + col0;
#pragma unroll
                for (int bj = 0; bj < 2; ++bj) { f32x4 v0 = acc[ai][bj][m][0] + bv[bj][0], v1 = acc[ai][bj][m][1] + bv[bj][1];
                    if (ACT == 1) { f32x2 a = gelu_pk((f32x2){v0[0], v0[1]}), b = gelu_pk((f32x2){v0[2], v0[3]}), c = gelu_pk((f32x2){v1[0], v1[1]}), d = gelu_pk((f32x2){v1[2], v1[3]});
                        v0 = (f32x4){a.x, a.y, b.x, b.y}; v1 = (f32x4){c.x, c.y, d.x, d.y}; }
                    v0 = v0 * sc; v1 = v1 * sc; u32x4 w; w.x = cvt_pk_bf16(v0[0], v0[1]); w.y = cvt_pk_bf16(v0[2], v0[3]); w.z = cvt_pk_bf16(v1[0], v1[1]); w.w = cvt_pk_bf16(v1[2], v1[3]);
                    *(u32x4*)(rowp + bj * HALF) = w; } }
    }
};

struct EpiQKV {
    static constexpr bool PERM = true, AFTER_DRAIN = false;
    bf16_t* O; int ldc; size_t split_stride; float scale0; float* ksum;
    __device__ __forceinline__ void operator()(const f32x4 (&acc)[2][2][4][2], const Unit& u, int wr, int wc, int fr, int fq) const {
        const int row0 = u.pm * BM + wr * 64 + fr; const int t = (u.pn * BM) / ldc; const int colt = u.pn * BM - t * ldc; bf16_t* base = O + (size_t)t * split_stride;
        const float sc = t == 0 ? scale0 : 1.f;
        const int col0 = colt + wc * 32 + 8 * fq;
#pragma unroll
        for (int ai = 0; ai < 2; ++ai)
#pragma unroll
            for (int m = 0; m < 4; ++m) { bf16_t* rowp = base + (size_t)(row0 + ai * HALF + m * 16) * ldc + col0;
#pragma unroll
                for (int bj = 0; bj < 2; ++bj) { const f32x4 v0 = acc[ai][bj][m][0] * sc, v1 = acc[ai][bj][m][1] * sc;
                    u32x4 w; w.x = cvt_pk_bf16(v0[0], v0[1]); w.y = cvt_pk_bf16(v0[2], v0[3]); w.z = cvt_pk_bf16(v1[0], v1[1]); w.w = cvt_pk_bf16(v1[2], v1[3]);
                    *(u32x4*)(rowp + bj * HALF) = w; } }
        if (ksum != nullptr && t == 1) {
            const int b = u.pm >> 5, blk = u.pm & 31;
#pragma unroll
            for (int bj = 0; bj < 2; ++bj) { const int h = (colt >> 7) + bj;
                float* dst = ksum + ((size_t)((b * 8 + h) * 32 + blk)) * 128 + wc * 32 + 8 * fq;
#pragma unroll
                for (int n = 0; n < 2; ++n) { f32x4 sacc = (f32x4){0.f, 0.f, 0.f, 0.f};
#pragma unroll
                    for (int ai = 0; ai < 2; ++ai)
#pragma unroll
                        for (int m = 0; m < 4; ++m) sacc += acc[ai][bj][m][n];
#pragma unroll
                    for (int e = 0; e < 4; ++e) { float v = sacc[e];
                        v += __shfl_xor(v, 1); v += __shfl_xor(v, 2); v += __shfl_xor(v, 4); v += __shfl_xor(v, 8);
                        if (fr == 0) atomicAdd(dst + 4 * n + e, v); } } }
        }
    }
};

struct EpiSwiglu {
    static constexpr bool PERM = true, AFTER_DRAIN = false;
    bf16_t* O; int ldc;
    __device__ __forceinline__ void operator()(const f32x4 (&acc)[2][2][4][2], const Unit& u, int wr, int wc, int fr, int fq) const {
        const int row0 = u.pm * BM + wr * 64 + fr, col0 = u.pn * HALF + wc * 32 + 8 * fq;
#pragma unroll
        for (int ai = 0; ai < 2; ++ai)
#pragma unroll
            for (int m = 0; m < 4; ++m) { bf16_t* rowp = O + (size_t)(row0 + ai * HALF + m * 16) * ldc + col0;
                float v[8];
#pragma unroll
                for (int n = 0; n < 2; ++n)
#pragma unroll
                    for (int e = 0; e < 4; ++e) { const float g = acc[ai][0][m][n][e], uu = acc[ai][1][m][n][e];
                        v[n * 4 + e] = g * __builtin_amdgcn_rcpf(1.0f + __builtin_amdgcn_exp2f(-1.4426950408889634f * g)) * uu; }
                u32x4 w; w.x = cvt_pk_bf16(v[0], v[1]); w.y = cvt_pk_bf16(v[2], v[3]); w.z = cvt_pk_bf16(v[4], v[5]); w.w = cvt_pk_bf16(v[6], v[7]);
                *(u32x4*)rowp = w; }
    }
};
template <class Epi, class Sched, bool ALIGN_EPI = false, bool SP2 = false>
__device__ __forceinline__ void gemm_phase(PG8_LAS unsigned char* lds, const Gemm g, const Sched& S, const Epi& E) {
    int tid_ = threadIdx.x; asm volatile("" : "+v"(tid_));
    const int tid = tid_, wid = __builtin_amdgcn_readfirstlane(tid >> 6), lane = tid & 63, wr = wid >> 2, wc = wid & 3, fr = lane & 15, fq = lane >> 4;
    const int K = g.K, nt = K / BK;
    unsigned voffA[2], voffB[2];
#pragma unroll
    for (int i = 0; i < 2; ++i) { int R, C; stage_rc(tid * 16 + i * 8192, R, C); const int Rb = Epi::PERM ? ((R & ~31) + perm32(R & 31)) : R;
        voffA[i] = (unsigned)(R * K + C) * 2u; voffB[i] = (unsigned)(Rb * K + C) * 2u; }
    const size_t kstep = (size_t)(BK * 2);
    const size_t hstep = (size_t)HALF * K * 2;
    const size_t tstep = 2 * hstep;
    const unsigned ldsw = (unsigned)wid * 1024u;
    const int aoff = lds_byte(wr * 64 + fr, fq * 8), boff = lds_byte(wc * 32 + fr, fq * 8);
#define PG8_SA(b, h) (((b) * 2 + (h)) * HTB)
#define PG8_SB(b, h) ((4 + (b) * 2 + (h)) * HTB)
#define PG8_STAGE(bufoff, gbase, voff) do { _Pragma("unroll") for (int _i = 0; _i < 2; ++_i) \
        __builtin_amdgcn_global_load_lds((const unsigned*)((const char*)(gbase) + (voff)[_i]), (PG8_LAS unsigned*)(lds + (bufoff) + ldsw + _i * 8192), 16, 0, 0); } while (0)
#define PG8_LDA(dst, b, h) do { _Pragma("unroll") for (int m = 0; m < 4; ++m) _Pragma("unroll") for (int k = 0; k < 2; ++k) dst[m][k] = *(const PG8_LAS bf16x8*)(lds + PG8_SA(b, h) + aoff + m * 2048 + k * 1024); } while (0)
#define PG8_LDB(dst, b, h) do { _Pragma("unroll") for (int n = 0; n < 2; ++n) _Pragma("unroll") for (int k = 0; k < 2; ++k) dst[n][k] = *(const PG8_LAS bf16x8*)(lds + PG8_SB(b, h) + boff + n * 2048 + k * 1024); } while (0)
#define PG8_MMA(ai, bj, At, Bt) do { __builtin_amdgcn_s_setprio(1); _Pragma("unroll") for (int m = 0; m < 4; ++m) _Pragma("unroll") for (int n = 0; n < 2; ++n) _Pragma("unroll") for (int k = 0; k < 2; ++k) \
        acc[ai][bj][m][n] = __builtin_amdgcn_mfma_f32_16x16x32_bf16(Bt[n][k], At[m][k], acc[ai][bj][m][n], 0, 0, 0); __builtin_amdgcn_s_setprio(0); } while (0)
#define PG8_WAIT_V(n) asm volatile("s_waitcnt vmcnt(" #n ")" ::: "memory")
#define PG8_WAIT_L(n) asm volatile("s_waitcnt lgkmcnt(" #n ")" ::: "memory")
#define PG8_BAR __builtin_amdgcn_s_barrier()
#define PG8_SCHED __builtin_amdgcn_sched_barrier(0)
    Unit cur, nxt; int ui = 0;
    if (!S.next(0, cur)) return;
    f32x4 acc[2][2][4][2];
#pragma unroll
    for (int a = 0; a < 2; ++a)
#pragma unroll
        for (int b = 0; b < 2; ++b)
#pragma unroll
            for (int m = 0; m < 4; ++m)
#pragma unroll
                for (int n = 0; n < 2; ++n) acc[a][b][m][n] = (f32x4){0.f, 0.f, 0.f, 0.f};
    bf16x8 At[4][2], B0[2][2], B1[2][2];
    const char* cA = (const char*)g.A + (size_t)cur.pm * tstep; const char* cB = (const char*)g.Bt + (size_t)cur.pn * tstep;
    S.a_ready(cur);
    if constexpr (SP2) {
        PG8_STAGE(PG8_SB(0, 0), cB, voffB); PG8_STAGE(PG8_SB(0, 1), cB + hstep, voffB); PG8_STAGE(PG8_SA(0, 0), cA, voffA); PG8_STAGE(PG8_SA(0, 1), cA + hstep, voffA);
        if (wr == 1) PG8_BAR;
        PG8_WAIT_V(2); PG8_BAR;
        PG8_STAGE(PG8_SB(1, 0), cB + kstep, voffB); PG8_STAGE(PG8_SA(1, 0), cA + kstep, voffA); PG8_STAGE(PG8_SB(1, 1), cB + hstep + kstep, voffB);
        PG8_WAIT_V(6); PG8_BAR;
    } else {
        PG8_STAGE(PG8_SB(0, 0), cB, voffB); PG8_STAGE(PG8_SA(0, 0), cA, voffA); PG8_STAGE(PG8_SB(0, 1), cB + hstep, voffB); PG8_STAGE(PG8_SA(0, 1), cA + hstep, voffA);
        if (wr == 1) PG8_BAR;
        PG8_WAIT_V(4); PG8_BAR;
        PG8_STAGE(PG8_SB(1, 0), cB + kstep, voffB); PG8_STAGE(PG8_SA(1, 0), cA + kstep, voffA); PG8_STAGE(PG8_SB(1, 1), cB + hstep + kstep, voffB);
        PG8_WAIT_V(6); PG8_BAR;
    }
    for (;;) {
        const bool has_next = S.next(ui + 1, nxt);
        const char* nA = has_next ? (const char*)g.A + (size_t)nxt.pm * tstep : cA; const char* nB = has_next ? (const char*)g.Bt + (size_t)nxt.pn * tstep : cB;
        for (int t = 0; t < nt; t += 2) {
            const bool last = (t == nt - 2);
            const char* a1 = cA + (size_t)(t + 1) * kstep;
            const char* a2 = last ? nA : cA + (size_t)(t + 2) * kstep; const char* b2 = last ? nB : cB + (size_t)(t + 2) * kstep;
            const char* a3 = a2 + kstep; const char* b3 = b2 + kstep;
            if (last && has_next) S.a_ready(nxt);
            if constexpr (SP2) {
            PG8_LDB(B0, 0, 0); PG8_LDB(B1, 0, 1); PG8_SCHED; PG8_LDA(At, 0, 0); PG8_STAGE(PG8_SA(1, 1), a1 + hstep, voffA);
            PG8_WAIT_V(8); PG8_WAIT_L(0); PG8_BAR; PG8_MMA(0, 0, At, B0); PG8_MMA(0, 1, At, B1); PG8_BAR; PG8_SCHED;
            PG8_LDA(At, 0, 1); PG8_STAGE(PG8_SB(0, 0), b2, voffB); PG8_STAGE(PG8_SB(0, 1), b2 + hstep, voffB); PG8_STAGE(PG8_SA(0, 0), a2, voffA);
            PG8_WAIT_V(8); PG8_WAIT_L(0); PG8_BAR; PG8_MMA(1, 0, At, B0); PG8_MMA(1, 1, At, B1); PG8_BAR; PG8_SCHED;
            PG8_LDB(B0, 1, 0); PG8_LDB(B1, 1, 1); PG8_SCHED; PG8_LDA(At, 1, 0); PG8_STAGE(PG8_SA(0, 1), a2 + hstep, voffA);
            PG8_WAIT_V(8); PG8_WAIT_L(0); PG8_BAR; PG8_MMA(0, 0, At, B0); PG8_MMA(0, 1, At, B1); PG8_BAR; PG8_SCHED;
            PG8_LDA(At, 1, 1); PG8_STAGE(PG8_SB(1, 0), b3, voffB); PG8_STAGE(PG8_SB(1, 1), b3 + hstep, voffB); PG8_STAGE(PG8_SA(1, 0), a3, voffA);
            PG8_WAIT_V(8); PG8_WAIT_L(0); PG8_BAR; PG8_MMA(1, 0, At, B0); PG8_MMA(1, 1, At, B1); PG8_BAR; PG8_SCHED;
            } else {
            PG8_LDB(B0, 0, 0); PG8_SCHED; PG8_LDA(At, 0, 0); PG8_STAGE(PG8_SA(1, 1), a1 + hstep, voffA);
            PG8_WAIT_L(8); PG8_BAR; PG8_WAIT_L(0); PG8_MMA(0, 0, At, B0); PG8_BAR; PG8_SCHED;
            PG8_LDB(B1, 0, 1); PG8_STAGE(PG8_SB(0, 0), b2, voffB);
            PG8_BAR; PG8_WAIT_L(0); PG8_MMA(0, 1, At, B1); PG8_BAR;
            PG8_LDA(At, 0, 1); PG8_STAGE(PG8_SA(0, 0), a2, voffA);
            PG8_BAR; PG8_WAIT_L(0); PG8_MMA(1, 0, At, B0); PG8_BAR; PG8_SCHED;
            PG8_STAGE(PG8_SB(0, 1), b2 + hstep, voffB);
            PG8_WAIT_V(6); PG8_BAR; PG8_MMA(1, 1, At, B1); PG8_BAR;
            PG8_LDB(B0, 1, 0); PG8_SCHED; PG8_LDA(At, 1, 0); PG8_STAGE(PG8_SA(0, 1), a2 + hstep, voffA);
            PG8_WAIT_L(8); PG8_BAR; PG8_WAIT_L(0); PG8_MMA(0, 0, At, B0); PG8_BAR; PG8_SCHED;
            PG8_LDB(B1, 1, 1); PG8_STAGE(PG8_SB(1, 0), b3, voffB);
            PG8_BAR; PG8_WAIT_L(0); PG8_MMA(0, 1, At, B1); PG8_BAR;
            PG8_LDA(At, 1, 1); PG8_STAGE(PG8_SA(1, 0), a3, voffA);
            PG8_BAR; PG8_WAIT_L(0); PG8_MMA(1, 0, At, B0); PG8_BAR; PG8_SCHED;
            PG8_STAGE(PG8_SB(1, 1), b3 + hstep, voffB);
            PG8_WAIT_V(6); PG8_BAR; PG8_MMA(1, 1, At, B1); PG8_BAR;
            }
        }
        if constexpr (ALIGN_EPI) { if (wr == 0) PG8_BAR; }
        if constexpr (!Epi::AFTER_DRAIN) { E(acc, cur, wr, wc, fr, fq); S.done(cur); }
        if (!has_next) break;
#pragma unroll
        for (int a = 0; a < 2; ++a)
#pragma unroll
            for (int b = 0; b < 2; ++b)
#pragma unroll
                for (int m = 0; m < 4; ++m)
#pragma unroll
                    for (int n = 0; n < 2; ++n) acc[a][b][m][n] = (f32x4){0.f, 0.f, 0.f, 0.f};
        cur = nxt; cA = nA; cB = nB; ++ui;
        if constexpr (ALIGN_EPI) { if (wr == 1) PG8_BAR; }
    }
    PG8_WAIT_V(0);
    if constexpr (!ALIGN_EPI) { if (wr == 0) PG8_BAR; }
    PG8_BAR;
    if constexpr (Epi::AFTER_DRAIN) { E.fused(acc, cur, wr, wc, fr, fq, lds, wid, lane); S.done(cur); }
#undef PG8_SA
#undef PG8_SB
#undef PG8_STAGE
#undef PG8_LDA
#undef PG8_LDB
#undef PG8_MMA
#undef PG8_WAIT_V
#undef PG8_WAIT_L
#undef PG8_BAR
#undef PG8_SCHED
}
}

__device__ __forceinline__ float wave_sum(float v) {
#pragma unroll
    for (int o = 1; o < 64; o <<= 1) v += __shfl_xor(v, o);
    return v;
}
__device__ __forceinline__ float wave_max(float v) {
#pragma unroll
    for (int o = 1; o < 64; o <<= 1) v = fmaxf(v, __shfl_xor(v, o));
    return v;
}
__device__ __forceinline__ float silu_f(float v) { return v / (1.f + __expf(-v)); }

struct Args {
    const float* x; const float* c; const float* rel_bias; const float* ada_w; const float* ada_b; const float* norm_g;
    const float* moba_w_qkv; const float* moba_w_o; const float* diff_w_qkv; const float* diff_w_o;
    const float* diff_lambda; const float* diff_subln_g; const float* ffn_w_in; const float* ffn_w_out;
    float* out; unsigned char* ws;
};

__device__ __forceinline__ int t5_bucket(int rel) {
    const int n = rel < 0 ? 0 : rel;
    const float nf = (float)(n < 1 ? 1 : n);
    int large = 16 + (int)(logf(nf / 16.0f) / 4.852030263919617f * 16.0f);
    large = large < 31 ? large : 31;
    return n < 16 ? n : large;
}

__device__ __forceinline__ void p_mod(const Args& a, LAS unsigned char* lds, int blk, int G, int tid, int wave, int lane) {
    LAS float* sc = (LAS float*)lds;
    LAS float* red = sc + 2048;
    for (int i = tid; i < 2048; i += NTHR) sc[i] = silu_f(a.c[i]);
    __syncthreads();
    float* mod = (float*)(a.ws + WS_MOD);
    for (int it = blk; it < 192; it += G) {
        const int l = it / 96, j0 = (it % 96) * 64;
        const float* w = a.ada_w + (size_t)l * D * 6144 + j0 + lane;
        float s0 = 0.f, s1 = 0.f;
#pragma unroll 1
        for (int kb = wave * 128; kb < wave * 128 + 128; kb += 32) { float wv[32];
#pragma unroll
            for (int k = 0; k < 32; ++k) wv[k] = w[(size_t)(kb + k) * 6144];
#pragma unroll
            for (int k = 0; k < 32; ++k) { s0 += sc[kb + k] * wv[k]; s1 += sc[1024 + kb + k] * wv[k]; } }
        red[(wave * 2 + 0) * 64 + lane] = s0; red[(wave * 2 + 1) * 64 + lane] = s1;
        __syncthreads();
        if (tid < 128) { const int bb = tid >> 6, cl = tid & 63; float sum = 0.f;
#pragma unroll
            for (int w8 = 0; w8 < 8; ++w8) sum += red[(w8 * 2 + bb) * 64 + cl];
            mod[(l * 2 + bb) * 6144 + j0 + cl] = sum + a.ada_b[l * 6144 + j0 + cl]; }
        __syncthreads();
    }
    float* bt = (float*)(a.ws + WS_BIAST);
    for (int i = blk * NTHR + tid; i < 8 * 2304; i += G * NTHR) { const int h = i / 2304, rel = 2047 - (i % 2304); bt[i] = rel >= 0 ? a.rel_bias[t5_bucket(rel) * NH + h] * LOG2E : 0.f; }
}

__device__ __forceinline__ void transpose_item(const float* W, int K, int N, int k0, int n0, bf16* WT, int dst_row0, LAS float* scr, int lane) {
    float tv[32];
#pragma unroll
    for (int i = 0; i < 32; ++i) tv[i] = W[(size_t)(k0 + 2 * i + (lane >> 5)) * N + n0 + (lane & 31)];
#pragma unroll
    for (int i = 0; i < 32; ++i) scr[(2 * i + (lane >> 5)) * 33 + (lane & 31)] = tv[i];
    asm volatile("s_waitcnt lgkmcnt(0)" ::: "memory");
    const int c = lane & 7;
#pragma unroll
    for (int j = 0; j < 4; ++j) { const int n = (lane >> 3) + 8 * j; const LAS float* sp = scr + (8 * c) * 33 + n;
        u32x4 o; o.x = pk2(sp[0 * 33], sp[1 * 33]); o.y = pk2(sp[2 * 33], sp[3 * 33]); o.z = pk2(sp[4 * 33], sp[5 * 33]); o.w = pk2(sp[6 * 33], sp[7 * 33]);
        *(u32x4*)(WT + (size_t)(dst_row0 + n) * K + k0 + 8 * c) = o; }
    asm volatile("s_waitcnt lgkmcnt(0)" ::: "memory");
}
__device__ __forceinline__ void p_weights(const Args& a, LAS unsigned char* lds, int gw, int ngw, int wave, int lane) {
    LAS float* scr = (LAS float*)(lds + wave * 16384);
    constexpr int I_QKV = (D / 64) * (3 * D / 32), I_O = (D / 64) * (D / 32), I_IN = (D / 64) * (2 * DFF / 32), I_OUT = (DFF / 64) * (D / 32);
    constexpr int PER_L = I_QKV + I_O + I_IN + I_OUT;
    for (int it = gw; it < 2 * PER_L; it += ngw) {
        const int l = it / PER_L; int r = it % PER_L;
        unsigned char* wl = a.ws + WS_W + (size_t)l * WL_STRIDE;
        if (r < I_QKV) { const int nb = 3 * D / 32, kb = r / nb, n0 = (r % nb) * 32; transpose_item(l == 0 ? a.moba_w_qkv : a.diff_w_qkv, D, 3 * D, kb * 64, n0, (bf16*)(wl + WO_QKV), n0, scr, lane); continue; } r -= I_QKV;
        if (r < I_O) continue; r -= I_O;
        if (r < I_IN) { const int nb = 2 * DFF / 32, kb = r / nb, n0 = (r % nb) * 32;
            const int isu = n0 >= DFF ? 1 : 0, nn = n0 - isu * DFF, dst = 256 * (nn / 128) + 128 * isu + (nn % 128);
            transpose_item(a.ffn_w_in + (size_t)l * D * 2 * DFF, D, 2 * DFF, kb * 64, n0, (bf16*)(wl + WO_IN), dst, scr, lane); continue; } r -= I_IN;
        { const int nb = D / 32, kb = r / nb, n0 = (r % nb) * 32; transpose_item(a.ffn_w_out + (size_t)l * DFF * D, DFF, D, kb * 64, n0, (bf16*)(wl + WO_OUT), n0, scr, lane); }
    }
}

__device__ __forceinline__ void p_wo_perm(const Args& a, int gtid, int gthreads) {
    for (int idx = gtid; idx < 2 * 128 * D; idx += gthreads) {
        const int l = idx / (128 * D), rem = idx % (128 * D), c = rem / D, n = rem % D;
        const float* W = l == 0 ? a.moba_w_o : a.diff_w_o;
        float v[8];
#pragma unroll
        for (int e = 0; e < 8; ++e) { const int kp = 8 * c + e, hh = kp >> 7, wi = kp & 127, k = hh * 128 + (wi & 3) * 32 + (wi >> 2); v[e] = W[(size_t)k * D + n]; }
        u32x4 o; o.x = pk2(v[0], v[1]); o.y = pk2(v[2], v[3]); o.z = pk2(v[4], v[5]); o.w = pk2(v[6], v[7]);
        *(u32x4*)((bf16*)(a.ws + WS_W + (size_t)l * WL_STRIDE + WO_O) + (size_t)n * D + 8 * c) = o;
    }
}

__device__ __forceinline__ void p_norm_in(const float* X, const float* g, const float* sh, const float* sc, bf16* H, int gw, int ngw, int lane) {
    for (int m = gw; m < M; m += ngw) {
        const int b = m / SEQ;
        const f32x4* xr = (const f32x4*)(X + (size_t)m * D) + lane;
        f32x4 v[4]; float s = 0.f;
#pragma unroll
        for (int j = 0; j < 4; ++j) { v[j] = xr[64 * j]; s += (v[j].x * v[j].x + v[j].y * v[j].y) + (v[j].z * v[j].z + v[j].w * v[j].w); }
        const float r = 1.0f / sqrtf(wave_sum(s) * (1.f / D) + RMS_EPS);
        u32x2* o = (u32x2*)(H + (size_t)m * D) + lane;
#pragma unroll
        for (int j = 0; j < 4; ++j) {
            const f32x4 gg = ((const f32x4*)g)[lane + 64 * j], s1 = ((const f32x4*)(sc + b * 6144))[lane + 64 * j], s0 = ((const f32x4*)(sh + b * 6144))[lane + 64 * j];
            const f32x4 h = v[j] * r * gg * (1.0f + s1) + s0;
            u32x2 w; w.x = pk2(h.x, h.y); w.y = pk2(h.z, h.w); o[64 * j] = w;
        }
    }
}
__device__ __forceinline__ void p_post(const float* Xin, const bf16* Y, const float* g1, const float* gate, float* Xout,
                                       const float* g2, const float* sh, const float* sc, bf16* H, int gw, int ngw, int lane) {
    for (int m = gw; m < M; m += ngw) {
        const int b = m / SEQ;
        const u32x2* yr = (const u32x2*)(Y + (size_t)m * D) + lane;
        const f32x4* xr = (const f32x4*)(Xin + (size_t)m * D) + lane;
        f32x4 y[4], xv[4]; float s = 0.f;
#pragma unroll
        for (int j = 0; j < 4; ++j) { const u32x2 w = yr[64 * j]; y[j] = (f32x4){bflo(w.x), bfhi(w.x), bflo(w.y), bfhi(w.y)}; xv[j] = xr[64 * j];
            s += (y[j].x * y[j].x + y[j].y * y[j].y) + (y[j].z * y[j].z + y[j].w * y[j].w); }
        const float r = 1.0f / sqrtf(wave_sum(s) * (1.f / D) + RMS_EPS);
        float s2 = 0.f;
#pragma unroll
        for (int j = 0; j < 4; ++j) {
            const f32x4 gg = ((const f32x4*)g1)[lane + 64 * j], gt = ((const f32x4*)(gate + b * 6144))[lane + 64 * j];
            xv[j] = xv[j] + gt * (y[j] * r * gg);
            s2 += (xv[j].x * xv[j].x + xv[j].y * xv[j].y) + (xv[j].z * xv[j].z + xv[j].w * xv[j].w);
            ((f32x4*)(Xout + (size_t)m * D))[lane + 64 * j] = xv[j];
        }
        if (H) {
            const float r2 = 1.0f / sqrtf(wave_sum(s2) * (1.f / D) + RMS_EPS);
            u32x2* o = (u32x2*)(H + (size_t)m * D) + lane;
#pragma unroll
            for (int j = 0; j < 4; ++j) {
                const f32x4 gg = ((const f32x4*)g2)[lane + 64 * j], s1 = ((const f32x4*)(sc + b * 6144))[lane + 64 * j], s0 = ((const f32x4*)(sh + b * 6144))[lane + 64 * j];
                const f32x4 h = xv[j] * r2 * gg * (1.0f + s1) + s0;
                u32x2 w; w.x = pk2(h.x, h.y); w.y = pk2(h.z, h.w); o[64 * j] = w;
            }
        }
    }
}

__device__ __forceinline__ void p_kmean(const bf16* Kb, float* kmean, LAS unsigned char* lds, int blk, int G, int tid, int wave, int lane) {
    LAS float* red = (LAS float*)lds;
    for (int it = blk; it < BATCH * NH * 32; it += G) {
        const int b = it >> 8, h = (it >> 5) & 7, kb = it & 31;
        const bf16* p = Kb + ((size_t)b * SEQ + kb * 256 + wave * 32) * D + h * HD + 2 * lane;
        float s0 = 0.f, s1 = 0.f;
#pragma unroll 8
        for (int r = 0; r < 32; ++r) { const unsigned w = *(const unsigned*)(p + (size_t)r * D); s0 += bflo(w); s1 += bfhi(w); }
        red[wave * 128 + 2 * lane] = s0; red[wave * 128 + 2 * lane + 1] = s1;
        __syncthreads();
        if (tid < 128) { float sum = 0.f;
#pragma unroll
            for (int w8 = 0; w8 < 8; ++w8) sum += red[w8 * 128 + tid];
            kmean[(size_t)it * 128 + tid] = sum * (1.0f / 256.0f); }
        __syncthreads();
    }
}
__device__ __forceinline__ void p_gate(const bf16* Qb, const float* kmean, unsigned* sel, unsigned* cnt, unsigned short* lists, LAS unsigned char* lds, int blk, int G, int tid, int wave, int lane) {
    LAS float* km = (LAS float*)lds;
    for (int it = blk; it < 256; it += G) {
        const int bh = it >> 4, span = it & 15, b = bh >> 3, h = bh & 7;
        __syncthreads();
        for (int i = tid; i < 1024; i += NTHR) ((LAS f32x4*)km)[i] = ((const f32x4*)(kmean + (size_t)bh * 4096))[i];
        __syncthreads();
        const int q = span * 512 + wave * 64 + lane, own = (span * 512 + wave * 64) >> 8;
        unsigned mask;
        if (own <= 3) mask = (1u << own) - 1u;
        else {
            float qf[128];
            const u32x4* qp = (const u32x4*)(Qb + ((size_t)b * SEQ + q) * D + h * HD);
#pragma unroll
            for (int c = 0; c < 16; ++c) { const u32x4 w = qp[c]; qf[c * 8 + 0] = bflo(w.x); qf[c * 8 + 1] = bfhi(w.x); qf[c * 8 + 2] = bflo(w.y); qf[c * 8 + 3] = bfhi(w.y);
                qf[c * 8 + 4] = bflo(w.z); qf[c * 8 + 5] = bfhi(w.z); qf[c * 8 + 6] = bflo(w.w); qf[c * 8 + 7] = bfhi(w.w); }
            float b0 = -3e38f, b1 = -3e38f, b2 = -3e38f; int i0 = 0, i1 = 0, i2 = 0;
#pragma unroll 1
            for (int n = 0; n < own; ++n) {
                float g0 = 0.f, g1 = 0.f, g2 = 0.f, g3 = 0.f;
#pragma unroll
                for (int d = 0; d < 128; d += 4) { const f32x4 kv = *(LAS f32x4*)(km + n * 128 + d); g0 += qf[d] * kv.x; g1 += qf[d + 1] * kv.y; g2 += qf[d + 2] * kv.z; g3 += qf[d + 3] * kv.w; }
                const float g = (g0 + g1) + (g2 + g3);
                if (g > b0) { b2 = b1; i2 = i1; b1 = b0; i1 = i0; b0 = g; i0 = n; }
                else if (g > b1) { b2 = b1; i2 = i1; b1 = g; i1 = n; }
                else if (g > b2) { b2 = g; i2 = n; }
            }
            mask = (1u << i0) | (1u << i1) | (1u << i2);
        }
        sel[(size_t)bh * SEQ + q] = mask;
        unsigned mycnt = 0u;
        for (int j = 0; j < own; ++j) { const unsigned long long bl = __ballot((mask >> j) & 1u); if (lane == j) mycnt = (unsigned)__popcll(bl); }
        unsigned base = 0u;
        if (lane < own && mycnt) base = __hip_atomic_fetch_add(cnt + bh * 32 + lane, mycnt, __ATOMIC_RELAXED, __HIP_MEMORY_SCOPE_AGENT);
        for (int j = 0; j < own; ++j) { const unsigned long long bl = __ballot((mask >> j) & 1u); const unsigned bj = (unsigned)__shfl((int)base, j);
            if ((mask >> j) & 1u) lists[((size_t)bh * 32 + j) * 8192 + bj + (unsigned)__popcll(bl & ((1ull << lane) - 1ull))] = (unsigned short)q; }
    }
}

namespace att {
typedef short bf16x8 __attribute__((ext_vector_type(8)));
typedef short s16x4 __attribute__((ext_vector_type(4)));
typedef float f32x16 __attribute__((ext_vector_type(16)));
typedef LAS const char* lcp;
constexpr int PITCH = 1024;
constexpr int SHM_V = 16384, SHM_K = 16384;
constexpr int L_K = 0, L_V = 65536, L_WS = 131072, L_LUT = 133120;
constexpr int LUTN = 2304, RMAXL = 2047, RFAR = 1536;
#define KSWZ(row, colB) ((row) * 256 + ((colB) ^ (((row) & 7) << 4)))
#define SBAR() __builtin_amdgcn_sched_barrier(0)
#define WG_BAR() do { asm volatile("s_waitcnt lgkmcnt(0)" ::: "memory"); __builtin_amdgcn_s_barrier(); asm volatile("" ::: "memory"); } while (0)
__device__ __forceinline__ int v_st(int k, int c) { const int kk = (k & ~0xC) | ((k & 4) << 1) | ((k & 8) >> 1); return ((kk >> 3) * 4 + (c >> 5)) * 512 + ((kk & 7) * 32 + (c & 31)) * 2; }
__device__ __forceinline__ int v_rd_base(int lane) { return ((lane & 3) << 3) | (((lane >> 2) & 3) << 6) | (((lane >> 4) & 1) << 5) | (((lane >> 5) & 1) << 8); }
constexpr int v_rd_off(int d0, int ks, int half) { return d0 * 512 + ks * 4096 + half * 2048; }
__device__ __forceinline__ int crow(int r, int hi) { return (r & 3) + 8 * (r >> 2) + 4 * hi; }
__device__ __forceinline__ unsigned cvtpk(float lo, float hi) { unsigned r; asm volatile("v_cvt_pk_bf16_f32 %0, %1, %2" : "=v"(r) : "v"(lo), "v"(hi)); return r; }

template <int KB, int NDS>
__device__ __forceinline__ void qkt(f32x16& p0, f32x16& p1, lcp K_lds, int r32, int hi, int coff, const bf16x8* qr) {
    p0 = f32x16{}; p1 = f32x16{};
    lcp kb[4];
#pragma unroll
    for (int dd = 0; dd < 4; ++dd) kb[dd] = K_lds + KB * SHM_K + KSWZ(r32, (dd * 16 + hi * 8) * 2) + coff;
#pragma unroll
    for (int d0 = 0; d0 < NDS; ++d0) { lcp a = kb[d0 & 3] + (d0 >> 2) * 128;
        const bf16x8 b0 = *(LAS const bf16x8*)a;
        const bf16x8 b1 = *(LAS const bf16x8*)(a + 32 * 256);
        p0 = __builtin_amdgcn_mfma_f32_32x32x16_bf16(b0, qr[d0], p0, 0, 0, 0);
        p1 = __builtin_amdgcn_mfma_f32_32x32x16_bf16(b1, qr[d0], p1, 0, 0, 0);
        if (NDS == 8 && (d0 & 1) == 1) SBAR(); }
}
template <int VB>
__device__ __forceinline__ void pv_tile(f32x16* o, int vb0, bf16x8 pa0, bf16x8 pa1, bf16x8 pa2, bf16x8 pa3) {
#define TRRD(dst, off) asm volatile("ds_read_b64_tr_b16 %0, %1 offset:%2" : "=&v"(dst) : "v"(vb0), "i"(off) : "memory")
#define PV_D0(d0) do { s16x4 l0, l1, l2, l3, h0, h1, h2, h3; constexpr int b_ = VB * SHM_V + v_rd_off(d0, 0, 0); \
        TRRD(l0, b_); TRRD(h0, b_ + 2048); TRRD(l1, b_ + 4096); TRRD(h1, b_ + 6144); TRRD(l2, b_ + 8192); TRRD(h2, b_ + 10240); TRRD(l3, b_ + 12288); TRRD(h3, b_ + 14336); \
        asm volatile("s_waitcnt lgkmcnt(0)" ::: "memory"); SBAR(); \
        o[d0] = __builtin_amdgcn_mfma_f32_32x32x16_bf16(pa0, (bf16x8){l0[0], l0[1], l0[2], l0[3], h0[0], h0[1], h0[2], h0[3]}, o[d0], 0, 0, 0); \
        o[d0] = __builtin_amdgcn_mfma_f32_32x32x16_bf16(pa1, (bf16x8){l1[0], l1[1], l1[2], l1[3], h1[0], h1[1], h1[2], h1[3]}, o[d0], 0, 0, 0); \
        o[d0] = __builtin_amdgcn_mfma_f32_32x32x16_bf16(pa2, (bf16x8){l2[0], l2[1], l2[2], l2[3], h2[0], h2[1], h2[2], h2[3]}, o[d0], 0, 0, 0); \
        o[d0] = __builtin_amdgcn_mfma_f32_32x32x16_bf16(pa3, (bf16x8){l3[0], l3[1], l3[2], l3[3], h3[0], h3[1], h3[2], h3[3]}, o[d0], 0, 0, 0); } while (0)
    PV_D0(0); PV_D0(1); PV_D0(2); PV_D0(3);
#undef PV_D0
#undef TRRD
}

template <int NDS>
__device__ __forceinline__ void kread(bf16x8* kf, int kaddr_base, int r32, int hi, int coff) {
#pragma unroll
    for (int d0 = 0; d0 < NDS; ++d0) { const int a = kaddr_base + KSWZ(r32, ((d0 & 3) * 16 + hi * 8) * 2) + coff + (d0 >> 2) * 128;
        asm volatile("ds_read_b128 %0, %1" : "=&v"(kf[2 * d0]) : "v"(a) : "memory");
        asm volatile("ds_read_b128 %0, %1 offset:8192" : "=&v"(kf[2 * d0 + 1]) : "v"(a) : "memory"); }
}
template <int NDS>
__device__ __forceinline__ void kmma(f32x16& p0, f32x16& p1, const bf16x8* kf, const bf16x8* qr) {
    p0 = f32x16{}; p1 = f32x16{};
#pragma unroll
    for (int d0 = 0; d0 < NDS; ++d0) { p0 = __builtin_amdgcn_mfma_f32_32x32x16_bf16(kf[2 * d0], qr[d0], p0, 0, 0, 0); p1 = __builtin_amdgcn_mfma_f32_32x32x16_bf16(kf[2 * d0 + 1], qr[d0], p1, 0, 0, 0); }
}

__device__ __forceinline__ void pv_tile_pf(f32x16* o, int vb0, bf16x8 pa0, bf16x8 pa1, bf16x8 pa2, bf16x8 pa3) {
#define TRRD(dst, off) asm volatile("ds_read_b64_tr_b16 %0, %1 offset:%2" : "=&v"(dst) : "v"(vb0), "i"(off) : "memory")
#define RD8(S, d0) do { constexpr int b_ = v_rd_off(d0, 0, 0); TRRD(S[0], b_); TRRD(S[1], b_ + 2048); TRRD(S[2], b_ + 4096); TRRD(S[3], b_ + 6144); \
        TRRD(S[4], b_ + 8192); TRRD(S[5], b_ + 10240); TRRD(S[6], b_ + 12288); TRRD(S[7], b_ + 14336); } while (0)
#define MMA4(d0, S) do { \
        o[d0] = __builtin_amdgcn_mfma_f32_32x32x16_bf16(pa0, (bf16x8){S[0][0], S[0][1], S[0][2], S[0][3], S[1][0], S[1][1], S[1][2], S[1][3]}, o[d0], 0, 0, 0); \
        o[d0] = __builtin_amdgcn_mfma_f32_32x32x16_bf16(pa1, (bf16x8){S[2][0], S[2][1], S[2][2], S[2][3], S[3][0], S[3][1], S[3][2], S[3][3]}, o[d0], 0, 0, 0); \
        o[d0] = __builtin_amdgcn_mfma_f32_32x32x16_bf16(pa2, (bf16x8){S[4][0], S[4][1], S[4][2], S[4][3], S[5][0], S[5][1], S[5][2], S[5][3]}, o[d0], 0, 0, 0); \
        o[d0] = __builtin_amdgcn_mfma_f32_32x32x16_bf16(pa3, (bf16x8){S[6][0], S[6][1], S[6][2], S[6][3], S[7][0], S[7][1], S[7][2], S[7][3]}, o[d0], 0, 0, 0); } while (0)
    s16x4 sa[8], sb[8];
    RD8(sa, 0); RD8(sb, 1);
    asm volatile("s_waitcnt lgkmcnt(8)" ::: "memory"); SBAR(); MMA4(0, sa); SBAR();
    RD8(sa, 2);
    asm volatile("s_waitcnt lgkmcnt(8)" ::: "memory"); SBAR(); MMA4(1, sb); SBAR();
    RD8(sb, 3);
    asm volatile("s_waitcnt lgkmcnt(8)" ::: "memory"); SBAR(); MMA4(2, sa); SBAR();
    asm volatile("s_waitcnt lgkmcnt(0)" ::: "memory"); SBAR(); MMA4(3, sb);
#undef MMA4
#undef RD8
#undef TRRD
}
constexpr float THR2 = 8.0f;
__device__ __forceinline__ void partial_sm(f32x16& p0, f32x16& p1, float sh, float& m_reg, float& alpha) {
    float pmax = p0[0];
#pragma unroll
    for (int r = 1; r < 16; ++r) pmax = fmaxf(pmax, p0[r]);
#pragma unroll
    for (int r = 0; r < 16; ++r) pmax = fmaxf(pmax, p1[r]);
    { auto rr = __builtin_amdgcn_permlane32_swap(__float_as_uint(pmax), __float_as_uint(pmax), false, false);
      pmax = fmaxf(__uint_as_float(rr[0]), __uint_as_float(rr[1])); }
    pmax += sh;
    float mn;
    if (__builtin_expect(__all((pmax - m_reg) <= THR2), 1)) { mn = m_reg; alpha = 1.f; }
    else { mn = fmaxf(m_reg, pmax); alpha = __builtin_amdgcn_exp2f(m_reg - mn); m_reg = mn; }
    const float off = mn - sh;
#pragma unroll
    for (int r = 0; r < 16; ++r) p0[r] = __builtin_amdgcn_exp2f(p0[r] - off);
#pragma unroll
    for (int r = 0; r < 16; ++r) p1[r] = p1[r] - off;
}
__device__ __forceinline__ void finish_sm(f32x16& p0, f32x16& p1, float alpha, float& l_reg, bf16x8& pa0, bf16x8& pa1, bf16x8& pa2, bf16x8& pa3) {
#pragma unroll
    for (int r = 0; r < 16; ++r) p1[r] = __builtin_amdgcn_exp2f(p1[r]);
    float ps = 0.f;
#pragma unroll
    for (int r = 0; r < 16; ++r) ps += p0[r];
#pragma unroll
    for (int r = 0; r < 16; ++r) ps += p1[r];
    { auto rr = __builtin_amdgcn_permlane32_swap(__float_as_uint(ps), __float_as_uint(ps), false, false);
      ps = __uint_as_float(rr[0]) + __uint_as_float(rr[1]); }
    l_reg = l_reg * alpha + ps;
#define PK4(P, B_, OUT) do { unsigned a0 = cvtpk(P[B_+0], P[B_+1]), a1 = cvtpk(P[B_+2], P[B_+3]); \
        unsigned b0 = cvtpk(P[B_+4], P[B_+5]), b1 = cvtpk(P[B_+6], P[B_+7]); \
        auto r0 = __builtin_amdgcn_permlane32_swap(a0, b0, false, false); auto r1 = __builtin_amdgcn_permlane32_swap(a1, b1, false, false); \
        u32x4 w = {r0[0], r1[0], r0[1], r1[1]}; OUT = __builtin_bit_cast(bf16x8, w); } while (0)
    PK4(p0, 0, pa0); PK4(p0, 8, pa1); PK4(p1, 0, pa2); PK4(p1, 8, pa3);
#undef PK4
}
__device__ __forceinline__ void softmax_tile(f32x16& p0, f32x16& p1, float sh, float& m_reg, float& l_reg, float& alpha, bf16x8& pa0, bf16x8& pa1, bf16x8& pa2, bf16x8& pa3) {
    partial_sm(p0, p1, sh, m_reg, alpha); finish_sm(p0, p1, alpha, l_reg, pa0, pa1, pa2, pa3);
}
__device__ __forceinline__ void add_bias_lut(f32x16& p0, f32x16& p1, LAS const float* lut, int dq) {
    LAS const float* bp = lut + (RMAXL - dq);
#pragma unroll
    for (int r = 0; r < 16; ++r) { const int c = (r & 3) + 8 * (r >> 2); p0[r] += bp[c]; p1[r] += bp[c + 32]; if ((r & 3) == 3) asm volatile("" ::: "memory"); }
}
__device__ __forceinline__ void causal_mask(f32x16& p0, f32x16& p1, int dq) {
    const float NEG = -__builtin_inff();
#pragma unroll
    for (int r = 0; r < 16; ++r) { const int c = (r & 3) + 8 * (r >> 2); if (dq - c < 0) p0[r] = NEG; if (dq - c - 32 < 0) p1[r] = NEG; }
}
struct DmaOff { unsigned k[2], v[2]; };
__device__ __forceinline__ DmaOff dma_offsets(int wid, int lane) {
    DmaOff d;
#pragma unroll
    for (int i = 0; i < 2; ++i) { const int p = wid * 2 + i;
        { const int row = 4 * p + (lane >> 4), c = (lane & 15) ^ (row & 7); d.k[i] = (unsigned)(row * PITCH * 2 + c * 16); }
        { const int sub = 2 * p + (lane >> 5), kkhi = sub >> 2, cblk = sub & 3, kklo = (lane & 31) >> 2, kk = kkhi * 8 + kklo;
          const int k = (kk & ~0xC) | ((kk & 4) << 1) | ((kk & 8) >> 1), c = cblk * 32 + (lane & 3) * 8; d.v[i] = (unsigned)(k * PITCH * 2 + c * 2); } }
    return d;
}
__device__ __forceinline__ void dma_tile(LAS char* lds, int bf, const bf16* Kc, const bf16* Vc, int k0, const DmaOff& d, int wid) {
    const char* kt = (const char*)Kc + (size_t)k0 * (PITCH * 2); const char* vt = (const char*)Vc + (size_t)k0 * (PITCH * 2);
#pragma unroll
    for (int i = 0; i < 2; ++i) {
        __builtin_amdgcn_global_load_lds((const unsigned*)(kt + d.k[i]), (LAS unsigned*)(lds + L_K + bf * SHM_K + (wid * 2 + i) * 1024), 16, 0, 0);
        __builtin_amdgcn_global_load_lds((const unsigned*)(vt + d.v[i]), (LAS unsigned*)(lds + L_V + bf * SHM_V + (wid * 2 + i) * 1024), 16, 0, 0); }
}
constexpr int L_CF = 142336, L_TAB = 146432, L_FOUND = 148544;
__device__ __forceinline__ void build_lut(LAS char* lds, const float* biasT, int h, int tid) {
    LAS float* lut = (LAS float*)(lds + L_LUT);
    for (int i = tid; i < LUTN; i += 512) lut[i] = biasT[h * LUTN + i];
}

template <int VAR> __device__ __forceinline__ void diff_unit(LAS char* lds, int b, int h, int qb, const bf16* Q, const bf16* K, const bf16* V, bf16* O, const float* relb, const float* biasT,
                                          float lam_full, const float* subg, int tid, int wid, int lane) {
    asm volatile("" : "+v"(lane), "+v"(tid));
    const int r32 = lane & 31, hi = lane >> 5, cm = wid >> 2, w4 = wid & 3;
    const size_t rowbase = (size_t)b * SEQ;
    const int q0 = qb * 128, qw0 = q0 + w4 * 32, qpos = qw0 + r32;
    const bf16* Kc = K + rowbase * PITCH + h * HD; const bf16* Vc = V + rowbase * PITCH + h * HD;
    const int NT = (q0 + 128) / 64;
    const DmaOff dmo = dma_offsets(wid, lane);
    const int vb0 = (int)(unsigned)(uintptr_t)(lds + L_V) + v_rd_base(lane);
    LAS float* ws = (LAS float*)(lds + L_WS) + wid * 64;
    LAS const float* lut = (LAS const float*)(lds + L_LUT);
    lcp K_lds = (lcp)(lds + L_K);
    const float b31 = relb[31 * 8 + h] * 1.4426950408889634f;
    build_lut(lds, biasT, h, tid);
    bf16x8 qr[4];
#pragma unroll
    for (int d0 = 0; d0 < 4; ++d0) qr[d0] = *(const bf16x8*)(Q + (rowbase + qpos) * PITCH + h * HD + cm * 64 + d0 * 16 + hi * 8);
    dma_tile(lds, 0, Kc, Vc, 0, dmo, wid);
    dma_tile(lds, 1, Kc, Vc, 64, dmo, wid);
    asm volatile("s_waitcnt vmcnt(0)" ::: "memory");
    WG_BAR();
    float m_reg = -1e30f, l_reg = 0.f; f32x16 o[4] = {};
    f32x16 p0, p1; bf16x8 pa0, pa1, pa2, pa3;
    const bool halfB = cm != 0;
    const int kl0 = (int)(unsigned)(uintptr_t)(lds + L_K);
    if (halfB) WG_BAR();
    for (int t = 0; t < NT; ++t) {
        __builtin_amdgcn_s_setprio(2);
        if (VAR != 2 && VAR != 3 && VAR != 7 && VAR != 8) { bf16x8 kf[8];
            kread<4>(kf, kl0 + (t & 3) * SHM_K, r32, hi, cm * 128);
            if (t > 0) pv_tile_pf(o, vb0 + ((t - 1) & 3) * SHM_V, pa0, pa1, pa2, pa3);
            asm volatile("s_waitcnt lgkmcnt(0)" ::: "memory"); SBAR();
            kmma<4>(p0, p1, kf, qr); } else { p0 = f32x16{}; p1 = f32x16{}; asm volatile("" : "+v"(p0), "+v"(p1)); }
        __builtin_amdgcn_s_setprio(0);
        if (halfB) asm volatile("s_waitcnt vmcnt(0)" ::: "memory");
        WG_BAR();
        const bool issue = VAR != 4 && VAR != 7 && VAR != 8 && t + 2 < NT;
        if (issue) dma_tile(lds, (t + 2) & 3, Kc, Vc, (t + 2) * 64, dmo, wid);
        { const int k0_ = t * 64; float sh_ = 0.f, alpha; const int dq_ = qpos - k0_ - 4 * hi;
          if (VAR != 8) { if (qw0 - (k0_ + 63) >= RFAR) sh_ = b31; else add_bias_lut(p0, p1, lut, dq_);
          if (k0_ + 63 > qw0) causal_mask(p0, p1, dq_); }
          if (VAR == 1 || VAR == 3 || VAR == 5 || VAR == 7 || VAR == 8) { alpha = 1.f; l_reg += p0[0] + sh_; u32x4 w0_ = {cvtpk(p0[0], p0[1]), cvtpk(p0[2], p0[3]), cvtpk(p0[4], p0[5]), cvtpk(p0[6], p0[7])}; pa0 = __builtin_bit_cast(bf16x8, w0_);
              u32x4 w1_ = {cvtpk(p0[8], p0[9]), cvtpk(p0[10], p0[11]), cvtpk(p0[12], p0[13]), cvtpk(p0[14], p0[15])}; pa1 = __builtin_bit_cast(bf16x8, w1_);
              u32x4 w2_ = {cvtpk(p1[0], p1[1]), cvtpk(p1[2], p1[3]), cvtpk(p1[4], p1[5]), cvtpk(p1[6], p1[7])}; pa2 = __builtin_bit_cast(bf16x8, w2_);
              u32x4 w3_ = {cvtpk(p1[8], p1[9]), cvtpk(p1[10], p1[11]), cvtpk(p1[12], p1[13]), cvtpk(p1[14], p1[15])}; pa3 = __builtin_bit_cast(bf16x8, w3_); }
          else softmax_tile(p0, p1, sh_, m_reg, l_reg, alpha, pa0, pa1, pa2, pa3);
          if (__any(alpha < 1.f)) { if (hi == 0) ws[r32] = alpha; asm volatile("s_waitcnt lgkmcnt(0)" ::: "memory");
#pragma unroll
              for (int d_ = 0; d_ < 4; ++d_)
#pragma unroll
                  for (int r = 0; r < 16; ++r) o[d_][r] *= ws[crow(r, hi)]; } }
        if (!halfB) { if (issue) asm volatile("s_waitcnt vmcnt(4)" ::: "memory"); else asm volatile("s_waitcnt vmcnt(0)" ::: "memory"); }
        WG_BAR();
    }
    __builtin_amdgcn_s_setprio(2);
    if (VAR != 2 && VAR != 3 && VAR != 7 && VAR != 8) pv_tile_pf(o, vb0 + ((NT - 1) & 3) * SHM_V, pa0, pa1, pa2, pa3);
    __builtin_amdgcn_s_setprio(0);
    if (!halfB) WG_BAR();
    WG_BAR();
    if (hi == 0) ws[32 + r32] = l_reg; asm volatile("s_waitcnt lgkmcnt(0)" ::: "memory");
#pragma unroll
    for (int r = 0; r < 16; ++r) { const float rl = __builtin_amdgcn_rcpf(ws[32 + crow(r, hi)]);
#pragma unroll
        for (int d0 = 0; d0 < 4; ++d0) o[d0][r] *= rl; }
    LAS float* xch = (LAS float*)lds + (size_t)w4 * 64 * 64;
    if (cm == 1) {
#pragma unroll
        for (int d0 = 0; d0 < 4; ++d0)
#pragma unroll
            for (int r = 0; r < 16; ++r) xch[(d0 * 16 + r) * 64 + lane] = o[d0][r];
    }
    WG_BAR();
    if (cm == 0) {
        float ss[16];
#pragma unroll
        for (int r = 0; r < 16; ++r) { float a = 0.f;
#pragma unroll
            for (int d0 = 0; d0 < 4; ++d0) { o[d0][r] -= lam_full * xch[(d0 * 16 + r) * 64 + lane]; a += o[d0][r] * o[d0][r]; }
            ss[r] = a; }
#pragma unroll
        for (int r = 0; r < 16; ++r) {
#pragma unroll
            for (int sft = 1; sft < 32; sft <<= 1) ss[r] += __shfl_xor(ss[r], sft); }
        float gg[4];
#pragma unroll
        for (int d0 = 0; d0 < 4; ++d0) gg[d0] = subg[d0 * 32 + r32] * (1.0f - LAMBDA_INIT);
        bf16* Ow = O + (rowbase + qw0) * PITCH + h * HD;
#pragma unroll
        for (int r = 0; r < 16; ++r) { const int orow = crow(r, hi); const float rs = 1.0f / sqrtf(ss[r] * (1.0f / HD) + RMS_EPS);
            u32x2 wo; wo.x = cvtpk(o[0][r] * rs * gg[0], o[1][r] * rs * gg[1]); wo.y = cvtpk(o[2][r] * rs * gg[2], o[3][r] * rs * gg[3]);
            *(u32x2*)(Ow + (size_t)orow * PITCH + r32 * 4) = wo; }
    }
    WG_BAR();
}


__device__ __forceinline__ void block_load(LAS char* lds, const bf16* Kc, const bf16* Vc, const DmaOff& d, int wid) {
#pragma unroll
    for (int t = 0; t < 4; ++t) dma_tile(lds, t, Kc, Vc, t * 64, d, wid);
}
#define MOBA_TILE(t, CAUSAL) do { const int k0_ = kbase + (t) * 64; \
        if (!(CAUSAL) || k0_ <= qw0 + 31) { f32x16 p0, p1; bf16x8 pa0, pa1, pa2, pa3; float alpha, sh = 0.f; \
            qkt<t, 8>(p0, p1, K_lds, r32, hi, 0, qr); \
            const int dq_ = qpos - k0_ - 4 * hi; \
            if (CAUSAL) { add_bias_lut(p0, p1, lut, dq_); if (k0_ + 63 > qw0) causal_mask(p0, p1, dq_); } \
            else { if (__all(qpos - (k0_ + 63) >= RFAR)) sh = b31; else add_bias_lut(p0, p1, lut, dq_ < RFAR + 63 ? dq_ : RFAR + 63); } \
            softmax_tile(p0, p1, sh, m_reg, l_reg, alpha, pa0, pa1, pa2, pa3); \
            if (__any(alpha < 1.f)) { if (hi == 0) ws[r32] = alpha; asm volatile("s_waitcnt lgkmcnt(0)" ::: "memory"); \
                _Pragma("unroll") for (int d_ = 0; d_ < 4; ++d_) _Pragma("unroll") for (int r = 0; r < 16; ++r) o[d_][r] *= ws[crow(r, hi)]; } \
            pv_tile<t>(o, vb0, pa0, pa1, pa2, pa3); } } while (0)
__device__ __forceinline__ void moba_part_group(LAS char* lds, int bh, int j, int g, int cntj, const bf16* Q, const unsigned short* lists, const unsigned* sel,
                                                bf16* P0, bf16* P1, bf16* P2, f32x2* ml, float b31, int wid, int lane) {
    asm volatile("" : "+v"(lane));
    const int r32 = lane & 31, hi = lane >> 5, b = bh >> 3, h = bh & 7;
    const size_t rowbase = (size_t)b * SEQ;
    const int idx = g * 32 + r32; const bool valid = idx < cntj;
    const int qpos = (int)lists[((size_t)bh * 32 + j) * 8192 + (valid ? idx : cntj - 1)];
    const unsigned smask = sel[(size_t)bh * SEQ + qpos]; const int slot = __popc(smask & ((1u << j) - 1u));
    const int vb0 = (int)(unsigned)(uintptr_t)(lds + L_V) + v_rd_base(lane);
    LAS float* ws = (LAS float*)(lds + L_WS) + wid * 64;
    LAS const float* lut = (LAS const float*)(lds + L_LUT);
    lcp K_lds = (lcp)(lds + L_K);
    bf16x8 qr[8];
#pragma unroll
    for (int d0 = 0; d0 < 8; ++d0) qr[d0] = *(const bf16x8*)(Q + (rowbase + qpos) * PITCH + h * HD + d0 * 16 + hi * 8);
    if (hi == 0) ((LAS int*)ws)[32 + r32] = valid ? (int)((unsigned)(rowbase + qpos) | ((unsigned)slot << 24)) : -1;
    float m_reg = -1e30f, l_reg = 0.f; f32x16 o[4] = {};
    const int kbase = j * 256, qw0 = 0; (void)qw0;
    MOBA_TILE(0, false); MOBA_TILE(1, false); MOBA_TILE(2, false); MOBA_TILE(3, false);
    if (hi == 0) { ws[r32] = l_reg; if (valid) ml[((size_t)slot * M + rowbase + qpos) * NH + h] = (f32x2){m_reg, l_reg}; }
    asm volatile("s_waitcnt lgkmcnt(0)" ::: "memory");
#pragma unroll
    for (int r = 0; r < 16; ++r) { const int orow = crow(r, hi); const float rl = __builtin_amdgcn_rcpf(ws[orow]); const int info = ((LAS const int*)ws)[32 + orow];
        const int sl = info >> 24; bf16* Pb = sl == 0 ? P0 : (sl == 1 ? P1 : P2); bf16* Ow = Pb + (size_t)(info & 0xffffff) * PITCH + h * HD;
        u32x2 w; w.x = cvtpk(o[0][r] * rl, o[1][r] * rl); w.y = cvtpk(o[2][r] * rl, o[3][r] * rl);
        if (info >= 0) *(u32x2*)(Ow + r32 * 4) = w; }
    asm volatile("s_waitcnt lgkmcnt(0)" ::: "memory");
}
__device__ __forceinline__ void moba_own_rows(LAS char* lds, int b, int h, int qb, const bf16* Q, bf16* O, const bf16* P0, const bf16* P1, const bf16* P2, const f32x2* ml, int wid, int lane) {
    asm volatile("" : "+v"(lane));
    const int r32 = lane & 31, hi = lane >> 5;
    const size_t rowbase = (size_t)b * SEQ;
    const int q0 = qb * 256, qw0 = q0 + wid * 32, qpos = qw0 + r32, kbase = q0;
    const int vb0 = (int)(unsigned)(uintptr_t)(lds + L_V) + v_rd_base(lane);
    LAS float* ws = (LAS float*)(lds + L_WS) + wid * 64;
    LAS const float* lut = (LAS const float*)(lds + L_LUT);
    lcp K_lds = (lcp)(lds + L_K);
    const float b31 = 0.f; (void)b31;
    bf16x8 qr[8];
#pragma unroll
    for (int d0 = 0; d0 < 8; ++d0) qr[d0] = *(const bf16x8*)(Q + (rowbase + qpos) * PITCH + h * HD + d0 * 16 + hi * 8);
    float m_reg = -1e30f, l_reg = 0.f; f32x16 o[4] = {};
    MOBA_TILE(0, true); MOBA_TILE(1, true); MOBA_TILE(2, true); MOBA_TILE(3, true);
    const int nsel = qb < 3 ? qb : 3;
    {
        float ms[3], ls[3]; float mx = m_reg;
#pragma unroll
        for (int s_ = 0; s_ < 3; ++s_) { ms[s_] = -1e30f; ls[s_] = 0.f;
            if (s_ < nsel) { const f32x2 v = ml[((size_t)s_ * M + rowbase + qpos) * NH + h]; ms[s_] = v.x; ls[s_] = v.y; mx = fmaxf(mx, v.x); } }
        const float w0 = __builtin_amdgcn_exp2f(m_reg - mx);
        float wv[3]; float den = l_reg * w0;
#pragma unroll
        for (int s_ = 0; s_ < 3; ++s_) { wv[s_] = ls[s_] * __builtin_amdgcn_exp2f(ms[s_] - mx); den += wv[s_]; }
        const float rd = 1.0f / den;
        if (hi == 0) *(LAS f32x4*)(lds + L_CF + wid * 512 + r32 * 16) = (f32x4){w0 * rd, wv[0] * rd, wv[1] * rd, wv[2] * rd};
    }
    asm volatile("s_waitcnt lgkmcnt(0)" ::: "memory");
#pragma unroll
    for (int r = 0; r < 16; ++r) { const int orow = crow(r, hi); const f32x4 cf = *(LAS const f32x4*)(lds + L_CF + wid * 512 + orow * 16);
        const size_t ro = (rowbase + qw0 + orow) * PITCH + h * HD + r32 * 4;
        float v0 = o[0][r] * cf.x, v1 = o[1][r] * cf.x, v2 = o[2][r] * cf.x, v3 = o[3][r] * cf.x;
        if (nsel > 0) { const u32x2 w = *(const u32x2*)(P0 + ro); v0 += cf.y * bflo(w.x); v1 += cf.y * bfhi(w.x); v2 += cf.y * bflo(w.y); v3 += cf.y * bfhi(w.y); }
        if (nsel > 1) { const u32x2 w = *(const u32x2*)(P1 + ro); v0 += cf.z * bflo(w.x); v1 += cf.z * bfhi(w.x); v2 += cf.z * bflo(w.y); v3 += cf.z * bfhi(w.y); }
        if (nsel > 2) { const u32x2 w = *(const u32x2*)(P2 + ro); v0 += cf.w * bflo(w.x); v1 += cf.w * bfhi(w.x); v2 += cf.w * bflo(w.y); v3 += cf.w * bfhi(w.y); }
        u32x2 wo; wo.x = cvtpk(v0, v1); wo.y = cvtpk(v2, v3);
        *(u32x2*)(O + ro) = wo; }
    asm volatile("s_waitcnt lgkmcnt(0)" ::: "memory");
}
#undef MOBA_TILE
#undef KSWZ
#undef SBAR
#undef WG_BAR
}


template <int VAR> __device__ __forceinline__ void p_diff_attn_mfma(const Args& a, LAS unsigned char* lds, int vcu, int tid, int wave, int lane, size_t out_off) {
    const bf16* Qb = (const bf16*)(a.ws + WS_Q); const bf16* Kb = (const bf16*)(a.ws + WS_K); const bf16* Vb = (const bf16*)(a.ws + WS_V);
    bf16* Ob = (bf16*)(a.ws + out_off); const float* biasT = (const float*)(a.ws + WS_BIAST);
    float lam_full;
    { const float* lm = a.diff_lambda; const float p01 = wave_sum(lm[lane] * lm[64 + lane]), p23 = wave_sum(lm[128 + lane] * lm[192 + lane]); lam_full = __expf(p01) - __expf(p23) + LAMBDA_INIT; }
    const int G = gridDim.x;
    if (G == 256) {
#pragma unroll 1
        for (int k = 0; k < 4; ++k) {
            const int bh = 2 * (vcu >> 5) + (k >> 1), p = vcu & 31, qb = (k & 1) ? 63 - p : p;
            att::diff_unit<VAR>((LAS char*)lds, bh >> 3, bh & 7, qb, Qb, Kb, Vb, Ob, a.rel_bias, biasT, lam_full, a.diff_subln_g, tid, wave, lane);
        }
    } else {
        for (int pp = vcu; pp < 512; pp += G) {
#pragma unroll 1
            for (int k = 0; k < 2; ++k) {
                const int bh = pp >> 5, p = pp & 31, qb = k ? 63 - p : p;
                att::diff_unit<VAR>((LAS char*)lds, bh >> 3, bh & 7, qb, Qb, Kb, Vb, Ob, a.rel_bias, biasT, lam_full, a.diff_subln_g, tid, wave, lane);
            }
        }
    }
}


__device__ __forceinline__ void p_moba_part(const Args& a, LAS unsigned char* lds, int vcu, int tid, int wave, int lane) {
    const bf16* Qb = (const bf16*)(a.ws + WS_Q); const bf16* Kb = (const bf16*)(a.ws + WS_K); const bf16* Vb = (const bf16*)(a.ws + WS_V);
    const unsigned* cnt = (const unsigned*)(a.ws + WS_CTL) + CW_CNT; const unsigned short* lists = (const unsigned short*)(a.ws + WS_LIST); const unsigned* sel = (const unsigned*)(a.ws + WS_SEL);
    bf16* P0 = (bf16*)(a.ws + WS_H); bf16* P1 = (bf16*)(a.ws + WS_Y); bf16* P2 = (bf16*)a.out; f32x2* ml = (f32x2*)((unsigned char*)a.out + WS_ML);
    LAS int* pre = (LAS int*)(lds + att::L_TAB); LAS int* found = (LAS int*)(lds + att::L_FOUND);
    const int c = (int)cnt[tid], nch = (c + 255) >> 8;
    int incl = nch;
#pragma unroll
    for (int o = 1; o < 64; o <<= 1) { const int v = __shfl_up(incl, o); if (lane >= o) incl += v; }
    if (lane == 63) pre[513 + wave] = incl;
    __syncthreads();
    int woff = 0;
#pragma unroll
    for (int w8 = 0; w8 < 8; ++w8) woff += (w8 < wave) ? pre[513 + w8] : 0;
    pre[tid + 1] = woff + incl; if (tid == 0) pre[0] = 0;
    __syncthreads();
    const int T = pre[512], G = gridDim.x;
    const int lo = (int)(((long long)T * vcu) / G), hi_ = (int)(((long long)T * (vcu + 1)) / G);
    const att::DmaOff dmo = att::dma_offsets(wave, lane);
    int last_h = -1;
    for (int it = lo; it < hi_;) {
        if (pre[tid] <= it && it < pre[tid + 1]) found[0] = tid;
        __syncthreads();
        const int f = __builtin_amdgcn_readfirstlane(found[0]);
        const int bh = f >> 5, j = f & 31, c0 = it - pre[f];
        const int seg_end = pre[f + 1] < hi_ ? pre[f + 1] : hi_, c1 = seg_end - pre[f];
        const int cntj = (int)cnt[f];
        const size_t kvoff = ((size_t)(bh >> 3) * SEQ + j * 256) * D + (bh & 7) * HD;
        att::block_load((LAS char*)lds, Kb + kvoff, Vb + kvoff, dmo, wave);
        if ((bh & 7) != last_h) { last_h = bh & 7; att::build_lut((LAS char*)lds, (const float*)(a.ws + WS_BIAST), last_h, tid); }
        const float b31 = a.rel_bias[31 * 8 + (bh & 7)] * LOG2E;
        asm volatile("s_waitcnt vmcnt(0)" ::: "memory");
        __syncthreads();
        for (int g = c0 * 8 + wave; g < c1 * 8 && g * 32 < cntj; g += 8)
            att::moba_part_group((LAS char*)lds, bh, j, g, cntj, Qb, lists, sel, P0, P1, P2, ml, b31, wave, lane);
        it = seg_end;
    }
}
__device__ __forceinline__ void p_moba_own(const Args& a, LAS unsigned char* lds, int vcu, int tid, int wave, int lane) {
    const bf16* Qb = (const bf16*)(a.ws + WS_Q); const bf16* Kb = (const bf16*)(a.ws + WS_K); const bf16* Vb = (const bf16*)(a.ws + WS_V); bf16* Ob = (bf16*)(a.ws + WS_O);
    const bf16* P0 = (const bf16*)(a.ws + WS_H); const bf16* P1 = (const bf16*)(a.ws + WS_Y); const bf16* P2 = (const bf16*)a.out; const f32x2* ml = (const f32x2*)((const unsigned char*)a.out + WS_ML);
    const int G = gridDim.x;
    const att::DmaOff dmo = att::dma_offsets(wave, lane);
    for (int u0 = 2 * vcu; u0 < 512; u0 += 2 * G) {
#pragma unroll 1
        for (int k = 0; k < 2; ++k) { const int u = u0 + k; if (u >= 512) break; const int bh = u >> 5, qb = u & 31;
            __syncthreads();
            const size_t kvoff = ((size_t)(bh >> 3) * SEQ + qb * 256) * D + (bh & 7) * HD;
            att::block_load((LAS char*)lds, Kb + kvoff, Vb + kvoff, dmo, wave);
            if (k == 0 || (u & 31) == 0) att::build_lut((LAS char*)lds, (const float*)(a.ws + WS_BIAST), bh & 7, tid);
            asm volatile("s_waitcnt vmcnt(0)" ::: "memory");
            __syncthreads();
            att::moba_own_rows((LAS char*)lds, bh >> 3, bh & 7, qb, Qb, Ob, P0, P1, P2, ml, wave, lane); }
    }
}

struct TI { int tid, lane, wave, gtid, gw; };
__device__ __forceinline__ TI mk_ti() { int t = threadIdx.x; asm volatile("" : "+v"(t)); TI r; r.tid = t; r.lane = t & 63; r.wave = __builtin_amdgcn_readfirstlane(t >> 6);
    r.gtid = blockIdx.x * NTHR + t; r.gw = blockIdx.x * NWAVES + r.wave; return r; }

typedef const __attribute__((address_space(4))) Args* CArgs;
__device__ __forceinline__ Args load_args() {
#if defined(__HIP_DEVICE_COMPILE__)
    auto p = __builtin_amdgcn_kernarg_segment_ptr(); asm volatile("" : "+s"(p));
    typedef const __attribute__((address_space(4))) unsigned long long* cu64; cu64 q = (cu64)p;
    Args r; r.x = (const float*)q[0]; r.c = (const float*)q[1]; r.rel_bias = (const float*)q[2]; r.ada_w = (const float*)q[3]; r.ada_b = (const float*)q[4]; r.norm_g = (const float*)q[5];
    r.moba_w_qkv = (const float*)q[6]; r.moba_w_o = (const float*)q[7]; r.diff_w_qkv = (const float*)q[8]; r.diff_w_o = (const float*)q[9];
    r.diff_lambda = (const float*)q[10]; r.diff_subln_g = (const float*)q[11]; r.ffn_w_in = (const float*)q[12]; r.ffn_w_out = (const float*)q[13];
    r.out = (float*)q[14]; r.ws = (unsigned char*)q[15]; return r;
#else
    return Args{};
#endif
}
#define WSP(T, off) ((T*)(a.ws + (off)))
#define GEMM_PHASE(EPI, Aptr, Wptr, N_, K_, ...) do { const Args a = load_args(); const int G_ = gridDim.x; \
        pg8::Gemm g{Aptr, (const bf16*)(Wptr), M, N_, K_}; pg8::StaticOrder S; S.init(M, N_, G_, (int)blockIdx.x); \
        EPI E{__VA_ARGS__}; pg8::gemm_phase<EPI, pg8::StaticOrder, true, true>(lds, g, S, E); } while (0)
__global__ void __launch_bounds__(NTHR, 2) fwd(Args a_unused) {
    extern __shared__ __attribute__((aligned(16))) unsigned char lds_raw[];
    LAS unsigned char* lds = (LAS unsigned char*)lds_raw;
    volatile LAS unsigned* MISC = (volatile LAS unsigned*)(lds + MISC_OFF);
    for (int u = threadIdx.x; u < 64; u += NTHR) MISC[u] = 0u;
    __syncthreads();
    XcdBarrier bar;
    { const Args a = load_args(); bar = xcd_barrier_post(WSP(unsigned, WS_CTL) + CW_BAR, MISC + 8); }
#define VCU() ((gridDim.x % 8 == 0) ? (int)((blockIdx.x % 8) * (gridDim.x / 8) + blockIdx.x / 8) : (int)blockIdx.x)
#define NGW() ((int)gridDim.x * NWAVES)
#define NGT() ((int)gridDim.x * NTHR)
    constexpr float QS0 = 0.08838834764831845f * LOG2E, QS1 = 0.125f * LOG2E;
    constexpr size_t QKVS = (size_t)(WS_K - WS_Q) / 2;

    { const Args a = load_args(); const TI t = mk_ti(); p_weights(a, lds, t.gw, NGW(), t.wave, t.lane); p_wo_perm(a, t.gtid, NGT()); __syncthreads(); p_mod(a, lds, (int)blockIdx.x, (int)gridDim.x, t.tid, t.wave, t.lane); }
    xcd_barrier(bar);
    { const Args a = load_args(); const TI t = mk_ti(); const float* md = WSP(const float, WS_MOD); p_norm_in(a.x, a.norm_g, md, md + 1024, WSP(bf16, WS_H), t.gw, NGW(), t.lane); }
    xcd_barrier(bar);
    GEMM_PHASE(pg8::EpiQKV, WSP(bf16, WS_H), a.ws + WS_W + WO_QKV, 3 * D, D, WSP(bf16, WS_Q), D, QKVS, QS0, WSP(float, WS_KSUM));
    xcd_barrier(bar);
    { const Args a = load_args(); const TI t = mk_ti(); p_gate(WSP(bf16, WS_Q), WSP(const float, WS_KSUM), WSP(unsigned, WS_SEL), WSP(unsigned, WS_CTL) + CW_CNT, WSP(unsigned short, WS_LIST), lds, (int)blockIdx.x, (int)gridDim.x, t.tid, t.wave, t.lane); }
    xcd_barrier(bar);
    { const Args a = load_args(); const TI t = mk_ti(); p_moba_part(a, lds, VCU(), t.tid, t.wave, t.lane); }
    xcd_barrier(bar);
    { const Args a = load_args(); const TI t = mk_ti(); p_moba_own(a, lds, VCU(), t.tid, t.wave, t.lane); }
    xcd_barrier(bar);
    GEMM_PHASE(pg8::EpiBf16<0>, WSP(bf16, WS_O), a.ws + WS_W + WO_O, D, D, WSP(bf16, WS_Y), D, nullptr, 0, 0, 1.f);
    xcd_barrier(bar);
    { const Args a = load_args(); const TI t = mk_ti(); const float* md = WSP(const float, WS_MOD); const float* ng = a.norm_g;
      p_post(a.x, WSP(bf16, WS_Y), ng + D, md + 2048, a.out, ng + 2 * D, md + 3072, md + 4096, WSP(bf16, WS_H), t.gw, NGW(), t.lane); }
    xcd_barrier(bar);
    GEMM_PHASE(pg8::EpiSwiglu, WSP(bf16, WS_H), a.ws + WS_W + WO_IN, 2 * DFF, D, WSP(bf16, WS_HH), DFF);
    xcd_barrier(bar);
    GEMM_PHASE(pg8::EpiBf16<0>, WSP(bf16, WS_HH), a.ws + WS_W + WO_OUT, D, DFF, WSP(bf16, WS_Y), D, nullptr, 0, 0, 1.f);
    xcd_barrier(bar);
    { const Args a = load_args(); const TI t = mk_ti(); const float* md = WSP(const float, WS_MOD); const float* ng = a.norm_g; const float* md1 = md + 2 * 6144; const float* ng1 = ng + 4 * D;
      p_post(a.out, WSP(bf16, WS_Y), ng + 3 * D, md + 5120, a.out, ng1, md1, md1 + 1024, WSP(bf16, WS_H), t.gw, NGW(), t.lane); }
    xcd_barrier(bar);
    GEMM_PHASE(pg8::EpiQKV, WSP(bf16, WS_H), a.ws + WS_W + WL_STRIDE + WO_QKV, 3 * D, D, WSP(bf16, WS_Q), D, QKVS, QS1, nullptr);
    xcd_barrier(bar);
    { const Args a = load_args(); const TI t = mk_ti(); p_diff_attn_mfma<0>(a, lds, VCU(), t.tid, t.wave, t.lane, WS_O); }
#ifdef PROBE_VAR
    { const Args a = load_args(); const TI t = mk_ti(); p_diff_attn_mfma<PROBE_VAR>(a, lds, VCU(), t.tid, t.wave, t.lane, WS_Y); }
#endif
    xcd_barrier(bar);
    GEMM_PHASE(pg8::EpiBf16<0>, WSP(bf16, WS_O), a.ws + WS_W + WL_STRIDE + WO_O, D, D, WSP(bf16, WS_Y), D, nullptr, 0, 0, 1.f);
    xcd_barrier(bar);
    { const Args a = load_args(); const TI t = mk_ti(); const float* md = WSP(const float, WS_MOD) + 2 * 6144; const float* ng = a.norm_g + 4 * D;
      p_post(a.out, WSP(bf16, WS_Y), ng + D, md + 2048, a.out, ng + 2 * D, md + 3072, md + 4096, WSP(bf16, WS_H), t.gw, NGW(), t.lane); }
    xcd_barrier(bar);
    GEMM_PHASE(pg8::EpiSwiglu, WSP(bf16, WS_H), a.ws + WS_W + WL_STRIDE + WO_IN, 2 * DFF, D, WSP(bf16, WS_HH), DFF);
    xcd_barrier(bar);
    GEMM_PHASE(pg8::EpiBf16<0>, WSP(bf16, WS_HH), a.ws + WS_W + WL_STRIDE + WO_OUT, D, DFF, WSP(bf16, WS_Y), D, nullptr, 0, 0, 1.f);
    xcd_barrier(bar);
    { const Args a = load_args(); const TI t = mk_ti(); const float* md = WSP(const float, WS_MOD) + 2 * 6144; const float* ng = a.norm_g + 4 * D;
      p_post(a.out, WSP(bf16, WS_Y), ng + 3 * D, md + 5120, a.out, nullptr, nullptr, nullptr, nullptr, t.gw, NGW(), t.lane); }
}

extern "C" void kernel_launch(void* const* d_in, const int* in_sizes, int n_in, void* d_out, int out_size, void* d_ws, size_t ws_size, hipStream_t stream) {
    static int grid = 0;
    if (grid == 0) {
        if (n_in != 14 || out_size != M * D || ws_size < WS_END) { fprintf(stderr, "kernel_launch: unexpected shapes n_in %d out %d ws %zu\n", n_in, out_size, ws_size); grid = -1; return; }
        int dev = 0, cus = 0;
        if (hipGetDevice(&dev) != hipSuccess || hipDeviceGetAttribute(&cus, hipDeviceAttributeMultiprocessorCount, dev) != hipSuccess) { grid = -1; return; }
        if (hipFuncSetAttribute((const void*)fwd, hipFuncAttributeMaxDynamicSharedMemorySize, LDS_BYTES) != hipSuccess) { fprintf(stderr, "hipFuncSetAttribute failed\n"); grid = -1; return; }
        grid = cus;
    }
    if (grid < 0) return;
    (void)hipMemsetAsync((char*)d_ws + WS_CTL, 0, CTL_ZERO_BYTES, stream);
    Args a{};
    a.x = (const float*)d_in[0]; a.c = (const float*)d_in[1]; a.rel_bias = (const float*)d_in[2]; a.ada_w = (const float*)d_in[3]; a.ada_b = (const float*)d_in[4];
    a.norm_g = (const float*)d_in[5]; a.moba_w_qkv = (const float*)d_in[6]; a.moba_w_o = (const float*)d_in[7]; a.diff_w_qkv = (const float*)d_in[8]; a.diff_w_o = (const float*)d_in[9];
    a.diff_lambda = (const float*)d_in[10]; a.diff_subln_g = (const float*)d_in[11]; a.ffn_w_in = (const float*)d_in[12]; a.ffn_w_out = (const float*)d_in[13];
    a.out = (float*)d_out; a.ws = (unsigned char*)d_ws;
    hipLaunchKernelGGL(fwd, dim3(grid), dim3(NTHR), LDS_BYTES, stream, a);
}
```

```cpp
#include <hip/hip_runtime.h>
#include <cstdio>
#include <cstdint>

#define GAS __attribute__((address_space(1)))
#define LAS __attribute__((address_space(3)))
typedef unsigned short bf16;
typedef float f32x4 __attribute__((ext_vector_type(4)));
typedef float f32x2 __attribute__((ext_vector_type(2)));
typedef unsigned u32x4 __attribute__((ext_vector_type(4)));
typedef unsigned u32x2 __attribute__((ext_vector_type(2)));

constexpr int BATCH = 2, SEQ = 8192, D = 1024, NH = 8, HD = 128, DFF = 2816, NBKT = 32;
constexpr int M = BATCH * SEQ;
constexpr int NWAVES = 8, NTHR = 512;
constexpr float RMS_EPS = 1e-6f;
constexpr float LOG2E = 1.4426950408889634f;
constexpr float LAMBDA_INIT = 0.35550906759096926f;

constexpr size_t MiB = 1u << 20;
constexpr size_t WS_CTL = 0, CTL_ZERO_BYTES = 1 * MiB;
constexpr size_t WS_MOD = 1 * MiB;
constexpr size_t WS_BLUT = WS_MOD + 128 * 1024;
constexpr size_t WS_KMEAN = WS_BLUT + 16 * 1024;
constexpr size_t WS_SEL = WS_KMEAN + 256 * 1024;
constexpr size_t WS_BIAST = WS_SEL + 512 * 1024;
constexpr size_t WS_LIST = 244 * MiB;
constexpr size_t WS_ML = 32 * MiB;
constexpr size_t WS_KSUM = 256 * 1024;
constexpr int CW_CNT = 8192;
constexpr size_t WS_W = 2 * MiB, WL_STRIDE = 25 * MiB;
constexpr size_t WO_QKV = 0, WO_O = 6 * MiB, WO_IN = 8 * MiB, WO_OUT = 19 * MiB;
constexpr size_t WS_H = 52 * MiB;
constexpr size_t WS_Q = 84 * MiB, WS_K = 116 * MiB, WS_V = 148 * MiB;
constexpr size_t WS_HH = 84 * MiB;
constexpr size_t WS_O = 180 * MiB;
constexpr size_t WS_Y = 212 * MiB;
constexpr size_t WS_END = 252 * MiB;
constexpr int CW_BAR = 4096;

constexpr int LDS_BYTES = 155648;
constexpr int MISC_OFF = 150016;

#define RLX_AGENT __ATOMIC_RELAXED, __HIP_MEMORY_SCOPE_AGENT
__device__ __forceinline__ unsigned f2bf(float f) { unsigned u = __builtin_bit_cast(unsigned, f); return (u + 0x7fffu + ((u >> 16) & 1u)) >> 16; }
__device__ __forceinline__ unsigned pk2(float lo, float hi) { return f2bf(lo) | (f2bf(hi) << 16); }
__device__ __forceinline__ float bf2f(unsigned short b) { return __builtin_bit_cast(float, (unsigned)b << 16); }
__device__ __forceinline__ float bflo(unsigned w) { return __builtin_bit_cast(float, w << 16); }
__device__ __forceinline__ float bfhi(unsigned w) { return __builtin_bit_cast(float, w & 0xffff0000u); }

__device__ __forceinline__ int lane_opaque() { int l; asm volatile("v_mbcnt_lo_u32_b32 %0, -1, 0\n\tv_mbcnt_hi_u32_b32 %0, -1, %0" : "=v"(l)); return l; }
__device__ __forceinline__ float bperm_f(int src_lane, float v) { return __builtin_bit_cast(float, __builtin_amdgcn_ds_bpermute(src_lane << 2, __builtin_bit_cast(int, v))); }
__device__ __forceinline__ int bperm_i(int src_lane, int v) { return __builtin_amdgcn_ds_bpermute(src_lane << 2, v); }

#define XB_TMO      128
#define XB_XCNT(j)  (256  + 64 * (j))
#define XB_XSUB(j)  (1280 + 64 * (j))
#define XB_XGEN(j)  (2304 + 64 * (j))
#define XB_TOP      3328
#define XB_TOPGEN   3392
#define XCD_BAR_WORDS 3456
#define XB_SPIN_CAP (1u << 25)
__device__ __forceinline__ unsigned xb_ld(unsigned* p)              { return __hip_atomic_load(p, __ATOMIC_RELAXED, __HIP_MEMORY_SCOPE_AGENT); }
__device__ __forceinline__ unsigned xb_add(unsigned* p, unsigned v) { return __hip_atomic_fetch_add(p, v, __ATOMIC_RELAXED, __HIP_MEMORY_SCOPE_AGENT); }
__device__ __forceinline__ unsigned xb_xcc_id() { return (unsigned)__builtin_amdgcn_s_getreg((3 << 11) | 20) & 0xFu; }
#define XB_SPIN(cond, bar) do { unsigned _sp = 0; while (cond) { __builtin_amdgcn_s_sleep(1); \
    if ((++_sp & 255u) == 0u) { if (xb_ld(&(bar)[XB_TMO])) break; if (_sp > XB_SPIN_CAP) { atomicAdd(&(bar)[XB_TMO], 1u); break; } } } } while (0)
struct XcdBarrier { unsigned* bar; unsigned x; volatile LAS unsigned* st; int wave; };
__device__ __forceinline__ XcdBarrier xcd_barrier_post(unsigned* bar, volatile LAS unsigned* st, int wave) {
    XcdBarrier b; b.bar = bar; b.x = xb_xcc_id(); b.st = st; b.wave = wave;
    if (wave == 0 && lane_opaque() == 0) (void)xb_add(&bar[XB_XCNT(b.x)], 1u);
    return b;
}
__device__ __forceinline__ void xcd_barrier_complete(unsigned* bar, unsigned x, unsigned& nloc, unsigned& nx) {
    const unsigned G = gridDim.x * gridDim.y * gridDim.z;
    unsigned sum, cnt, mine, sp = 0u;
    for (;;) {
        sum = 0u; cnt = 0u; mine = 0u;
#pragma unroll
        for (unsigned j = 0; j < 16; ++j) { const unsigned c = xb_ld(&bar[XB_XCNT(j)]); sum += c; cnt += (c > 0u) ? 1u : 0u; mine = (j == x) ? c : mine; }
        if (sum == G) break;
        __builtin_amdgcn_s_sleep(1);
        if ((++sp & 255u) == 0u) { if (xb_ld(&bar[XB_TMO])) break; if (sp > XB_SPIN_CAP) { atomicAdd(&bar[XB_TMO], 1u); break; } }
    }
    nloc = mine > 0u ? mine : 1u; nx = cnt > 0u ? cnt : 1u;
}
__device__ __forceinline__ void xcd_barrier(const XcdBarrier& b) {
    asm volatile("s_waitcnt vmcnt(0)" ::: "memory");
    __syncthreads();
    if (b.wave == 0 && lane_opaque() == 0) {
        unsigned* bar = b.bar;
        __builtin_amdgcn_s_waitcnt(0);
        unsigned nloc = b.st[0], nx = b.st[1];
        if (nloc == 0u) { xcd_barrier_complete(bar, b.x, nloc, nx); b.st[0] = nloc; b.st[1] = nx; }
        const unsigned old = xb_add(&bar[XB_XSUB(b.x)], 1u);
        const unsigned gen = old / nloc;
        if (old + 1u == (gen + 1u) * nloc) {
            __builtin_amdgcn_fence(__ATOMIC_RELEASE, "agent");
            asm volatile("s_waitcnt vmcnt(0)" ::: "memory");
            const unsigned og = xb_add(&bar[XB_TOP], 1u);
            const unsigned tg = og / nx;
            if (og + 1u == (tg + 1u) * nx) xb_add(&bar[XB_TOPGEN], 1u);
            else XB_SPIN(xb_ld(&bar[XB_TOPGEN]) == tg, bar);
            __builtin_amdgcn_fence(__ATOMIC_ACQUIRE, "agent");
            xb_add(&bar[XB_XGEN(b.x)], 1u);
            asm volatile("s_waitcnt vmcnt(0)" ::: "memory");
        } else {
            XB_SPIN(xb_ld(&bar[XB_XGEN(b.x)]) == gen, bar);
            __builtin_amdgcn_fence(__ATOMIC_ACQUIRE, "agent");
            asm volatile("s_waitcnt vmcnt(0)" ::: "memory");
        }
    }
    __syncthreads();
}

namespace pg8 {
#define PG8_LAS __attribute__((address_space(3)))
typedef unsigned short bf16_t;
typedef short bf16x8 __attribute__((ext_vector_type(8)));
typedef float f32x4 __attribute__((ext_vector_type(4)));
typedef unsigned u32x4 __attribute__((ext_vector_type(4)));
constexpr int BM = 256, BK = 64, HALF = 128, HTB = HALF * BK * 2  , STAGE_BYTES = 8 * HTB, NXCD = 8, WGM = 8;

__host__ __device__ __forceinline__ int lds_byte(int r, int c) { const int st = (r >> 4) * 2 + (c >> 5), rr = r & 15, cc = c & 31, ob = rr * 64 + cc * 2; return st * 1024 + (ob ^ (((ob >> 9) & 1) << 5)); }
__host__ __device__ __forceinline__ void stage_rc(int b, int& R, int& C) { const int st = b / 1024, sb = b % 1024, swz = sb ^ (((sb >> 9) & 1) << 5); R = (st >> 1) * 16 + swz / 64; C = (st & 1) * 32 + (swz % 64) / 2; }
__host__ __device__ __forceinline__ int perm32(int rho) { const int n = rho >> 4, i = rho & 15; return 8 * (i >> 2) + 4 * n + (i & 3); }

struct Unit { int pm, pn; };
struct Gemm { const bf16_t* A; const bf16_t* Bt; int M, N, K; };

struct StaticOrder {
    int nM, nN, nwg, G, c;
    __host__ __device__ void init(int M, int N, int G_, int c_) { nM = M / BM; nN = N / BM; nwg = nM * nN; G = G_; c = c_; }
    __host__ __device__ bool next(int i, Unit& u) const {
        const long L = (long)i * G + c; if (L >= nwg) return false;
        int wgid = (int)L; { const int q = nwg / NXCD, r = nwg % NXCD, xcd = wgid % NXCD, off = wgid / NXCD; wgid = (xcd < r ? xcd * (q + 1) : r * (q + 1) + (xcd - r) * q) + off; }
        const int nig = WGM * nN, gid = wgid / nig, fm = gid * WGM, gsz = (nM - fm) < WGM ? (nM - fm) : WGM;
        u.pm = fm + ((wgid % nig) % gsz); u.pn = (wgid % nig) / gsz; return true;
    }
    __device__ __forceinline__ void a_ready(const Unit&) const {}
    __device__ __forceinline__ void done(const Unit&) const {}
};

__device__ __forceinline__ unsigned cvt_pk_bf16(float lo, float hi) { unsigned r; asm volatile("v_cvt_pk_bf16_f32 %0, %1, %2" : "=v"(r) : "v"(lo), "v"(hi)); return r; }
typedef float f32x2 __attribute__((ext_vector_type(2)));
__device__ __forceinline__ f32x2 gelu_pk(f32x2 v) {
    const f32x2 av = __builtin_elementwise_abs(v), d = av * 0.2316418882f + 1.0f;
    f32x2 t; t.x = __builtin_amdgcn_rcpf(d.x); t.y = __builtin_amdgcn_rcpf(d.y);
    f32x2 q = t * 0.5307027145f + (-0.7265760135f); q = q * t + 0.7107068705f; q = q * t + (-0.142248368f); q = q * t + 0.127414796f; q = q * t;
    const f32x2 s = (v * v) * (-0.72134752044f);
    f32x2 e; e.x = __builtin_amdgcn_exp2f(s.x); e.y = __builtin_amdgcn_exp2f(s.y);
    const f32x2 m = v * (q * e), r = v - m;
    f32x2 o; o.x = v.x < 0.f ? m.x : r.x; o.y = v.y < 0.f ? m.y : r.y; return o;
}

template <int ACT  > struct EpiBf16 {
    static constexpr bool PERM = true, AFTER_DRAIN = false; static_assert(ACT == 0 || ACT == 1, "EpiBf16: ACT is 0 (none) or 1 (gelu_pk)");
    bf16_t* O; int ldc; const float* bias; int split_cols; size_t split_stride; float scale0;
    __device__ __forceinline__ void operator()(const f32x4 (&acc)[2][2][4][2], const Unit& u, int wr, int wc, int fr, int fq) const {
        const int row0 = u.pm * BM + wr * 64 + fr; int colt = u.pn * BM; bf16_t* base = O;
        float sc = 1.f; if (split_cols) { const int t = colt / split_cols; base += (size_t)t * split_stride; colt -= t * split_cols; if (t == 0) sc = scale0; }
        const int col0 = colt + wc * 32 + 8 * fq, bcol0 = u.pn * BM + wc * 32 + 8 * fq;
        f32x4 bv[2][2];
#pragma unroll
        for (int bj = 0; bj < 2; ++bj)
#pragma unroll
            for (int n = 0; n < 2; ++n) bv[bj][n] = bias ? *(const f32x4*)(bias + bcol0 + bj * HALF + 4 * n) : (f32x4){0.f, 0.f, 0.f, 0.f};
#pragma unroll
        for (int ai = 0; ai < 2; ++ai)
#pragma unroll
            for (int m = 0; m < 4; ++m) { bf16_t* rowp = base + (size_t)(row0 + ai * HALF + m * 16) * ldc + col0;
#pragma unroll
                for (int bj = 0; bj < 2; ++bj) { f32x4 v0 = acc[ai][bj][m][0] + bv[bj][0], v1 = acc[ai][bj][m][1] + bv[bj][1];
                    if (ACT == 1) { f32x2 a = gelu_pk((f32x2){v0[0], v0[1]}), b = gelu_pk((f32x2){v0[2], v0[3]}), c = gelu_pk((f32x2){v1[0], v1[1]}), d = gelu_pk((f32x2){v1[2], v1[3]});
                        v0 = (f32x4){a.x, a.y, b.x, b.y}; v1 = (f32x4){c.x, c.y, d.x, d.y}; }
                    v0 = v0 * sc; v1 = v1 * sc; u32x4 w; w.x = cvt_pk_bf16(v0[0], v0[1]); w.y = cvt_pk_bf16(v0[2], v0[3]); w.z = cvt_pk_bf16(v1[0], v1[1]); w.w = cvt_pk_bf16(v1[2], v1[3]);
                    *(u32x4*)(rowp + bj * HALF) = w; } }
    }
};

struct EpiQKV {
    static constexpr bool PERM = true, AFTER_DRAIN = false;
    bf16_t* O; int ldc; size_t split_stride; float scale0; float* ksum;
    __device__ __forceinline__ void operator()(const f32x4 (&acc)[2][2][4][2], const Unit& u, int wr, int wc, int fr, int fq) const {
        const int row0 = u.pm * BM + wr * 64 + fr; const int t = (u.pn * BM) / ldc; const int colt = u.pn * BM - t * ldc; bf16_t* base = O + (size_t)t * split_stride;
        const float sc = t == 0 ? scale0 : 1.f;
        const int col0 = colt + wc * 32 + 8 * fq;
#pragma unroll
        for (int ai = 0; ai < 2; ++ai)
#pragma unroll
            for (int m = 0; m < 4; ++m) { bf16_t* rowp = base + (size_t)(row0 + ai * HALF + m * 16) * ldc + col0;
#pragma unroll
                for (int bj = 0; bj < 2; ++bj) { const f32x4 v0 = acc[ai][bj][m][0] * sc, v1 = acc[ai][bj][m][1] * sc;
                    u32x4 w; w.x = cvt_pk_bf16(v0[0], v0[1]); w.y = cvt_pk_bf16(v0[2], v0[3]); w.z = cvt_pk_bf16(v1[0], v1[1]); w.w = cvt_pk_bf16(v1[2], v1[3]);
                    *(u32x4*)(rowp + bj * HALF) = w; } }
        if (ksum != nullptr && t == 1) {
            const int b = u.pm >> 5, blk = u.pm & 31, lq_ = lane_opaque();
#pragma unroll
            for (int bj = 0; bj < 2; ++bj) { const int h = (colt >> 7) + bj;
                float* dst = ksum + ((size_t)((b * 8 + h) * 32 + blk)) * 128 + wc * 32 + 8 * fq;
#pragma unroll
                for (int n = 0; n < 2; ++n) { f32x4 sacc = (f32x4){0.f, 0.f, 0.f, 0.f};
#pragma unroll
                    for (int ai = 0; ai < 2; ++ai)
#pragma unroll
                        for (int m = 0; m < 4; ++m) sacc += acc[ai][bj][m][n];
#pragma unroll
                    for (int e = 0; e < 4; ++e) { float v = sacc[e];
                        v += bperm_f(lq_ ^ 1, v); v += bperm_f(lq_ ^ 2, v); v += bperm_f(lq_ ^ 4, v); v += bperm_f(lq_ ^ 8, v);
                        if (fr == 0) atomicAdd(dst + 4 * n + e, v); } } }
        }
    }
};

struct EpiSwiglu {
    static constexpr bool PERM = true, AFTER_DRAIN = false;
    bf16_t* O; int ldc; float inv;
    __device__ __forceinline__ void operator()(const f32x4 (&acc)[2][2][4][2], const Unit& u, int wr, int wc, int fr, int fq) const {
        const int row0 = u.pm * BM + wr * 64 + fr, col0 = u.pn * HALF + wc * 32 + 8 * fq;
#pragma unroll
        for (int ai = 0; ai < 2; ++ai)
#pragma unroll
            for (int m = 0; m < 4; ++m) { bf16_t* rowp = O + (size_t)(row0 + ai * HALF + m * 16) * ldc + col0;
                float v[8];
#pragma unroll
                for (int n = 0; n < 2; ++n)
#pragma unroll
                    for (int e = 0; e < 4; ++e) { const float g = acc[ai][0][m][n][e] * inv, uu = acc[ai][1][m][n][e] * inv;
                        v[n * 4 + e] = g * __builtin_amdgcn_rcpf(1.0f + __builtin_amdgcn_exp2f(-1.4426950408889634f * g)) * uu; }
                u32x4 w; w.x = cvt_pk_bf16(v[0], v[1]); w.y = cvt_pk_bf16(v[2], v[3]); w.z = cvt_pk_bf16(v[4], v[5]); w.w = cvt_pk_bf16(v[6], v[7]);
                *(u32x4*)rowp = w; }
    }
};
template <class Epi, class Sched, bool ALIGN_EPI = false, bool SP2 = false, bool FP8 = false>
__device__ __forceinline__ void gemm_phase(PG8_LAS unsigned char* lds, const Gemm g, const Sched& S, const Epi& E, const int wave0) {
    const int tid_ = wave0 * 64 + lane_opaque();
    const int tid = tid_, wid = __builtin_amdgcn_readfirstlane(tid >> 6), lane = tid & 63, wr = wid >> 2, wc = wid & 3, fr = lane & 15, fq = lane >> 4;
    const int K = g.K, nt = K / BK;
    unsigned voffA[2], voffB[2];
#pragma unroll
    for (int i = 0; i < 2; ++i) { int R, C; stage_rc(tid * 16 + i * 8192, R, C); const int Rb = Epi::PERM ? ((R & ~31) + perm32(R & 31)) : R;
        voffA[i] = (unsigned)(R * K + C) * 2u; voffB[i] = (unsigned)(Rb * K + C) * 2u; }
    const size_t kstep = (size_t)(BK * 2);
    const size_t hstep = (size_t)HALF * K * 2;
    const size_t tstep = 2 * hstep;
    const unsigned ldsw = (unsigned)wid * 1024u;
    const int aoff = lds_byte(wr * 64 + fr, fq * 8), boff = lds_byte(wc * 32 + fr, fq * 8);
#define PG8_SA(b, h) (((b) * 2 + (h)) * HTB)
#define PG8_SB(b, h) ((4 + (b) * 2 + (h)) * HTB)
#define PG8_STAGE(bufoff, gbase, voff) do { _Pragma("unroll") for (int _i = 0; _i < 2; ++_i) \
        __builtin_amdgcn_global_load_lds((const unsigned*)((const char*)(gbase) + (voff)[_i]), (PG8_LAS unsigned*)(lds + (bufoff) + ldsw + _i * 8192), 16, 0, 0); } while (0)
#define PG8_LDA(dst, b, h) do { _Pragma("unroll") for (int m = 0; m < 4; ++m) _Pragma("unroll") for (int k = 0; k < 2; ++k) dst[m][k] = *(const PG8_LAS bf16x8*)(lds + PG8_SA(b, h) + aoff + m * 2048 + k * 1024); } while (0)
#define PG8_LDB(dst, b, h) do { _Pragma("unroll") for (int n = 0; n < 2; ++n) _Pragma("unroll") for (int k = 0; k < 2; ++k) dst[n][k] = *(const PG8_LAS bf16x8*)(lds + PG8_SB(b, h) + boff + n * 2048 + k * 1024); } while (0)
#define PG8_MMA(ai, bj, At, Bt) do { __builtin_amdgcn_s_setprio(1); \
        if constexpr (FP8) { typedef int i32x8_t __attribute__((ext_vector_type(8))); typedef int i32x4_t __attribute__((ext_vector_type(4))); \
            _Pragma("unroll") for (int m = 0; m < 4; ++m) _Pragma("unroll") for (int n = 0; n < 2; ++n) { \
                const i32x4_t b0_ = __builtin_bit_cast(i32x4_t, Bt[n][0]), b1_ = __builtin_bit_cast(i32x4_t, Bt[n][1]), a0_ = __builtin_bit_cast(i32x4_t, At[m][0]), a1_ = __builtin_bit_cast(i32x4_t, At[m][1]); \
                const i32x8_t bb_ = {b0_[0], b0_[1], b0_[2], b0_[3], b1_[0], b1_[1], b1_[2], b1_[3]}, aa_ = {a0_[0], a0_[1], a0_[2], a0_[3], a1_[0], a1_[1], a1_[2], a1_[3]}; \
                asm volatile("v_mfma_f32_16x16x128_f8f6f4 %0, %1, %2, %0" : "+v"(acc[ai][bj][m][n]) : "v"(bb_), "v"(aa_)); } } \
        else { _Pragma("unroll") for (int m = 0; m < 4; ++m) _Pragma("unroll") for (int n = 0; n < 2; ++n) _Pragma("unroll") for (int k = 0; k < 2; ++k) \
        acc[ai][bj][m][n] = __builtin_amdgcn_mfma_f32_16x16x32_bf16(Bt[n][k], At[m][k], acc[ai][bj][m][n], 0, 0, 0); } __builtin_amdgcn_s_setprio(0); } while (0)
#define PG8_WAIT_V(n) asm volatile("s_waitcnt vmcnt(" #n ")" ::: "memory")
#define PG8_WAIT_L(n) asm volatile("s_waitcnt lgkmcnt(" #n ")" ::: "memory")
#define PG8_BAR __builtin_amdgcn_s_barrier()
#define PG8_SCHED __builtin_amdgcn_sched_barrier(0)
    Unit cur, nxt; int ui = 0;
    if (!S.next(0, cur)) return;
    f32x4 acc[2][2][4][2];
#pragma unroll
    for (int a = 0; a < 2; ++a)
#pragma unroll
        for (int b = 0; b < 2; ++b)
#pragma unroll
            for (int m = 0; m < 4; ++m)
#pragma unroll
                for (int n = 0; n < 2; ++n) acc[a][b][m][n] = (f32x4){0.f, 0.f, 0.f, 0.f};
    bf16x8 At[4][2], B0[2][2], B1[2][2];
    const char* cA = (const char*)g.A + (size_t)cur.pm * tstep; const char* cB = (const char*)g.Bt + (size_t)cur.pn * tstep;
    S.a_ready(cur);
    if constexpr (SP2) {
        PG8_STAGE(PG8_SB(0, 0), cB, voffB); PG8_STAGE(PG8_SB(0, 1), cB + hstep, voffB); PG8_STAGE(PG8_SA(0, 0), cA, voffA); PG8_STAGE(PG8_SA(0, 1), cA + hstep, voffA);
        if (wr == 1) PG8_BAR;
        PG8_WAIT_V(2); PG8_BAR;
        PG8_STAGE(PG8_SB(1, 0), cB + kstep, voffB); PG8_STAGE(PG8_SA(1, 0), cA + kstep, voffA); PG8_STAGE(PG8_SB(1, 1), cB + hstep + kstep, voffB);
        PG8_WAIT_V(6); PG8_BAR;
    } else {
        PG8_STAGE(PG8_SB(0, 0), cB, voffB); PG8_STAGE(PG8_SA(0, 0), cA, voffA); PG8_STAGE(PG8_SB(0, 1), cB + hstep, voffB); PG8_STAGE(PG8_SA(0, 1), cA + hstep, voffA);
        if (wr == 1) PG8_BAR;
        PG8_WAIT_V(4); PG8_BAR;
        PG8_STAGE(PG8_SB(1, 0), cB + kstep, voffB); PG8_STAGE(PG8_SA(1, 0), cA + kstep, voffA); PG8_STAGE(PG8_SB(1, 1), cB + hstep + kstep, voffB);
        PG8_WAIT_V(6); PG8_BAR;
    }
    for (;;) {
        const bool has_next = S.next(ui + 1, nxt);
        const char* nA = has_next ? (const char*)g.A + (size_t)nxt.pm * tstep : cA; const char* nB = has_next ? (const char*)g.Bt + (size_t)nxt.pn * tstep : cB;
#pragma unroll 1
        for (int t = 0; t < nt; t += 2) {
            if constexpr (FP8) asm volatile("" : "+v"(voffA[0]), "+v"(voffA[1]), "+v"(voffB[0]), "+v"(voffB[1]));
            const bool last = (t == nt - 2);
            const char* a1 = cA + (size_t)(t + 1) * kstep;
            const char* a2 = last ? nA : cA + (size_t)(t + 2) * kstep; const char* b2 = last ? nB : cB + (size_t)(t + 2) * kstep;
            const char* a3 = a2 + kstep; const char* b3 = b2 + kstep;
            if (last && has_next) S.a_ready(nxt);
            if constexpr (SP2) {
            PG8_LDB(B0, 0, 0); PG8_LDB(B1, 0, 1); PG8_SCHED; PG8_LDA(At, 0, 0); PG8_STAGE(PG8_SA(1, 1), a1 + hstep, voffA);
            PG8_WAIT_V(8); PG8_WAIT_L(0); PG8_BAR; PG8_MMA(0, 0, At, B0); PG8_MMA(0, 1, At, B1); PG8_BAR; PG8_SCHED;
            PG8_LDA(At, 0, 1); PG8_STAGE(PG8_SB(0, 0), b2, voffB); PG8_STAGE(PG8_SB(0, 1), b2 + hstep, voffB); PG8_STAGE(PG8_SA(0, 0), a2, voffA);
            PG8_WAIT_V(8); PG8_WAIT_L(0); PG8_BAR; PG8_MMA(1, 0, At, B0); PG8_MMA(1, 1, At, B1); PG8_BAR; PG8_SCHED;
            PG8_LDB(B0, 1, 0); PG8_LDB(B1, 1, 1); PG8_SCHED; PG8_LDA(At, 1, 0); PG8_STAGE(PG8_SA(0, 1), a2 + hstep, voffA);
            PG8_WAIT_V(8); PG8_WAIT_L(0); PG8_BAR; PG8_MMA(0, 0, At, B0); PG8_MMA(0, 1, At, B1); PG8_BAR; PG8_SCHED;
            PG8_LDA(At, 1, 1); PG8_STAGE(PG8_SB(1, 0), b3, voffB); PG8_STAGE(PG8_SB(1, 1), b3 + hstep, voffB); PG8_STAGE(PG8_SA(1, 0), a3, voffA);
            PG8_WAIT_V(8); PG8_WAIT_L(0); PG8_BAR; PG8_MMA(1, 0, At, B0); PG8_MMA(1, 1, At, B1); PG8_BAR; PG8_SCHED;
            } else {
            PG8_LDB(B0, 0, 0); PG8_SCHED; PG8_LDA(At, 0, 0); PG8_STAGE(PG8_SA(1, 1), a1 + hstep, voffA);
            PG8_WAIT_L(8); PG8_BAR; PG8_WAIT_L(0); PG8_MMA(0, 0, At, B0); PG8_BAR; PG8_SCHED;
            PG8_LDB(B1, 0, 1); PG8_STAGE(PG8_SB(0, 0), b2, voffB);
            PG8_BAR; PG8_WAIT_L(0); PG8_MMA(0, 1, At, B1); PG8_BAR;
            PG8_LDA(At, 0, 1); PG8_STAGE(PG8_SA(0, 0), a2, voffA);
            PG8_BAR; PG8_WAIT_L(0); PG8_MMA(1, 0, At, B0); PG8_BAR; PG8_SCHED;
            PG8_STAGE(PG8_SB(0, 1), b2 + hstep, voffB);
            PG8_WAIT_V(6); PG8_BAR; PG8_MMA(1, 1, At, B1); PG8_BAR;
            PG8_LDB(B0, 1, 0); PG8_SCHED; PG8_LDA(At, 1, 0); PG8_STAGE(PG8_SA(0, 1), a2 + hstep, voffA);
            PG8_WAIT_L(8); PG8_BAR; PG8_WAIT_L(0); PG8_MMA(0, 0, At, B0); PG8_BAR; PG8_SCHED;
            PG8_LDB(B1, 1, 1); PG8_STAGE(PG8_SB(1, 0), b3, voffB);
            PG8_BAR; PG8_WAIT_L(0); PG8_MMA(0, 1, At, B1); PG8_BAR;
            PG8_LDA(At, 1, 1); PG8_STAGE(PG8_SA(1, 0), a3, voffA);
            PG8_BAR; PG8_WAIT_L(0); PG8_MMA(1, 0, At, B0); PG8_BAR; PG8_SCHED;
            PG8_STAGE(PG8_SB(1, 1), b3 + hstep, voffB);
            PG8_WAIT_V(6); PG8_BAR; PG8_MMA(1, 1, At, B1); PG8_BAR;
            }
        }
        if constexpr (ALIGN_EPI) { if (wr == 0) PG8_BAR; }
        if constexpr (FP8) asm volatile("s_nop 15\n\ts_nop 15" ::: "memory");
        if constexpr (!Epi::AFTER_DRAIN) { const int l2_ = lane_opaque(); E(acc, cur, wr, wc, l2_ & 15, l2_ >> 4); S.done(cur); }
        if (!has_next) break;
#pragma unroll
        for (int a = 0; a < 2; ++a)
#pragma unroll
            for (int b = 0; b < 2; ++b)
#pragma unroll
                for (int m = 0; m < 4; ++m)
#pragma unroll
                    for (int n = 0; n < 2; ++n) acc[a][b][m][n] = (f32x4){0.f, 0.f, 0.f, 0.f};
        cur = nxt; cA = nA; cB = nB; ++ui;
        if constexpr (ALIGN_EPI) { if (wr == 1) PG8_BAR; }
    }
    PG8_WAIT_V(0);
    if constexpr (!ALIGN_EPI) { if (wr == 0) PG8_BAR; }
    PG8_BAR;
    if constexpr (Epi::AFTER_DRAIN) { E.fused(acc, cur, wr, wc, fr, fq, lds, wid, lane); S.done(cur); }
#undef PG8_SA
#undef PG8_SB
#undef PG8_STAGE
#undef PG8_LDA
#undef PG8_LDB
#undef PG8_MMA
#undef PG8_WAIT_V
#undef PG8_WAIT_L
#undef PG8_BAR
#undef PG8_SCHED
}
}

__device__ __forceinline__ float wave_sum(float v) {
    const int l = lane_opaque();
#pragma unroll
    for (int o = 1; o < 64; o <<= 1) v += __builtin_bit_cast(float, __builtin_amdgcn_ds_bpermute((l ^ o) << 2, __builtin_bit_cast(int, v)));
    return v;
}
__device__ __forceinline__ float wave_max(float v) {
    const int l = lane_opaque();
#pragma unroll
    for (int o = 1; o < 64; o <<= 1) v = fmaxf(v, __builtin_bit_cast(float, __builtin_amdgcn_ds_bpermute((l ^ o) << 2, __builtin_bit_cast(int, v))));
    return v;
}
__device__ __forceinline__ float silu_f(float v) { return v / (1.f + __expf(-v)); }

struct Args {
    const float* x; const float* c; const float* rel_bias; const float* ada_w; const float* ada_b; const float* norm_g;
    const float* moba_w_qkv; const float* moba_w_o; const float* diff_w_qkv; const float* diff_w_o;
    const float* diff_lambda; const float* diff_subln_g; const float* ffn_w_in; const float* ffn_w_out;
    float* out; unsigned char* ws;
};

__device__ __forceinline__ int t5_bucket(int rel) {
    const int n = rel < 0 ? 0 : rel;
    const float nf = (float)(n < 1 ? 1 : n);
    int large = 16 + (int)(logf(nf / 16.0f) / 4.852030263919617f * 16.0f);
    large = large < 31 ? large : 31;
    return n < 16 ? n : large;
}

__device__ __forceinline__ void p_mod(const Args& a, LAS unsigned char* lds, int blk, int G, int tid, int wave, int lane) {
    LAS float* sc = (LAS float*)lds;
    LAS float* red = sc + 2048;
    for (int i = tid; i < 2048; i += NTHR) sc[i] = silu_f(a.c[i]);
    __syncthreads();
    float* mod = (float*)(a.ws + WS_MOD);
    for (int it = blk; it < 192; it += G) {
        const int l = it / 96, j0 = (it % 96) * 64;
        const float* w = a.ada_w + (size_t)l * D * 6144 + j0 + lane;
        float s0 = 0.f, s1 = 0.f;
#pragma unroll 1
        for (int kb = wave * 128; kb < wave * 128 + 128; kb += 32) { float wv[32];
#pragma unroll
            for (int k = 0; k < 32; ++k) wv[k] = w[(size_t)(kb + k) * 6144];
#pragma unroll
            for (int k = 0; k < 32; ++k) { s0 += sc[kb + k] * wv[k]; s1 += sc[1024 + kb + k] * wv[k]; } }
        red[(wave * 2 + 0) * 64 + lane] = s0; red[(wave * 2 + 1) * 64 + lane] = s1;
        __syncthreads();
        if (tid < 128) { const int bb = tid >> 6, cl = tid & 63; float sum = 0.f;
#pragma unroll
            for (int w8 = 0; w8 < 8; ++w8) sum += red[(w8 * 2 + bb) * 64 + cl];
            mod[(l * 2 + bb) * 6144 + j0 + cl] = sum + a.ada_b[l * 6144 + j0 + cl]; }
        __syncthreads();
    }
    float* bt = (float*)(a.ws + WS_BIAST);
    for (int i = blk * NTHR + tid; i < 8 * 2304; i += G * NTHR) { const int h = i / 2304, rel = 2047 - (i % 2304); bt[i] = rel >= 0 ? a.rel_bias[t5_bucket(rel) * NH + h] * LOG2E : 0.f; }
}

__device__ __forceinline__ void transpose_item(const float* W, int K, int N, int k0, int n0, bf16* WT, int dst_row0, LAS float* scr, int lane) {
    float tv[32];
#pragma unroll
    for (int i = 0; i < 32; ++i) tv[i] = W[(size_t)(k0 + 2 * i + (lane >> 5)) * N + n0 + (lane & 31)];
#pragma unroll
    for (int i = 0; i < 32; ++i) scr[(2 * i + (lane >> 5)) * 33 + (lane & 31)] = tv[i];
    asm volatile("s_waitcnt lgkmcnt(0)" ::: "memory");
    const int c = lane & 7;
#pragma unroll
    for (int j = 0; j < 4; ++j) { const int n = (lane >> 3) + 8 * j; const LAS float* sp = scr + (8 * c) * 33 + n;
        u32x4 o; o.x = pk2(sp[0 * 33], sp[1 * 33]); o.y = pk2(sp[2 * 33], sp[3 * 33]); o.z = pk2(sp[4 * 33], sp[5 * 33]); o.w = pk2(sp[6 * 33], sp[7 * 33]);
        *(u32x4*)(WT + (size_t)(dst_row0 + n) * K + k0 + 8 * c) = o; }
    asm volatile("s_waitcnt lgkmcnt(0)" ::: "memory");
}
constexpr float F8_SA = 4.0f, F8_SB = 256.0f;
__device__ __forceinline__ unsigned pk4_fp8(float a, float b, float c, float d) {
    a = fminf(fmaxf(a, -448.f), 448.f); b = fminf(fmaxf(b, -448.f), 448.f); c = fminf(fmaxf(c, -448.f), 448.f); d = fminf(fmaxf(d, -448.f), 448.f);
    int w = __builtin_amdgcn_cvt_pk_fp8_f32(a, b, 0, false); w = __builtin_amdgcn_cvt_pk_fp8_f32(c, d, w, true); return (unsigned)w;
}
__device__ __forceinline__ void transpose_item_fp8(const float* W, int K, int N, int k0, int n0, unsigned char* WT, int dst_row0, LAS float* scr, int lane) {
    float tv[32];
#pragma unroll
    for (int i = 0; i < 32; ++i) tv[i] = W[(size_t)(k0 + 2 * i + (lane >> 5)) * N + n0 + (lane & 31)];
#pragma unroll
    for (int i = 0; i < 32; ++i) scr[(2 * i + (lane >> 5)) * 33 + (lane & 31)] = tv[i];
    asm volatile("s_waitcnt lgkmcnt(0)" ::: "memory");
#pragma unroll
    for (int j = 0; j < 2; ++j) { const int ch = lane + 64 * j, n = ch >> 2, c = ch & 3; const LAS float* sp = scr + (16 * c) * 33 + n;
        u32x4 o;
        o.x = pk4_fp8(sp[0 * 33] * F8_SB, sp[1 * 33] * F8_SB, sp[2 * 33] * F8_SB, sp[3 * 33] * F8_SB);
        o.y = pk4_fp8(sp[4 * 33] * F8_SB, sp[5 * 33] * F8_SB, sp[6 * 33] * F8_SB, sp[7 * 33] * F8_SB);
        o.z = pk4_fp8(sp[8 * 33] * F8_SB, sp[9 * 33] * F8_SB, sp[10 * 33] * F8_SB, sp[11 * 33] * F8_SB);
        o.w = pk4_fp8(sp[12 * 33] * F8_SB, sp[13 * 33] * F8_SB, sp[14 * 33] * F8_SB, sp[15 * 33] * F8_SB);
        *(u32x4*)(WT + (size_t)(dst_row0 + n) * K + k0 + 16 * c) = o; }
    asm volatile("s_waitcnt lgkmcnt(0)" ::: "memory");
}
__device__ __forceinline__ void p_weights(const Args& a, LAS unsigned char* lds, int gw, int ngw, int wave, int lane) {
    LAS float* scr = (LAS float*)(lds + wave * 16384);
    constexpr int I_QKV = (D / 64) * (3 * D / 32), I_O = (D / 64) * (D / 32), I_IN = (D / 64) * (2 * DFF / 32), I_OUT = (DFF / 64) * (D / 32);
    constexpr int PER_L = I_QKV + I_O + I_IN + I_OUT;
    for (int it = gw; it < 2 * PER_L; it += ngw) {
        const int l = it / PER_L; int r = it % PER_L;
        unsigned char* wl = a.ws + WS_W + (size_t)l * WL_STRIDE;
        if (r < I_QKV) { const int nb = 3 * D / 32, kb = r / nb, n0 = (r % nb) * 32; transpose_item(l == 0 ? a.moba_w_qkv : a.diff_w_qkv, D, 3 * D, kb * 64, n0, (bf16*)(wl + WO_QKV), n0, scr, lane); continue; } r -= I_QKV;
        if (r < I_O) continue; r -= I_O;
        if (r < I_IN) { const int nb = 2 * DFF / 32, kb = r / nb, n0 = (r % nb) * 32;
            const int isu = n0 >= DFF ? 1 : 0, nn = n0 - isu * DFF, dst = 256 * (nn / 128) + 128 * isu + (nn % 128);
            transpose_item_fp8(a.ffn_w_in + (size_t)l * D * 2 * DFF, D, 2 * DFF, kb * 64, n0, wl + WO_IN, dst, scr, lane); continue; } r -= I_IN;
        { const int nb = D / 32, kb = r / nb, n0 = (r % nb) * 32; transpose_item(a.ffn_w_out + (size_t)l * DFF * D, DFF, D, kb * 64, n0, (bf16*)(wl + WO_OUT), n0, scr, lane); }
    }
}

__device__ __forceinline__ void p_wo_perm(const Args& a, int gtid, int gthreads) {
    for (int idx = gtid; idx < 2 * 128 * D; idx += gthreads) {
        const int l = idx / (128 * D), rem = idx % (128 * D), c = rem / D, n = rem % D;
        const float* W = l == 0 ? a.moba_w_o : a.diff_w_o;
        float v[8];
#pragma unroll
        for (int e = 0; e < 8; ++e) { const int kp = 8 * c + e, hh = kp >> 7, wi = kp & 127, k = hh * 128 + (wi & 3) * 32 + (wi >> 2); v[e] = W[(size_t)k * D + n]; }
        u32x4 o; o.x = pk2(v[0], v[1]); o.y = pk2(v[2], v[3]); o.z = pk2(v[4], v[5]); o.w = pk2(v[6], v[7]);
        *(u32x4*)((bf16*)(a.ws + WS_W + (size_t)l * WL_STRIDE + WO_O) + (size_t)n * D + 8 * c) = o;
    }
}

__device__ __forceinline__ void p_norm_in(const float* X, const float* g, const float* sh, const float* sc, bf16* H, int gw, int ngw, int lane) {
    for (int m = gw; m < M; m += ngw) {
        const int b = m / SEQ;
        const f32x4* xr = (const f32x4*)(X + (size_t)m * D) + lane;
        f32x4 v[4]; float s = 0.f;
#pragma unroll
        for (int j = 0; j < 4; ++j) { v[j] = xr[64 * j]; s += (v[j].x * v[j].x + v[j].y * v[j].y) + (v[j].z * v[j].z + v[j].w * v[j].w); }
        const float r = 1.0f / sqrtf(wave_sum(s) * (1.f / D) + RMS_EPS);
        u32x2* o = (u32x2*)(H + (size_t)m * D) + lane;
#pragma unroll
        for (int j = 0; j < 4; ++j) {
            const f32x4 gg = ((const f32x4*)g)[lane + 64 * j], s1 = ((const f32x4*)(sc + b * 6144))[lane + 64 * j], s0 = ((const f32x4*)(sh + b * 6144))[lane + 64 * j];
            const f32x4 h = v[j] * r * gg * (1.0f + s1) + s0;
            u32x2 w; w.x = pk2(h.x, h.y); w.y = pk2(h.z, h.w); o[64 * j] = w;
        }
    }
}
template <bool XIN_BF, bool XOUT_BF, bool H_FP8>
__device__ __forceinline__ void p_post(const void* Xin, const bf16* Y, const float* g1, const float* gate, void* Xout,
                                       const float* g2, const float* sh, const float* sc, bf16* H, int gw, int ngw, int lane) {
    for (int m = gw; m < M; m += ngw) {
        const int b = m / SEQ;
        const u32x2* yr = (const u32x2*)(Y + (size_t)m * D) + lane;
        f32x4 y[4], xv[4]; float s = 0.f;
#pragma unroll
        for (int j = 0; j < 4; ++j) { const u32x2 w = yr[64 * j]; y[j] = (f32x4){bflo(w.x), bfhi(w.x), bflo(w.y), bfhi(w.y)};
            if (XIN_BF) { const u32x2 xw = ((const u32x2*)((const bf16*)Xin + (size_t)m * D))[lane + 64 * j]; xv[j] = (f32x4){bflo(xw.x), bfhi(xw.x), bflo(xw.y), bfhi(xw.y)}; }
            else xv[j] = ((const f32x4*)((const float*)Xin + (size_t)m * D))[lane + 64 * j];
            s += (y[j].x * y[j].x + y[j].y * y[j].y) + (y[j].z * y[j].z + y[j].w * y[j].w); }
        const float r = 1.0f / sqrtf(wave_sum(s) * (1.f / D) + RMS_EPS);
        float s2 = 0.f;
#pragma unroll
        for (int j = 0; j < 4; ++j) {
            const f32x4 gg = ((const f32x4*)g1)[lane + 64 * j], gt = ((const f32x4*)(gate + b * 6144))[lane + 64 * j];
            xv[j] = xv[j] + gt * (y[j] * r * gg);
            s2 += (xv[j].x * xv[j].x + xv[j].y * xv[j].y) + (xv[j].z * xv[j].z + xv[j].w * xv[j].w);
            if (XOUT_BF) { u32x2 w; w.x = pk2(xv[j].x, xv[j].y); w.y = pk2(xv[j].z, xv[j].w); ((u32x2*)((bf16*)Xout + (size_t)m * D))[lane + 64 * j] = w; }
            else ((f32x4*)((float*)Xout + (size_t)m * D))[lane + 64 * j] = xv[j];
        }
        if (H) {
            const float r2 = 1.0f / sqrtf(wave_sum(s2) * (1.f / D) + RMS_EPS);
            u32x2* o = (u32x2*)(H + (size_t)m * D) + lane;
#pragma unroll
            for (int j = 0; j < 4; ++j) {
                const f32x4 gg = ((const f32x4*)g2)[lane + 64 * j], s1 = ((const f32x4*)(sc + b * 6144))[lane + 64 * j], s0 = ((const f32x4*)(sh + b * 6144))[lane + 64 * j];
                const f32x4 h = xv[j] * r2 * gg * (1.0f + s1) + s0;
                if (H_FP8) ((unsigned*)((unsigned char*)H + (size_t)m * D))[lane + 64 * j] = pk4_fp8(h.x * F8_SA, h.y * F8_SA, h.z * F8_SA, h.w * F8_SA);
                else { u32x2 w; w.x = pk2(h.x, h.y); w.y = pk2(h.z, h.w); o[64 * j] = w; }
            }
        }
    }
}

__device__ __forceinline__ void p_kmean(const bf16* Kb, float* kmean, LAS unsigned char* lds, int blk, int G, int tid, int wave, int lane) {
    LAS float* red = (LAS float*)lds;
    for (int it = blk; it < BATCH * NH * 32; it += G) {
        const int b = it >> 8, h = (it >> 5) & 7, kb = it & 31;
        const bf16* p = Kb + ((size_t)b * SEQ + kb * 256 + wave * 32) * D + h * HD + 2 * lane;
        float s0 = 0.f, s1 = 0.f;
#pragma unroll 8
        for (int r = 0; r < 32; ++r) { const unsigned w = *(const unsigned*)(p + (size_t)r * D); s0 += bflo(w); s1 += bfhi(w); }
        red[wave * 128 + 2 * lane] = s0; red[wave * 128 + 2 * lane + 1] = s1;
        __syncthreads();
        if (tid < 128) { float sum = 0.f;
#pragma unroll
            for (int w8 = 0; w8 < 8; ++w8) sum += red[w8 * 128 + tid];
            kmean[(size_t)it * 128 + tid] = sum * (1.0f / 256.0f); }
        __syncthreads();
    }
}
__device__ __forceinline__ void p_gate(const bf16* Qb, const float* kmean, unsigned* sel, unsigned* cnt, unsigned short* lists, LAS unsigned char* lds, int blk, int G, int tid, int wave, int lane) {
    LAS float* km = (LAS float*)lds;
    for (int it = blk; it < 256; it += G) {
        const int bh = it >> 4, span = it & 15, b = bh >> 3, h = bh & 7;
        __syncthreads();
        for (int i = tid; i < 1024; i += NTHR) ((LAS f32x4*)km)[i] = ((const f32x4*)(kmean + (size_t)bh * 4096))[i];
        __syncthreads();
        const int q = span * 512 + wave * 64 + lane, own = (span * 512 + wave * 64) >> 8;
        unsigned mask;
        if (own <= 3) mask = (1u << own) - 1u;
        else {
            float qf[128];
            const u32x4* qp = (const u32x4*)(Qb + ((size_t)b * SEQ + q) * D + h * HD);
#pragma unroll
            for (int c = 0; c < 16; ++c) { const u32x4 w = qp[c]; qf[c * 8 + 0] = bflo(w.x); qf[c * 8 + 1] = bfhi(w.x); qf[c * 8 + 2] = bflo(w.y); qf[c * 8 + 3] = bfhi(w.y);
                qf[c * 8 + 4] = bflo(w.z); qf[c * 8 + 5] = bfhi(w.z); qf[c * 8 + 6] = bflo(w.w); qf[c * 8 + 7] = bfhi(w.w); }
            float b0 = -3e38f, b1 = -3e38f, b2 = -3e38f; int i0 = 0, i1 = 0, i2 = 0;
#pragma unroll 1
            for (int n = 0; n < own; ++n) {
                float g0 = 0.f, g1 = 0.f, g2 = 0.f, g3 = 0.f;
#pragma unroll
                for (int d = 0; d < 128; d += 4) { const f32x4 kv = *(LAS f32x4*)(km + n * 128 + d); g0 += qf[d] * kv.x; g1 += qf[d + 1] * kv.y; g2 += qf[d + 2] * kv.z; g3 += qf[d + 3] * kv.w; }
                const float g = (g0 + g1) + (g2 + g3);
                if (g > b0) { b2 = b1; i2 = i1; b1 = b0; i1 = i0; b0 = g; i0 = n; }
                else if (g > b1) { b2 = b1; i2 = i1; b1 = g; i1 = n; }
                else if (g > b2) { b2 = g; i2 = n; }
            }
            mask = (1u << i0) | (1u << i1) | (1u << i2);
        }
        sel[(size_t)bh * SEQ + q] = mask;
        unsigned mycnt = 0u;
        for (int j = 0; j < own; ++j) { const unsigned long long bl = __ballot((mask >> j) & 1u); if (lane == j) mycnt = (unsigned)__popcll(bl); }
        unsigned base = 0u;
        if (lane < own && mycnt) base = __hip_atomic_fetch_add(cnt + bh * 32 + lane, mycnt, __ATOMIC_RELAXED, __HIP_MEMORY_SCOPE_AGENT);
        for (int j = 0; j < own; ++j) { const unsigned long long bl = __ballot((mask >> j) & 1u); const unsigned bj = (unsigned)__builtin_amdgcn_readlane((int)base, j);
            if ((mask >> j) & 1u) lists[((size_t)bh * 32 + j) * 8192 + bj + (unsigned)__popcll(bl & ((1ull << lane) - 1ull))] = (unsigned short)q; }
    }
}

namespace att {
typedef short bf16x8 __attribute__((ext_vector_type(8)));
typedef short s16x4 __attribute__((ext_vector_type(4)));
typedef float f32x16 __attribute__((ext_vector_type(16)));
typedef LAS const char* lcp;
constexpr int PITCH = 1024;
constexpr int SHM_V = 16384, SHM_K = 16384;
constexpr int L_K = 0, L_V = 65536, L_WS = 131072, L_LUT = 133120;
constexpr int LUTN = 2304, RMAXL = 2047, RFAR = 1536;
#define KSWZ(row, colB) ((row) * 256 + ((colB) ^ (((row) & 7) << 4)))
#define SBAR() __builtin_amdgcn_sched_barrier(0)
#define WG_BAR() do { asm volatile("s_waitcnt lgkmcnt(0)" ::: "memory"); __builtin_amdgcn_s_barrier(); asm volatile("" ::: "memory"); } while (0)
__device__ __forceinline__ int v_st(int k, int c) { const int kk = (k & ~0xC) | ((k & 4) << 1) | ((k & 8) >> 1); return ((kk >> 3) * 4 + (c >> 5)) * 512 + ((kk & 7) * 32 + (c & 31)) * 2; }
__device__ __forceinline__ int v_rd_base(int lane) { return ((lane & 3) << 3) | (((lane >> 2) & 3) << 6) | (((lane >> 4) & 1) << 5) | (((lane >> 5) & 1) << 8); }
constexpr int v_rd_off(int d0, int ks, int half) { return d0 * 512 + ks * 4096 + half * 2048; }
__device__ __forceinline__ int crow(int r, int hi) { return (r & 3) + 8 * (r >> 2) + 4 * hi; }
__device__ __forceinline__ unsigned cvtpk(float lo, float hi) { unsigned r; asm volatile("v_cvt_pk_bf16_f32 %0, %1, %2" : "=v"(r) : "v"(lo), "v"(hi)); return r; }

template <int KB, int NDS>
__device__ __forceinline__ void qkt(f32x16& p0, f32x16& p1, lcp K_lds, int r32, int hi, int coff, const bf16x8* qr) {
    lcp kb[4];
#pragma unroll
    for (int dd = 0; dd < 4; ++dd) kb[dd] = K_lds + KB * SHM_K + KSWZ(r32, (dd * 16 + hi * 8) * 2) + coff;
#pragma unroll
    for (int d0 = 0; d0 < NDS; ++d0) { lcp a = kb[d0 & 3] + (d0 >> 2) * 128;
        const bf16x8 b0 = *(LAS const bf16x8*)a;
        const bf16x8 b1 = *(LAS const bf16x8*)(a + 32 * 256);
        p0 = __builtin_amdgcn_mfma_f32_32x32x16_bf16(b0, qr[d0], p0, 0, 0, 0);
        p1 = __builtin_amdgcn_mfma_f32_32x32x16_bf16(b1, qr[d0], p1, 0, 0, 0);
        if (NDS == 8 && (d0 & 1) == 1) SBAR(); }
}
template <int VB>
__device__ __forceinline__ void pv_tile(f32x16* o, int vb0, bf16x8 pa0, bf16x8 pa1, bf16x8 pa2, bf16x8 pa3) {
#define TRRD(dst, off) asm volatile("ds_read_b64_tr_b16 %0, %1 offset:%2" : "=&v"(dst) : "v"(vb0), "i"(off) : "memory")
#define PV_D0(d0) do { s16x4 l0, l1, l2, l3, h0, h1, h2, h3; constexpr int b_ = VB * SHM_V + v_rd_off(d0, 0, 0); \
        TRRD(l0, b_); TRRD(h0, b_ + 2048); TRRD(l1, b_ + 4096); TRRD(h1, b_ + 6144); TRRD(l2, b_ + 8192); TRRD(h2, b_ + 10240); TRRD(l3, b_ + 12288); TRRD(h3, b_ + 14336); \
        asm volatile("s_waitcnt lgkmcnt(0)" ::: "memory"); SBAR(); \
        o[d0] = __builtin_amdgcn_mfma_f32_32x32x16_bf16(pa0, (bf16x8){l0[0], l0[1], l0[2], l0[3], h0[0], h0[1], h0[2], h0[3]}, o[d0], 0, 0, 0); \
        o[d0] = __builtin_amdgcn_mfma_f32_32x32x16_bf16(pa1, (bf16x8){l1[0], l1[1], l1[2], l1[3], h1[0], h1[1], h1[2], h1[3]}, o[d0], 0, 0, 0); \
        o[d0] = __builtin_amdgcn_mfma_f32_32x32x16_bf16(pa2, (bf16x8){l2[0], l2[1], l2[2], l2[3], h2[0], h2[1], h2[2], h2[3]}, o[d0], 0, 0, 0); \
        o[d0] = __builtin_amdgcn_mfma_f32_32x32x16_bf16(pa3, (bf16x8){l3[0], l3[1], l3[2], l3[3], h3[0], h3[1], h3[2], h3[3]}, o[d0], 0, 0, 0); } while (0)
    PV_D0(0); PV_D0(1); PV_D0(2); PV_D0(3);
#undef PV_D0
#undef TRRD
}

template <int NDS>
__device__ __forceinline__ void kread(bf16x8* kf, int kaddr_base, int r32, int hi, int coff) {
#pragma unroll
    for (int d0 = 0; d0 < NDS; ++d0) { const int a = kaddr_base + KSWZ(r32, ((d0 & 3) * 16 + hi * 8) * 2) + coff + (d0 >> 2) * 128;
        asm volatile("ds_read_b128 %0, %1" : "=&v"(kf[2 * d0]) : "v"(a) : "memory");
        asm volatile("ds_read_b128 %0, %1 offset:8192" : "=&v"(kf[2 * d0 + 1]) : "v"(a) : "memory"); }
}
template <int NDS>
__device__ __forceinline__ void kmma(f32x16& p0, f32x16& p1, const bf16x8* kf, const bf16x8* qr) {
#pragma unroll
    for (int d0 = 0; d0 < NDS; ++d0) { p0 = __builtin_amdgcn_mfma_f32_32x32x16_bf16(kf[2 * d0], qr[d0], p0, 0, 0, 0); p1 = __builtin_amdgcn_mfma_f32_32x32x16_bf16(kf[2 * d0 + 1], qr[d0], p1, 0, 0, 0); }
}

__device__ __forceinline__ void pv_tile_pf(f32x16* o, int vb0, bf16x8 pa0, bf16x8 pa1, bf16x8 pa2, bf16x8 pa3) {
#define TRRD(dst, off) asm volatile("ds_read_b64_tr_b16 %0, %1 offset:%2" : "=&v"(dst) : "v"(vb0), "i"(off) : "memory")
#define RD8(S, d0) do { constexpr int b_ = v_rd_off(d0, 0, 0); TRRD(S[0], b_); TRRD(S[1], b_ + 2048); TRRD(S[2], b_ + 4096); TRRD(S[3], b_ + 6144); \
        TRRD(S[4], b_ + 8192); TRRD(S[5], b_ + 10240); TRRD(S[6], b_ + 12288); TRRD(S[7], b_ + 14336); } while (0)
#define MMA4(d0, S) do { \
        o[d0] = __builtin_amdgcn_mfma_f32_32x32x16_bf16(pa0, (bf16x8){S[0][0], S[0][1], S[0][2], S[0][3], S[1][0], S[1][1], S[1][2], S[1][3]}, o[d0], 0, 0, 0); \
        o[d0] = __builtin_amdgcn_mfma_f32_32x32x16_bf16(pa1, (bf16x8){S[2][0], S[2][1], S[2][2], S[2][3], S[3][0], S[3][1], S[3][2], S[3][3]}, o[d0], 0, 0, 0); \
        o[d0] = __builtin_amdgcn_mfma_f32_32x32x16_bf16(pa2, (bf16x8){S[4][0], S[4][1], S[4][2], S[4][3], S[5][0], S[5][1], S[5][2], S[5][3]}, o[d0], 0, 0, 0); \
        o[d0] = __builtin_amdgcn_mfma_f32_32x32x16_bf16(pa3, (bf16x8){S[6][0], S[6][1], S[6][2], S[6][3], S[7][0], S[7][1], S[7][2], S[7][3]}, o[d0], 0, 0, 0); } while (0)
    s16x4 sa[8], sb[8];
    RD8(sa, 0); RD8(sb, 1);
    asm volatile("s_waitcnt lgkmcnt(8)" ::: "memory"); SBAR(); MMA4(0, sa); SBAR();
    RD8(sa, 2);
    asm volatile("s_waitcnt lgkmcnt(8)" ::: "memory"); SBAR(); MMA4(1, sb); SBAR();
    RD8(sb, 3);
    asm volatile("s_waitcnt lgkmcnt(8)" ::: "memory"); SBAR(); MMA4(2, sa); SBAR();
    asm volatile("s_waitcnt lgkmcnt(0)" ::: "memory"); SBAR(); MMA4(3, sb);
#undef MMA4
#undef RD8
#undef TRRD
}
constexpr float THR2 = 8.0f;
__device__ __forceinline__ void partial_sm(f32x16& p0, f32x16& p1, float sh, float& m_reg, float& alpha) {
    float pmax = p0[0];
#pragma unroll
    for (int r = 1; r < 16; ++r) pmax = fmaxf(pmax, p0[r]);
#pragma unroll
    for (int r = 0; r < 16; ++r) pmax = fmaxf(pmax, p1[r]);
    { auto rr = __builtin_amdgcn_permlane32_swap(__float_as_uint(pmax), __float_as_uint(pmax), false, false);
      pmax = fmaxf(__uint_as_float(rr[0]), __uint_as_float(rr[1])); }
    pmax += sh;
    float mn;
    if (__builtin_expect(__all((pmax - m_reg) <= THR2), 1)) { mn = m_reg; alpha = 1.f; }
    else { const bool upd = (pmax - m_reg) > THR2;
        mn = upd ? fmaxf(m_reg, pmax) : m_reg; alpha = upd ? __builtin_amdgcn_exp2f(m_reg - mn) : 1.f; m_reg = mn; }
    const float off = mn - sh;
#pragma unroll
    for (int r = 0; r < 16; ++r) p0[r] = __builtin_amdgcn_exp2f(p0[r] - off);
#pragma unroll
    for (int r = 0; r < 16; ++r) p1[r] = p1[r] - off;
}
__device__ __forceinline__ void finish_sm(f32x16& p0, f32x16& p1, float alpha, float& l_reg, bf16x8& pa0, bf16x8& pa1, bf16x8& pa2, bf16x8& pa3) {
#pragma unroll
    for (int r = 0; r < 16; ++r) p1[r] = __builtin_amdgcn_exp2f(p1[r]);
    float ps = 0.f;
#pragma unroll
    for (int r = 0; r < 16; ++r) ps += p0[r];
#pragma unroll
    for (int r = 0; r < 16; ++r) ps += p1[r];
    { auto rr = __builtin_amdgcn_permlane32_swap(__float_as_uint(ps), __float_as_uint(ps), false, false);
      ps = __uint_as_float(rr[0]) + __uint_as_float(rr[1]); }
    l_reg = l_reg * alpha + ps;
#define PK4(P, B_, OUT) do { unsigned a0 = cvtpk(P[B_+0], P[B_+1]), a1 = cvtpk(P[B_+2], P[B_+3]); \
        unsigned b0 = cvtpk(P[B_+4], P[B_+5]), b1 = cvtpk(P[B_+6], P[B_+7]); \
        auto r0 = __builtin_amdgcn_permlane32_swap(a0, b0, false, false); auto r1 = __builtin_amdgcn_permlane32_swap(a1, b1, false, false); \
        u32x4 w = {r0[0], r1[0], r0[1], r1[1]}; OUT = __builtin_bit_cast(bf16x8, w); } while (0)
    PK4(p0, 0, pa0); PK4(p0, 8, pa1); PK4(p1, 0, pa2); PK4(p1, 8, pa3);
#undef PK4
}
__device__ __forceinline__ void softmax_tile(f32x16& p0, f32x16& p1, float sh, float& m_reg, float& l_reg, float& alpha, bf16x8& pa0, bf16x8& pa1, bf16x8& pa2, bf16x8& pa3) {
    partial_sm(p0, p1, sh, m_reg, alpha); finish_sm(p0, p1, alpha, l_reg, pa0, pa1, pa2, pa3);
}
__device__ __forceinline__ void add_bias_lut(f32x16& p0, f32x16& p1, LAS const float* lut, int dq) {
    LAS const float* bp = lut + (RMAXL - dq);
#pragma unroll
    for (int r = 0; r < 16; ++r) { const int c = (r & 3) + 8 * (r >> 2); p0[r] += bp[c]; p1[r] += bp[c + 32]; if ((r & 3) == 3) asm volatile("" ::: "memory"); }
}
__device__ __forceinline__ void load_bias_lut(f32x16& p0, f32x16& p1, LAS const float* lut, int dq) {
    LAS const float* bp = lut + (RMAXL - dq);
#pragma unroll
    for (int r = 0; r < 16; ++r) { const int c = (r & 3) + 8 * (r >> 2); p0[r] = bp[c]; p1[r] = bp[c + 32]; }
}
__device__ __forceinline__ void causal_mask(f32x16& p0, f32x16& p1, int dq) {
    const float NEG = -__builtin_inff();
#pragma unroll
    for (int r = 0; r < 16; ++r) { const int c = (r & 3) + 8 * (r >> 2); if (dq - c < 0) p0[r] = NEG; if (dq - c - 32 < 0) p1[r] = NEG; }
}
struct DmaOff { unsigned k[2], v[2]; };
__device__ __forceinline__ DmaOff dma_offsets(int wid, int lane) {
    DmaOff d;
#pragma unroll
    for (int i = 0; i < 2; ++i) { const int p = wid * 2 + i;
        { const int row = 4 * p + (lane >> 4), c = (lane & 15) ^ (row & 7); d.k[i] = (unsigned)(row * PITCH * 2 + c * 16); }
        { const int sub = 2 * p + (lane >> 5), kkhi = sub >> 2, cblk = sub & 3, kklo = (lane & 31) >> 2, kk = kkhi * 8 + kklo;
          const int k = (kk & ~0xC) | ((kk & 4) << 1) | ((kk & 8) >> 1), c = cblk * 32 + (lane & 3) * 8; d.v[i] = (unsigned)(k * PITCH * 2 + c * 2); } }
    return d;
}
__device__ __forceinline__ void dma_tile(LAS char* lds, int bf, const bf16* Kc, const bf16* Vc, int k0, const DmaOff& d, int wid) {
    const char* kt = (const char*)Kc + (size_t)k0 * (PITCH * 2); const char* vt = (const char*)Vc + (size_t)k0 * (PITCH * 2);
#pragma unroll
    for (int i = 0; i < 2; ++i) {
        __builtin_amdgcn_global_load_lds((const unsigned*)(kt + d.k[i]), (LAS unsigned*)(lds + L_K + bf * SHM_K + (wid * 2 + i) * 1024), 16, 0, 0);
        __builtin_amdgcn_global_load_lds((const unsigned*)(vt + d.v[i]), (LAS unsigned*)(lds + L_V + bf * SHM_V + (wid * 2 + i) * 1024), 16, 0, 0); }
}
constexpr int L_CF = 142336, L_TAB = 146432, L_FOUND = 148544;
__device__ __forceinline__ void build_lut(LAS char* lds, const float* biasT, int h, int tid) {
    LAS float* lut = (LAS float*)(lds + L_LUT);
    for (int i = tid; i < LUTN; i += 512) lut[i] = biasT[h * LUTN + i];
}

template <int VAR> __device__ __forceinline__ void diff_unit(LAS char* lds, int b, int h, int qb, const bf16* Q, const bf16* K, const bf16* V, bf16* O, const float* relb, const float* biasT,
                                          float lam_full, const float* subg, int tid, int wid, int lane) {
    asm volatile("" : "+v"(lane), "+v"(tid));
    const int r32 = lane & 31, hi = lane >> 5, cm = wid >> 2, w4 = wid & 3;
    const size_t rowbase = (size_t)b * SEQ;
    const int q0 = qb * 128, qw0 = q0 + w4 * 32, qpos = qw0 + r32;
    const bf16* Kc = K + rowbase * PITCH + h * HD; const bf16* Vc = V + rowbase * PITCH + h * HD;
    const int NT = (q0 + 128) / 64;
    const DmaOff dmo = dma_offsets(wid, lane);
    const int vb0 = (int)(unsigned)(uintptr_t)(lds + L_V) + v_rd_base(lane);
    LAS float* ws = (LAS float*)(lds + L_WS) + wid * 64;
    LAS const float* lut = (LAS const float*)(lds + L_LUT);
    lcp K_lds = (lcp)(lds + L_K);
    const float b31 = relb[31 * 8 + h] * 1.4426950408889634f;
    build_lut(lds, biasT, h, tid);
    bf16x8 qr[4];
#pragma unroll
    for (int d0 = 0; d0 < 4; ++d0) qr[d0] = *(const bf16x8*)(Q + (rowbase + qpos) * PITCH + h * HD + cm * 64 + d0 * 16 + hi * 8);
    dma_tile(lds, 0, Kc, Vc, 0, dmo, wid);
    dma_tile(lds, 1, Kc, Vc, 64, dmo, wid);
    asm volatile("s_waitcnt vmcnt(0)" ::: "memory");
    WG_BAR();
    float m_reg = -1e30f, l_reg = 0.f; f32x16 o[4] = {};
    f32x16 p0, p1; bf16x8 pa0, pa1, pa2, pa3;
    const bool halfB = cm != 0;
    const int kl0 = (int)(unsigned)(uintptr_t)(lds + L_K);
    if (halfB) WG_BAR();
    for (int t = 0; t < NT; ++t) {
        __builtin_amdgcn_s_setprio(2);
        if (VAR != 2 && VAR != 3 && VAR != 7 && VAR != 8) { bf16x8 kf[8];
            kread<4>(kf, kl0 + (t & 3) * SHM_K, r32, hi, cm * 128);
            if (qw0 - (t * 64 + 63) >= RFAR) { p0 = f32x16{}; p1 = f32x16{}; } else load_bias_lut(p0, p1, lut, qpos - t * 64 - 4 * hi);
            if (t > 0) pv_tile_pf(o, vb0 + ((t - 1) & 3) * SHM_V, pa0, pa1, pa2, pa3);
            asm volatile("s_waitcnt lgkmcnt(0)" ::: "memory"); SBAR();
            kmma<4>(p0, p1, kf, qr); } else { p0 = f32x16{}; p1 = f32x16{}; asm volatile("" : "+v"(p0), "+v"(p1)); }
        __builtin_amdgcn_s_setprio(0);
        if (halfB) asm volatile("s_waitcnt vmcnt(0)" ::: "memory");
        WG_BAR();
        const bool issue = VAR != 4 && VAR != 7 && VAR != 8 && t + 2 < NT;
        if (issue) dma_tile(lds, (t + 2) & 3, Kc, Vc, (t + 2) * 64, dmo, wid);
        { const int k0_ = t * 64; float sh_ = 0.f, alpha; const int dq_ = qpos - k0_ - 4 * hi;
          if (VAR != 8) { if (qw0 - (k0_ + 63) >= RFAR) sh_ = b31;
          if (k0_ + 63 > qw0) causal_mask(p0, p1, dq_); }
          if (VAR == 1 || VAR == 3 || VAR == 5 || VAR == 7 || VAR == 8) { alpha = 1.f; l_reg += p0[0] + sh_; u32x4 w0_ = {cvtpk(p0[0], p0[1]), cvtpk(p0[2], p0[3]), cvtpk(p0[4], p0[5]), cvtpk(p0[6], p0[7])}; pa0 = __builtin_bit_cast(bf16x8, w0_);
              u32x4 w1_ = {cvtpk(p0[8], p0[9]), cvtpk(p0[10], p0[11]), cvtpk(p0[12], p0[13]), cvtpk(p0[14], p0[15])}; pa1 = __builtin_bit_cast(bf16x8, w1_);
              u32x4 w2_ = {cvtpk(p1[0], p1[1]), cvtpk(p1[2], p1[3]), cvtpk(p1[4], p1[5]), cvtpk(p1[6], p1[7])}; pa2 = __builtin_bit_cast(bf16x8, w2_);
              u32x4 w3_ = {cvtpk(p1[8], p1[9]), cvtpk(p1[10], p1[11]), cvtpk(p1[12], p1[13]), cvtpk(p1[14], p1[15])}; pa3 = __builtin_bit_cast(bf16x8, w3_); }
          else softmax_tile(p0, p1, sh_, m_reg, l_reg, alpha, pa0, pa1, pa2, pa3);
          if (__any(alpha < 1.f)) { if (hi == 0) ws[r32] = alpha; asm volatile("s_waitcnt lgkmcnt(0)" ::: "memory");
#pragma unroll
              for (int d_ = 0; d_ < 4; ++d_)
#pragma unroll
                  for (int r = 0; r < 16; ++r) o[d_][r] *= ws[crow(r, hi)]; } }
        if (!halfB) { if (issue) asm volatile("s_waitcnt vmcnt(4)" ::: "memory"); else asm volatile("s_waitcnt vmcnt(0)" ::: "memory"); }
        WG_BAR();
    }
    __builtin_amdgcn_s_setprio(2);
    if (VAR != 2 && VAR != 3 && VAR != 7 && VAR != 8) pv_tile_pf(o, vb0 + ((NT - 1) & 3) * SHM_V, pa0, pa1, pa2, pa3);
    __builtin_amdgcn_s_setprio(0);
    if (!halfB) WG_BAR();
    WG_BAR();
    if (hi == 0) ws[32 + r32] = l_reg; asm volatile("s_waitcnt lgkmcnt(0)" ::: "memory");
#pragma unroll
    for (int r = 0; r < 16; ++r) { const float rl = __builtin_amdgcn_rcpf(ws[32 + crow(r, hi)]);
#pragma unroll
        for (int d0 = 0; d0 < 4; ++d0) o[d0][r] *= rl; }
    LAS float* xch = (LAS float*)lds + (size_t)w4 * 64 * 64;
    if (cm == 1) {
#pragma unroll
        for (int d0 = 0; d0 < 4; ++d0)
#pragma unroll
            for (int r = 0; r < 16; ++r) xch[(d0 * 16 + r) * 64 + lane] = o[d0][r];
    }
    WG_BAR();
    if (cm == 0) {
        float ss[16];
#pragma unroll
        for (int r = 0; r < 16; ++r) { float a = 0.f;
#pragma unroll
            for (int d0 = 0; d0 < 4; ++d0) { o[d0][r] -= lam_full * xch[(d0 * 16 + r) * 64 + lane]; a += o[d0][r] * o[d0][r]; }
            ss[r] = a; }
#pragma unroll
        for (int r = 0; r < 16; ++r) {
#pragma unroll
            for (int sft = 1; sft < 32; sft <<= 1) ss[r] += bperm_f(lane ^ sft, ss[r]); }
        float gg[4];
#pragma unroll
        for (int d0 = 0; d0 < 4; ++d0) gg[d0] = subg[d0 * 32 + r32] * (1.0f - LAMBDA_INIT);
        bf16* Ow = O + (rowbase + qw0) * PITCH + h * HD;
#pragma unroll
        for (int r = 0; r < 16; ++r) { const int orow = crow(r, hi); const float rs = 1.0f / sqrtf(ss[r] * (1.0f / HD) + RMS_EPS);
            u32x2 wo; wo.x = cvtpk(o[0][r] * rs * gg[0], o[1][r] * rs * gg[1]); wo.y = cvtpk(o[2][r] * rs * gg[2], o[3][r] * rs * gg[3]);
            *(u32x2*)(Ow + (size_t)orow * PITCH + r32 * 4) = wo; }
    }
    WG_BAR();
}


__device__ __forceinline__ void block_load(LAS char* lds, const bf16* Kc, const bf16* Vc, const DmaOff& d, int wid) {
#pragma unroll
    for (int t = 0; t < 4; ++t) dma_tile(lds, t, Kc, Vc, t * 64, d, wid);
}
#define MOBA_TILE(t, CAUSAL) do { const int k0_ = kbase + (t) * 64; \
        if (!(CAUSAL) || k0_ <= qw0 + 31) { f32x16 p0, p1; bf16x8 pa0, pa1, pa2, pa3; float alpha, sh = 0.f; \
            const int dq_ = qpos - k0_ - 4 * hi; \
            if (CAUSAL) load_bias_lut(p0, p1, lut, dq_); \
            else { if (__all(qpos - (k0_ + 63) >= RFAR)) { sh = b31; p0 = f32x16{}; p1 = f32x16{}; } else load_bias_lut(p0, p1, lut, dq_ < RFAR + 63 ? dq_ : RFAR + 63); } \
            qkt<t, 8>(p0, p1, K_lds, r32, hi, 0, qr); \
            if ((CAUSAL) && k0_ + 63 > qw0) causal_mask(p0, p1, dq_); \
            softmax_tile(p0, p1, sh, m_reg, l_reg, alpha, pa0, pa1, pa2, pa3); \
            if (__any(alpha < 1.f)) { if (hi == 0) ws[r32] = alpha; asm volatile("s_waitcnt lgkmcnt(0)" ::: "memory"); \
                _Pragma("unroll") for (int d_ = 0; d_ < 4; ++d_) _Pragma("unroll") for (int r = 0; r < 16; ++r) o[d_][r] *= ws[crow(r, hi)]; } \
            pv_tile<t>(o, vb0, pa0, pa1, pa2, pa3); } } while (0)
__device__ __forceinline__ void moba_part_group(LAS char* lds, int bh, int j, int g, int cntj, const bf16* Q, const unsigned short* lists, const unsigned* sel,
                                                bf16* P0, bf16* P1, bf16* P2, f32x2* ml, float b31, int wid, int lane) {
    asm volatile("" : "+v"(lane));
    const int r32 = lane & 31, hi = lane >> 5, b = bh >> 3, h = bh & 7;
    const size_t rowbase = (size_t)b * SEQ;
    const int idx = g * 32 + r32; const bool valid = idx < cntj;
    const int qpos = (int)lists[((size_t)bh * 32 + j) * 8192 + (valid ? idx : cntj - 1)];
    const unsigned smask = sel[(size_t)bh * SEQ + qpos]; const int slot = __popc(smask & ((1u << j) - 1u));
    const int vb0 = (int)(unsigned)(uintptr_t)(lds + L_V) + v_rd_base(lane);
    LAS float* ws = (LAS float*)(lds + L_WS) + wid * 64;
    LAS const float* lut = (LAS const float*)(lds + L_LUT);
    lcp K_lds = (lcp)(lds + L_K);
    bf16x8 qr[8];
#pragma unroll
    for (int d0 = 0; d0 < 8; ++d0) qr[d0] = *(const bf16x8*)(Q + (rowbase + qpos) * PITCH + h * HD + d0 * 16 + hi * 8);
    if (hi == 0) ((LAS int*)ws)[32 + r32] = valid ? (int)((unsigned)(rowbase + qpos) | ((unsigned)slot << 24)) : -1;
    float m_reg = -1e30f, l_reg = 0.f; f32x16 o[4] = {};
    const int kbase = j * 256, qw0 = 0; (void)qw0;
    MOBA_TILE(0, false); MOBA_TILE(1, false); MOBA_TILE(2, false); MOBA_TILE(3, false);
    if (hi == 0) { ws[r32] = l_reg; if (valid) ml[((size_t)slot * M + rowbase + qpos) * NH + h] = (f32x2){m_reg, l_reg}; }
    asm volatile("s_waitcnt lgkmcnt(0)" ::: "memory");
#pragma unroll
    for (int r = 0; r < 16; ++r) { const int orow = crow(r, hi); const float rl = __builtin_amdgcn_rcpf(ws[orow]); const int info = ((LAS const int*)ws)[32 + orow];
        const int sl = info >> 24; bf16* Pb = sl == 0 ? P0 : (sl == 1 ? P1 : P2); bf16* Ow = Pb + (size_t)(info & 0xffffff) * PITCH + h * HD;
        u32x2 w; w.x = cvtpk(o[0][r] * rl, o[1][r] * rl); w.y = cvtpk(o[2][r] * rl, o[3][r] * rl);
        if (info >= 0) *(u32x2*)(Ow + r32 * 4) = w; }
    asm volatile("s_waitcnt lgkmcnt(0)" ::: "memory");
}
__device__ __forceinline__ void moba_own_rows(LAS char* lds, int b, int h, int qb, const bf16* Q, bf16* O, const bf16* P0, const bf16* P1, const bf16* P2, const f32x2* ml, int wid, int lane) {
    asm volatile("" : "+v"(lane));
    const int r32 = lane & 31, hi = lane >> 5;
    const size_t rowbase = (size_t)b * SEQ;
    const int q0 = qb * 256, qw0 = q0 + wid * 32, qpos = qw0 + r32, kbase = q0;
    const int vb0 = (int)(unsigned)(uintptr_t)(lds + L_V) + v_rd_base(lane);
    LAS float* ws = (LAS float*)(lds + L_WS) + wid * 64;
    LAS const float* lut = (LAS const float*)(lds + L_LUT);
    lcp K_lds = (lcp)(lds + L_K);
    const float b31 = 0.f; (void)b31;
    bf16x8 qr[8];
#pragma unroll
    for (int d0 = 0; d0 < 8; ++d0) qr[d0] = *(const bf16x8*)(Q + (rowbase + qpos) * PITCH + h * HD + d0 * 16 + hi * 8);
    float m_reg = -1e30f, l_reg = 0.f; f32x16 o[4] = {};
    MOBA_TILE(0, true); MOBA_TILE(1, true); MOBA_TILE(2, true); MOBA_TILE(3, true);
    const int nsel = qb < 3 ? qb : 3;
    {
        float ms[3], ls[3]; float mx = m_reg;
#pragma unroll
        for (int s_ = 0; s_ < 3; ++s_) { ms[s_] = -1e30f; ls[s_] = 0.f;
            if (s_ < nsel) { const f32x2 v = ml[((size_t)s_ * M + rowbase + qpos) * NH + h]; ms[s_] = v.x; ls[s_] = v.y; mx = fmaxf(mx, v.x); } }
        const float w0 = __builtin_amdgcn_exp2f(m_reg - mx);
        float wv[3]; float den = l_reg * w0;
#pragma unroll
        for (int s_ = 0; s_ < 3; ++s_) { wv[s_] = ls[s_] * __builtin_amdgcn_exp2f(ms[s_] - mx); den += wv[s_]; }
        const float rd = 1.0f / den;
        if (hi == 0) *(LAS f32x4*)(lds + L_CF + wid * 512 + r32 * 16) = (f32x4){w0 * rd, wv[0] * rd, wv[1] * rd, wv[2] * rd};
    }
    asm volatile("s_waitcnt lgkmcnt(0)" ::: "memory");
#pragma unroll
    for (int r = 0; r < 16; ++r) { const int orow = crow(r, hi); const f32x4 cf = *(LAS const f32x4*)(lds + L_CF + wid * 512 + orow * 16);
        const size_t ro = (rowbase + qw0 + orow) * PITCH + h * HD + r32 * 4;
        float v0 = o[0][r] * cf.x, v1 = o[1][r] * cf.x, v2 = o[2][r] * cf.x, v3 = o[3][r] * cf.x;
        if (nsel > 0) { const u32x2 w = *(const u32x2*)(P0 + ro); v0 += cf.y * bflo(w.x); v1 += cf.y * bfhi(w.x); v2 += cf.y * bflo(w.y); v3 += cf.y * bfhi(w.y); }
        if (nsel > 1) { const u32x2 w = *(const u32x2*)(P1 + ro); v0 += cf.z * bflo(w.x); v1 += cf.z * bfhi(w.x); v2 += cf.z * bflo(w.y); v3 += cf.z * bfhi(w.y); }
        if (nsel > 2) { const u32x2 w = *(const u32x2*)(P2 + ro); v0 += cf.w * bflo(w.x); v1 += cf.w * bfhi(w.x); v2 += cf.w * bflo(w.y); v3 += cf.w * bfhi(w.y); }
        u32x2 wo; wo.x = cvtpk(v0, v1); wo.y = cvtpk(v2, v3);
        *(u32x2*)(O + ro) = wo; }
    asm volatile("s_waitcnt lgkmcnt(0)" ::: "memory");
}
#undef MOBA_TILE
#undef KSWZ
#undef SBAR
#undef WG_BAR
}


template <int VAR> __device__ __forceinline__ void p_diff_attn_mfma(const Args& a, LAS unsigned char* lds, int vcu, int tid, int wave, int lane, size_t out_off) {
    const bf16* Qb = (const bf16*)(a.ws + WS_Q); const bf16* Kb = (const bf16*)(a.ws + WS_K); const bf16* Vb = (const bf16*)(a.ws + WS_V);
    bf16* Ob = (bf16*)(a.ws + out_off); const float* biasT = (const float*)(a.ws + WS_BIAST);
    float lam_full;
    { const float* lm = a.diff_lambda; const float p01 = wave_sum(lm[lane] * lm[64 + lane]), p23 = wave_sum(lm[128 + lane] * lm[192 + lane]); lam_full = __expf(p01) - __expf(p23) + LAMBDA_INIT; }
    const int G = gridDim.x;
    if (G == 256) {
#pragma unroll 1
        for (int k = 0; k < 4; ++k) {
            const int bh = 2 * (vcu >> 5) + (k >> 1), p = vcu & 31, qb = (k & 1) ? 63 - p : p;
            att::diff_unit<VAR>((LAS char*)lds, bh >> 3, bh & 7, qb, Qb, Kb, Vb, Ob, a.rel_bias, biasT, lam_full, a.diff_subln_g, tid, wave, lane);
        }
    } else {
        for (int pp = vcu; pp < 512; pp += G) {
#pragma unroll 1
            for (int k = 0; k < 2; ++k) {
                const int bh = pp >> 5, p = pp & 31, qb = k ? 63 - p : p;
                att::diff_unit<VAR>((LAS char*)lds, bh >> 3, bh & 7, qb, Qb, Kb, Vb, Ob, a.rel_bias, biasT, lam_full, a.diff_subln_g, tid, wave, lane);
            }
        }
    }
}


__device__ __forceinline__ void p_moba_part(const Args& a, LAS unsigned char* lds, int vcu, int tid, int wave, int lane) {
    const bf16* Qb = (const bf16*)(a.ws + WS_Q); const bf16* Kb = (const bf16*)(a.ws + WS_K); const bf16* Vb = (const bf16*)(a.ws + WS_V);
    const unsigned* cnt = (const unsigned*)(a.ws + WS_CTL) + CW_CNT; const unsigned short* lists = (const unsigned short*)(a.ws + WS_LIST); const unsigned* sel = (const unsigned*)(a.ws + WS_SEL);
    bf16* P0 = (bf16*)(a.ws + WS_H); bf16* P1 = (bf16*)(a.ws + WS_Y); bf16* P2 = (bf16*)a.out; f32x2* ml = (f32x2*)((unsigned char*)a.out + WS_ML);
    LAS int* pre = (LAS int*)(lds + att::L_TAB); LAS int* found = (LAS int*)(lds + att::L_FOUND);
    const int c = (int)cnt[tid], nch = (c + 255) >> 8;
    int incl = nch;
#pragma unroll
    for (int o = 1; o < 64; o <<= 1) { const int v = bperm_i(lane >= o ? lane - o : lane, incl); if (lane >= o) incl += v; }
    if (lane == 63) pre[513 + wave] = incl;
    __syncthreads();
    int woff = 0;
#pragma unroll
    for (int w8 = 0; w8 < 8; ++w8) woff += (w8 < wave) ? pre[513 + w8] : 0;
    pre[tid + 1] = woff + incl; if (tid == 0) pre[0] = 0;
    __syncthreads();
    const int T = pre[512], G = gridDim.x;
    const int lo = (int)(((long long)T * vcu) / G), hi_ = (int)(((long long)T * (vcu + 1)) / G);
    const att::DmaOff dmo = att::dma_offsets(wave, lane);
    int last_h = -1;
    for (int it = lo; it < hi_;) {
        if (pre[tid] <= it && it < pre[tid + 1]) found[0] = tid;
        __syncthreads();
        const int f = __builtin_amdgcn_readfirstlane(found[0]);
        const int bh = f >> 5, j = f & 31, c0 = it - pre[f];
        const int seg_end = pre[f + 1] < hi_ ? pre[f + 1] : hi_, c1 = seg_end - pre[f];
        const int cntj = (int)cnt[f];
        const size_t kvoff = ((size_t)(bh >> 3) * SEQ + j * 256) * D + (bh & 7) * HD;
        att::block_load((LAS char*)lds, Kb + kvoff, Vb + kvoff, dmo, wave);
        if ((bh & 7) != last_h) { last_h = bh & 7; att::build_lut((LAS char*)lds, (const float*)(a.ws + WS_BIAST), last_h, tid); }
        const float b31 = a.rel_bias[31 * 8 + (bh & 7)] * LOG2E;
        asm volatile("s_waitcnt vmcnt(0)" ::: "memory");
        __syncthreads();
        for (int g = c0 * 8 + wave; g < c1 * 8 && g * 32 < cntj; g += 8)
            att::moba_part_group((LAS char*)lds, bh, j, g, cntj, Qb, lists, sel, P0, P1, P2, ml, b31, wave, lane);
        it = seg_end;
    }
}
__device__ __forceinline__ void p_moba_own(const Args& a, LAS unsigned char* lds, int vcu, int tid, int wave, int lane) {
    const bf16* Qb = (const bf16*)(a.ws + WS_Q); const bf16* Kb = (const bf16*)(a.ws + WS_K); const bf16* Vb = (const bf16*)(a.ws + WS_V); bf16* Ob = (bf16*)(a.ws + WS_O);
    const bf16* P0 = (const bf16*)(a.ws + WS_H); const bf16* P1 = (const bf16*)(a.ws + WS_Y); const bf16* P2 = (const bf16*)a.out; const f32x2* ml = (const f32x2*)((const unsigned char*)a.out + WS_ML);
    const int G = gridDim.x;
    const att::DmaOff dmo = att::dma_offsets(wave, lane);
    for (int u0 = 2 * vcu; u0 < 512; u0 += 2 * G) {
#pragma unroll 1
        for (int k = 0; k < 2; ++k) { const int u = u0 + k; if (u >= 512) break; const int bh = u >> 5, qb = u & 31;
            __syncthreads();
            const size_t kvoff = ((size_t)(bh >> 3) * SEQ + qb * 256) * D + (bh & 7) * HD;
            att::block_load((LAS char*)lds, Kb + kvoff, Vb + kvoff, dmo, wave);
            if (k == 0 || (u & 31) == 0) att::build_lut((LAS char*)lds, (const float*)(a.ws + WS_BIAST), bh & 7, tid);
            asm volatile("s_waitcnt vmcnt(0)" ::: "memory");
            __syncthreads();
            att::moba_own_rows((LAS char*)lds, bh >> 3, bh & 7, qb, Qb, Ob, P0, P1, P2, ml, wave, lane); }
    }
}

struct TI { int tid, lane, wave, gtid, gw; };
__device__ __forceinline__ TI mk_ti(int wave0) { const int l = lane_opaque(); const int t = wave0 * 64 + l; TI r; r.tid = t; r.lane = l; r.wave = wave0;
    r.gtid = blockIdx.x * NTHR + t; r.gw = blockIdx.x * NWAVES + r.wave; return r; }

typedef const __attribute__((address_space(4))) Args* CArgs;
__device__ __forceinline__ Args load_args() {
#if defined(__HIP_DEVICE_COMPILE__)
    auto p = __builtin_amdgcn_kernarg_segment_ptr(); asm volatile("" : "+s"(p));
    typedef const __attribute__((address_space(4))) unsigned long long* cu64; cu64 q = (cu64)p;
    Args r; r.x = (const float*)q[0]; r.c = (const float*)q[1]; r.rel_bias = (const float*)q[2]; r.ada_w = (const float*)q[3]; r.ada_b = (const float*)q[4]; r.norm_g = (const float*)q[5];
    r.moba_w_qkv = (const float*)q[6]; r.moba_w_o = (const float*)q[7]; r.diff_w_qkv = (const float*)q[8]; r.diff_w_o = (const float*)q[9];
    r.diff_lambda = (const float*)q[10]; r.diff_subln_g = (const float*)q[11]; r.ffn_w_in = (const float*)q[12]; r.ffn_w_out = (const float*)q[13];
    r.out = (float*)q[14]; r.ws = (unsigned char*)q[15]; return r;
#else
    return Args{};
#endif
}
#define WSP(T, off) ((T*)(a.ws + (off)))
#define GEMM_PHASE_F8(EPI, Aptr, Wptr, N_, K_, ...) do { const Args a = load_args(); const int G_ = gridDim.x; \
        pg8::Gemm g{Aptr, (const bf16*)(Wptr), M, N_, K_}; pg8::StaticOrder S; S.init(M, N_, G_, (int)blockIdx.x); \
        EPI E{__VA_ARGS__}; pg8::gemm_phase<EPI, pg8::StaticOrder, true, true, true>(lds, g, S, E, wave0); } while (0)
#define GEMM_PHASE(EPI, Aptr, Wptr, N_, K_, ...) do { const Args a = load_args(); const int G_ = gridDim.x; \
        pg8::Gemm g{Aptr, (const bf16*)(Wptr), M, N_, K_}; pg8::StaticOrder S; S.init(M, N_, G_, (int)blockIdx.x); \
        EPI E{__VA_ARGS__}; pg8::gemm_phase<EPI, pg8::StaticOrder, true, true>(lds, g, S, E, wave0); } while (0)
__global__ void __launch_bounds__(NTHR, 2) fwd(Args a_unused) {
    extern __shared__ __attribute__((aligned(16))) unsigned char lds_raw[];
    LAS unsigned char* lds = (LAS unsigned char*)lds_raw;
    volatile LAS unsigned* MISC = (volatile LAS unsigned*)(lds + MISC_OFF);
    const int wave0 = __builtin_amdgcn_readfirstlane((int)threadIdx.x >> 6);
    if (wave0 == 0) MISC[lane_opaque()] = 0u;
    __syncthreads();
    XcdBarrier bar;
    { const Args a = load_args(); bar = xcd_barrier_post(WSP(unsigned, WS_CTL) + CW_BAR, MISC + 8, wave0); }
#define VCU() ((gridDim.x % 8 == 0) ? (int)((blockIdx.x % 8) * (gridDim.x / 8) + blockIdx.x / 8) : (int)blockIdx.x)
#define NGW() ((int)gridDim.x * NWAVES)
#define NGT() ((int)gridDim.x * NTHR)
    constexpr float QS0 = 0.08838834764831845f * LOG2E, QS1 = 0.125f * LOG2E;
    constexpr size_t QKVS = (size_t)(WS_K - WS_Q) / 2;

    { const Args a = load_args(); const TI t = mk_ti(wave0); p_weights(a, lds, t.gw, NGW(), t.wave, t.lane); p_wo_perm(a, t.gtid, NGT()); __syncthreads(); p_mod(a, lds, (int)blockIdx.x, (int)gridDim.x, t.tid, t.wave, t.lane); }
    xcd_barrier(bar);
    { const Args a = load_args(); const TI t = mk_ti(wave0); const float* md = WSP(const float, WS_MOD); p_norm_in(a.x, a.norm_g, md, md + 1024, WSP(bf16, WS_H), t.gw, NGW(), t.lane); }
    xcd_barrier(bar);
    GEMM_PHASE(pg8::EpiQKV, WSP(bf16, WS_H), a.ws + WS_W + WO_QKV, 3 * D, D, WSP(bf16, WS_Q), D, QKVS, QS0, WSP(float, WS_KSUM));
    xcd_barrier(bar);
    { const Args a = load_args(); const TI t = mk_ti(wave0); p_gate(WSP(bf16, WS_Q), WSP(const float, WS_KSUM), WSP(unsigned, WS_SEL), WSP(unsigned, WS_CTL) + CW_CNT, WSP(unsigned short, WS_LIST), lds, (int)blockIdx.x, (int)gridDim.x, t.tid, t.wave, t.lane); }
    xcd_barrier(bar);
    { const Args a = load_args(); const TI t = mk_ti(wave0); p_moba_part(a, lds, VCU(), t.tid, t.wave, t.lane); }
    xcd_barrier(bar);
    { const Args a = load_args(); const TI t = mk_ti(wave0); p_moba_own(a, lds, VCU(), t.tid, t.wave, t.lane); }
    xcd_barrier(bar);
    GEMM_PHASE(pg8::EpiBf16<0>, WSP(bf16, WS_O), a.ws + WS_W + WO_O, D, D, WSP(bf16, WS_Y), D, nullptr, 0, 0, 1.f);
    xcd_barrier(bar);
    { const Args a = load_args(); const TI t = mk_ti(wave0); const float* md = WSP(const float, WS_MOD); const float* ng = a.norm_g;
      p_post<false, true, true>(a.x, WSP(bf16, WS_Y), ng + D, md + 2048, a.out, ng + 2 * D, md + 3072, md + 4096, WSP(bf16, WS_H), t.gw, NGW(), t.lane); }
    xcd_barrier(bar);
    GEMM_PHASE_F8(pg8::EpiSwiglu, WSP(bf16, WS_H), a.ws + WS_W + WO_IN, 2 * DFF, D / 2, WSP(bf16, WS_HH), DFF, 1.0f / (F8_SA * F8_SB));
    xcd_barrier(bar);
    GEMM_PHASE(pg8::EpiBf16<0>, WSP(bf16, WS_HH), a.ws + WS_W + WO_OUT, D, DFF, WSP(bf16, WS_Y), D, nullptr, 0, 0, 1.f);
    xcd_barrier(bar);
    { const Args a = load_args(); const TI t = mk_ti(wave0); const float* md = WSP(const float, WS_MOD); const float* ng = a.norm_g; const float* md1 = md + 2 * 6144; const float* ng1 = ng + 4 * D;
      p_post<true, true, false>(a.out, WSP(bf16, WS_Y), ng + 3 * D, md + 5120, (unsigned char*)a.out + 32 * MiB, ng1, md1, md1 + 1024, WSP(bf16, WS_H), t.gw, NGW(), t.lane); }
    xcd_barrier(bar);
    GEMM_PHASE(pg8::EpiQKV, WSP(bf16, WS_H), a.ws + WS_W + WL_STRIDE + WO_QKV, 3 * D, D, WSP(bf16, WS_Q), D, QKVS, QS1, nullptr);
    xcd_barrier(bar);
    { const Args a = load_args(); const TI t = mk_ti(wave0); p_diff_attn_mfma<0>(a, lds, VCU(), t.tid, t.wave, t.lane, WS_O); }
#ifdef PROBE_VAR
    { const Args a = load_args(); const TI t = mk_ti(wave0); p_diff_attn_mfma<PROBE_VAR>(a, lds, VCU(), t.tid, t.wave, t.lane, WS_Y); }
#endif
    xcd_barrier(bar);
    GEMM_PHASE(pg8::EpiBf16<0>, WSP(bf16, WS_O), a.ws + WS_W + WL_STRIDE + WO_O, D, D, WSP(bf16, WS_Y), D, nullptr, 0, 0, 1.f);
    xcd_barrier(bar);
    { const Args a = load_args(); const TI t = mk_ti(wave0); const float* md = WSP(const float, WS_MOD) + 2 * 6144; const float* ng = a.norm_g + 4 * D;
      p_post<true, true, true>((unsigned char*)a.out + 32 * MiB, WSP(bf16, WS_Y), ng + D, md + 2048, WSP(bf16, WS_O), ng + 2 * D, md + 3072, md + 4096, WSP(bf16, WS_H), t.gw, NGW(), t.lane); }
    xcd_barrier(bar);
    GEMM_PHASE_F8(pg8::EpiSwiglu, WSP(bf16, WS_H), a.ws + WS_W + WL_STRIDE + WO_IN, 2 * DFF, D / 2, WSP(bf16, WS_HH), DFF, 1.0f / (F8_SA * F8_SB));
    xcd_barrier(bar);
    GEMM_PHASE(pg8::EpiBf16<0>, WSP(bf16, WS_HH), a.ws + WS_W + WL_STRIDE + WO_OUT, D, DFF, WSP(bf16, WS_Y), D, nullptr, 0, 0, 1.f);
    xcd_barrier(bar);
    { const Args a = load_args(); const TI t = mk_ti(wave0); const float* md = WSP(const float, WS_MOD) + 2 * 6144; const float* ng = a.norm_g + 4 * D;
      p_post<true, false, false>(WSP(bf16, WS_O), WSP(bf16, WS_Y), ng + 3 * D, md + 5120, a.out, nullptr, nullptr, nullptr, nullptr, t.gw, NGW(), t.lane); }
}

extern "C" void kernel_launch(void* const* d_in, const int* in_sizes, int n_in, void* d_out, int out_size, void* d_ws, size_t ws_size, hipStream_t stream) {
    static int grid = 0;
    if (grid == 0) {
        if (n_in != 14 || out_size != M * D || ws_size < WS_END) { fprintf(stderr, "kernel_launch: unexpected shapes n_in %d out %d ws %zu\n", n_in, out_size, ws_size); grid = -1; return; }
        int dev = 0, cus = 0;
        if (hipGetDevice(&dev) != hipSuccess || hipDeviceGetAttribute(&cus, hipDeviceAttributeMultiprocessorCount, dev) != hipSuccess) { grid = -1; return; }
        if (hipFuncSetAttribute((const void*)fwd, hipFuncAttributeMaxDynamicSharedMemorySize, LDS_BYTES) != hipSuccess) { fprintf(stderr, "hipFuncSetAttribute failed\n"); grid = -1; return; }
        grid = cus;
    }
    if (grid < 0) return;
    (void)hipMemsetAsync((char*)d_ws + WS_CTL, 0, CTL_ZERO_BYTES, stream);
    Args a{};
    a.x = (const float*)d_in[0]; a.c = (const float*)d_in[1]; a.rel_bias = (const float*)d_in[2]; a.ada_w = (const float*)d_in[3]; a.ada_b = (const float*)d_in[4];
    a.norm_g = (const float*)d_in[5]; a.moba_w_qkv = (const float*)d_in[6]; a.moba_w_o = (const float*)d_in[7]; a.diff_w_qkv = (const float*)d_in[8]; a.diff_w_o = (const float*)d_in[9];
    a.diff_lambda = (const float*)d_in[10]; a.diff_subln_g = (const float*)d_in[11]; a.ffn_w_in = (const float*)d_in[12]; a.ffn_w_out = (const float*)d_in[13];
    a.out = (float*)d_out; a.ws = (unsigned char*)d_ws;
    hipLaunchKernelGGL(fwd, dim3(grid), dim3(NTHR), LDS_BYTES, stream, a);
}
```

```cpp
#include <hip/hip_runtime.h>
#include <cstdio>
#include <cstdint>

#define GAS __attribute__((address_space(1)))
#define LAS __attribute__((address_space(3)))
typedef unsigned short bf16;
typedef float f32x4 __attribute__((ext_vector_type(4)));
typedef float f32x2 __attribute__((ext_vector_type(2)));
typedef unsigned u32x4 __attribute__((ext_vector_type(4)));
typedef unsigned u32x2 __attribute__((ext_vector_type(2)));

constexpr int BATCH = 2, SEQ = 8192, D = 1024, NH = 8, HD = 128, DFF = 2816, NBKT = 32;
constexpr int M = BATCH * SEQ;
constexpr int NWAVES = 8, NTHR = 512;
constexpr float RMS_EPS = 1e-6f;
constexpr float LOG2E = 1.4426950408889634f;
constexpr float LAMBDA_INIT = 0.35550906759096926f;

constexpr size_t MiB = 1u << 20;
constexpr size_t WS_CTL = 0, CTL_ZERO_BYTES = 1 * MiB;
constexpr size_t WS_MOD = 1 * MiB;
constexpr size_t WS_BLUT = WS_MOD + 128 * 1024;
constexpr size_t WS_KMEAN = WS_BLUT + 16 * 1024;
constexpr size_t WS_SEL = WS_KMEAN + 256 * 1024;
constexpr size_t WS_BIAST = WS_SEL + 512 * 1024;
constexpr size_t WS_LIST = 244 * MiB;
constexpr size_t WS_ML = 32 * MiB;
constexpr size_t WS_KSUM = 256 * 1024;
constexpr int CW_CNT = 8192;
constexpr size_t WS_W = 2 * MiB, WL_STRIDE = 25 * MiB;
constexpr size_t WO_QKV = 0, WO_O = 6 * MiB, WO_IN = 8 * MiB, WO_OUT = 19 * MiB;
constexpr size_t WS_H = 52 * MiB;
constexpr size_t WS_Q = 84 * MiB, WS_K = 116 * MiB, WS_V = 148 * MiB;
constexpr size_t WS_HH = 84 * MiB;
constexpr size_t WS_O = 180 * MiB;
constexpr size_t WS_Y = 212 * MiB;
constexpr size_t WS_END = 252 * MiB;
constexpr int CW_BAR = 4096;

constexpr int LDS_BYTES = 155648;
constexpr int MISC_OFF = 150016;

#define RLX_AGENT __ATOMIC_RELAXED, __HIP_MEMORY_SCOPE_AGENT
__device__ __forceinline__ unsigned f2bf(float f) { unsigned u = __builtin_bit_cast(unsigned, f); return (u + 0x7fffu + ((u >> 16) & 1u)) >> 16; }
__device__ __forceinline__ unsigned pk2(float lo, float hi) { return f2bf(lo) | (f2bf(hi) << 16); }
__device__ __forceinline__ float bf2f(unsigned short b) { return __builtin_bit_cast(float, (unsigned)b << 16); }
__device__ __forceinline__ float bflo(unsigned w) { return __builtin_bit_cast(float, w << 16); }
__device__ __forceinline__ float bfhi(unsigned w) { return __builtin_bit_cast(float, w & 0xffff0000u); }

__device__ __forceinline__ int lane_opaque() { int l; asm volatile("v_mbcnt_lo_u32_b32 %0, -1, 0\n\tv_mbcnt_hi_u32_b32 %0, -1, %0" : "=v"(l)); return l; }
__device__ __forceinline__ float bperm_f(int src_lane, float v) { return __builtin_bit_cast(float, __builtin_amdgcn_ds_bpermute(src_lane << 2, __builtin_bit_cast(int, v))); }
__device__ __forceinline__ int bperm_i(int src_lane, int v) { return __builtin_amdgcn_ds_bpermute(src_lane << 2, v); }

#define XB_TMO      128
#define XB_XCNT(j)  (256  + 64 * (j))
#define XB_XSUB(j)  (1280 + 64 * (j))
#define XB_XGEN(j)  (2304 + 64 * (j))
#define XB_TOP      3328
#define XB_TOPGEN   3392
#define XCD_BAR_WORDS 3456
#define XB_SPIN_CAP (1u << 25)
__device__ __forceinline__ unsigned xb_ld(unsigned* p)              { return __hip_atomic_load(p, __ATOMIC_RELAXED, __HIP_MEMORY_SCOPE_AGENT); }
__device__ __forceinline__ unsigned xb_add(unsigned* p, unsigned v) { return __hip_atomic_fetch_add(p, v, __ATOMIC_RELAXED, __HIP_MEMORY_SCOPE_AGENT); }
__device__ __forceinline__ unsigned xb_xcc_id() { return (unsigned)__builtin_amdgcn_s_getreg((3 << 11) | 20) & 0xFu; }
#define XB_SPIN(cond, bar) do { unsigned _sp = 0; while (cond) { __builtin_amdgcn_s_sleep(1); \
    if ((++_sp & 255u) == 0u) { if (xb_ld(&(bar)[XB_TMO])) break; if (_sp > XB_SPIN_CAP) { atomicAdd(&(bar)[XB_TMO], 1u); break; } } } } while (0)
struct XcdBarrier { unsigned* bar; unsigned x; volatile LAS unsigned* st; int wave; };
__device__ __forceinline__ XcdBarrier xcd_barrier_post(unsigned* bar, volatile LAS unsigned* st, int wave) {
    XcdBarrier b; b.bar = bar; b.x = xb_xcc_id(); b.st = st; b.wave = wave;
    if (wave == 0 && lane_opaque() == 0) (void)xb_add(&bar[XB_XCNT(b.x)], 1u);
    return b;
}
__device__ __forceinline__ void xcd_barrier_complete(unsigned* bar, unsigned x, unsigned& nloc, unsigned& nx) {
    const unsigned G = gridDim.x * gridDim.y * gridDim.z;
    unsigned sum, cnt, mine, sp = 0u;
    for (;;) {
        sum = 0u; cnt = 0u; mine = 0u;
#pragma unroll
        for (unsigned j = 0; j < 16; ++j) { const unsigned c = xb_ld(&bar[XB_XCNT(j)]); sum += c; cnt += (c > 0u) ? 1u : 0u; mine = (j == x) ? c : mine; }
        if (sum == G) break;
        __builtin_amdgcn_s_sleep(1);
        if ((++sp & 255u) == 0u) { if (xb_ld(&bar[XB_TMO])) break; if (sp > XB_SPIN_CAP) { atomicAdd(&bar[XB_TMO], 1u); break; } }
    }
    nloc = mine > 0u ? mine : 1u; nx = cnt > 0u ? cnt : 1u;
}
__device__ __forceinline__ void xcd_barrier(const XcdBarrier& b) {
    asm volatile("s_waitcnt vmcnt(0)" ::: "memory");
    __syncthreads();
    if (b.wave == 0 && lane_opaque() == 0) {
        unsigned* bar = b.bar;
        __builtin_amdgcn_s_waitcnt(0);
        unsigned nloc = b.st[0], nx = b.st[1];
        if (nloc == 0u) { xcd_barrier_complete(bar, b.x, nloc, nx); b.st[0] = nloc; b.st[1] = nx; }
        const unsigned old = xb_add(&bar[XB_XSUB(b.x)], 1u);
        const unsigned gen = old / nloc;
        if (old + 1u == (gen + 1u) * nloc) {
            __builtin_amdgcn_fence(__ATOMIC_RELEASE, "agent");
            asm volatile("s_waitcnt vmcnt(0)" ::: "memory");
            const unsigned og = xb_add(&bar[XB_TOP], 1u);
            const unsigned tg = og / nx;
            if (og + 1u == (tg + 1u) * nx) xb_add(&bar[XB_TOPGEN], 1u);
            else XB_SPIN(xb_ld(&bar[XB_TOPGEN]) == tg, bar);
            __builtin_amdgcn_fence(__ATOMIC_ACQUIRE, "agent");
            xb_add(&bar[XB_XGEN(b.x)], 1u);
            asm volatile("s_waitcnt vmcnt(0)" ::: "memory");
        } else {
            XB_SPIN(xb_ld(&bar[XB_XGEN(b.x)]) == gen, bar);
            __builtin_amdgcn_fence(__ATOMIC_ACQUIRE, "agent");
            asm volatile("s_waitcnt vmcnt(0)" ::: "memory");
        }
    }
    __syncthreads();
}

namespace pg8 {
#define PG8_LAS __attribute__((address_space(3)))
typedef unsigned short bf16_t;
typedef short bf16x8 __attribute__((ext_vector_type(8)));
typedef float f32x4 __attribute__((ext_vector_type(4)));
typedef unsigned u32x4 __attribute__((ext_vector_type(4)));
constexpr int BM = 256, BK = 64, HALF = 128, HTB = HALF * BK * 2  , STAGE_BYTES = 8 * HTB, NXCD = 8, WGM = 8;

__host__ __device__ __forceinline__ int lds_byte(int r, int c) { const int st = (r >> 4) * 2 + (c >> 5), rr = r & 15, cc = c & 31, ob = rr * 64 + cc * 2; return st * 1024 + (ob ^ (((ob >> 9) & 1) << 5)); }
__host__ __device__ __forceinline__ void stage_rc(int b, int& R, int& C) { const int st = b / 1024, sb = b % 1024, swz = sb ^ (((sb >> 9) & 1) << 5); R = (st >> 1) * 16 + swz / 64; C = (st & 1) * 32 + (swz % 64) / 2; }
__host__ __device__ __forceinline__ int perm32(int rho) { const int n = rho >> 4, i = rho & 15; return 8 * (i >> 2) + 4 * n + (i & 3); }

struct Unit { int pm, pn; };
struct Gemm { const bf16_t* A; const bf16_t* Bt; int M, N, K; };

struct StaticOrder {
    int nM, nN, nwg, G, c;
    __host__ __device__ void init(int M, int N, int G_, int c_) { nM = M / BM; nN = N / BM; nwg = nM * nN; G = G_; c = c_; }
    __host__ __device__ bool next(int i, Unit& u) const {
        const long L = (long)i * G + c; if (L >= nwg) return false;
        int wgid = (int)L; { const int q = nwg / NXCD, r = nwg % NXCD, xcd = wgid % NXCD, off = wgid / NXCD; wgid = (xcd < r ? xcd * (q + 1) : r * (q + 1) + (xcd - r) * q) + off; }
        const int nig = WGM * nN, gid = wgid / nig, fm = gid * WGM, gsz = (nM - fm) < WGM ? (nM - fm) : WGM;
        u.pm = fm + ((wgid % nig) % gsz); u.pn = (wgid % nig) / gsz; return true;
    }
    __device__ __forceinline__ void a_ready(const Unit&) const {}
    __device__ __forceinline__ void done(const Unit&) const {}
};

__device__ __forceinline__ unsigned cvt_pk_bf16(float lo, float hi) { unsigned r; asm volatile("v_cvt_pk_bf16_f32 %0, %1, %2" : "=v"(r) : "v"(lo), "v"(hi)); return r; }
typedef float f32x2 __attribute__((ext_vector_type(2)));
__device__ __forceinline__ f32x2 gelu_pk(f32x2 v) {
    const f32x2 av = __builtin_elementwise_abs(v), d = av * 0.2316418882f + 1.0f;
    f32x2 t; t.x = __builtin_amdgcn_rcpf(d.x); t.y = __builtin_amdgcn_rcpf(d.y);
    f32x2 q = t * 0.5307027145f + (-0.7265760135f); q = q * t + 0.7107068705f; q = q * t + (-0.142248368f); q = q * t + 0.127414796f; q = q * t;
    const f32x2 s = (v * v) * (-0.72134752044f);
    f32x2 e; e.x = __builtin_amdgcn_exp2f(s.x); e.y = __builtin_amdgcn_exp2f(s.y);
    const f32x2 m = v * (q * e), r = v - m;
    f32x2 o; o.x = v.x < 0.f ? m.x : r.x; o.y = v.y < 0.f ? m.y : r.y; return o;
}

template <int ACT  > struct EpiBf16 {
    static constexpr bool PERM = true, AFTER_DRAIN = false; static_assert(ACT == 0 || ACT == 1, "EpiBf16: ACT is 0 (none) or 1 (gelu_pk)");
    bf16_t* O; int ldc; const float* bias; int split_cols; size_t split_stride; float scale0;
    __device__ __forceinline__ void operator()(const f32x4 (&acc)[2][2][4][2], const Unit& u, int wr, int wc, int fr, int fq) const {
        const int row0 = u.pm * BM + wr * 64 + fr; int colt = u.pn * BM; bf16_t* base = O;
        float sc = 1.f; if (split_cols) { const int t = colt / split_cols; base += (size_t)t * split_stride; colt -= t * split_cols; if (t == 0) sc = scale0; }
        const int col0 = colt + wc * 32 + 8 * fq, bcol0 = u.pn * BM + wc * 32 + 8 * fq;
        f32x4 bv[2][2];
#pragma unroll
        for (int bj = 0; bj < 2; ++bj)
#pragma unroll
            for (int n = 0; n < 2; ++n) bv[bj][n] = bias ? *(const f32x4*)(bias + bcol0 + bj * HALF + 4 * n) : (f32x4){0.f, 0.f, 0.f, 0.f};
#pragma unroll
        for (int ai = 0; ai < 2; ++ai)
#pragma unroll
            for (int m = 0; m < 4; ++m) { bf16_t* rowp = base + (size_t)(row0 + ai * HALF + m * 16) * ldc + col0;
#pragma unroll
                for (int bj = 0; bj < 2; ++bj) { f32x4 v0 = acc[ai][bj][m][0] + bv[bj][0], v1 = acc[ai][bj][m][1] + bv[bj][1];
                    if (ACT == 1) { f32x2 a = gelu_pk((f32x2){v0[0], v0[1]}), b = gelu_pk((f32x2){v0[2], v0[3]}), c = gelu_pk((f32x2){v1[0], v1[1]}), d = gelu_pk((f32x2){v1[2], v1[3]});
                        v0 = (f32x4){a.x, a.y, b.x, b.y}; v1 = (f32x4){c.x, c.y, d.x, d.y}; }
                    v0 = v0 * sc; v1 = v1 * sc; u32x4 w; w.x = cvt_pk_bf16(v0[0], v0[1]); w.y = cvt_pk_bf16(v0[2], v0[3]); w.z = cvt_pk_bf16(v1[0], v1[1]); w.w = cvt_pk_bf16(v1[2], v1[3]);
                    *(u32x4*)(rowp + bj * HALF) = w; } }
    }
};

struct EpiQKV {
    static constexpr bool PERM = true, AFTER_DRAIN = false;
    bf16_t* O; int ldc; size_t split_stride; float scale0; float* ksum;
    __device__ __forceinline__ void operator()(const f32x4 (&acc)[2][2][4][2], const Unit& u, int wr, int wc, int fr, int fq) const {
        const int row0 = u.pm * BM + wr * 64 + fr; const int t = (u.pn * BM) / ldc; const int colt = u.pn * BM - t * ldc; bf16_t* base = O + (size_t)t * split_stride;
        const float sc = t == 0 ? scale0 : 1.f;
        const int col0 = colt + wc * 32 + 8 * fq;
#pragma unroll
        for (int ai = 0; ai < 2; ++ai)
#pragma unroll
            for (int m = 0; m < 4; ++m) { bf16_t* rowp = base + (size_t)(row0 + ai * HALF + m * 16) * ldc + col0;
#pragma unroll
                for (int bj = 0; bj < 2; ++bj) { const f32x4 v0 = acc[ai][bj][m][0] * sc, v1 = acc[ai][bj][m][1] * sc;
                    u32x4 w; w.x = cvt_pk_bf16(v0[0], v0[1]); w.y = cvt_pk_bf16(v0[2], v0[3]); w.z = cvt_pk_bf16(v1[0], v1[1]); w.w = cvt_pk_bf16(v1[2], v1[3]);
                    *(u32x4*)(rowp + bj * HALF) = w; } }
        if (ksum != nullptr && t == 1) {
            const int b = u.pm >> 5, blk = u.pm & 31, lq_ = lane_opaque();
#pragma unroll
            for (int bj = 0; bj < 2; ++bj) { const int h = (colt >> 7) + bj;
                float* dst = ksum + ((size_t)((b * 8 + h) * 32 + blk)) * 128 + wc * 32 + 8 * fq;
#pragma unroll
                for (int n = 0; n < 2; ++n) { f32x4 sacc = (f32x4){0.f, 0.f, 0.f, 0.f};
#pragma unroll
                    for (int ai = 0; ai < 2; ++ai)
#pragma unroll
                        for (int m = 0; m < 4; ++m) sacc += acc[ai][bj][m][n];
#pragma unroll
                    for (int e = 0; e < 4; ++e) { float v = sacc[e];
                        v += bperm_f(lq_ ^ 1, v); v += bperm_f(lq_ ^ 2, v); v += bperm_f(lq_ ^ 4, v); v += bperm_f(lq_ ^ 8, v);
                        if (fr == 0) atomicAdd(dst + 4 * n + e, v); } } }
        }
    }
};

struct EpiSwiglu {
    static constexpr bool PERM = true, AFTER_DRAIN = false;
    bf16_t* O; int ldc; float inv; float oscale;
    __device__ __forceinline__ void operator()(const f32x4 (&acc)[2][2][4][2], const Unit& u, int wr, int wc, int fr, int fq) const {
        const int row0 = u.pm * BM + wr * 64 + fr, col0 = u.pn * HALF + wc * 32 + 8 * fq;
#pragma unroll
        for (int ai = 0; ai < 2; ++ai)
#pragma unroll
            for (int m = 0; m < 4; ++m) { bf16_t* rowp = O + (size_t)(row0 + ai * HALF + m * 16) * ldc + col0;
                float v[8];
#pragma unroll
                for (int n = 0; n < 2; ++n)
#pragma unroll
                    for (int e = 0; e < 4; ++e) { const float g = acc[ai][0][m][n][e] * inv, uu = acc[ai][1][m][n][e] * inv;
                        v[n * 4 + e] = g * __builtin_amdgcn_rcpf(1.0f + __builtin_amdgcn_exp2f(-1.4426950408889634f * g)) * uu; }
                if (oscale > 0.f) { u32x2 w8;
                    { float c0 = fminf(fmaxf(v[0] * oscale, -448.f), 448.f), c1 = fminf(fmaxf(v[1] * oscale, -448.f), 448.f), c2 = fminf(fmaxf(v[2] * oscale, -448.f), 448.f), c3 = fminf(fmaxf(v[3] * oscale, -448.f), 448.f);
                      int t_ = __builtin_amdgcn_cvt_pk_fp8_f32(c0, c1, 0, false); t_ = __builtin_amdgcn_cvt_pk_fp8_f32(c2, c3, t_, true); w8.x = (unsigned)t_; }
                    { float c0 = fminf(fmaxf(v[4] * oscale, -448.f), 448.f), c1 = fminf(fmaxf(v[5] * oscale, -448.f), 448.f), c2 = fminf(fmaxf(v[6] * oscale, -448.f), 448.f), c3 = fminf(fmaxf(v[7] * oscale, -448.f), 448.f);
                      int t_ = __builtin_amdgcn_cvt_pk_fp8_f32(c0, c1, 0, false); t_ = __builtin_amdgcn_cvt_pk_fp8_f32(c2, c3, t_, true); w8.y = (unsigned)t_; }
                    *(u32x2*)((unsigned char*)O + (size_t)(row0 + ai * HALF + m * 16) * ldc + col0) = w8; }
                else { u32x4 w; w.x = cvt_pk_bf16(v[0], v[1]); w.y = cvt_pk_bf16(v[2], v[3]); w.z = cvt_pk_bf16(v[4], v[5]); w.w = cvt_pk_bf16(v[6], v[7]);
                *(u32x4*)rowp = w; } }
    }
};
struct EpiScaled {
    static constexpr bool PERM = true, AFTER_DRAIN = false;
    bf16_t* O; int ldc; float inv;
    __device__ __forceinline__ void operator()(const f32x4 (&acc)[2][2][4][2], const Unit& u, int wr, int wc, int fr, int fq) const {
        const int row0 = u.pm * BM + wr * 64 + fr, col0 = u.pn * BM + wc * 32 + 8 * fq;
#pragma unroll
        for (int ai = 0; ai < 2; ++ai)
#pragma unroll
            for (int m = 0; m < 4; ++m) { bf16_t* rowp = O + (size_t)(row0 + ai * HALF + m * 16) * ldc + col0;
#pragma unroll
                for (int bj = 0; bj < 2; ++bj) { const f32x4 v0 = acc[ai][bj][m][0] * inv, v1 = acc[ai][bj][m][1] * inv;
                    u32x4 w; w.x = cvt_pk_bf16(v0[0], v0[1]); w.y = cvt_pk_bf16(v0[2], v0[3]); w.z = cvt_pk_bf16(v1[0], v1[1]); w.w = cvt_pk_bf16(v1[2], v1[3]);
                    *(u32x4*)(rowp + bj * HALF) = w; } }
    }
};
template <class Epi, class Sched, bool ALIGN_EPI = false, bool SP2 = false, bool FP8 = false>
__device__ __forceinline__ void gemm_phase(PG8_LAS unsigned char* lds, const Gemm g, const Sched& S, const Epi& E, const int wave0) {
    const int tid_ = wave0 * 64 + lane_opaque();
    const int tid = tid_, wid = __builtin_amdgcn_readfirstlane(tid >> 6), lane = tid & 63, wr = wid >> 2, wc = wid & 3, fr = lane & 15, fq = lane >> 4;
    const int K = g.K, nt = K / BK;
    unsigned voffA[2], voffB[2];
#pragma unroll
    for (int i = 0; i < 2; ++i) { int R, C; stage_rc(tid * 16 + i * 8192, R, C); const int Rb = Epi::PERM ? ((R & ~31) + perm32(R & 31)) : R;
        voffA[i] = (unsigned)(R * K + C) * 2u; voffB[i] = (unsigned)(Rb * K + C) * 2u; }
    const size_t kstep = (size_t)(BK * 2);
    const size_t hstep = (size_t)HALF * K * 2;
    const size_t tstep = 2 * hstep;
    const unsigned ldsw = (unsigned)wid * 1024u;
    const int aoff = lds_byte(wr * 64 + fr, fq * 8), boff = lds_byte(wc * 32 + fr, fq * 8);
#define PG8_SA(b, h) (((b) * 2 + (h)) * HTB)
#define PG8_SB(b, h) ((4 + (b) * 2 + (h)) * HTB)
#define PG8_STAGE(bufoff, gbase, voff) do { _Pragma("unroll") for (int _i = 0; _i < 2; ++_i) \
        __builtin_amdgcn_global_load_lds((const unsigned*)((const char*)(gbase) + (voff)[_i]), (PG8_LAS unsigned*)(lds + (bufoff) + ldsw + _i * 8192), 16, 0, 0); } while (0)
#define PG8_LDA(dst, b, h) do { _Pragma("unroll") for (int m = 0; m < 4; ++m) _Pragma("unroll") for (int k = 0; k < 2; ++k) dst[m][k] = *(const PG8_LAS bf16x8*)(lds + PG8_SA(b, h) + aoff + m * 2048 + k * 1024); } while (0)
#define PG8_LDB(dst, b, h) do { _Pragma("unroll") for (int n = 0; n < 2; ++n) _Pragma("unroll") for (int k = 0; k < 2; ++k) dst[n][k] = *(const PG8_LAS bf16x8*)(lds + PG8_SB(b, h) + boff + n * 2048 + k * 1024); } while (0)
#define PG8_MMA(ai, bj, At, Bt) do { __builtin_amdgcn_s_setprio(1); \
        if constexpr (FP8) { typedef int i32x8_t __attribute__((ext_vector_type(8))); typedef int i32x4_t __attribute__((ext_vector_type(4))); \
            _Pragma("unroll") for (int m = 0; m < 4; ++m) _Pragma("unroll") for (int n = 0; n < 2; ++n) { \
                const i32x4_t b0_ = __builtin_bit_cast(i32x4_t, Bt[n][0]), b1_ = __builtin_bit_cast(i32x4_t, Bt[n][1]), a0_ = __builtin_bit_cast(i32x4_t, At[m][0]), a1_ = __builtin_bit_cast(i32x4_t, At[m][1]); \
                const i32x8_t bb_ = {b0_[0], b0_[1], b0_[2], b0_[3], b1_[0], b1_[1], b1_[2], b1_[3]}, aa_ = {a0_[0], a0_[1], a0_[2], a0_[3], a1_[0], a1_[1], a1_[2], a1_[3]}; \
                asm volatile("v_mfma_f32_16x16x128_f8f6f4 %0, %1, %2, %0" : "+v"(acc[ai][bj][m][n]) : "v"(bb_), "v"(aa_)); } } \
        else { _Pragma("unroll") for (int m = 0; m < 4; ++m) _Pragma("unroll") for (int n = 0; n < 2; ++n) _Pragma("unroll") for (int k = 0; k < 2; ++k) \
        acc[ai][bj][m][n] = __builtin_amdgcn_mfma_f32_16x16x32_bf16(Bt[n][k], At[m][k], acc[ai][bj][m][n], 0, 0, 0); } __builtin_amdgcn_s_setprio(0); } while (0)
#define PG8_WAIT_V(n) asm volatile("s_waitcnt vmcnt(" #n ")" ::: "memory")
#define PG8_WAIT_L(n) asm volatile("s_waitcnt lgkmcnt(" #n ")" ::: "memory")
#define PG8_BAR __builtin_amdgcn_s_barrier()
#define PG8_SCHED __builtin_amdgcn_sched_barrier(0)
    Unit cur, nxt; int ui = 0;
    if (!S.next(0, cur)) return;
    f32x4 acc[2][2][4][2];
#pragma unroll
    for (int a = 0; a < 2; ++a)
#pragma unroll
        for (int b = 0; b < 2; ++b)
#pragma unroll
            for (int m = 0; m < 4; ++m)
#pragma unroll
                for (int n = 0; n < 2; ++n) acc[a][b][m][n] = (f32x4){0.f, 0.f, 0.f, 0.f};
    bf16x8 At[4][2], B0[2][2], B1[2][2];
    const char* cA = (const char*)g.A + (size_t)cur.pm * tstep; const char* cB = (const char*)g.Bt + (size_t)cur.pn * tstep;
    S.a_ready(cur);
    if constexpr (SP2) {
        PG8_STAGE(PG8_SB(0, 0), cB, voffB); PG8_STAGE(PG8_SB(0, 1), cB + hstep, voffB); PG8_STAGE(PG8_SA(0, 0), cA, voffA); PG8_STAGE(PG8_SA(0, 1), cA + hstep, voffA);
        if (wr == 1) PG8_BAR;
        PG8_WAIT_V(2); PG8_BAR;
        PG8_STAGE(PG8_SB(1, 0), cB + kstep, voffB); PG8_STAGE(PG8_SA(1, 0), cA + kstep, voffA); PG8_STAGE(PG8_SB(1, 1), cB + hstep + kstep, voffB);
        PG8_WAIT_V(6); PG8_BAR;
    } else {
        PG8_STAGE(PG8_SB(0, 0), cB, voffB); PG8_STAGE(PG8_SA(0, 0), cA, voffA); PG8_STAGE(PG8_SB(0, 1), cB + hstep, voffB); PG8_STAGE(PG8_SA(0, 1), cA + hstep, voffA);
        if (wr == 1) PG8_BAR;
        PG8_WAIT_V(4); PG8_BAR;
        PG8_STAGE(PG8_SB(1, 0), cB + kstep, voffB); PG8_STAGE(PG8_SA(1, 0), cA + kstep, voffA); PG8_STAGE(PG8_SB(1, 1), cB + hstep + kstep, voffB);
        PG8_WAIT_V(6); PG8_BAR;
    }
    for (;;) {
        const bool has_next = S.next(ui + 1, nxt);
        const char* nA = has_next ? (const char*)g.A + (size_t)nxt.pm * tstep : cA; const char* nB = has_next ? (const char*)g.Bt + (size_t)nxt.pn * tstep : cB;
#pragma unroll 1
        for (int t = 0; t < nt; t += 2) {
            if constexpr (FP8) asm volatile("" : "+v"(voffA[0]), "+v"(voffA[1]), "+v"(voffB[0]), "+v"(voffB[1]));
            const bool last = (t == nt - 2);
            const char* a1 = cA + (size_t)(t + 1) * kstep;
            const char* a2 = last ? nA : cA + (size_t)(t + 2) * kstep; const char* b2 = last ? nB : cB + (size_t)(t + 2) * kstep;
            const char* a3 = a2 + kstep; const char* b3 = b2 + kstep;
            if (last && has_next) S.a_ready(nxt);
            if constexpr (SP2) {
            PG8_LDB(B0, 0, 0); PG8_LDB(B1, 0, 1); PG8_SCHED; PG8_LDA(At, 0, 0); PG8_STAGE(PG8_SA(1, 1), a1 + hstep, voffA);
            PG8_WAIT_V(8); PG8_WAIT_L(0); PG8_BAR; PG8_MMA(0, 0, At, B0); PG8_MMA(0, 1, At, B1); PG8_BAR; PG8_SCHED;
            PG8_LDA(At, 0, 1); PG8_STAGE(PG8_SB(0, 0), b2, voffB); PG8_STAGE(PG8_SB(0, 1), b2 + hstep, voffB); PG8_STAGE(PG8_SA(0, 0), a2, voffA);
            PG8_WAIT_V(8); PG8_WAIT_L(0); PG8_BAR; PG8_MMA(1, 0, At, B0); PG8_MMA(1, 1, At, B1); PG8_BAR; PG8_SCHED;
            PG8_LDB(B0, 1, 0); PG8_LDB(B1, 1, 1); PG8_SCHED; PG8_LDA(At, 1, 0); PG8_STAGE(PG8_SA(0, 1), a2 + hstep, voffA);
            PG8_WAIT_V(8); PG8_WAIT_L(0); PG8_BAR; PG8_MMA(0, 0, At, B0); PG8_MMA(0, 1, At, B1); PG8_BAR; PG8_SCHED;
            PG8_LDA(At, 1, 1); PG8_STAGE(PG8_SB(1, 0), b3, voffB); PG8_STAGE(PG8_SB(1, 1), b3 + hstep, voffB); PG8_STAGE(PG8_SA(1, 0), a3, voffA);
            PG8_WAIT_V(8); PG8_WAIT_L(0); PG8_BAR; PG8_MMA(1, 0, At, B0); PG8_MMA(1, 1, At, B1); PG8_BAR; PG8_SCHED;
            } else {
            PG8_LDB(B0, 0, 0); PG8_SCHED; PG8_LDA(At, 0, 0); PG8_STAGE(PG8_SA(1, 1), a1 + hstep, voffA);
            PG8_WAIT_L(8); PG8_BAR; PG8_WAIT_L(0); PG8_MMA(0, 0, At, B0); PG8_BAR; PG8_SCHED;
            PG8_LDB(B1, 0, 1); PG8_STAGE(PG8_SB(0, 0), b2, voffB);
            PG8_BAR; PG8_WAIT_L(0); PG8_MMA(0, 1, At, B1); PG8_BAR;
            PG8_LDA(At, 0, 1); PG8_STAGE(PG8_SA(0, 0), a2, voffA);
            PG8_BAR; PG8_WAIT_L(0); PG8_MMA(1, 0, At, B0); PG8_BAR; PG8_SCHED;
            PG8_STAGE(PG8_SB(0, 1), b2 + hstep, voffB);
            PG8_WAIT_V(6); PG8_BAR; PG8_MMA(1, 1, At, B1); PG8_BAR;
            PG8_LDB(B0, 1, 0); PG8_SCHED; PG8_LDA(At, 1, 0); PG8_STAGE(PG8_SA(0, 1), a2 + hstep, voffA);
            PG8_WAIT_L(8); PG8_BAR; PG8_WAIT_L(0); PG8_MMA(0, 0, At, B0); PG8_BAR; PG8_SCHED;
            PG8_LDB(B1, 1, 1); PG8_STAGE(PG8_SB(1, 0), b3, voffB);
            PG8_BAR; PG8_WAIT_L(0); PG8_MMA(0, 1, At, B1); PG8_BAR;
            PG8_LDA(At, 1, 1); PG8_STAGE(PG8_SA(1, 0), a3, voffA);
            PG8_BAR; PG8_WAIT_L(0); PG8_MMA(1, 0, At, B0); PG8_BAR; PG8_SCHED;
            PG8_STAGE(PG8_SB(1, 1), b3 + hstep, voffB);
            PG8_WAIT_V(6); PG8_BAR; PG8_MMA(1, 1, At, B1); PG8_BAR;
            }
        }
        if constexpr (ALIGN_EPI) { if (wr == 0) PG8_BAR; }
        if constexpr (FP8) asm volatile("s_nop 15\n\ts_nop 15" ::: "memory");
        if constexpr (!Epi::AFTER_DRAIN) { const int l2_ = lane_opaque(); E(acc, cur, wr, wc, l2_ & 15, l2_ >> 4); S.done(cur); }
        if (!has_next) break;
#pragma unroll
        for (int a = 0; a < 2; ++a)
#pragma unroll
            for (int b = 0; b < 2; ++b)
#pragma unroll
                for (int m = 0; m < 4; ++m)
#pragma unroll
                    for (int n = 0; n < 2; ++n) acc[a][b][m][n] = (f32x4){0.f, 0.f, 0.f, 0.f};
        cur = nxt; cA = nA; cB = nB; ++ui;
        if constexpr (ALIGN_EPI) { if (wr == 1) PG8_BAR; }
    }
    PG8_WAIT_V(0);
    if constexpr (!ALIGN_EPI) { if (wr == 0) PG8_BAR; }
    PG8_BAR;
    if constexpr (Epi::AFTER_DRAIN) { E.fused(acc, cur, wr, wc, fr, fq, lds, wid, lane); S.done(cur); }
#undef PG8_SA
#undef PG8_SB
#undef PG8_STAGE
#undef PG8_LDA
#undef PG8_LDB
#undef PG8_MMA
#undef PG8_WAIT_V
#undef PG8_WAIT_L
#undef PG8_BAR
#undef PG8_SCHED
}
}

__device__ __forceinline__ float wave_sum(float v) {
    const int l = lane_opaque();
#pragma unroll
    for (int o = 1; o < 64; o <<= 1) v += __builtin_bit_cast(float, __builtin_amdgcn_ds_bpermute((l ^ o) << 2, __builtin_bit_cast(int, v)));
    return v;
}
__device__ __forceinline__ float wave_max(float v) {
    const int l = lane_opaque();
#pragma unroll
    for (int o = 1; o < 64; o <<= 1) v = fmaxf(v, __builtin_bit_cast(float, __builtin_amdgcn_ds_bpermute((l ^ o) << 2, __builtin_bit_cast(int, v))));
    return v;
}
__device__ __forceinline__ float silu_f(float v) { return v / (1.f + __expf(-v)); }

struct Args {
    const float* x; const float* c; const float* rel_bias; const float* ada_w; const float* ada_b; const float* norm_g;
    const float* moba_w_qkv; const float* moba_w_o; const float* diff_w_qkv; const float* diff_w_o;
    const float* diff_lambda; const float* diff_subln_g; const float* ffn_w_in; const float* ffn_w_out;
    float* out; unsigned char* ws;
};

__device__ __forceinline__ int t5_bucket(int rel) {
    const int n = rel < 0 ? 0 : rel;
    const float nf = (float)(n < 1 ? 1 : n);
    int large = 16 + (int)(logf(nf / 16.0f) / 4.852030263919617f * 16.0f);
    large = large < 31 ? large : 31;
    return n < 16 ? n : large;
}

__device__ __forceinline__ void p_mod(const Args& a, LAS unsigned char* lds, int blk, int G, int tid, int wave, int lane) {
    LAS float* sc = (LAS float*)lds;
    LAS float* red = sc + 2048;
    for (int i = tid; i < 2048; i += NTHR) sc[i] = silu_f(a.c[i]);
    __syncthreads();
    float* mod = (float*)(a.ws + WS_MOD);
    for (int it = blk; it < 192; it += G) {
        const int l = it / 96, j0 = (it % 96) * 64;
        const float* w = a.ada_w + (size_t)l * D * 6144 + j0 + lane;
        float s0 = 0.f, s1 = 0.f;
#pragma unroll 1
        for (int kb = wave * 128; kb < wave * 128 + 128; kb += 32) { float wv[32];
#pragma unroll
            for (int k = 0; k < 32; ++k) wv[k] = w[(size_t)(kb + k) * 6144];
#pragma unroll
            for (int k = 0; k < 32; ++k) { s0 += sc[kb + k] * wv[k]; s1 += sc[1024 + kb + k] * wv[k]; } }
        red[(wave * 2 + 0) * 64 + lane] = s0; red[(wave * 2 + 1) * 64 + lane] = s1;
        __syncthreads();
        if (tid < 128) { const int bb = tid >> 6, cl = tid & 63; float sum = 0.f;
#pragma unroll
            for (int w8 = 0; w8 < 8; ++w8) sum += red[(w8 * 2 + bb) * 64 + cl];
            mod[(l * 2 + bb) * 6144 + j0 + cl] = sum + a.ada_b[l * 6144 + j0 + cl]; }
        __syncthreads();
    }
    float* bt = (float*)(a.ws + WS_BIAST);
    for (int i = blk * NTHR + tid; i < 8 * 2304; i += G * NTHR) { const int h = i / 2304, rel = 2047 - (i % 2304); bt[i] = rel >= 0 ? a.rel_bias[t5_bucket(rel) * NH + h] * LOG2E : 0.f; }
}

__device__ __forceinline__ void transpose_item(const float* W, int K, int N, int k0, int n0, bf16* WT, int dst_row0, LAS float* scr, int lane) {
    float tv[32];
#pragma unroll
    for (int i = 0; i < 32; ++i) tv[i] = W[(size_t)(k0 + 2 * i + (lane >> 5)) * N + n0 + (lane & 31)];
#pragma unroll
    for (int i = 0; i < 32; ++i) scr[(2 * i + (lane >> 5)) * 33 + (lane & 31)] = tv[i];
    asm volatile("s_waitcnt lgkmcnt(0)" ::: "memory");
    const int c = lane & 7;
#pragma unroll
    for (int j = 0; j < 4; ++j) { const int n = (lane >> 3) + 8 * j; const LAS float* sp = scr + (8 * c) * 33 + n;
        u32x4 o; o.x = pk2(sp[0 * 33], sp[1 * 33]); o.y = pk2(sp[2 * 33], sp[3 * 33]); o.z = pk2(sp[4 * 33], sp[5 * 33]); o.w = pk2(sp[6 * 33], sp[7 * 33]);
        *(u32x4*)(WT + (size_t)(dst_row0 + n) * K + k0 + 8 * c) = o; }
    asm volatile("s_waitcnt lgkmcnt(0)" ::: "memory");
}
constexpr float F8_SH = 8.0f;
constexpr float F8_SA = 4.0f, F8_SB = 256.0f;
__device__ __forceinline__ unsigned pk4_fp8(float a, float b, float c, float d) {
    a = fminf(fmaxf(a, -448.f), 448.f); b = fminf(fmaxf(b, -448.f), 448.f); c = fminf(fmaxf(c, -448.f), 448.f); d = fminf(fmaxf(d, -448.f), 448.f);
    int w = __builtin_amdgcn_cvt_pk_fp8_f32(a, b, 0, false); w = __builtin_amdgcn_cvt_pk_fp8_f32(c, d, w, true); return (unsigned)w;
}
__device__ __forceinline__ void transpose_item_fp8(const float* W, int K, int N, int k0, int n0, unsigned char* WT, int dst_row0, LAS float* scr, int lane) {
    float tv[32];
#pragma unroll
    for (int i = 0; i < 32; ++i) tv[i] = W[(size_t)(k0 + 2 * i + (lane >> 5)) * N + n0 + (lane & 31)];
#pragma unroll
    for (int i = 0; i < 32; ++i) scr[(2 * i + (lane >> 5)) * 33 + (lane & 31)] = tv[i];
    asm volatile("s_waitcnt lgkmcnt(0)" ::: "memory");
#pragma unroll
    for (int j = 0; j < 2; ++j) { const int ch = lane + 64 * j, n = ch >> 2, c = ch & 3; const LAS float* sp = scr + (16 * c) * 33 + n;
        u32x4 o;
        o.x = pk4_fp8(sp[0 * 33] * F8_SB, sp[1 * 33] * F8_SB, sp[2 * 33] * F8_SB, sp[3 * 33] * F8_SB);
        o.y = pk4_fp8(sp[4 * 33] * F8_SB, sp[5 * 33] * F8_SB, sp[6 * 33] * F8_SB, sp[7 * 33] * F8_SB);
        o.z = pk4_fp8(sp[8 * 33] * F8_SB, sp[9 * 33] * F8_SB, sp[10 * 33] * F8_SB, sp[11 * 33] * F8_SB);
        o.w = pk4_fp8(sp[12 * 33] * F8_SB, sp[13 * 33] * F8_SB, sp[14 * 33] * F8_SB, sp[15 * 33] * F8_SB);
        *(u32x4*)(WT + (size_t)(dst_row0 + n) * K + k0 + 16 * c) = o; }
    asm volatile("s_waitcnt lgkmcnt(0)" ::: "memory");
}
__device__ __forceinline__ void p_weights(const Args& a, LAS unsigned char* lds, int gw, int ngw, int wave, int lane) {
    LAS float* scr = (LAS float*)(lds + wave * 16384);
    constexpr int I_QKV = (D / 64) * (3 * D / 32), I_O = (D / 64) * (D / 32), I_IN = (D / 64) * (2 * DFF / 32), I_OUT = (DFF / 64) * (D / 32);
    constexpr int PER_L = I_QKV + I_O + I_IN + I_OUT;
    for (int it = gw; it < 2 * PER_L; it += ngw) {
        const int l = it / PER_L; int r = it % PER_L;
        unsigned char* wl = a.ws + WS_W + (size_t)l * WL_STRIDE;
        if (r < I_QKV) { const int nb = 3 * D / 32, kb = r / nb, n0 = (r % nb) * 32; transpose_item(l == 0 ? a.moba_w_qkv : a.diff_w_qkv, D, 3 * D, kb * 64, n0, (bf16*)(wl + WO_QKV), n0, scr, lane); continue; } r -= I_QKV;
        if (r < I_O) continue; r -= I_O;
        if (r < I_IN) { const int nb = 2 * DFF / 32, kb = r / nb, n0 = (r % nb) * 32;
            const int isu = n0 >= DFF ? 1 : 0, nn = n0 - isu * DFF, dst = 256 * (nn / 128) + 128 * isu + (nn % 128);
            transpose_item_fp8(a.ffn_w_in + (size_t)l * D * 2 * DFF, D, 2 * DFF, kb * 64, n0, wl + WO_IN, dst, scr, lane); continue; } r -= I_IN;
        { const int nb = D / 32, kb = r / nb, n0 = (r % nb) * 32; transpose_item_fp8(a.ffn_w_out + (size_t)l * DFF * D, DFF, D, kb * 64, n0, wl + WO_OUT, n0, scr, lane); }
    }
}

__device__ __forceinline__ void p_wo_perm(const Args& a, int gtid, int gthreads) {
    for (int idx = gtid; idx < 2 * 128 * D; idx += gthreads) {
        const int l = idx / (128 * D), rem = idx % (128 * D), c = rem / D, n = rem % D;
        const float* W = l == 0 ? a.moba_w_o : a.diff_w_o;
        float v[8];
#pragma unroll
        for (int e = 0; e < 8; ++e) { const int kp = 8 * c + e, hh = kp >> 7, wi = kp & 127, k = hh * 128 + (wi & 3) * 32 + (wi >> 2); v[e] = W[(size_t)k * D + n]; }
        u32x4 o; o.x = pk2(v[0], v[1]); o.y = pk2(v[2], v[3]); o.z = pk2(v[4], v[5]); o.w = pk2(v[6], v[7]);
        *(u32x4*)((bf16*)(a.ws + WS_W + (size_t)l * WL_STRIDE + WO_O) + (size_t)n * D + 8 * c) = o;
    }
}

__device__ __forceinline__ void p_norm_in(const float* X, const float* g, const float* sh, const float* sc, bf16* H, int gw, int ngw, int lane) {
    for (int m = gw; m < M; m += ngw) {
        const int b = m / SEQ;
        const f32x4* xr = (const f32x4*)(X + (size_t)m * D) + lane;
        f32x4 v[4]; float s = 0.f;
#pragma unroll
        for (int j = 0; j < 4; ++j) { v[j] = xr[64 * j]; s += (v[j].x * v[j].x + v[j].y * v[j].y) + (v[j].z * v[j].z + v[j].w * v[j].w); }
        const float r = 1.0f / sqrtf(wave_sum(s) * (1.f / D) + RMS_EPS);
        u32x2* o = (u32x2*)(H + (size_t)m * D) + lane;
#pragma unroll
        for (int j = 0; j < 4; ++j) {
            const f32x4 gg = ((const f32x4*)g)[lane + 64 * j], s1 = ((const f32x4*)(sc + b * 6144))[lane + 64 * j], s0 = ((const f32x4*)(sh + b * 6144))[lane + 64 * j];
            const f32x4 h = v[j] * r * gg * (1.0f + s1) + s0;
            u32x2 w; w.x = pk2(h.x, h.y); w.y = pk2(h.z, h.w); o[64 * j] = w;
        }
    }
}
template <bool XIN_BF, bool XOUT_BF, bool H_FP8>
__device__ __forceinline__ void p_post(const void* Xin, const bf16* Y, const float* g1, const float* gate, void* Xout,
                                       const float* g2, const float* sh, const float* sc, bf16* H, int gw, int ngw, int lane) {
    for (int m = gw; m < M; m += ngw) {
        const int b = m / SEQ;
        const u32x2* yr = (const u32x2*)(Y + (size_t)m * D) + lane;
        f32x4 y[4], xv[4]; float s = 0.f;
#pragma unroll
        for (int j = 0; j < 4; ++j) { const u32x2 w = yr[64 * j]; y[j] = (f32x4){bflo(w.x), bfhi(w.x), bflo(w.y), bfhi(w.y)};
            if (XIN_BF) { const u32x2 xw = ((const u32x2*)((const bf16*)Xin + (size_t)m * D))[lane + 64 * j]; xv[j] = (f32x4){bflo(xw.x), bfhi(xw.x), bflo(xw.y), bfhi(xw.y)}; }
            else xv[j] = ((const f32x4*)((const float*)Xin + (size_t)m * D))[lane + 64 * j];
            s += (y[j].x * y[j].x + y[j].y * y[j].y) + (y[j].z * y[j].z + y[j].w * y[j].w); }
        const float r = 1.0f / sqrtf(wave_sum(s) * (1.f / D) + RMS_EPS);
        float s2 = 0.f;
#pragma unroll
        for (int j = 0; j < 4; ++j) {
            const f32x4 gg = ((const f32x4*)g1)[lane + 64 * j], gt = ((const f32x4*)(gate + b * 6144))[lane + 64 * j];
            xv[j] = xv[j] + gt * (y[j] * r * gg);
            s2 += (xv[j].x * xv[j].x + xv[j].y * xv[j].y) + (xv[j].z * xv[j].z + xv[j].w * xv[j].w);
            if (XOUT_BF) { u32x2 w; w.x = pk2(xv[j].x, xv[j].y); w.y = pk2(xv[j].z, xv[j].w); ((u32x2*)((bf16*)Xout + (size_t)m * D))[lane + 64 * j] = w; }
            else ((f32x4*)((float*)Xout + (size_t)m * D))[lane + 64 * j] = xv[j];
        }
        if (H) {
            const float r2 = 1.0f / sqrtf(wave_sum(s2) * (1.f / D) + RMS_EPS);
            u32x2* o = (u32x2*)(H + (size_t)m * D) + lane;
#pragma unroll
            for (int j = 0; j < 4; ++j) {
                const f32x4 gg = ((const f32x4*)g2)[lane + 64 * j], s1 = ((const f32x4*)(sc + b * 6144))[lane + 64 * j], s0 = ((const f32x4*)(sh + b * 6144))[lane + 64 * j];
                const f32x4 h = xv[j] * r2 * gg * (1.0f + s1) + s0;
                if (H_FP8) ((unsigned*)((unsigned char*)H + (size_t)m * D))[lane + 64 * j] = pk4_fp8(h.x * F8_SA, h.y * F8_SA, h.z * F8_SA, h.w * F8_SA);
                else { u32x2 w; w.x = pk2(h.x, h.y); w.y = pk2(h.z, h.w); o[64 * j] = w; }
            }
        }
    }
}

__device__ __forceinline__ void p_kmean(const bf16* Kb, float* kmean, LAS unsigned char* lds, int blk, int G, int tid, int wave, int lane) {
    LAS float* red = (LAS float*)lds;
    for (int it = blk; it < BATCH * NH * 32; it += G) {
        const int b = it >> 8, h = (it >> 5) & 7, kb = it & 31;
        const bf16* p = Kb + ((size_t)b * SEQ + kb * 256 + wave * 32) * D + h * HD + 2 * lane;
        float s0 = 0.f, s1 = 0.f;
#pragma unroll 8
        for (int r = 0; r < 32; ++r) { const unsigned w = *(const unsigned*)(p + (size_t)r * D); s0 += bflo(w); s1 += bfhi(w); }
        red[wave * 128 + 2 * lane] = s0; red[wave * 128 + 2 * lane + 1] = s1;
        __syncthreads();
        if (tid < 128) { float sum = 0.f;
#pragma unroll
            for (int w8 = 0; w8 < 8; ++w8) sum += red[w8 * 128 + tid];
            kmean[(size_t)it * 128 + tid] = sum * (1.0f / 256.0f); }
        __syncthreads();
    }
}
__device__ __forceinline__ void p_gate(const bf16* Qb, const float* kmean, unsigned* sel, unsigned* cnt, unsigned short* lists, LAS unsigned char* lds, int blk, int G, int tid, int wave, int lane) {
    LAS float* km = (LAS float*)lds;
    for (int it = blk; it < 256; it += G) {
        const int bh = it >> 4, span = it & 15, b = bh >> 3, h = bh & 7;
        __syncthreads();
        for (int i = tid; i < 1024; i += NTHR) ((LAS f32x4*)km)[i] = ((const f32x4*)(kmean + (size_t)bh * 4096))[i];
        __syncthreads();
        const int q = span * 512 + wave * 64 + lane, own = (span * 512 + wave * 64) >> 8;
        unsigned mask;
        if (own <= 3) mask = (1u << own) - 1u;
        else {
            float qf[128];
            const u32x4* qp = (const u32x4*)(Qb + ((size_t)b * SEQ + q) * D + h * HD);
#pragma unroll
            for (int c = 0; c < 16; ++c) { const u32x4 w = qp[c]; qf[c * 8 + 0] = bflo(w.x); qf[c * 8 + 1] = bfhi(w.x); qf[c * 8 + 2] = bflo(w.y); qf[c * 8 + 3] = bfhi(w.y);
                qf[c * 8 + 4] = bflo(w.z); qf[c * 8 + 5] = bfhi(w.z); qf[c * 8 + 6] = bflo(w.w); qf[c * 8 + 7] = bfhi(w.w); }
            float b0 = -3e38f, b1 = -3e38f, b2 = -3e38f; int i0 = 0, i1 = 0, i2 = 0;
#pragma unroll 1
            for (int n = 0; n < own; ++n) {
                float g0 = 0.f, g1 = 0.f, g2 = 0.f, g3 = 0.f;
#pragma unroll
                for (int d = 0; d < 128; d += 4) { const f32x4 kv = *(LAS f32x4*)(km + n * 128 + d); g0 += qf[d] * kv.x; g1 += qf[d + 1] * kv.y; g2 += qf[d + 2] * kv.z; g3 += qf[d + 3] * kv.w; }
                const float g = (g0 + g1) + (g2 + g3);
                if (g > b0) { b2 = b1; i2 = i1; b1 = b0; i1 = i0; b0 = g; i0 = n; }
                else if (g > b1) { b2 = b1; i2 = i1; b1 = g; i1 = n; }
                else if (g > b2) { b2 = g; i2 = n; }
            }
            mask = (1u << i0) | (1u << i1) | (1u << i2);
        }
        sel[(size_t)bh * SEQ + q] = mask;
        unsigned mycnt = 0u;
        for (int j = 0; j < own; ++j) { const unsigned long long bl = __ballot((mask >> j) & 1u); if (lane == j) mycnt = (unsigned)__popcll(bl); }
        unsigned base = 0u;
        if (lane < own && mycnt) base = __hip_atomic_fetch_add(cnt + bh * 32 + lane, mycnt, __ATOMIC_RELAXED, __HIP_MEMORY_SCOPE_AGENT);
        for (int j = 0; j < own; ++j) { const unsigned long long bl = __ballot((mask >> j) & 1u); const unsigned bj = (unsigned)__builtin_amdgcn_readlane((int)base, j);
            if ((mask >> j) & 1u) lists[((size_t)bh * 32 + j) * 8192 + bj + (unsigned)__popcll(bl & ((1ull << lane) - 1ull))] = (unsigned short)q; }
    }
}

namespace att {
typedef short bf16x8 __attribute__((ext_vector_type(8)));
typedef short s16x4 __attribute__((ext_vector_type(4)));
typedef float f32x16 __attribute__((ext_vector_type(16)));
typedef LAS const char* lcp;
constexpr int PITCH = 1024;
constexpr int SHM_V = 16384, SHM_K = 16384;
constexpr int L_K = 0, L_V = 65536, L_WS = 131072, L_LUT = 133120;
constexpr int LUTN = 2304, RMAXL = 2047, RFAR = 1536;
#define KSWZ(row, colB) ((row) * 256 + ((colB) ^ (((row) & 7) << 4)))
#define SBAR() __builtin_amdgcn_sched_barrier(0)
#define WG_BAR() do { asm volatile("s_waitcnt lgkmcnt(0)" ::: "memory"); __builtin_amdgcn_s_barrier(); asm volatile("" ::: "memory"); } while (0)
__device__ __forceinline__ int v_st(int k, int c) { const int kk = (k & ~0xC) | ((k & 4) << 1) | ((k & 8) >> 1); return ((kk >> 3) * 4 + (c >> 5)) * 512 + ((kk & 7) * 32 + (c & 31)) * 2; }
__device__ __forceinline__ int v_rd_base(int lane) { return ((lane & 3) << 3) | (((lane >> 2) & 3) << 6) | (((lane >> 4) & 1) << 5) | (((lane >> 5) & 1) << 8); }
constexpr int v_rd_off(int d0, int ks, int half) { return d0 * 512 + ks * 4096 + half * 2048; }
__device__ __forceinline__ int crow(int r, int hi) { return (r & 3) + 8 * (r >> 2) + 4 * hi; }
__device__ __forceinline__ unsigned cvtpk(float lo, float hi) { unsigned r; asm volatile("v_cvt_pk_bf16_f32 %0, %1, %2" : "=v"(r) : "v"(lo), "v"(hi)); return r; }

template <int KB, int NDS>
__device__ __forceinline__ void qkt(f32x16& p0, f32x16& p1, lcp K_lds, int r32, int hi, int coff, const bf16x8* qr) {
    lcp kb[4];
#pragma unroll
    for (int dd = 0; dd < 4; ++dd) kb[dd] = K_lds + KB * SHM_K + KSWZ(r32, (dd * 16 + hi * 8) * 2) + coff;
#pragma unroll
    for (int d0 = 0; d0 < NDS; ++d0) { lcp a = kb[d0 & 3] + (d0 >> 2) * 128;
        const bf16x8 b0 = *(LAS const bf16x8*)a;
        const bf16x8 b1 = *(LAS const bf16x8*)(a + 32 * 256);
        p0 = __builtin_amdgcn_mfma_f32_32x32x16_bf16(b0, qr[d0], p0, 0, 0, 0);
        p1 = __builtin_amdgcn_mfma_f32_32x32x16_bf16(b1, qr[d0], p1, 0, 0, 0);
        if (NDS == 8 && (d0 & 1) == 1) SBAR(); }
}
template <int VB>
__device__ __forceinline__ void pv_tile(f32x16* o, int vb0, bf16x8 pa0, bf16x8 pa1, bf16x8 pa2, bf16x8 pa3) {
#define TRRD(dst, off) asm volatile("ds_read_b64_tr_b16 %0, %1 offset:%2" : "=&v"(dst) : "v"(vb0), "i"(off) : "memory")
#define PV_D0(d0) do { s16x4 l0, l1, l2, l3, h0, h1, h2, h3; constexpr int b_ = VB * SHM_V + v_rd_off(d0, 0, 0); \
        TRRD(l0, b_); TRRD(h0, b_ + 2048); TRRD(l1, b_ + 4096); TRRD(h1, b_ + 6144); TRRD(l2, b_ + 8192); TRRD(h2, b_ + 10240); TRRD(l3, b_ + 12288); TRRD(h3, b_ + 14336); \
        asm volatile("s_waitcnt lgkmcnt(0)" ::: "memory"); SBAR(); \
        o[d0] = __builtin_amdgcn_mfma_f32_32x32x16_bf16(pa0, (bf16x8){l0[0], l0[1], l0[2], l0[3], h0[0], h0[1], h0[2], h0[3]}, o[d0], 0, 0, 0); \
        o[d0] = __builtin_amdgcn_mfma_f32_32x32x16_bf16(pa1, (bf16x8){l1[0], l1[1], l1[2], l1[3], h1[0], h1[1], h1[2], h1[3]}, o[d0], 0, 0, 0); \
        o[d0] = __builtin_amdgcn_mfma_f32_32x32x16_bf16(pa2, (bf16x8){l2[0], l2[1], l2[2], l2[3], h2[0], h2[1], h2[2], h2[3]}, o[d0], 0, 0, 0); \
        o[d0] = __builtin_amdgcn_mfma_f32_32x32x16_bf16(pa3, (bf16x8){l3[0], l3[1], l3[2], l3[3], h3[0], h3[1], h3[2], h3[3]}, o[d0], 0, 0, 0); } while (0)
    PV_D0(0); PV_D0(1); PV_D0(2); PV_D0(3);
#undef PV_D0
#undef TRRD
}

template <int NDS>
__device__ __forceinline__ void kread(bf16x8* kf, int kaddr_base, int r32, int hi, int coff) {
#pragma unroll
    for (int d0 = 0; d0 < NDS; ++d0) { const int a = kaddr_base + KSWZ(r32, ((d0 & 3) * 16 + hi * 8) * 2) + coff + (d0 >> 2) * 128;
        asm volatile("ds_read_b128 %0, %1" : "=&v"(kf[2 * d0]) : "v"(a) : "memory");
        asm volatile("ds_read_b128 %0, %1 offset:8192" : "=&v"(kf[2 * d0 + 1]) : "v"(a) : "memory"); }
}
template <int NDS>
__device__ __forceinline__ void kmma(f32x16& p0, f32x16& p1, const bf16x8* kf, const bf16x8* qr) {
#pragma unroll
    for (int d0 = 0; d0 < NDS; ++d0) { p0 = __builtin_amdgcn_mfma_f32_32x32x16_bf16(kf[2 * d0], qr[d0], p0, 0, 0, 0); p1 = __builtin_amdgcn_mfma_f32_32x32x16_bf16(kf[2 * d0 + 1], qr[d0], p1, 0, 0, 0); }
}

__device__ __forceinline__ void pv_tile_pf(f32x16* o, int vb0, bf16x8 pa0, bf16x8 pa1, bf16x8 pa2, bf16x8 pa3) {
#define TRRD(dst, off) asm volatile("ds_read_b64_tr_b16 %0, %1 offset:%2" : "=&v"(dst) : "v"(vb0), "i"(off) : "memory")
#define RD8(S, d0) do { constexpr int b_ = v_rd_off(d0, 0, 0); TRRD(S[0], b_); TRRD(S[1], b_ + 2048); TRRD(S[2], b_ + 4096); TRRD(S[3], b_ + 6144); \
        TRRD(S[4], b_ + 8192); TRRD(S[5], b_ + 10240); TRRD(S[6], b_ + 12288); TRRD(S[7], b_ + 14336); } while (0)
#define MMA4(d0, S) do { \
        o[d0] = __builtin_amdgcn_mfma_f32_32x32x16_bf16(pa0, (bf16x8){S[0][0], S[0][1], S[0][2], S[0][3], S[1][0], S[1][1], S[1][2], S[1][3]}, o[d0], 0, 0, 0); \
        o[d0] = __builtin_amdgcn_mfma_f32_32x32x16_bf16(pa1, (bf16x8){S[2][0], S[2][1], S[2][2], S[2][3], S[3][0], S[3][1], S[3][2], S[3][3]}, o[d0], 0, 0, 0); \
        o[d0] = __builtin_amdgcn_mfma_f32_32x32x16_bf16(pa2, (bf16x8){S[4][0], S[4][1], S[4][2], S[4][3], S[5][0], S[5][1], S[5][2], S[5][3]}, o[d0], 0, 0, 0); \
        o[d0] = __builtin_amdgcn_mfma_f32_32x32x16_bf16(pa3, (bf16x8){S[6][0], S[6][1], S[6][2], S[6][3], S[7][0], S[7][1], S[7][2], S[7][3]}, o[d0], 0, 0, 0); } while (0)
    s16x4 sa[8], sb[8];
    RD8(sa, 0); RD8(sb, 1);
    asm volatile("s_waitcnt lgkmcnt(8)" ::: "memory"); SBAR(); MMA4(0, sa); SBAR();
    RD8(sa, 2);
    asm volatile("s_waitcnt lgkmcnt(8)" ::: "memory"); SBAR(); MMA4(1, sb); SBAR();
    RD8(sb, 3);
    asm volatile("s_waitcnt lgkmcnt(8)" ::: "memory"); SBAR(); MMA4(2, sa); SBAR();
    asm volatile("s_waitcnt lgkmcnt(0)" ::: "memory"); SBAR(); MMA4(3, sb);
#undef MMA4
#undef RD8
#undef TRRD
}
constexpr float THR2 = 8.0f;
__device__ __forceinline__ void partial_sm(f32x16& p0, f32x16& p1, float sh, float& m_reg, float& alpha) {
    float pmax = p0[0];
#pragma unroll
    for (int r = 1; r < 16; ++r) pmax = fmaxf(pmax, p0[r]);
#pragma unroll
    for (int r = 0; r < 16; ++r) pmax = fmaxf(pmax, p1[r]);
    { auto rr = __builtin_amdgcn_permlane32_swap(__float_as_uint(pmax), __float_as_uint(pmax), false, false);
      pmax = fmaxf(__uint_as_float(rr[0]), __uint_as_float(rr[1])); }
    pmax += sh;
    float mn;
    if (__builtin_expect(__all((pmax - m_reg) <= THR2), 1)) { mn = m_reg; alpha = 1.f; }
    else { const bool upd = (pmax - m_reg) > THR2;
        mn = upd ? fmaxf(m_reg, pmax) : m_reg; alpha = upd ? __builtin_amdgcn_exp2f(m_reg - mn) : 1.f; m_reg = mn; }
    const float off = mn - sh;
#pragma unroll
    for (int r = 0; r < 16; ++r) p0[r] = __builtin_amdgcn_exp2f(p0[r] - off);
#pragma unroll
    for (int r = 0; r < 16; ++r) p1[r] = p1[r] - off;
}
__device__ __forceinline__ void finish_sm(f32x16& p0, f32x16& p1, float alpha, float& l_reg, bf16x8& pa0, bf16x8& pa1, bf16x8& pa2, bf16x8& pa3) {
#pragma unroll
    for (int r = 0; r < 16; ++r) p1[r] = __builtin_amdgcn_exp2f(p1[r]);
    float ps = 0.f;
#pragma unroll
    for (int r = 0; r < 16; ++r) ps += p0[r];
#pragma unroll
    for (int r = 0; r < 16; ++r) ps += p1[r];
    { auto rr = __builtin_amdgcn_permlane32_swap(__float_as_uint(ps), __float_as_uint(ps), false, false);
      ps = __uint_as_float(rr[0]) + __uint_as_float(rr[1]); }
    l_reg = l_reg * alpha + ps;
#define PK4(P, B_, OUT) do { unsigned a0 = cvtpk(P[B_+0], P[B_+1]), a1 = cvtpk(P[B_+2], P[B_+3]); \
        unsigned b0 = cvtpk(P[B_+4], P[B_+5]), b1 = cvtpk(P[B_+6], P[B_+7]); \
        auto r0 = __builtin_amdgcn_permlane32_swap(a0, b0, false, false); auto r1 = __builtin_amdgcn_permlane32_swap(a1, b1, false, false); \
        u32x4 w = {r0[0], r1[0], r0[1], r1[1]}; OUT = __builtin_bit_cast(bf16x8, w); } while (0)
    PK4(p0, 0, pa0); PK4(p0, 8, pa1); PK4(p1, 0, pa2); PK4(p1, 8, pa3);
#undef PK4
}
__device__ __forceinline__ void softmax_tile(f32x16& p0, f32x16& p1, float sh, float& m_reg, float& l_reg, float& alpha, bf16x8& pa0, bf16x8& pa1, bf16x8& pa2, bf16x8& pa3) {
    partial_sm(p0, p1, sh, m_reg, alpha); finish_sm(p0, p1, alpha, l_reg, pa0, pa1, pa2, pa3);
}
__device__ __forceinline__ void add_bias_lut(f32x16& p0, f32x16& p1, LAS const float* lut, int dq) {
    LAS const float* bp = lut + (RMAXL - dq);
#pragma unroll
    for (int r = 0; r < 16; ++r) { const int c = (r & 3) + 8 * (r >> 2); p0[r] += bp[c]; p1[r] += bp[c + 32]; if ((r & 3) == 3) asm volatile("" ::: "memory"); }
}
__device__ __forceinline__ void load_bias_lut(f32x16& p0, f32x16& p1, LAS const float* lut, int dq) {
    LAS const float* bp = lut + (RMAXL - dq);
#pragma unroll
    for (int r = 0; r < 16; ++r) { const int c = (r & 3) + 8 * (r >> 2); p0[r] = bp[c]; p1[r] = bp[c + 32]; }
}
__device__ __forceinline__ void causal_mask(f32x16& p0, f32x16& p1, int dq) {
    const float NEG = -__builtin_inff();
#pragma unroll
    for (int r = 0; r < 16; ++r) { const int c = (r & 3) + 8 * (r >> 2); if (dq - c < 0) p0[r] = NEG; if (dq - c - 32 < 0) p1[r] = NEG; }
}
struct DmaOff { unsigned k[2], v[2]; };
__device__ __forceinline__ DmaOff dma_offsets(int wid, int lane) {
    DmaOff d;
#pragma unroll
    for (int i = 0; i < 2; ++i) { const int p = wid * 2 + i;
        { const int row = 4 * p + (lane >> 4), c = (lane & 15) ^ (row & 7); d.k[i] = (unsigned)(row * PITCH * 2 + c * 16); }
        { const int sub = 2 * p + (lane >> 5), kkhi = sub >> 2, cblk = sub & 3, kklo = (lane & 31) >> 2, kk = kkhi * 8 + kklo;
          const int k = (kk & ~0xC) | ((kk & 4) << 1) | ((kk & 8) >> 1), c = cblk * 32 + (lane & 3) * 8; d.v[i] = (unsigned)(k * PITCH * 2 + c * 2); } }
    return d;
}
__device__ __forceinline__ void dma_tile(LAS char* lds, int bf, const bf16* Kc, const bf16* Vc, int k0, const DmaOff& d, int wid) {
    const char* kt = (const char*)Kc + (size_t)k0 * (PITCH * 2); const char* vt = (const char*)Vc + (size_t)k0 * (PITCH * 2);
#pragma unroll
    for (int i = 0; i < 2; ++i) {
        __builtin_amdgcn_global_load_lds((const unsigned*)(kt + d.k[i]), (LAS unsigned*)(lds + L_K + bf * SHM_K + (wid * 2 + i) * 1024), 16, 0, 0);
        __builtin_amdgcn_global_load_lds((const unsigned*)(vt + d.v[i]), (LAS unsigned*)(lds + L_V + bf * SHM_V + (wid * 2 + i) * 1024), 16, 0, 0); }
}
constexpr int L_CF = 142336, L_TAB = 146432, L_FOUND = 148544;
__device__ __forceinline__ void build_lut(LAS char* lds, const float* biasT, int h, int tid) {
    LAS float* lut = (LAS float*)(lds + L_LUT);
    for (int i = tid; i < LUTN; i += 512) lut[i] = biasT[h * LUTN + i];
}

template <int VAR> __device__ __forceinline__ void diff_unit(LAS char* lds, int b, int h, int qb, const bf16* Q, const bf16* K, const bf16* V, bf16* O, const float* relb, const float* biasT,
                                          float lam_full, const float* subg, int tid, int wid, int lane) {
    asm volatile("" : "+v"(lane), "+v"(tid));
    const int r32 = lane & 31, hi = lane >> 5, cm = wid >> 2, w4 = wid & 3;
    const size_t rowbase = (size_t)b * SEQ;
    const int q0 = qb * 128, qw0 = q0 + w4 * 32, qpos = qw0 + r32;
    const bf16* Kc = K + rowbase * PITCH + h * HD; const bf16* Vc = V + rowbase * PITCH + h * HD;
    const int NT = (q0 + 128) / 64;
    const DmaOff dmo = dma_offsets(wid, lane);
    const int vb0 = (int)(unsigned)(uintptr_t)(lds + L_V) + v_rd_base(lane);
    LAS float* ws = (LAS float*)(lds + L_WS) + wid * 64;
    LAS const float* lut = (LAS const float*)(lds + L_LUT);
    lcp K_lds = (lcp)(lds + L_K);
    const float b31 = relb[31 * 8 + h] * 1.4426950408889634f;
    build_lut(lds, biasT, h, tid);
    bf16x8 qr[4];
#pragma unroll
    for (int d0 = 0; d0 < 4; ++d0) qr[d0] = *(const bf16x8*)(Q + (rowbase + qpos) * PITCH + h * HD + cm * 64 + d0 * 16 + hi * 8);
    dma_tile(lds, 0, Kc, Vc, 0, dmo, wid);
    dma_tile(lds, 1, Kc, Vc, 64, dmo, wid);
    asm volatile("s_waitcnt vmcnt(0)" ::: "memory");
    WG_BAR();
    float m_reg = -1e30f, l_reg = 0.f; f32x16 o[4] = {};
    f32x16 p0, p1; bf16x8 pa0, pa1, pa2, pa3;
    const bool halfB = cm != 0;
    const int kl0 = (int)(unsigned)(uintptr_t)(lds + L_K);
    if (halfB) WG_BAR();
    for (int t = 0; t < NT; ++t) {
        __builtin_amdgcn_s_setprio(2);
        if (VAR != 2 && VAR != 3 && VAR != 7 && VAR != 8) { bf16x8 kf[8];
            kread<4>(kf, kl0 + (t & 3) * SHM_K, r32, hi, cm * 128);
            if (qw0 - (t * 64 + 63) >= RFAR) { p0 = f32x16{}; p1 = f32x16{}; } else load_bias_lut(p0, p1, lut, qpos - t * 64 - 4 * hi);
            if (t > 0) pv_tile_pf(o, vb0 + ((t - 1) & 3) * SHM_V, pa0, pa1, pa2, pa3);
            asm volatile("s_waitcnt lgkmcnt(0)" ::: "memory"); SBAR();
            kmma<4>(p0, p1, kf, qr); } else { p0 = f32x16{}; p1 = f32x16{}; asm volatile("" : "+v"(p0), "+v"(p1)); }
        __builtin_amdgcn_s_setprio(0);
        if (halfB) asm volatile("s_waitcnt vmcnt(0)" ::: "memory");
        WG_BAR();
        const bool issue = VAR != 4 && VAR != 7 && VAR != 8 && t + 2 < NT;
        if (issue) dma_tile(lds, (t + 2) & 3, Kc, Vc, (t + 2) * 64, dmo, wid);
        { const int k0_ = t * 64; float sh_ = 0.f, alpha; const int dq_ = qpos - k0_ - 4 * hi;
          if (VAR != 8) { if (qw0 - (k0_ + 63) >= RFAR) sh_ = b31;
          if (k0_ + 63 > qw0) causal_mask(p0, p1, dq_); }
          if (VAR == 1 || VAR == 3 || VAR == 5 || VAR == 7 || VAR == 8) { alpha = 1.f; l_reg += p0[0] + sh_; u32x4 w0_ = {cvtpk(p0[0], p0[1]), cvtpk(p0[2], p0[3]), cvtpk(p0[4], p0[5]), cvtpk(p0[6], p0[7])}; pa0 = __builtin_bit_cast(bf16x8, w0_);
              u32x4 w1_ = {cvtpk(p0[8], p0[9]), cvtpk(p0[10], p0[11]), cvtpk(p0[12], p0[13]), cvtpk(p0[14], p0[15])}; pa1 = __builtin_bit_cast(bf16x8, w1_);
              u32x4 w2_ = {cvtpk(p1[0], p1[1]), cvtpk(p1[2], p1[3]), cvtpk(p1[4], p1[5]), cvtpk(p1[6], p1[7])}; pa2 = __builtin_bit_cast(bf16x8, w2_);
              u32x4 w3_ = {cvtpk(p1[8], p1[9]), cvtpk(p1[10], p1[11]), cvtpk(p1[12], p1[13]), cvtpk(p1[14], p1[15])}; pa3 = __builtin_bit_cast(bf16x8, w3_); }
          else softmax_tile(p0, p1, sh_, m_reg, l_reg, alpha, pa0, pa1, pa2, pa3);
          if (__any(alpha < 1.f)) { if (hi == 0) ws[r32] = alpha; asm volatile("s_waitcnt lgkmcnt(0)" ::: "memory");
#pragma unroll
              for (int d_ = 0; d_ < 4; ++d_)
#pragma unroll
                  for (int r = 0; r < 16; ++r) o[d_][r] *= ws[crow(r, hi)]; } }
        if (!halfB) { if (issue) asm volatile("s_waitcnt vmcnt(4)" ::: "memory"); else asm volatile("s_waitcnt vmcnt(0)" ::: "memory"); }
        WG_BAR();
    }
    __builtin_amdgcn_s_setprio(2);
    if (VAR != 2 && VAR != 3 && VAR != 7 && VAR != 8) pv_tile_pf(o, vb0 + ((NT - 1) & 3) * SHM_V, pa0, pa1, pa2, pa3);
    __builtin_amdgcn_s_setprio(0);
    if (!halfB) WG_BAR();
    WG_BAR();
    if (hi == 0) ws[32 + r32] = l_reg; asm volatile("s_waitcnt lgkmcnt(0)" ::: "memory");
#pragma unroll
    for (int r = 0; r < 16; ++r) { const float rl = __builtin_amdgcn_rcpf(ws[32 + crow(r, hi)]);
#pragma unroll
        for (int d0 = 0; d0 < 4; ++d0) o[d0][r] *= rl; }
    LAS float* xch = (LAS float*)lds + (size_t)w4 * 64 * 64;
    if (cm == 1) {
#pragma unroll
        for (int d0 = 0; d0 < 4; ++d0)
#pragma unroll
            for (int r = 0; r < 16; ++r) xch[(d0 * 16 + r) * 64 + lane] = o[d0][r];
    }
    WG_BAR();
    if (cm == 0) {
        float ss[16];
#pragma unroll
        for (int r = 0; r < 16; ++r) { float a = 0.f;
#pragma unroll
            for (int d0 = 0; d0 < 4; ++d0) { o[d0][r] -= lam_full * xch[(d0 * 16 + r) * 64 + lane]; a += o[d0][r] * o[d0][r]; }
            ss[r] = a; }
#pragma unroll
        for (int r = 0; r < 16; ++r) {
#pragma unroll
            for (int sft = 1; sft < 32; sft <<= 1) ss[r] += bperm_f(lane ^ sft, ss[r]); }
        float gg[4];
#pragma unroll
        for (int d0 = 0; d0 < 4; ++d0) gg[d0] = subg[d0 * 32 + r32] * (1.0f - LAMBDA_INIT);
        bf16* Ow = O + (rowbase + qw0) * PITCH + h * HD;
#pragma unroll
        for (int r = 0; r < 16; ++r) { const int orow = crow(r, hi); const float rs = 1.0f / sqrtf(ss[r] * (1.0f / HD) + RMS_EPS);
            u32x2 wo; wo.x = cvtpk(o[0][r] * rs * gg[0], o[1][r] * rs * gg[1]); wo.y = cvtpk(o[2][r] * rs * gg[2], o[3][r] * rs * gg[3]);
            *(u32x2*)(Ow + (size_t)orow * PITCH + r32 * 4) = wo; }
    }
    WG_BAR();
}


__device__ __forceinline__ void block_load(LAS char* lds, const bf16* Kc, const bf16* Vc, const DmaOff& d, int wid) {
#pragma unroll
    for (int t = 0; t < 4; ++t) dma_tile(lds, t, Kc, Vc, t * 64, d, wid);
}
#define MOBA_TILE(t, CAUSAL) do { const int k0_ = kbase + (t) * 64; \
        if (!(CAUSAL) || k0_ <= qw0 + 31) { f32x16 p0, p1; bf16x8 pa0, pa1, pa2, pa3; float alpha, sh = 0.f; \
            const int dq_ = qpos - k0_ - 4 * hi; \
            if (CAUSAL) load_bias_lut(p0, p1, lut, dq_); \
            else load_bias_lut(p0, p1, lut, dq_ < RFAR + 63 ? dq_ : RFAR + 63);     \
            qkt<t, 8>(p0, p1, K_lds, r32, hi, 0, qr); \
            if ((CAUSAL) && k0_ + 63 > qw0) causal_mask(p0, p1, dq_); \
            softmax_tile(p0, p1, sh, m_reg, l_reg, alpha, pa0, pa1, pa2, pa3); \
            if (__any(alpha < 1.f)) { if (hi == 0) ws[r32] = alpha; asm volatile("s_waitcnt lgkmcnt(0)" ::: "memory"); \
                _Pragma("unroll") for (int d_ = 0; d_ < 4; ++d_) _Pragma("unroll") for (int r = 0; r < 16; ++r) o[d_][r] *= ws[crow(r, hi)]; } \
            pv_tile<t>(o, vb0, pa0, pa1, pa2, pa3); } } while (0)
__device__ __forceinline__ void moba_part_group(LAS char* lds, int bh, int j, int g, int cntj, const bf16* Q, const unsigned short* lists, const unsigned* sel,
                                                bf16* P0, bf16* P1, bf16* P2, f32x2* ml, float b31, int wid, int lane) {
    asm volatile("" : "+v"(lane));
    const int r32 = lane & 31, hi = lane >> 5, b = bh >> 3, h = bh & 7;
    const size_t rowbase = (size_t)b * SEQ;
    const int idx = g * 32 + r32; const bool valid = idx < cntj;
    const int qpos = (int)lists[((size_t)bh * 32 + j) * 8192 + (valid ? idx : cntj - 1)];
    const unsigned smask = sel[(size_t)bh * SEQ + qpos]; const int slot = __popc(smask & ((1u << j) - 1u));
    const int vb0 = (int)(unsigned)(uintptr_t)(lds + L_V) + v_rd_base(lane);
    LAS float* ws = (LAS float*)(lds + L_WS) + wid * 64;
    LAS const float* lut = (LAS const float*)(lds + L_LUT);
    lcp K_lds = (lcp)(lds + L_K);
    bf16x8 qr[8];
#pragma unroll
    for (int d0 = 0; d0 < 8; ++d0) qr[d0] = *(const bf16x8*)(Q + (rowbase + qpos) * PITCH + h * HD + d0 * 16 + hi * 8);
    if (hi == 0) ((LAS int*)ws)[32 + r32] = valid ? (int)((unsigned)(rowbase + qpos) | ((unsigned)slot << 24)) : -1;
    float m_reg = -1e30f, l_reg = 0.f; f32x16 o[4] = {};
    const int kbase = j * 256, qw0 = 0; (void)qw0;
    MOBA_TILE(0, false); MOBA_TILE(1, false); MOBA_TILE(2, false); MOBA_TILE(3, false);
    if (hi == 0) { ws[r32] = l_reg; if (valid) ml[((size_t)slot * M + rowbase + qpos) * NH + h] = (f32x2){m_reg, l_reg}; }
    asm volatile("s_waitcnt lgkmcnt(0)" ::: "memory");
#pragma unroll
    for (int r = 0; r < 16; ++r) { const int orow = crow(r, hi); const float rl = __builtin_amdgcn_rcpf(ws[orow]); const int info = ((LAS const int*)ws)[32 + orow];
        const int sl = info >> 24; bf16* Pb = sl == 0 ? P0 : (sl == 1 ? P1 : P2); bf16* Ow = Pb + (size_t)(info & 0xffffff) * PITCH + h * HD;
        u32x2 w; w.x = cvtpk(o[0][r] * rl, o[1][r] * rl); w.y = cvtpk(o[2][r] * rl, o[3][r] * rl);
        if (info >= 0) *(u32x2*)(Ow + r32 * 4) = w; }
    asm volatile("s_waitcnt lgkmcnt(0)" ::: "memory");
}
__device__ __forceinline__ void moba_own_rows(LAS char* lds, int b, int h, int qb, const bf16* Q, bf16* O, const bf16* P0, const bf16* P1, const bf16* P2, const f32x2* ml, int wid, int lane) {
    asm volatile("" : "+v"(lane));
    const int r32 = lane & 31, hi = lane >> 5;
    const size_t rowbase = (size_t)b * SEQ;
    const int q0 = qb * 256, qw0 = q0 + wid * 32, qpos = qw0 + r32, kbase = q0;
    const int vb0 = (int)(unsigned)(uintptr_t)(lds + L_V) + v_rd_base(lane);
    LAS float* ws = (LAS float*)(lds + L_WS) + wid * 64;
    LAS const float* lut = (LAS const float*)(lds + L_LUT);
    lcp K_lds = (lcp)(lds + L_K);
    const float b31 = 0.f; (void)b31;
    bf16x8 qr[8];
#pragma unroll
    for (int d0 = 0; d0 < 8; ++d0) qr[d0] = *(const bf16x8*)(Q + (rowbase + qpos) * PITCH + h * HD + d0 * 16 + hi * 8);
    float m_reg = -1e30f, l_reg = 0.f; f32x16 o[4] = {};
    MOBA_TILE(0, true); MOBA_TILE(1, true); MOBA_TILE(2, true); MOBA_TILE(3, true);
    const int nsel = qb < 3 ? qb : 3;
    {
        float ms[3], ls[3]; float mx = m_reg;
#pragma unroll
        for (int s_ = 0; s_ < 3; ++s_) { ms[s_] = -1e30f; ls[s_] = 0.f;
            if (s_ < nsel) { const f32x2 v = ml[((size_t)s_ * M + rowbase + qpos) * NH + h]; ms[s_] = v.x; ls[s_] = v.y; mx = fmaxf(mx, v.x); } }
        const float w0 = __builtin_amdgcn_exp2f(m_reg - mx);
        float wv[3]; float den = l_reg * w0;
#pragma unroll
        for (int s_ = 0; s_ < 3; ++s_) { wv[s_] = ls[s_] * __builtin_amdgcn_exp2f(ms[s_] - mx); den += wv[s_]; }
        const float rd = 1.0f / den;
        if (hi == 0) *(LAS f32x4*)(lds + L_CF + wid * 512 + r32 * 16) = (f32x4){w0 * rd, wv[0] * rd, wv[1] * rd, wv[2] * rd};
    }
    asm volatile("s_waitcnt lgkmcnt(0)" ::: "memory");
#pragma unroll
    for (int r = 0; r < 16; ++r) { const int orow = crow(r, hi); const f32x4 cf = *(LAS const f32x4*)(lds + L_CF + wid * 512 + orow * 16);
        const size_t ro = (rowbase + qw0 + orow) * PITCH + h * HD + r32 * 4;
        float v0 = o[0][r] * cf.x, v1 = o[1][r] * cf.x, v2 = o[2][r] * cf.x, v3 = o[3][r] * cf.x;
        if (nsel > 0) { const u32x2 w = *(const u32x2*)(P0 + ro); v0 += cf.y * bflo(w.x); v1 += cf.y * bfhi(w.x); v2 += cf.y * bflo(w.y); v3 += cf.y * bfhi(w.y); }
        if (nsel > 1) { const u32x2 w = *(const u32x2*)(P1 + ro); v0 += cf.z * bflo(w.x); v1 += cf.z * bfhi(w.x); v2 += cf.z * bflo(w.y); v3 += cf.z * bfhi(w.y); }
        if (nsel > 2) { const u32x2 w = *(const u32x2*)(P2 + ro); v0 += cf.w * bflo(w.x); v1 += cf.w * bfhi(w.x); v2 += cf.w * bflo(w.y); v3 += cf.w * bfhi(w.y); }
        u32x2 wo; wo.x = cvtpk(v0, v1); wo.y = cvtpk(v2, v3);
        *(u32x2*)(O + ro) = wo; }
    asm volatile("s_waitcnt lgkmcnt(0)" ::: "memory");
}
#undef MOBA_TILE
#undef KSWZ
#undef SBAR
#undef WG_BAR
}


template <int VAR> __device__ __forceinline__ void p_diff_attn_mfma(const Args& a, LAS unsigned char* lds, int vcu, int tid, int wave, int lane, size_t out_off) {
    const bf16* Qb = (const bf16*)(a.ws + WS_Q); const bf16* Kb = (const bf16*)(a.ws + WS_K); const bf16* Vb = (const bf16*)(a.ws + WS_V);
    bf16* Ob = (bf16*)(a.ws + out_off); const float* biasT = (const float*)(a.ws + WS_BIAST);
    float lam_full;
    { const float* lm = a.diff_lambda; const float p01 = wave_sum(lm[lane] * lm[64 + lane]), p23 = wave_sum(lm[128 + lane] * lm[192 + lane]); lam_full = __expf(p01) - __expf(p23) + LAMBDA_INIT; }
    const int G = gridDim.x;
    if (G == 256) {
#pragma unroll 1
        for (int k = 0; k < 4; ++k) {
            const int bh = 2 * (vcu >> 5) + (k >> 1), p = vcu & 31, qb = (k & 1) ? 63 - p : p;
            att::diff_unit<VAR>((LAS char*)lds, bh >> 3, bh & 7, qb, Qb, Kb, Vb, Ob, a.rel_bias, biasT, lam_full, a.diff_subln_g, tid, wave, lane);
        }
    } else {
        for (int pp = vcu; pp < 512; pp += G) {
#pragma unroll 1
            for (int k = 0; k < 2; ++k) {
                const int bh = pp >> 5, p = pp & 31, qb = k ? 63 - p : p;
                att::diff_unit<VAR>((LAS char*)lds, bh >> 3, bh & 7, qb, Qb, Kb, Vb, Ob, a.rel_bias, biasT, lam_full, a.diff_subln_g, tid, wave, lane);
            }
        }
    }
}


__device__ __forceinline__ void p_moba_part(const Args& a, LAS unsigned char* lds, int vcu, int tid, int wave, int lane) {
    const bf16* Qb = (const bf16*)(a.ws + WS_Q); const bf16* Kb = (const bf16*)(a.ws + WS_K); const bf16* Vb = (const bf16*)(a.ws + WS_V);
    const unsigned* cnt = (const unsigned*)(a.ws + WS_CTL) + CW_CNT; const unsigned short* lists = (const unsigned short*)(a.ws + WS_LIST); const unsigned* sel = (const unsigned*)(a.ws + WS_SEL);
    bf16* P0 = (bf16*)(a.ws + WS_H); bf16* P1 = (bf16*)(a.ws + WS_Y); bf16* P2 = (bf16*)a.out; f32x2* ml = (f32x2*)((unsigned char*)a.out + WS_ML);
    LAS int* pre = (LAS int*)(lds + att::L_TAB); LAS int* found = (LAS int*)(lds + att::L_FOUND);
    const int c = (int)cnt[tid], nch = (c + 255) >> 8;
    int incl = nch;
#pragma unroll
    for (int o = 1; o < 64; o <<= 1) { const int v = bperm_i(lane >= o ? lane - o : lane, incl); if (lane >= o) incl += v; }
    if (lane == 63) pre[513 + wave] = incl;
    __syncthreads();
    int woff = 0;
#pragma unroll
    for (int w8 = 0; w8 < 8; ++w8) woff += (w8 < wave) ? pre[513 + w8] : 0;
    pre[tid + 1] = woff + incl; if (tid == 0) pre[0] = 0;
    __syncthreads();
    const int T = pre[512], G = gridDim.x;
    const int lo = (int)(((long long)T * vcu) / G), hi_ = (int)(((long long)T * (vcu + 1)) / G);
    const att::DmaOff dmo = att::dma_offsets(wave, lane);
    int last_h = -1;
    for (int it = lo; it < hi_;) {
        if (pre[tid] <= it && it < pre[tid + 1]) found[0] = tid;
        __syncthreads();
        const int f = __builtin_amdgcn_readfirstlane(found[0]);
        const int bh = f >> 5, j = f & 31, c0 = it - pre[f];
        const int seg_end = pre[f + 1] < hi_ ? pre[f + 1] : hi_, c1 = seg_end - pre[f];
        const int cntj = (int)cnt[f];
        const size_t kvoff = ((size_t)(bh >> 3) * SEQ + j * 256) * D + (bh & 7) * HD;
        att::block_load((LAS char*)lds, Kb + kvoff, Vb + kvoff, dmo, wave);
        if ((bh & 7) != last_h) { last_h = bh & 7; att::build_lut((LAS char*)lds, (const float*)(a.ws + WS_BIAST), last_h, tid); }
        const float b31 = a.rel_bias[31 * 8 + (bh & 7)] * LOG2E;
        asm volatile("s_waitcnt vmcnt(0)" ::: "memory");
        __syncthreads();
        for (int g = c0 * 8 + wave; g < c1 * 8 && g * 32 < cntj; g += 8)
            att::moba_part_group((LAS char*)lds, bh, j, g, cntj, Qb, lists, sel, P0, P1, P2, ml, b31, wave, lane);
        it = seg_end;
    }
}
__device__ __forceinline__ void p_moba_own(const Args& a, LAS unsigned char* lds, int vcu, int tid, int wave, int lane) {
    const bf16* Qb = (const bf16*)(a.ws + WS_Q); const bf16* Kb = (const bf16*)(a.ws + WS_K); const bf16* Vb = (const bf16*)(a.ws + WS_V); bf16* Ob = (bf16*)(a.ws + WS_O);
    const bf16* P0 = (const bf16*)(a.ws + WS_H); const bf16* P1 = (const bf16*)(a.ws + WS_Y); const bf16* P2 = (const bf16*)a.out; const f32x2* ml = (const f32x2*)((const unsigned char*)a.out + WS_ML);
    const int G = gridDim.x;
    const att::DmaOff dmo = att::dma_offsets(wave, lane);
    for (int u0 = 2 * vcu; u0 < 512; u0 += 2 * G) {
#pragma unroll 1
        for (int k = 0; k < 2; ++k) { const int u = u0 + k; if (u >= 512) break; const int bh = u >> 5, qb = u & 31;
            __syncthreads();
            const size_t kvoff = ((size_t)(bh >> 3) * SEQ + qb * 256) * D + (bh & 7) * HD;
            att::block_load((LAS char*)lds, Kb + kvoff, Vb + kvoff, dmo, wave);
            if (k == 0 || (u & 31) == 0) att::build_lut((LAS char*)lds, (const float*)(a.ws + WS_BIAST), bh & 7, tid);
            asm volatile("s_waitcnt vmcnt(0)" ::: "memory");
            __syncthreads();
            att::moba_own_rows((LAS char*)lds, bh >> 3, bh & 7, qb, Qb, Ob, P0, P1, P2, ml, wave, lane); }
    }
}

struct TI { int tid, lane, wave, gtid, gw; };
__device__ __forceinline__ TI mk_ti(int wave0) { const int l = lane_opaque(); const int t = wave0 * 64 + l; TI r; r.tid = t; r.lane = l; r.wave = wave0;
    r.gtid = blockIdx.x * NTHR + t; r.gw = blockIdx.x * NWAVES + r.wave; return r; }

typedef const __attribute__((address_space(4))) Args* CArgs;
__device__ __forceinline__ Args load_args() {
#if defined(__HIP_DEVICE_COMPILE__)
    auto p = __builtin_amdgcn_kernarg_segment_ptr(); asm volatile("" : "+s"(p));
    typedef const __attribute__((address_space(4))) unsigned long long* cu64; cu64 q = (cu64)p;
    Args r; r.x = (const float*)q[0]; r.c = (const float*)q[1]; r.rel_bias = (const float*)q[2]; r.ada_w = (const float*)q[3]; r.ada_b = (const float*)q[4]; r.norm_g = (const float*)q[5];
    r.moba_w_qkv = (const float*)q[6]; r.moba_w_o = (const float*)q[7]; r.diff_w_qkv = (const float*)q[8]; r.diff_w_o = (const float*)q[9];
    r.diff_lambda = (const float*)q[10]; r.diff_subln_g = (const float*)q[11]; r.ffn_w_in = (const float*)q[12]; r.ffn_w_out = (const float*)q[13];
    r.out = (float*)q[14]; r.ws = (unsigned char*)q[15]; return r;
#else
    return Args{};
#endif
}
#define WSP(T, off) ((T*)(a.ws + (off)))
#define GEMM_PHASE_F8(EPI, Aptr, Wptr, N_, K_, ...) do { const Args a = load_args(); const int G_ = gridDim.x; \
        pg8::Gemm g{Aptr, (const bf16*)(Wptr), M, N_, K_}; pg8::StaticOrder S; S.init(M, N_, G_, (int)blockIdx.x); \
        EPI E{__VA_ARGS__}; pg8::gemm_phase<EPI, pg8::StaticOrder, true, true, true>(lds, g, S, E, wave0); } while (0)
#define GEMM_PHASE(EPI, Aptr, Wptr, N_, K_, ...) do { const Args a = load_args(); const int G_ = gridDim.x; \
        pg8::Gemm g{Aptr, (const bf16*)(Wptr), M, N_, K_}; pg8::StaticOrder S; S.init(M, N_, G_, (int)blockIdx.x); \
        EPI E{__VA_ARGS__}; pg8::gemm_phase<EPI, pg8::StaticOrder, true, true>(lds, g, S, E, wave0); } while (0)
__global__ void __launch_bounds__(NTHR, 2) fwd(Args a_unused) {
    extern __shared__ __attribute__((aligned(16))) unsigned char lds_raw[];
    LAS unsigned char* lds = (LAS unsigned char*)lds_raw;
    volatile LAS unsigned* MISC = (volatile LAS unsigned*)(lds + MISC_OFF);
    const int wave0 = __builtin_amdgcn_readfirstlane((int)threadIdx.x >> 6);
    if (wave0 == 0) MISC[lane_opaque()] = 0u;
    __syncthreads();
    XcdBarrier bar;
    { const Args a = load_args(); bar = xcd_barrier_post(WSP(unsigned, WS_CTL) + CW_BAR, MISC + 8, wave0); }
#define VCU() ((gridDim.x % 8 == 0) ? (int)((blockIdx.x % 8) * (gridDim.x / 8) + blockIdx.x / 8) : (int)blockIdx.x)
#define NGW() ((int)gridDim.x * NWAVES)
#define NGT() ((int)gridDim.x * NTHR)
    constexpr float QS0 = 0.08838834764831845f * LOG2E, QS1 = 0.125f * LOG2E;
    constexpr size_t QKVS = (size_t)(WS_K - WS_Q) / 2;

    { const Args a = load_args(); const TI t = mk_ti(wave0); p_weights(a, lds, t.gw, NGW(), t.wave, t.lane); p_wo_perm(a, t.gtid, NGT()); __syncthreads(); p_mod(a, lds, (int)blockIdx.x, (int)gridDim.x, t.tid, t.wave, t.lane); }
    xcd_barrier(bar);
    { const Args a = load_args(); const TI t = mk_ti(wave0); const float* md = WSP(const float, WS_MOD); p_norm_in(a.x, a.norm_g, md, md + 1024, WSP(bf16, WS_H), t.gw, NGW(), t.lane); }
    xcd_barrier(bar);
    GEMM_PHASE(pg8::EpiQKV, WSP(bf16, WS_H), a.ws + WS_W + WO_QKV, 3 * D, D, WSP(bf16, WS_Q), D, QKVS, QS0, WSP(float, WS_KSUM));
    xcd_barrier(bar);
    { const Args a = load_args(); const TI t = mk_ti(wave0); p_gate(WSP(bf16, WS_Q), WSP(const float, WS_KSUM), WSP(unsigned, WS_SEL), WSP(unsigned, WS_CTL) + CW_CNT, WSP(unsigned short, WS_LIST), lds, (int)blockIdx.x, (int)gridDim.x, t.tid, t.wave, t.lane); }
    xcd_barrier(bar);
    { const Args a = load_args(); const TI t = mk_ti(wave0); p_moba_part(a, lds, VCU(), t.tid, t.wave, t.lane); }
    xcd_barrier(bar);
    { const Args a = load_args(); const TI t = mk_ti(wave0); p_moba_own(a, lds, VCU(), t.tid, t.wave, t.lane); }
    xcd_barrier(bar);
    GEMM_PHASE(pg8::EpiBf16<0>, WSP(bf16, WS_O), a.ws + WS_W + WO_O, D, D, WSP(bf16, WS_Y), D, nullptr, 0, 0, 1.f);
    xcd_barrier(bar);
    { const Args a = load_args(); const TI t = mk_ti(wave0); const float* md = WSP(const float, WS_MOD); const float* ng = a.norm_g;
      p_post<false, true, true>(a.x, WSP(bf16, WS_Y), ng + D, md + 2048, a.out, ng + 2 * D, md + 3072, md + 4096, WSP(bf16, WS_H), t.gw, NGW(), t.lane); }
    xcd_barrier(bar);
    GEMM_PHASE_F8(pg8::EpiSwiglu, WSP(bf16, WS_H), a.ws + WS_W + WO_IN, 2 * DFF, D / 2, WSP(bf16, WS_HH), DFF, 1.0f / (F8_SA * F8_SB), F8_SH);
    xcd_barrier(bar);
    GEMM_PHASE_F8(pg8::EpiScaled, WSP(bf16, WS_HH), a.ws + WS_W + WO_OUT, D, DFF / 2, WSP(bf16, WS_Y), D, 1.0f / (F8_SH * F8_SB));
    xcd_barrier(bar);
    { const Args a = load_args(); const TI t = mk_ti(wave0); const float* md = WSP(const float, WS_MOD); const float* ng = a.norm_g; const float* md1 = md + 2 * 6144; const float* ng1 = ng + 4 * D;
      p_post<true, true, false>(a.out, WSP(bf16, WS_Y), ng + 3 * D, md + 5120, (unsigned char*)a.out + 32 * MiB, ng1, md1, md1 + 1024, WSP(bf16, WS_H), t.gw, NGW(), t.lane); }
    xcd_barrier(bar);
    GEMM_PHASE(pg8::EpiQKV, WSP(bf16, WS_H), a.ws + WS_W + WL_STRIDE + WO_QKV, 3 * D, D, WSP(bf16, WS_Q), D, QKVS, QS1, nullptr);
    xcd_barrier(bar);
    { const Args a = load_args(); const TI t = mk_ti(wave0); p_diff_attn_mfma<0>(a, lds, VCU(), t.tid, t.wave, t.lane, WS_O); }
#ifdef PROBE_VAR
    { const Args a = load_args(); const TI t = mk_ti(wave0); p_diff_attn_mfma<PROBE_VAR>(a, lds, VCU(), t.tid, t.wave, t.lane, WS_Y); }
#endif
    xcd_barrier(bar);
    GEMM_PHASE(pg8::EpiBf16<0>, WSP(bf16, WS_O), a.ws + WS_W + WL_STRIDE + WO_O, D, D, WSP(bf16, WS_Y), D, nullptr, 0, 0, 1.f);
    xcd_barrier(bar);
    { const Args a = load_args(); const TI t = mk_ti(wave0); const float* md = WSP(const float, WS_MOD) + 2 * 6144; const float* ng = a.norm_g + 4 * D;
      p_post<true, true, true>((unsigned char*)a.out + 32 * MiB, WSP(bf16, WS_Y), ng + D, md + 2048, WSP(bf16, WS_O), ng + 2 * D, md + 3072, md + 4096, WSP(bf16, WS_H), t.gw, NGW(), t.lane); }
    xcd_barrier(bar);
    GEMM_PHASE_F8(pg8::EpiSwiglu, WSP(bf16, WS_H), a.ws + WS_W + WL_STRIDE + WO_IN, 2 * DFF, D / 2, WSP(bf16, WS_HH), DFF, 1.0f / (F8_SA * F8_SB), F8_SH);
    xcd_barrier(bar);
    GEMM_PHASE_F8(pg8::EpiScaled, WSP(bf16, WS_HH), a.ws + WS_W + WL_STRIDE + WO_OUT, D, DFF / 2, WSP(bf16, WS_Y), D, 1.0f / (F8_SH * F8_SB));
    xcd_barrier(bar);
    { const Args a = load_args(); const TI t = mk_ti(wave0); const float* md = WSP(const float, WS_MOD) + 2 * 6144; const float* ng = a.norm_g + 4 * D;
      p_post<true, false, false>(WSP(bf16, WS_O), WSP(bf16, WS_Y), ng + 3 * D, md + 5120, a.out, nullptr, nullptr, nullptr, nullptr, t.gw, NGW(), t.lane); }
}

extern "C" void kernel_launch(void* const* d_in, const int* in_sizes, int n_in, void* d_out, int out_size, void* d_ws, size_t ws_size, hipStream_t stream) {
    static int grid = 0;
    if (grid == 0) {
        if (n_in != 14 || out_size != M * D || ws_size < WS_END) { fprintf(stderr, "kernel_launch: unexpected shapes n_in %d out %d ws %zu\n", n_in, out_size, ws_size); grid = -1; return; }
        int dev = 0, cus = 0;
        if (hipGetDevice(&dev) != hipSuccess || hipDeviceGetAttribute(&cus, hipDeviceAttributeMultiprocessorCount, dev) != hipSuccess) { grid = -1; return; }
        if (hipFuncSetAttribute((const void*)fwd, hipFuncAttributeMaxDynamicSharedMemorySize, LDS_BYTES) != hipSuccess) { fprintf(stderr, "hipFuncSetAttribute failed\n"); grid = -1; return; }
        grid = cus;
    }
    if (grid < 0) return;
    (void)hipMemsetAsync((char*)d_ws + WS_CTL, 0, CTL_ZERO_BYTES, stream);
    Args a{};
    a.x = (const float*)d_in[0]; a.c = (const float*)d_in[1]; a.rel_bias = (const float*)d_in[2]; a.ada_w = (const float*)d_in[3]; a.ada_b = (const float*)d_in[4];
    a.norm_g = (const float*)d_in[5]; a.moba_w_qkv = (const float*)d_in[6]; a.moba_w_o = (const float*)d_in[7]; a.diff_w_qkv = (const float*)d_in[8]; a.diff_w_o = (const float*)d_in[9];
    a.diff_lambda = (const float*)d_in[10]; a.diff_subln_g = (const float*)d_in[11]; a.ffn_w_in = (const float*)d_in[12]; a.ffn_w_out = (const float*)d_in[13];
    a.out = (float*)d_out; a.ws = (unsigned char*)d_ws;
    hipLaunchKernelGGL(fwd, dim3(grid), dim3(NTHR), LDS_BYTES, stream, a);
}
```

```cpp
#include <hip/hip_runtime.h>
#include <cstdio>
#include <cstdint>

#define GAS __attribute__((address_space(1)))
#define LAS __attribute__((address_space(3)))
typedef unsigned short bf16;
typedef float f32x4 __attribute__((ext_vector_type(4)));
typedef float f32x2 __attribute__((ext_vector_type(2)));
typedef unsigned u32x4 __attribute__((ext_vector_type(4)));
typedef unsigned u32x2 __attribute__((ext_vector_type(2)));

constexpr int BATCH = 2, SEQ = 8192, D = 1024, NH = 8, HD = 128, DFF = 2816, NBKT = 32;
constexpr int M = BATCH * SEQ;
constexpr int NWAVES = 8, NTHR = 512;
constexpr float RMS_EPS = 1e-6f;
constexpr float LOG2E = 1.4426950408889634f;
constexpr float LAMBDA_INIT = 0.35550906759096926f;

constexpr size_t MiB = 1u << 20;
constexpr size_t WS_CTL = 0, CTL_ZERO_BYTES = 1 * MiB;
constexpr size_t WS_MOD = 1 * MiB;
constexpr size_t WS_BLUT = WS_MOD + 128 * 1024;
constexpr size_t WS_KMEAN = WS_BLUT + 16 * 1024;
constexpr size_t WS_SEL = WS_KMEAN + 256 * 1024;
constexpr size_t WS_BIAST = WS_SEL + 512 * 1024;
constexpr size_t WS_LIST = 244 * MiB;
constexpr size_t WS_ML = 32 * MiB;
constexpr size_t WS_KSUM = 256 * 1024;
constexpr int CW_CNT = 8192;
constexpr size_t WS_W = 2 * MiB, WL_STRIDE = 25 * MiB;
constexpr size_t WO_QKV = 0, WO_O = 6 * MiB, WO_IN = 8 * MiB, WO_OUT = 19 * MiB;
constexpr size_t WS_H = 52 * MiB;
constexpr size_t WS_Q = 84 * MiB, WS_K = 116 * MiB, WS_V = 148 * MiB;
constexpr size_t WS_HH = 84 * MiB;
constexpr size_t WS_O = 180 * MiB;
constexpr size_t WS_Y = 212 * MiB;
constexpr size_t WS_END = 252 * MiB;
constexpr int CW_BAR = 4096;

constexpr int LDS_BYTES = 155648;
constexpr int MISC_OFF = 150016;

#define RLX_AGENT __ATOMIC_RELAXED, __HIP_MEMORY_SCOPE_AGENT
__device__ __forceinline__ unsigned f2bf(float f) { unsigned u = __builtin_bit_cast(unsigned, f); return (u + 0x7fffu + ((u >> 16) & 1u)) >> 16; }
__device__ __forceinline__ unsigned pk2(float lo, float hi) { return f2bf(lo) | (f2bf(hi) << 16); }
__device__ __forceinline__ float bf2f(unsigned short b) { return __builtin_bit_cast(float, (unsigned)b << 16); }
__device__ __forceinline__ float bflo(unsigned w) { return __builtin_bit_cast(float, w << 16); }
__device__ __forceinline__ float bfhi(unsigned w) { return __builtin_bit_cast(float, w & 0xffff0000u); }

__device__ __forceinline__ int lane_opaque() { int l; asm volatile("v_mbcnt_lo_u32_b32 %0, -1, 0\n\tv_mbcnt_hi_u32_b32 %0, -1, %0" : "=v"(l)); return l; }
__device__ __forceinline__ float bperm_f(int src_lane, float v) { return __builtin_bit_cast(float, __builtin_amdgcn_ds_bpermute(src_lane << 2, __builtin_bit_cast(int, v))); }
__device__ __forceinline__ int bperm_i(int src_lane, int v) { return __builtin_amdgcn_ds_bpermute(src_lane << 2, v); }

#define XB_TMO      128
#define XB_XCNT(j)  (256  + 64 * (j))
#define XB_XSUB(j)  (1280 + 64 * (j))
#define XB_XGEN(j)  (2304 + 64 * (j))
#define XB_TOP      3328
#define XB_TOPGEN   3392
#define XCD_BAR_WORDS 3456
#define XB_SPIN_CAP (1u << 25)
__device__ __forceinline__ unsigned xb_ld(unsigned* p)              { return __hip_atomic_load(p, __ATOMIC_RELAXED, __HIP_MEMORY_SCOPE_AGENT); }
__device__ __forceinline__ unsigned xb_add(unsigned* p, unsigned v) { return __hip_atomic_fetch_add(p, v, __ATOMIC_RELAXED, __HIP_MEMORY_SCOPE_AGENT); }
__device__ __forceinline__ unsigned xb_xcc_id() { return (unsigned)__builtin_amdgcn_s_getreg((3 << 11) | 20) & 0xFu; }
#define XB_SPIN(cond, bar) do { unsigned _sp = 0; while (cond) { __builtin_amdgcn_s_sleep(1); \
    if ((++_sp & 255u) == 0u) { if (xb_ld(&(bar)[XB_TMO])) break; if (_sp > XB_SPIN_CAP) { atomicAdd(&(bar)[XB_TMO], 1u); break; } } } } while (0)
struct XcdBarrier { unsigned* bar; unsigned x; volatile LAS unsigned* st; int wave; };
__device__ __forceinline__ XcdBarrier xcd_barrier_post(unsigned* bar, volatile LAS unsigned* st, int wave) {
    XcdBarrier b; b.bar = bar; b.x = xb_xcc_id(); b.st = st; b.wave = wave;
    if (wave == 0 && lane_opaque() == 0) (void)xb_add(&bar[XB_XCNT(b.x)], 1u);
    return b;
}
__device__ __forceinline__ void xcd_barrier_complete(unsigned* bar, unsigned x, unsigned& nloc, unsigned& nx) {
    const unsigned G = gridDim.x * gridDim.y * gridDim.z;
    unsigned sum, cnt, mine, sp = 0u;
    for (;;) {
        sum = 0u; cnt = 0u; mine = 0u;
#pragma unroll
        for (unsigned j = 0; j < 16; ++j) { const unsigned c = xb_ld(&bar[XB_XCNT(j)]); sum += c; cnt += (c > 0u) ? 1u : 0u; mine = (j == x) ? c : mine; }
        if (sum == G) break;
        __builtin_amdgcn_s_sleep(1);
        if ((++sp & 255u) == 0u) { if (xb_ld(&bar[XB_TMO])) break; if (sp > XB_SPIN_CAP) { atomicAdd(&bar[XB_TMO], 1u); break; } }
    }
    nloc = mine > 0u ? mine : 1u; nx = cnt > 0u ? cnt : 1u;
}
__device__ __forceinline__ void xcd_barrier(const XcdBarrier& b) {
    asm volatile("s_waitcnt vmcnt(0)" ::: "memory");
    __syncthreads();
    if (b.wave == 0 && lane_opaque() == 0) {
        unsigned* bar = b.bar;
        __builtin_amdgcn_s_waitcnt(0);
        unsigned nloc = b.st[0], nx = b.st[1];
        if (nloc == 0u) { xcd_barrier_complete(bar, b.x, nloc, nx); b.st[0] = nloc; b.st[1] = nx; }
        const unsigned old = xb_add(&bar[XB_XSUB(b.x)], 1u);
        const unsigned gen = old / nloc;
        if (old + 1u == (gen + 1u) * nloc) {
            __builtin_amdgcn_fence(__ATOMIC_RELEASE, "agent");
            asm volatile("s_waitcnt vmcnt(0)" ::: "memory");
            const unsigned og = xb_add(&bar[XB_TOP], 1u);
            const unsigned tg = og / nx;
            if (og + 1u == (tg + 1u) * nx) xb_add(&bar[XB_TOPGEN], 1u);
            else XB_SPIN(xb_ld(&bar[XB_TOPGEN]) == tg, bar);
            __builtin_amdgcn_fence(__ATOMIC_ACQUIRE, "agent");
            xb_add(&bar[XB_XGEN(b.x)], 1u);
            asm volatile("s_waitcnt vmcnt(0)" ::: "memory");
        } else {
            XB_SPIN(xb_ld(&bar[XB_XGEN(b.x)]) == gen, bar);
            __builtin_amdgcn_fence(__ATOMIC_ACQUIRE, "agent");
            asm volatile("s_waitcnt vmcnt(0)" ::: "memory");
        }
    }
    __syncthreads();
}

namespace pg8 {
#define PG8_LAS __attribute__((address_space(3)))
typedef unsigned short bf16_t;
typedef short bf16x8 __attribute__((ext_vector_type(8)));
typedef float f32x4 __attribute__((ext_vector_type(4)));
typedef unsigned u32x4 __attribute__((ext_vector_type(4)));
constexpr int BM = 256, BK = 64, HALF = 128, HTB = HALF * BK * 2  , STAGE_BYTES = 8 * HTB, NXCD = 8, WGM = 8;

__host__ __device__ __forceinline__ int lds_byte(int r, int c) { const int st = (r >> 4) * 2 + (c >> 5), rr = r & 15, cc = c & 31, ob = rr * 64 + cc * 2; return st * 1024 + (ob ^ (((ob >> 9) & 1) << 5)); }
__host__ __device__ __forceinline__ void stage_rc(int b, int& R, int& C) { const int st = b / 1024, sb = b % 1024, swz = sb ^ (((sb >> 9) & 1) << 5); R = (st >> 1) * 16 + swz / 64; C = (st & 1) * 32 + (swz % 64) / 2; }
__host__ __device__ __forceinline__ int perm32(int rho) { const int n = rho >> 4, i = rho & 15; return 8 * (i >> 2) + 4 * n + (i & 3); }

struct Unit { int pm, pn; };
struct Gemm { const bf16_t* A; const bf16_t* Bt; int M, N, K; };

struct StaticOrder {
    int nM, nN, nwg, G, c;
    __host__ __device__ void init(int M, int N, int G_, int c_) { nM = M / BM; nN = N / BM; nwg = nM * nN; G = G_; c = c_; }
    __host__ __device__ bool next(int i, Unit& u) const {
        const long L = (long)i * G + c; if (L >= nwg) return false;
        int wgid = (int)L; { const int q = nwg / NXCD, r = nwg % NXCD, xcd = wgid % NXCD, off = wgid / NXCD; wgid = (xcd < r ? xcd * (q + 1) : r * (q + 1) + (xcd - r) * q) + off; }
        const int nig = WGM * nN, gid = wgid / nig, fm = gid * WGM, gsz = (nM - fm) < WGM ? (nM - fm) : WGM;
        u.pm = fm + ((wgid % nig) % gsz); u.pn = (wgid % nig) / gsz; return true;
    }
    __device__ __forceinline__ void a_ready(const Unit&) const {}
    __device__ __forceinline__ void done(const Unit&) const {}
};

__device__ __forceinline__ unsigned cvt_pk_bf16(float lo, float hi) { unsigned r; asm volatile("v_cvt_pk_bf16_f32 %0, %1, %2" : "=v"(r) : "v"(lo), "v"(hi)); return r; }
typedef float f32x2 __attribute__((ext_vector_type(2)));
__device__ __forceinline__ f32x2 gelu_pk(f32x2 v) {
    const f32x2 av = __builtin_elementwise_abs(v), d = av * 0.2316418882f + 1.0f;
    f32x2 t; t.x = __builtin_amdgcn_rcpf(d.x); t.y = __builtin_amdgcn_rcpf(d.y);
    f32x2 q = t * 0.5307027145f + (-0.7265760135f); q = q * t + 0.7107068705f; q = q * t + (-0.142248368f); q = q * t + 0.127414796f; q = q * t;
    const f32x2 s = (v * v) * (-0.72134752044f);
    f32x2 e; e.x = __builtin_amdgcn_exp2f(s.x); e.y = __builtin_amdgcn_exp2f(s.y);
    const f32x2 m = v * (q * e), r = v - m;
    f32x2 o; o.x = v.x < 0.f ? m.x : r.x; o.y = v.y < 0.f ? m.y : r.y; return o;
}

template <int ACT  > struct EpiBf16 {
    static constexpr bool PERM = true, AFTER_DRAIN = false; static_assert(ACT == 0 || ACT == 1, "EpiBf16: ACT is 0 (none) or 1 (gelu_pk)");
    bf16_t* O; int ldc; const float* bias; int split_cols; size_t split_stride; float scale0;
    __device__ __forceinline__ void operator()(const f32x4 (&acc)[2][2][4][2], const Unit& u, int wr, int wc, int fr, int fq) const {
        const int row0 = u.pm * BM + wr * 64 + fr; int colt = u.pn * BM; bf16_t* base = O;
        float sc = 1.f; if (split_cols) { const int t = colt / split_cols; base += (size_t)t * split_stride; colt -= t * split_cols; if (t == 0) sc = scale0; }
        const int col0 = colt + wc * 32 + 8 * fq, bcol0 = u.pn * BM + wc * 32 + 8 * fq;
        f32x4 bv[2][2];
#pragma unroll
        for (int bj = 0; bj < 2; ++bj)
#pragma unroll
            for (int n = 0; n < 2; ++n) bv[bj][n] = bias ? *(const f32x4*)(bias + bcol0 + bj * HALF + 4 * n) : (f32x4){0.f, 0.f, 0.f, 0.f};
#pragma unroll
        for (int ai = 0; ai < 2; ++ai)
#pragma unroll
            for (int m = 0; m < 4; ++m) { bf16_t* rowp = base + (size_t)(row0 + ai * HALF + m * 16) * ldc + col0;
#pragma unroll
                for (int bj = 0; bj < 2; ++bj) { f32x4 v0 = acc[ai][bj][m][0] + bv[bj][0], v1 = acc[ai][bj][m][1] + bv[bj][1];
                    if (ACT == 1) { f32x2 a = gelu_pk((f32x2){v0[0], v0[1]}), b = gelu_pk((f32x2){v0[2], v0[3]}), c = gelu_pk((f32x2){v1[0], v1[1]}), d = gelu_pk((f32x2){v1[2], v1[3]});
                        v0 = (f32x4){a.x, a.y, b.x, b.y}; v1 = (f32x4){c.x, c.y, d.x, d.y}; }
                    v0 = v0 * sc; v1 = v1 * sc; u32x4 w; w.x = cvt_pk_bf16(v0[0], v0[1]); w.y = cvt_pk_bf16(v0[2], v0[3]); w.z = cvt_pk_bf16(v1[0], v1[1]); w.w = cvt_pk_bf16(v1[2], v1[3]);
                    *(u32x4*)(rowp + bj * HALF) = w; } }
    }
};

struct EpiQKV {
    static constexpr bool PERM = true, AFTER_DRAIN = false;
    bf16_t* O; int ldc; size_t split_stride; float scale0; float* ksum;
    __device__ __forceinline__ void operator()(const f32x4 (&acc)[2][2][4][2], const Unit& u, int wr, int wc, int fr, int fq) const {
        const int row0 = u.pm * BM + wr * 64 + fr; const int t = (u.pn * BM) / ldc; const int colt = u.pn * BM - t * ldc; bf16_t* base = O + (size_t)t * split_stride;
        const float sc = t == 0 ? scale0 : 1.f;
        const int col0 = colt + wc * 32 + 8 * fq;
#pragma unroll
        for (int ai = 0; ai < 2; ++ai)
#pragma unroll
            for (int m = 0; m < 4; ++m) { bf16_t* rowp = base + (size_t)(row0 + ai * HALF + m * 16) * ldc + col0;
#pragma unroll
                for (int bj = 0; bj < 2; ++bj) { const f32x4 v0 = acc[ai][bj][m][0] * sc, v1 = acc[ai][bj][m][1] * sc;
                    u32x4 w; w.x = cvt_pk_bf16(v0[0], v0[1]); w.y = cvt_pk_bf16(v0[2], v0[3]); w.z = cvt_pk_bf16(v1[0], v1[1]); w.w = cvt_pk_bf16(v1[2], v1[3]);
                    *(u32x4*)(rowp + bj * HALF) = w; } }
        if (ksum != nullptr && t == 1) {
            const int b = u.pm >> 5, blk = u.pm & 31, lq_ = lane_opaque();
#pragma unroll
            for (int bj = 0; bj < 2; ++bj) { const int h = (colt >> 7) + bj;
                float* dst = ksum + ((size_t)((b * 8 + h) * 32 + blk)) * 128 + wc * 32 + 8 * fq;
#pragma unroll
                for (int n = 0; n < 2; ++n) { f32x4 sacc = (f32x4){0.f, 0.f, 0.f, 0.f};
#pragma unroll
                    for (int ai = 0; ai < 2; ++ai)
#pragma unroll
                        for (int m = 0; m < 4; ++m) sacc += acc[ai][bj][m][n];
#pragma unroll
                    for (int e = 0; e < 4; ++e) { float v = sacc[e];
                        v += bperm_f(lq_ ^ 1, v); v += bperm_f(lq_ ^ 2, v); v += bperm_f(lq_ ^ 4, v); v += bperm_f(lq_ ^ 8, v);
                        if (fr == 0) atomicAdd(dst + 4 * n + e, v); } } }
        }
    }
};

struct EpiSwiglu {
    static constexpr bool PERM = true, AFTER_DRAIN = false;
    bf16_t* O; int ldc; float inv; float oscale;
    __device__ __forceinline__ void operator()(const f32x4 (&acc)[2][2][4][2], const Unit& u, int wr, int wc, int fr, int fq) const {
        const int row0 = u.pm * BM + wr * 64 + fr, col0 = u.pn * HALF + wc * 32 + 8 * fq;
#pragma unroll
        for (int ai = 0; ai < 2; ++ai)
#pragma unroll
            for (int m = 0; m < 4; ++m) { bf16_t* rowp = O + (size_t)(row0 + ai * HALF + m * 16) * ldc + col0;
                float v[8];
#pragma unroll
                for (int n = 0; n < 2; ++n)
#pragma unroll
                    for (int e = 0; e < 4; ++e) { const float g = acc[ai][0][m][n][e] * inv, uu = acc[ai][1][m][n][e] * inv;
                        v[n * 4 + e] = g * __builtin_amdgcn_rcpf(1.0f + __builtin_amdgcn_exp2f(-1.4426950408889634f * g)) * uu; }
                if (oscale > 0.f) { u32x2 w8;
                    { float c0 = fminf(fmaxf(v[0] * oscale, -448.f), 448.f), c1 = fminf(fmaxf(v[1] * oscale, -448.f), 448.f), c2 = fminf(fmaxf(v[2] * oscale, -448.f), 448.f), c3 = fminf(fmaxf(v[3] * oscale, -448.f), 448.f);
                      int t_ = __builtin_amdgcn_cvt_pk_fp8_f32(c0, c1, 0, false); t_ = __builtin_amdgcn_cvt_pk_fp8_f32(c2, c3, t_, true); w8.x = (unsigned)t_; }
                    { float c0 = fminf(fmaxf(v[4] * oscale, -448.f), 448.f), c1 = fminf(fmaxf(v[5] * oscale, -448.f), 448.f), c2 = fminf(fmaxf(v[6] * oscale, -448.f), 448.f), c3 = fminf(fmaxf(v[7] * oscale, -448.f), 448.f);
                      int t_ = __builtin_amdgcn_cvt_pk_fp8_f32(c0, c1, 0, false); t_ = __builtin_amdgcn_cvt_pk_fp8_f32(c2, c3, t_, true); w8.y = (unsigned)t_; }
                    *(u32x2*)((unsigned char*)O + (size_t)(row0 + ai * HALF + m * 16) * ldc + col0) = w8; }
                else { u32x4 w; w.x = cvt_pk_bf16(v[0], v[1]); w.y = cvt_pk_bf16(v[2], v[3]); w.z = cvt_pk_bf16(v[4], v[5]); w.w = cvt_pk_bf16(v[6], v[7]);
                *(u32x4*)rowp = w; } }
    }
};
struct EpiScaled {
    static constexpr bool PERM = true, AFTER_DRAIN = false;
    bf16_t* O; int ldc; float inv;
    __device__ __forceinline__ void operator()(const f32x4 (&acc)[2][2][4][2], const Unit& u, int wr, int wc, int fr, int fq) const {
        const int row0 = u.pm * BM + wr * 64 + fr, col0 = u.pn * BM + wc * 32 + 8 * fq;
#pragma unroll
        for (int ai = 0; ai < 2; ++ai)
#pragma unroll
            for (int m = 0; m < 4; ++m) { bf16_t* rowp = O + (size_t)(row0 + ai * HALF + m * 16) * ldc + col0;
#pragma unroll
                for (int bj = 0; bj < 2; ++bj) { const f32x4 v0 = acc[ai][bj][m][0] * inv, v1 = acc[ai][bj][m][1] * inv;
                    u32x4 w; w.x = cvt_pk_bf16(v0[0], v0[1]); w.y = cvt_pk_bf16(v0[2], v0[3]); w.z = cvt_pk_bf16(v1[0], v1[1]); w.w = cvt_pk_bf16(v1[2], v1[3]);
                    *(u32x4*)(rowp + bj * HALF) = w; } }
    }
};
struct EpiVT8 {
    static constexpr bool PERM = true, AFTER_DRAIN = false;
    unsigned char* O; int ldb; float scale;
    __device__ __forceinline__ void operator()(const f32x4 (&acc)[2][2][4][2], const Unit& u, int wr, int wc, int fr, int fq) const {
        const int row0 = u.pm * BM + wr * 64 + fr;
#pragma unroll
        for (int ai = 0; ai < 2; ++ai)
#pragma unroll
            for (int m = 0; m < 4; ++m) { unsigned char* rowp = O + (size_t)(row0 + ai * HALF + m * 16) * ldb;
#pragma unroll
                for (int bj = 0; bj < 2; ++bj)
#pragma unroll
                    for (int n = 0; n < 2; ++n) { const int col = u.pn * BM + bj * HALF + wc * 32 + 8 * fq + 4 * n, g4 = (col >> 2) & 15;
                        const int pos = (g4 & 1) * 32 + (g4 >> 3) * 16 + ((g4 >> 1) & 3) * 4;
                        const f32x4 v = acc[ai][bj][m][n] * scale;
                        float c0 = fminf(fmaxf(v[0], -448.f), 448.f), c1 = fminf(fmaxf(v[1], -448.f), 448.f), c2 = fminf(fmaxf(v[2], -448.f), 448.f), c3 = fminf(fmaxf(v[3], -448.f), 448.f);
                        int t_ = __builtin_amdgcn_cvt_pk_fp8_f32(c0, c1, 0, false); t_ = __builtin_amdgcn_cvt_pk_fp8_f32(c2, c3, t_, true);
                        *(unsigned*)(rowp + (col & ~63) + pos) = (unsigned)t_; } }
    }
};

template <class Epi, class Sched, bool ALIGN_EPI = false, bool SP2 = false, bool FP8 = false>
__device__ __forceinline__ void gemm_phase(PG8_LAS unsigned char* lds, const Gemm g, const Sched& S, const Epi& E, const int wave0) {
    const int tid_ = wave0 * 64 + lane_opaque();
    const int tid = tid_, wid = __builtin_amdgcn_readfirstlane(tid >> 6), lane = tid & 63, wr = wid >> 2, wc = wid & 3, fr = lane & 15, fq = lane >> 4;
    const int K = g.K, nt = K / BK;
    unsigned voffA[2], voffB[2];
#pragma unroll
    for (int i = 0; i < 2; ++i) { int R, C; stage_rc(tid * 16 + i * 8192, R, C); const int Rb = Epi::PERM ? ((R & ~31) + perm32(R & 31)) : R;
        voffA[i] = (unsigned)(R * K + C) * 2u; voffB[i] = (unsigned)(Rb * K + C) * 2u; }
    const size_t kstep = (size_t)(BK * 2);
    const size_t hstep = (size_t)HALF * K * 2;
    const size_t tstep = 2 * hstep;
    const unsigned ldsw = (unsigned)wid * 1024u;
    const int aoff = lds_byte(wr * 64 + fr, fq * 8), boff = lds_byte(wc * 32 + fr, fq * 8);
#define PG8_SA(b, h) (((b) * 2 + (h)) * HTB)
#define PG8_SB(b, h) ((4 + (b) * 2 + (h)) * HTB)
#define PG8_STAGE(bufoff, gbase, voff) do { _Pragma("unroll") for (int _i = 0; _i < 2; ++_i) \
        __builtin_amdgcn_global_load_lds((const unsigned*)((const char*)(gbase) + (voff)[_i]), (PG8_LAS unsigned*)(lds + (bufoff) + ldsw + _i * 8192), 16, 0, 0); } while (0)
#define PG8_LDA(dst, b, h) do { _Pragma("unroll") for (int m = 0; m < 4; ++m) _Pragma("unroll") for (int k = 0; k < 2; ++k) dst[m][k] = *(const PG8_LAS bf16x8*)(lds + PG8_SA(b, h) + aoff + m * 2048 + k * 1024); } while (0)
#define PG8_LDB(dst, b, h) do { _Pragma("unroll") for (int n = 0; n < 2; ++n) _Pragma("unroll") for (int k = 0; k < 2; ++k) dst[n][k] = *(const PG8_LAS bf16x8*)(lds + PG8_SB(b, h) + boff + n * 2048 + k * 1024); } while (0)
#define PG8_MMA(ai, bj, At, Bt) do { __builtin_amdgcn_s_setprio(1); \
        if constexpr (FP8) { typedef int i32x8_t __attribute__((ext_vector_type(8))); typedef int i32x4_t __attribute__((ext_vector_type(4))); \
            _Pragma("unroll") for (int m = 0; m < 4; ++m) _Pragma("unroll") for (int n = 0; n < 2; ++n) { \
                const i32x4_t b0_ = __builtin_bit_cast(i32x4_t, Bt[n][0]), b1_ = __builtin_bit_cast(i32x4_t, Bt[n][1]), a0_ = __builtin_bit_cast(i32x4_t, At[m][0]), a1_ = __builtin_bit_cast(i32x4_t, At[m][1]); \
                const i32x8_t bb_ = {b0_[0], b0_[1], b0_[2], b0_[3], b1_[0], b1_[1], b1_[2], b1_[3]}, aa_ = {a0_[0], a0_[1], a0_[2], a0_[3], a1_[0], a1_[1], a1_[2], a1_[3]}; \
                asm volatile("v_mfma_f32_16x16x128_f8f6f4 %0, %1, %2, %0" : "+v"(acc[ai][bj][m][n]) : "v"(bb_), "v"(aa_)); } } \
        else { _Pragma("unroll") for (int m = 0; m < 4; ++m) _Pragma("unroll") for (int n = 0; n < 2; ++n) _Pragma("unroll") for (int k = 0; k < 2; ++k) \
        acc[ai][bj][m][n] = __builtin_amdgcn_mfma_f32_16x16x32_bf16(Bt[n][k], At[m][k], acc[ai][bj][m][n], 0, 0, 0); } __builtin_amdgcn_s_setprio(0); } while (0)
#define PG8_WAIT_V(n) asm volatile("s_waitcnt vmcnt(" #n ")" ::: "memory")
#define PG8_WAIT_L(n) asm volatile("s_waitcnt lgkmcnt(" #n ")" ::: "memory")
#define PG8_BAR __builtin_amdgcn_s_barrier()
#define PG8_SCHED __builtin_amdgcn_sched_barrier(0)
    Unit cur, nxt; int ui = 0;
    if (!S.next(0, cur)) return;
    f32x4 acc[2][2][4][2];
#pragma unroll
    for (int a = 0; a < 2; ++a)
#pragma unroll
        for (int b = 0; b < 2; ++b)
#pragma unroll
            for (int m = 0; m < 4; ++m)
#pragma unroll
                for (int n = 0; n < 2; ++n) acc[a][b][m][n] = (f32x4){0.f, 0.f, 0.f, 0.f};
    bf16x8 At[4][2], B0[2][2], B1[2][2];
    const char* cA = (const char*)g.A + (size_t)cur.pm * tstep; const char* cB = (const char*)g.Bt + (size_t)cur.pn * tstep;
    S.a_ready(cur);
    if constexpr (SP2) {
        PG8_STAGE(PG8_SB(0, 0), cB, voffB); PG8_STAGE(PG8_SB(0, 1), cB + hstep, voffB); PG8_STAGE(PG8_SA(0, 0), cA, voffA); PG8_STAGE(PG8_SA(0, 1), cA + hstep, voffA);
        if (wr == 1) PG8_BAR;
        PG8_WAIT_V(2); PG8_BAR;
        PG8_STAGE(PG8_SB(1, 0), cB + kstep, voffB); PG8_STAGE(PG8_SA(1, 0), cA + kstep, voffA); PG8_STAGE(PG8_SB(1, 1), cB + hstep + kstep, voffB);
        PG8_WAIT_V(6); PG8_BAR;
    } else {
        PG8_STAGE(PG8_SB(0, 0), cB, voffB); PG8_STAGE(PG8_SA(0, 0), cA, voffA); PG8_STAGE(PG8_SB(0, 1), cB + hstep, voffB); PG8_STAGE(PG8_SA(0, 1), cA + hstep, voffA);
        if (wr == 1) PG8_BAR;
        PG8_WAIT_V(4); PG8_BAR;
        PG8_STAGE(PG8_SB(1, 0), cB + kstep, voffB); PG8_STAGE(PG8_SA(1, 0), cA + kstep, voffA); PG8_STAGE(PG8_SB(1, 1), cB + hstep + kstep, voffB);
        PG8_WAIT_V(6); PG8_BAR;
    }
    for (;;) {
        const bool has_next = S.next(ui + 1, nxt);
        const char* nA = has_next ? (const char*)g.A + (size_t)nxt.pm * tstep : cA; const char* nB = has_next ? (const char*)g.Bt + (size_t)nxt.pn * tstep : cB;
#pragma unroll 1
        for (int t = 0; t < nt; t += 2) {
            if constexpr (FP8) asm volatile("" : "+v"(voffA[0]), "+v"(voffA[1]), "+v"(voffB[0]), "+v"(voffB[1]));
            const bool last = (t == nt - 2);
            const char* a1 = cA + (size_t)(t + 1) * kstep;
            const char* a2 = last ? nA : cA + (size_t)(t + 2) * kstep; const char* b2 = last ? nB : cB + (size_t)(t + 2) * kstep;
            const char* a3 = a2 + kstep; const char* b3 = b2 + kstep;
            if (last && has_next) S.a_ready(nxt);
            if constexpr (SP2) {
            PG8_LDB(B0, 0, 0); PG8_LDB(B1, 0, 1); PG8_SCHED; PG8_LDA(At, 0, 0); PG8_STAGE(PG8_SA(1, 1), a1 + hstep, voffA);
            PG8_WAIT_V(8); PG8_WAIT_L(0); PG8_BAR; PG8_MMA(0, 0, At, B0); PG8_MMA(0, 1, At, B1); PG8_BAR; PG8_SCHED;
            PG8_LDA(At, 0, 1); PG8_STAGE(PG8_SB(0, 0), b2, voffB); PG8_STAGE(PG8_SB(0, 1), b2 + hstep, voffB); PG8_STAGE(PG8_SA(0, 0), a2, voffA);
            PG8_WAIT_V(8); PG8_WAIT_L(0); PG8_BAR; PG8_MMA(1, 0, At, B0); PG8_MMA(1, 1, At, B1); PG8_BAR; PG8_SCHED;
            PG8_LDB(B0, 1, 0); PG8_LDB(B1, 1, 1); PG8_SCHED; PG8_LDA(At, 1, 0); PG8_STAGE(PG8_SA(0, 1), a2 + hstep, voffA);
            PG8_WAIT_V(8); PG8_WAIT_L(0); PG8_BAR; PG8_MMA(0, 0, At, B0); PG8_MMA(0, 1, At, B1); PG8_BAR; PG8_SCHED;
            PG8_LDA(At, 1, 1); PG8_STAGE(PG8_SB(1, 0), b3, voffB); PG8_STAGE(PG8_SB(1, 1), b3 + hstep, voffB); PG8_STAGE(PG8_SA(1, 0), a3, voffA);
            PG8_WAIT_V(8); PG8_WAIT_L(0); PG8_BAR; PG8_MMA(1, 0, At, B0); PG8_MMA(1, 1, At, B1); PG8_BAR; PG8_SCHED;
            } else {
            PG8_LDB(B0, 0, 0); PG8_SCHED; PG8_LDA(At, 0, 0); PG8_STAGE(PG8_SA(1, 1), a1 + hstep, voffA);
            PG8_WAIT_L(8); PG8_BAR; PG8_WAIT_L(0); PG8_MMA(0, 0, At, B0); PG8_BAR; PG8_SCHED;
            PG8_LDB(B1, 0, 1); PG8_STAGE(PG8_SB(0, 0), b2, voffB);
            PG8_BAR; PG8_WAIT_L(0); PG8_MMA(0, 1, At, B1); PG8_BAR;
            PG8_LDA(At, 0, 1); PG8_STAGE(PG8_SA(0, 0), a2, voffA);
            PG8_BAR; PG8_WAIT_L(0); PG8_MMA(1, 0, At, B0); PG8_BAR; PG8_SCHED;
            PG8_STAGE(PG8_SB(0, 1), b2 + hstep, voffB);
            PG8_WAIT_V(6); PG8_BAR; PG8_MMA(1, 1, At, B1); PG8_BAR;
            PG8_LDB(B0, 1, 0); PG8_SCHED; PG8_LDA(At, 1, 0); PG8_STAGE(PG8_SA(0, 1), a2 + hstep, voffA);
            PG8_WAIT_L(8); PG8_BAR; PG8_WAIT_L(0); PG8_MMA(0, 0, At, B0); PG8_BAR; PG8_SCHED;
            PG8_LDB(B1, 1, 1); PG8_STAGE(PG8_SB(1, 0), b3, voffB);
            PG8_BAR; PG8_WAIT_L(0); PG8_MMA(0, 1, At, B1); PG8_BAR;
            PG8_LDA(At, 1, 1); PG8_STAGE(PG8_SA(1, 0), a3, voffA);
            PG8_BAR; PG8_WAIT_L(0); PG8_MMA(1, 0, At, B0); PG8_BAR; PG8_SCHED;
            PG8_STAGE(PG8_SB(1, 1), b3 + hstep, voffB);
            PG8_WAIT_V(6); PG8_BAR; PG8_MMA(1, 1, At, B1); PG8_BAR;
            }
        }
        if constexpr (ALIGN_EPI) { if (wr == 0) PG8_BAR; }
        if constexpr (FP8) asm volatile("s_nop 15\n\ts_nop 15" ::: "memory");
        if constexpr (!Epi::AFTER_DRAIN) { const int l2_ = lane_opaque(); E(acc, cur, wr, wc, l2_ & 15, l2_ >> 4); S.done(cur); }
        if (!has_next) break;
#pragma unroll
        for (int a = 0; a < 2; ++a)
#pragma unroll
            for (int b = 0; b < 2; ++b)
#pragma unroll
                for (int m = 0; m < 4; ++m)
#pragma unroll
                    for (int n = 0; n < 2; ++n) acc[a][b][m][n] = (f32x4){0.f, 0.f, 0.f, 0.f};
        cur = nxt; cA = nA; cB = nB; ++ui;
        if constexpr (ALIGN_EPI) { if (wr == 1) PG8_BAR; }
    }
    PG8_WAIT_V(0);
    if constexpr (!ALIGN_EPI) { if (wr == 0) PG8_BAR; }
    PG8_BAR;
    if constexpr (Epi::AFTER_DRAIN) { E.fused(acc, cur, wr, wc, fr, fq, lds, wid, lane); S.done(cur); }
#undef PG8_SA
#undef PG8_SB
#undef PG8_STAGE
#undef PG8_LDA
#undef PG8_LDB
#undef PG8_MMA
#undef PG8_WAIT_V
#undef PG8_WAIT_L
#undef PG8_BAR
#undef PG8_SCHED
}
}

__device__ __forceinline__ float wave_sum(float v) {
    const int l = lane_opaque();
#pragma unroll
    for (int o = 1; o < 64; o <<= 1) v += __builtin_bit_cast(float, __builtin_amdgcn_ds_bpermute((l ^ o) << 2, __builtin_bit_cast(int, v)));
    return v;
}
__device__ __forceinline__ float wave_max(float v) {
    const int l = lane_opaque();
#pragma unroll
    for (int o = 1; o < 64; o <<= 1) v = fmaxf(v, __builtin_bit_cast(float, __builtin_amdgcn_ds_bpermute((l ^ o) << 2, __builtin_bit_cast(int, v))));
    return v;
}
__device__ __forceinline__ float silu_f(float v) { return v / (1.f + __expf(-v)); }

struct Args {
    const float* x; const float* c; const float* rel_bias; const float* ada_w; const float* ada_b; const float* norm_g;
    const float* moba_w_qkv; const float* moba_w_o; const float* diff_w_qkv; const float* diff_w_o;
    const float* diff_lambda; const float* diff_subln_g; const float* ffn_w_in; const float* ffn_w_out;
    float* out; unsigned char* ws;
};

__device__ __forceinline__ int t5_bucket(int rel) {
    const int n = rel < 0 ? 0 : rel;
    const float nf = (float)(n < 1 ? 1 : n);
    int large = 16 + (int)(logf(nf / 16.0f) / 4.852030263919617f * 16.0f);
    large = large < 31 ? large : 31;
    return n < 16 ? n : large;
}

__device__ __forceinline__ void p_mod(const Args& a, LAS unsigned char* lds, int blk, int G, int tid, int wave, int lane) {
    LAS float* sc = (LAS float*)lds;
    LAS float* red = sc + 2048;
    for (int i = tid; i < 2048; i += NTHR) sc[i] = silu_f(a.c[i]);
    __syncthreads();
    float* mod = (float*)(a.ws + WS_MOD);
    for (int it = blk; it < 192; it += G) {
        const int l = it / 96, j0 = (it % 96) * 64;
        const float* w = a.ada_w + (size_t)l * D * 6144 + j0 + lane;
        float s0 = 0.f, s1 = 0.f;
#pragma unroll 1
        for (int kb = wave * 128; kb < wave * 128 + 128; kb += 32) { float wv[32];
#pragma unroll
            for (int k = 0; k < 32; ++k) wv[k] = w[(size_t)(kb + k) * 6144];
#pragma unroll
            for (int k = 0; k < 32; ++k) { s0 += sc[kb + k] * wv[k]; s1 += sc[1024 + kb + k] * wv[k]; } }
        red[(wave * 2 + 0) * 64 + lane] = s0; red[(wave * 2 + 1) * 64 + lane] = s1;
        __syncthreads();
        if (tid < 128) { const int bb = tid >> 6, cl = tid & 63; float sum = 0.f;
#pragma unroll
            for (int w8 = 0; w8 < 8; ++w8) sum += red[(w8 * 2 + bb) * 64 + cl];
            mod[(l * 2 + bb) * 6144 + j0 + cl] = sum + a.ada_b[l * 6144 + j0 + cl]; }
        __syncthreads();
    }
    float* bt = (float*)(a.ws + WS_BIAST);
    for (int i = blk * NTHR + tid; i < 8 * 2304; i += G * NTHR) { const int h = i / 2304, rel = 2047 - (i % 2304); bt[i] = rel >= 0 ? a.rel_bias[t5_bucket(rel) * NH + h] * LOG2E : 0.f; }
}

__device__ __forceinline__ void transpose_item(const float* W, int K, int N, int k0, int n0, bf16* WT, int dst_row0, LAS float* scr, int lane) {
    float tv[32];
#pragma unroll
    for (int i = 0; i < 32; ++i) tv[i] = W[(size_t)(k0 + 2 * i + (lane >> 5)) * N + n0 + (lane & 31)];
#pragma unroll
    for (int i = 0; i < 32; ++i) scr[(2 * i + (lane >> 5)) * 33 + (lane & 31)] = tv[i];
    asm volatile("s_waitcnt lgkmcnt(0)" ::: "memory");
    const int c = lane & 7;
#pragma unroll
    for (int j = 0; j < 4; ++j) { const int n = (lane >> 3) + 8 * j; const LAS float* sp = scr + (8 * c) * 33 + n;
        u32x4 o; o.x = pk2(sp[0 * 33], sp[1 * 33]); o.y = pk2(sp[2 * 33], sp[3 * 33]); o.z = pk2(sp[4 * 33], sp[5 * 33]); o.w = pk2(sp[6 * 33], sp[7 * 33]);
        *(u32x4*)(WT + (size_t)(dst_row0 + n) * K + k0 + 8 * c) = o; }
    asm volatile("s_waitcnt lgkmcnt(0)" ::: "memory");
}
constexpr float F8_SH = 8.0f;
constexpr float F8_SA = 4.0f, F8_SB = 256.0f;
__device__ __forceinline__ unsigned pk4_fp8(float a, float b, float c, float d) {
    a = fminf(fmaxf(a, -448.f), 448.f); b = fminf(fmaxf(b, -448.f), 448.f); c = fminf(fmaxf(c, -448.f), 448.f); d = fminf(fmaxf(d, -448.f), 448.f);
    int w = __builtin_amdgcn_cvt_pk_fp8_f32(a, b, 0, false); w = __builtin_amdgcn_cvt_pk_fp8_f32(c, d, w, true); return (unsigned)w;
}
__device__ __forceinline__ void transpose_item_fp8(const float* W, int K, int N, int k0, int n0, unsigned char* WT, int dst_row0, LAS float* scr, int lane) {
    float tv[32];
#pragma unroll
    for (int i = 0; i < 32; ++i) tv[i] = W[(size_t)(k0 + 2 * i + (lane >> 5)) * N + n0 + (lane & 31)];
#pragma unroll
    for (int i = 0; i < 32; ++i) scr[(2 * i + (lane >> 5)) * 33 + (lane & 31)] = tv[i];
    asm volatile("s_waitcnt lgkmcnt(0)" ::: "memory");
#pragma unroll
    for (int j = 0; j < 2; ++j) { const int ch = lane + 64 * j, n = ch >> 2, c = ch & 3; const LAS float* sp = scr + (16 * c) * 33 + n;
        u32x4 o;
        o.x = pk4_fp8(sp[0 * 33] * F8_SB, sp[1 * 33] * F8_SB, sp[2 * 33] * F8_SB, sp[3 * 33] * F8_SB);
        o.y = pk4_fp8(sp[4 * 33] * F8_SB, sp[5 * 33] * F8_SB, sp[6 * 33] * F8_SB, sp[7 * 33] * F8_SB);
        o.z = pk4_fp8(sp[8 * 33] * F8_SB, sp[9 * 33] * F8_SB, sp[10 * 33] * F8_SB, sp[11 * 33] * F8_SB);
        o.w = pk4_fp8(sp[12 * 33] * F8_SB, sp[13 * 33] * F8_SB, sp[14 * 33] * F8_SB, sp[15 * 33] * F8_SB);
        *(u32x4*)(WT + (size_t)(dst_row0 + n) * K + k0 + 16 * c) = o; }
    asm volatile("s_waitcnt lgkmcnt(0)" ::: "memory");
}
__device__ __forceinline__ void p_weights(const Args& a, LAS unsigned char* lds, int gw, int ngw, int wave, int lane) {
    LAS float* scr = (LAS float*)(lds + wave * 16384);
    constexpr int I_QKV = (D / 64) * (3 * D / 32), I_O = (D / 64) * (D / 32), I_IN = (D / 64) * (2 * DFF / 32), I_OUT = (DFF / 64) * (D / 32);
    constexpr int PER_L = I_QKV + I_O + I_IN + I_OUT;
    for (int it = gw; it < 2 * PER_L; it += ngw) {
        const int l = it / PER_L; int r = it % PER_L;
        unsigned char* wl = a.ws + WS_W + (size_t)l * WL_STRIDE;
        if (r < I_QKV) { const int nb = 3 * D / 32, kb = r / nb, n0 = (r % nb) * 32; transpose_item(l == 0 ? a.moba_w_qkv : a.diff_w_qkv, D, 3 * D, kb * 64, n0, (bf16*)(wl + WO_QKV), n0, scr, lane); continue; } r -= I_QKV;
        if (r < I_O) continue; r -= I_O;
        if (r < I_IN) { const int nb = 2 * DFF / 32, kb = r / nb, n0 = (r % nb) * 32;
            const int isu = n0 >= DFF ? 1 : 0, nn = n0 - isu * DFF, dst = 256 * (nn / 128) + 128 * isu + (nn % 128);
            transpose_item_fp8(a.ffn_w_in + (size_t)l * D * 2 * DFF, D, 2 * DFF, kb * 64, n0, wl + WO_IN, dst, scr, lane); continue; } r -= I_IN;
        { const int nb = D / 32, kb = r / nb, n0 = (r % nb) * 32; transpose_item_fp8(a.ffn_w_out + (size_t)l * DFF * D, DFF, D, kb * 64, n0, wl + WO_OUT, n0, scr, lane); }
    }
}

__device__ __forceinline__ void p_wo_perm(const Args& a, int gtid, int gthreads) {
    for (int idx = gtid; idx < 2 * 128 * D; idx += gthreads) {
        const int l = idx / (128 * D), rem = idx % (128 * D), c = rem / D, n = rem % D;
        const float* W = l == 0 ? a.moba_w_o : a.diff_w_o;
        float v[8];
#pragma unroll
        for (int e = 0; e < 8; ++e) { const int kp = 8 * c + e, hh = kp >> 7, wi = kp & 127, k = hh * 128 + (wi & 3) * 32 + (wi >> 2); v[e] = W[(size_t)k * D + n]; }
        u32x4 o; o.x = pk2(v[0], v[1]); o.y = pk2(v[2], v[3]); o.z = pk2(v[4], v[5]); o.w = pk2(v[6], v[7]);
        *(u32x4*)((bf16*)(a.ws + WS_W + (size_t)l * WL_STRIDE + WO_O) + (size_t)n * D + 8 * c) = o;
    }
}

__device__ __forceinline__ void p_norm_in(const float* X, const float* g, const float* sh, const float* sc, bf16* H, int gw, int ngw, int lane) {
    for (int m = gw; m < M; m += ngw) {
        const int b = m / SEQ;
        const f32x4* xr = (const f32x4*)(X + (size_t)m * D) + lane;
        f32x4 v[4]; float s = 0.f;
#pragma unroll
        for (int j = 0; j < 4; ++j) { v[j] = xr[64 * j]; s += (v[j].x * v[j].x + v[j].y * v[j].y) + (v[j].z * v[j].z + v[j].w * v[j].w); }
        const float r = 1.0f / sqrtf(wave_sum(s) * (1.f / D) + RMS_EPS);
        u32x2* o = (u32x2*)(H + (size_t)m * D) + lane;
#pragma unroll
        for (int j = 0; j < 4; ++j) {
            const f32x4 gg = ((const f32x4*)g)[lane + 64 * j], s1 = ((const f32x4*)(sc + b * 6144))[lane + 64 * j], s0 = ((const f32x4*)(sh + b * 6144))[lane + 64 * j];
            const f32x4 h = v[j] * r * gg * (1.0f + s1) + s0;
            u32x2 w; w.x = pk2(h.x, h.y); w.y = pk2(h.z, h.w); o[64 * j] = w;
        }
    }
}
template <bool XIN_BF, bool XOUT_BF, bool H_FP8>
__device__ __forceinline__ void p_post(const void* Xin, const bf16* Y, const float* g1, const float* gate, void* Xout,
                                       const float* g2, const float* sh, const float* sc, bf16* H, int gw, int ngw, int lane) {
    for (int m = gw; m < M; m += ngw) {
        const int b = m / SEQ;
        const u32x2* yr = (const u32x2*)(Y + (size_t)m * D) + lane;
        f32x4 y[4], xv[4]; float s = 0.f;
#pragma unroll
        for (int j = 0; j < 4; ++j) { const u32x2 w = yr[64 * j]; y[j] = (f32x4){bflo(w.x), bfhi(w.x), bflo(w.y), bfhi(w.y)};
            if (XIN_BF) { const u32x2 xw = ((const u32x2*)((const bf16*)Xin + (size_t)m * D))[lane + 64 * j]; xv[j] = (f32x4){bflo(xw.x), bfhi(xw.x), bflo(xw.y), bfhi(xw.y)}; }
            else xv[j] = ((const f32x4*)((const float*)Xin + (size_t)m * D))[lane + 64 * j];
            s += (y[j].x * y[j].x + y[j].y * y[j].y) + (y[j].z * y[j].z + y[j].w * y[j].w); }
        const float r = 1.0f / sqrtf(wave_sum(s) * (1.f / D) + RMS_EPS);
        float s2 = 0.f;
#pragma unroll
        for (int j = 0; j < 4; ++j) {
            const f32x4 gg = ((const f32x4*)g1)[lane + 64 * j], gt = ((const f32x4*)(gate + b * 6144))[lane + 64 * j];
            xv[j] = xv[j] + gt * (y[j] * r * gg);
            s2 += (xv[j].x * xv[j].x + xv[j].y * xv[j].y) + (xv[j].z * xv[j].z + xv[j].w * xv[j].w);
            if (XOUT_BF) { u32x2 w; w.x = pk2(xv[j].x, xv[j].y); w.y = pk2(xv[j].z, xv[j].w); ((u32x2*)((bf16*)Xout + (size_t)m * D))[lane + 64 * j] = w; }
            else ((f32x4*)((float*)Xout + (size_t)m * D))[lane + 64 * j] = xv[j];
        }
        if (H) {
            const float r2 = 1.0f / sqrtf(wave_sum(s2) * (1.f / D) + RMS_EPS);
            u32x2* o = (u32x2*)(H + (size_t)m * D) + lane;
#pragma unroll
            for (int j = 0; j < 4; ++j) {
                const f32x4 gg = ((const f32x4*)g2)[lane + 64 * j], s1 = ((const f32x4*)(sc + b * 6144))[lane + 64 * j], s0 = ((const f32x4*)(sh + b * 6144))[lane + 64 * j];
                const f32x4 h = xv[j] * r2 * gg * (1.0f + s1) + s0;
                if (H_FP8) ((unsigned*)((unsigned char*)H + (size_t)m * D))[lane + 64 * j] = pk4_fp8(h.x * F8_SA, h.y * F8_SA, h.z * F8_SA, h.w * F8_SA);
                else { u32x2 w; w.x = pk2(h.x, h.y); w.y = pk2(h.z, h.w); o[64 * j] = w; }
            }
        }
    }
}

__device__ __forceinline__ void p_kmean(const bf16* Kb, float* kmean, LAS unsigned char* lds, int blk, int G, int tid, int wave, int lane) {
    LAS float* red = (LAS float*)lds;
    for (int it = blk; it < BATCH * NH * 32; it += G) {
        const int b = it >> 8, h = (it >> 5) & 7, kb = it & 31;
        const bf16* p = Kb + ((size_t)b * SEQ + kb * 256 + wave * 32) * D + h * HD + 2 * lane;
        float s0 = 0.f, s1 = 0.f;
#pragma unroll 8
        for (int r = 0; r < 32; ++r) { const unsigned w = *(const unsigned*)(p + (size_t)r * D); s0 += bflo(w); s1 += bfhi(w); }
        red[wave * 128 + 2 * lane] = s0; red[wave * 128 + 2 * lane + 1] = s1;
        __syncthreads();
        if (tid < 128) { float sum = 0.f;
#pragma unroll
            for (int w8 = 0; w8 < 8; ++w8) sum += red[w8 * 128 + tid];
            kmean[(size_t)it * 128 + tid] = sum * (1.0f / 256.0f); }
        __syncthreads();
    }
}
__device__ __forceinline__ void p_gate(const bf16* Qb, const float* kmean, unsigned* sel, unsigned* cnt, unsigned short* lists, LAS unsigned char* lds, int blk, int G, int tid, int wave, int lane) {
    LAS float* km = (LAS float*)lds;
    for (int it = blk; it < 256; it += G) {
        const int bh = it >> 4, span = it & 15, b = bh >> 3, h = bh & 7;
        __syncthreads();
        for (int i = tid; i < 1024; i += NTHR) ((LAS f32x4*)km)[i] = ((const f32x4*)(kmean + (size_t)bh * 4096))[i];
        __syncthreads();
        const int q = span * 512 + wave * 64 + lane, own = (span * 512 + wave * 64) >> 8;
        unsigned mask;
        if (own <= 3) mask = (1u << own) - 1u;
        else {
            float qf[128];
            const u32x4* qp = (const u32x4*)(Qb + ((size_t)b * SEQ + q) * D + h * HD);
#pragma unroll
            for (int c = 0; c < 16; ++c) { const u32x4 w = qp[c]; qf[c * 8 + 0] = bflo(w.x); qf[c * 8 + 1] = bfhi(w.x); qf[c * 8 + 2] = bflo(w.y); qf[c * 8 + 3] = bfhi(w.y);
                qf[c * 8 + 4] = bflo(w.z); qf[c * 8 + 5] = bfhi(w.z); qf[c * 8 + 6] = bflo(w.w); qf[c * 8 + 7] = bfhi(w.w); }
            float b0 = -3e38f, b1 = -3e38f, b2 = -3e38f; int i0 = 0, i1 = 0, i2 = 0;
#pragma unroll 1
            for (int n = 0; n < own; ++n) {
                float g0 = 0.f, g1 = 0.f, g2 = 0.f, g3 = 0.f;
#pragma unroll
                for (int d = 0; d < 128; d += 4) { const f32x4 kv = *(LAS f32x4*)(km + n * 128 + d); g0 += qf[d] * kv.x; g1 += qf[d + 1] * kv.y; g2 += qf[d + 2] * kv.z; g3 += qf[d + 3] * kv.w; }
                const float g = (g0 + g1) + (g2 + g3);
                if (g > b0) { b2 = b1; i2 = i1; b1 = b0; i1 = i0; b0 = g; i0 = n; }
                else if (g > b1) { b2 = b1; i2 = i1; b1 = g; i1 = n; }
                else if (g > b2) { b2 = g; i2 = n; }
            }
            mask = (1u << i0) | (1u << i1) | (1u << i2);
        }
        sel[(size_t)bh * SEQ + q] = mask;
        unsigned mycnt = 0u;
        for (int j = 0; j < own; ++j) { const unsigned long long bl = __ballot((mask >> j) & 1u); if (lane == j) mycnt = (unsigned)__popcll(bl); }
        unsigned base = 0u;
        if (lane < own && mycnt) base = __hip_atomic_fetch_add(cnt + bh * 32 + lane, mycnt, __ATOMIC_RELAXED, __HIP_MEMORY_SCOPE_AGENT);
        for (int j = 0; j < own; ++j) { const unsigned long long bl = __ballot((mask >> j) & 1u); const unsigned bj = (unsigned)__builtin_amdgcn_readlane((int)base, j);
            if ((mask >> j) & 1u) lists[((size_t)bh * 32 + j) * 8192 + bj + (unsigned)__popcll(bl & ((1ull << lane) - 1ull))] = (unsigned short)q; }
    }
}

namespace att {
typedef short bf16x8 __attribute__((ext_vector_type(8)));
typedef short s16x4 __attribute__((ext_vector_type(4)));
typedef float f32x16 __attribute__((ext_vector_type(16)));
typedef LAS const char* lcp;
constexpr int PITCH = 1024;
constexpr int SHM_V = 16384, SHM_K = 16384;
constexpr int L_K = 0, L_V = 65536, L_WS = 131072, L_LUT = 133120;
constexpr int LUTN = 2304, RMAXL = 2047, RFAR = 1536;
#define KSWZ(row, colB) ((row) * 256 + ((colB) ^ (((row) & 7) << 4)))
#define SBAR() __builtin_amdgcn_sched_barrier(0)
#define WG_BAR() do { asm volatile("s_waitcnt lgkmcnt(0)" ::: "memory"); __builtin_amdgcn_s_barrier(); asm volatile("" ::: "memory"); } while (0)
__device__ __forceinline__ int v_st(int k, int c) { const int kk = (k & ~0xC) | ((k & 4) << 1) | ((k & 8) >> 1); return ((kk >> 3) * 4 + (c >> 5)) * 512 + ((kk & 7) * 32 + (c & 31)) * 2; }
__device__ __forceinline__ int v_rd_base(int lane) { return ((lane & 3) << 3) | (((lane >> 2) & 3) << 6) | (((lane >> 4) & 1) << 5) | (((lane >> 5) & 1) << 8); }
constexpr int v_rd_off(int d0, int ks, int half) { return d0 * 512 + ks * 4096 + half * 2048; }
__device__ __forceinline__ int crow(int r, int hi) { return (r & 3) + 8 * (r >> 2) + 4 * hi; }
__device__ __forceinline__ unsigned cvtpk(float lo, float hi) { unsigned r; asm volatile("v_cvt_pk_bf16_f32 %0, %1, %2" : "=v"(r) : "v"(lo), "v"(hi)); return r; }

template <int KB, int NDS>
__device__ __forceinline__ void qkt(f32x16& p0, f32x16& p1, lcp K_lds, int r32, int hi, int coff, const bf16x8* qr) {
    lcp kb[4];
#pragma unroll
    for (int dd = 0; dd < 4; ++dd) kb[dd] = K_lds + KB * SHM_K + KSWZ(r32, (dd * 16 + hi * 8) * 2) + coff;
#pragma unroll
    for (int d0 = 0; d0 < NDS; ++d0) { lcp a = kb[d0 & 3] + (d0 >> 2) * 128;
        const bf16x8 b0 = *(LAS const bf16x8*)a;
        const bf16x8 b1 = *(LAS const bf16x8*)(a + 32 * 256);
        p0 = __builtin_amdgcn_mfma_f32_32x32x16_bf16(b0, qr[d0], p0, 0, 0, 0);
        p1 = __builtin_amdgcn_mfma_f32_32x32x16_bf16(b1, qr[d0], p1, 0, 0, 0);
        if (NDS == 8 && (d0 & 1) == 1) SBAR(); }
}
template <int VB>
__device__ __forceinline__ void pv_tile(f32x16* o, int vb0, bf16x8 pa0, bf16x8 pa1, bf16x8 pa2, bf16x8 pa3) {
#define TRRD(dst, off) asm volatile("ds_read_b64_tr_b16 %0, %1 offset:%2" : "=&v"(dst) : "v"(vb0), "i"(off) : "memory")
#define PV_D0(d0) do { s16x4 l0, l1, l2, l3, h0, h1, h2, h3; constexpr int b_ = VB * SHM_V + v_rd_off(d0, 0, 0); \
        TRRD(l0, b_); TRRD(h0, b_ + 2048); TRRD(l1, b_ + 4096); TRRD(h1, b_ + 6144); TRRD(l2, b_ + 8192); TRRD(h2, b_ + 10240); TRRD(l3, b_ + 12288); TRRD(h3, b_ + 14336); \
        asm volatile("s_waitcnt lgkmcnt(0)" ::: "memory"); SBAR(); \
        o[d0] = __builtin_amdgcn_mfma_f32_32x32x16_bf16(pa0, (bf16x8){l0[0], l0[1], l0[2], l0[3], h0[0], h0[1], h0[2], h0[3]}, o[d0], 0, 0, 0); \
        o[d0] = __builtin_amdgcn_mfma_f32_32x32x16_bf16(pa1, (bf16x8){l1[0], l1[1], l1[2], l1[3], h1[0], h1[1], h1[2], h1[3]}, o[d0], 0, 0, 0); \
        o[d0] = __builtin_amdgcn_mfma_f32_32x32x16_bf16(pa2, (bf16x8){l2[0], l2[1], l2[2], l2[3], h2[0], h2[1], h2[2], h2[3]}, o[d0], 0, 0, 0); \
        o[d0] = __builtin_amdgcn_mfma_f32_32x32x16_bf16(pa3, (bf16x8){l3[0], l3[1], l3[2], l3[3], h3[0], h3[1], h3[2], h3[3]}, o[d0], 0, 0, 0); } while (0)
    PV_D0(0); PV_D0(1); PV_D0(2); PV_D0(3);
#undef PV_D0
#undef TRRD
}

template <int NDS>
__device__ __forceinline__ void kread(bf16x8* kf, int kaddr_base, int r32, int hi, int coff) {
#pragma unroll
    for (int d0 = 0; d0 < NDS; ++d0) { const int a = kaddr_base + KSWZ(r32, ((d0 & 3) * 16 + hi * 8) * 2) + coff + (d0 >> 2) * 128;
        asm volatile("ds_read_b128 %0, %1" : "=&v"(kf[2 * d0]) : "v"(a) : "memory");
        asm volatile("ds_read_b128 %0, %1 offset:8192" : "=&v"(kf[2 * d0 + 1]) : "v"(a) : "memory"); }
}
template <int NDS>
__device__ __forceinline__ void kmma(f32x16& p0, f32x16& p1, const bf16x8* kf, const bf16x8* qr) {
#pragma unroll
    for (int d0 = 0; d0 < NDS; ++d0) { p0 = __builtin_amdgcn_mfma_f32_32x32x16_bf16(kf[2 * d0], qr[d0], p0, 0, 0, 0); p1 = __builtin_amdgcn_mfma_f32_32x32x16_bf16(kf[2 * d0 + 1], qr[d0], p1, 0, 0, 0); }
}

__device__ __forceinline__ void pv_tile_pf(f32x16* o, int vb0, bf16x8 pa0, bf16x8 pa1, bf16x8 pa2, bf16x8 pa3) {
#define TRRD(dst, off) asm volatile("ds_read_b64_tr_b16 %0, %1 offset:%2" : "=&v"(dst) : "v"(vb0), "i"(off) : "memory")
#define RD8(S, d0) do { constexpr int b_ = v_rd_off(d0, 0, 0); TRRD(S[0], b_); TRRD(S[1], b_ + 2048); TRRD(S[2], b_ + 4096); TRRD(S[3], b_ + 6144); \
        TRRD(S[4], b_ + 8192); TRRD(S[5], b_ + 10240); TRRD(S[6], b_ + 12288); TRRD(S[7], b_ + 14336); } while (0)
#define MMA4(d0, S) do { \
        o[d0] = __builtin_amdgcn_mfma_f32_32x32x16_bf16(pa0, (bf16x8){S[0][0], S[0][1], S[0][2], S[0][3], S[1][0], S[1][1], S[1][2], S[1][3]}, o[d0], 0, 0, 0); \
        o[d0] = __builtin_amdgcn_mfma_f32_32x32x16_bf16(pa1, (bf16x8){S[2][0], S[2][1], S[2][2], S[2][3], S[3][0], S[3][1], S[3][2], S[3][3]}, o[d0], 0, 0, 0); \
        o[d0] = __builtin_amdgcn_mfma_f32_32x32x16_bf16(pa2, (bf16x8){S[4][0], S[4][1], S[4][2], S[4][3], S[5][0], S[5][1], S[5][2], S[5][3]}, o[d0], 0, 0, 0); \
        o[d0] = __builtin_amdgcn_mfma_f32_32x32x16_bf16(pa3, (bf16x8){S[6][0], S[6][1], S[6][2], S[6][3], S[7][0], S[7][1], S[7][2], S[7][3]}, o[d0], 0, 0, 0); } while (0)
    s16x4 sa[8], sb[8];
    RD8(sa, 0); RD8(sb, 1);
    asm volatile("s_waitcnt lgkmcnt(8)" ::: "memory"); SBAR(); MMA4(0, sa); SBAR();
    RD8(sa, 2);
    asm volatile("s_waitcnt lgkmcnt(8)" ::: "memory"); SBAR(); MMA4(1, sb); SBAR();
    RD8(sb, 3);
    asm volatile("s_waitcnt lgkmcnt(8)" ::: "memory"); SBAR(); MMA4(2, sa); SBAR();
    asm volatile("s_waitcnt lgkmcnt(0)" ::: "memory"); SBAR(); MMA4(3, sb);
#undef MMA4
#undef RD8
#undef TRRD
}
constexpr float THR2 = 8.0f;
__device__ __forceinline__ void partial_sm(f32x16& p0, f32x16& p1, float sh, float& m_reg, float& alpha) {
    float pmax = p0[0];
#pragma unroll
    for (int r = 1; r < 16; ++r) pmax = fmaxf(pmax, p0[r]);
#pragma unroll
    for (int r = 0; r < 16; ++r) pmax = fmaxf(pmax, p1[r]);
    { auto rr = __builtin_amdgcn_permlane32_swap(__float_as_uint(pmax), __float_as_uint(pmax), false, false);
      pmax = fmaxf(__uint_as_float(rr[0]), __uint_as_float(rr[1])); }
    pmax += sh;
    float mn;
    if (__builtin_expect(__all((pmax - m_reg) <= THR2), 1)) { mn = m_reg; alpha = 1.f; }
    else { const bool upd = (pmax - m_reg) > THR2;
        mn = upd ? fmaxf(m_reg, pmax) : m_reg; alpha = upd ? __builtin_amdgcn_exp2f(m_reg - mn) : 1.f; m_reg = mn; }
    const float off = mn - sh;
#pragma unroll
    for (int r = 0; r < 16; ++r) p0[r] = __builtin_amdgcn_exp2f(p0[r] - off);
#pragma unroll
    for (int r = 0; r < 16; ++r) p1[r] = p1[r] - off;
}
__device__ __forceinline__ void finish_sm(f32x16& p0, f32x16& p1, float alpha, float& l_reg, bf16x8& pa0, bf16x8& pa1, bf16x8& pa2, bf16x8& pa3) {
#pragma unroll
    for (int r = 0; r < 16; ++r) p1[r] = __builtin_amdgcn_exp2f(p1[r]);
    float ps = 0.f;
#pragma unroll
    for (int r = 0; r < 16; ++r) ps += p0[r];
#pragma unroll
    for (int r = 0; r < 16; ++r) ps += p1[r];
    { auto rr = __builtin_amdgcn_permlane32_swap(__float_as_uint(ps), __float_as_uint(ps), false, false);
      ps = __uint_as_float(rr[0]) + __uint_as_float(rr[1]); }
    l_reg = l_reg * alpha + ps;
#define PK4(P, B_, OUT) do { unsigned a0 = cvtpk(P[B_+0], P[B_+1]), a1 = cvtpk(P[B_+2], P[B_+3]); \
        unsigned b0 = cvtpk(P[B_+4], P[B_+5]), b1 = cvtpk(P[B_+6], P[B_+7]); \
        auto r0 = __builtin_amdgcn_permlane32_swap(a0, b0, false, false); auto r1 = __builtin_amdgcn_permlane32_swap(a1, b1, false, false); \
        u32x4 w = {r0[0], r1[0], r0[1], r1[1]}; OUT = __builtin_bit_cast(bf16x8, w); } while (0)
    PK4(p0, 0, pa0); PK4(p0, 8, pa1); PK4(p1, 0, pa2); PK4(p1, 8, pa3);
#undef PK4
}
__device__ __forceinline__ void softmax_tile(f32x16& p0, f32x16& p1, float sh, float& m_reg, float& l_reg, float& alpha, bf16x8& pa0, bf16x8& pa1, bf16x8& pa2, bf16x8& pa3) {
    partial_sm(p0, p1, sh, m_reg, alpha); finish_sm(p0, p1, alpha, l_reg, pa0, pa1, pa2, pa3);
}
__device__ __forceinline__ void add_bias_lut(f32x16& p0, f32x16& p1, LAS const float* lut, int dq) {
    LAS const float* bp = lut + (RMAXL - dq);
#pragma unroll
    for (int r = 0; r < 16; ++r) { const int c = (r & 3) + 8 * (r >> 2); p0[r] += bp[c]; p1[r] += bp[c + 32]; if ((r & 3) == 3) asm volatile("" ::: "memory"); }
}
__device__ __forceinline__ void load_bias_lut(f32x16& p0, f32x16& p1, LAS const float* lut, int dq) {
    LAS const float* bp = lut + (RMAXL - dq);
#pragma unroll
    for (int r = 0; r < 16; ++r) { const int c = (r & 3) + 8 * (r >> 2); p0[r] = bp[c]; p1[r] = bp[c + 32]; }
}
__device__ __forceinline__ void causal_mask(f32x16& p0, f32x16& p1, int dq) {
    const float NEG = -__builtin_inff();
#pragma unroll
    for (int r = 0; r < 16; ++r) { const int c = (r & 3) + 8 * (r >> 2); if (dq - c < 0) p0[r] = NEG; if (dq - c - 32 < 0) p1[r] = NEG; }
}
struct DmaOff { unsigned k[2], v[2]; };
__device__ __forceinline__ DmaOff dma_offsets(int wid, int lane) {
    DmaOff d;
#pragma unroll
    for (int i = 0; i < 2; ++i) { const int p = wid * 2 + i;
        { const int row = 4 * p + (lane >> 4), c = (lane & 15) ^ (row & 7); d.k[i] = (unsigned)(row * PITCH * 2 + c * 16); }
        { const int sub = 2 * p + (lane >> 5), kkhi = sub >> 2, cblk = sub & 3, kklo = (lane & 31) >> 2, kk = kkhi * 8 + kklo;
          const int k = (kk & ~0xC) | ((kk & 4) << 1) | ((kk & 8) >> 1), c = cblk * 32 + (lane & 3) * 8; d.v[i] = (unsigned)(k * PITCH * 2 + c * 2); } }
    return d;
}
__device__ __forceinline__ void dma_tile(LAS char* lds, int bf, const bf16* Kc, const bf16* Vc, int k0, const DmaOff& d, int wid) {
    const char* kt = (const char*)Kc + (size_t)k0 * (PITCH * 2); const char* vt = (const char*)Vc + (size_t)k0 * (PITCH * 2);
#pragma unroll
    for (int i = 0; i < 2; ++i) {
        __builtin_amdgcn_global_load_lds((const unsigned*)(kt + d.k[i]), (LAS unsigned*)(lds + L_K + bf * SHM_K + (wid * 2 + i) * 1024), 16, 0, 0);
        __builtin_amdgcn_global_load_lds((const unsigned*)(vt + d.v[i]), (LAS unsigned*)(lds + L_V + bf * SHM_V + (wid * 2 + i) * 1024), 16, 0, 0); }
}
constexpr int L_CF = 142336, L_TAB = 146432, L_FOUND = 148544;
__device__ __forceinline__ void build_lut(LAS char* lds, const float* biasT, int h, int tid) {
    LAS float* lut = (LAS float*)(lds + L_LUT);
    for (int i = tid; i < LUTN; i += 512) lut[i] = biasT[h * LUTN + i];
}

typedef int i32x8v __attribute__((ext_vector_type(8)));
typedef int i32x4v __attribute__((ext_vector_type(4)));
constexpr int SHM_V8 = 8192;
constexpr float F8_SP = 256.0f, F8_SV = 8.0f;
__device__ __forceinline__ unsigned dma_v8_offset(int wid, int lane) { const int row = wid * 16 + (lane >> 2), c = (lane & 3) ^ ((row >> 2) & 3); return (unsigned)(row * M + c * 16); }
__device__ __forceinline__ void dma_tile_k_v8(LAS char* lds, int slot, const bf16* Kc, const unsigned char* V8c, int k0, const DmaOff& d, unsigned v8off, int wid) {
    const char* kt = (const char*)Kc + (size_t)k0 * (PITCH * 2);
#pragma unroll
    for (int i = 0; i < 2; ++i) __builtin_amdgcn_global_load_lds((const unsigned*)(kt + d.k[i]), (LAS unsigned*)(lds + L_K + slot * SHM_K + (wid * 2 + i) * 1024), 16, 0, 0);
    __builtin_amdgcn_global_load_lds((const unsigned*)(V8c + k0 + v8off), (LAS unsigned*)(lds + L_V + slot * SHM_V8 + wid * 1024), 16, 0, 0);
}
__device__ __forceinline__ void pv8(f32x16* o, int a0, int a1, const i32x8v& P8) {
    i32x4v lo0, lo1, lo2, lo3, h0, h1, h2, h3;
    asm volatile("ds_read_b128 %0, %1" : "=&v"(lo0) : "v"(a0) : "memory");            asm volatile("ds_read_b128 %0, %1" : "=&v"(h0) : "v"(a1) : "memory");
    asm volatile("ds_read_b128 %0, %1 offset:2048" : "=&v"(lo1) : "v"(a0) : "memory"); asm volatile("ds_read_b128 %0, %1 offset:2048" : "=&v"(h1) : "v"(a1) : "memory");
    asm volatile("ds_read_b128 %0, %1 offset:4096" : "=&v"(lo2) : "v"(a0) : "memory"); asm volatile("ds_read_b128 %0, %1 offset:4096" : "=&v"(h2) : "v"(a1) : "memory");
    asm volatile("ds_read_b128 %0, %1 offset:6144" : "=&v"(lo3) : "v"(a0) : "memory"); asm volatile("ds_read_b128 %0, %1 offset:6144" : "=&v"(h3) : "v"(a1) : "memory");
#define PV8_MMA(d0, L, H) do { const i32x8v b_ = {L[0], L[1], L[2], L[3], H[0], H[1], H[2], H[3]}; \
        asm volatile("v_mfma_f32_32x32x64_f8f6f4 %0, %1, %2, %0" : "+v"(o[d0]) : "v"(P8), "v"(b_)); } while (0)
    asm volatile("s_waitcnt lgkmcnt(6)" ::: "memory"); PV8_MMA(0, lo0, h0);
    asm volatile("s_waitcnt lgkmcnt(4)" ::: "memory"); PV8_MMA(1, lo1, h1);
    asm volatile("s_waitcnt lgkmcnt(2)" ::: "memory"); PV8_MMA(2, lo2, h2);
    asm volatile("s_waitcnt lgkmcnt(0)" ::: "memory"); PV8_MMA(3, lo3, h3);
#undef PV8_MMA
}
__device__ __forceinline__ void softmax_tile8(f32x16& p0, f32x16& p1, float sh, float& m_reg, float& l_reg, float& alpha, i32x8v& P8) {
    float pmax = p0[0];
#pragma unroll
    for (int r = 1; r < 16; ++r) pmax = fmaxf(pmax, p0[r]);
#pragma unroll
    for (int r = 0; r < 16; ++r) pmax = fmaxf(pmax, p1[r]);
    { auto rr = __builtin_amdgcn_permlane32_swap(__float_as_uint(pmax), __float_as_uint(pmax), false, false);
      pmax = fmaxf(__uint_as_float(rr[0]), __uint_as_float(rr[1])); }
    pmax += sh;
    const float mn = fmaxf(m_reg, pmax); alpha = __builtin_amdgcn_exp2f(m_reg - mn); m_reg = mn;
    const float off = mn - sh - 8.0f;
#pragma unroll
    for (int r = 0; r < 16; ++r) p0[r] = __builtin_amdgcn_exp2f(p0[r] - off);
#pragma unroll
    for (int r = 0; r < 16; ++r) p1[r] = __builtin_amdgcn_exp2f(p1[r] - off);
    float ps = 0.f;
#pragma unroll
    for (int r = 0; r < 16; ++r) ps += p0[r];
#pragma unroll
    for (int r = 0; r < 16; ++r) ps += p1[r];
    { auto rr = __builtin_amdgcn_permlane32_swap(__float_as_uint(ps), __float_as_uint(ps), false, false);
      ps = __uint_as_float(rr[0]) + __uint_as_float(rr[1]); }
    l_reg = l_reg * alpha + ps;
#pragma unroll
    for (int i = 0; i < 4; ++i) { int t_ = __builtin_amdgcn_cvt_pk_fp8_f32(p0[4 * i], p0[4 * i + 1], 0, false); P8[i] = __builtin_amdgcn_cvt_pk_fp8_f32(p0[4 * i + 2], p0[4 * i + 3], t_, true); }
#pragma unroll
    for (int i = 0; i < 4; ++i) { int t_ = __builtin_amdgcn_cvt_pk_fp8_f32(p1[4 * i], p1[4 * i + 1], 0, false); P8[4 + i] = __builtin_amdgcn_cvt_pk_fp8_f32(p1[4 * i + 2], p1[4 * i + 3], t_, true); }
}

template <int VAR> __device__ __forceinline__ void diff_unit(LAS char* lds, int b, int h, int qb, const bf16* Q, const bf16* K, const unsigned char* V8T, bf16* O, const float* relb, const float* biasT,
                                          float lam_full, const float* subg, int tid, int wid, int lane) {
    asm volatile("" : "+v"(lane), "+v"(tid));
    const int r32 = lane & 31, hi = lane >> 5, cm = wid >> 2, w4 = wid & 3;
    const size_t rowbase = (size_t)b * SEQ;
    const int q0 = qb * 128, qw0 = q0 + w4 * 32, qpos = qw0 + r32;
    const bf16* Kc = K + rowbase * PITCH + h * HD; const unsigned char* V8c = V8T + (size_t)(h * HD) * M + rowbase;
    const int NT = (q0 + 128) / 64;
    const DmaOff dmo = dma_offsets(wid, lane);
    const unsigned v8off = dma_v8_offset(wid, lane);
    const int va0 = (int)(unsigned)(uintptr_t)(lds + L_V) + r32 * 64 + (((2 * hi) ^ ((r32 >> 2) & 3)) << 4), va1 = va0 ^ 16;
    LAS float* ws = (LAS float*)(lds + L_WS) + wid * 64;
    LAS const float* lut = (LAS const float*)(lds + L_LUT);
    lcp K_lds = (lcp)(lds + L_K);
    const float b31 = relb[31 * 8 + h] * 1.4426950408889634f;
    build_lut(lds, biasT, h, tid);
    bf16x8 qr[4];
#pragma unroll
    for (int d0 = 0; d0 < 4; ++d0) qr[d0] = *(const bf16x8*)(Q + (rowbase + qpos) * PITCH + h * HD + cm * 64 + d0 * 16 + hi * 8);
    dma_tile_k_v8(lds, 0, Kc, V8c, 0, dmo, v8off, wid);
    dma_tile_k_v8(lds, 1, Kc, V8c, 64, dmo, v8off, wid);
    asm volatile("s_waitcnt vmcnt(0)" ::: "memory");
    WG_BAR();
    float m_reg = -1e30f, l_reg = 0.f; f32x16 o[4] = {};
    f32x16 p0, p1; i32x8v P8 = {0, 0, 0, 0, 0, 0, 0, 0};
    const bool halfB = cm != 0;
    const int kl0 = (int)(unsigned)(uintptr_t)(lds + L_K);
    if (halfB) WG_BAR();
    for (int t = 0; t < NT; ++t) {
        __builtin_amdgcn_s_setprio(2);
        if (VAR != 2 && VAR != 3 && VAR != 7 && VAR != 8) { bf16x8 kf[8];
            kread<4>(kf, kl0 + (t & 3) * SHM_K, r32, hi, cm * 128);
            if (qw0 - (t * 64 + 63) >= RFAR) { p0 = f32x16{}; p1 = f32x16{}; } else load_bias_lut(p0, p1, lut, qpos - t * 64 - 4 * hi);
            if (t > 0) pv8(o, va0 + ((t - 1) & 3) * SHM_V8, va1 + ((t - 1) & 3) * SHM_V8, P8);
            asm volatile("s_waitcnt lgkmcnt(0)" ::: "memory"); SBAR();
            kmma<4>(p0, p1, kf, qr); } else { p0 = f32x16{}; p1 = f32x16{}; asm volatile("" : "+v"(p0), "+v"(p1)); }
        __builtin_amdgcn_s_setprio(0);
        if (halfB) asm volatile("s_waitcnt vmcnt(0)" ::: "memory");
        WG_BAR();
        const bool issue = VAR != 4 && VAR != 7 && VAR != 8 && t + 2 < NT;
        if (issue) dma_tile_k_v8(lds, (t + 2) & 3, Kc, V8c, (t + 2) * 64, dmo, v8off, wid);
        { const int k0_ = t * 64; float sh_ = 0.f, alpha; const int dq_ = qpos - k0_ - 4 * hi;
          if (VAR != 8) { if (qw0 - (k0_ + 63) >= RFAR) sh_ = b31;
          if (k0_ + 63 > qw0) causal_mask(p0, p1, dq_); }
          softmax_tile8(p0, p1, sh_, m_reg, l_reg, alpha, P8);
          if (__any(alpha < 1.f)) { if (hi == 0) ws[r32] = alpha; asm volatile("s_waitcnt lgkmcnt(0)" ::: "memory");
#pragma unroll
              for (int d_ = 0; d_ < 4; ++d_)
#pragma unroll
                  for (int r = 0; r < 16; ++r) o[d_][r] *= ws[crow(r, hi)]; } }
        if (!halfB) { if (issue) asm volatile("s_waitcnt vmcnt(3)" ::: "memory"); else asm volatile("s_waitcnt vmcnt(0)" ::: "memory"); }
        WG_BAR();
    }
    __builtin_amdgcn_s_setprio(2);
    pv8(o, va0 + ((NT - 1) & 3) * SHM_V8, va1 + ((NT - 1) & 3) * SHM_V8, P8);
    asm volatile("s_nop 15\n\ts_nop 15" ::: "memory");
    __builtin_amdgcn_s_setprio(0);
    if (!halfB) WG_BAR();
    WG_BAR();
    if (hi == 0) ws[32 + r32] = l_reg; asm volatile("s_waitcnt lgkmcnt(0)" ::: "memory");
#pragma unroll
    for (int r = 0; r < 16; ++r) { const float rl = __builtin_amdgcn_rcpf(ws[32 + crow(r, hi)] * F8_SV);
#pragma unroll
        for (int d0 = 0; d0 < 4; ++d0) o[d0][r] *= rl; }
    LAS float* xch = (LAS float*)lds + (size_t)w4 * 64 * 64;
    if (cm == 1) {
#pragma unroll
        for (int d0 = 0; d0 < 4; ++d0)
#pragma unroll
            for (int r = 0; r < 16; ++r) xch[(d0 * 16 + r) * 64 + lane] = o[d0][r];
    }
    WG_BAR();
    if (cm == 0) {
        float ss[16];
#pragma unroll
        for (int r = 0; r < 16; ++r) { float a = 0.f;
#pragma unroll
            for (int d0 = 0; d0 < 4; ++d0) { o[d0][r] -= lam_full * xch[(d0 * 16 + r) * 64 + lane]; a += o[d0][r] * o[d0][r]; }
            ss[r] = a; }
#pragma unroll
        for (int r = 0; r < 16; ++r) {
#pragma unroll
            for (int sft = 1; sft < 32; sft <<= 1) ss[r] += bperm_f(lane ^ sft, ss[r]); }
        float gg[4];
#pragma unroll
        for (int d0 = 0; d0 < 4; ++d0) gg[d0] = subg[d0 * 32 + r32] * (1.0f - LAMBDA_INIT);
        bf16* Ow = O + (rowbase + qw0) * PITCH + h * HD;
#pragma unroll
        for (int r = 0; r < 16; ++r) { const int orow = crow(r, hi); const float rs = 1.0f / sqrtf(ss[r] * (1.0f / HD) + RMS_EPS);
            u32x2 wo; wo.x = cvtpk(o[0][r] * rs * gg[0], o[1][r] * rs * gg[1]); wo.y = cvtpk(o[2][r] * rs * gg[2], o[3][r] * rs * gg[3]);
            *(u32x2*)(Ow + (size_t)orow * PITCH + r32 * 4) = wo; }
    }
    WG_BAR();
}


__device__ __forceinline__ void block_load(LAS char* lds, const bf16* Kc, const bf16* Vc, const DmaOff& d, int wid) {
#pragma unroll
    for (int t = 0; t < 4; ++t) dma_tile(lds, t, Kc, Vc, t * 64, d, wid);
}
#define MOBA_TILE(t, CAUSAL) do { const int k0_ = kbase + (t) * 64; \
        if (!(CAUSAL) || k0_ <= qw0 + 31) { f32x16 p0, p1; bf16x8 pa0, pa1, pa2, pa3; float alpha, sh = 0.f; \
            const int dq_ = qpos - k0_ - 4 * hi; \
            if (CAUSAL) load_bias_lut(p0, p1, lut, dq_); \
            else load_bias_lut(p0, p1, lut, dq_ < RFAR + 63 ? dq_ : RFAR + 63);     \
            qkt<t, 8>(p0, p1, K_lds, r32, hi, 0, qr); \
            if ((CAUSAL) && k0_ + 63 > qw0) causal_mask(p0, p1, dq_); \
            softmax_tile(p0, p1, sh, m_reg, l_reg, alpha, pa0, pa1, pa2, pa3); \
            if (__any(alpha < 1.f)) { if (hi == 0) ws[r32] = alpha; asm volatile("s_waitcnt lgkmcnt(0)" ::: "memory"); \
                _Pragma("unroll") for (int d_ = 0; d_ < 4; ++d_) _Pragma("unroll") for (int r = 0; r < 16; ++r) o[d_][r] *= ws[crow(r, hi)]; } \
            pv_tile<t>(o, vb0, pa0, pa1, pa2, pa3); } } while (0)
__device__ __forceinline__ void moba_part_group(LAS char* lds, int bh, int j, int g, int cntj, const bf16* Q, const unsigned short* lists, const unsigned* sel,
                                                bf16* P0, bf16* P1, bf16* P2, f32x2* ml, float b31, int wid, int lane) {
    asm volatile("" : "+v"(lane));
    const int r32 = lane & 31, hi = lane >> 5, b = bh >> 3, h = bh & 7;
    const size_t rowbase = (size_t)b * SEQ;
    const int idx = g * 32 + r32; const bool valid = idx < cntj;
    const int qpos = (int)lists[((size_t)bh * 32 + j) * 8192 + (valid ? idx : cntj - 1)];
    const unsigned smask = sel[(size_t)bh * SEQ + qpos]; const int slot = __popc(smask & ((1u << j) - 1u));
    const int vb0 = (int)(unsigned)(uintptr_t)(lds + L_V) + v_rd_base(lane);
    LAS float* ws = (LAS float*)(lds + L_WS) + wid * 64;
    LAS const float* lut = (LAS const float*)(lds + L_LUT);
    lcp K_lds = (lcp)(lds + L_K);
    bf16x8 qr[8];
#pragma unroll
    for (int d0 = 0; d0 < 8; ++d0) qr[d0] = *(const bf16x8*)(Q + (rowbase + qpos) * PITCH + h * HD + d0 * 16 + hi * 8);
    if (hi == 0) ((LAS int*)ws)[32 + r32] = valid ? (int)((unsigned)(rowbase + qpos) | ((unsigned)slot << 24)) : -1;
    float m_reg = -1e30f, l_reg = 0.f; f32x16 o[4] = {};
    const int kbase = j * 256, qw0 = 0; (void)qw0;
    MOBA_TILE(0, false); MOBA_TILE(1, false); MOBA_TILE(2, false); MOBA_TILE(3, false);
    if (hi == 0) { ws[r32] = l_reg; if (valid) ml[((size_t)slot * M + rowbase + qpos) * NH + h] = (f32x2){m_reg, l_reg}; }
    asm volatile("s_waitcnt lgkmcnt(0)" ::: "memory");
#pragma unroll
    for (int r = 0; r < 16; ++r) { const int orow = crow(r, hi); const float rl = __builtin_amdgcn_rcpf(ws[orow]); const int info = ((LAS const int*)ws)[32 + orow];
        const int sl = info >> 24; bf16* Pb = sl == 0 ? P0 : (sl == 1 ? P1 : P2); bf16* Ow = Pb + (size_t)(info & 0xffffff) * PITCH + h * HD;
        u32x2 w; w.x = cvtpk(o[0][r] * rl, o[1][r] * rl); w.y = cvtpk(o[2][r] * rl, o[3][r] * rl);
        if (info >= 0) *(u32x2*)(Ow + r32 * 4) = w; }
    asm volatile("s_waitcnt lgkmcnt(0)" ::: "memory");
}
__device__ __forceinline__ void moba_own_rows(LAS char* lds, int b, int h, int qb, const bf16* Q, bf16* O, const bf16* P0, const bf16* P1, const bf16* P2, const f32x2* ml, int wid, int lane) {
    asm volatile("" : "+v"(lane));
    const int r32 = lane & 31, hi = lane >> 5;
    const size_t rowbase = (size_t)b * SEQ;
    const int q0 = qb * 256, qw0 = q0 + wid * 32, qpos = qw0 + r32, kbase = q0;
    const int vb0 = (int)(unsigned)(uintptr_t)(lds + L_V) + v_rd_base(lane);
    LAS float* ws = (LAS float*)(lds + L_WS) + wid * 64;
    LAS const float* lut = (LAS const float*)(lds + L_LUT);
    lcp K_lds = (lcp)(lds + L_K);
    const float b31 = 0.f; (void)b31;
    bf16x8 qr[8];
#pragma unroll
    for (int d0 = 0; d0 < 8; ++d0) qr[d0] = *(const bf16x8*)(Q + (rowbase + qpos) * PITCH + h * HD + d0 * 16 + hi * 8);
    float m_reg = -1e30f, l_reg = 0.f; f32x16 o[4] = {};
    MOBA_TILE(0, true); MOBA_TILE(1, true); MOBA_TILE(2, true); MOBA_TILE(3, true);
    const int nsel = qb < 3 ? qb : 3;
    {
        float ms[3], ls[3]; float mx = m_reg;
#pragma unroll
        for (int s_ = 0; s_ < 3; ++s_) { ms[s_] = -1e30f; ls[s_] = 0.f;
            if (s_ < nsel) { const f32x2 v = ml[((size_t)s_ * M + rowbase + qpos) * NH + h]; ms[s_] = v.x; ls[s_] = v.y; mx = fmaxf(mx, v.x); } }
        const float w0 = __builtin_amdgcn_exp2f(m_reg - mx);
        float wv[3]; float den = l_reg * w0;
#pragma unroll
        for (int s_ = 0; s_ < 3; ++s_) { wv[s_] = ls[s_] * __builtin_amdgcn_exp2f(ms[s_] - mx); den += wv[s_]; }
        const float rd = 1.0f / den;
        if (hi == 0) *(LAS f32x4*)(lds + L_CF + wid * 512 + r32 * 16) = (f32x4){w0 * rd, wv[0] * rd, wv[1] * rd, wv[2] * rd};
    }
    asm volatile("s_waitcnt lgkmcnt(0)" ::: "memory");
#pragma unroll
    for (int r = 0; r < 16; ++r) { const int orow = crow(r, hi); const f32x4 cf = *(LAS const f32x4*)(lds + L_CF + wid * 512 + orow * 16);
        const size_t ro = (rowbase + qw0 + orow) * PITCH + h * HD + r32 * 4;
        float v0 = o[0][r] * cf.x, v1 = o[1][r] * cf.x, v2 = o[2][r] * cf.x, v3 = o[3][r] * cf.x;
        if (nsel > 0) { const u32x2 w = *(const u32x2*)(P0 + ro); v0 += cf.y * bflo(w.x); v1 += cf.y * bfhi(w.x); v2 += cf.y * bflo(w.y); v3 += cf.y * bfhi(w.y); }
        if (nsel > 1) { const u32x2 w = *(const u32x2*)(P1 + ro); v0 += cf.z * bflo(w.x); v1 += cf.z * bfhi(w.x); v2 += cf.z * bflo(w.y); v3 += cf.z * bfhi(w.y); }
        if (nsel > 2) { const u32x2 w = *(const u32x2*)(P2 + ro); v0 += cf.w * bflo(w.x); v1 += cf.w * bfhi(w.x); v2 += cf.w * bflo(w.y); v3 += cf.w * bfhi(w.y); }
        u32x2 wo; wo.x = cvtpk(v0, v1); wo.y = cvtpk(v2, v3);
        *(u32x2*)(O + ro) = wo; }
    asm volatile("s_waitcnt lgkmcnt(0)" ::: "memory");
}
#undef MOBA_TILE
#undef KSWZ
#undef SBAR
#undef WG_BAR
}


template <int VAR> __device__ __forceinline__ void p_diff_attn_mfma(const Args& a, LAS unsigned char* lds, int vcu, int tid, int wave, int lane, size_t out_off) {
    const bf16* Qb = (const bf16*)(a.ws + WS_Q); const bf16* Kb = (const bf16*)(a.ws + WS_K); const unsigned char* Vb = a.ws + WS_V;
    bf16* Ob = (bf16*)(a.ws + out_off); const float* biasT = (const float*)(a.ws + WS_BIAST);
    float lam_full;
    { const float* lm = a.diff_lambda; const float p01 = wave_sum(lm[lane] * lm[64 + lane]), p23 = wave_sum(lm[128 + lane] * lm[192 + lane]); lam_full = __expf(p01) - __expf(p23) + LAMBDA_INIT; }
    const int G = gridDim.x;
    if (G == 256) {
#pragma unroll 1
        for (int k = 0; k < 4; ++k) {
            const int bh = 2 * (vcu >> 5) + (k >> 1), p = vcu & 31, qb = (k & 1) ? 63 - p : p;
            att::diff_unit<VAR>((LAS char*)lds, bh >> 3, bh & 7, qb, Qb, Kb, Vb, Ob, a.rel_bias, biasT, lam_full, a.diff_subln_g, tid, wave, lane);
        }
    } else {
        for (int pp = vcu; pp < 512; pp += G) {
#pragma unroll 1
            for (int k = 0; k < 2; ++k) {
                const int bh = pp >> 5, p = pp & 31, qb = k ? 63 - p : p;
                att::diff_unit<VAR>((LAS char*)lds, bh >> 3, bh & 7, qb, Qb, Kb, Vb, Ob, a.rel_bias, biasT, lam_full, a.diff_subln_g, tid, wave, lane);
            }
        }
    }
}


__device__ __forceinline__ void p_moba_part(const Args& a, LAS unsigned char* lds, int vcu, int tid, int wave, int lane) {
    const bf16* Qb = (const bf16*)(a.ws + WS_Q); const bf16* Kb = (const bf16*)(a.ws + WS_K); const bf16* Vb = (const bf16*)(a.ws + WS_V);
    const unsigned* cnt = (const unsigned*)(a.ws + WS_CTL) + CW_CNT; const unsigned short* lists = (const unsigned short*)(a.ws + WS_LIST); const unsigned* sel = (const unsigned*)(a.ws + WS_SEL);
    bf16* P0 = (bf16*)(a.ws + WS_H); bf16* P1 = (bf16*)(a.ws + WS_Y); bf16* P2 = (bf16*)a.out; f32x2* ml = (f32x2*)((unsigned char*)a.out + WS_ML);
    LAS int* pre = (LAS int*)(lds + att::L_TAB); LAS int* found = (LAS int*)(lds + att::L_FOUND);
    const int c = (int)cnt[tid], nch = (c + 255) >> 8;
    int incl = nch;
#pragma unroll
    for (int o = 1; o < 64; o <<= 1) { const int v = bperm_i(lane >= o ? lane - o : lane, incl); if (lane >= o) incl += v; }
    if (lane == 63) pre[513 + wave] = incl;
    __syncthreads();
    int woff = 0;
#pragma unroll
    for (int w8 = 0; w8 < 8; ++w8) woff += (w8 < wave) ? pre[513 + w8] : 0;
    pre[tid + 1] = woff + incl; if (tid == 0) pre[0] = 0;
    __syncthreads();
    const int T = pre[512], G = gridDim.x;
    const int lo = (int)(((long long)T * vcu) / G), hi_ = (int)(((long long)T * (vcu + 1)) / G);
    const att::DmaOff dmo = att::dma_offsets(wave, lane);
    int last_h = -1;
    for (int it = lo; it < hi_;) {
        if (pre[tid] <= it && it < pre[tid + 1]) found[0] = tid;
        __syncthreads();
        const int f = __builtin_amdgcn_readfirstlane(found[0]);
        const int bh = f >> 5, j = f & 31, c0 = it - pre[f];
        const int seg_end = pre[f + 1] < hi_ ? pre[f + 1] : hi_, c1 = seg_end - pre[f];
        const int cntj = (int)cnt[f];
        const size_t kvoff = ((size_t)(bh >> 3) * SEQ + j * 256) * D + (bh & 7) * HD;
        att::block_load((LAS char*)lds, Kb + kvoff, Vb + kvoff, dmo, wave);
        if ((bh & 7) != last_h) { last_h = bh & 7; att::build_lut((LAS char*)lds, (const float*)(a.ws + WS_BIAST), last_h, tid); }
        const float b31 = a.rel_bias[31 * 8 + (bh & 7)] * LOG2E;
        asm volatile("s_waitcnt vmcnt(0)" ::: "memory");
        __syncthreads();
        for (int g = c0 * 8 + wave; g < c1 * 8 && g * 32 < cntj; g += 8)
            att::moba_part_group((LAS char*)lds, bh, j, g, cntj, Qb, lists, sel, P0, P1, P2, ml, b31, wave, lane);
        it = seg_end;
    }
}
__device__ __forceinline__ void p_moba_own(const Args& a, LAS unsigned char* lds, int vcu, int tid, int wave, int lane) {
    const bf16* Qb = (const bf16*)(a.ws + WS_Q); const bf16* Kb = (const bf16*)(a.ws + WS_K); const bf16* Vb = (const bf16*)(a.ws + WS_V); bf16* Ob = (bf16*)(a.ws + WS_O);
    const bf16* P0 = (const bf16*)(a.ws + WS_H); const bf16* P1 = (const bf16*)(a.ws + WS_Y); const bf16* P2 = (const bf16*)a.out; const f32x2* ml = (const f32x2*)((const unsigned char*)a.out + WS_ML);
    const int G = gridDim.x;
    const att::DmaOff dmo = att::dma_offsets(wave, lane);
    for (int u0 = 2 * vcu; u0 < 512; u0 += 2 * G) {
#pragma unroll 1
        for (int k = 0; k < 2; ++k) { const int u = u0 + k; if (u >= 512) break; const int bh = u >> 5, qb = u & 31;
            __syncthreads();
            const size_t kvoff = ((size_t)(bh >> 3) * SEQ + qb * 256) * D + (bh & 7) * HD;
            att::block_load((LAS char*)lds, Kb + kvoff, Vb + kvoff, dmo, wave);
            if (k == 0 || (u & 31) == 0) att::build_lut((LAS char*)lds, (const float*)(a.ws + WS_BIAST), bh & 7, tid);
            asm volatile("s_waitcnt vmcnt(0)" ::: "memory");
            __syncthreads();
            att::moba_own_rows((LAS char*)lds, bh >> 3, bh & 7, qb, Qb, Ob, P0, P1, P2, ml, wave, lane); }
    }
}

struct TI { int tid, lane, wave, gtid, gw; };
__device__ __forceinline__ TI mk_ti(int wave0) { const int l = lane_opaque(); const int t = wave0 * 64 + l; TI r; r.tid = t; r.lane = l; r.wave = wave0;
    r.gtid = blockIdx.x * NTHR + t; r.gw = blockIdx.x * NWAVES + r.wave; return r; }

typedef const __attribute__((address_space(4))) Args* CArgs;
__device__ __forceinline__ Args load_args() {
#if defined(__HIP_DEVICE_COMPILE__)
    auto p = __builtin_amdgcn_kernarg_segment_ptr(); asm volatile("" : "+s"(p));
    typedef const __attribute__((address_space(4))) unsigned long long* cu64; cu64 q = (cu64)p;
    Args r; r.x = (const float*)q[0]; r.c = (const float*)q[1]; r.rel_bias = (const float*)q[2]; r.ada_w = (const float*)q[3]; r.ada_b = (const float*)q[4]; r.norm_g = (const float*)q[5];
    r.moba_w_qkv = (const float*)q[6]; r.moba_w_o = (const float*)q[7]; r.diff_w_qkv = (const float*)q[8]; r.diff_w_o = (const float*)q[9];
    r.diff_lambda = (const float*)q[10]; r.diff_subln_g = (const float*)q[11]; r.ffn_w_in = (const float*)q[12]; r.ffn_w_out = (const float*)q[13];
    r.out = (float*)q[14]; r.ws = (unsigned char*)q[15]; return r;
#else
    return Args{};
#endif
}
#define WSP(T, off) ((T*)(a.ws + (off)))
#define GEMM_PHASE_F8(EPI, Aptr, Wptr, N_, K_, ...) do { const Args a = load_args(); const int G_ = gridDim.x; \
        pg8::Gemm g{Aptr, (const bf16*)(Wptr), M, N_, K_}; pg8::StaticOrder S; S.init(M, N_, G_, (int)blockIdx.x); \
        EPI E{__VA_ARGS__}; pg8::gemm_phase<EPI, pg8::StaticOrder, true, true, true>(lds, g, S, E, wave0); } while (0)
#define GEMM_PHASE(EPI, Aptr, Wptr, N_, K_, ...) do { const Args a = load_args(); const int G_ = gridDim.x; \
        pg8::Gemm g{Aptr, (const bf16*)(Wptr), M, N_, K_}; pg8::StaticOrder S; S.init(M, N_, G_, (int)blockIdx.x); \
        EPI E{__VA_ARGS__}; pg8::gemm_phase<EPI, pg8::StaticOrder, true, true>(lds, g, S, E, wave0); } while (0)
__global__ void __launch_bounds__(NTHR, 2) fwd(Args a_unused) {
    extern __shared__ __attribute__((aligned(16))) unsigned char lds_raw[];
    LAS unsigned char* lds = (LAS unsigned char*)lds_raw;
    volatile LAS unsigned* MISC = (volatile LAS unsigned*)(lds + MISC_OFF);
    const int wave0 = __builtin_amdgcn_readfirstlane((int)threadIdx.x >> 6);
    if (wave0 == 0) MISC[lane_opaque()] = 0u;
    __syncthreads();
    XcdBarrier bar;
    { const Args a = load_args(); bar = xcd_barrier_post(WSP(unsigned, WS_CTL) + CW_BAR, MISC + 8, wave0); }
#define VCU() ((gridDim.x % 8 == 0) ? (int)((blockIdx.x % 8) * (gridDim.x / 8) + blockIdx.x / 8) : (int)blockIdx.x)
#define NGW() ((int)gridDim.x * NWAVES)
#define NGT() ((int)gridDim.x * NTHR)
    constexpr float QS0 = 0.08838834764831845f * LOG2E, QS1 = 0.125f * LOG2E;
    constexpr size_t QKVS = (size_t)(WS_K - WS_Q) / 2;

    { const Args a = load_args(); const TI t = mk_ti(wave0); p_weights(a, lds, t.gw, NGW(), t.wave, t.lane); p_wo_perm(a, t.gtid, NGT()); __syncthreads(); p_mod(a, lds, (int)blockIdx.x, (int)gridDim.x, t.tid, t.wave, t.lane); }
    xcd_barrier(bar);
    { const Args a = load_args(); const TI t = mk_ti(wave0); const float* md = WSP(const float, WS_MOD); p_norm_in(a.x, a.norm_g, md, md + 1024, WSP(bf16, WS_H), t.gw, NGW(), t.lane); }
    xcd_barrier(bar);
    GEMM_PHASE(pg8::EpiQKV, WSP(bf16, WS_H), a.ws + WS_W + WO_QKV, 3 * D, D, WSP(bf16, WS_Q), D, QKVS, QS0, WSP(float, WS_KSUM));
    xcd_barrier(bar);
    { const Args a = load_args(); const TI t = mk_ti(wave0); p_gate(WSP(bf16, WS_Q), WSP(const float, WS_KSUM), WSP(unsigned, WS_SEL), WSP(unsigned, WS_CTL) + CW_CNT, WSP(unsigned short, WS_LIST), lds, (int)blockIdx.x, (int)gridDim.x, t.tid, t.wave, t.lane); }
    xcd_barrier(bar);
    { const Args a = load_args(); const TI t = mk_ti(wave0); p_moba_part(a, lds, VCU(), t.tid, t.wave, t.lane); }
    xcd_barrier(bar);
    { const Args a = load_args(); const TI t = mk_ti(wave0); p_moba_own(a, lds, VCU(), t.tid, t.wave, t.lane); }
    xcd_barrier(bar);
    GEMM_PHASE(pg8::EpiBf16<0>, WSP(bf16, WS_O), a.ws + WS_W + WO_O, D, D, WSP(bf16, WS_Y), D, nullptr, 0, 0, 1.f);
    xcd_barrier(bar);
    { const Args a = load_args(); const TI t = mk_ti(wave0); const float* md = WSP(const float, WS_MOD); const float* ng = a.norm_g;
      p_post<false, true, true>(a.x, WSP(bf16, WS_Y), ng + D, md + 2048, a.out, ng + 2 * D, md + 3072, md + 4096, WSP(bf16, WS_H), t.gw, NGW(), t.lane); }
    xcd_barrier(bar);
    GEMM_PHASE_F8(pg8::EpiSwiglu, WSP(bf16, WS_H), a.ws + WS_W + WO_IN, 2 * DFF, D / 2, WSP(bf16, WS_HH), DFF, 1.0f / (F8_SA * F8_SB), F8_SH);
    xcd_barrier(bar);
    GEMM_PHASE_F8(pg8::EpiScaled, WSP(bf16, WS_HH), a.ws + WS_W + WO_OUT, D, DFF / 2, WSP(bf16, WS_Y), D, 1.0f / (F8_SH * F8_SB));
    xcd_barrier(bar);
    { const Args a = load_args(); const TI t = mk_ti(wave0); const float* md = WSP(const float, WS_MOD); const float* ng = a.norm_g; const float* md1 = md + 2 * 6144; const float* ng1 = ng + 4 * D;
      p_post<true, true, false>(a.out, WSP(bf16, WS_Y), ng + 3 * D, md + 5120, (unsigned char*)a.out + 32 * MiB, ng1, md1, md1 + 1024, WSP(bf16, WS_H), t.gw, NGW(), t.lane); }
    xcd_barrier(bar);
    GEMM_PHASE(pg8::EpiQKV, WSP(bf16, WS_H), a.ws + WS_W + WL_STRIDE + WO_QKV, 2 * D, D, WSP(bf16, WS_Q), D, QKVS, QS1, nullptr);
    __syncthreads();
    { const Args a = load_args(); const int G_ = gridDim.x;
      pg8::Gemm g{(const bf16*)(a.ws + WS_W + WL_STRIDE + WO_QKV) + (size_t)2 * D * D, WSP(bf16, WS_H), D, M, D}; pg8::StaticOrder S; S.init(D, M, G_, (int)blockIdx.x);
      pg8::EpiVT8 E{a.ws + WS_V, M, att::F8_SV}; pg8::gemm_phase<pg8::EpiVT8, pg8::StaticOrder, true, true>(lds, g, S, E, wave0); }
    xcd_barrier(bar);
    { const Args a = load_args(); const TI t = mk_ti(wave0); p_diff_attn_mfma<0>(a, lds, VCU(), t.tid, t.wave, t.lane, WS_O); }
#ifdef PROBE_VAR
    { const Args a = load_args(); const TI t = mk_ti(wave0); p_diff_attn_mfma<PROBE_VAR>(a, lds, VCU(), t.tid, t.wave, t.lane, WS_Y); }
#endif
    xcd_barrier(bar);
    GEMM_PHASE(pg8::EpiBf16<0>, WSP(bf16, WS_O), a.ws + WS_W + WL_STRIDE + WO_O, D, D, WSP(bf16, WS_Y), D, nullptr, 0, 0, 1.f);
    xcd_barrier(bar);
    { const Args a = load_args(); const TI t = mk_ti(wave0); const float* md = WSP(const float, WS_MOD) + 2 * 6144; const float* ng = a.norm_g + 4 * D;
      p_post<true, true, true>((unsigned char*)a.out + 32 * MiB, WSP(bf16, WS_Y), ng + D, md + 2048, WSP(bf16, WS_O), ng + 2 * D, md + 3072, md + 4096, WSP(bf16, WS_H), t.gw, NGW(), t.lane); }
    xcd_barrier(bar);
    GEMM_PHASE_F8(pg8::EpiSwiglu, WSP(bf16, WS_H), a.ws + WS_W + WL_STRIDE + WO_IN, 2 * DFF, D / 2, WSP(bf16, WS_HH), DFF, 1.0f / (F8_SA * F8_SB), F8_SH);
    xcd_barrier(bar);
    GEMM_PHASE_F8(pg8::EpiScaled, WSP(bf16, WS_HH), a.ws + WS_W + WL_STRIDE + WO_OUT, D, DFF / 2, WSP(bf16, WS_Y), D, 1.0f / (F8_SH * F8_SB));
    xcd_barrier(bar);
    { const Args a = load_args(); const TI t = mk_ti(wave0); const float* md = WSP(const float, WS_MOD) + 2 * 6144; const float* ng = a.norm_g + 4 * D;
      p_post<true, false, false>(WSP(bf16, WS_O), WSP(bf16, WS_Y), ng + 3 * D, md + 5120, a.out, nullptr, nullptr, nullptr, nullptr, t.gw, NGW(), t.lane); }
}

extern "C" void kernel_launch(void* const* d_in, const int* in_sizes, int n_in, void* d_out, int out_size, void* d_ws, size_t ws_size, hipStream_t stream) {
    static int grid = 0;
    if (grid == 0) {
        if (n_in != 14 || out_size != M * D || ws_size < WS_END) { fprintf(stderr, "kernel_launch: unexpected shapes n_in %d out %d ws %zu\n", n_in, out_size, ws_size); grid = -1; return; }
        int dev = 0, cus = 0;
        if (hipGetDevice(&dev) != hipSuccess || hipDeviceGetAttribute(&cus, hipDeviceAttributeMultiprocessorCount, dev) != hipSuccess) { grid = -1; return; }
        if (hipFuncSetAttribute((const void*)fwd, hipFuncAttributeMaxDynamicSharedMemorySize, LDS_BYTES) != hipSuccess) { fprintf(stderr, "hipFuncSetAttribute failed\n"); grid = -1; return; }
        grid = cus;
    }
    if (grid < 0) return;
    (void)hipMemsetAsync((char*)d_ws + WS_CTL, 0, CTL_ZERO_BYTES, stream);
    Args a{};
    a.x = (const float*)d_in[0]; a.c = (const float*)d_in[1]; a.rel_bias = (const float*)d_in[2]; a.ada_w = (const float*)d_in[3]; a.ada_b = (const float*)d_in[4];
    a.norm_g = (const float*)d_in[5]; a.moba_w_qkv = (const float*)d_in[6]; a.moba_w_o = (const float*)d_in[7]; a.diff_w_qkv = (const float*)d_in[8]; a.diff_w_o = (const float*)d_in[9];
    a.diff_lambda = (const float*)d_in[10]; a.diff_subln_g = (const float*)d_in[11]; a.ffn_w_in = (const float*)d_in[12]; a.ffn_w_out = (const float*)d_in[13];
    a.out = (float*)d_out; a.ws = (unsigned char*)d_ws;
    hipLaunchKernelGGL(fwd, dim3(grid), dim3(NTHR), LDS_BYTES, stream, a);
}
```

```cpp
#include <hip/hip_runtime.h>
#include <cstdio>
#include <cstdint>

#define GAS __attribute__((address_space(1)))
#define LAS __attribute__((address_space(3)))
typedef unsigned short bf16;
typedef float f32x4 __attribute__((ext_vector_type(4)));
typedef float f32x2 __attribute__((ext_vector_type(2)));
typedef unsigned u32x4 __attribute__((ext_vector_type(4)));
typedef unsigned u32x2 __attribute__((ext_vector_type(2)));

constexpr int BATCH = 2, SEQ = 8192, D = 1024, NH = 8, HD = 128, DFF = 2816, NBKT = 32;
constexpr int M = BATCH * SEQ;
constexpr int NWAVES = 8, NTHR = 512;
constexpr float RMS_EPS = 1e-6f;
constexpr float LOG2E = 1.4426950408889634f;
constexpr float LAMBDA_INIT = 0.35550906759096926f;

constexpr size_t MiB = 1u << 20;
constexpr size_t WS_CTL = 0, CTL_ZERO_BYTES = 1 * MiB;
constexpr size_t WS_MOD = 1 * MiB;
constexpr size_t WS_BLUT = WS_MOD + 128 * 1024;
constexpr size_t WS_KMEAN = WS_BLUT + 16 * 1024;
constexpr size_t WS_SEL = WS_KMEAN + 256 * 1024;
constexpr size_t WS_BIAST = WS_SEL + 512 * 1024;
constexpr size_t WS_LIST = 244 * MiB;
constexpr size_t WS_ML = 32 * MiB;
constexpr size_t WS_KSUM = 256 * 1024;
constexpr int CW_CNT = 8192;
constexpr size_t WS_W = 2 * MiB, WL_STRIDE = 25 * MiB;
constexpr size_t WO_QKV = 0, WO_O = 6 * MiB, WO_IN = 8 * MiB, WO_OUT = 19 * MiB;
constexpr size_t WS_H = 52 * MiB;
constexpr size_t WS_Q = 84 * MiB, WS_K = 116 * MiB, WS_V = 148 * MiB;
constexpr size_t WS_HH = 84 * MiB;
constexpr size_t WS_O = 180 * MiB;
constexpr size_t WS_Y = 212 * MiB;
constexpr size_t WS_END = 252 * MiB;
constexpr int CW_BAR = 4096;

constexpr int LDS_BYTES = 155648;
constexpr int MISC_OFF = 150016;

#define RLX_AGENT __ATOMIC_RELAXED, __HIP_MEMORY_SCOPE_AGENT
__device__ __forceinline__ unsigned f2bf(float f) { unsigned u = __builtin_bit_cast(unsigned, f); return (u + 0x7fffu + ((u >> 16) & 1u)) >> 16; }
__device__ __forceinline__ unsigned pk2(float lo, float hi) { return f2bf(lo) | (f2bf(hi) << 16); }
__device__ __forceinline__ float bf2f(unsigned short b) { return __builtin_bit_cast(float, (unsigned)b << 16); }
__device__ __forceinline__ float bflo(unsigned w) { return __builtin_bit_cast(float, w << 16); }
__device__ __forceinline__ float bfhi(unsigned w) { return __builtin_bit_cast(float, w & 0xffff0000u); }

__device__ __forceinline__ int lane_opaque() { int l; asm volatile("v_mbcnt_lo_u32_b32 %0, -1, 0\n\tv_mbcnt_hi_u32_b32 %0, -1, %0" : "=v"(l)); return l; }
__device__ __forceinline__ float bperm_f(int src_lane, float v) { return __builtin_bit_cast(float, __builtin_amdgcn_ds_bpermute(src_lane << 2, __builtin_bit_cast(int, v))); }
__device__ __forceinline__ int bperm_i(int src_lane, int v) { return __builtin_amdgcn_ds_bpermute(src_lane << 2, v); }

#define XB_TMO      128
#define XB_XCNT(j)  (256  + 64 * (j))
#define XB_XSUB(j)  (1280 + 64 * (j))
#define XB_XGEN(j)  (2304 + 64 * (j))
#define XB_TOP      3328
#define XB_TOPGEN   3392
#define XCD_BAR_WORDS 3456
#define XB_SPIN_CAP (1u << 25)
__device__ __forceinline__ unsigned xb_ld(unsigned* p)              { return __hip_atomic_load(p, __ATOMIC_RELAXED, __HIP_MEMORY_SCOPE_AGENT); }
__device__ __forceinline__ unsigned xb_add(unsigned* p, unsigned v) { return __hip_atomic_fetch_add(p, v, __ATOMIC_RELAXED, __HIP_MEMORY_SCOPE_AGENT); }
__device__ __forceinline__ unsigned xb_xcc_id() { return (unsigned)__builtin_amdgcn_s_getreg((3 << 11) | 20) & 0xFu; }
#define XB_SPIN(cond, bar) do { unsigned _sp = 0; while (cond) { __builtin_amdgcn_s_sleep(1); \
    if ((++_sp & 255u) == 0u) { if (xb_ld(&(bar)[XB_TMO])) break; if (_sp > XB_SPIN_CAP) { atomicAdd(&(bar)[XB_TMO], 1u); break; } } } } while (0)
struct XcdBarrier { unsigned* bar; unsigned x; volatile LAS unsigned* st; int wave; };
__device__ __forceinline__ XcdBarrier xcd_barrier_post(unsigned* bar, volatile LAS unsigned* st, int wave) {
    XcdBarrier b; b.bar = bar; b.x = xb_xcc_id(); b.st = st; b.wave = wave;
    if (wave == 0 && lane_opaque() == 0) (void)xb_add(&bar[XB_XCNT(b.x)], 1u);
    return b;
}
__device__ __forceinline__ void xcd_barrier_complete(unsigned* bar, unsigned x, unsigned& nloc, unsigned& nx) {
    const unsigned G = gridDim.x * gridDim.y * gridDim.z;
    unsigned sum, cnt, mine, sp = 0u;
    for (;;) {
        sum = 0u; cnt = 0u; mine = 0u;
#pragma unroll
        for (unsigned j = 0; j < 16; ++j) { const unsigned c = xb_ld(&bar[XB_XCNT(j)]); sum += c; cnt += (c > 0u) ? 1u : 0u; mine = (j == x) ? c : mine; }
        if (sum == G) break;
        __builtin_amdgcn_s_sleep(1);
        if ((++sp & 255u) == 0u) { if (xb_ld(&bar[XB_TMO])) break; if (sp > XB_SPIN_CAP) { atomicAdd(&bar[XB_TMO], 1u); break; } }
    }
    nloc = mine > 0u ? mine : 1u; nx = cnt > 0u ? cnt : 1u;
}
__device__ __forceinline__ void xcd_barrier(const XcdBarrier& b) {
    asm volatile("s_waitcnt vmcnt(0)" ::: "memory");
    __syncthreads();
    if (b.wave == 0 && lane_opaque() == 0) {
        unsigned* bar = b.bar;
        __builtin_amdgcn_s_waitcnt(0);
        unsigned nloc = b.st[0], nx = b.st[1];
        if (nloc == 0u) { xcd_barrier_complete(bar, b.x, nloc, nx); b.st[0] = nloc; b.st[1] = nx; }
        const unsigned old = xb_add(&bar[XB_XSUB(b.x)], 1u);
        const unsigned gen = old / nloc;
        if (old + 1u == (gen + 1u) * nloc) {
            __builtin_amdgcn_fence(__ATOMIC_RELEASE, "agent");
            asm volatile("s_waitcnt vmcnt(0)" ::: "memory");
            const unsigned og = xb_add(&bar[XB_TOP], 1u);
            const unsigned tg = og / nx;
            if (og + 1u == (tg + 1u) * nx) xb_add(&bar[XB_TOPGEN], 1u);
            else XB_SPIN(xb_ld(&bar[XB_TOPGEN]) == tg, bar);
            __builtin_amdgcn_fence(__ATOMIC_ACQUIRE, "agent");
            xb_add(&bar[XB_XGEN(b.x)], 1u);
            asm volatile("s_waitcnt vmcnt(0)" ::: "memory");
        } else {
            XB_SPIN(xb_ld(&bar[XB_XGEN(b.x)]) == gen, bar);
            __builtin_amdgcn_fence(__ATOMIC_ACQUIRE, "agent");
            asm volatile("s_waitcnt vmcnt(0)" ::: "memory");
        }
    }
    __syncthreads();
}

namespace pg8 {
#define PG8_LAS __attribute__((address_space(3)))
typedef unsigned short bf16_t;
typedef short bf16x8 __attribute__((ext_vector_type(8)));
typedef float f32x4 __attribute__((ext_vector_type(4)));
typedef unsigned u32x4 __attribute__((ext_vector_type(4)));
constexpr int BM = 256, BK = 64, HALF = 128, HTB = HALF * BK * 2  , STAGE_BYTES = 8 * HTB, NXCD = 8, WGM = 8;

__host__ __device__ __forceinline__ int lds_byte(int r, int c) { const int st = (r >> 4) * 2 + (c >> 5), rr = r & 15, cc = c & 31, ob = rr * 64 + cc * 2; return st * 1024 + (ob ^ (((ob >> 9) & 1) << 5)); }
__host__ __device__ __forceinline__ void stage_rc(int b, int& R, int& C) { const int st = b / 1024, sb = b % 1024, swz = sb ^ (((sb >> 9) & 1) << 5); R = (st >> 1) * 16 + swz / 64; C = (st & 1) * 32 + (swz % 64) / 2; }
__host__ __device__ __forceinline__ int perm32(int rho) { const int n = rho >> 4, i = rho & 15; return 8 * (i >> 2) + 4 * n + (i & 3); }

struct Unit { int pm, pn; };
struct Gemm { const bf16_t* A; const bf16_t* Bt; int M, N, K; };

struct StaticOrder {
    int nM, nN, nwg, G, c;
    __host__ __device__ void init(int M, int N, int G_, int c_) { nM = M / BM; nN = N / BM; nwg = nM * nN; G = G_; c = c_; }
    __host__ __device__ bool next(int i, Unit& u) const {
        const long L = (long)i * G + c; if (L >= nwg) return false;
        int wgid = (int)L; { const int q = nwg / NXCD, r = nwg % NXCD, xcd = wgid % NXCD, off = wgid / NXCD; wgid = (xcd < r ? xcd * (q + 1) : r * (q + 1) + (xcd - r) * q) + off; }
        const int nig = WGM * nN, gid = wgid / nig, fm = gid * WGM, gsz = (nM - fm) < WGM ? (nM - fm) : WGM;
        u.pm = fm + ((wgid % nig) % gsz); u.pn = (wgid % nig) / gsz; return true;
    }
    __device__ __forceinline__ void a_ready(const Unit&) const {}
    __device__ __forceinline__ void done(const Unit&) const {}
};

__device__ __forceinline__ unsigned cvt_pk_bf16(float lo, float hi) { unsigned r; asm volatile("v_cvt_pk_bf16_f32 %0, %1, %2" : "=v"(r) : "v"(lo), "v"(hi)); return r; }
typedef float f32x2 __attribute__((ext_vector_type(2)));
__device__ __forceinline__ f32x2 gelu_pk(f32x2 v) {
    const f32x2 av = __builtin_elementwise_abs(v), d = av * 0.2316418882f + 1.0f;
    f32x2 t; t.x = __builtin_amdgcn_rcpf(d.x); t.y = __builtin_amdgcn_rcpf(d.y);
    f32x2 q = t * 0.5307027145f + (-0.7265760135f); q = q * t + 0.7107068705f; q = q * t + (-0.142248368f); q = q * t + 0.127414796f; q = q * t;
    const f32x2 s = (v * v) * (-0.72134752044f);
    f32x2 e; e.x = __builtin_amdgcn_exp2f(s.x); e.y = __builtin_amdgcn_exp2f(s.y);
    const f32x2 m = v * (q * e), r = v - m;
    f32x2 o; o.x = v.x < 0.f ? m.x : r.x; o.y = v.y < 0.f ? m.y : r.y; return o;
}

template <int ACT  > struct EpiBf16 {
    static constexpr bool PERM = true, AFTER_DRAIN = false; static_assert(ACT == 0 || ACT == 1, "EpiBf16: ACT is 0 (none) or 1 (gelu_pk)");
    bf16_t* O; int ldc; const float* bias; int split_cols; size_t split_stride; float scale0;
    __device__ __forceinline__ void operator()(const f32x4 (&acc)[2][2][4][2], const Unit& u, int wr, int wc, int fr, int fq) const {
        const int row0 = u.pm * BM + wr * 64 + fr; int colt = u.pn * BM; bf16_t* base = O;
        float sc = 1.f; if (split_cols) { const int t = colt / split_cols; base += (size_t)t * split_stride; colt -= t * split_cols; if (t == 0) sc = scale0; }
        const int col0 = colt + wc * 32 + 8 * fq, bcol0 = u.pn * BM + wc * 32 + 8 * fq;
        f32x4 bv[2][2];
#pragma unroll
        for (int bj = 0; bj < 2; ++bj)
#pragma unroll
            for (int n = 0; n < 2; ++n) bv[bj][n] = bias ? *(const f32x4*)(bias + bcol0 + bj * HALF + 4 * n) : (f32x4){0.f, 0.f, 0.f, 0.f};
#pragma unroll
        for (int ai = 0; ai < 2; ++ai)
#pragma unroll
            for (int m = 0; m < 4; ++m) { bf16_t* rowp = base + (size_t)(row0 + ai * HALF + m * 16) * ldc + col0;
#pragma unroll
                for (int bj = 0; bj < 2; ++bj) { f32x4 v0 = acc[ai][bj][m][0] + bv[bj][0], v1 = acc[ai][bj][m][1] + bv[bj][1];
                    if (ACT == 1) { f32x2 a = gelu_pk((f32x2){v0[0], v0[1]}), b = gelu_pk((f32x2){v0[2], v0[3]}), c = gelu_pk((f32x2){v1[0], v1[1]}), d = gelu_pk((f32x2){v1[2], v1[3]});
                        v0 = (f32x4){a.x, a.y, b.x, b.y}; v1 = (f32x4){c.x, c.y, d.x, d.y}; }
                    v0 = v0 * sc; v1 = v1 * sc; u32x4 w; w.x = cvt_pk_bf16(v0[0], v0[1]); w.y = cvt_pk_bf16(v0[2], v0[3]); w.z = cvt_pk_bf16(v1[0], v1[1]); w.w = cvt_pk_bf16(v1[2], v1[3]);
                    *(u32x4*)(rowp + bj * HALF) = w; } }
    }
};

struct EpiQKV {
    static constexpr bool PERM = true, AFTER_DRAIN = false;
    bf16_t* O; int ldc; size_t split_stride; float scale0; float* ksum;
    __device__ __forceinline__ void operator()(const f32x4 (&acc)[2][2][4][2], const Unit& u, int wr, int wc, int fr, int fq) const {
        const int row0 = u.pm * BM + wr * 64 + fr; const int t = (u.pn * BM) / ldc; const int colt = u.pn * BM - t * ldc; bf16_t* base = O + (size_t)t * split_stride;
        const float sc = t == 0 ? scale0 : 1.f;
        const int col0 = colt + wc * 32 + 8 * fq;
#pragma unroll
        for (int ai = 0; ai < 2; ++ai)
#pragma unroll
            for (int m = 0; m < 4; ++m) { bf16_t* rowp = base + (size_t)(row0 + ai * HALF + m * 16) * ldc + col0;
#pragma unroll
                for (int bj = 0; bj < 2; ++bj) { const f32x4 v0 = acc[ai][bj][m][0] * sc, v1 = acc[ai][bj][m][1] * sc;
                    u32x4 w; w.x = cvt_pk_bf16(v0[0], v0[1]); w.y = cvt_pk_bf16(v0[2], v0[3]); w.z = cvt_pk_bf16(v1[0], v1[1]); w.w = cvt_pk_bf16(v1[2], v1[3]);
                    *(u32x4*)(rowp + bj * HALF) = w; } }
        if (ksum != nullptr && t == 1) {
            const int b = u.pm >> 5, blk = u.pm & 31, lq_ = lane_opaque();
#pragma unroll
            for (int bj = 0; bj < 2; ++bj) { const int h = (colt >> 7) + bj;
                float* dst = ksum + ((size_t)((b * 8 + h) * 32 + blk)) * 128 + wc * 32 + 8 * fq;
#pragma unroll
                for (int n = 0; n < 2; ++n) { f32x4 sacc = (f32x4){0.f, 0.f, 0.f, 0.f};
#pragma unroll
                    for (int ai = 0; ai < 2; ++ai)
#pragma unroll
                        for (int m = 0; m < 4; ++m) sacc += acc[ai][bj][m][n];
#pragma unroll
                    for (int e = 0; e < 4; ++e) { float v = sacc[e];
                        v += bperm_f(lq_ ^ 1, v); v += bperm_f(lq_ ^ 2, v); v += bperm_f(lq_ ^ 4, v); v += bperm_f(lq_ ^ 8, v);
                        if (fr == 0) atomicAdd(dst + 4 * n + e, v); } } }
        }
    }
};

struct EpiSwiglu {
    static constexpr bool PERM = true, AFTER_DRAIN = false;
    bf16_t* O; int ldc; float inv; float oscale;
    __device__ __forceinline__ void operator()(const f32x4 (&acc)[2][2][4][2], const Unit& u, int wr, int wc, int fr, int fq) const {
        const int row0 = u.pm * BM + wr * 64 + fr, col0 = u.pn * HALF + wc * 32 + 8 * fq;
#pragma unroll
        for (int ai = 0; ai < 2; ++ai)
#pragma unroll
            for (int m = 0; m < 4; ++m) { bf16_t* rowp = O + (size_t)(row0 + ai * HALF + m * 16) * ldc + col0;
                float v[8];
#pragma unroll
                for (int n = 0; n < 2; ++n)
#pragma unroll
                    for (int e = 0; e < 4; ++e) { const float g = acc[ai][0][m][n][e] * inv, uu = acc[ai][1][m][n][e] * inv;
                        v[n * 4 + e] = g * __builtin_amdgcn_rcpf(1.0f + __builtin_amdgcn_exp2f(-1.4426950408889634f * g)) * uu; }
                if (oscale > 0.f) { u32x2 w8;
                    { float c0 = fminf(fmaxf(v[0] * oscale, -448.f), 448.f), c1 = fminf(fmaxf(v[1] * oscale, -448.f), 448.f), c2 = fminf(fmaxf(v[2] * oscale, -448.f), 448.f), c3 = fminf(fmaxf(v[3] * oscale, -448.f), 448.f);
                      int t_ = __builtin_amdgcn_cvt_pk_fp8_f32(c0, c1, 0, false); t_ = __builtin_amdgcn_cvt_pk_fp8_f32(c2, c3, t_, true); w8.x = (unsigned)t_; }
                    { float c0 = fminf(fmaxf(v[4] * oscale, -448.f), 448.f), c1 = fminf(fmaxf(v[5] * oscale, -448.f), 448.f), c2 = fminf(fmaxf(v[6] * oscale, -448.f), 448.f), c3 = fminf(fmaxf(v[7] * oscale, -448.f), 448.f);
                      int t_ = __builtin_amdgcn_cvt_pk_fp8_f32(c0, c1, 0, false); t_ = __builtin_amdgcn_cvt_pk_fp8_f32(c2, c3, t_, true); w8.y = (unsigned)t_; }
                    *(u32x2*)((unsigned char*)O + (size_t)(row0 + ai * HALF + m * 16) * ldc + col0) = w8; }
                else { u32x4 w; w.x = cvt_pk_bf16(v[0], v[1]); w.y = cvt_pk_bf16(v[2], v[3]); w.z = cvt_pk_bf16(v[4], v[5]); w.w = cvt_pk_bf16(v[6], v[7]);
                *(u32x4*)rowp = w; } }
    }
};
struct EpiScaled {
    static constexpr bool PERM = true, AFTER_DRAIN = false;
    bf16_t* O; int ldc; float inv;
    __device__ __forceinline__ void operator()(const f32x4 (&acc)[2][2][4][2], const Unit& u, int wr, int wc, int fr, int fq) const {
        const int row0 = u.pm * BM + wr * 64 + fr, col0 = u.pn * BM + wc * 32 + 8 * fq;
#pragma unroll
        for (int ai = 0; ai < 2; ++ai)
#pragma unroll
            for (int m = 0; m < 4; ++m) { bf16_t* rowp = O + (size_t)(row0 + ai * HALF + m * 16) * ldc + col0;
#pragma unroll
                for (int bj = 0; bj < 2; ++bj) { const f32x4 v0 = acc[ai][bj][m][0] * inv, v1 = acc[ai][bj][m][1] * inv;
                    u32x4 w; w.x = cvt_pk_bf16(v0[0], v0[1]); w.y = cvt_pk_bf16(v0[2], v0[3]); w.z = cvt_pk_bf16(v1[0], v1[1]); w.w = cvt_pk_bf16(v1[2], v1[3]);
                    *(u32x4*)(rowp + bj * HALF) = w; } }
    }
};
struct EpiVT8 {
    static constexpr bool PERM = true, AFTER_DRAIN = false;
    unsigned char* O; int ldb; float scale;
    __device__ __forceinline__ void operator()(const f32x4 (&acc)[2][2][4][2], const Unit& u, int wr, int wc, int fr, int fq) const {
        const int row0 = u.pm * BM + wr * 64 + fr;
#pragma unroll
        for (int ai = 0; ai < 2; ++ai)
#pragma unroll
            for (int m = 0; m < 4; ++m) { unsigned char* rowp = O + (size_t)(row0 + ai * HALF + m * 16) * ldb;
#pragma unroll
                for (int bj = 0; bj < 2; ++bj)
#pragma unroll
                    for (int n = 0; n < 2; ++n) { const int col = u.pn * BM + bj * HALF + wc * 32 + 8 * fq + 4 * n, g4 = (col >> 2) & 15;
                        const int pos = (g4 & 1) * 32 + (g4 >> 3) * 16 + ((g4 >> 1) & 3) * 4;
                        const f32x4 v = acc[ai][bj][m][n] * scale;
                        float c0 = fminf(fmaxf(v[0], -448.f), 448.f), c1 = fminf(fmaxf(v[1], -448.f), 448.f), c2 = fminf(fmaxf(v[2], -448.f), 448.f), c3 = fminf(fmaxf(v[3], -448.f), 448.f);
                        int t_ = __builtin_amdgcn_cvt_pk_fp8_f32(c0, c1, 0, false); t_ = __builtin_amdgcn_cvt_pk_fp8_f32(c2, c3, t_, true);
                        *(unsigned*)(rowp + (col & ~63) + pos) = (unsigned)t_; } }
    }
};

template <class Epi, class Sched, bool ALIGN_EPI = false, bool SP2 = false, bool FP8 = false>
__device__ __forceinline__ void gemm_phase(PG8_LAS unsigned char* lds, const Gemm g, const Sched& S, const Epi& E, const int wave0) {
    const int tid_ = wave0 * 64 + lane_opaque();
    const int tid = tid_, wid = __builtin_amdgcn_readfirstlane(tid >> 6), lane = tid & 63, wr = wid >> 2, wc = wid & 3, fr = lane & 15, fq = lane >> 4;
    const int K = g.K, nt = K / BK;
    unsigned voffA[2], voffB[2];
#pragma unroll
    for (int i = 0; i < 2; ++i) { int R, C; stage_rc(tid * 16 + i * 8192, R, C); const int Rb = Epi::PERM ? ((R & ~31) + perm32(R & 31)) : R;
        voffA[i] = (unsigned)(R * K + C) * 2u; voffB[i] = (unsigned)(Rb * K + C) * 2u; }
    const size_t kstep = (size_t)(BK * 2);
    const size_t hstep = (size_t)HALF * K * 2;
    const size_t tstep = 2 * hstep;
    const unsigned ldsw = (unsigned)wid * 1024u;
    const int aoff = lds_byte(wr * 64 + fr, fq * 8), boff = lds_byte(wc * 32 + fr, fq * 8);
#define PG8_SA(b, h) (((b) * 2 + (h)) * HTB)
#define PG8_SB(b, h) ((4 + (b) * 2 + (h)) * HTB)
#define PG8_STAGE(bufoff, gbase, voff) do { _Pragma("unroll") for (int _i = 0; _i < 2; ++_i) \
        __builtin_amdgcn_global_load_lds((const unsigned*)((const char*)(gbase) + (voff)[_i]), (PG8_LAS unsigned*)(lds + (bufoff) + ldsw + _i * 8192), 16, 0, 0); } while (0)
#define PG8_LDA(dst, b, h) do { _Pragma("unroll") for (int m = 0; m < 4; ++m) _Pragma("unroll") for (int k = 0; k < 2; ++k) dst[m][k] = *(const PG8_LAS bf16x8*)(lds + PG8_SA(b, h) + aoff + m * 2048 + k * 1024); } while (0)
#define PG8_LDB(dst, b, h) do { _Pragma("unroll") for (int n = 0; n < 2; ++n) _Pragma("unroll") for (int k = 0; k < 2; ++k) dst[n][k] = *(const PG8_LAS bf16x8*)(lds + PG8_SB(b, h) + boff + n * 2048 + k * 1024); } while (0)
#define PG8_MMA(ai, bj, At, Bt) do { __builtin_amdgcn_s_setprio(1); \
        if constexpr (FP8) { typedef int i32x8_t __attribute__((ext_vector_type(8))); typedef int i32x4_t __attribute__((ext_vector_type(4))); \
            _Pragma("unroll") for (int m = 0; m < 4; ++m) _Pragma("unroll") for (int n = 0; n < 2; ++n) { \
                const i32x4_t b0_ = __builtin_bit_cast(i32x4_t, Bt[n][0]), b1_ = __builtin_bit_cast(i32x4_t, Bt[n][1]), a0_ = __builtin_bit_cast(i32x4_t, At[m][0]), a1_ = __builtin_bit_cast(i32x4_t, At[m][1]); \
                const i32x8_t bb_ = {b0_[0], b0_[1], b0_[2], b0_[3], b1_[0], b1_[1], b1_[2], b1_[3]}, aa_ = {a0_[0], a0_[1], a0_[2], a0_[3], a1_[0], a1_[1], a1_[2], a1_[3]}; \
                asm volatile("v_mfma_f32_16x16x128_f8f6f4 %0, %1, %2, %0" : "+v"(acc[ai][bj][m][n]) : "v"(bb_), "v"(aa_)); } } \
        else { _Pragma("unroll") for (int m = 0; m < 4; ++m) _Pragma("unroll") for (int n = 0; n < 2; ++n) _Pragma("unroll") for (int k = 0; k < 2; ++k) \
        acc[ai][bj][m][n] = __builtin_amdgcn_mfma_f32_16x16x32_bf16(Bt[n][k], At[m][k], acc[ai][bj][m][n], 0, 0, 0); } __builtin_amdgcn_s_setprio(0); } while (0)
#define PG8_WAIT_V(n) asm volatile("s_waitcnt vmcnt(" #n ")" ::: "memory")
#define PG8_WAIT_L(n) asm volatile("s_waitcnt lgkmcnt(" #n ")" ::: "memory")
#define PG8_BAR __builtin_amdgcn_s_barrier()
#define PG8_SCHED __builtin_amdgcn_sched_barrier(0)
    Unit cur, nxt; int ui = 0;
    if (!S.next(0, cur)) return;
    f32x4 acc[2][2][4][2];
#pragma unroll
    for (int a = 0; a < 2; ++a)
#pragma unroll
        for (int b = 0; b < 2; ++b)
#pragma unroll
            for (int m = 0; m < 4; ++m)
#pragma unroll
                for (int n = 0; n < 2; ++n) acc[a][b][m][n] = (f32x4){0.f, 0.f, 0.f, 0.f};
    bf16x8 At[4][2], B0[2][2], B1[2][2];
    const char* cA = (const char*)g.A + (size_t)cur.pm * tstep; const char* cB = (const char*)g.Bt + (size_t)cur.pn * tstep;
    S.a_ready(cur);
    if constexpr (SP2) {
        PG8_STAGE(PG8_SB(0, 0), cB, voffB); PG8_STAGE(PG8_SB(0, 1), cB + hstep, voffB); PG8_STAGE(PG8_SA(0, 0), cA, voffA); PG8_STAGE(PG8_SA(0, 1), cA + hstep, voffA);
        if (wr == 1) PG8_BAR;
        PG8_WAIT_V(2); PG8_BAR;
        PG8_STAGE(PG8_SB(1, 0), cB + kstep, voffB); PG8_STAGE(PG8_SA(1, 0), cA + kstep, voffA); PG8_STAGE(PG8_SB(1, 1), cB + hstep + kstep, voffB);
        PG8_WAIT_V(6); PG8_BAR;
    } else {
        PG8_STAGE(PG8_SB(0, 0), cB, voffB); PG8_STAGE(PG8_SA(0, 0), cA, voffA); PG8_STAGE(PG8_SB(0, 1), cB + hstep, voffB); PG8_STAGE(PG8_SA(0, 1), cA + hstep, voffA);
        if (wr == 1) PG8_BAR;
        PG8_WAIT_V(4); PG8_BAR;
        PG8_STAGE(PG8_SB(1, 0), cB + kstep, voffB); PG8_STAGE(PG8_SA(1, 0), cA + kstep, voffA); PG8_STAGE(PG8_SB(1, 1), cB + hstep + kstep, voffB);
        PG8_WAIT_V(6); PG8_BAR;
    }
    for (;;) {
        const bool has_next = S.next(ui + 1, nxt);
        const char* nA = has_next ? (const char*)g.A + (size_t)nxt.pm * tstep : cA; const char* nB = has_next ? (const char*)g.Bt + (size_t)nxt.pn * tstep : cB;
#pragma unroll 1
        for (int t = 0; t < nt; t += 2) {
            if constexpr (FP8) asm volatile("" : "+v"(voffA[0]), "+v"(voffA[1]), "+v"(voffB[0]), "+v"(voffB[1]));
            const bool last = (t == nt - 2);
            const char* a1 = cA + (size_t)(t + 1) * kstep;
            const char* a2 = last ? nA : cA + (size_t)(t + 2) * kstep; const char* b2 = last ? nB : cB + (size_t)(t + 2) * kstep;
            const char* a3 = a2 + kstep; const char* b3 = b2 + kstep;
            if (last && has_next) S.a_ready(nxt);
            if constexpr (SP2) {
            PG8_LDB(B0, 0, 0); PG8_LDB(B1, 0, 1); PG8_SCHED; PG8_LDA(At, 0, 0); PG8_STAGE(PG8_SA(1, 1), a1 + hstep, voffA);
            PG8_WAIT_V(8); PG8_WAIT_L(0); PG8_BAR; PG8_MMA(0, 0, At, B0); PG8_MMA(0, 1, At, B1); PG8_BAR; PG8_SCHED;
            PG8_LDA(At, 0, 1); PG8_STAGE(PG8_SB(0, 0), b2, voffB); PG8_STAGE(PG8_SB(0, 1), b2 + hstep, voffB); PG8_STAGE(PG8_SA(0, 0), a2, voffA);
            PG8_WAIT_V(8); PG8_WAIT_L(0); PG8_BAR; PG8_MMA(1, 0, At, B0); PG8_MMA(1, 1, At, B1); PG8_BAR; PG8_SCHED;
            PG8_LDB(B0, 1, 0); PG8_LDB(B1, 1, 1); PG8_SCHED; PG8_LDA(At, 1, 0); PG8_STAGE(PG8_SA(0, 1), a2 + hstep, voffA);
            PG8_WAIT_V(8); PG8_WAIT_L(0); PG8_BAR; PG8_MMA(0, 0, At, B0); PG8_MMA(0, 1, At, B1); PG8_BAR; PG8_SCHED;
            PG8_LDA(At, 1, 1); PG8_STAGE(PG8_SB(1, 0), b3, voffB); PG8_STAGE(PG8_SB(1, 1), b3 + hstep, voffB); PG8_STAGE(PG8_SA(1, 0), a3, voffA);
            PG8_WAIT_V(8); PG8_WAIT_L(0); PG8_BAR; PG8_MMA(1, 0, At, B0); PG8_MMA(1, 1, At, B1); PG8_BAR; PG8_SCHED;
            } else {
            PG8_LDB(B0, 0, 0); PG8_SCHED; PG8_LDA(At, 0, 0); PG8_STAGE(PG8_SA(1, 1), a1 + hstep, voffA);
            PG8_WAIT_L(8); PG8_BAR; PG8_WAIT_L(0); PG8_MMA(0, 0, At, B0); PG8_BAR; PG8_SCHED;
            PG8_LDB(B1, 0, 1); PG8_STAGE(PG8_SB(0, 0), b2, voffB);
            PG8_BAR; PG8_WAIT_L(0); PG8_MMA(0, 1, At, B1); PG8_BAR;
            PG8_LDA(At, 0, 1); PG8_STAGE(PG8_SA(0, 0), a2, voffA);
            PG8_BAR; PG8_WAIT_L(0); PG8_MMA(1, 0, At, B0); PG8_BAR; PG8_SCHED;
            PG8_STAGE(PG8_SB(0, 1), b2 + hstep, voffB);
            PG8_WAIT_V(6); PG8_BAR; PG8_MMA(1, 1, At, B1); PG8_BAR;
            PG8_LDB(B0, 1, 0); PG8_SCHED; PG8_LDA(At, 1, 0); PG8_STAGE(PG8_SA(0, 1), a2 + hstep, voffA);
            PG8_WAIT_L(8); PG8_BAR; PG8_WAIT_L(0); PG8_MMA(0, 0, At, B0); PG8_BAR; PG8_SCHED;
            PG8_LDB(B1, 1, 1); PG8_STAGE(PG8_SB(1, 0), b3, voffB);
            PG8_BAR; PG8_WAIT_L(0); PG8_MMA(0, 1, At, B1); PG8_BAR;
            PG8_LDA(At, 1, 1); PG8_STAGE(PG8_SA(1, 0), a3, voffA);
            PG8_BAR; PG8_WAIT_L(0); PG8_MMA(1, 0, At, B0); PG8_BAR; PG8_SCHED;
            PG8_STAGE(PG8_SB(1, 1), b3 + hstep, voffB);
            PG8_WAIT_V(6); PG8_BAR; PG8_MMA(1, 1, At, B1); PG8_BAR;
            }
        }
        if constexpr (ALIGN_EPI) { if (wr == 0) PG8_BAR; }
        if constexpr (FP8) asm volatile("s_nop 15\n\ts_nop 15" ::: "memory");
        if constexpr (!Epi::AFTER_DRAIN) { const int l2_ = lane_opaque(); E(acc, cur, wr, wc, l2_ & 15, l2_ >> 4); S.done(cur); }
        if (!has_next) break;
#pragma unroll
        for (int a = 0; a < 2; ++a)
#pragma unroll
            for (int b = 0; b < 2; ++b)
#pragma unroll
                for (int m = 0; m < 4; ++m)
#pragma unroll
                    for (int n = 0; n < 2; ++n) acc[a][b][m][n] = (f32x4){0.f, 0.f, 0.f, 0.f};
        cur = nxt; cA = nA; cB = nB; ++ui;
        if constexpr (ALIGN_EPI) { if (wr == 1) PG8_BAR; }
    }
    PG8_WAIT_V(0);
    if constexpr (!ALIGN_EPI) { if (wr == 0) PG8_BAR; }
    PG8_BAR;
    if constexpr (Epi::AFTER_DRAIN) { E.fused(acc, cur, wr, wc, fr, fq, lds, wid, lane); S.done(cur); }
#undef PG8_SA
#undef PG8_SB
#undef PG8_STAGE
#undef PG8_LDA
#undef PG8_LDB
#undef PG8_MMA
#undef PG8_WAIT_V
#undef PG8_WAIT_L
#undef PG8_BAR
#undef PG8_SCHED
}
}

__device__ __forceinline__ float wave_sum(float v) {
    const int l = lane_opaque();
#pragma unroll
    for (int o = 1; o < 64; o <<= 1) v += __builtin_bit_cast(float, __builtin_amdgcn_ds_bpermute((l ^ o) << 2, __builtin_bit_cast(int, v)));
    return v;
}
__device__ __forceinline__ float wave_max(float v) {
    const int l = lane_opaque();
#pragma unroll
    for (int o = 1; o < 64; o <<= 1) v = fmaxf(v, __builtin_bit_cast(float, __builtin_amdgcn_ds_bpermute((l ^ o) << 2, __builtin_bit_cast(int, v))));
    return v;
}
__device__ __forceinline__ float silu_f(float v) { return v / (1.f + __expf(-v)); }

struct Args {
    const float* x; const float* c; const float* rel_bias; const float* ada_w; const float* ada_b; const float* norm_g;
    const float* moba_w_qkv; const float* moba_w_o; const float* diff_w_qkv; const float* diff_w_o;
    const float* diff_lambda; const float* diff_subln_g; const float* ffn_w_in; const float* ffn_w_out;
    float* out; unsigned char* ws;
};

__device__ __forceinline__ int t5_bucket(int rel) {
    const int n = rel < 0 ? 0 : rel;
    const float nf = (float)(n < 1 ? 1 : n);
    int large = 16 + (int)(logf(nf / 16.0f) / 4.852030263919617f * 16.0f);
    large = large < 31 ? large : 31;
    return n < 16 ? n : large;
}

__device__ __forceinline__ void p_mod(const Args& a, LAS unsigned char* lds, int blk, int G, int tid, int wave, int lane) {
    LAS float* sc = (LAS float*)lds;
    LAS float* red = sc + 2048;
    for (int i = tid; i < 2048; i += NTHR) sc[i] = silu_f(a.c[i]);
    __syncthreads();
    float* mod = (float*)(a.ws + WS_MOD);
    for (int it = blk; it < 192; it += G) {
        const int l = it / 96, j0 = (it % 96) * 64;
        const float* w = a.ada_w + (size_t)l * D * 6144 + j0 + lane;
        float s0 = 0.f, s1 = 0.f;
#pragma unroll 1
        for (int kb = wave * 128; kb < wave * 128 + 128; kb += 32) { float wv[32];
#pragma unroll
            for (int k = 0; k < 32; ++k) wv[k] = w[(size_t)(kb + k) * 6144];
#pragma unroll
            for (int k = 0; k < 32; ++k) { s0 += sc[kb + k] * wv[k]; s1 += sc[1024 + kb + k] * wv[k]; } }
        red[(wave * 2 + 0) * 64 + lane] = s0; red[(wave * 2 + 1) * 64 + lane] = s1;
        __syncthreads();
        if (tid < 128) { const int bb = tid >> 6, cl = tid & 63; float sum = 0.f;
#pragma unroll
            for (int w8 = 0; w8 < 8; ++w8) sum += red[(w8 * 2 + bb) * 64 + cl];
            mod[(l * 2 + bb) * 6144 + j0 + cl] = sum + a.ada_b[l * 6144 + j0 + cl]; }
        __syncthreads();
    }
    float* bt = (float*)(a.ws + WS_BIAST);
    for (int i = blk * NTHR + tid; i < 8 * 2304; i += G * NTHR) { const int h = i / 2304, rel = 2047 - (i % 2304); bt[i] = rel >= 0 ? a.rel_bias[t5_bucket(rel) * NH + h] * LOG2E : 0.f; }
}

__device__ __forceinline__ void transpose_item(const float* W, int K, int N, int k0, int n0, bf16* WT, int dst_row0, LAS float* scr, int lane) {
    float tv[32];
#pragma unroll
    for (int i = 0; i < 32; ++i) tv[i] = W[(size_t)(k0 + 2 * i + (lane >> 5)) * N + n0 + (lane & 31)];
#pragma unroll
    for (int i = 0; i < 32; ++i) scr[(2 * i + (lane >> 5)) * 33 + (lane & 31)] = tv[i];
    asm volatile("s_waitcnt lgkmcnt(0)" ::: "memory");
    const int c = lane & 7;
#pragma unroll
    for (int j = 0; j < 4; ++j) { const int n = (lane >> 3) + 8 * j; const LAS float* sp = scr + (8 * c) * 33 + n;
        u32x4 o; o.x = pk2(sp[0 * 33], sp[1 * 33]); o.y = pk2(sp[2 * 33], sp[3 * 33]); o.z = pk2(sp[4 * 33], sp[5 * 33]); o.w = pk2(sp[6 * 33], sp[7 * 33]);
        *(u32x4*)(WT + (size_t)(dst_row0 + n) * K + k0 + 8 * c) = o; }
    asm volatile("s_waitcnt lgkmcnt(0)" ::: "memory");
}
constexpr float F8_SH = 8.0f;
constexpr float F8_SA = 4.0f, F8_SB = 256.0f;
__device__ __forceinline__ unsigned pk4_fp8(float a, float b, float c, float d) {
    a = fminf(fmaxf(a, -448.f), 448.f); b = fminf(fmaxf(b, -448.f), 448.f); c = fminf(fmaxf(c, -448.f), 448.f); d = fminf(fmaxf(d, -448.f), 448.f);
    int w = __builtin_amdgcn_cvt_pk_fp8_f32(a, b, 0, false); w = __builtin_amdgcn_cvt_pk_fp8_f32(c, d, w, true); return (unsigned)w;
}
__device__ __forceinline__ void transpose_item_fp8(const float* W, int K, int N, int k0, int n0, unsigned char* WT, int dst_row0, LAS float* scr, int lane) {
    float tv[32];
#pragma unroll
    for (int i = 0; i < 32; ++i) tv[i] = W[(size_t)(k0 + 2 * i + (lane >> 5)) * N + n0 + (lane & 31)];
#pragma unroll
    for (int i = 0; i < 32; ++i) scr[(2 * i + (lane >> 5)) * 33 + (lane & 31)] = tv[i];
    asm volatile("s_waitcnt lgkmcnt(0)" ::: "memory");
#pragma unroll
    for (int j = 0; j < 2; ++j) { const int ch = lane + 64 * j, n = ch >> 2, c = ch & 3; const LAS float* sp = scr + (16 * c) * 33 + n;
        u32x4 o;
        o.x = pk4_fp8(sp[0 * 33] * F8_SB, sp[1 * 33] * F8_SB, sp[2 * 33] * F8_SB, sp[3 * 33] * F8_SB);
        o.y = pk4_fp8(sp[4 * 33] * F8_SB, sp[5 * 33] * F8_SB, sp[6 * 33] * F8_SB, sp[7 * 33] * F8_SB);
        o.z = pk4_fp8(sp[8 * 33] * F8_SB, sp[9 * 33] * F8_SB, sp[10 * 33] * F8_SB, sp[11 * 33] * F8_SB);
        o.w = pk4_fp8(sp[12 * 33] * F8_SB, sp[13 * 33] * F8_SB, sp[14 * 33] * F8_SB, sp[15 * 33] * F8_SB);
        *(u32x4*)(WT + (size_t)(dst_row0 + n) * K + k0 + 16 * c) = o; }
    asm volatile("s_waitcnt lgkmcnt(0)" ::: "memory");
}
__device__ __forceinline__ void p_weights(const Args& a, LAS unsigned char* lds, int gw, int ngw, int wave, int lane) {
    LAS float* scr = (LAS float*)(lds + wave * 16384);
    constexpr int I_QKV = (D / 64) * (3 * D / 32), I_O = (D / 64) * (D / 32), I_IN = (D / 64) * (2 * DFF / 32), I_OUT = (DFF / 64) * (D / 32);
    constexpr int PER_L = I_QKV + I_O + I_IN + I_OUT;
    for (int it = gw; it < 2 * PER_L; it += ngw) {
        const int l = it / PER_L; int r = it % PER_L;
        unsigned char* wl = a.ws + WS_W + (size_t)l * WL_STRIDE;
        if (r < I_QKV) { const int nb = 3 * D / 32, kb = r / nb, n0 = (r % nb) * 32; transpose_item(l == 0 ? a.moba_w_qkv : a.diff_w_qkv, D, 3 * D, kb * 64, n0, (bf16*)(wl + WO_QKV), n0, scr, lane); continue; } r -= I_QKV;
        if (r < I_O) continue; r -= I_O;
        if (r < I_IN) { const int nb = 2 * DFF / 32, kb = r / nb, n0 = (r % nb) * 32;
            const int isu = n0 >= DFF ? 1 : 0, nn = n0 - isu * DFF, dst = 256 * (nn / 128) + 128 * isu + (nn % 128);
            transpose_item_fp8(a.ffn_w_in + (size_t)l * D * 2 * DFF, D, 2 * DFF, kb * 64, n0, wl + WO_IN, dst, scr, lane); continue; } r -= I_IN;
        { const int nb = D / 32, kb = r / nb, n0 = (r % nb) * 32; transpose_item_fp8(a.ffn_w_out + (size_t)l * DFF * D, DFF, D, kb * 64, n0, wl + WO_OUT, n0, scr, lane); }
    }
}

__device__ __forceinline__ void p_wo_perm(const Args& a, int gtid, int gthreads) {
    for (int idx = gtid; idx < 2 * 128 * D; idx += gthreads) {
        const int l = idx / (128 * D), rem = idx % (128 * D), c = rem / D, n = rem % D;
        const float* W = l == 0 ? a.moba_w_o : a.diff_w_o;
        float v[8];
#pragma unroll
        for (int e = 0; e < 8; ++e) { const int kp = 8 * c + e, hh = kp >> 7, wi = kp & 127, k = hh * 128 + (wi & 3) * 32 + (wi >> 2); v[e] = W[(size_t)k * D + n]; }
        u32x4 o; o.x = pk2(v[0], v[1]); o.y = pk2(v[2], v[3]); o.z = pk2(v[4], v[5]); o.w = pk2(v[6], v[7]);
        *(u32x4*)((bf16*)(a.ws + WS_W + (size_t)l * WL_STRIDE + WO_O) + (size_t)n * D + 8 * c) = o;
    }
}

__device__ __forceinline__ void p_norm_in(const float* X, const float* g, const float* sh, const float* sc, bf16* H, int gw, int ngw, int lane) {
    for (int m = gw; m < M; m += ngw) {
        const int b = m / SEQ;
        const f32x4* xr = (const f32x4*)(X + (size_t)m * D) + lane;
        f32x4 v[4]; float s = 0.f;
#pragma unroll
        for (int j = 0; j < 4; ++j) { v[j] = xr[64 * j]; s += (v[j].x * v[j].x + v[j].y * v[j].y) + (v[j].z * v[j].z + v[j].w * v[j].w); }
        const float r = 1.0f / sqrtf(wave_sum(s) * (1.f / D) + RMS_EPS);
        u32x2* o = (u32x2*)(H + (size_t)m * D) + lane;
#pragma unroll
        for (int j = 0; j < 4; ++j) {
            const f32x4 gg = ((const f32x4*)g)[lane + 64 * j], s1 = ((const f32x4*)(sc + b * 6144))[lane + 64 * j], s0 = ((const f32x4*)(sh + b * 6144))[lane + 64 * j];
            const f32x4 h = v[j] * r * gg * (1.0f + s1) + s0;
            u32x2 w; w.x = pk2(h.x, h.y); w.y = pk2(h.z, h.w); o[64 * j] = w;
        }
    }
}
template <bool XIN_BF, bool XOUT_BF, bool H_FP8>
__device__ __forceinline__ void p_post(const void* Xin, const bf16* Y, const float* g1, const float* gate, void* Xout,
                                       const float* g2, const float* sh, const float* sc, bf16* H, int gw, int ngw, int lane) {
    for (int m = gw; m < M; m += ngw) {
        const int b = m / SEQ;
        const u32x2* yr = (const u32x2*)(Y + (size_t)m * D) + lane;
        f32x4 y[4], xv[4]; float s = 0.f;
#pragma unroll
        for (int j = 0; j < 4; ++j) { const u32x2 w = yr[64 * j]; y[j] = (f32x4){bflo(w.x), bfhi(w.x), bflo(w.y), bfhi(w.y)};
            if (XIN_BF) { const u32x2 xw = ((const u32x2*)((const bf16*)Xin + (size_t)m * D))[lane + 64 * j]; xv[j] = (f32x4){bflo(xw.x), bfhi(xw.x), bflo(xw.y), bfhi(xw.y)}; }
            else xv[j] = ((const f32x4*)((const float*)Xin + (size_t)m * D))[lane + 64 * j];
            s += (y[j].x * y[j].x + y[j].y * y[j].y) + (y[j].z * y[j].z + y[j].w * y[j].w); }
        const float r = 1.0f / sqrtf(wave_sum(s) * (1.f / D) + RMS_EPS);
        float s2 = 0.f;
#pragma unroll
        for (int j = 0; j < 4; ++j) {
            const f32x4 gg = ((const f32x4*)g1)[lane + 64 * j], gt = ((const f32x4*)(gate + b * 6144))[lane + 64 * j];
            xv[j] = xv[j] + gt * (y[j] * r * gg);
            s2 += (xv[j].x * xv[j].x + xv[j].y * xv[j].y) + (xv[j].z * xv[j].z + xv[j].w * xv[j].w);
            if (XOUT_BF) { u32x2 w; w.x = pk2(xv[j].x, xv[j].y); w.y = pk2(xv[j].z, xv[j].w); ((u32x2*)((bf16*)Xout + (size_t)m * D))[lane + 64 * j] = w; }
            else ((f32x4*)((float*)Xout + (size_t)m * D))[lane + 64 * j] = xv[j];
        }
        if (H) {
            const float r2 = 1.0f / sqrtf(wave_sum(s2) * (1.f / D) + RMS_EPS);
            u32x2* o = (u32x2*)(H + (size_t)m * D) + lane;
#pragma unroll
            for (int j = 0; j < 4; ++j) {
                const f32x4 gg = ((const f32x4*)g2)[lane + 64 * j], s1 = ((const f32x4*)(sc + b * 6144))[lane + 64 * j], s0 = ((const f32x4*)(sh + b * 6144))[lane + 64 * j];
                const f32x4 h = xv[j] * r2 * gg * (1.0f + s1) + s0;
                if (H_FP8) ((unsigned*)((unsigned char*)H + (size_t)m * D))[lane + 64 * j] = pk4_fp8(h.x * F8_SA, h.y * F8_SA, h.z * F8_SA, h.w * F8_SA);
                else { u32x2 w; w.x = pk2(h.x, h.y); w.y = pk2(h.z, h.w); o[64 * j] = w; }
            }
        }
    }
}

__device__ __forceinline__ void p_kmean(const bf16* Kb, float* kmean, LAS unsigned char* lds, int blk, int G, int tid, int wave, int lane) {
    LAS float* red = (LAS float*)lds;
    for (int it = blk; it < BATCH * NH * 32; it += G) {
        const int b = it >> 8, h = (it >> 5) & 7, kb = it & 31;
        const bf16* p = Kb + ((size_t)b * SEQ + kb * 256 + wave * 32) * D + h * HD + 2 * lane;
        float s0 = 0.f, s1 = 0.f;
#pragma unroll 8
        for (int r = 0; r < 32; ++r) { const unsigned w = *(const unsigned*)(p + (size_t)r * D); s0 += bflo(w); s1 += bfhi(w); }
        red[wave * 128 + 2 * lane] = s0; red[wave * 128 + 2 * lane + 1] = s1;
        __syncthreads();
        if (tid < 128) { float sum = 0.f;
#pragma unroll
            for (int w8 = 0; w8 < 8; ++w8) sum += red[w8 * 128 + tid];
            kmean[(size_t)it * 128 + tid] = sum * (1.0f / 256.0f); }
        __syncthreads();
    }
}
__device__ __forceinline__ void p_gate(const bf16* Qb, const float* kmean, unsigned* sel, unsigned* cnt, unsigned short* lists, LAS unsigned char* lds, int blk, int G, int tid, int wave, int lane) {
    LAS float* km = (LAS float*)lds;
    for (int it = blk; it < 256; it += G) {
        const int bh = it >> 4, span = it & 15, b = bh >> 3, h = bh & 7;
        __syncthreads();
        for (int i = tid; i < 1024; i += NTHR) ((LAS f32x4*)km)[i] = ((const f32x4*)(kmean + (size_t)bh * 4096))[i];
        __syncthreads();
        const int q = span * 512 + wave * 64 + lane, own = (span * 512 + wave * 64) >> 8;
        unsigned mask;
        if (own <= 3) mask = (1u << own) - 1u;
        else {
            float qf[128];
            const u32x4* qp = (const u32x4*)(Qb + ((size_t)b * SEQ + q) * D + h * HD);
#pragma unroll
            for (int c = 0; c < 16; ++c) { const u32x4 w = qp[c]; qf[c * 8 + 0] = bflo(w.x); qf[c * 8 + 1] = bfhi(w.x); qf[c * 8 + 2] = bflo(w.y); qf[c * 8 + 3] = bfhi(w.y);
                qf[c * 8 + 4] = bflo(w.z); qf[c * 8 + 5] = bfhi(w.z); qf[c * 8 + 6] = bflo(w.w); qf[c * 8 + 7] = bfhi(w.w); }
            float b0 = -3e38f, b1 = -3e38f, b2 = -3e38f; int i0 = 0, i1 = 0, i2 = 0;
#pragma unroll 1
            for (int n = 0; n < own; ++n) {
                float g0 = 0.f, g1 = 0.f, g2 = 0.f, g3 = 0.f;
#pragma unroll
                for (int d = 0; d < 128; d += 4) { const f32x4 kv = *(LAS f32x4*)(km + n * 128 + d); g0 += qf[d] * kv.x; g1 += qf[d + 1] * kv.y; g2 += qf[d + 2] * kv.z; g3 += qf[d + 3] * kv.w; }
                const float g = (g0 + g1) + (g2 + g3);
                if (g > b0) { b2 = b1; i2 = i1; b1 = b0; i1 = i0; b0 = g; i0 = n; }
                else if (g > b1) { b2 = b1; i2 = i1; b1 = g; i1 = n; }
                else if (g > b2) { b2 = g; i2 = n; }
            }
            mask = (1u << i0) | (1u << i1) | (1u << i2);
        }
        sel[(size_t)bh * SEQ + q] = mask;
        unsigned mycnt = 0u;
        for (int j = 0; j < own; ++j) { const unsigned long long bl = __ballot((mask >> j) & 1u); if (lane == j) mycnt = (unsigned)__popcll(bl); }
        unsigned base = 0u;
        if (lane < own && mycnt) base = __hip_atomic_fetch_add(cnt + bh * 32 + lane, mycnt, __ATOMIC_RELAXED, __HIP_MEMORY_SCOPE_AGENT);
        for (int j = 0; j < own; ++j) { const unsigned long long bl = __ballot((mask >> j) & 1u); const unsigned bj = (unsigned)__builtin_amdgcn_readlane((int)base, j);
            if ((mask >> j) & 1u) lists[((size_t)bh * 32 + j) * 8192 + bj + (unsigned)__popcll(bl & ((1ull << lane) - 1ull))] = (unsigned short)q; }
    }
}

namespace att {
typedef short bf16x8 __attribute__((ext_vector_type(8)));
typedef short s16x4 __attribute__((ext_vector_type(4)));
typedef float f32x16 __attribute__((ext_vector_type(16)));
typedef LAS const char* lcp;
constexpr int PITCH = 1024;
constexpr int SHM_V = 16384, SHM_K = 16384;
constexpr int L_K = 0, L_V = 65536, L_WS = 131072, L_LUT = 133120;
constexpr int LUTN = 2304, RMAXL = 2047, RFAR = 1536;
#define KSWZ(row, colB) ((row) * 256 + ((colB) ^ (((row) & 7) << 4)))
#define SBAR() __builtin_amdgcn_sched_barrier(0)
#define WG_BAR() do { asm volatile("s_waitcnt lgkmcnt(0)" ::: "memory"); __builtin_amdgcn_s_barrier(); asm volatile("" ::: "memory"); } while (0)
__device__ __forceinline__ int v_st(int k, int c) { const int kk = (k & ~0xC) | ((k & 4) << 1) | ((k & 8) >> 1); return ((kk >> 3) * 4 + (c >> 5)) * 512 + ((kk & 7) * 32 + (c & 31)) * 2; }
__device__ __forceinline__ int v_rd_base(int lane) { return ((lane & 3) << 3) | (((lane >> 2) & 3) << 6) | (((lane >> 4) & 1) << 5) | (((lane >> 5) & 1) << 8); }
constexpr int v_rd_off(int d0, int ks, int half) { return d0 * 512 + ks * 4096 + half * 2048; }
__device__ __forceinline__ int crow(int r, int hi) { return (r & 3) + 8 * (r >> 2) + 4 * hi; }
__device__ __forceinline__ unsigned cvtpk(float lo, float hi) { unsigned r; asm volatile("v_cvt_pk_bf16_f32 %0, %1, %2" : "=v"(r) : "v"(lo), "v"(hi)); return r; }

template <int KB, int NDS>
__device__ __forceinline__ void qkt(f32x16& p0, f32x16& p1, lcp K_lds, int r32, int hi, int coff, const bf16x8* qr) {
    lcp kb[4];
#pragma unroll
    for (int dd = 0; dd < 4; ++dd) kb[dd] = K_lds + KB * SHM_K + KSWZ(r32, (dd * 16 + hi * 8) * 2) + coff;
#pragma unroll
    for (int d0 = 0; d0 < NDS; ++d0) { lcp a = kb[d0 & 3] + (d0 >> 2) * 128;
        const bf16x8 b0 = *(LAS const bf16x8*)a;
        const bf16x8 b1 = *(LAS const bf16x8*)(a + 32 * 256);
        p0 = __builtin_amdgcn_mfma_f32_32x32x16_bf16(b0, qr[d0], p0, 0, 0, 0);
        p1 = __builtin_amdgcn_mfma_f32_32x32x16_bf16(b1, qr[d0], p1, 0, 0, 0);
        if (NDS == 8 && (d0 & 1) == 1) SBAR(); }
}
template <int VB>
__device__ __forceinline__ void pv_tile(f32x16* o, int vb0, bf16x8 pa0, bf16x8 pa1, bf16x8 pa2, bf16x8 pa3) {
#define TRRD(dst, off) asm volatile("ds_read_b64_tr_b16 %0, %1 offset:%2" : "=&v"(dst) : "v"(vb0), "i"(off) : "memory")
#define PV_D0(d0) do { s16x4 l0, l1, l2, l3, h0, h1, h2, h3; constexpr int b_ = VB * SHM_V + v_rd_off(d0, 0, 0); \
        TRRD(l0, b_); TRRD(h0, b_ + 2048); TRRD(l1, b_ + 4096); TRRD(h1, b_ + 6144); TRRD(l2, b_ + 8192); TRRD(h2, b_ + 10240); TRRD(l3, b_ + 12288); TRRD(h3, b_ + 14336); \
        asm volatile("s_waitcnt lgkmcnt(0)" ::: "memory"); SBAR(); \
        o[d0] = __builtin_amdgcn_mfma_f32_32x32x16_bf16(pa0, (bf16x8){l0[0], l0[1], l0[2], l0[3], h0[0], h0[1], h0[2], h0[3]}, o[d0], 0, 0, 0); \
        o[d0] = __builtin_amdgcn_mfma_f32_32x32x16_bf16(pa1, (bf16x8){l1[0], l1[1], l1[2], l1[3], h1[0], h1[1], h1[2], h1[3]}, o[d0], 0, 0, 0); \
        o[d0] = __builtin_amdgcn_mfma_f32_32x32x16_bf16(pa2, (bf16x8){l2[0], l2[1], l2[2], l2[3], h2[0], h2[1], h2[2], h2[3]}, o[d0], 0, 0, 0); \
        o[d0] = __builtin_amdgcn_mfma_f32_32x32x16_bf16(pa3, (bf16x8){l3[0], l3[1], l3[2], l3[3], h3[0], h3[1], h3[2], h3[3]}, o[d0], 0, 0, 0); } while (0)
    PV_D0(0); PV_D0(1); PV_D0(2); PV_D0(3);
#undef PV_D0
#undef TRRD
}

template <int NDS>
__device__ __forceinline__ void kread(bf16x8* kf, int kaddr_base, int r32, int hi, int coff) {
#pragma unroll
    for (int d0 = 0; d0 < NDS; ++d0) { const int a = kaddr_base + KSWZ(r32, ((d0 & 3) * 16 + hi * 8) * 2) + coff + (d0 >> 2) * 128;
        asm volatile("ds_read_b128 %0, %1" : "=&v"(kf[2 * d0]) : "v"(a) : "memory");
        asm volatile("ds_read_b128 %0, %1 offset:8192" : "=&v"(kf[2 * d0 + 1]) : "v"(a) : "memory"); }
}
template <int NDS>
__device__ __forceinline__ void kmma(f32x16& p0, f32x16& p1, const bf16x8* kf, const bf16x8* qr) {
#pragma unroll
    for (int d0 = 0; d0 < NDS; ++d0) { p0 = __builtin_amdgcn_mfma_f32_32x32x16_bf16(kf[2 * d0], qr[d0], p0, 0, 0, 0); p1 = __builtin_amdgcn_mfma_f32_32x32x16_bf16(kf[2 * d0 + 1], qr[d0], p1, 0, 0, 0); }
}

__device__ __forceinline__ void pv_tile_pf(f32x16* o, int vb0, bf16x8 pa0, bf16x8 pa1, bf16x8 pa2, bf16x8 pa3) {
#define TRRD(dst, off) asm volatile("ds_read_b64_tr_b16 %0, %1 offset:%2" : "=&v"(dst) : "v"(vb0), "i"(off) : "memory")
#define RD8(S, d0) do { constexpr int b_ = v_rd_off(d0, 0, 0); TRRD(S[0], b_); TRRD(S[1], b_ + 2048); TRRD(S[2], b_ + 4096); TRRD(S[3], b_ + 6144); \
        TRRD(S[4], b_ + 8192); TRRD(S[5], b_ + 10240); TRRD(S[6], b_ + 12288); TRRD(S[7], b_ + 14336); } while (0)
#define MMA4(d0, S) do { \
        o[d0] = __builtin_amdgcn_mfma_f32_32x32x16_bf16(pa0, (bf16x8){S[0][0], S[0][1], S[0][2], S[0][3], S[1][0], S[1][1], S[1][2], S[1][3]}, o[d0], 0, 0, 0); \
        o[d0] = __builtin_amdgcn_mfma_f32_32x32x16_bf16(pa1, (bf16x8){S[2][0], S[2][1], S[2][2], S[2][3], S[3][0], S[3][1], S[3][2], S[3][3]}, o[d0], 0, 0, 0); \
        o[d0] = __builtin_amdgcn_mfma_f32_32x32x16_bf16(pa2, (bf16x8){S[4][0], S[4][1], S[4][2], S[4][3], S[5][0], S[5][1], S[5][2], S[5][3]}, o[d0], 0, 0, 0); \
        o[d0] = __builtin_amdgcn_mfma_f32_32x32x16_bf16(pa3, (bf16x8){S[6][0], S[6][1], S[6][2], S[6][3], S[7][0], S[7][1], S[7][2], S[7][3]}, o[d0], 0, 0, 0); } while (0)
    s16x4 sa[8], sb[8];
    RD8(sa, 0); RD8(sb, 1);
    asm volatile("s_waitcnt lgkmcnt(8)" ::: "memory"); SBAR(); MMA4(0, sa); SBAR();
    RD8(sa, 2);
    asm volatile("s_waitcnt lgkmcnt(8)" ::: "memory"); SBAR(); MMA4(1, sb); SBAR();
    RD8(sb, 3);
    asm volatile("s_waitcnt lgkmcnt(8)" ::: "memory"); SBAR(); MMA4(2, sa); SBAR();
    asm volatile("s_waitcnt lgkmcnt(0)" ::: "memory"); SBAR(); MMA4(3, sb);
#undef MMA4
#undef RD8
#undef TRRD
}
constexpr float THR2 = 8.0f;
__device__ __forceinline__ void partial_sm(f32x16& p0, f32x16& p1, float sh, float& m_reg, float& alpha) {
    float pmax = p0[0];
#pragma unroll
    for (int r = 1; r < 16; ++r) pmax = fmaxf(pmax, p0[r]);
#pragma unroll
    for (int r = 0; r < 16; ++r) pmax = fmaxf(pmax, p1[r]);
    { auto rr = __builtin_amdgcn_permlane32_swap(__float_as_uint(pmax), __float_as_uint(pmax), false, false);
      pmax = fmaxf(__uint_as_float(rr[0]), __uint_as_float(rr[1])); }
    pmax += sh;
    float mn;
    if (__builtin_expect(__all((pmax - m_reg) <= THR2), 1)) { mn = m_reg; alpha = 1.f; }
    else { const bool upd = (pmax - m_reg) > THR2;
        mn = upd ? fmaxf(m_reg, pmax) : m_reg; alpha = upd ? __builtin_amdgcn_exp2f(m_reg - mn) : 1.f; m_reg = mn; }
    const float off = mn - sh;
#pragma unroll
    for (int r = 0; r < 16; ++r) p0[r] = __builtin_amdgcn_exp2f(p0[r] - off);
#pragma unroll
    for (int r = 0; r < 16; ++r) p1[r] = p1[r] - off;
}
__device__ __forceinline__ void finish_sm(f32x16& p0, f32x16& p1, float alpha, float& l_reg, bf16x8& pa0, bf16x8& pa1, bf16x8& pa2, bf16x8& pa3) {
#pragma unroll
    for (int r = 0; r < 16; ++r) p1[r] = __builtin_amdgcn_exp2f(p1[r]);
    float ps = 0.f;
#pragma unroll
    for (int r = 0; r < 16; ++r) ps += p0[r];
#pragma unroll
    for (int r = 0; r < 16; ++r) ps += p1[r];
    { auto rr = __builtin_amdgcn_permlane32_swap(__float_as_uint(ps), __float_as_uint(ps), false, false);
      ps = __uint_as_float(rr[0]) + __uint_as_float(rr[1]); }
    l_reg = l_reg * alpha + ps;
#define PK4(P, B_, OUT) do { unsigned a0 = cvtpk(P[B_+0], P[B_+1]), a1 = cvtpk(P[B_+2], P[B_+3]); \
        unsigned b0 = cvtpk(P[B_+4], P[B_+5]), b1 = cvtpk(P[B_+6], P[B_+7]); \
        auto r0 = __builtin_amdgcn_permlane32_swap(a0, b0, false, false); auto r1 = __builtin_amdgcn_permlane32_swap(a1, b1, false, false); \
        u32x4 w = {r0[0], r1[0], r0[1], r1[1]}; OUT = __builtin_bit_cast(bf16x8, w); } while (0)
    PK4(p0, 0, pa0); PK4(p0, 8, pa1); PK4(p1, 0, pa2); PK4(p1, 8, pa3);
#undef PK4
}
__device__ __forceinline__ void softmax_tile(f32x16& p0, f32x16& p1, float sh, float& m_reg, float& l_reg, float& alpha, bf16x8& pa0, bf16x8& pa1, bf16x8& pa2, bf16x8& pa3) {
    partial_sm(p0, p1, sh, m_reg, alpha); finish_sm(p0, p1, alpha, l_reg, pa0, pa1, pa2, pa3);
}
__device__ __forceinline__ void add_bias_lut(f32x16& p0, f32x16& p1, LAS const float* lut, int dq) {
    LAS const float* bp = lut + (RMAXL - dq);
#pragma unroll
    for (int r = 0; r < 16; ++r) { const int c = (r & 3) + 8 * (r >> 2); p0[r] += bp[c]; p1[r] += bp[c + 32]; if ((r & 3) == 3) asm volatile("" ::: "memory"); }
}
__device__ __forceinline__ void load_bias_lut(f32x16& p0, f32x16& p1, LAS const float* lut, int dq) {
    LAS const float* bp = lut + (RMAXL - dq);
#pragma unroll
    for (int r = 0; r < 16; ++r) { const int c = (r & 3) + 8 * (r >> 2); p0[r] = bp[c]; p1[r] = bp[c + 32]; }
}
__device__ __forceinline__ void causal_mask(f32x16& p0, f32x16& p1, int dq) {
    const float NEG = -__builtin_inff();
#pragma unroll
    for (int r = 0; r < 16; ++r) { const int c = (r & 3) + 8 * (r >> 2); if (dq - c < 0) p0[r] = NEG; if (dq - c - 32 < 0) p1[r] = NEG; }
}
struct DmaOff { unsigned k[2], v[2]; };
__device__ __forceinline__ DmaOff dma_offsets(int wid, int lane) {
    DmaOff d;
#pragma unroll
    for (int i = 0; i < 2; ++i) { const int p = wid * 2 + i;
        { const int row = 4 * p + (lane >> 4), c = (lane & 15) ^ (row & 7); d.k[i] = (unsigned)(row * PITCH * 2 + c * 16); }
        { const int sub = 2 * p + (lane >> 5), kkhi = sub >> 2, cblk = sub & 3, kklo = (lane & 31) >> 2, kk = kkhi * 8 + kklo;
          const int k = (kk & ~0xC) | ((kk & 4) << 1) | ((kk & 8) >> 1), c = cblk * 32 + (lane & 3) * 8; d.v[i] = (unsigned)(k * PITCH * 2 + c * 2); } }
    return d;
}
__device__ __forceinline__ void dma_tile(LAS char* lds, int bf, const bf16* Kc, const bf16* Vc, int k0, const DmaOff& d, int wid) {
    const char* kt = (const char*)Kc + (size_t)k0 * (PITCH * 2); const char* vt = (const char*)Vc + (size_t)k0 * (PITCH * 2);
#pragma unroll
    for (int i = 0; i < 2; ++i) {
        __builtin_amdgcn_global_load_lds((const unsigned*)(kt + d.k[i]), (LAS unsigned*)(lds + L_K + bf * SHM_K + (wid * 2 + i) * 1024), 16, 0, 0);
        __builtin_amdgcn_global_load_lds((const unsigned*)(vt + d.v[i]), (LAS unsigned*)(lds + L_V + bf * SHM_V + (wid * 2 + i) * 1024), 16, 0, 0); }
}
constexpr int L_CF = 142336, L_TAB = 146432, L_FOUND = 148544;
__device__ __forceinline__ void build_lut(LAS char* lds, const float* biasT, int h, int tid) {
    LAS float* lut = (LAS float*)(lds + L_LUT);
    for (int i = tid; i < LUTN; i += 512) lut[i] = biasT[h * LUTN + i];
}

typedef int i32x8v __attribute__((ext_vector_type(8)));
typedef int i32x4v __attribute__((ext_vector_type(4)));
constexpr int SHM_V8 = 8192;
constexpr float F8_SP = 256.0f, F8_SV = 8.0f;
__device__ __forceinline__ unsigned dma_v8_offset(int wid, int lane) { const int row = wid * 16 + (lane >> 2), c = (lane & 3) ^ ((row >> 2) & 3); return (unsigned)(row * M + c * 16); }
__device__ __forceinline__ void dma_tile_k_v8(LAS char* lds, int slot, const bf16* Kc, const unsigned char* V8c, int k0, const DmaOff& d, unsigned v8off, int wid) {
    const char* kt = (const char*)Kc + (size_t)k0 * (PITCH * 2);
#pragma unroll
    for (int i = 0; i < 2; ++i) __builtin_amdgcn_global_load_lds((const unsigned*)(kt + d.k[i]), (LAS unsigned*)(lds + L_K + slot * SHM_K + (wid * 2 + i) * 1024), 16, 0, 0);
    __builtin_amdgcn_global_load_lds((const unsigned*)(V8c + k0 + v8off), (LAS unsigned*)(lds + L_V + slot * SHM_V8 + wid * 1024), 16, 0, 0);
}
__device__ __forceinline__ void pv8(f32x16* o, int a0, int a1, const i32x8v& P8) {
    i32x4v lo0, lo1, lo2, lo3, h0, h1, h2, h3;
    asm volatile("ds_read_b128 %0, %1" : "=&v"(lo0) : "v"(a0) : "memory");            asm volatile("ds_read_b128 %0, %1" : "=&v"(h0) : "v"(a1) : "memory");
    asm volatile("ds_read_b128 %0, %1 offset:2048" : "=&v"(lo1) : "v"(a0) : "memory"); asm volatile("ds_read_b128 %0, %1 offset:2048" : "=&v"(h1) : "v"(a1) : "memory");
    asm volatile("ds_read_b128 %0, %1 offset:4096" : "=&v"(lo2) : "v"(a0) : "memory"); asm volatile("ds_read_b128 %0, %1 offset:4096" : "=&v"(h2) : "v"(a1) : "memory");
    asm volatile("ds_read_b128 %0, %1 offset:6144" : "=&v"(lo3) : "v"(a0) : "memory"); asm volatile("ds_read_b128 %0, %1 offset:6144" : "=&v"(h3) : "v"(a1) : "memory");
#define PV8_MMA(d0, L, H) do { const i32x8v b_ = {L[0], L[1], L[2], L[3], H[0], H[1], H[2], H[3]}; \
        asm volatile("v_mfma_f32_32x32x64_f8f6f4 %0, %1, %2, %0 cbsz:1" : "+v"(o[d0]) : "v"(P8), "v"(b_)); } while (0)
    asm volatile("s_waitcnt lgkmcnt(6)" ::: "memory"); PV8_MMA(0, lo0, h0);
    asm volatile("s_waitcnt lgkmcnt(4)" ::: "memory"); PV8_MMA(1, lo1, h1);
    asm volatile("s_waitcnt lgkmcnt(2)" ::: "memory"); PV8_MMA(2, lo2, h2);
    asm volatile("s_waitcnt lgkmcnt(0)" ::: "memory"); PV8_MMA(3, lo3, h3);
#undef PV8_MMA
}
__device__ __forceinline__ void softmax_tile8(f32x16& p0, f32x16& p1, float sh, float& m_reg, float& l_reg, float& alpha, i32x8v& P8) {
    float pmax = p0[0];
#pragma unroll
    for (int r = 1; r < 16; ++r) pmax = fmaxf(pmax, p0[r]);
#pragma unroll
    for (int r = 0; r < 16; ++r) pmax = fmaxf(pmax, p1[r]);
    { auto rr = __builtin_amdgcn_permlane32_swap(__float_as_uint(pmax), __float_as_uint(pmax), false, false);
      pmax = fmaxf(__uint_as_float(rr[0]), __uint_as_float(rr[1])); }
    pmax += sh;
    float mn;
    if (__builtin_expect(__all((pmax - m_reg) <= 6.0f), 1)) { mn = m_reg; alpha = 1.f; }
    else { const bool upd = (pmax - m_reg) > 6.0f; mn = upd ? fmaxf(m_reg, pmax) : m_reg; alpha = upd ? __builtin_amdgcn_exp2f(m_reg - mn) : 1.f; m_reg = mn; }
    const float off = mn - sh - 8.0f;
#pragma unroll
    for (int r = 0; r < 16; ++r) p0[r] = __builtin_amdgcn_exp2f(p0[r] - off);
#pragma unroll
    for (int r = 0; r < 16; ++r) p1[r] = __builtin_amdgcn_exp2f(p1[r] - off);
    float ps = 0.f;
#pragma unroll
    for (int r = 0; r < 16; ++r) ps += p0[r];
#pragma unroll
    for (int r = 0; r < 16; ++r) ps += p1[r];
    { auto rr = __builtin_amdgcn_permlane32_swap(__float_as_uint(ps), __float_as_uint(ps), false, false);
      ps = __uint_as_float(rr[0]) + __uint_as_float(rr[1]); }
    l_reg = l_reg * alpha + ps;
#pragma unroll
    for (int i = 0; i < 4; ++i) { int t_ = __builtin_amdgcn_cvt_pk_bf8_f32(p0[4 * i], p0[4 * i + 1], 0, false); P8[i] = __builtin_amdgcn_cvt_pk_bf8_f32(p0[4 * i + 2], p0[4 * i + 3], t_, true); }
#pragma unroll
    for (int i = 0; i < 4; ++i) { int t_ = __builtin_amdgcn_cvt_pk_bf8_f32(p1[4 * i], p1[4 * i + 1], 0, false); P8[4 + i] = __builtin_amdgcn_cvt_pk_bf8_f32(p1[4 * i + 2], p1[4 * i + 3], t_, true); }
}

template <int VAR> __device__ __forceinline__ void diff_unit(LAS char* lds, int b, int h, int qb, const bf16* Q, const bf16* K, const unsigned char* V8T, bf16* O, const float* relb, const float* biasT,
                                          float lam_full, const float* subg, int tid, int wid, int lane) {
    asm volatile("" : "+v"(lane), "+v"(tid));
    const int r32 = lane & 31, hi = lane >> 5, cm = wid >> 2, w4 = wid & 3;
    const size_t rowbase = (size_t)b * SEQ;
    const int q0 = qb * 128, qw0 = q0 + w4 * 32, qpos = qw0 + r32;
    const bf16* Kc = K + rowbase * PITCH + h * HD; const unsigned char* V8c = V8T + (size_t)(h * HD) * M + rowbase;
    const int NT = (q0 + 128) / 64;
    const DmaOff dmo = dma_offsets(wid, lane);
    const unsigned v8off = dma_v8_offset(wid, lane);
    const int va0 = (int)(unsigned)(uintptr_t)(lds + L_V) + r32 * 64 + (((2 * hi) ^ ((r32 >> 2) & 3)) << 4), va1 = va0 ^ 16;
    LAS float* ws = (LAS float*)(lds + L_WS) + wid * 64;
    LAS const float* lut = (LAS const float*)(lds + L_LUT);
    lcp K_lds = (lcp)(lds + L_K);
    const float b31 = relb[31 * 8 + h] * 1.4426950408889634f;
    build_lut(lds, biasT, h, tid);
    bf16x8 qr[4];
#pragma unroll
    for (int d0 = 0; d0 < 4; ++d0) qr[d0] = *(const bf16x8*)(Q + (rowbase + qpos) * PITCH + h * HD + cm * 64 + d0 * 16 + hi * 8);
    dma_tile_k_v8(lds, 0, Kc, V8c, 0, dmo, v8off, wid);
    dma_tile_k_v8(lds, 1, Kc, V8c, 64, dmo, v8off, wid);
    asm volatile("s_waitcnt vmcnt(0)" ::: "memory");
    WG_BAR();
    float m_reg = -1e30f, l_reg = 0.f; f32x16 o[4] = {};
    f32x16 p0, p1; i32x8v P8 = {0, 0, 0, 0, 0, 0, 0, 0};
    const bool halfB = cm != 0;
    const int kl0 = (int)(unsigned)(uintptr_t)(lds + L_K);
    if (halfB) WG_BAR();
    for (int t = 0; t < NT; ++t) {
        __builtin_amdgcn_s_setprio(2);
        if (VAR != 2 && VAR != 3 && VAR != 7 && VAR != 8) { bf16x8 kf[8];
            kread<4>(kf, kl0 + (t & 3) * SHM_K, r32, hi, cm * 128);
            if (qw0 - (t * 64 + 63) >= RFAR) { p0 = f32x16{}; p1 = f32x16{}; } else load_bias_lut(p0, p1, lut, qpos - t * 64 - 4 * hi);
            if (t > 0) pv8(o, va0 + ((t - 1) & 3) * SHM_V8, va1 + ((t - 1) & 3) * SHM_V8, P8);
            asm volatile("s_waitcnt lgkmcnt(0)" ::: "memory"); SBAR();
            kmma<4>(p0, p1, kf, qr); } else { p0 = f32x16{}; p1 = f32x16{}; asm volatile("" : "+v"(p0), "+v"(p1)); }
        __builtin_amdgcn_s_setprio(0);
        if (halfB) asm volatile("s_waitcnt vmcnt(0)" ::: "memory");
        WG_BAR();
        const bool issue = VAR != 4 && VAR != 7 && VAR != 8 && t + 2 < NT;
        if (issue) dma_tile_k_v8(lds, (t + 2) & 3, Kc, V8c, (t + 2) * 64, dmo, v8off, wid);
        { const int k0_ = t * 64; float sh_ = 0.f, alpha; const int dq_ = qpos - k0_ - 4 * hi;
          if (VAR != 8) { if (qw0 - (k0_ + 63) >= RFAR) sh_ = b31;
          if (k0_ + 63 > qw0) causal_mask(p0, p1, dq_); }
          softmax_tile8(p0, p1, sh_, m_reg, l_reg, alpha, P8);
          if (__any(alpha < 1.f)) { if (hi == 0) ws[r32] = alpha; asm volatile("s_waitcnt lgkmcnt(0)" ::: "memory");
#pragma unroll
              for (int d_ = 0; d_ < 4; ++d_)
#pragma unroll
                  for (int r = 0; r < 16; ++r) o[d_][r] *= ws[crow(r, hi)]; } }
        if (!halfB) { if (issue) asm volatile("s_waitcnt vmcnt(3)" ::: "memory"); else asm volatile("s_waitcnt vmcnt(0)" ::: "memory"); }
        WG_BAR();
    }
    __builtin_amdgcn_s_setprio(2);
    pv8(o, va0 + ((NT - 1) & 3) * SHM_V8, va1 + ((NT - 1) & 3) * SHM_V8, P8);
    asm volatile("s_nop 15\n\ts_nop 15" ::: "memory");
    __builtin_amdgcn_s_setprio(0);
    if (!halfB) WG_BAR();
    WG_BAR();
    if (hi == 0) ws[32 + r32] = l_reg; asm volatile("s_waitcnt lgkmcnt(0)" ::: "memory");
#pragma unroll
    for (int r = 0; r < 16; ++r) { const float rl = __builtin_amdgcn_rcpf(ws[32 + crow(r, hi)] * F8_SV);
#pragma unroll
        for (int d0 = 0; d0 < 4; ++d0) o[d0][r] *= rl; }
    LAS float* xch = (LAS float*)lds + (size_t)w4 * 64 * 64;
    if (cm == 1) {
#pragma unroll
        for (int d0 = 0; d0 < 4; ++d0)
#pragma unroll
            for (int r = 0; r < 16; ++r) xch[(d0 * 16 + r) * 64 + lane] = o[d0][r];
    }
    WG_BAR();
    if (cm == 0) {
        float ss[16];
#pragma unroll
        for (int r = 0; r < 16; ++r) { float a = 0.f;
#pragma unroll
            for (int d0 = 0; d0 < 4; ++d0) { o[d0][r] -= lam_full * xch[(d0 * 16 + r) * 64 + lane]; a += o[d0][r] * o[d0][r]; }
            ss[r] = a; }
#pragma unroll
        for (int r = 0; r < 16; ++r) {
#pragma unroll
            for (int sft = 1; sft < 32; sft <<= 1) ss[r] += bperm_f(lane ^ sft, ss[r]); }
        float gg[4];
#pragma unroll
        for (int d0 = 0; d0 < 4; ++d0) gg[d0] = subg[d0 * 32 + r32] * (1.0f - LAMBDA_INIT);
        bf16* Ow = O + (rowbase + qw0) * PITCH + h * HD;
#pragma unroll
        for (int r = 0; r < 16; ++r) { const int orow = crow(r, hi); const float rs = 1.0f / sqrtf(ss[r] * (1.0f / HD) + RMS_EPS);
            u32x2 wo; wo.x = cvtpk(o[0][r] * rs * gg[0], o[1][r] * rs * gg[1]); wo.y = cvtpk(o[2][r] * rs * gg[2], o[3][r] * rs * gg[3]);
            *(u32x2*)(Ow + (size_t)orow * PITCH + r32 * 4) = wo; }
    }
    WG_BAR();
}


__device__ __forceinline__ void block_load(LAS char* lds, const bf16* Kc, const bf16* Vc, const DmaOff& d, int wid) {
#pragma unroll
    for (int t = 0; t < 4; ++t) dma_tile(lds, t, Kc, Vc, t * 64, d, wid);
}
#define MOBA_TILE(t, CAUSAL) do { const int k0_ = kbase + (t) * 64; \
        if (!(CAUSAL) || k0_ <= qw0 + 31) { f32x16 p0, p1; bf16x8 pa0, pa1, pa2, pa3; float alpha, sh = 0.f; \
            const int dq_ = qpos - k0_ - 4 * hi; \
            if (CAUSAL) load_bias_lut(p0, p1, lut, dq_); \
            else load_bias_lut(p0, p1, lut, dq_ < RFAR + 63 ? dq_ : RFAR + 63);     \
            qkt<t, 8>(p0, p1, K_lds, r32, hi, 0, qr); \
            if ((CAUSAL) && k0_ + 63 > qw0) causal_mask(p0, p1, dq_); \
            softmax_tile(p0, p1, sh, m_reg, l_reg, alpha, pa0, pa1, pa2, pa3); \
            if (__any(alpha < 1.f)) { if (hi == 0) ws[r32] = alpha; asm volatile("s_waitcnt lgkmcnt(0)" ::: "memory"); \
                _Pragma("unroll") for (int d_ = 0; d_ < 4; ++d_) _Pragma("unroll") for (int r = 0; r < 16; ++r) o[d_][r] *= ws[crow(r, hi)]; } \
            pv_tile<t>(o, vb0, pa0, pa1, pa2, pa3); } } while (0)
__device__ __forceinline__ void moba_part_group(LAS char* lds, int bh, int j, int g, int cntj, const bf16* Q, const unsigned short* lists, const unsigned* sel,
                                                bf16* P0, bf16* P1, bf16* P2, f32x2* ml, float b31, int wid, int lane) {
    asm volatile("" : "+v"(lane));
    const int r32 = lane & 31, hi = lane >> 5, b = bh >> 3, h = bh & 7;
    const size_t rowbase = (size_t)b * SEQ;
    const int idx = g * 32 + r32; const bool valid = idx < cntj;
    const int qpos = (int)lists[((size_t)bh * 32 + j) * 8192 + (valid ? idx : cntj - 1)];
    const unsigned smask = sel[(size_t)bh * SEQ + qpos]; const int slot = __popc(smask & ((1u << j) - 1u));
    const int vb0 = (int)(unsigned)(uintptr_t)(lds + L_V) + v_rd_base(lane);
    LAS float* ws = (LAS float*)(lds + L_WS) + wid * 64;
    LAS const float* lut = (LAS const float*)(lds + L_LUT);
    lcp K_lds = (lcp)(lds + L_K);
    bf16x8 qr[8];
#pragma unroll
    for (int d0 = 0; d0 < 8; ++d0) qr[d0] = *(const bf16x8*)(Q + (rowbase + qpos) * PITCH + h * HD + d0 * 16 + hi * 8);
    if (hi == 0) ((LAS int*)ws)[32 + r32] = valid ? (int)((unsigned)(rowbase + qpos) | ((unsigned)slot << 24)) : -1;
    float m_reg = -1e30f, l_reg = 0.f; f32x16 o[4] = {};
    const int kbase = j * 256, qw0 = 0; (void)qw0;
    MOBA_TILE(0, false); MOBA_TILE(1, false); MOBA_TILE(2, false); MOBA_TILE(3, false);
    if (hi == 0) { ws[r32] = l_reg; if (valid) ml[((size_t)slot * M + rowbase + qpos) * NH + h] = (f32x2){m_reg, l_reg}; }
    asm volatile("s_waitcnt lgkmcnt(0)" ::: "memory");
#pragma unroll
    for (int r = 0; r < 16; ++r) { const int orow = crow(r, hi); const float rl = __builtin_amdgcn_rcpf(ws[orow]); const int info = ((LAS const int*)ws)[32 + orow];
        const int sl = info >> 24; bf16* Pb = sl == 0 ? P0 : (sl == 1 ? P1 : P2); bf16* Ow = Pb + (size_t)(info & 0xffffff) * PITCH + h * HD;
        u32x2 w; w.x = cvtpk(o[0][r] * rl, o[1][r] * rl); w.y = cvtpk(o[2][r] * rl, o[3][r] * rl);
        if (info >= 0) *(u32x2*)(Ow + r32 * 4) = w; }
    asm volatile("s_waitcnt lgkmcnt(0)" ::: "memory");
}
__device__ __forceinline__ void moba_own_rows(LAS char* lds, int b, int h, int qb, const bf16* Q, bf16* O, const bf16* P0, const bf16* P1, const bf16* P2, const f32x2* ml, int wid, int lane) {
    asm volatile("" : "+v"(lane));
    const int r32 = lane & 31, hi = lane >> 5;
    const size_t rowbase = (size_t)b * SEQ;
    const int q0 = qb * 256, qw0 = q0 + wid * 32, qpos = qw0 + r32, kbase = q0;
    const int vb0 = (int)(unsigned)(uintptr_t)(lds + L_V) + v_rd_base(lane);
    LAS float* ws = (LAS float*)(lds + L_WS) + wid * 64;
    LAS const float* lut = (LAS const float*)(lds + L_LUT);
    lcp K_lds = (lcp)(lds + L_K);
    const float b31 = 0.f; (void)b31;
    bf16x8 qr[8];
#pragma unroll
    for (int d0 = 0; d0 < 8; ++d0) qr[d0] = *(const bf16x8*)(Q + (rowbase + qpos) * PITCH + h * HD + d0 * 16 + hi * 8);
    float m_reg = -1e30f, l_reg = 0.f; f32x16 o[4] = {};
    MOBA_TILE(0, true); MOBA_TILE(1, true); MOBA_TILE(2, true); MOBA_TILE(3, true);
    const int nsel = qb < 3 ? qb : 3;
    {
        float ms[3], ls[3]; float mx = m_reg;
#pragma unroll
        for (int s_ = 0; s_ < 3; ++s_) { ms[s_] = -1e30f; ls[s_] = 0.f;
            if (s_ < nsel) { const f32x2 v = ml[((size_t)s_ * M + rowbase + qpos) * NH + h]; ms[s_] = v.x; ls[s_] = v.y; mx = fmaxf(mx, v.x); } }
        const float w0 = __builtin_amdgcn_exp2f(m_reg - mx);
        float wv[3]; float den = l_reg * w0;
#pragma unroll
        for (int s_ = 0; s_ < 3; ++s_) { wv[s_] = ls[s_] * __builtin_amdgcn_exp2f(ms[s_] - mx); den += wv[s_]; }
        const float rd = 1.0f / den;
        if (hi == 0) *(LAS f32x4*)(lds + L_CF + wid * 512 + r32 * 16) = (f32x4){w0 * rd, wv[0] * rd, wv[1] * rd, wv[2] * rd};
    }
    asm volatile("s_waitcnt lgkmcnt(0)" ::: "memory");
#pragma unroll
    for (int r = 0; r < 16; ++r) { const int orow = crow(r, hi); const f32x4 cf = *(LAS const f32x4*)(lds + L_CF + wid * 512 + orow * 16);
        const size_t ro = (rowbase + qw0 + orow) * PITCH + h * HD + r32 * 4;
        float v0 = o[0][r] * cf.x, v1 = o[1][r] * cf.x, v2 = o[2][r] * cf.x, v3 = o[3][r] * cf.x;
        if (nsel > 0) { const u32x2 w = *(const u32x2*)(P0 + ro); v0 += cf.y * bflo(w.x); v1 += cf.y * bfhi(w.x); v2 += cf.y * bflo(w.y); v3 += cf.y * bfhi(w.y); }
        if (nsel > 1) { const u32x2 w = *(const u32x2*)(P1 + ro); v0 += cf.z * bflo(w.x); v1 += cf.z * bfhi(w.x); v2 += cf.z * bflo(w.y); v3 += cf.z * bfhi(w.y); }
        if (nsel > 2) { const u32x2 w = *(const u32x2*)(P2 + ro); v0 += cf.w * bflo(w.x); v1 += cf.w * bfhi(w.x); v2 += cf.w * bflo(w.y); v3 += cf.w * bfhi(w.y); }
        u32x2 wo; wo.x = cvtpk(v0, v1); wo.y = cvtpk(v2, v3);
        *(u32x2*)(O + ro) = wo; }
    asm volatile("s_waitcnt lgkmcnt(0)" ::: "memory");
}
#undef MOBA_TILE
#undef KSWZ
#undef SBAR
#undef WG_BAR
}


template <int VAR> __device__ __forceinline__ void p_diff_attn_mfma(const Args& a, LAS unsigned char* lds, int vcu, int tid, int wave, int lane, size_t out_off) {
    const bf16* Qb = (const bf16*)(a.ws + WS_Q); const bf16* Kb = (const bf16*)(a.ws + WS_K); const unsigned char* Vb = a.ws + WS_V;
    bf16* Ob = (bf16*)(a.ws + out_off); const float* biasT = (const float*)(a.ws + WS_BIAST);
    float lam_full;
    { const float* lm = a.diff_lambda; const float p01 = wave_sum(lm[lane] * lm[64 + lane]), p23 = wave_sum(lm[128 + lane] * lm[192 + lane]); lam_full = __expf(p01) - __expf(p23) + LAMBDA_INIT; }
    const int G = gridDim.x;
    if (G == 256) {
#pragma unroll 1
        for (int k = 0; k < 4; ++k) {
            const int bh = 2 * (vcu >> 5) + (k >> 1), p = vcu & 31, qb = (k & 1) ? 63 - p : p;
            att::diff_unit<VAR>((LAS char*)lds, bh >> 3, bh & 7, qb, Qb, Kb, Vb, Ob, a.rel_bias, biasT, lam_full, a.diff_subln_g, tid, wave, lane);
        }
    } else {
        for (int pp = vcu; pp < 512; pp += G) {
#pragma unroll 1
            for (int k = 0; k < 2; ++k) {
                const int bh = pp >> 5, p = pp & 31, qb = k ? 63 - p : p;
                att::diff_unit<VAR>((LAS char*)lds, bh >> 3, bh & 7, qb, Qb, Kb, Vb, Ob, a.rel_bias, biasT, lam_full, a.diff_subln_g, tid, wave, lane);
            }
        }
    }
}


__device__ __forceinline__ void p_moba_part(const Args& a, LAS unsigned char* lds, int vcu, int tid, int wave, int lane) {
    const bf16* Qb = (const bf16*)(a.ws + WS_Q); const bf16* Kb = (const bf16*)(a.ws + WS_K); const bf16* Vb = (const bf16*)(a.ws + WS_V);
    const unsigned* cnt = (const unsigned*)(a.ws + WS_CTL) + CW_CNT; const unsigned short* lists = (const unsigned short*)(a.ws + WS_LIST); const unsigned* sel = (const unsigned*)(a.ws + WS_SEL);
    bf16* P0 = (bf16*)(a.ws + WS_H); bf16* P1 = (bf16*)(a.ws + WS_Y); bf16* P2 = (bf16*)a.out; f32x2* ml = (f32x2*)((unsigned char*)a.out + WS_ML);
    LAS int* pre = (LAS int*)(lds + att::L_TAB); LAS int* found = (LAS int*)(lds + att::L_FOUND);
    const int c = (int)cnt[tid], nch = (c + 255) >> 8;
    int incl = nch;
#pragma unroll
    for (int o = 1; o < 64; o <<= 1) { const int v = bperm_i(lane >= o ? lane - o : lane, incl); if (lane >= o) incl += v; }
    if (lane == 63) pre[513 + wave] = incl;
    __syncthreads();
    int woff = 0;
#pragma unroll
    for (int w8 = 0; w8 < 8; ++w8) woff += (w8 < wave) ? pre[513 + w8] : 0;
    pre[tid + 1] = woff + incl; if (tid == 0) pre[0] = 0;
    __syncthreads();
    const int T = pre[512], G = gridDim.x;
    const int lo = (int)(((long long)T * vcu) / G), hi_ = (int)(((long long)T * (vcu + 1)) / G);
    const att::DmaOff dmo = att::dma_offsets(wave, lane);
    int last_h = -1;
    for (int it = lo; it < hi_;) {
        if (pre[tid] <= it && it < pre[tid + 1]) found[0] = tid;
        __syncthreads();
        const int f = __builtin_amdgcn_readfirstlane(found[0]);
        const int bh = f >> 5, j = f & 31, c0 = it - pre[f];
        const int seg_end = pre[f + 1] < hi_ ? pre[f + 1] : hi_, c1 = seg_end - pre[f];
        const int cntj = (int)cnt[f];
        const size_t kvoff = ((size_t)(bh >> 3) * SEQ + j * 256) * D + (bh & 7) * HD;
        att::block_load((LAS char*)lds, Kb + kvoff, Vb + kvoff, dmo, wave);
        if ((bh & 7) != last_h) { last_h = bh & 7; att::build_lut((LAS char*)lds, (const float*)(a.ws + WS_BIAST), last_h, tid); }
        const float b31 = a.rel_bias[31 * 8 + (bh & 7)] * LOG2E;
        asm volatile("s_waitcnt vmcnt(0)" ::: "memory");
        __syncthreads();
        for (int g = c0 * 8 + wave; g < c1 * 8 && g * 32 < cntj; g += 8)
            att::moba_part_group((LAS char*)lds, bh, j, g, cntj, Qb, lists, sel, P0, P1, P2, ml, b31, wave, lane);
        it = seg_end;
    }
}
__device__ __forceinline__ void p_moba_own(const Args& a, LAS unsigned char* lds, int vcu, int tid, int wave, int lane) {
    const bf16* Qb = (const bf16*)(a.ws + WS_Q); const bf16* Kb = (const bf16*)(a.ws + WS_K); const bf16* Vb = (const bf16*)(a.ws + WS_V); bf16* Ob = (bf16*)(a.ws + WS_O);
    const bf16* P0 = (const bf16*)(a.ws + WS_H); const bf16* P1 = (const bf16*)(a.ws + WS_Y); const bf16* P2 = (const bf16*)a.out; const f32x2* ml = (const f32x2*)((const unsigned char*)a.out + WS_ML);
    const int G = gridDim.x;
    const att::DmaOff dmo = att::dma_offsets(wave, lane);
    for (int u0 = 2 * vcu; u0 < 512; u0 += 2 * G) {
#pragma unroll 1
        for (int k = 0; k < 2; ++k) { const int u = u0 + k; if (u >= 512) break; const int bh = u >> 5, qb = u & 31;
            __syncthreads();
            const size_t kvoff = ((size_t)(bh >> 3) * SEQ + qb * 256) * D + (bh & 7) * HD;
            att::block_load((LAS char*)lds, Kb + kvoff, Vb + kvoff, dmo, wave);
            if (k == 0 || (u & 31) == 0) att::build_lut((LAS char*)lds, (const float*)(a.ws + WS_BIAST), bh & 7, tid);
            asm volatile("s_waitcnt vmcnt(0)" ::: "memory");
            __syncthreads();
            att::moba_own_rows((LAS char*)lds, bh >> 3, bh & 7, qb, Qb, Ob, P0, P1, P2, ml, wave, lane); }
    }
}

struct TI { int tid, lane, wave, gtid, gw; };
__device__ __forceinline__ TI mk_ti(int wave0) { const int l = lane_opaque(); const int t = wave0 * 64 + l; TI r; r.tid = t; r.lane = l; r.wave = wave0;
    r.gtid = blockIdx.x * NTHR + t; r.gw = blockIdx.x * NWAVES + r.wave; return r; }

typedef const __attribute__((address_space(4))) Args* CArgs;
__device__ __forceinline__ Args load_args() {
#if defined(__HIP_DEVICE_COMPILE__)
    auto p = __builtin_amdgcn_kernarg_segment_ptr(); asm volatile("" : "+s"(p));
    typedef const __attribute__((address_space(4))) unsigned long long* cu64; cu64 q = (cu64)p;
    Args r; r.x = (const float*)q[0]; r.c = (const float*)q[1]; r.rel_bias = (const float*)q[2]; r.ada_w = (const float*)q[3]; r.ada_b = (const float*)q[4]; r.norm_g = (const float*)q[5];
    r.moba_w_qkv = (const float*)q[6]; r.moba_w_o = (const float*)q[7]; r.diff_w_qkv = (const float*)q[8]; r.diff_w_o = (const float*)q[9];
    r.diff_lambda = (const float*)q[10]; r.diff_subln_g = (const float*)q[11]; r.ffn_w_in = (const float*)q[12]; r.ffn_w_out = (const float*)q[13];
    r.out = (float*)q[14]; r.ws = (unsigned char*)q[15]; return r;
#else
    return Args{};
#endif
}
#define WSP(T, off) ((T*)(a.ws + (off)))
#define GEMM_PHASE_F8(EPI, Aptr, Wptr, N_, K_, ...) do { const Args a = load_args(); const int G_ = gridDim.x; \
        pg8::Gemm g{Aptr, (const bf16*)(Wptr), M, N_, K_}; pg8::StaticOrder S; S.init(M, N_, G_, (int)blockIdx.x); \
        EPI E{__VA_ARGS__}; pg8::gemm_phase<EPI, pg8::StaticOrder, true, true, true>(lds, g, S, E, wave0); } while (0)
#define GEMM_PHASE(EPI, Aptr, Wptr, N_, K_, ...) do { const Args a = load_args(); const int G_ = gridDim.x; \
        pg8::Gemm g{Aptr, (const bf16*)(Wptr), M, N_, K_}; pg8::StaticOrder S; S.init(M, N_, G_, (int)blockIdx.x); \
        EPI E{__VA_ARGS__}; pg8::gemm_phase<EPI, pg8::StaticOrder, true, true>(lds, g, S, E, wave0); } while (0)
__global__ void __launch_bounds__(NTHR, 2) fwd(Args a_unused) {
    extern __shared__ __attribute__((aligned(16))) unsigned char lds_raw[];
    LAS unsigned char* lds = (LAS unsigned char*)lds_raw;
    volatile LAS unsigned* MISC = (volatile LAS unsigned*)(lds + MISC_OFF);
    const int wave0 = __builtin_amdgcn_readfirstlane((int)threadIdx.x >> 6);
    if (wave0 == 0) MISC[lane_opaque()] = 0u;
    __syncthreads();
    XcdBarrier bar;
    { const Args a = load_args(); bar = xcd_barrier_post(WSP(unsigned, WS_CTL) + CW_BAR, MISC + 8, wave0); }
#define VCU() ((gridDim.x % 8 == 0) ? (int)((blockIdx.x % 8) * (gridDim.x / 8) + blockIdx.x / 8) : (int)blockIdx.x)
#define NGW() ((int)gridDim.x * NWAVES)
#define NGT() ((int)gridDim.x * NTHR)
    constexpr float QS0 = 0.08838834764831845f * LOG2E, QS1 = 0.125f * LOG2E;
    constexpr size_t QKVS = (size_t)(WS_K - WS_Q) / 2;

    { const Args a = load_args(); const TI t = mk_ti(wave0); p_weights(a, lds, t.gw, NGW(), t.wave, t.lane); p_wo_perm(a, t.gtid, NGT()); __syncthreads(); p_mod(a, lds, (int)blockIdx.x, (int)gridDim.x, t.tid, t.wave, t.lane); }
    xcd_barrier(bar);
    { const Args a = load_args(); const TI t = mk_ti(wave0); const float* md = WSP(const float, WS_MOD); p_norm_in(a.x, a.norm_g, md, md + 1024, WSP(bf16, WS_H), t.gw, NGW(), t.lane); }
    xcd_barrier(bar);
    GEMM_PHASE(pg8::EpiQKV, WSP(bf16, WS_H), a.ws + WS_W + WO_QKV, 3 * D, D, WSP(bf16, WS_Q), D, QKVS, QS0, WSP(float, WS_KSUM));
    xcd_barrier(bar);
    { const Args a = load_args(); const TI t = mk_ti(wave0); p_gate(WSP(bf16, WS_Q), WSP(const float, WS_KSUM), WSP(unsigned, WS_SEL), WSP(unsigned, WS_CTL) + CW_CNT, WSP(unsigned short, WS_LIST), lds, (int)blockIdx.x, (int)gridDim.x, t.tid, t.wave, t.lane); }
    xcd_barrier(bar);
    { const Args a = load_args(); const TI t = mk_ti(wave0); p_moba_part(a, lds, VCU(), t.tid, t.wave, t.lane); }
    xcd_barrier(bar);
    { const Args a = load_args(); const TI t = mk_ti(wave0); p_moba_own(a, lds, VCU(), t.tid, t.wave, t.lane); }
    xcd_barrier(bar);
    GEMM_PHASE(pg8::EpiBf16<0>, WSP(bf16, WS_O), a.ws + WS_W + WO_O, D, D, WSP(bf16, WS_Y), D, nullptr, 0, 0, 1.f);
    xcd_barrier(bar);
    { const Args a = load_args(); const TI t = mk_ti(wave0); const float* md = WSP(const float, WS_MOD); const float* ng = a.norm_g;
      p_post<false, true, true>(a.x, WSP(bf16, WS_Y), ng + D, md + 2048, a.out, ng + 2 * D, md + 3072, md + 4096, WSP(bf16, WS_H), t.gw, NGW(), t.lane); }
    xcd_barrier(bar);
    GEMM_PHASE_F8(pg8::EpiSwiglu, WSP(bf16, WS_H), a.ws + WS_W + WO_IN, 2 * DFF, D / 2, WSP(bf16, WS_HH), DFF, 1.0f / (F8_SA * F8_SB), F8_SH);
    xcd_barrier(bar);
    GEMM_PHASE_F8(pg8::EpiScaled, WSP(bf16, WS_HH), a.ws + WS_W + WO_OUT, D, DFF / 2, WSP(bf16, WS_Y), D, 1.0f / (F8_SH * F8_SB));
    xcd_barrier(bar);
    { const Args a = load_args(); const TI t = mk_ti(wave0); const float* md = WSP(const float, WS_MOD); const float* ng = a.norm_g; const float* md1 = md + 2 * 6144; const float* ng1 = ng + 4 * D;
      p_post<true, true, false>(a.out, WSP(bf16, WS_Y), ng + 3 * D, md + 5120, (unsigned char*)a.out + 32 * MiB, ng1, md1, md1 + 1024, WSP(bf16, WS_H), t.gw, NGW(), t.lane); }
    xcd_barrier(bar);
    GEMM_PHASE(pg8::EpiQKV, WSP(bf16, WS_H), a.ws + WS_W + WL_STRIDE + WO_QKV, 2 * D, D, WSP(bf16, WS_Q), D, QKVS, QS1, nullptr);
    __syncthreads();
    { const Args a = load_args(); const int G_ = gridDim.x;
      pg8::Gemm g{(const bf16*)(a.ws + WS_W + WL_STRIDE + WO_QKV) + (size_t)2 * D * D, WSP(bf16, WS_H), D, M, D}; pg8::StaticOrder S; S.init(D, M, G_, (int)blockIdx.x);
      pg8::EpiVT8 E{a.ws + WS_V, M, att::F8_SV}; pg8::gemm_phase<pg8::EpiVT8, pg8::StaticOrder, true, true>(lds, g, S, E, wave0); }
    xcd_barrier(bar);
    { const Args a = load_args(); const TI t = mk_ti(wave0); p_diff_attn_mfma<0>(a, lds, VCU(), t.tid, t.wave, t.lane, WS_O); }
#ifdef PROBE_VAR
    { const Args a = load_args(); const TI t = mk_ti(wave0); p_diff_attn_mfma<PROBE_VAR>(a, lds, VCU(), t.tid, t.wave, t.lane, WS_Y); }
#endif
    xcd_barrier(bar);
    GEMM_PHASE(pg8::EpiBf16<0>, WSP(bf16, WS_O), a.ws + WS_W + WL_STRIDE + WO_O, D, D, WSP(bf16, WS_Y), D, nullptr, 0, 0, 1.f);
    xcd_barrier(bar);
    { const Args a = load_args(); const TI t = mk_ti(wave0); const float* md = WSP(const float, WS_MOD) + 2 * 6144; const float* ng = a.norm_g + 4 * D;
      p_post<true, true, true>((unsigned char*)a.out + 32 * MiB, WSP(bf16, WS_Y), ng + D, md + 2048, WSP(bf16, WS_O), ng + 2 * D, md + 3072, md + 4096, WSP(bf16, WS_H), t.gw, NGW(), t.lane); }
    xcd_barrier(bar);
    GEMM_PHASE_F8(pg8::EpiSwiglu, WSP(bf16, WS_H), a.ws + WS_W + WL_STRIDE + WO_IN, 2 * DFF, D / 2, WSP(bf16, WS_HH), DFF, 1.0f / (F8_SA * F8_SB), F8_SH);
    xcd_barrier(bar);
    GEMM_PHASE_F8(pg8::EpiScaled, WSP(bf16, WS_HH), a.ws + WS_W + WL_STRIDE + WO_OUT, D, DFF / 2, WSP(bf16, WS_Y), D, 1.0f / (F8_SH * F8_SB));
    xcd_barrier(bar);
    { const Args a = load_args(); const TI t = mk_ti(wave0); const float* md = WSP(const float, WS_MOD) + 2 * 6144; const float* ng = a.norm_g + 4 * D;
      p_post<true, false, false>(WSP(bf16, WS_O), WSP(bf16, WS_Y), ng + 3 * D, md + 5120, a.out, nullptr, nullptr, nullptr, nullptr, t.gw, NGW(), t.lane); }
}

extern "C" void kernel_launch(void* const* d_in, const int* in_sizes, int n_in, void* d_out, int out_size, void* d_ws, size_t ws_size, hipStream_t stream) {
    static int grid = 0;
    if (grid == 0) {
        if (n_in != 14 || out_size != M * D || ws_size < WS_END) { fprintf(stderr, "kernel_launch: unexpected shapes n_in %d out %d ws %zu\n", n_in, out_size, ws_size); grid = -1; return; }
        int dev = 0, cus = 0;
        if (hipGetDevice(&dev) != hipSuccess || hipDeviceGetAttribute(&cus, hipDeviceAttributeMultiprocessorCount, dev) != hipSuccess) { grid = -1; return; }
        if (hipFuncSetAttribute((const void*)fwd, hipFuncAttributeMaxDynamicSharedMemorySize, LDS_BYTES) != hipSuccess) { fprintf(stderr, "hipFuncSetAttribute failed\n"); grid = -1; return; }
        grid = cus;
    }
    if (grid < 0) return;
    (void)hipMemsetAsync((char*)d_ws + WS_CTL, 0, CTL_ZERO_BYTES, stream);
    Args a{};
    a.x = (const float*)d_in[0]; a.c = (const float*)d_in[1]; a.rel_bias = (const float*)d_in[2]; a.ada_w = (const float*)d_in[3]; a.ada_b = (const float*)d_in[4];
    a.norm_g = (const float*)d_in[5]; a.moba_w_qkv = (const float*)d_in[6]; a.moba_w_o = (const float*)d_in[7]; a.diff_w_qkv = (const float*)d_in[8]; a.diff_w_o = (const float*)d_in[9];
    a.diff_lambda = (const float*)d_in[10]; a.diff_subln_g = (const float*)d_in[11]; a.ffn_w_in = (const float*)d_in[12]; a.ffn_w_out = (const float*)d_in[13];
    a.out = (float*)d_out; a.ws = (unsigned char*)d_ws;
    hipLaunchKernelGGL(fwd, dim3(grid), dim3(NTHR), LDS_BYTES, stream, a);
}
```

```cpp
#include <hip/hip_runtime.h>
#include <cstdio>
#include <cstdint>

#define GAS __attribute__((address_space(1)))
#define LAS __attribute__((address_space(3)))
typedef unsigned short bf16;
typedef float f32x4 __attribute__((ext_vector_type(4)));
typedef float f32x2 __attribute__((ext_vector_type(2)));
typedef unsigned u32x4 __attribute__((ext_vector_type(4)));
typedef unsigned u32x2 __attribute__((ext_vector_type(2)));

constexpr int BATCH = 2, SEQ = 8192, D = 1024, NH = 8, HD = 128, DFF = 2816, NBKT = 32;
constexpr int M = BATCH * SEQ;
constexpr int NWAVES = 8, NTHR = 512;
constexpr float RMS_EPS = 1e-6f;
constexpr float LOG2E = 1.4426950408889634f;
constexpr float LAMBDA_INIT = 0.35550906759096926f;

constexpr size_t MiB = 1u << 20;
constexpr size_t WS_CTL = 0, CTL_ZERO_BYTES = 1 * MiB;
constexpr size_t WS_MOD = 1 * MiB;
constexpr size_t WS_BLUT = WS_MOD + 128 * 1024;
constexpr size_t WS_KMEAN = WS_BLUT + 16 * 1024;
constexpr size_t WS_SEL = WS_KMEAN + 256 * 1024;
constexpr size_t WS_BIAST = WS_SEL + 512 * 1024;
constexpr size_t WS_LIST = 244 * MiB;
constexpr size_t WS_ML = 32 * MiB;
constexpr size_t WS_KSUM = 256 * 1024;
constexpr int CW_CNT = 8192;
constexpr size_t WS_W = 2 * MiB, WL_STRIDE = 25 * MiB;
constexpr size_t WO_QKV = 0, WO_O = 6 * MiB, WO_IN = 8 * MiB, WO_OUT = 19 * MiB;
constexpr size_t WS_H = 52 * MiB;
constexpr size_t WS_Q = 84 * MiB, WS_K = 116 * MiB, WS_V = 148 * MiB;
constexpr size_t WS_HH = 84 * MiB;
constexpr size_t WS_O = 180 * MiB;
constexpr size_t WS_Y = 212 * MiB;
constexpr size_t WS_END = 252 * MiB;
constexpr int CW_BAR = 4096;

constexpr int LDS_BYTES = 155648;
constexpr int MISC_OFF = 150016;

#define RLX_AGENT __ATOMIC_RELAXED, __HIP_MEMORY_SCOPE_AGENT
__device__ __forceinline__ unsigned f2bf(float f) { unsigned u = __builtin_bit_cast(unsigned, f); return (u + 0x7fffu + ((u >> 16) & 1u)) >> 16; }
__device__ __forceinline__ unsigned pk2(float lo, float hi) { return f2bf(lo) | (f2bf(hi) << 16); }
__device__ __forceinline__ float bf2f(unsigned short b) { return __builtin_bit_cast(float, (unsigned)b << 16); }
__device__ __forceinline__ float bflo(unsigned w) { return __builtin_bit_cast(float, w << 16); }
__device__ __forceinline__ float bfhi(unsigned w) { return __builtin_bit_cast(float, w & 0xffff0000u); }

__device__ __forceinline__ int lane_opaque() { int l; asm volatile("v_mbcnt_lo_u32_b32 %0, -1, 0\n\tv_mbcnt_hi_u32_b32 %0, -1, %0" : "=v"(l)); return l; }
__device__ __forceinline__ float bperm_f(int src_lane, float v) { return __builtin_bit_cast(float, __builtin_amdgcn_ds_bpermute(src_lane << 2, __builtin_bit_cast(int, v))); }
__device__ __forceinline__ int bperm_i(int src_lane, int v) { return __builtin_amdgcn_ds_bpermute(src_lane << 2, v); }

#define XB_TMO      128
#define XB_XCNT(j)  (256  + 64 * (j))
#define XB_XSUB(j)  (1280 + 64 * (j))
#define XB_XGEN(j)  (2304 + 64 * (j))
#define XB_TOP      3328
#define XB_TOPGEN   3392
#define XCD_BAR_WORDS 3456
#define XB_SPIN_CAP (1u << 25)
__device__ __forceinline__ unsigned xb_ld(unsigned* p)              { return __hip_atomic_load(p, __ATOMIC_RELAXED, __HIP_MEMORY_SCOPE_AGENT); }
__device__ __forceinline__ unsigned xb_add(unsigned* p, unsigned v) { return __hip_atomic_fetch_add(p, v, __ATOMIC_RELAXED, __HIP_MEMORY_SCOPE_AGENT); }
__device__ __forceinline__ unsigned xb_xcc_id() { return (unsigned)__builtin_amdgcn_s_getreg((3 << 11) | 20) & 0xFu; }
#define XB_SPIN(cond, bar) do { unsigned _sp = 0; while (cond) { __builtin_amdgcn_s_sleep(1); \
    if ((++_sp & 255u) == 0u) { if (xb_ld(&(bar)[XB_TMO])) break; if (_sp > XB_SPIN_CAP) { atomicAdd(&(bar)[XB_TMO], 1u); break; } } } } while (0)
struct XcdBarrier { unsigned* bar; unsigned x; volatile LAS unsigned* st; int wave; };
__device__ __forceinline__ XcdBarrier xcd_barrier_post(unsigned* bar, volatile LAS unsigned* st, int wave) {
    XcdBarrier b; b.bar = bar; b.x = xb_xcc_id(); b.st = st; b.wave = wave;
    if (wave == 0 && lane_opaque() == 0) (void)xb_add(&bar[XB_XCNT(b.x)], 1u);
    return b;
}
__device__ __forceinline__ void xcd_barrier_complete(unsigned* bar, unsigned x, unsigned& nloc, unsigned& nx) {
    const unsigned G = gridDim.x * gridDim.y * gridDim.z;
    unsigned sum, cnt, mine, sp = 0u;
    for (;;) {
        sum = 0u; cnt = 0u; mine = 0u;
#pragma unroll
        for (unsigned j = 0; j < 16; ++j) { const unsigned c = xb_ld(&bar[XB_XCNT(j)]); sum += c; cnt += (c > 0u) ? 1u : 0u; mine = (j == x) ? c : mine; }
        if (sum == G) break;
        __builtin_amdgcn_s_sleep(1);
        if ((++sp & 255u) == 0u) { if (xb_ld(&bar[XB_TMO])) break; if (sp > XB_SPIN_CAP) { atomicAdd(&bar[XB_TMO], 1u); break; } }
    }
    nloc = mine > 0u ? mine : 1u; nx = cnt > 0u ? cnt : 1u;
}
__device__ __forceinline__ void xcd_barrier(const XcdBarrier& b) {
    asm volatile("s_waitcnt vmcnt(0)" ::: "memory");
    __syncthreads();
    if (b.wave == 0 && lane_opaque() == 0) {
        unsigned* bar = b.bar;
        __builtin_amdgcn_s_waitcnt(0);
        unsigned nloc = b.st[0], nx = b.st[1];
        if (nloc == 0u) { xcd_barrier_complete(bar, b.x, nloc, nx); b.st[0] = nloc; b.st[1] = nx; }
        const unsigned old = xb_add(&bar[XB_XSUB(b.x)], 1u);
        const unsigned gen = old / nloc;
        if (old + 1u == (gen + 1u) * nloc) {
            __builtin_amdgcn_fence(__ATOMIC_RELEASE, "agent");
            asm volatile("s_waitcnt vmcnt(0)" ::: "memory");
            const unsigned og = xb_add(&bar[XB_TOP], 1u);
            const unsigned tg = og / nx;
            if (og + 1u == (tg + 1u) * nx) xb_add(&bar[XB_TOPGEN], 1u);
            else XB_SPIN(xb_ld(&bar[XB_TOPGEN]) == tg, bar);
            __builtin_amdgcn_fence(__ATOMIC_ACQUIRE, "agent");
            xb_add(&bar[XB_XGEN(b.x)], 1u);
            asm volatile("s_waitcnt vmcnt(0)" ::: "memory");
        } else {
            XB_SPIN(xb_ld(&bar[XB_XGEN(b.x)]) == gen, bar);
            __builtin_amdgcn_fence(__ATOMIC_ACQUIRE, "agent");
            asm volatile("s_waitcnt vmcnt(0)" ::: "memory");
        }
    }
    __syncthreads();
}

namespace pg8 {
#define PG8_LAS __attribute__((address_space(3)))
typedef unsigned short bf16_t;
typedef short bf16x8 __attribute__((ext_vector_type(8)));
typedef float f32x4 __attribute__((ext_vector_type(4)));
typedef unsigned u32x4 __attribute__((ext_vector_type(4)));
constexpr int BM = 256, BK = 64, HALF = 128, HTB = HALF * BK * 2  , STAGE_BYTES = 8 * HTB, NXCD = 8, WGM = 8;

__host__ __device__ __forceinline__ int lds_byte(int r, int c) { const int st = (r >> 4) * 2 + (c >> 5), rr = r & 15, cc = c & 31, ob = rr * 64 + cc * 2; return st * 1024 + (ob ^ (((ob >> 9) & 1) << 5)); }
__host__ __device__ __forceinline__ void stage_rc(int b, int& R, int& C) { const int st = b / 1024, sb = b % 1024, swz = sb ^ (((sb >> 9) & 1) << 5); R = (st >> 1) * 16 + swz / 64; C = (st & 1) * 32 + (swz % 64) / 2; }
__host__ __device__ __forceinline__ int perm32(int rho) { const int n = rho >> 4, i = rho & 15; return 8 * (i >> 2) + 4 * n + (i & 3); }

struct Unit { int pm, pn; };
struct Gemm { const bf16_t* A; const bf16_t* Bt; int M, N, K; };

struct StaticOrder {
    int nM, nN, nwg, G, c;
    __host__ __device__ void init(int M, int N, int G_, int c_) { nM = M / BM; nN = N / BM; nwg = nM * nN; G = G_; c = c_; }
    __host__ __device__ bool next(int i, Unit& u) const {
        const long L = (long)i * G + c; if (L >= nwg) return false;
        int wgid = (int)L; { const int q = nwg / NXCD, r = nwg % NXCD, xcd = wgid % NXCD, off = wgid / NXCD; wgid = (xcd < r ? xcd * (q + 1) : r * (q + 1) + (xcd - r) * q) + off; }
        const int nig = WGM * nN, gid = wgid / nig, fm = gid * WGM, gsz = (nM - fm) < WGM ? (nM - fm) : WGM;
        u.pm = fm + ((wgid % nig) % gsz); u.pn = (wgid % nig) / gsz; return true;
    }
    __device__ __forceinline__ void a_ready(const Unit&) const {}
    __device__ __forceinline__ void done(const Unit&) const {}
};

__device__ __forceinline__ unsigned cvt_pk_bf16(float lo, float hi) { unsigned r; asm volatile("v_cvt_pk_bf16_f32 %0, %1, %2" : "=v"(r) : "v"(lo), "v"(hi)); return r; }
typedef float f32x2 __attribute__((ext_vector_type(2)));
__device__ __forceinline__ f32x2 gelu_pk(f32x2 v) {
    const f32x2 av = __builtin_elementwise_abs(v), d = av * 0.2316418882f + 1.0f;
    f32x2 t; t.x = __builtin_amdgcn_rcpf(d.x); t.y = __builtin_amdgcn_rcpf(d.y);
    f32x2 q = t * 0.5307027145f + (-0.7265760135f); q = q * t + 0.7107068705f; q = q * t + (-0.142248368f); q = q * t + 0.127414796f; q = q * t;
    const f32x2 s = (v * v) * (-0.72134752044f);
    f32x2 e; e.x = __builtin_amdgcn_exp2f(s.x); e.y = __builtin_amdgcn_exp2f(s.y);
    const f32x2 m = v * (q * e), r = v - m;
    f32x2 o; o.x = v.x < 0.f ? m.x : r.x; o.y = v.y < 0.f ? m.y : r.y; return o;
}

template <int ACT  > struct EpiBf16 {
    static constexpr bool PERM = true, AFTER_DRAIN = false; static_assert(ACT == 0 || ACT == 1, "EpiBf16: ACT is 0 (none) or 1 (gelu_pk)");
    bf16_t* O; int ldc; const float* bias; int split_cols; size_t split_stride; float scale0;
    __device__ __forceinline__ void operator()(const f32x4 (&acc)[2][2][4][2], const Unit& u, int wr, int wc, int fr, int fq) const {
        const int row0 = u.pm * BM + wr * 64 + fr; int colt = u.pn * BM; bf16_t* base = O;
        float sc = 1.f; if (split_cols) { const int t = colt / split_cols; base += (size_t)t * split_stride; colt -= t * split_cols; if (t == 0) sc = scale0; }
        const int col0 = colt + wc * 32 + 8 * fq, bcol0 = u.pn * BM + wc * 32 + 8 * fq;
        f32x4 bv[2][2];
#pragma unroll
        for (int bj = 0; bj < 2; ++bj)
#pragma unroll
            for (int n = 0; n < 2; ++n) bv[bj][n] = bias ? *(const f32x4*)(bias + bcol0 + bj * HALF + 4 * n) : (f32x4){0.f, 0.f, 0.f, 0.f};
#pragma unroll
        for (int ai = 0; ai < 2; ++ai)
#pragma unroll
            for (int m = 0; m < 4; ++m) { bf16_t* rowp = base + (size_t)(row0 + ai * HALF + m * 16) * ldc + col0;
#pragma unroll
                for (int bj = 0; bj < 2; ++bj) { f32x4 v0 = acc[ai][bj][m][0] + bv[bj][0], v1 = acc[ai][bj][m][1] + bv[bj][1];
                    if (ACT == 1) { f32x2 a = gelu_pk((f32x2){v0[0], v0[1]}), b = gelu_pk((f32x2){v0[2], v0[3]}), c = gelu_pk((f32x2){v1[0], v1[1]}), d = gelu_pk((f32x2){v1[2], v1[3]});
                        v0 = (f32x4){a.x, a.y, b.x, b.y}; v1 = (f32x4){c.x, c.y, d.x, d.y}; }
                    v0 = v0 * sc; v1 = v1 * sc; u32x4 w; w.x = cvt_pk_bf16(v0[0], v0[1]); w.y = cvt_pk_bf16(v0[2], v0[3]); w.z = cvt_pk_bf16(v1[0], v1[1]); w.w = cvt_pk_bf16(v1[2], v1[3]);
                    *(u32x4*)(rowp + bj * HALF) = w; } }
    }
};

struct EpiQKV {
    static constexpr bool PERM = true, AFTER_DRAIN = false;
    bf16_t* O; int ldc; size_t split_stride; float scale0; float* ksum;
    __device__ __forceinline__ void operator()(const f32x4 (&acc)[2][2][4][2], const Unit& u, int wr, int wc, int fr, int fq) const {
        const int row0 = u.pm * BM + wr * 64 + fr; const int t = (u.pn * BM) / ldc; const int colt = u.pn * BM - t * ldc; bf16_t* base = O + (size_t)t * split_stride;
        const float sc = t == 0 ? scale0 : 1.f;
        const int col0 = colt + wc * 32 + 8 * fq;
#pragma unroll
        for (int ai = 0; ai < 2; ++ai)
#pragma unroll
            for (int m = 0; m < 4; ++m) { bf16_t* rowp = base + (size_t)(row0 + ai * HALF + m * 16) * ldc + col0;
#pragma unroll
                for (int bj = 0; bj < 2; ++bj) { const f32x4 v0 = acc[ai][bj][m][0] * sc, v1 = acc[ai][bj][m][1] * sc;
                    u32x4 w; w.x = cvt_pk_bf16(v0[0], v0[1]); w.y = cvt_pk_bf16(v0[2], v0[3]); w.z = cvt_pk_bf16(v1[0], v1[1]); w.w = cvt_pk_bf16(v1[2], v1[3]);
                    *(u32x4*)(rowp + bj * HALF) = w; } }
        if (ksum != nullptr && t == 1) {
            const int b = u.pm >> 5, blk = u.pm & 31, lq_ = lane_opaque();
#pragma unroll
            for (int bj = 0; bj < 2; ++bj) { const int h = (colt >> 7) + bj;
                float* dst = ksum + ((size_t)((b * 8 + h) * 32 + blk)) * 128 + wc * 32 + 8 * fq;
#pragma unroll
                for (int n = 0; n < 2; ++n) { f32x4 sacc = (f32x4){0.f, 0.f, 0.f, 0.f};
#pragma unroll
                    for (int ai = 0; ai < 2; ++ai)
#pragma unroll
                        for (int m = 0; m < 4; ++m) sacc += acc[ai][bj][m][n];
#pragma unroll
                    for (int e = 0; e < 4; ++e) { float v = sacc[e];
                        v += bperm_f(lq_ ^ 1, v); v += bperm_f(lq_ ^ 2, v); v += bperm_f(lq_ ^ 4, v); v += bperm_f(lq_ ^ 8, v);
                        if (fr == 0) atomicAdd(dst + 4 * n + e, v); } } }
        }
    }
};

struct EpiSwiglu {
    static constexpr bool PERM = true, AFTER_DRAIN = false;
    bf16_t* O; int ldc; float inv; float oscale;
    __device__ __forceinline__ void operator()(const f32x4 (&acc)[2][2][4][2], const Unit& u, int wr, int wc, int fr, int fq) const {
        const int row0 = u.pm * BM + wr * 64 + fr, col0 = u.pn * HALF + wc * 32 + 8 * fq;
#pragma unroll
        for (int ai = 0; ai < 2; ++ai)
#pragma unroll
            for (int m = 0; m < 4; ++m) { bf16_t* rowp = O + (size_t)(row0 + ai * HALF + m * 16) * ldc + col0;
                float v[8];
#pragma unroll
                for (int n = 0; n < 2; ++n)
#pragma unroll
                    for (int e = 0; e < 4; ++e) { const float g = acc[ai][0][m][n][e] * inv, uu = acc[ai][1][m][n][e] * inv;
                        v[n * 4 + e] = g * __builtin_amdgcn_rcpf(1.0f + __builtin_amdgcn_exp2f(-1.4426950408889634f * g)) * uu; }
                if (oscale > 0.f) { u32x2 w8;
                    { float c0 = fminf(fmaxf(v[0] * oscale, -448.f), 448.f), c1 = fminf(fmaxf(v[1] * oscale, -448.f), 448.f), c2 = fminf(fmaxf(v[2] * oscale, -448.f), 448.f), c3 = fminf(fmaxf(v[3] * oscale, -448.f), 448.f);
                      int t_ = __builtin_amdgcn_cvt_pk_fp8_f32(c0, c1, 0, false); t_ = __builtin_amdgcn_cvt_pk_fp8_f32(c2, c3, t_, true); w8.x = (unsigned)t_; }
                    { float c0 = fminf(fmaxf(v[4] * oscale, -448.f), 448.f), c1 = fminf(fmaxf(v[5] * oscale, -448.f), 448.f), c2 = fminf(fmaxf(v[6] * oscale, -448.f), 448.f), c3 = fminf(fmaxf(v[7] * oscale, -448.f), 448.f);
                      int t_ = __builtin_amdgcn_cvt_pk_fp8_f32(c0, c1, 0, false); t_ = __builtin_amdgcn_cvt_pk_fp8_f32(c2, c3, t_, true); w8.y = (unsigned)t_; }
                    *(u32x2*)((unsigned char*)O + (size_t)(row0 + ai * HALF + m * 16) * ldc + col0) = w8; }
                else { u32x4 w; w.x = cvt_pk_bf16(v[0], v[1]); w.y = cvt_pk_bf16(v[2], v[3]); w.z = cvt_pk_bf16(v[4], v[5]); w.w = cvt_pk_bf16(v[6], v[7]);
                *(u32x4*)rowp = w; } }
    }
};
struct EpiScaled {
    static constexpr bool PERM = true, AFTER_DRAIN = false;
    bf16_t* O; int ldc; float inv;
    __device__ __forceinline__ void operator()(const f32x4 (&acc)[2][2][4][2], const Unit& u, int wr, int wc, int fr, int fq) const {
        const int row0 = u.pm * BM + wr * 64 + fr, col0 = u.pn * BM + wc * 32 + 8 * fq;
#pragma unroll
        for (int ai = 0; ai < 2; ++ai)
#pragma unroll
            for (int m = 0; m < 4; ++m) { bf16_t* rowp = O + (size_t)(row0 + ai * HALF + m * 16) * ldc + col0;
#pragma unroll
                for (int bj = 0; bj < 2; ++bj) { const f32x4 v0 = acc[ai][bj][m][0] * inv, v1 = acc[ai][bj][m][1] * inv;
                    u32x4 w; w.x = cvt_pk_bf16(v0[0], v0[1]); w.y = cvt_pk_bf16(v0[2], v0[3]); w.z = cvt_pk_bf16(v1[0], v1[1]); w.w = cvt_pk_bf16(v1[2], v1[3]);
                    *(u32x4*)(rowp + bj * HALF) = w; } }
    }
};
struct EpiVT8 {
    static constexpr bool PERM = true, AFTER_DRAIN = false;
    unsigned char* O; int ldb; float scale;
    __device__ __forceinline__ void operator()(const f32x4 (&acc)[2][2][4][2], const Unit& u, int wr, int wc, int fr, int fq) const {
        const int row0 = u.pm * BM + wr * 64 + fr;
#pragma unroll
        for (int ai = 0; ai < 2; ++ai)
#pragma unroll
            for (int m = 0; m < 4; ++m) { unsigned char* rowp = O + (size_t)(row0 + ai * HALF + m * 16) * ldb;
#pragma unroll
                for (int bj = 0; bj < 2; ++bj)
#pragma unroll
                    for (int n = 0; n < 2; ++n) { const int col = u.pn * BM + bj * HALF + wc * 32 + 8 * fq + 4 * n, g4 = (col >> 2) & 15;
                        const int pos = (g4 & 1) * 32 + (g4 >> 3) * 16 + ((g4 >> 1) & 3) * 4;
                        const f32x4 v = acc[ai][bj][m][n] * scale;
                        float c0 = fminf(fmaxf(v[0], -448.f), 448.f), c1 = fminf(fmaxf(v[1], -448.f), 448.f), c2 = fminf(fmaxf(v[2], -448.f), 448.f), c3 = fminf(fmaxf(v[3], -448.f), 448.f);
                        int t_ = __builtin_amdgcn_cvt_pk_fp8_f32(c0, c1, 0, false); t_ = __builtin_amdgcn_cvt_pk_fp8_f32(c2, c3, t_, true);
                        *(unsigned*)(rowp + (col & ~63) + pos) = (unsigned)t_; } }
    }
};

template <class Epi, class Sched, bool ALIGN_EPI = false, bool SP2 = false, bool FP8 = false>
__device__ __forceinline__ void gemm_phase(PG8_LAS unsigned char* lds, const Gemm g, const Sched& S, const Epi& E, const int wave0) {
    const int tid_ = wave0 * 64 + lane_opaque();
    const int tid = tid_, wid = __builtin_amdgcn_readfirstlane(tid >> 6), lane = tid & 63, wr = wid >> 2, wc = wid & 3, fr = lane & 15, fq = lane >> 4;
    const int K = g.K, nt = K / BK;
    unsigned voffA[2], voffB[2];
#pragma unroll
    for (int i = 0; i < 2; ++i) { int R, C; stage_rc(tid * 16 + i * 8192, R, C); const int Rb = Epi::PERM ? ((R & ~31) + perm32(R & 31)) : R;
        voffA[i] = (unsigned)(R * K + C) * 2u; voffB[i] = (unsigned)(Rb * K + C) * 2u; }
    const size_t kstep = (size_t)(BK * 2);
    const size_t hstep = (size_t)HALF * K * 2;
    const size_t tstep = 2 * hstep;
    const unsigned ldsw = (unsigned)wid * 1024u;
    const int aoff = lds_byte(wr * 64 + fr, fq * 8), boff = lds_byte(wc * 32 + fr, fq * 8);
#define PG8_SA(b, h) (((b) * 2 + (h)) * HTB)
#define PG8_SB(b, h) ((4 + (b) * 2 + (h)) * HTB)
#define PG8_STAGE(bufoff, gbase, voff) do { _Pragma("unroll") for (int _i = 0; _i < 2; ++_i) \
        __builtin_amdgcn_global_load_lds((const unsigned*)((const char*)(gbase) + (voff)[_i]), (PG8_LAS unsigned*)(lds + (bufoff) + ldsw + _i * 8192), 16, 0, 0); } while (0)
#define PG8_LDA(dst, b, h) do { _Pragma("unroll") for (int m = 0; m < 4; ++m) _Pragma("unroll") for (int k = 0; k < 2; ++k) dst[m][k] = *(const PG8_LAS bf16x8*)(lds + PG8_SA(b, h) + aoff + m * 2048 + k * 1024); } while (0)
#define PG8_LDB(dst, b, h) do { _Pragma("unroll") for (int n = 0; n < 2; ++n) _Pragma("unroll") for (int k = 0; k < 2; ++k) dst[n][k] = *(const PG8_LAS bf16x8*)(lds + PG8_SB(b, h) + boff + n * 2048 + k * 1024); } while (0)
#define PG8_MMA(ai, bj, At, Bt) do { __builtin_amdgcn_s_setprio(1); \
        if constexpr (FP8) { typedef int i32x8_t __attribute__((ext_vector_type(8))); typedef int i32x4_t __attribute__((ext_vector_type(4))); \
            _Pragma("unroll") for (int m = 0; m < 4; ++m) _Pragma("unroll") for (int n = 0; n < 2; ++n) { \
                const i32x4_t b0_ = __builtin_bit_cast(i32x4_t, Bt[n][0]), b1_ = __builtin_bit_cast(i32x4_t, Bt[n][1]), a0_ = __builtin_bit_cast(i32x4_t, At[m][0]), a1_ = __builtin_bit_cast(i32x4_t, At[m][1]); \
                const i32x8_t bb_ = {b0_[0], b0_[1], b0_[2], b0_[3], b1_[0], b1_[1], b1_[2], b1_[3]}, aa_ = {a0_[0], a0_[1], a0_[2], a0_[3], a1_[0], a1_[1], a1_[2], a1_[3]}; \
                asm volatile("v_mfma_f32_16x16x128_f8f6f4 %0, %1, %2, %0" : "+v"(acc[ai][bj][m][n]) : "v"(bb_), "v"(aa_)); } } \
        else { _Pragma("unroll") for (int m = 0; m < 4; ++m) _Pragma("unroll") for (int n = 0; n < 2; ++n) _Pragma("unroll") for (int k = 0; k < 2; ++k) \
        acc[ai][bj][m][n] = __builtin_amdgcn_mfma_f32_16x16x32_bf16(Bt[n][k], At[m][k], acc[ai][bj][m][n], 0, 0, 0); } __builtin_amdgcn_s_setprio(0); } while (0)
#define PG8_WAIT_V(n) asm volatile("s_waitcnt vmcnt(" #n ")" ::: "memory")
#define PG8_WAIT_L(n) asm volatile("s_waitcnt lgkmcnt(" #n ")" ::: "memory")
#define PG8_BAR __builtin_amdgcn_s_barrier()
#define PG8_SCHED __builtin_amdgcn_sched_barrier(0)
    Unit cur, nxt; int ui = 0;
    if (!S.next(0, cur)) return;
    f32x4 acc[2][2][4][2];
#pragma unroll
    for (int a = 0; a < 2; ++a)
#pragma unroll
        for (int b = 0; b < 2; ++b)
#pragma unroll
            for (int m = 0; m < 4; ++m)
#pragma unroll
                for (int n = 0; n < 2; ++n) acc[a][b][m][n] = (f32x4){0.f, 0.f, 0.f, 0.f};
    bf16x8 At[4][2], B0[2][2], B1[2][2];
    const char* cA = (const char*)g.A + (size_t)cur.pm * tstep; const char* cB = (const char*)g.Bt + (size_t)cur.pn * tstep;
    S.a_ready(cur);
    if constexpr (SP2) {
        PG8_STAGE(PG8_SB(0, 0), cB, voffB); PG8_STAGE(PG8_SB(0, 1), cB + hstep, voffB); PG8_STAGE(PG8_SA(0, 0), cA, voffA); PG8_STAGE(PG8_SA(0, 1), cA + hstep, voffA);
        if (wr == 1) PG8_BAR;
        PG8_WAIT_V(2); PG8_BAR;
        PG8_STAGE(PG8_SB(1, 0), cB + kstep, voffB); PG8_STAGE(PG8_SA(1, 0), cA + kstep, voffA); PG8_STAGE(PG8_SB(1, 1), cB + hstep + kstep, voffB);
        PG8_WAIT_V(6); PG8_BAR;
    } else {
        PG8_STAGE(PG8_SB(0, 0), cB, voffB); PG8_STAGE(PG8_SA(0, 0), cA, voffA); PG8_STAGE(PG8_SB(0, 1), cB + hstep, voffB); PG8_STAGE(PG8_SA(0, 1), cA + hstep, voffA);
        if (wr == 1) PG8_BAR;
        PG8_WAIT_V(4); PG8_BAR;
        PG8_STAGE(PG8_SB(1, 0), cB + kstep, voffB); PG8_STAGE(PG8_SA(1, 0), cA + kstep, voffA); PG8_STAGE(PG8_SB(1, 1), cB + hstep + kstep, voffB);
        PG8_WAIT_V(6); PG8_BAR;
    }
    for (;;) {
        const bool has_next = S.next(ui + 1, nxt);
        const char* nA = has_next ? (const char*)g.A + (size_t)nxt.pm * tstep : cA; const char* nB = has_next ? (const char*)g.Bt + (size_t)nxt.pn * tstep : cB;
#pragma unroll 1
        for (int t = 0; t < nt; t += 2) {
            if constexpr (FP8) asm volatile("" : "+v"(voffA[0]), "+v"(voffA[1]), "+v"(voffB[0]), "+v"(voffB[1]));
            const bool last = (t == nt - 2);
            const char* a1 = cA + (size_t)(t + 1) * kstep;
            const char* a2 = last ? nA : cA + (size_t)(t + 2) * kstep; const char* b2 = last ? nB : cB + (size_t)(t + 2) * kstep;
            const char* a3 = a2 + kstep; const char* b3 = b2 + kstep;
            if (last && has_next) S.a_ready(nxt);
            if constexpr (SP2) {
            PG8_LDB(B0, 0, 0); PG8_LDB(B1, 0, 1); PG8_SCHED; PG8_LDA(At, 0, 0); PG8_STAGE(PG8_SA(1, 1), a1 + hstep, voffA);
            PG8_WAIT_V(8); PG8_WAIT_L(0); PG8_BAR; PG8_MMA(0, 0, At, B0); PG8_MMA(0, 1, At, B1); PG8_BAR; PG8_SCHED;
            PG8_LDA(At, 0, 1); PG8_STAGE(PG8_SB(0, 0), b2, voffB); PG8_STAGE(PG8_SB(0, 1), b2 + hstep, voffB); PG8_STAGE(PG8_SA(0, 0), a2, voffA);
            PG8_WAIT_V(8); PG8_WAIT_L(0); PG8_BAR; PG8_MMA(1, 0, At, B0); PG8_MMA(1, 1, At, B1); PG8_BAR; PG8_SCHED;
            PG8_LDB(B0, 1, 0); PG8_LDB(B1, 1, 1); PG8_SCHED; PG8_LDA(At, 1, 0); PG8_STAGE(PG8_SA(0, 1), a2 + hstep, voffA);
            PG8_WAIT_V(8); PG8_WAIT_L(0); PG8_BAR; PG8_MMA(0, 0, At, B0); PG8_MMA(0, 1, At, B1); PG8_BAR; PG8_SCHED;
            PG8_LDA(At, 1, 1); PG8_STAGE(PG8_SB(1, 0), b3, voffB); PG8_STAGE(PG8_SB(1, 1), b3 + hstep, voffB); PG8_STAGE(PG8_SA(1, 0), a3, voffA);
            PG8_WAIT_V(8); PG8_WAIT_L(0); PG8_BAR; PG8_MMA(1, 0, At, B0); PG8_MMA(1, 1, At, B1); PG8_BAR; PG8_SCHED;
            } else {
            PG8_LDB(B0, 0, 0); PG8_SCHED; PG8_LDA(At, 0, 0); PG8_STAGE(PG8_SA(1, 1), a1 + hstep, voffA);
            PG8_WAIT_L(8); PG8_BAR; PG8_WAIT_L(0); PG8_MMA(0, 0, At, B0); PG8_BAR; PG8_SCHED;
            PG8_LDB(B1, 0, 1); PG8_STAGE(PG8_SB(0, 0), b2, voffB);
            PG8_BAR; PG8_WAIT_L(0); PG8_MMA(0, 1, At, B1); PG8_BAR;
            PG8_LDA(At, 0, 1); PG8_STAGE(PG8_SA(0, 0), a2, voffA);
            PG8_BAR; PG8_WAIT_L(0); PG8_MMA(1, 0, At, B0); PG8_BAR; PG8_SCHED;
            PG8_STAGE(PG8_SB(0, 1), b2 + hstep, voffB);
            PG8_WAIT_V(6); PG8_BAR; PG8_MMA(1, 1, At, B1); PG8_BAR;
            PG8_LDB(B0, 1, 0); PG8_SCHED; PG8_LDA(At, 1, 0); PG8_STAGE(PG8_SA(0, 1), a2 + hstep, voffA);
            PG8_WAIT_L(8); PG8_BAR; PG8_WAIT_L(0); PG8_MMA(0, 0, At, B0); PG8_BAR; PG8_SCHED;
            PG8_LDB(B1, 1, 1); PG8_STAGE(PG8_SB(1, 0), b3, voffB);
            PG8_BAR; PG8_WAIT_L(0); PG8_MMA(0, 1, At, B1); PG8_BAR;
            PG8_LDA(At, 1, 1); PG8_STAGE(PG8_SA(1, 0), a3, voffA);
            PG8_BAR; PG8_WAIT_L(0); PG8_MMA(1, 0, At, B0); PG8_BAR; PG8_SCHED;
            PG8_STAGE(PG8_SB(1, 1), b3 + hstep, voffB);
            PG8_WAIT_V(6); PG8_BAR; PG8_MMA(1, 1, At, B1); PG8_BAR;
            }
        }
        if constexpr (ALIGN_EPI) { if (wr == 0) PG8_BAR; }
        if constexpr (FP8) asm volatile("s_nop 15\n\ts_nop 15" ::: "memory");
        if constexpr (!Epi::AFTER_DRAIN) { const int l2_ = lane_opaque(); E(acc, cur, wr, wc, l2_ & 15, l2_ >> 4); S.done(cur); }
        if (!has_next) break;
#pragma unroll
        for (int a = 0; a < 2; ++a)
#pragma unroll
            for (int b = 0; b < 2; ++b)
#pragma unroll
                for (int m = 0; m < 4; ++m)
#pragma unroll
                    for (int n = 0; n < 2; ++n) acc[a][b][m][n] = (f32x4){0.f, 0.f, 0.f, 0.f};
        cur = nxt; cA = nA; cB = nB; ++ui;
        if constexpr (ALIGN_EPI) { if (wr == 1) PG8_BAR; }
    }
    PG8_WAIT_V(0);
    if constexpr (!ALIGN_EPI) { if (wr == 0) PG8_BAR; }
    PG8_BAR;
    if constexpr (Epi::AFTER_DRAIN) { E.fused(acc, cur, wr, wc, fr, fq, lds, wid, lane); S.done(cur); }
#undef PG8_SA
#undef PG8_SB
#undef PG8_STAGE
#undef PG8_LDA
#undef PG8_LDB
#undef PG8_MMA
#undef PG8_WAIT_V
#undef PG8_WAIT_L
#undef PG8_BAR
#undef PG8_SCHED
}
}

__device__ __forceinline__ float wave_sum(float v) {
    const int l = lane_opaque();
#pragma unroll
    for (int o = 1; o < 64; o <<= 1) v += __builtin_bit_cast(float, __builtin_amdgcn_ds_bpermute((l ^ o) << 2, __builtin_bit_cast(int, v)));
    return v;
}
__device__ __forceinline__ float wave_max(float v) {
    const int l = lane_opaque();
#pragma unroll
    for (int o = 1; o < 64; o <<= 1) v = fmaxf(v, __builtin_bit_cast(float, __builtin_amdgcn_ds_bpermute((l ^ o) << 2, __builtin_bit_cast(int, v))));
    return v;
}
__device__ __forceinline__ float silu_f(float v) { return v / (1.f + __expf(-v)); }

struct Args {
    const float* x; const float* c; const float* rel_bias; const float* ada_w; const float* ada_b; const float* norm_g;
    const float* moba_w_qkv; const float* moba_w_o; const float* diff_w_qkv; const float* diff_w_o;
    const float* diff_lambda; const float* diff_subln_g; const float* ffn_w_in; const float* ffn_w_out;
    float* out; unsigned char* ws;
};

__device__ __forceinline__ int t5_bucket(int rel) {
    const int n = rel < 0 ? 0 : rel;
    const float nf = (float)(n < 1 ? 1 : n);
    int large = 16 + (int)(logf(nf / 16.0f) / 4.852030263919617f * 16.0f);
    large = large < 31 ? large : 31;
    return n < 16 ? n : large;
}

__device__ __forceinline__ void p_mod(const Args& a, LAS unsigned char* lds, int blk, int G, int tid, int wave, int lane) {
    LAS float* sc = (LAS float*)lds;
    LAS float* red = sc + 2048;
    for (int i = tid; i < 2048; i += NTHR) sc[i] = silu_f(a.c[i]);
    __syncthreads();
    float* mod = (float*)(a.ws + WS_MOD);
    for (int it = blk; it < 192; it += G) {
        const int l = it / 96, j0 = (it % 96) * 64;
        const float* w = a.ada_w + (size_t)l * D * 6144 + j0 + lane;
        float s0 = 0.f, s1 = 0.f;
#pragma unroll 1
        for (int kb = wave * 128; kb < wave * 128 + 128; kb += 32) { float wv[32];
#pragma unroll
            for (int k = 0; k < 32; ++k) wv[k] = w[(size_t)(kb + k) * 6144];
#pragma unroll
            for (int k = 0; k < 32; ++k) { s0 += sc[kb + k] * wv[k]; s1 += sc[1024 + kb + k] * wv[k]; } }
        red[(wave * 2 + 0) * 64 + lane] = s0; red[(wave * 2 + 1) * 64 + lane] = s1;
        __syncthreads();
        if (tid < 128) { const int bb = tid >> 6, cl = tid & 63; float sum = 0.f;
#pragma unroll
            for (int w8 = 0; w8 < 8; ++w8) sum += red[(w8 * 2 + bb) * 64 + cl];
            mod[(l * 2 + bb) * 6144 + j0 + cl] = sum + a.ada_b[l * 6144 + j0 + cl]; }
        __syncthreads();
    }
    float* bt = (float*)(a.ws + WS_BIAST);
    for (int i = blk * NTHR + tid; i < 8 * 2304; i += G * NTHR) { const int h = i / 2304, rel = 2047 - (i % 2304); bt[i] = rel >= 0 ? a.rel_bias[t5_bucket(rel) * NH + h] * LOG2E : 0.f; }
}

__device__ __forceinline__ void transpose_item(const float* W, int K, int N, int k0, int n0, bf16* WT, int dst_row0, LAS float* scr, int lane) {
    float tv[32];
#pragma unroll
    for (int i = 0; i < 32; ++i) tv[i] = W[(size_t)(k0 + 2 * i + (lane >> 5)) * N + n0 + (lane & 31)];
#pragma unroll
    for (int i = 0; i < 32; ++i) scr[(2 * i + (lane >> 5)) * 33 + (lane & 31)] = tv[i];
    asm volatile("s_waitcnt lgkmcnt(0)" ::: "memory");
    const int c = lane & 7;
#pragma unroll
    for (int j = 0; j < 4; ++j) { const int n = (lane >> 3) + 8 * j; const LAS float* sp = scr + (8 * c) * 33 + n;
        u32x4 o; o.x = pk2(sp[0 * 33], sp[1 * 33]); o.y = pk2(sp[2 * 33], sp[3 * 33]); o.z = pk2(sp[4 * 33], sp[5 * 33]); o.w = pk2(sp[6 * 33], sp[7 * 33]);
        *(u32x4*)(WT + (size_t)(dst_row0 + n) * K + k0 + 8 * c) = o; }
    asm volatile("s_waitcnt lgkmcnt(0)" ::: "memory");
}
constexpr float F8_SH = 8.0f;
constexpr float F8_SA = 4.0f, F8_SB = 256.0f;
__device__ __forceinline__ unsigned pk4_fp8(float a, float b, float c, float d) {
    a = fminf(fmaxf(a, -448.f), 448.f); b = fminf(fmaxf(b, -448.f), 448.f); c = fminf(fmaxf(c, -448.f), 448.f); d = fminf(fmaxf(d, -448.f), 448.f);
    int w = __builtin_amdgcn_cvt_pk_fp8_f32(a, b, 0, false); w = __builtin_amdgcn_cvt_pk_fp8_f32(c, d, w, true); return (unsigned)w;
}
__device__ __forceinline__ void transpose_item_fp8(const float* W, int K, int N, int k0, int n0, unsigned char* WT, int dst_row0, LAS float* scr, int lane) {
    float tv[32];
#pragma unroll
    for (int i = 0; i < 32; ++i) tv[i] = W[(size_t)(k0 + 2 * i + (lane >> 5)) * N + n0 + (lane & 31)];
#pragma unroll
    for (int i = 0; i < 32; ++i) scr[(2 * i + (lane >> 5)) * 33 + (lane & 31)] = tv[i];
    asm volatile("s_waitcnt lgkmcnt(0)" ::: "memory");
#pragma unroll
    for (int j = 0; j < 2; ++j) { const int ch = lane + 64 * j, n = ch >> 2, c = ch & 3; const LAS float* sp = scr + (16 * c) * 33 + n;
        u32x4 o;
        o.x = pk4_fp8(sp[0 * 33] * F8_SB, sp[1 * 33] * F8_SB, sp[2 * 33] * F8_SB, sp[3 * 33] * F8_SB);
        o.y = pk4_fp8(sp[4 * 33] * F8_SB, sp[5 * 33] * F8_SB, sp[6 * 33] * F8_SB, sp[7 * 33] * F8_SB);
        o.z = pk4_fp8(sp[8 * 33] * F8_SB, sp[9 * 33] * F8_SB, sp[10 * 33] * F8_SB, sp[11 * 33] * F8_SB);
        o.w = pk4_fp8(sp[12 * 33] * F8_SB, sp[13 * 33] * F8_SB, sp[14 * 33] * F8_SB, sp[15 * 33] * F8_SB);
        *(u32x4*)(WT + (size_t)(dst_row0 + n) * K + k0 + 16 * c) = o; }
    asm volatile("s_waitcnt lgkmcnt(0)" ::: "memory");
}
__device__ __forceinline__ void p_weights(const Args& a, LAS unsigned char* lds, int gw, int ngw, int wave, int lane) {
    LAS float* scr = (LAS float*)(lds + wave * 16384);
    constexpr int I_QKV = (D / 64) * (3 * D / 32), I_O = (D / 64) * (D / 32), I_IN = (D / 64) * (2 * DFF / 32), I_OUT = (DFF / 64) * (D / 32);
    constexpr int PER_L = I_QKV + I_O + I_IN + I_OUT;
    for (int it = gw; it < 2 * PER_L; it += ngw) {
        const int l = it / PER_L; int r = it % PER_L;
        unsigned char* wl = a.ws + WS_W + (size_t)l * WL_STRIDE;
        if (r < I_QKV) { const int nb = 3 * D / 32, kb = r / nb, n0 = (r % nb) * 32; transpose_item(l == 0 ? a.moba_w_qkv : a.diff_w_qkv, D, 3 * D, kb * 64, n0, (bf16*)(wl + WO_QKV), n0, scr, lane); continue; } r -= I_QKV;
        if (r < I_O) continue; r -= I_O;
        if (r < I_IN) { const int nb = 2 * DFF / 32, kb = r / nb, n0 = (r % nb) * 32;
            const int isu = n0 >= DFF ? 1 : 0, nn = n0 - isu * DFF, dst = 256 * (nn / 128) + 128 * isu + (nn % 128);
            transpose_item_fp8(a.ffn_w_in + (size_t)l * D * 2 * DFF, D, 2 * DFF, kb * 64, n0, wl + WO_IN, dst, scr, lane); continue; } r -= I_IN;
        { const int nb = D / 32, kb = r / nb, n0 = (r % nb) * 32; transpose_item_fp8(a.ffn_w_out + (size_t)l * DFF * D, DFF, D, kb * 64, n0, wl + WO_OUT, n0, scr, lane); }
    }
}

__device__ __forceinline__ void p_wo_perm(const Args& a, int gtid, int gthreads) {
    for (int idx = gtid; idx < 2 * 128 * D; idx += gthreads) {
        const int l = idx / (128 * D), rem = idx % (128 * D), c = rem / D, n = rem % D;
        const float* W = l == 0 ? a.moba_w_o : a.diff_w_o;
        float v[8];
#pragma unroll
        for (int e = 0; e < 8; ++e) { const int kp = 8 * c + e, hh = kp >> 7, wi = kp & 127, k = hh * 128 + (wi & 3) * 32 + (wi >> 2); v[e] = W[(size_t)k * D + n]; }
        u32x4 o; o.x = pk2(v[0], v[1]); o.y = pk2(v[2], v[3]); o.z = pk2(v[4], v[5]); o.w = pk2(v[6], v[7]);
        *(u32x4*)((bf16*)(a.ws + WS_W + (size_t)l * WL_STRIDE + WO_O) + (size_t)n * D + 8 * c) = o;
    }
}

__device__ __forceinline__ void p_norm_in(const float* X, const float* g, const float* sh, const float* sc, bf16* H, int gw, int ngw, int lane) {
    for (int m = gw; m < M; m += ngw) {
        const int b = m / SEQ;
        const f32x4* xr = (const f32x4*)(X + (size_t)m * D) + lane;
        f32x4 v[4]; float s = 0.f;
#pragma unroll
        for (int j = 0; j < 4; ++j) { v[j] = xr[64 * j]; s += (v[j].x * v[j].x + v[j].y * v[j].y) + (v[j].z * v[j].z + v[j].w * v[j].w); }
        const float r = 1.0f / sqrtf(wave_sum(s) * (1.f / D) + RMS_EPS);
        u32x2* o = (u32x2*)(H + (size_t)m * D) + lane;
#pragma unroll
        for (int j = 0; j < 4; ++j) {
            const f32x4 gg = ((const f32x4*)g)[lane + 64 * j], s1 = ((const f32x4*)(sc + b * 6144))[lane + 64 * j], s0 = ((const f32x4*)(sh + b * 6144))[lane + 64 * j];
            const f32x4 h = v[j] * r * gg * (1.0f + s1) + s0;
            u32x2 w; w.x = pk2(h.x, h.y); w.y = pk2(h.z, h.w); o[64 * j] = w;
        }
    }
}
template <bool XIN_BF, bool XOUT_BF, bool H_FP8>
__device__ __forceinline__ void p_post(const void* Xin, const bf16* Y, const float* g1, const float* gate, void* Xout,
                                       const float* g2, const float* sh, const float* sc, bf16* H, int gw, int ngw, int lane) {
    for (int m = gw; m < M; m += ngw) {
        const int b = m / SEQ;
        const u32x2* yr = (const u32x2*)(Y + (size_t)m * D) + lane;
        f32x4 y[4], xv[4]; float s = 0.f;
#pragma unroll
        for (int j = 0; j < 4; ++j) { const u32x2 w = yr[64 * j]; y[j] = (f32x4){bflo(w.x), bfhi(w.x), bflo(w.y), bfhi(w.y)};
            if (XIN_BF) { const u32x2 xw = ((const u32x2*)((const bf16*)Xin + (size_t)m * D))[lane + 64 * j]; xv[j] = (f32x4){bflo(xw.x), bfhi(xw.x), bflo(xw.y), bfhi(xw.y)}; }
            else xv[j] = ((const f32x4*)((const float*)Xin + (size_t)m * D))[lane + 64 * j];
            s += (y[j].x * y[j].x + y[j].y * y[j].y) + (y[j].z * y[j].z + y[j].w * y[j].w); }
        const float r = 1.0f / sqrtf(wave_sum(s) * (1.f / D) + RMS_EPS);
        float s2 = 0.f;
#pragma unroll
        for (int j = 0; j < 4; ++j) {
            const f32x4 gg = ((const f32x4*)g1)[lane + 64 * j], gt = ((const f32x4*)(gate + b * 6144))[lane + 64 * j];
            xv[j] = xv[j] + gt * (y[j] * r * gg);
            s2 += (xv[j].x * xv[j].x + xv[j].y * xv[j].y) + (xv[j].z * xv[j].z + xv[j].w * xv[j].w);
            if (XOUT_BF) { u32x2 w; w.x = pk2(xv[j].x, xv[j].y); w.y = pk2(xv[j].z, xv[j].w); ((u32x2*)((bf16*)Xout + (size_t)m * D))[lane + 64 * j] = w; }
            else ((f32x4*)((float*)Xout + (size_t)m * D))[lane + 64 * j] = xv[j];
        }
        if (H) {
            const float r2 = 1.0f / sqrtf(wave_sum(s2) * (1.f / D) + RMS_EPS);
            u32x2* o = (u32x2*)(H + (size_t)m * D) + lane;
#pragma unroll
            for (int j = 0; j < 4; ++j) {
                const f32x4 gg = ((const f32x4*)g2)[lane + 64 * j], s1 = ((const f32x4*)(sc + b * 6144))[lane + 64 * j], s0 = ((const f32x4*)(sh + b * 6144))[lane + 64 * j];
                const f32x4 h = xv[j] * r2 * gg * (1.0f + s1) + s0;
                if (H_FP8) ((unsigned*)((unsigned char*)H + (size_t)m * D))[lane + 64 * j] = pk4_fp8(h.x * F8_SA, h.y * F8_SA, h.z * F8_SA, h.w * F8_SA);
                else { u32x2 w; w.x = pk2(h.x, h.y); w.y = pk2(h.z, h.w); o[64 * j] = w; }
            }
        }
    }
}

__device__ __forceinline__ void p_kmean(const bf16* Kb, float* kmean, LAS unsigned char* lds, int blk, int G, int tid, int wave, int lane) {
    LAS float* red = (LAS float*)lds;
    for (int it = blk; it < BATCH * NH * 32; it += G) {
        const int b = it >> 8, h = (it >> 5) & 7, kb = it & 31;
        const bf16* p = Kb + ((size_t)b * SEQ + kb * 256 + wave * 32) * D + h * HD + 2 * lane;
        float s0 = 0.f, s1 = 0.f;
#pragma unroll 8
        for (int r = 0; r < 32; ++r) { const unsigned w = *(const unsigned*)(p + (size_t)r * D); s0 += bflo(w); s1 += bfhi(w); }
        red[wave * 128 + 2 * lane] = s0; red[wave * 128 + 2 * lane + 1] = s1;
        __syncthreads();
        if (tid < 128) { float sum = 0.f;
#pragma unroll
            for (int w8 = 0; w8 < 8; ++w8) sum += red[w8 * 128 + tid];
            kmean[(size_t)it * 128 + tid] = sum * (1.0f / 256.0f); }
        __syncthreads();
    }
}
__device__ __forceinline__ void p_gate(const bf16* Qb, const float* kmean, unsigned* sel, unsigned* cnt, unsigned short* lists, LAS unsigned char* lds, int blk, int G, int tid, int wave, int lane) {
    LAS float* km = (LAS float*)lds;
    for (int it = blk; it < 256; it += G) {
        const int bh = it >> 4, span = it & 15, b = bh >> 3, h = bh & 7;
        __syncthreads();
        for (int i = tid; i < 1024; i += NTHR) ((LAS f32x4*)km)[i] = ((const f32x4*)(kmean + (size_t)bh * 4096))[i];
        __syncthreads();
        const int q = span * 512 + wave * 64 + lane, own = (span * 512 + wave * 64) >> 8;
        unsigned mask;
        if (own <= 3) mask = (1u << own) - 1u;
        else {
            float qf[128];
            const u32x4* qp = (const u32x4*)(Qb + ((size_t)b * SEQ + q) * D + h * HD);
#pragma unroll
            for (int c = 0; c < 16; ++c) { const u32x4 w = qp[c]; qf[c * 8 + 0] = bflo(w.x); qf[c * 8 + 1] = bfhi(w.x); qf[c * 8 + 2] = bflo(w.y); qf[c * 8 + 3] = bfhi(w.y);
                qf[c * 8 + 4] = bflo(w.z); qf[c * 8 + 5] = bfhi(w.z); qf[c * 8 + 6] = bflo(w.w); qf[c * 8 + 7] = bfhi(w.w); }
            float b0 = -3e38f, b1 = -3e38f, b2 = -3e38f; int i0 = 0, i1 = 0, i2 = 0;
#pragma unroll 1
            for (int n = 0; n < own; ++n) {
                float g0 = 0.f, g1 = 0.f, g2 = 0.f, g3 = 0.f;
#pragma unroll
                for (int d = 0; d < 128; d += 4) { const f32x4 kv = *(LAS f32x4*)(km + n * 128 + d); g0 += qf[d] * kv.x; g1 += qf[d + 1] * kv.y; g2 += qf[d + 2] * kv.z; g3 += qf[d + 3] * kv.w; }
                const float g = (g0 + g1) + (g2 + g3);
                if (g > b0) { b2 = b1; i2 = i1; b1 = b0; i1 = i0; b0 = g; i0 = n; }
                else if (g > b1) { b2 = b1; i2 = i1; b1 = g; i1 = n; }
                else if (g > b2) { b2 = g; i2 = n; }
            }
            mask = (1u << i0) | (1u << i1) | (1u << i2);
        }
        sel[(size_t)bh * SEQ + q] = mask;
        unsigned mycnt = 0u;
        for (int j = 0; j < own; ++j) { const unsigned long long bl = __ballot((mask >> j) & 1u); if (lane == j) mycnt = (unsigned)__popcll(bl); }
        unsigned base = 0u;
        if (lane < own && mycnt) base = __hip_atomic_fetch_add(cnt + bh * 32 + lane, mycnt, __ATOMIC_RELAXED, __HIP_MEMORY_SCOPE_AGENT);
        for (int j = 0; j < own; ++j) { const unsigned long long bl = __ballot((mask >> j) & 1u); const unsigned bj = (unsigned)__builtin_amdgcn_readlane((int)base, j);
            if ((mask >> j) & 1u) lists[((size_t)bh * 32 + j) * 8192 + bj + (unsigned)__popcll(bl & ((1ull << lane) - 1ull))] = (unsigned short)q; }
    }
}

namespace att {
typedef short bf16x8 __attribute__((ext_vector_type(8)));
typedef short s16x4 __attribute__((ext_vector_type(4)));
typedef float f32x16 __attribute__((ext_vector_type(16)));
typedef LAS const char* lcp;
constexpr int PITCH = 1024;
constexpr int SHM_V = 16384, SHM_K = 16384;
constexpr int L_K = 0, L_V = 65536, L_WS = 131072, L_LUT = 133120;
constexpr int LUTN = 2304, RMAXL = 2047, RFAR = 1536;
#define KSWZ(row, colB) ((row) * 256 + ((colB) ^ (((row) & 7) << 4)))
#define SBAR() __builtin_amdgcn_sched_barrier(0)
#define WG_BAR() do { asm volatile("s_waitcnt lgkmcnt(0)" ::: "memory"); __builtin_amdgcn_s_barrier(); asm volatile("" ::: "memory"); } while (0)
__device__ __forceinline__ int v_st(int k, int c) { const int kk = (k & ~0xC) | ((k & 4) << 1) | ((k & 8) >> 1); return ((kk >> 3) * 4 + (c >> 5)) * 512 + ((kk & 7) * 32 + (c & 31)) * 2; }
__device__ __forceinline__ int v_rd_base(int lane) { return ((lane & 3) << 3) | (((lane >> 2) & 3) << 6) | (((lane >> 4) & 1) << 5) | (((lane >> 5) & 1) << 8); }
constexpr int v_rd_off(int d0, int ks, int half) { return d0 * 512 + ks * 4096 + half * 2048; }
__device__ __forceinline__ int crow(int r, int hi) { return (r & 3) + 8 * (r >> 2) + 4 * hi; }
__device__ __forceinline__ unsigned cvtpk(float lo, float hi) { unsigned r; asm volatile("v_cvt_pk_bf16_f32 %0, %1, %2" : "=v"(r) : "v"(lo), "v"(hi)); return r; }

template <int KB, int NDS>
__device__ __forceinline__ void qkt(f32x16& p0, f32x16& p1, lcp K_lds, int r32, int hi, int coff, const bf16x8* qr) {
    lcp kb[4];
#pragma unroll
    for (int dd = 0; dd < 4; ++dd) kb[dd] = K_lds + KB * SHM_K + KSWZ(r32, (dd * 16 + hi * 8) * 2) + coff;
#pragma unroll
    for (int d0 = 0; d0 < NDS; ++d0) { lcp a = kb[d0 & 3] + (d0 >> 2) * 128;
        const bf16x8 b0 = *(LAS const bf16x8*)a;
        const bf16x8 b1 = *(LAS const bf16x8*)(a + 32 * 256);
        p0 = __builtin_amdgcn_mfma_f32_32x32x16_bf16(b0, qr[d0], p0, 0, 0, 0);
        p1 = __builtin_amdgcn_mfma_f32_32x32x16_bf16(b1, qr[d0], p1, 0, 0, 0);
        if (NDS == 8 && (d0 & 1) == 1) SBAR(); }
}
template <int VB>
__device__ __forceinline__ void pv_tile(f32x16* o, int vb0, bf16x8 pa0, bf16x8 pa1, bf16x8 pa2, bf16x8 pa3) {
#define TRRD(dst, off) asm volatile("ds_read_b64_tr_b16 %0, %1 offset:%2" : "=&v"(dst) : "v"(vb0), "i"(off) : "memory")
#define PV_D0(d0) do { s16x4 l0, l1, l2, l3, h0, h1, h2, h3; constexpr int b_ = VB * SHM_V + v_rd_off(d0, 0, 0); \
        TRRD(l0, b_); TRRD(h0, b_ + 2048); TRRD(l1, b_ + 4096); TRRD(h1, b_ + 6144); TRRD(l2, b_ + 8192); TRRD(h2, b_ + 10240); TRRD(l3, b_ + 12288); TRRD(h3, b_ + 14336); \
        asm volatile("s_waitcnt lgkmcnt(0)" ::: "memory"); SBAR(); \
        o[d0] = __builtin_amdgcn_mfma_f32_32x32x16_bf16(pa0, (bf16x8){l0[0], l0[1], l0[2], l0[3], h0[0], h0[1], h0[2], h0[3]}, o[d0], 0, 0, 0); \
        o[d0] = __builtin_amdgcn_mfma_f32_32x32x16_bf16(pa1, (bf16x8){l1[0], l1[1], l1[2], l1[3], h1[0], h1[1], h1[2], h1[3]}, o[d0], 0, 0, 0); \
        o[d0] = __builtin_amdgcn_mfma_f32_32x32x16_bf16(pa2, (bf16x8){l2[0], l2[1], l2[2], l2[3], h2[0], h2[1], h2[2], h2[3]}, o[d0], 0, 0, 0); \
        o[d0] = __builtin_amdgcn_mfma_f32_32x32x16_bf16(pa3, (bf16x8){l3[0], l3[1], l3[2], l3[3], h3[0], h3[1], h3[2], h3[3]}, o[d0], 0, 0, 0); } while (0)
    PV_D0(0); PV_D0(1); PV_D0(2); PV_D0(3);
#undef PV_D0
#undef TRRD
}

template <int NDS>
__device__ __forceinline__ void kread(bf16x8* kf, int kaddr_base, int r32, int hi, int coff) {
#pragma unroll
    for (int d0 = 0; d0 < NDS; ++d0) { const int a = kaddr_base + KSWZ(r32, ((d0 & 3) * 16 + hi * 8) * 2) + coff + (d0 >> 2) * 128;
        asm volatile("ds_read_b128 %0, %1" : "=&v"(kf[2 * d0]) : "v"(a) : "memory");
        asm volatile("ds_read_b128 %0, %1 offset:8192" : "=&v"(kf[2 * d0 + 1]) : "v"(a) : "memory"); }
}
template <int NDS>
__device__ __forceinline__ void kmma(f32x16& p0, f32x16& p1, const bf16x8* kf, const bf16x8* qr) {
#pragma unroll
    for (int d0 = 0; d0 < NDS; ++d0) { p0 = __builtin_amdgcn_mfma_f32_32x32x16_bf16(kf[2 * d0], qr[d0], p0, 0, 0, 0); p1 = __builtin_amdgcn_mfma_f32_32x32x16_bf16(kf[2 * d0 + 1], qr[d0], p1, 0, 0, 0); }
}

__device__ __forceinline__ void pv_tile_pf(f32x16* o, int vb0, bf16x8 pa0, bf16x8 pa1, bf16x8 pa2, bf16x8 pa3) {
#define TRRD(dst, off) asm volatile("ds_read_b64_tr_b16 %0, %1 offset:%2" : "=&v"(dst) : "v"(vb0), "i"(off) : "memory")
#define RD8(S, d0) do { constexpr int b_ = v_rd_off(d0, 0, 0); TRRD(S[0], b_); TRRD(S[1], b_ + 2048); TRRD(S[2], b_ + 4096); TRRD(S[3], b_ + 6144); \
        TRRD(S[4], b_ + 8192); TRRD(S[5], b_ + 10240); TRRD(S[6], b_ + 12288); TRRD(S[7], b_ + 14336); } while (0)
#define MMA4(d0, S) do { \
        o[d0] = __builtin_amdgcn_mfma_f32_32x32x16_bf16(pa0, (bf16x8){S[0][0], S[0][1], S[0][2], S[0][3], S[1][0], S[1][1], S[1][2], S[1][3]}, o[d0], 0, 0, 0); \
        o[d0] = __builtin_amdgcn_mfma_f32_32x32x16_bf16(pa1, (bf16x8){S[2][0], S[2][1], S[2][2], S[2][3], S[3][0], S[3][1], S[3][2], S[3][3]}, o[d0], 0, 0, 0); \
        o[d0] = __builtin_amdgcn_mfma_f32_32x32x16_bf16(pa2, (bf16x8){S[4][0], S[4][1], S[4][2], S[4][3], S[5][0], S[5][1], S[5][2], S[5][3]}, o[d0], 0, 0, 0); \
        o[d0] = __builtin_amdgcn_mfma_f32_32x32x16_bf16(pa3, (bf16x8){S[6][0], S[6][1], S[6][2], S[6][3], S[7][0], S[7][1], S[7][2], S[7][3]}, o[d0], 0, 0, 0); } while (0)
    s16x4 sa[8], sb[8];
    RD8(sa, 0); RD8(sb, 1);
    asm volatile("s_waitcnt lgkmcnt(8)" ::: "memory"); SBAR(); MMA4(0, sa); SBAR();
    RD8(sa, 2);
    asm volatile("s_waitcnt lgkmcnt(8)" ::: "memory"); SBAR(); MMA4(1, sb); SBAR();
    RD8(sb, 3);
    asm volatile("s_waitcnt lgkmcnt(8)" ::: "memory"); SBAR(); MMA4(2, sa); SBAR();
    asm volatile("s_waitcnt lgkmcnt(0)" ::: "memory"); SBAR(); MMA4(3, sb);
#undef MMA4
#undef RD8
#undef TRRD
}
constexpr float THR2 = 8.0f;
__device__ __forceinline__ void partial_sm(f32x16& p0, f32x16& p1, float sh, float& m_reg, float& alpha) {
    float pmax = p0[0];
#pragma unroll
    for (int r = 1; r < 16; ++r) pmax = fmaxf(pmax, p0[r]);
#pragma unroll
    for (int r = 0; r < 16; ++r) pmax = fmaxf(pmax, p1[r]);
    { auto rr = __builtin_amdgcn_permlane32_swap(__float_as_uint(pmax), __float_as_uint(pmax), false, false);
      pmax = fmaxf(__uint_as_float(rr[0]), __uint_as_float(rr[1])); }
    pmax += sh;
    float mn;
    if (__builtin_expect(__all((pmax - m_reg) <= THR2), 1)) { mn = m_reg; alpha = 1.f; }
    else { const bool upd = (pmax - m_reg) > THR2;
        mn = upd ? fmaxf(m_reg, pmax) : m_reg; alpha = upd ? __builtin_amdgcn_exp2f(m_reg - mn) : 1.f; m_reg = mn; }
    const float off = mn - sh;
#pragma unroll
    for (int r = 0; r < 16; ++r) p0[r] = __builtin_amdgcn_exp2f(p0[r] - off);
#pragma unroll
    for (int r = 0; r < 16; ++r) p1[r] = p1[r] - off;
}
__device__ __forceinline__ void finish_sm(f32x16& p0, f32x16& p1, float alpha, float& l_reg, bf16x8& pa0, bf16x8& pa1, bf16x8& pa2, bf16x8& pa3) {
#pragma unroll
    for (int r = 0; r < 16; ++r) p1[r] = __builtin_amdgcn_exp2f(p1[r]);
    float ps = 0.f;
#pragma unroll
    for (int r = 0; r < 16; ++r) ps += p0[r];
#pragma unroll
    for (int r = 0; r < 16; ++r) ps += p1[r];
    { auto rr = __builtin_amdgcn_permlane32_swap(__float_as_uint(ps), __float_as_uint(ps), false, false);
      ps = __uint_as_float(rr[0]) + __uint_as_float(rr[1]); }
    l_reg = l_reg * alpha + ps;
#define PK4(P, B_, OUT) do { unsigned a0 = cvtpk(P[B_+0], P[B_+1]), a1 = cvtpk(P[B_+2], P[B_+3]); \
        unsigned b0 = cvtpk(P[B_+4], P[B_+5]), b1 = cvtpk(P[B_+6], P[B_+7]); \
        auto r0 = __builtin_amdgcn_permlane32_swap(a0, b0, false, false); auto r1 = __builtin_amdgcn_permlane32_swap(a1, b1, false, false); \
        u32x4 w = {r0[0], r1[0], r0[1], r1[1]}; OUT = __builtin_bit_cast(bf16x8, w); } while (0)
    PK4(p0, 0, pa0); PK4(p0, 8, pa1); PK4(p1, 0, pa2); PK4(p1, 8, pa3);
#undef PK4
}
__device__ __forceinline__ void softmax_tile(f32x16& p0, f32x16& p1, float sh, float& m_reg, float& l_reg, float& alpha, bf16x8& pa0, bf16x8& pa1, bf16x8& pa2, bf16x8& pa3) {
    partial_sm(p0, p1, sh, m_reg, alpha); finish_sm(p0, p1, alpha, l_reg, pa0, pa1, pa2, pa3);
}
__device__ __forceinline__ void add_bias_lut(f32x16& p0, f32x16& p1, LAS const float* lut, int dq) {
    LAS const float* bp = lut + (RMAXL - dq);
#pragma unroll
    for (int r = 0; r < 16; ++r) { const int c = (r & 3) + 8 * (r >> 2); p0[r] += bp[c]; p1[r] += bp[c + 32]; if ((r & 3) == 3) asm volatile("" ::: "memory"); }
}
__device__ __forceinline__ void load_bias_lut(f32x16& p0, f32x16& p1, LAS const float* lut, int dq) {
    LAS const float* bp = lut + (RMAXL - dq);
#pragma unroll
    for (int r = 0; r < 16; ++r) { const int c = (r & 3) + 8 * (r >> 2); p0[r] = bp[c]; p1[r] = bp[c + 32]; }
}
__device__ __forceinline__ void causal_mask(f32x16& p0, f32x16& p1, int dq) {
    const float NEG = -__builtin_inff();
#pragma unroll
    for (int r = 0; r < 16; ++r) { const int c = (r & 3) + 8 * (r >> 2); if (dq - c < 0) p0[r] = NEG; if (dq - c - 32 < 0) p1[r] = NEG; }
}
struct DmaOff { unsigned k[2], v[2]; };
__device__ __forceinline__ DmaOff dma_offsets(int wid, int lane) {
    DmaOff d;
#pragma unroll
    for (int i = 0; i < 2; ++i) { const int p = wid * 2 + i;
        { const int row = 4 * p + (lane >> 4), c = (lane & 15) ^ (row & 7); d.k[i] = (unsigned)(row * PITCH * 2 + c * 16); }
        { const int sub = 2 * p + (lane >> 5), kkhi = sub >> 2, cblk = sub & 3, kklo = (lane & 31) >> 2, kk = kkhi * 8 + kklo;
          const int k = (kk & ~0xC) | ((kk & 4) << 1) | ((kk & 8) >> 1), c = cblk * 32 + (lane & 3) * 8; d.v[i] = (unsigned)(k * PITCH * 2 + c * 2); } }
    return d;
}
__device__ __forceinline__ void dma_tile(LAS char* lds, int bf, const bf16* Kc, const bf16* Vc, int k0, const DmaOff& d, int wid) {
    const char* kt = (const char*)Kc + (size_t)k0 * (PITCH * 2); const char* vt = (const char*)Vc + (size_t)k0 * (PITCH * 2);
#pragma unroll
    for (int i = 0; i < 2; ++i) {
        __builtin_amdgcn_global_load_lds((const unsigned*)(kt + d.k[i]), (LAS unsigned*)(lds + L_K + bf * SHM_K + (wid * 2 + i) * 1024), 16, 0, 0);
        __builtin_amdgcn_global_load_lds((const unsigned*)(vt + d.v[i]), (LAS unsigned*)(lds + L_V + bf * SHM_V + (wid * 2 + i) * 1024), 16, 0, 0); }
}
constexpr int L_CF = 142336, L_TAB = 146432, L_FOUND = 148544;
__device__ __forceinline__ void build_lut(LAS char* lds, const float* biasT, int h, int tid) {
    LAS float* lut = (LAS float*)(lds + L_LUT);
    for (int i = tid; i < LUTN; i += 512) lut[i] = biasT[h * LUTN + i];
}

typedef int i32x8v __attribute__((ext_vector_type(8)));
typedef int i32x4v __attribute__((ext_vector_type(4)));
constexpr int SHM_V8 = 8192;
constexpr float F8_SP = 256.0f, F8_SV = 8.0f;
__device__ __forceinline__ unsigned dma_v8_offset(int wid, int lane) { const int row = wid * 16 + (lane >> 2), c = (lane & 3) ^ ((row >> 2) & 3); return (unsigned)(row * M + c * 16); }
__device__ __forceinline__ void dma_tile_k_v8(LAS char* lds, int slot, const bf16* Kc, const unsigned char* V8c, int k0, const DmaOff& d, unsigned v8off, int wid) {
    const char* kt = (const char*)Kc + (size_t)k0 * (PITCH * 2);
#pragma unroll
    for (int i = 0; i < 2; ++i) __builtin_amdgcn_global_load_lds((const unsigned*)(kt + d.k[i]), (LAS unsigned*)(lds + L_K + slot * SHM_K + (wid * 2 + i) * 1024), 16, 0, 0);
    __builtin_amdgcn_global_load_lds((const unsigned*)(V8c + k0 + v8off), (LAS unsigned*)(lds + L_V + slot * SHM_V8 + wid * 1024), 16, 0, 0);
}
__device__ __forceinline__ void pv8(f32x16* o, f32x16& ol, int a0, int a1, const i32x8v& P8, const i32x8v& ONES8) {
    i32x4v lo0, lo1, lo2, lo3, h0, h1, h2, h3;
    asm volatile("ds_read_b128 %0, %1" : "=&v"(lo0) : "v"(a0) : "memory");            asm volatile("ds_read_b128 %0, %1" : "=&v"(h0) : "v"(a1) : "memory");
    asm volatile("ds_read_b128 %0, %1 offset:2048" : "=&v"(lo1) : "v"(a0) : "memory"); asm volatile("ds_read_b128 %0, %1 offset:2048" : "=&v"(h1) : "v"(a1) : "memory");
    asm volatile("ds_read_b128 %0, %1 offset:4096" : "=&v"(lo2) : "v"(a0) : "memory"); asm volatile("ds_read_b128 %0, %1 offset:4096" : "=&v"(h2) : "v"(a1) : "memory");
    asm volatile("ds_read_b128 %0, %1 offset:6144" : "=&v"(lo3) : "v"(a0) : "memory"); asm volatile("ds_read_b128 %0, %1 offset:6144" : "=&v"(h3) : "v"(a1) : "memory");
#define PV8_MMA(d0, L, H) do { const i32x8v b_ = {L[0], L[1], L[2], L[3], H[0], H[1], H[2], H[3]}; \
        asm volatile("v_mfma_f32_32x32x64_f8f6f4 %0, %1, %2, %0 cbsz:1" : "+v"(o[d0]) : "v"(P8), "v"(b_)); } while (0)
    asm volatile("v_mfma_f32_32x32x64_f8f6f4 %0, %1, %2, %0 cbsz:1" : "+v"(ol) : "v"(P8), "v"(ONES8));
    asm volatile("s_waitcnt lgkmcnt(6)" ::: "memory"); PV8_MMA(0, lo0, h0);
    asm volatile("s_waitcnt lgkmcnt(4)" ::: "memory"); PV8_MMA(1, lo1, h1);
    asm volatile("s_waitcnt lgkmcnt(2)" ::: "memory"); PV8_MMA(2, lo2, h2);
    asm volatile("s_waitcnt lgkmcnt(0)" ::: "memory"); PV8_MMA(3, lo3, h3);
#undef PV8_MMA
}
__device__ __forceinline__ void softmax_tile8(f32x16& p0, f32x16& p1, float sh, float& m_reg, float& alpha, i32x8v& P8) {
    float pmax = p0[0];
#pragma unroll
    for (int r = 1; r < 16; ++r) pmax = fmaxf(pmax, p0[r]);
#pragma unroll
    for (int r = 0; r < 16; ++r) pmax = fmaxf(pmax, p1[r]);
    { auto rr = __builtin_amdgcn_permlane32_swap(__float_as_uint(pmax), __float_as_uint(pmax), false, false);
      pmax = fmaxf(__uint_as_float(rr[0]), __uint_as_float(rr[1])); }
    pmax += sh;
    float mn;
    if (__builtin_expect(__all((pmax - m_reg) <= 6.0f), 1)) { mn = m_reg; alpha = 1.f; }
    else { const bool upd = (pmax - m_reg) > 6.0f; mn = upd ? fmaxf(m_reg, pmax) : m_reg; alpha = upd ? __builtin_amdgcn_exp2f(m_reg - mn) : 1.f; m_reg = mn; }
    const float off = mn - sh - 8.0f;
#pragma unroll
    for (int r = 0; r < 16; ++r) p0[r] = __builtin_amdgcn_exp2f(p0[r] - off);
#pragma unroll
    for (int r = 0; r < 16; ++r) p1[r] = __builtin_amdgcn_exp2f(p1[r] - off);
#pragma unroll
    for (int i = 0; i < 4; ++i) { int t_ = __builtin_amdgcn_cvt_pk_bf8_f32(p0[4 * i], p0[4 * i + 1], 0, false); P8[i] = __builtin_amdgcn_cvt_pk_bf8_f32(p0[4 * i + 2], p0[4 * i + 3], t_, true); }
#pragma unroll
    for (int i = 0; i < 4; ++i) { int t_ = __builtin_amdgcn_cvt_pk_bf8_f32(p1[4 * i], p1[4 * i + 1], 0, false); P8[4 + i] = __builtin_amdgcn_cvt_pk_bf8_f32(p1[4 * i + 2], p1[4 * i + 3], t_, true); }
}

template <int VAR> __device__ __forceinline__ void diff_unit(LAS char* lds, int b, int h, int qb, const bf16* Q, const bf16* K, const unsigned char* V8T, bf16* O, const float* relb, const float* biasT,
                                          float lam_full, const float* subg, int tid, int wid, int lane) {
    asm volatile("" : "+v"(lane), "+v"(tid));
    const int r32 = lane & 31, hi = lane >> 5, cm = wid >> 2, w4 = wid & 3;
    const size_t rowbase = (size_t)b * SEQ;
    const int q0 = qb * 128, qw0 = q0 + w4 * 32, qpos = qw0 + r32;
    const bf16* Kc = K + rowbase * PITCH + h * HD; const unsigned char* V8c = V8T + (size_t)(h * HD) * M + rowbase;
    const int NT = (q0 + 128) / 64;
    const DmaOff dmo = dma_offsets(wid, lane);
    const unsigned v8off = dma_v8_offset(wid, lane);
    const int va0 = (int)(unsigned)(uintptr_t)(lds + L_V) + r32 * 64 + (((2 * hi) ^ ((r32 >> 2) & 3)) << 4), va1 = va0 ^ 16;
    LAS float* ws = (LAS float*)(lds + L_WS) + wid * 64;
    LAS const float* lut = (LAS const float*)(lds + L_LUT);
    lcp K_lds = (lcp)(lds + L_K);
    const float b31 = relb[31 * 8 + h] * 1.4426950408889634f;
    build_lut(lds, biasT, h, tid);
    bf16x8 qr[4];
#pragma unroll
    for (int d0 = 0; d0 < 4; ++d0) qr[d0] = *(const bf16x8*)(Q + (rowbase + qpos) * PITCH + h * HD + cm * 64 + d0 * 16 + hi * 8);
    dma_tile_k_v8(lds, 0, Kc, V8c, 0, dmo, v8off, wid);
    dma_tile_k_v8(lds, 1, Kc, V8c, 64, dmo, v8off, wid);
    asm volatile("s_waitcnt vmcnt(0)" ::: "memory");
    WG_BAR();
    float m_reg = -1e30f; f32x16 o[4] = {};
    f32x16 p0, p1; i32x8v P8 = {0, 0, 0, 0, 0, 0, 0, 0}; f32x16 ol = {};
    i32x8v ONES8; { int one_ = 0x38383838; asm volatile("" : "+v"(one_)); ONES8 = (i32x8v){one_, one_, one_, one_, one_, one_, one_, one_}; }
    const bool halfB = cm != 0;
    const int kl0 = (int)(unsigned)(uintptr_t)(lds + L_K);
    if (halfB) WG_BAR();
    for (int t = 0; t < NT; ++t) {
        __builtin_amdgcn_s_setprio(2);
        if (VAR != 2 && VAR != 3 && VAR != 7 && VAR != 8) { bf16x8 kf[8];
            kread<4>(kf, kl0 + (t & 3) * SHM_K, r32, hi, cm * 128);
            if (qw0 - (t * 64 + 63) >= RFAR) { p0 = f32x16{}; p1 = f32x16{}; } else load_bias_lut(p0, p1, lut, qpos - t * 64 - 4 * hi);
            if (t > 0) pv8(o, ol, va0 + ((t - 1) & 3) * SHM_V8, va1 + ((t - 1) & 3) * SHM_V8, P8, ONES8);
            asm volatile("s_waitcnt lgkmcnt(0)" ::: "memory"); SBAR();
            kmma<4>(p0, p1, kf, qr); } else { p0 = f32x16{}; p1 = f32x16{}; asm volatile("" : "+v"(p0), "+v"(p1)); }
        __builtin_amdgcn_s_setprio(0);
        if (halfB) asm volatile("s_waitcnt vmcnt(0)" ::: "memory");
        WG_BAR();
        const bool issue = VAR != 4 && VAR != 7 && VAR != 8 && t + 2 < NT;
        if (issue) dma_tile_k_v8(lds, (t + 2) & 3, Kc, V8c, (t + 2) * 64, dmo, v8off, wid);
        { const int k0_ = t * 64; float sh_ = 0.f, alpha; const int dq_ = qpos - k0_ - 4 * hi;
          if (VAR != 8) { if (qw0 - (k0_ + 63) >= RFAR) sh_ = b31;
          if (k0_ + 63 > qw0) causal_mask(p0, p1, dq_); }
          softmax_tile8(p0, p1, sh_, m_reg, alpha, P8);
          if (__any(alpha < 1.f)) { if (hi == 0) ws[r32] = alpha; asm volatile("s_waitcnt lgkmcnt(0)" ::: "memory");
#pragma unroll
              for (int r = 0; r < 16; ++r) { const float a_ = ws[crow(r, hi)]; o[0][r] *= a_; o[1][r] *= a_; o[2][r] *= a_; o[3][r] *= a_; ol[r] *= a_; } } }
        if (!halfB) { if (issue) asm volatile("s_waitcnt vmcnt(3)" ::: "memory"); else asm volatile("s_waitcnt vmcnt(0)" ::: "memory"); }
        WG_BAR();
    }
    __builtin_amdgcn_s_setprio(2);
    pv8(o, ol, va0 + ((NT - 1) & 3) * SHM_V8, va1 + ((NT - 1) & 3) * SHM_V8, P8, ONES8);
    asm volatile("s_nop 15\n\ts_nop 15" ::: "memory");
    __builtin_amdgcn_s_setprio(0);
    if (!halfB) WG_BAR();
    WG_BAR();
#pragma unroll
    for (int r = 0; r < 16; ++r) { const float rl = __builtin_amdgcn_rcpf(ol[r] * F8_SV);
#pragma unroll
        for (int d0 = 0; d0 < 4; ++d0) o[d0][r] *= rl; }
    LAS float* xch = (LAS float*)lds + (size_t)w4 * 64 * 64;
    if (cm == 1) {
#pragma unroll
        for (int d0 = 0; d0 < 4; ++d0)
#pragma unroll
            for (int r = 0; r < 16; ++r) xch[(d0 * 16 + r) * 64 + lane] = o[d0][r];
    }
    WG_BAR();
    if (cm == 0) {
        float ss[16];
#pragma unroll
        for (int r = 0; r < 16; ++r) { float a = 0.f;
#pragma unroll
            for (int d0 = 0; d0 < 4; ++d0) { o[d0][r] -= lam_full * xch[(d0 * 16 + r) * 64 + lane]; a += o[d0][r] * o[d0][r]; }
            ss[r] = a; }
#pragma unroll
        for (int r = 0; r < 16; ++r) {
#pragma unroll
            for (int sft = 1; sft < 32; sft <<= 1) ss[r] += bperm_f(lane ^ sft, ss[r]); }
        float gg[4];
#pragma unroll
        for (int d0 = 0; d0 < 4; ++d0) gg[d0] = subg[d0 * 32 + r32] * (1.0f - LAMBDA_INIT);
        bf16* Ow = O + (rowbase + qw0) * PITCH + h * HD;
#pragma unroll
        for (int r = 0; r < 16; ++r) { const int orow = crow(r, hi); const float rs = 1.0f / sqrtf(ss[r] * (1.0f / HD) + RMS_EPS);
            u32x2 wo; wo.x = cvtpk(o[0][r] * rs * gg[0], o[1][r] * rs * gg[1]); wo.y = cvtpk(o[2][r] * rs * gg[2], o[3][r] * rs * gg[3]);
            *(u32x2*)(Ow + (size_t)orow * PITCH + r32 * 4) = wo; }
    }
    WG_BAR();
}


__device__ __forceinline__ void block_load(LAS char* lds, const bf16* Kc, const bf16* Vc, const DmaOff& d, int wid) {
#pragma unroll
    for (int t = 0; t < 4; ++t) dma_tile(lds, t, Kc, Vc, t * 64, d, wid);
}
#define MOBA_TILE(t, CAUSAL) do { const int k0_ = kbase + (t) * 64; \
        if (!(CAUSAL) || k0_ <= qw0 + 31) { f32x16 p0, p1; bf16x8 pa0, pa1, pa2, pa3; float alpha, sh = 0.f; \
            const int dq_ = qpos - k0_ - 4 * hi; \
            if (CAUSAL) load_bias_lut(p0, p1, lut, dq_); \
            else load_bias_lut(p0, p1, lut, dq_ < RFAR + 63 ? dq_ : RFAR + 63);     \
            qkt<t, 8>(p0, p1, K_lds, r32, hi, 0, qr); \
            if ((CAUSAL) && k0_ + 63 > qw0) causal_mask(p0, p1, dq_); \
            softmax_tile(p0, p1, sh, m_reg, l_reg, alpha, pa0, pa1, pa2, pa3); \
            if (__any(alpha < 1.f)) { if (hi == 0) ws[r32] = alpha; asm volatile("s_waitcnt lgkmcnt(0)" ::: "memory"); \
                _Pragma("unroll") for (int d_ = 0; d_ < 4; ++d_) _Pragma("unroll") for (int r = 0; r < 16; ++r) o[d_][r] *= ws[crow(r, hi)]; } \
            pv_tile<t>(o, vb0, pa0, pa1, pa2, pa3); } } while (0)
__device__ __forceinline__ void moba_part_group(LAS char* lds, int bh, int j, int g, int cntj, const bf16* Q, const unsigned short* lists, const unsigned* sel,
                                                bf16* P0, bf16* P1, bf16* P2, f32x2* ml, float b31, int wid, int lane) {
    asm volatile("" : "+v"(lane));
    const int r32 = lane & 31, hi = lane >> 5, b = bh >> 3, h = bh & 7;
    const size_t rowbase = (size_t)b * SEQ;
    const int idx = g * 32 + r32; const bool valid = idx < cntj;
    const int qpos = (int)lists[((size_t)bh * 32 + j) * 8192 + (valid ? idx : cntj - 1)];
    const unsigned smask = sel[(size_t)bh * SEQ + qpos]; const int slot = __popc(smask & ((1u << j) - 1u));
    const int vb0 = (int)(unsigned)(uintptr_t)(lds + L_V) + v_rd_base(lane);
    LAS float* ws = (LAS float*)(lds + L_WS) + wid * 64;
    LAS const float* lut = (LAS const float*)(lds + L_LUT);
    lcp K_lds = (lcp)(lds + L_K);
    bf16x8 qr[8];
#pragma unroll
    for (int d0 = 0; d0 < 8; ++d0) qr[d0] = *(const bf16x8*)(Q + (rowbase + qpos) * PITCH + h * HD + d0 * 16 + hi * 8);
    if (hi == 0) ((LAS int*)ws)[32 + r32] = valid ? (int)((unsigned)(rowbase + qpos) | ((unsigned)slot << 24)) : -1;
    float m_reg = -1e30f, l_reg = 0.f; f32x16 o[4] = {};
    const int kbase = j * 256, qw0 = 0; (void)qw0;
    MOBA_TILE(0, false); MOBA_TILE(1, false); MOBA_TILE(2, false); MOBA_TILE(3, false);
    if (hi == 0) { ws[r32] = l_reg; if (valid) ml[((size_t)slot * M + rowbase + qpos) * NH + h] = (f32x2){m_reg, l_reg}; }
    asm volatile("s_waitcnt lgkmcnt(0)" ::: "memory");
#pragma unroll
    for (int r = 0; r < 16; ++r) { const int orow = crow(r, hi); const float rl = __builtin_amdgcn_rcpf(ws[orow]); const int info = ((LAS const int*)ws)[32 + orow];
        const int sl = info >> 24; bf16* Pb = sl == 0 ? P0 : (sl == 1 ? P1 : P2); bf16* Ow = Pb + (size_t)(info & 0xffffff) * PITCH + h * HD;
        u32x2 w; w.x = cvtpk(o[0][r] * rl, o[1][r] * rl); w.y = cvtpk(o[2][r] * rl, o[3][r] * rl);
        if (info >= 0) *(u32x2*)(Ow + r32 * 4) = w; }
    asm volatile("s_waitcnt lgkmcnt(0)" ::: "memory");
}
__device__ __forceinline__ void moba_own_rows(LAS char* lds, int b, int h, int qb, const bf16* Q, bf16* O, const bf16* P0, const bf16* P1, const bf16* P2, const f32x2* ml, int wid, int lane) {
    asm volatile("" : "+v"(lane));
    const int r32 = lane & 31, hi = lane >> 5;
    const size_t rowbase = (size_t)b * SEQ;
    const int q0 = qb * 256, qw0 = q0 + wid * 32, qpos = qw0 + r32, kbase = q0;
    const int vb0 = (int)(unsigned)(uintptr_t)(lds + L_V) + v_rd_base(lane);
    LAS float* ws = (LAS float*)(lds + L_WS) + wid * 64;
    LAS const float* lut = (LAS const float*)(lds + L_LUT);
    lcp K_lds = (lcp)(lds + L_K);
    const float b31 = 0.f; (void)b31;
    bf16x8 qr[8];
#pragma unroll
    for (int d0 = 0; d0 < 8; ++d0) qr[d0] = *(const bf16x8*)(Q + (rowbase + qpos) * PITCH + h * HD + d0 * 16 + hi * 8);
    float m_reg = -1e30f, l_reg = 0.f; f32x16 o[4] = {};
    MOBA_TILE(0, true); MOBA_TILE(1, true); MOBA_TILE(2, true); MOBA_TILE(3, true);
    const int nsel = qb < 3 ? qb : 3;
    {
        float ms[3], ls[3]; float mx = m_reg;
#pragma unroll
        for (int s_ = 0; s_ < 3; ++s_) { ms[s_] = -1e30f; ls[s_] = 0.f;
            if (s_ < nsel) { const f32x2 v = ml[((size_t)s_ * M + rowbase + qpos) * NH + h]; ms[s_] = v.x; ls[s_] = v.y; mx = fmaxf(mx, v.x); } }
        const float w0 = __builtin_amdgcn_exp2f(m_reg - mx);
        float wv[3]; float den = l_reg * w0;
#pragma unroll
        for (int s_ = 0; s_ < 3; ++s_) { wv[s_] = ls[s_] * __builtin_amdgcn_exp2f(ms[s_] - mx); den += wv[s_]; }
        const float rd = 1.0f / den;
        if (hi == 0) *(LAS f32x4*)(lds + L_CF + wid * 512 + r32 * 16) = (f32x4){w0 * rd, wv[0] * rd, wv[1] * rd, wv[2] * rd};
    }
    asm volatile("s_waitcnt lgkmcnt(0)" ::: "memory");
#pragma unroll
    for (int r = 0; r < 16; ++r) { const int orow = crow(r, hi); const f32x4 cf = *(LAS const f32x4*)(lds + L_CF + wid * 512 + orow * 16);
        const size_t ro = (rowbase + qw0 + orow) * PITCH + h * HD + r32 * 4;
        float v0 = o[0][r] * cf.x, v1 = o[1][r] * cf.x, v2 = o[2][r] * cf.x, v3 = o[3][r] * cf.x;
        if (nsel > 0) { const u32x2 w = *(const u32x2*)(P0 + ro); v0 += cf.y * bflo(w.x); v1 += cf.y * bfhi(w.x); v2 += cf.y * bflo(w.y); v3 += cf.y * bfhi(w.y); }
        if (nsel > 1) { const u32x2 w = *(const u32x2*)(P1 + ro); v0 += cf.z * bflo(w.x); v1 += cf.z * bfhi(w.x); v2 += cf.z * bflo(w.y); v3 += cf.z * bfhi(w.y); }
        if (nsel > 2) { const u32x2 w = *(const u32x2*)(P2 + ro); v0 += cf.w * bflo(w.x); v1 += cf.w * bfhi(w.x); v2 += cf.w * bflo(w.y); v3 += cf.w * bfhi(w.y); }
        u32x2 wo; wo.x = cvtpk(v0, v1); wo.y = cvtpk(v2, v3);
        *(u32x2*)(O + ro) = wo; }
    asm volatile("s_waitcnt lgkmcnt(0)" ::: "memory");
}
#undef MOBA_TILE
#undef KSWZ
#undef SBAR
#undef WG_BAR
}


template <int VAR> __device__ __forceinline__ void p_diff_attn_mfma(const Args& a, LAS unsigned char* lds, int vcu, int tid, int wave, int lane, size_t out_off) {
    const bf16* Qb = (const bf16*)(a.ws + WS_Q); const bf16* Kb = (const bf16*)(a.ws + WS_K); const unsigned char* Vb = a.ws + WS_V;
    bf16* Ob = (bf16*)(a.ws + out_off); const float* biasT = (const float*)(a.ws + WS_BIAST);
    float lam_full;
    { const float* lm = a.diff_lambda; const float p01 = wave_sum(lm[lane] * lm[64 + lane]), p23 = wave_sum(lm[128 + lane] * lm[192 + lane]); lam_full = __expf(p01) - __expf(p23) + LAMBDA_INIT; }
    const int G = gridDim.x;
    if (G == 256) {
#pragma unroll 1
        for (int k = 0; k < 4; ++k) {
            const int bh = 2 * (vcu >> 5) + (k >> 1), p = vcu & 31, qb = (k & 1) ? 63 - p : p;
            att::diff_unit<VAR>((LAS char*)lds, bh >> 3, bh & 7, qb, Qb, Kb, Vb, Ob, a.rel_bias, biasT, lam_full, a.diff_subln_g, tid, wave, lane);
        }
    } else {
        for (int pp = vcu; pp < 512; pp += G) {
#pragma unroll 1
            for (int k = 0; k < 2; ++k) {
                const int bh = pp >> 5, p = pp & 31, qb = k ? 63 - p : p;
                att::diff_unit<VAR>((LAS char*)lds, bh >> 3, bh & 7, qb, Qb, Kb, Vb, Ob, a.rel_bias, biasT, lam_full, a.diff_subln_g, tid, wave, lane);
            }
        }
    }
}


__device__ __forceinline__ void p_moba_part(const Args& a, LAS unsigned char* lds, int vcu, int tid, int wave, int lane) {
    const bf16* Qb = (const bf16*)(a.ws + WS_Q); const bf16* Kb = (const bf16*)(a.ws + WS_K); const bf16* Vb = (const bf16*)(a.ws + WS_V);
    const unsigned* cnt = (const unsigned*)(a.ws + WS_CTL) + CW_CNT; const unsigned short* lists = (const unsigned short*)(a.ws + WS_LIST); const unsigned* sel = (const unsigned*)(a.ws + WS_SEL);
    bf16* P0 = (bf16*)(a.ws + WS_H); bf16* P1 = (bf16*)(a.ws + WS_Y); bf16* P2 = (bf16*)a.out; f32x2* ml = (f32x2*)((unsigned char*)a.out + WS_ML);
    LAS int* pre = (LAS int*)(lds + att::L_TAB); LAS int* found = (LAS int*)(lds + att::L_FOUND);
    const int c = (int)cnt[tid], nch = (c + 255) >> 8;
    int incl = nch;
#pragma unroll
    for (int o = 1; o < 64; o <<= 1) { const int v = bperm_i(lane >= o ? lane - o : lane, incl); if (lane >= o) incl += v; }
    if (lane == 63) pre[513 + wave] = incl;
    __syncthreads();
    int woff = 0;
#pragma unroll
    for (int w8 = 0; w8 < 8; ++w8) woff += (w8 < wave) ? pre[513 + w8] : 0;
    pre[tid + 1] = woff + incl; if (tid == 0) pre[0] = 0;
    __syncthreads();
    const int T = pre[512], G = gridDim.x;
    const int lo = (int)(((long long)T * vcu) / G), hi_ = (int)(((long long)T * (vcu + 1)) / G);
    const att::DmaOff dmo = att::dma_offsets(wave, lane);
    int last_h = -1;
    for (int it = lo; it < hi_;) {
        if (pre[tid] <= it && it < pre[tid + 1]) found[0] = tid;
        __syncthreads();
        const int f = __builtin_amdgcn_readfirstlane(found[0]);
        const int bh = f >> 5, j = f & 31, c0 = it - pre[f];
        const int seg_end = pre[f + 1] < hi_ ? pre[f + 1] : hi_, c1 = seg_end - pre[f];
        const int cntj = (int)cnt[f];
        const size_t kvoff = ((size_t)(bh >> 3) * SEQ + j * 256) * D + (bh & 7) * HD;
        att::block_load((LAS char*)lds, Kb + kvoff, Vb + kvoff, dmo, wave);
        if ((bh & 7) != last_h) { last_h = bh & 7; att::build_lut((LAS char*)lds, (const float*)(a.ws + WS_BIAST), last_h, tid); }
        const float b31 = a.rel_bias[31 * 8 + (bh & 7)] * LOG2E;
        asm volatile("s_waitcnt vmcnt(0)" ::: "memory");
        __syncthreads();
        for (int g = c0 * 8 + wave; g < c1 * 8 && g * 32 < cntj; g += 8)
            att::moba_part_group((LAS char*)lds, bh, j, g, cntj, Qb, lists, sel, P0, P1, P2, ml, b31, wave, lane);
        it = seg_end;
    }
}
__device__ __forceinline__ void p_moba_own(const Args& a, LAS unsigned char* lds, int vcu, int tid, int wave, int lane) {
    const bf16* Qb = (const bf16*)(a.ws + WS_Q); const bf16* Kb = (const bf16*)(a.ws + WS_K); const bf16* Vb = (const bf16*)(a.ws + WS_V); bf16* Ob = (bf16*)(a.ws + WS_O);
    const bf16* P0 = (const bf16*)(a.ws + WS_H); const bf16* P1 = (const bf16*)(a.ws + WS_Y); const bf16* P2 = (const bf16*)a.out; const f32x2* ml = (const f32x2*)((const unsigned char*)a.out + WS_ML);
    const int G = gridDim.x;
    const att::DmaOff dmo = att::dma_offsets(wave, lane);
    for (int u0 = 2 * vcu; u0 < 512; u0 += 2 * G) {
#pragma unroll 1
        for (int k = 0; k < 2; ++k) { const int u = u0 + k; if (u >= 512) break; const int bh = u >> 5, qb = u & 31;
            __syncthreads();
            const size_t kvoff = ((size_t)(bh >> 3) * SEQ + qb * 256) * D + (bh & 7) * HD;
            att::block_load((LAS char*)lds, Kb + kvoff, Vb + kvoff, dmo, wave);
            if (k == 0 || (u & 31) == 0) att::build_lut((LAS char*)lds, (const float*)(a.ws + WS_BIAST), bh & 7, tid);
            asm volatile("s_waitcnt vmcnt(0)" ::: "memory");
            __syncthreads();
            att::moba_own_rows((LAS char*)lds, bh >> 3, bh & 7, qb, Qb, Ob, P0, P1, P2, ml, wave, lane); }
    }
}

struct TI { int tid, lane, wave, gtid, gw; };
__device__ __forceinline__ TI mk_ti(int wave0) { const int l = lane_opaque(); const int t = wave0 * 64 + l; TI r; r.tid = t; r.lane = l; r.wave = wave0;
    r.gtid = blockIdx.x * NTHR + t; r.gw = blockIdx.x * NWAVES + r.wave; return r; }

typedef const __attribute__((address_space(4))) Args* CArgs;
__device__ __forceinline__ Args load_args() {
#if defined(__HIP_DEVICE_COMPILE__)
    auto p = __builtin_amdgcn_kernarg_segment_ptr(); asm volatile("" : "+s"(p));
    typedef const __attribute__((address_space(4))) unsigned long long* cu64; cu64 q = (cu64)p;
    Args r; r.x = (const float*)q[0]; r.c = (const float*)q[1]; r.rel_bias = (const float*)q[2]; r.ada_w = (const float*)q[3]; r.ada_b = (const float*)q[4]; r.norm_g = (const float*)q[5];
    r.moba_w_qkv = (const float*)q[6]; r.moba_w_o = (const float*)q[7]; r.diff_w_qkv = (const float*)q[8]; r.diff_w_o = (const float*)q[9];
    r.diff_lambda = (const float*)q[10]; r.diff_subln_g = (const float*)q[11]; r.ffn_w_in = (const float*)q[12]; r.ffn_w_out = (const float*)q[13];
    r.out = (float*)q[14]; r.ws = (unsigned char*)q[15]; return r;
#else
    return Args{};
#endif
}
#define WSP(T, off) ((T*)(a.ws + (off)))
#define GEMM_PHASE_F8(EPI, Aptr, Wptr, N_, K_, ...) do { const Args a = load_args(); const int G_ = gridDim.x; \
        pg8::Gemm g{Aptr, (const bf16*)(Wptr), M, N_, K_}; pg8::StaticOrder S; S.init(M, N_, G_, (int)blockIdx.x); \
        EPI E{__VA_ARGS__}; pg8::gemm_phase<EPI, pg8::StaticOrder, true, true, true>(lds, g, S, E, wave0); } while (0)
#define GEMM_PHASE(EPI, Aptr, Wptr, N_, K_, ...) do { const Args a = load_args(); const int G_ = gridDim.x; \
        pg8::Gemm g{Aptr, (const bf16*)(Wptr), M, N_, K_}; pg8::StaticOrder S; S.init(M, N_, G_, (int)blockIdx.x); \
        EPI E{__VA_ARGS__}; pg8::gemm_phase<EPI, pg8::StaticOrder, true, true>(lds, g, S, E, wave0); } while (0)
__global__ void __launch_bounds__(NTHR, 2) fwd(Args a_unused) {
    extern __shared__ __attribute__((aligned(16))) unsigned char lds_raw[];
    LAS unsigned char* lds = (LAS unsigned char*)lds_raw;
    volatile LAS unsigned* MISC = (volatile LAS unsigned*)(lds + MISC_OFF);
    const int wave0 = __builtin_amdgcn_readfirstlane((int)threadIdx.x >> 6);
    if (wave0 == 0) MISC[lane_opaque()] = 0u;
    __syncthreads();
    XcdBarrier bar;
    { const Args a = load_args(); bar = xcd_barrier_post(WSP(unsigned, WS_CTL) + CW_BAR, MISC + 8, wave0); }
#define VCU() ((gridDim.x % 8 == 0) ? (int)((blockIdx.x % 8) * (gridDim.x / 8) + blockIdx.x / 8) : (int)blockIdx.x)
#define NGW() ((int)gridDim.x * NWAVES)
#define NGT() ((int)gridDim.x * NTHR)
    constexpr float QS0 = 0.08838834764831845f * LOG2E, QS1 = 0.125f * LOG2E;
    constexpr size_t QKVS = (size_t)(WS_K - WS_Q) / 2;

    { const Args a = load_args(); const TI t = mk_ti(wave0); p_weights(a, lds, t.gw, NGW(), t.wave, t.lane); p_wo_perm(a, t.gtid, NGT()); __syncthreads(); p_mod(a, lds, (int)blockIdx.x, (int)gridDim.x, t.tid, t.wave, t.lane); }
    xcd_barrier(bar);
    { const Args a = load_args(); const TI t = mk_ti(wave0); const float* md = WSP(const float, WS_MOD); p_norm_in(a.x, a.norm_g, md, md + 1024, WSP(bf16, WS_H), t.gw, NGW(), t.lane); }
    xcd_barrier(bar);
    GEMM_PHASE(pg8::EpiQKV, WSP(bf16, WS_H), a.ws + WS_W + WO_QKV, 3 * D, D, WSP(bf16, WS_Q), D, QKVS, QS0, WSP(float, WS_KSUM));
    xcd_barrier(bar);
    { const Args a = load_args(); const TI t = mk_ti(wave0); p_gate(WSP(bf16, WS_Q), WSP(const float, WS_KSUM), WSP(unsigned, WS_SEL), WSP(unsigned, WS_CTL) + CW_CNT, WSP(unsigned short, WS_LIST), lds, (int)blockIdx.x, (int)gridDim.x, t.tid, t.wave, t.lane); }
    xcd_barrier(bar);
    { const Args a = load_args(); const TI t = mk_ti(wave0); p_moba_part(a, lds, VCU(), t.tid, t.wave, t.lane); }
    xcd_barrier(bar);
    { const Args a = load_args(); const TI t = mk_ti(wave0); p_moba_own(a, lds, VCU(), t.tid, t.wave, t.lane); }
    xcd_barrier(bar);
    GEMM_PHASE(pg8::EpiBf16<0>, WSP(bf16, WS_O), a.ws + WS_W + WO_O, D, D, WSP(bf16, WS_Y), D, nullptr, 0, 0, 1.f);
    xcd_barrier(bar);
    { const Args a = load_args(); const TI t = mk_ti(wave0); const float* md = WSP(const float, WS_MOD); const float* ng = a.norm_g;
      p_post<false, true, true>(a.x, WSP(bf16, WS_Y), ng + D, md + 2048, a.out, ng + 2 * D, md + 3072, md + 4096, WSP(bf16, WS_H), t.gw, NGW(), t.lane); }
    xcd_barrier(bar);
    GEMM_PHASE_F8(pg8::EpiSwiglu, WSP(bf16, WS_H), a.ws + WS_W + WO_IN, 2 * DFF, D / 2, WSP(bf16, WS_HH), DFF, 1.0f / (F8_SA * F8_SB), F8_SH);
    xcd_barrier(bar);
    GEMM_PHASE_F8(pg8::EpiScaled, WSP(bf16, WS_HH), a.ws + WS_W + WO_OUT, D, DFF / 2, WSP(bf16, WS_Y), D, 1.0f / (F8_SH * F8_SB));
    xcd_barrier(bar);
    { const Args a = load_args(); const TI t = mk_ti(wave0); const float* md = WSP(const float, WS_MOD); const float* ng = a.norm_g; const float* md1 = md + 2 * 6144; const float* ng1 = ng + 4 * D;
      p_post<true, true, false>(a.out, WSP(bf16, WS_Y), ng + 3 * D, md + 5120, (unsigned char*)a.out + 32 * MiB, ng1, md1, md1 + 1024, WSP(bf16, WS_H), t.gw, NGW(), t.lane); }
    xcd_barrier(bar);
    GEMM_PHASE(pg8::EpiQKV, WSP(bf16, WS_H), a.ws + WS_W + WL_STRIDE + WO_QKV, 2 * D, D, WSP(bf16, WS_Q), D, QKVS, QS1, nullptr);
    __syncthreads();
    { const Args a = load_args(); const int G_ = gridDim.x;
      pg8::Gemm g{(const bf16*)(a.ws + WS_W + WL_STRIDE + WO_QKV) + (size_t)2 * D * D, WSP(bf16, WS_H), D, M, D}; pg8::StaticOrder S; S.init(D, M, G_, (int)blockIdx.x);
      pg8::EpiVT8 E{a.ws + WS_V, M, att::F8_SV}; pg8::gemm_phase<pg8::EpiVT8, pg8::StaticOrder, true, true>(lds, g, S, E, wave0); }
    xcd_barrier(bar);
    { const Args a = load_args(); const TI t = mk_ti(wave0); p_diff_attn_mfma<0>(a, lds, VCU(), t.tid, t.wave, t.lane, WS_O); }
#ifdef PROBE_VAR
    { const Args a = load_args(); const TI t = mk_ti(wave0); p_diff_attn_mfma<PROBE_VAR>(a, lds, VCU(), t.tid, t.wave, t.lane, WS_Y); }
#endif
    xcd_barrier(bar);
    GEMM_PHASE(pg8::EpiBf16<0>, WSP(bf16, WS_O), a.ws + WS_W + WL_STRIDE + WO_O, D, D, WSP(bf16, WS_Y), D, nullptr, 0, 0, 1.f);
    xcd_barrier(bar);
    { const Args a = load_args(); const TI t = mk_ti(wave0); const float* md = WSP(const float, WS_MOD) + 2 * 6144; const float* ng = a.norm_g + 4 * D;
      p_post<true, true, true>((unsigned char*)a.out + 32 * MiB, WSP(bf16, WS_Y), ng + D, md + 2048, WSP(bf16, WS_O), ng + 2 * D, md + 3072, md + 4096, WSP(bf16, WS_H), t.gw, NGW(), t.lane); }
    xcd_barrier(bar);
    GEMM_PHASE_F8(pg8::EpiSwiglu, WSP(bf16, WS_H), a.ws + WS_W + WL_STRIDE + WO_IN, 2 * DFF, D / 2, WSP(bf16, WS_HH), DFF, 1.0f / (F8_SA * F8_SB), F8_SH);
    xcd_barrier(bar);
    GEMM_PHASE_F8(pg8::EpiScaled, WSP(bf16, WS_HH), a.ws + WS_W + WL_STRIDE + WO_OUT, D, DFF / 2, WSP(bf16, WS_Y), D, 1.0f / (F8_SH * F8_SB));
    xcd_barrier(bar);
    { const Args a = load_args(); const TI t = mk_ti(wave0); const float* md = WSP(const float, WS_MOD) + 2 * 6144; const float* ng = a.norm_g + 4 * D;
      p_post<true, false, false>(WSP(bf16, WS_O), WSP(bf16, WS_Y), ng + 3 * D, md + 5120, a.out, nullptr, nullptr, nullptr, nullptr, t.gw, NGW(), t.lane); }
}

extern "C" void kernel_launch(void* const* d_in, const int* in_sizes, int n_in, void* d_out, int out_size, void* d_ws, size_t ws_size, hipStream_t stream) {
    static int grid = 0;
    if (grid == 0) {
        if (n_in != 14 || out_size != M * D || ws_size < WS_END) { fprintf(stderr, "kernel_launch: unexpected shapes n_in %d out %d ws %zu\n", n_in, out_size, ws_size); grid = -1; return; }
        int dev = 0, cus = 0;
        if (hipGetDevice(&dev) != hipSuccess || hipDeviceGetAttribute(&cus, hipDeviceAttributeMultiprocessorCount, dev) != hipSuccess) { grid = -1; return; }
        if (hipFuncSetAttribute((const void*)fwd, hipFuncAttributeMaxDynamicSharedMemorySize, LDS_BYTES) != hipSuccess) { fprintf(stderr, "hipFuncSetAttribute failed\n"); grid = -1; return; }
        grid = cus;
    }
    if (grid < 0) return;
    (void)hipMemsetAsync((char*)d_ws + WS_CTL, 0, CTL_ZERO_BYTES, stream);
    Args a{};
    a.x = (const float*)d_in[0]; a.c = (const float*)d_in[1]; a.rel_bias = (const float*)d_in[2]; a.ada_w = (const float*)d_in[3]; a.ada_b = (const float*)d_in[4];
    a.norm_g = (const float*)d_in[5]; a.moba_w_qkv = (const float*)d_in[6]; a.moba_w_o = (const float*)d_in[7]; a.diff_w_qkv = (const float*)d_in[8]; a.diff_w_o = (const float*)d_in[9];
    a.diff_lambda = (const float*)d_in[10]; a.diff_subln_g = (const float*)d_in[11]; a.ffn_w_in = (const float*)d_in[12]; a.ffn_w_out = (const float*)d_in[13];
    a.out = (float*)d_out; a.ws = (unsigned char*)d_ws;
    hipLaunchKernelGGL(fwd, dim3(grid), dim3(NTHR), LDS_BYTES, stream, a);
}
```

```cpp
#include <hip/hip_runtime.h>
#include <cstdio>
#include <cstdint>

#define GAS __attribute__((address_space(1)))
#define LAS __attribute__((address_space(3)))
typedef unsigned short bf16;
typedef float f32x4 __attribute__((ext_vector_type(4)));
typedef float f32x2 __attribute__((ext_vector_type(2)));
typedef unsigned u32x4 __attribute__((ext_vector_type(4)));
typedef unsigned u32x2 __attribute__((ext_vector_type(2)));

constexpr int BATCH = 2, SEQ = 8192, D = 1024, NH = 8, HD = 128, DFF = 2816, NBKT = 32;
constexpr int M = BATCH * SEQ;
constexpr int NWAVES = 8, NTHR = 512;
constexpr float RMS_EPS = 1e-6f;
constexpr float LOG2E = 1.4426950408889634f;
constexpr float LAMBDA_INIT = 0.35550906759096926f;

constexpr size_t MiB = 1u << 20;
constexpr size_t WS_CTL = 0, CTL_ZERO_BYTES = 1 * MiB;
constexpr size_t WS_MOD = 1 * MiB;
constexpr size_t WS_BLUT = WS_MOD + 128 * 1024;
constexpr size_t WS_KMEAN = WS_BLUT + 16 * 1024;
constexpr size_t WS_SEL = WS_KMEAN + 256 * 1024;
constexpr size_t WS_BIAST = WS_SEL + 512 * 1024;
constexpr size_t WS_LIST = 244 * MiB;
constexpr size_t WS_ML = 32 * MiB;
constexpr size_t WS_KSUM = 256 * 1024;
constexpr int CW_CNT = 8192;
constexpr size_t WS_W = 2 * MiB, WL_STRIDE = 25 * MiB;
constexpr size_t WO_QKV = 0, WO_O = 6 * MiB, WO_IN = 8 * MiB, WO_OUT = 19 * MiB;
constexpr size_t WS_H = 52 * MiB;
constexpr size_t WS_Q = 84 * MiB, WS_K = 116 * MiB, WS_V = 148 * MiB;
constexpr size_t WS_HH = 84 * MiB;
constexpr size_t WS_O = 180 * MiB;
constexpr size_t WS_Y = 212 * MiB;
constexpr size_t WS_END = 252 * MiB;
constexpr int CW_BAR = 4096;

constexpr int LDS_BYTES = 155648;
constexpr int MISC_OFF = 150016;

#define RLX_AGENT __ATOMIC_RELAXED, __HIP_MEMORY_SCOPE_AGENT
__device__ __forceinline__ unsigned f2bf(float f) { unsigned u = __builtin_bit_cast(unsigned, f); return (u + 0x7fffu + ((u >> 16) & 1u)) >> 16; }
__device__ __forceinline__ unsigned pk2(float lo, float hi) { return f2bf(lo) | (f2bf(hi) << 16); }
__device__ __forceinline__ float bf2f(unsigned short b) { return __builtin_bit_cast(float, (unsigned)b << 16); }
__device__ __forceinline__ float bflo(unsigned w) { return __builtin_bit_cast(float, w << 16); }
__device__ __forceinline__ float bfhi(unsigned w) { return __builtin_bit_cast(float, w & 0xffff0000u); }

__device__ __forceinline__ int lane_opaque() { int l; asm volatile("v_mbcnt_lo_u32_b32 %0, -1, 0\n\tv_mbcnt_hi_u32_b32 %0, -1, %0" : "=v"(l)); return l; }
__device__ __forceinline__ float bperm_f(int src_lane, float v) { return __builtin_bit_cast(float, __builtin_amdgcn_ds_bpermute(src_lane << 2, __builtin_bit_cast(int, v))); }
__device__ __forceinline__ int bperm_i(int src_lane, int v) { return __builtin_amdgcn_ds_bpermute(src_lane << 2, v); }

#define XB_TMO      128
#define XB_XCNT(j)  (256  + 64 * (j))
#define XB_XSUB(j)  (1280 + 64 * (j))
#define XB_XGEN(j)  (2304 + 64 * (j))
#define XB_TOP      3328
#define XB_TOPGEN   3392
#define XCD_BAR_WORDS 3456
#define XB_SPIN_CAP (1u << 25)
__device__ __forceinline__ unsigned xb_ld(unsigned* p)              { return __hip_atomic_load(p, __ATOMIC_RELAXED, __HIP_MEMORY_SCOPE_AGENT); }
__device__ __forceinline__ unsigned xb_add(unsigned* p, unsigned v) { return __hip_atomic_fetch_add(p, v, __ATOMIC_RELAXED, __HIP_MEMORY_SCOPE_AGENT); }
__device__ __forceinline__ unsigned xb_xcc_id() { return (unsigned)__builtin_amdgcn_s_getreg((3 << 11) | 20) & 0xFu; }
#define XB_SPIN(cond, bar) do { unsigned _sp = 0; while (cond) { __builtin_amdgcn_s_sleep(1); \
    if ((++_sp & 255u) == 0u) { if (xb_ld(&(bar)[XB_TMO])) break; if (_sp > XB_SPIN_CAP) { atomicAdd(&(bar)[XB_TMO], 1u); break; } } } } while (0)
struct XcdBarrier { unsigned* bar; unsigned x; volatile LAS unsigned* st; int wave; };
__device__ __forceinline__ XcdBarrier xcd_barrier_post(unsigned* bar, volatile LAS unsigned* st, int wave) {
    XcdBarrier b; b.bar = bar; b.x = xb_xcc_id(); b.st = st; b.wave = wave;
    if (wave == 0 && lane_opaque() == 0) (void)xb_add(&bar[XB_XCNT(b.x)], 1u);
    return b;
}
__device__ __forceinline__ void xcd_barrier_complete(unsigned* bar, unsigned x, unsigned& nloc, unsigned& nx) {
    const unsigned G = gridDim.x * gridDim.y * gridDim.z;
    unsigned sum, cnt, mine, sp = 0u;
    for (;;) {
        sum = 0u; cnt = 0u; mine = 0u;
#pragma unroll
        for (unsigned j = 0; j < 16; ++j) { const unsigned c = xb_ld(&bar[XB_XCNT(j)]); sum += c; cnt += (c > 0u) ? 1u : 0u; mine = (j == x) ? c : mine; }
        if (sum == G) break;
        __builtin_amdgcn_s_sleep(1);
        if ((++sp & 255u) == 0u) { if (xb_ld(&bar[XB_TMO])) break; if (sp > XB_SPIN_CAP) { atomicAdd(&bar[XB_TMO], 1u); break; } }
    }
    nloc = mine > 0u ? mine : 1u; nx = cnt > 0u ? cnt : 1u;
}
__device__ __forceinline__ void xcd_barrier(const XcdBarrier& b) {
    asm volatile("s_waitcnt vmcnt(0)" ::: "memory");
    __syncthreads();
    if (b.wave == 0 && lane_opaque() == 0) {
        unsigned* bar = b.bar;
        __builtin_amdgcn_s_waitcnt(0);
        unsigned nloc = b.st[0], nx = b.st[1];
        if (nloc == 0u) { xcd_barrier_complete(bar, b.x, nloc, nx); b.st[0] = nloc; b.st[1] = nx; }
        const unsigned old = xb_add(&bar[XB_XSUB(b.x)], 1u);
        const unsigned gen = old / nloc;
        if (old + 1u == (gen + 1u) * nloc) {
            __builtin_amdgcn_fence(__ATOMIC_RELEASE, "agent");
            asm volatile("s_waitcnt vmcnt(0)" ::: "memory");
            const unsigned og = xb_add(&bar[XB_TOP], 1u);
            const unsigned tg = og / nx;
            if (og + 1u == (tg + 1u) * nx) xb_add(&bar[XB_TOPGEN], 1u);
            else XB_SPIN(xb_ld(&bar[XB_TOPGEN]) == tg, bar);
            __builtin_amdgcn_fence(__ATOMIC_ACQUIRE, "agent");
            xb_add(&bar[XB_XGEN(b.x)], 1u);
            asm volatile("s_waitcnt vmcnt(0)" ::: "memory");
        } else {
            XB_SPIN(xb_ld(&bar[XB_XGEN(b.x)]) == gen, bar);
            __builtin_amdgcn_fence(__ATOMIC_ACQUIRE, "agent");
            asm volatile("s_waitcnt vmcnt(0)" ::: "memory");
        }
    }
    __syncthreads();
}

namespace pg8 {
#define PG8_LAS __attribute__((address_space(3)))
typedef unsigned short bf16_t;
typedef short bf16x8 __attribute__((ext_vector_type(8)));
typedef float f32x4 __attribute__((ext_vector_type(4)));
typedef unsigned u32x4 __attribute__((ext_vector_type(4)));
constexpr int BM = 256, BK = 64, HALF = 128, HTB = HALF * BK * 2  , STAGE_BYTES = 8 * HTB, NXCD = 8, WGM = 8;

__host__ __device__ __forceinline__ int lds_byte(int r, int c) { const int st = (r >> 4) * 2 + (c >> 5), rr = r & 15, cc = c & 31, ob = rr * 64 + cc * 2; return st * 1024 + (ob ^ (((ob >> 9) & 1) << 5)); }
__host__ __device__ __forceinline__ void stage_rc(int b, int& R, int& C) { const int st = b / 1024, sb = b % 1024, swz = sb ^ (((sb >> 9) & 1) << 5); R = (st >> 1) * 16 + swz / 64; C = (st & 1) * 32 + (swz % 64) / 2; }
__host__ __device__ __forceinline__ int perm32(int rho) { const int n = rho >> 4, i = rho & 15; return 8 * (i >> 2) + 4 * n + (i & 3); }

struct Unit { int pm, pn; };
struct Gemm { const bf16_t* A; const bf16_t* Bt; int M, N, K; };

struct StaticOrder {
    int nM, nN, nwg, G, c;
    __host__ __device__ void init(int M, int N, int G_, int c_) { nM = M / BM; nN = N / BM; nwg = nM * nN; G = G_; c = c_; }
    __host__ __device__ bool next(int i, Unit& u) const {
        const long L = (long)i * G + c; if (L >= nwg) return false;
        int wgid = (int)L; { const int q = nwg / NXCD, r = nwg % NXCD, xcd = wgid % NXCD, off = wgid / NXCD; wgid = (xcd < r ? xcd * (q + 1) : r * (q + 1) + (xcd - r) * q) + off; }
        const int nig = WGM * nN, gid = wgid / nig, fm = gid * WGM, gsz = (nM - fm) < WGM ? (nM - fm) : WGM;
        u.pm = fm + ((wgid % nig) % gsz); u.pn = (wgid % nig) / gsz; return true;
    }
    __device__ __forceinline__ void a_ready(const Unit&) const {}
    __device__ __forceinline__ void done(const Unit&) const {}
};

__device__ __forceinline__ unsigned cvt_pk_bf16(float lo, float hi) { unsigned r; asm volatile("v_cvt_pk_bf16_f32 %0, %1, %2" : "=v"(r) : "v"(lo), "v"(hi)); return r; }
typedef float f32x2 __attribute__((ext_vector_type(2)));
__device__ __forceinline__ f32x2 gelu_pk(f32x2 v) {
    const f32x2 av = __builtin_elementwise_abs(v), d = av * 0.2316418882f + 1.0f;
    f32x2 t; t.x = __builtin_amdgcn_rcpf(d.x); t.y = __builtin_amdgcn_rcpf(d.y);
    f32x2 q = t * 0.5307027145f + (-0.7265760135f); q = q * t + 0.7107068705f; q = q * t + (-0.142248368f); q = q * t + 0.127414796f; q = q * t;
    const f32x2 s = (v * v) * (-0.72134752044f);
    f32x2 e; e.x = __builtin_amdgcn_exp2f(s.x); e.y = __builtin_amdgcn_exp2f(s.y);
    const f32x2 m = v * (q * e), r = v - m;
    f32x2 o; o.x = v.x < 0.f ? m.x : r.x; o.y = v.y < 0.f ? m.y : r.y; return o;
}

template <int ACT  > struct EpiBf16 {
    static constexpr bool PERM = true, AFTER_DRAIN = false; static_assert(ACT == 0 || ACT == 1, "EpiBf16: ACT is 0 (none) or 1 (gelu_pk)");
    bf16_t* O; int ldc; const float* bias; int split_cols; size_t split_stride; float scale0;
    __device__ __forceinline__ void operator()(const f32x4 (&acc)[2][2][4][2], const Unit& u, int wr, int wc, int fr, int fq) const {
        const int row0 = u.pm * BM + wr * 64 + fr; int colt = u.pn * BM; bf16_t* base = O;
        float sc = 1.f; if (split_cols) { const int t = colt / split_cols; base += (size_t)t * split_stride; colt -= t * split_cols; if (t == 0) sc = scale0; }
        const int col0 = colt + wc * 32 + 8 * fq, bcol0 = u.pn * BM + wc * 32 + 8 * fq;
        f32x4 bv[2][2];
#pragma unroll
        for (int bj = 0; bj < 2; ++bj)
#pragma unroll
            for (int n = 0; n < 2; ++n) bv[bj][n] = bias ? *(const f32x4*)(bias + bcol0 + bj * HALF + 4 * n) : (f32x4){0.f, 0.f, 0.f, 0.f};
#pragma unroll
        for (int ai = 0; ai < 2; ++ai)
#pragma unroll
            for (int m = 0; m < 4; ++m) { bf16_t* rowp = base + (size_t)(row0 + ai * HALF + m * 16) * ldc + col0;
#pragma unroll
                for (int bj = 0; bj < 2; ++bj) { f32x4 v0 = acc[ai][bj][m][0] + bv[bj][0], v1 = acc[ai][bj][m][1] + bv[bj][1];
                    if (ACT == 1) { f32x2 a = gelu_pk((f32x2){v0[0], v0[1]}), b = gelu_pk((f32x2){v0[2], v0[3]}), c = gelu_pk((f32x2){v1[0], v1[1]}), d = gelu_pk((f32x2){v1[2], v1[3]});
                        v0 = (f32x4){a.x, a.y, b.x, b.y}; v1 = (f32x4){c.x, c.y, d.x, d.y}; }
                    v0 = v0 * sc; v1 = v1 * sc; u32x4 w; w.x = cvt_pk_bf16(v0[0], v0[1]); w.y = cvt_pk_bf16(v0[2], v0[3]); w.z = cvt_pk_bf16(v1[0], v1[1]); w.w = cvt_pk_bf16(v1[2], v1[3]);
                    *(u32x4*)(rowp + bj * HALF) = w; } }
    }
};

struct EpiQKV {
    static constexpr bool PERM = true, AFTER_DRAIN = false;
    bf16_t* O; int ldc; size_t split_stride; float scale0; float* ksum;
    __device__ __forceinline__ void operator()(const f32x4 (&acc)[2][2][4][2], const Unit& u, int wr, int wc, int fr, int fq) const {
        const int row0 = u.pm * BM + wr * 64 + fr; const int t = (u.pn * BM) / ldc; const int colt = u.pn * BM - t * ldc; bf16_t* base = O + (size_t)t * split_stride;
        const float sc = t == 0 ? scale0 : 1.f;
        const int col0 = colt + wc * 32 + 8 * fq;
#pragma unroll
        for (int ai = 0; ai < 2; ++ai)
#pragma unroll
            for (int m = 0; m < 4; ++m) { bf16_t* rowp = base + (size_t)(row0 + ai * HALF + m * 16) * ldc + col0;
#pragma unroll
                for (int bj = 0; bj < 2; ++bj) { const f32x4 v0 = acc[ai][bj][m][0] * sc, v1 = acc[ai][bj][m][1] * sc;
                    u32x4 w; w.x = cvt_pk_bf16(v0[0], v0[1]); w.y = cvt_pk_bf16(v0[2], v0[3]); w.z = cvt_pk_bf16(v1[0], v1[1]); w.w = cvt_pk_bf16(v1[2], v1[3]);
                    *(u32x4*)(rowp + bj * HALF) = w; } }
        if (ksum != nullptr && t == 1) {
            const int b = u.pm >> 5, blk = u.pm & 31, lq_ = lane_opaque();
#pragma unroll
            for (int bj = 0; bj < 2; ++bj) { const int h = (colt >> 7) + bj;
                float* dst = ksum + ((size_t)((b * 8 + h) * 32 + blk)) * 128 + wc * 32 + 8 * fq;
#pragma unroll
                for (int n = 0; n < 2; ++n) { f32x4 sacc = (f32x4){0.f, 0.f, 0.f, 0.f};
#pragma unroll
                    for (int ai = 0; ai < 2; ++ai)
#pragma unroll
                        for (int m = 0; m < 4; ++m) sacc += acc[ai][bj][m][n];
#pragma unroll
                    for (int e = 0; e < 4; ++e) { float v = sacc[e];
                        v += bperm_f(lq_ ^ 1, v); v += bperm_f(lq_ ^ 2, v); v += bperm_f(lq_ ^ 4, v); v += bperm_f(lq_ ^ 8, v);
                        if (fr == 0) atomicAdd(dst + 4 * n + e, v); } } }
        }
    }
};

struct EpiSwiglu {
    static constexpr bool PERM = true, AFTER_DRAIN = false;
    bf16_t* O; int ldc; float inv; float oscale;
    __device__ __forceinline__ void operator()(const f32x4 (&acc)[2][2][4][2], const Unit& u, int wr, int wc, int fr, int fq) const {
        const int row0 = u.pm * BM + wr * 64 + fr, col0 = u.pn * HALF + wc * 32 + 8 * fq;
#pragma unroll
        for (int ai = 0; ai < 2; ++ai)
#pragma unroll
            for (int m = 0; m < 4; ++m) { bf16_t* rowp = O + (size_t)(row0 + ai * HALF + m * 16) * ldc + col0;
                float v[8];
#pragma unroll
                for (int n = 0; n < 2; ++n)
#pragma unroll
                    for (int e = 0; e < 4; ++e) { const float g = acc[ai][0][m][n][e] * inv, uu = acc[ai][1][m][n][e] * inv;
                        v[n * 4 + e] = g * __builtin_amdgcn_rcpf(1.0f + __builtin_amdgcn_exp2f(-1.4426950408889634f * g)) * uu; }
                if (oscale > 0.f) { u32x2 w8;
                    { float c0 = fminf(fmaxf(v[0] * oscale, -448.f), 448.f), c1 = fminf(fmaxf(v[1] * oscale, -448.f), 448.f), c2 = fminf(fmaxf(v[2] * oscale, -448.f), 448.f), c3 = fminf(fmaxf(v[3] * oscale, -448.f), 448.f);
                      int t_ = __builtin_amdgcn_cvt_pk_fp8_f32(c0, c1, 0, false); t_ = __builtin_amdgcn_cvt_pk_fp8_f32(c2, c3, t_, true); w8.x = (unsigned)t_; }
                    { float c0 = fminf(fmaxf(v[4] * oscale, -448.f), 448.f), c1 = fminf(fmaxf(v[5] * oscale, -448.f), 448.f), c2 = fminf(fmaxf(v[6] * oscale, -448.f), 448.f), c3 = fminf(fmaxf(v[7] * oscale, -448.f), 448.f);
                      int t_ = __builtin_amdgcn_cvt_pk_fp8_f32(c0, c1, 0, false); t_ = __builtin_amdgcn_cvt_pk_fp8_f32(c2, c3, t_, true); w8.y = (unsigned)t_; }
                    *(u32x2*)((unsigned char*)O + (size_t)(row0 + ai * HALF + m * 16) * ldc + col0) = w8; }
                else { u32x4 w; w.x = cvt_pk_bf16(v[0], v[1]); w.y = cvt_pk_bf16(v[2], v[3]); w.z = cvt_pk_bf16(v[4], v[5]); w.w = cvt_pk_bf16(v[6], v[7]);
                *(u32x4*)rowp = w; } }
    }
};
struct EpiScaled {
    static constexpr bool PERM = true, AFTER_DRAIN = false;
    bf16_t* O; int ldc; float inv;
    __device__ __forceinline__ void operator()(const f32x4 (&acc)[2][2][4][2], const Unit& u, int wr, int wc, int fr, int fq) const {
        const int row0 = u.pm * BM + wr * 64 + fr, col0 = u.pn * BM + wc * 32 + 8 * fq;
#pragma unroll
        for (int ai = 0; ai < 2; ++ai)
#pragma unroll
            for (int m = 0; m < 4; ++m) { bf16_t* rowp = O + (size_t)(row0 + ai * HALF + m * 16) * ldc + col0;
#pragma unroll
                for (int bj = 0; bj < 2; ++bj) { const f32x4 v0 = acc[ai][bj][m][0] * inv, v1 = acc[ai][bj][m][1] * inv;
                    u32x4 w; w.x = cvt_pk_bf16(v0[0], v0[1]); w.y = cvt_pk_bf16(v0[2], v0[3]); w.z = cvt_pk_bf16(v1[0], v1[1]); w.w = cvt_pk_bf16(v1[2], v1[3]);
                    *(u32x4*)(rowp + bj * HALF) = w; } }
    }
};
struct EpiVT8 {
    static constexpr bool PERM = true, AFTER_DRAIN = false;
    unsigned char* O; int ldb; float scale;
    __device__ __forceinline__ void operator()(const f32x4 (&acc)[2][2][4][2], const Unit& u, int wr, int wc, int fr, int fq) const {
        const int row0 = u.pm * BM + wr * 64 + fr;
#pragma unroll
        for (int ai = 0; ai < 2; ++ai)
#pragma unroll
            for (int m = 0; m < 4; ++m) { unsigned char* rowp = O + (size_t)(row0 + ai * HALF + m * 16) * ldb;
#pragma unroll
                for (int bj = 0; bj < 2; ++bj)
#pragma unroll
                    for (int n = 0; n < 2; ++n) { const int col = u.pn * BM + bj * HALF + wc * 32 + 8 * fq + 4 * n, g4 = (col >> 2) & 15;
                        const int pos = (g4 & 1) * 32 + (g4 >> 3) * 16 + ((g4 >> 1) & 3) * 4;
                        const f32x4 v = acc[ai][bj][m][n] * scale;
                        float c0 = fminf(fmaxf(v[0], -448.f), 448.f), c1 = fminf(fmaxf(v[1], -448.f), 448.f), c2 = fminf(fmaxf(v[2], -448.f), 448.f), c3 = fminf(fmaxf(v[3], -448.f), 448.f);
                        int t_ = __builtin_amdgcn_cvt_pk_fp8_f32(c0, c1, 0, false); t_ = __builtin_amdgcn_cvt_pk_fp8_f32(c2, c3, t_, true);
                        *(unsigned*)(rowp + (col & ~63) + pos) = (unsigned)t_; } }
    }
};

template <class Epi, class Sched, bool ALIGN_EPI = false, bool SP2 = false, bool FP8 = false>
__device__ __forceinline__ void gemm_phase(PG8_LAS unsigned char* lds, const Gemm g, const Sched& S, const Epi& E, const int wave0) {
    const int tid_ = wave0 * 64 + lane_opaque();
    const int tid = tid_, wid = __builtin_amdgcn_readfirstlane(tid >> 6), lane = tid & 63, wr = wid >> 2, wc = wid & 3, fr = lane & 15, fq = lane >> 4;
    const int K = g.K, nt = K / BK;
    unsigned voffA[2], voffB[2];
#pragma unroll
    for (int i = 0; i < 2; ++i) { int R, C; stage_rc(tid * 16 + i * 8192, R, C); const int Rb = Epi::PERM ? ((R & ~31) + perm32(R & 31)) : R;
        voffA[i] = (unsigned)(R * K + C) * 2u; voffB[i] = (unsigned)(Rb * K + C) * 2u; }
    const size_t kstep = (size_t)(BK * 2);
    const size_t hstep = (size_t)HALF * K * 2;
    const size_t tstep = 2 * hstep;
    const unsigned ldsw = (unsigned)wid * 1024u;
    const int aoff = lds_byte(wr * 64 + fr, fq * 8), boff = lds_byte(wc * 32 + fr, fq * 8);
#define PG8_SA(b, h) (((b) * 2 + (h)) * HTB)
#define PG8_SB(b, h) ((4 + (b) * 2 + (h)) * HTB)
#define PG8_STAGE(bufoff, gbase, voff) do { _Pragma("unroll") for (int _i = 0; _i < 2; ++_i) \
        __builtin_amdgcn_global_load_lds((const unsigned*)((const char*)(gbase) + (voff)[_i]), (PG8_LAS unsigned*)(lds + (bufoff) + ldsw + _i * 8192), 16, 0, 0); } while (0)
#define PG8_LDA(dst, b, h) do { _Pragma("unroll") for (int m = 0; m < 4; ++m) _Pragma("unroll") for (int k = 0; k < 2; ++k) dst[m][k] = *(const PG8_LAS bf16x8*)(lds + PG8_SA(b, h) + aoff + m * 2048 + k * 1024); } while (0)
#define PG8_LDB(dst, b, h) do { _Pragma("unroll") for (int n = 0; n < 2; ++n) _Pragma("unroll") for (int k = 0; k < 2; ++k) dst[n][k] = *(const PG8_LAS bf16x8*)(lds + PG8_SB(b, h) + boff + n * 2048 + k * 1024); } while (0)
#define PG8_MMA(ai, bj, At, Bt) do { __builtin_amdgcn_s_setprio(1); \
        if constexpr (FP8) { typedef int i32x8_t __attribute__((ext_vector_type(8))); typedef int i32x4_t __attribute__((ext_vector_type(4))); \
            _Pragma("unroll") for (int m = 0; m < 4; ++m) _Pragma("unroll") for (int n = 0; n < 2; ++n) { \
                const i32x4_t b0_ = __builtin_bit_cast(i32x4_t, Bt[n][0]), b1_ = __builtin_bit_cast(i32x4_t, Bt[n][1]), a0_ = __builtin_bit_cast(i32x4_t, At[m][0]), a1_ = __builtin_bit_cast(i32x4_t, At[m][1]); \
                const i32x8_t bb_ = {b0_[0], b0_[1], b0_[2], b0_[3], b1_[0], b1_[1], b1_[2], b1_[3]}, aa_ = {a0_[0], a0_[1], a0_[2], a0_[3], a1_[0], a1_[1], a1_[2], a1_[3]}; \
                asm volatile("v_mfma_f32_16x16x128_f8f6f4 %0, %1, %2, %0" : "+v"(acc[ai][bj][m][n]) : "v"(bb_), "v"(aa_)); } } \
        else { _Pragma("unroll") for (int m = 0; m < 4; ++m) _Pragma("unroll") for (int n = 0; n < 2; ++n) _Pragma("unroll") for (int k = 0; k < 2; ++k) \
        acc[ai][bj][m][n] = __builtin_amdgcn_mfma_f32_16x16x32_bf16(Bt[n][k], At[m][k], acc[ai][bj][m][n], 0, 0, 0); } __builtin_amdgcn_s_setprio(0); } while (0)
#define PG8_WAIT_V(n) asm volatile("s_waitcnt vmcnt(" #n ")" ::: "memory")
#define PG8_WAIT_L(n) asm volatile("s_waitcnt lgkmcnt(" #n ")" ::: "memory")
#define PG8_BAR __builtin_amdgcn_s_barrier()
#define PG8_SCHED __builtin_amdgcn_sched_barrier(0)
    Unit cur, nxt; int ui = 0;
    if (!S.next(0, cur)) return;
    f32x4 acc[2][2][4][2];
#pragma unroll
    for (int a = 0; a < 2; ++a)
#pragma unroll
        for (int b = 0; b < 2; ++b)
#pragma unroll
            for (int m = 0; m < 4; ++m)
#pragma unroll
                for (int n = 0; n < 2; ++n) acc[a][b][m][n] = (f32x4){0.f, 0.f, 0.f, 0.f};
    bf16x8 At[4][2], B0[2][2], B1[2][2];
    const char* cA = (const char*)g.A + (size_t)cur.pm * tstep; const char* cB = (const char*)g.Bt + (size_t)cur.pn * tstep;
    S.a_ready(cur);
    if constexpr (SP2) {
        PG8_STAGE(PG8_SB(0, 0), cB, voffB); PG8_STAGE(PG8_SB(0, 1), cB + hstep, voffB); PG8_STAGE(PG8_SA(0, 0), cA, voffA); PG8_STAGE(PG8_SA(0, 1), cA + hstep, voffA);
        if (wr == 1) PG8_BAR;
        PG8_WAIT_V(2); PG8_BAR;
        PG8_STAGE(PG8_SB(1, 0), cB + kstep, voffB); PG8_STAGE(PG8_SA(1, 0), cA + kstep, voffA); PG8_STAGE(PG8_SB(1, 1), cB + hstep + kstep, voffB);
        PG8_WAIT_V(6); PG8_BAR;
    } else {
        PG8_STAGE(PG8_SB(0, 0), cB, voffB); PG8_STAGE(PG8_SA(0, 0), cA, voffA); PG8_STAGE(PG8_SB(0, 1), cB + hstep, voffB); PG8_STAGE(PG8_SA(0, 1), cA + hstep, voffA);
        if (wr == 1) PG8_BAR;
        PG8_WAIT_V(4); PG8_BAR;
        PG8_STAGE(PG8_SB(1, 0), cB + kstep, voffB); PG8_STAGE(PG8_SA(1, 0), cA + kstep, voffA); PG8_STAGE(PG8_SB(1, 1), cB + hstep + kstep, voffB);
        PG8_WAIT_V(6); PG8_BAR;
    }
    for (;;) {
        const bool has_next = S.next(ui + 1, nxt);
        const char* nA = has_next ? (const char*)g.A + (size_t)nxt.pm * tstep : cA; const char* nB = has_next ? (const char*)g.Bt + (size_t)nxt.pn * tstep : cB;
#pragma unroll 1
        for (int t = 0; t < nt; t += 2) {
            if constexpr (FP8) asm volatile("" : "+v"(voffA[0]), "+v"(voffA[1]), "+v"(voffB[0]), "+v"(voffB[1]));
            const bool last = (t == nt - 2);
            const char* a1 = cA + (size_t)(t + 1) * kstep;
            const char* a2 = last ? nA : cA + (size_t)(t + 2) * kstep; const char* b2 = last ? nB : cB + (size_t)(t + 2) * kstep;
            const char* a3 = a2 + kstep; const char* b3 = b2 + kstep;
            if (last && has_next) S.a_ready(nxt);
            if constexpr (SP2) {
            PG8_LDB(B0, 0, 0); PG8_LDB(B1, 0, 1); PG8_SCHED; PG8_LDA(At, 0, 0); PG8_STAGE(PG8_SA(1, 1), a1 + hstep, voffA);
            PG8_WAIT_V(8); PG8_WAIT_L(0); PG8_BAR; PG8_MMA(0, 0, At, B0); PG8_MMA(0, 1, At, B1); PG8_BAR; PG8_SCHED;
            PG8_LDA(At, 0, 1); PG8_STAGE(PG8_SB(0, 0), b2, voffB); PG8_STAGE(PG8_SB(0, 1), b2 + hstep, voffB); PG8_STAGE(PG8_SA(0, 0), a2, voffA);
            PG8_WAIT_V(8); PG8_WAIT_L(0); PG8_BAR; PG8_MMA(1, 0, At, B0); PG8_MMA(1, 1, At, B1); PG8_BAR; PG8_SCHED;
            PG8_LDB(B0, 1, 0); PG8_LDB(B1, 1, 1); PG8_SCHED; PG8_LDA(At, 1, 0); PG8_STAGE(PG8_SA(0, 1), a2 + hstep, voffA);
            PG8_WAIT_V(8); PG8_WAIT_L(0); PG8_BAR; PG8_MMA(0, 0, At, B0); PG8_MMA(0, 1, At, B1); PG8_BAR; PG8_SCHED;
            PG8_LDA(At, 1, 1); PG8_STAGE(PG8_SB(1, 0), b3, voffB); PG8_STAGE(PG8_SB(1, 1), b3 + hstep, voffB); PG8_STAGE(PG8_SA(1, 0), a3, voffA);
            PG8_WAIT_V(8); PG8_WAIT_L(0); PG8_BAR; PG8_MMA(1, 0, At, B0); PG8_MMA(1, 1, At, B1); PG8_BAR; PG8_SCHED;
            } else {
            PG8_LDB(B0, 0, 0); PG8_SCHED; PG8_LDA(At, 0, 0); PG8_STAGE(PG8_SA(1, 1), a1 + hstep, voffA);
            PG8_WAIT_L(8); PG8_BAR; PG8_WAIT_L(0); PG8_MMA(0, 0, At, B0); PG8_BAR; PG8_SCHED;
            PG8_LDB(B1, 0, 1); PG8_STAGE(PG8_SB(0, 0), b2, voffB);
            PG8_BAR; PG8_WAIT_L(0); PG8_MMA(0, 1, At, B1); PG8_BAR;
            PG8_LDA(At, 0, 1); PG8_STAGE(PG8_SA(0, 0), a2, voffA);
            PG8_BAR; PG8_WAIT_L(0); PG8_MMA(1, 0, At, B0); PG8_BAR; PG8_SCHED;
            PG8_STAGE(PG8_SB(0, 1), b2 + hstep, voffB);
            PG8_WAIT_V(6); PG8_BAR; PG8_MMA(1, 1, At, B1); PG8_BAR;
            PG8_LDB(B0, 1, 0); PG8_SCHED; PG8_LDA(At, 1, 0); PG8_STAGE(PG8_SA(0, 1), a2 + hstep, voffA);
            PG8_WAIT_L(8); PG8_BAR; PG8_WAIT_L(0); PG8_MMA(0, 0, At, B0); PG8_BAR; PG8_SCHED;
            PG8_LDB(B1, 1, 1); PG8_STAGE(PG8_SB(1, 0), b3, voffB);
            PG8_BAR; PG8_WAIT_L(0); PG8_MMA(0, 1, At, B1); PG8_BAR;
            PG8_LDA(At, 1, 1); PG8_STAGE(PG8_SA(1, 0), a3, voffA);
            PG8_BAR; PG8_WAIT_L(0); PG8_MMA(1, 0, At, B0); PG8_BAR; PG8_SCHED;
            PG8_STAGE(PG8_SB(1, 1), b3 + hstep, voffB);
            PG8_WAIT_V(6); PG8_BAR; PG8_MMA(1, 1, At, B1); PG8_BAR;
            }
        }
        if constexpr (ALIGN_EPI) { if (wr == 0) PG8_BAR; }
        if constexpr (FP8) asm volatile("s_nop 15\n\ts_nop 15" ::: "memory");
        if constexpr (!Epi::AFTER_DRAIN) { const int l2_ = lane_opaque(); E(acc, cur, wr, wc, l2_ & 15, l2_ >> 4); S.done(cur); }
        if (!has_next) break;
#pragma unroll
        for (int a = 0; a < 2; ++a)
#pragma unroll
            for (int b = 0; b < 2; ++b)
#pragma unroll
                for (int m = 0; m < 4; ++m)
#pragma unroll
                    for (int n = 0; n < 2; ++n) acc[a][b][m][n] = (f32x4){0.f, 0.f, 0.f, 0.f};
        cur = nxt; cA = nA; cB = nB; ++ui;
        if constexpr (ALIGN_EPI) { if (wr == 1) PG8_BAR; }
    }
    PG8_WAIT_V(0);
    if constexpr (!ALIGN_EPI) { if (wr == 0) PG8_BAR; }
    PG8_BAR;
    if constexpr (Epi::AFTER_DRAIN) { E.fused(acc, cur, wr, wc, fr, fq, lds, wid, lane); S.done(cur); }
#undef PG8_SA
#undef PG8_SB
#undef PG8_STAGE
#undef PG8_LDA
#undef PG8_LDB
#undef PG8_MMA
#undef PG8_WAIT_V
#undef PG8_WAIT_L
#undef PG8_BAR
#undef PG8_SCHED
}
}

__device__ __forceinline__ float wave_sum(float v) {
    const int l = lane_opaque();
#pragma unroll
    for (int o = 1; o < 64; o <<= 1) v += __builtin_bit_cast(float, __builtin_amdgcn_ds_bpermute((l ^ o) << 2, __builtin_bit_cast(int, v)));
    return v;
}
__device__ __forceinline__ float wave_max(float v) {
    const int l = lane_opaque();
#pragma unroll
    for (int o = 1; o < 64; o <<= 1) v = fmaxf(v, __builtin_bit_cast(float, __builtin_amdgcn_ds_bpermute((l ^ o) << 2, __builtin_bit_cast(int, v))));
    return v;
}
__device__ __forceinline__ float silu_f(float v) { return v / (1.f + __expf(-v)); }

struct Args {
    const float* x; const float* c; const float* rel_bias; const float* ada_w; const float* ada_b; const float* norm_g;
    const float* moba_w_qkv; const float* moba_w_o; const float* diff_w_qkv; const float* diff_w_o;
    const float* diff_lambda; const float* diff_subln_g; const float* ffn_w_in; const float* ffn_w_out;
    float* out; unsigned char* ws;
};

__device__ __forceinline__ int t5_bucket(int rel) {
    const int n = rel < 0 ? 0 : rel;
    const float nf = (float)(n < 1 ? 1 : n);
    int large = 16 + (int)(logf(nf / 16.0f) / 4.852030263919617f * 16.0f);
    large = large < 31 ? large : 31;
    return n < 16 ? n : large;
}

__device__ __forceinline__ void p_mod(const Args& a, LAS unsigned char* lds, int blk, int G, int tid, int wave, int lane) {
    LAS float* sc = (LAS float*)lds;
    LAS float* red = sc + 2048;
    for (int i = tid; i < 2048; i += NTHR) sc[i] = silu_f(a.c[i]);
    __syncthreads();
    float* mod = (float*)(a.ws + WS_MOD);
    for (int it = blk; it < 192; it += G) {
        const int l = it / 96, j0 = (it % 96) * 64;
        const float* w = a.ada_w + (size_t)l * D * 6144 + j0 + lane;
        float s0 = 0.f, s1 = 0.f;
#pragma unroll 1
        for (int kb = wave * 128; kb < wave * 128 + 128; kb += 32) { float wv[32];
#pragma unroll
            for (int k = 0; k < 32; ++k) wv[k] = w[(size_t)(kb + k) * 6144];
#pragma unroll
            for (int k = 0; k < 32; ++k) { s0 += sc[kb + k] * wv[k]; s1 += sc[1024 + kb + k] * wv[k]; } }
        red[(wave * 2 + 0) * 64 + lane] = s0; red[(wave * 2 + 1) * 64 + lane] = s1;
        __syncthreads();
        if (tid < 128) { const int bb = tid >> 6, cl = tid & 63; float sum = 0.f;
#pragma unroll
            for (int w8 = 0; w8 < 8; ++w8) sum += red[(w8 * 2 + bb) * 64 + cl];
            mod[(l * 2 + bb) * 6144 + j0 + cl] = sum + a.ada_b[l * 6144 + j0 + cl]; }
        __syncthreads();
    }
    float* bt = (float*)(a.ws + WS_BIAST);
    for (int i = blk * NTHR + tid; i < 8 * 2304; i += G * NTHR) { const int h = i / 2304, rel = 2047 - (i % 2304); bt[i] = rel >= 0 ? a.rel_bias[t5_bucket(rel) * NH + h] * LOG2E : 0.f; }
}

__device__ __forceinline__ void transpose_item(const float* W, int K, int N, int k0, int n0, bf16* WT, int dst_row0, LAS float* scr, int lane) {
    float tv[32];
#pragma unroll
    for (int i = 0; i < 32; ++i) tv[i] = W[(size_t)(k0 + 2 * i + (lane >> 5)) * N + n0 + (lane & 31)];
#pragma unroll
    for (int i = 0; i < 32; ++i) scr[(2 * i + (lane >> 5)) * 33 + (lane & 31)] = tv[i];
    asm volatile("s_waitcnt lgkmcnt(0)" ::: "memory");
    const int c = lane & 7;
#pragma unroll
    for (int j = 0; j < 4; ++j) { const int n = (lane >> 3) + 8 * j; const LAS float* sp = scr + (8 * c) * 33 + n;
        u32x4 o; o.x = pk2(sp[0 * 33], sp[1 * 33]); o.y = pk2(sp[2 * 33], sp[3 * 33]); o.z = pk2(sp[4 * 33], sp[5 * 33]); o.w = pk2(sp[6 * 33], sp[7 * 33]);
        *(u32x4*)(WT + (size_t)(dst_row0 + n) * K + k0 + 8 * c) = o; }
    asm volatile("s_waitcnt lgkmcnt(0)" ::: "memory");
}
constexpr float F8_SH = 8.0f;
constexpr float F8_SA = 4.0f, F8_SB = 256.0f;
__device__ __forceinline__ unsigned pk4_fp8(float a, float b, float c, float d) {
    a = fminf(fmaxf(a, -448.f), 448.f); b = fminf(fmaxf(b, -448.f), 448.f); c = fminf(fmaxf(c, -448.f), 448.f); d = fminf(fmaxf(d, -448.f), 448.f);
    int w = __builtin_amdgcn_cvt_pk_fp8_f32(a, b, 0, false); w = __builtin_amdgcn_cvt_pk_fp8_f32(c, d, w, true); return (unsigned)w;
}
__device__ __forceinline__ void transpose_item_fp8(const float* W, int K, int N, int k0, int n0, unsigned char* WT, int dst_row0, LAS float* scr, int lane) {
    float tv[32];
#pragma unroll
    for (int i = 0; i < 32; ++i) tv[i] = W[(size_t)(k0 + 2 * i + (lane >> 5)) * N + n0 + (lane & 31)];
#pragma unroll
    for (int i = 0; i < 32; ++i) scr[(2 * i + (lane >> 5)) * 33 + (lane & 31)] = tv[i];
    asm volatile("s_waitcnt lgkmcnt(0)" ::: "memory");
#pragma unroll
    for (int j = 0; j < 2; ++j) { const int ch = lane + 64 * j, n = ch >> 2, c = ch & 3; const LAS float* sp = scr + (16 * c) * 33 + n;
        u32x4 o;
        o.x = pk4_fp8(sp[0 * 33] * F8_SB, sp[1 * 33] * F8_SB, sp[2 * 33] * F8_SB, sp[3 * 33] * F8_SB);
        o.y = pk4_fp8(sp[4 * 33] * F8_SB, sp[5 * 33] * F8_SB, sp[6 * 33] * F8_SB, sp[7 * 33] * F8_SB);
        o.z = pk4_fp8(sp[8 * 33] * F8_SB, sp[9 * 33] * F8_SB, sp[10 * 33] * F8_SB, sp[11 * 33] * F8_SB);
        o.w = pk4_fp8(sp[12 * 33] * F8_SB, sp[13 * 33] * F8_SB, sp[14 * 33] * F8_SB, sp[15 * 33] * F8_SB);
        *(u32x4*)(WT + (size_t)(dst_row0 + n) * K + k0 + 16 * c) = o; }
    asm volatile("s_waitcnt lgkmcnt(0)" ::: "memory");
}
__device__ __forceinline__ void p_weights(const Args& a, LAS unsigned char* lds, int gw, int ngw, int wave, int lane) {
    LAS float* scr = (LAS float*)(lds + wave * 16384);
    constexpr int I_QKV = (D / 64) * (3 * D / 32), I_O = (D / 64) * (D / 32), I_IN = (D / 64) * (2 * DFF / 32), I_OUT = (DFF / 64) * (D / 32);
    constexpr int PER_L = I_QKV + I_O + I_IN + I_OUT;
    for (int it = gw; it < 2 * PER_L; it += ngw) {
        const int l = it / PER_L; int r = it % PER_L;
        unsigned char* wl = a.ws + WS_W + (size_t)l * WL_STRIDE;
        if (r < I_QKV) { const int nb = 3 * D / 32, kb = r / nb, n0 = (r % nb) * 32; transpose_item(l == 0 ? a.moba_w_qkv : a.diff_w_qkv, D, 3 * D, kb * 64, n0, (bf16*)(wl + WO_QKV), n0, scr, lane); continue; } r -= I_QKV;
        if (r < I_O) continue; r -= I_O;
        if (r < I_IN) { const int nb = 2 * DFF / 32, kb = r / nb, n0 = (r % nb) * 32;
            const int isu = n0 >= DFF ? 1 : 0, nn = n0 - isu * DFF, dst = 256 * (nn / 128) + 128 * isu + (nn % 128);
            transpose_item_fp8(a.ffn_w_in + (size_t)l * D * 2 * DFF, D, 2 * DFF, kb * 64, n0, wl + WO_IN, dst, scr, lane); continue; } r -= I_IN;
        { const int nb = D / 32, kb = r / nb, n0 = (r % nb) * 32; transpose_item_fp8(a.ffn_w_out + (size_t)l * DFF * D, DFF, D, kb * 64, n0, wl + WO_OUT, n0, scr, lane); }
    }
}

__device__ __forceinline__ void p_wo_perm(const Args& a, int gtid, int gthreads) {
    for (int idx = gtid; idx < 2 * 128 * D; idx += gthreads) {
        const int l = idx / (128 * D), rem = idx % (128 * D), c = rem / D, n = rem % D;
        const float* W = l == 0 ? a.moba_w_o : a.diff_w_o;
        float v[8];
#pragma unroll
        for (int e = 0; e < 8; ++e) { const int kp = 8 * c + e, hh = kp >> 7, wi = kp & 127, k = hh * 128 + (wi & 3) * 32 + (wi >> 2); v[e] = W[(size_t)k * D + n]; }
        u32x4 o; o.x = pk2(v[0], v[1]); o.y = pk2(v[2], v[3]); o.z = pk2(v[4], v[5]); o.w = pk2(v[6], v[7]);
        *(u32x4*)((bf16*)(a.ws + WS_W + (size_t)l * WL_STRIDE + WO_O) + (size_t)n * D + 8 * c) = o;
    }
}

__device__ __forceinline__ void p_norm_in(const float* X, const float* g, const float* sh, const float* sc, bf16* H, int gw, int ngw, int lane) {
    for (int m = gw; m < M; m += ngw) {
        const int b = m / SEQ;
        const f32x4* xr = (const f32x4*)(X + (size_t)m * D) + lane;
        f32x4 v[4]; float s = 0.f;
#pragma unroll
        for (int j = 0; j < 4; ++j) { v[j] = xr[64 * j]; s += (v[j].x * v[j].x + v[j].y * v[j].y) + (v[j].z * v[j].z + v[j].w * v[j].w); }
        const float r = 1.0f / sqrtf(wave_sum(s) * (1.f / D) + RMS_EPS);
        u32x2* o = (u32x2*)(H + (size_t)m * D) + lane;
#pragma unroll
        for (int j = 0; j < 4; ++j) {
            const f32x4 gg = ((const f32x4*)g)[lane + 64 * j], s1 = ((const f32x4*)(sc + b * 6144))[lane + 64 * j], s0 = ((const f32x4*)(sh + b * 6144))[lane + 64 * j];
            const f32x4 h = v[j] * r * gg * (1.0f + s1) + s0;
            u32x2 w; w.x = pk2(h.x, h.y); w.y = pk2(h.z, h.w); o[64 * j] = w;
        }
    }
}
template <bool XIN_BF, bool XOUT_BF, bool H_FP8>
__device__ __forceinline__ void p_post(const void* Xin, const bf16* Y, const float* g1, const float* gate, void* Xout,
                                       const float* g2, const float* sh, const float* sc, bf16* H, int gw, int ngw, int lane) {
    for (int m = gw; m < M; m += ngw) {
        const int b = m / SEQ;
        const u32x2* yr = (const u32x2*)(Y + (size_t)m * D) + lane;
        f32x4 y[4], xv[4]; float s = 0.f;
#pragma unroll
        for (int j = 0; j < 4; ++j) { const u32x2 w = yr[64 * j]; y[j] = (f32x4){bflo(w.x), bfhi(w.x), bflo(w.y), bfhi(w.y)};
            if (XIN_BF) { const u32x2 xw = ((const u32x2*)((const bf16*)Xin + (size_t)m * D))[lane + 64 * j]; xv[j] = (f32x4){bflo(xw.x), bfhi(xw.x), bflo(xw.y), bfhi(xw.y)}; }
            else xv[j] = ((const f32x4*)((const float*)Xin + (size_t)m * D))[lane + 64 * j];
            s += (y[j].x * y[j].x + y[j].y * y[j].y) + (y[j].z * y[j].z + y[j].w * y[j].w); }
        const float r = 1.0f / sqrtf(wave_sum(s) * (1.f / D) + RMS_EPS);
        float s2 = 0.f;
#pragma unroll
        for (int j = 0; j < 4; ++j) {
            const f32x4 gg = ((const f32x4*)g1)[lane + 64 * j], gt = ((const f32x4*)(gate + b * 6144))[lane + 64 * j];
            xv[j] = xv[j] + gt * (y[j] * r * gg);
            s2 += (xv[j].x * xv[j].x + xv[j].y * xv[j].y) + (xv[j].z * xv[j].z + xv[j].w * xv[j].w);
            if (XOUT_BF) { u32x2 w; w.x = pk2(xv[j].x, xv[j].y); w.y = pk2(xv[j].z, xv[j].w); ((u32x2*)((bf16*)Xout + (size_t)m * D))[lane + 64 * j] = w; }
            else ((f32x4*)((float*)Xout + (size_t)m * D))[lane + 64 * j] = xv[j];
        }
        if (H) {
            const float r2 = 1.0f / sqrtf(wave_sum(s2) * (1.f / D) + RMS_EPS);
            u32x2* o = (u32x2*)(H + (size_t)m * D) + lane;
#pragma unroll
            for (int j = 0; j < 4; ++j) {
                const f32x4 gg = ((const f32x4*)g2)[lane + 64 * j], s1 = ((const f32x4*)(sc + b * 6144))[lane + 64 * j], s0 = ((const f32x4*)(sh + b * 6144))[lane + 64 * j];
                const f32x4 h = xv[j] * r2 * gg * (1.0f + s1) + s0;
                if (H_FP8) ((unsigned*)((unsigned char*)H + (size_t)m * D))[lane + 64 * j] = pk4_fp8(h.x * F8_SA, h.y * F8_SA, h.z * F8_SA, h.w * F8_SA);
                else { u32x2 w; w.x = pk2(h.x, h.y); w.y = pk2(h.z, h.w); o[64 * j] = w; }
            }
        }
    }
}

__device__ __forceinline__ void p_kmean(const bf16* Kb, float* kmean, LAS unsigned char* lds, int blk, int G, int tid, int wave, int lane) {
    LAS float* red = (LAS float*)lds;
    for (int it = blk; it < BATCH * NH * 32; it += G) {
        const int b = it >> 8, h = (it >> 5) & 7, kb = it & 31;
        const bf16* p = Kb + ((size_t)b * SEQ + kb * 256 + wave * 32) * D + h * HD + 2 * lane;
        float s0 = 0.f, s1 = 0.f;
#pragma unroll 8
        for (int r = 0; r < 32; ++r) { const unsigned w = *(const unsigned*)(p + (size_t)r * D); s0 += bflo(w); s1 += bfhi(w); }
        red[wave * 128 + 2 * lane] = s0; red[wave * 128 + 2 * lane + 1] = s1;
        __syncthreads();
        if (tid < 128) { float sum = 0.f;
#pragma unroll
            for (int w8 = 0; w8 < 8; ++w8) sum += red[w8 * 128 + tid];
            kmean[(size_t)it * 128 + tid] = sum * (1.0f / 256.0f); }
        __syncthreads();
    }
}
__device__ __forceinline__ void p_gate(const bf16* Qb, const float* kmean, unsigned* sel, unsigned* cnt, unsigned short* lists, LAS unsigned char* lds, int blk, int G, int tid, int wave, int lane) {
    LAS float* km = (LAS float*)lds;
    for (int it = blk; it < 256; it += G) {
        const int bh = it >> 4, span = it & 15, b = bh >> 3, h = bh & 7;
        __syncthreads();
        for (int i = tid; i < 1024; i += NTHR) ((LAS f32x4*)km)[i] = ((const f32x4*)(kmean + (size_t)bh * 4096))[i];
        __syncthreads();
        const int q = span * 512 + wave * 64 + lane, own = (span * 512 + wave * 64) >> 8;
        unsigned mask;
        if (own <= 3) mask = (1u << own) - 1u;
        else {
            float qf[128];
            const u32x4* qp = (const u32x4*)(Qb + ((size_t)b * SEQ + q) * D + h * HD);
#pragma unroll
            for (int c = 0; c < 16; ++c) { const u32x4 w = qp[c]; qf[c * 8 + 0] = bflo(w.x); qf[c * 8 + 1] = bfhi(w.x); qf[c * 8 + 2] = bflo(w.y); qf[c * 8 + 3] = bfhi(w.y);
                qf[c * 8 + 4] = bflo(w.z); qf[c * 8 + 5] = bfhi(w.z); qf[c * 8 + 6] = bflo(w.w); qf[c * 8 + 7] = bfhi(w.w); }
            float b0 = -3e38f, b1 = -3e38f, b2 = -3e38f; int i0 = 0, i1 = 0, i2 = 0;
#pragma unroll 1
            for (int n = 0; n < own; ++n) {
                float g0 = 0.f, g1 = 0.f, g2 = 0.f, g3 = 0.f;
#pragma unroll
                for (int d = 0; d < 128; d += 4) { const f32x4 kv = *(LAS f32x4*)(km + n * 128 + d); g0 += qf[d] * kv.x; g1 += qf[d + 1] * kv.y; g2 += qf[d + 2] * kv.z; g3 += qf[d + 3] * kv.w; }
                const float g = (g0 + g1) + (g2 + g3);
                if (g > b0) { b2 = b1; i2 = i1; b1 = b0; i1 = i0; b0 = g; i0 = n; }
                else if (g > b1) { b2 = b1; i2 = i1; b1 = g; i1 = n; }
                else if (g > b2) { b2 = g; i2 = n; }
            }
            mask = (1u << i0) | (1u << i1) | (1u << i2);
        }
        sel[(size_t)bh * SEQ + q] = mask;
        unsigned mycnt = 0u;
        for (int j = 0; j < own; ++j) { const unsigned long long bl = __ballot((mask >> j) & 1u); if (lane == j) mycnt = (unsigned)__popcll(bl); }
        unsigned base = 0u;
        if (lane < own && mycnt) base = __hip_atomic_fetch_add(cnt + bh * 32 + lane, mycnt, __ATOMIC_RELAXED, __HIP_MEMORY_SCOPE_AGENT);
        for (int j = 0; j < own; ++j) { const unsigned long long bl = __ballot((mask >> j) & 1u); const unsigned bj = (unsigned)__builtin_amdgcn_readlane((int)base, j);
            if ((mask >> j) & 1u) lists[((size_t)bh * 32 + j) * 8192 + bj + (unsigned)__popcll(bl & ((1ull << lane) - 1ull))] = (unsigned short)q; }
    }
}

namespace att {
typedef short bf16x8 __attribute__((ext_vector_type(8)));
typedef short s16x4 __attribute__((ext_vector_type(4)));
typedef float f32x16 __attribute__((ext_vector_type(16)));
typedef LAS const char* lcp;
constexpr int PITCH = 1024;
constexpr int SHM_V = 16384, SHM_K = 16384;
constexpr int L_K = 0, L_V = 65536, L_WS = 131072, L_LUT = 133120;
constexpr int LUTN = 2304, RMAXL = 2047, RFAR = 1536;
#define KSWZ(row, colB) ((row) * 256 + ((colB) ^ (((row) & 7) << 4)))
#define SBAR() __builtin_amdgcn_sched_barrier(0)
#define WG_BAR() do { asm volatile("s_waitcnt lgkmcnt(0)" ::: "memory"); __builtin_amdgcn_s_barrier(); asm volatile("" ::: "memory"); } while (0)
__device__ __forceinline__ int v_st(int k, int c) { const int kk = (k & ~0xC) | ((k & 4) << 1) | ((k & 8) >> 1); return ((kk >> 3) * 4 + (c >> 5)) * 512 + ((kk & 7) * 32 + (c & 31)) * 2; }
__device__ __forceinline__ int v_rd_base(int lane) { return ((lane & 3) << 3) | (((lane >> 2) & 3) << 6) | (((lane >> 4) & 1) << 5) | (((lane >> 5) & 1) << 8); }
constexpr int v_rd_off(int d0, int ks, int half) { return d0 * 512 + ks * 4096 + half * 2048; }
__device__ __forceinline__ int crow(int r, int hi) { return (r & 3) + 8 * (r >> 2) + 4 * hi; }
__device__ __forceinline__ unsigned cvtpk(float lo, float hi) { unsigned r; asm volatile("v_cvt_pk_bf16_f32 %0, %1, %2" : "=v"(r) : "v"(lo), "v"(hi)); return r; }

template <int KB, int NDS>
__device__ __forceinline__ void qkt(f32x16& p0, f32x16& p1, lcp K_lds, int r32, int hi, int coff, const bf16x8* qr) {
    lcp kb[4];
#pragma unroll
    for (int dd = 0; dd < 4; ++dd) kb[dd] = K_lds + KB * SHM_K + KSWZ(r32, (dd * 16 + hi * 8) * 2) + coff;
#pragma unroll
    for (int d0 = 0; d0 < NDS; ++d0) { lcp a = kb[d0 & 3] + (d0 >> 2) * 128;
        const bf16x8 b0 = *(LAS const bf16x8*)a;
        const bf16x8 b1 = *(LAS const bf16x8*)(a + 32 * 256);
        p0 = __builtin_amdgcn_mfma_f32_32x32x16_bf16(b0, qr[d0], p0, 0, 0, 0);
        p1 = __builtin_amdgcn_mfma_f32_32x32x16_bf16(b1, qr[d0], p1, 0, 0, 0);
        if (NDS == 8 && (d0 & 1) == 1) SBAR(); }
}
template <int VB>
__device__ __forceinline__ void pv_tile(f32x16* o, int vb0, bf16x8 pa0, bf16x8 pa1, bf16x8 pa2, bf16x8 pa3) {
#define TRRD(dst, off) asm volatile("ds_read_b64_tr_b16 %0, %1 offset:%2" : "=&v"(dst) : "v"(vb0), "i"(off) : "memory")
#define PV_D0(d0) do { s16x4 l0, l1, l2, l3, h0, h1, h2, h3; constexpr int b_ = VB * SHM_V + v_rd_off(d0, 0, 0); \
        TRRD(l0, b_); TRRD(h0, b_ + 2048); TRRD(l1, b_ + 4096); TRRD(h1, b_ + 6144); TRRD(l2, b_ + 8192); TRRD(h2, b_ + 10240); TRRD(l3, b_ + 12288); TRRD(h3, b_ + 14336); \
        asm volatile("s_waitcnt lgkmcnt(0)" ::: "memory"); SBAR(); \
        o[d0] = __builtin_amdgcn_mfma_f32_32x32x16_bf16(pa0, (bf16x8){l0[0], l0[1], l0[2], l0[3], h0[0], h0[1], h0[2], h0[3]}, o[d0], 0, 0, 0); \
        o[d0] = __builtin_amdgcn_mfma_f32_32x32x16_bf16(pa1, (bf16x8){l1[0], l1[1], l1[2], l1[3], h1[0], h1[1], h1[2], h1[3]}, o[d0], 0, 0, 0); \
        o[d0] = __builtin_amdgcn_mfma_f32_32x32x16_bf16(pa2, (bf16x8){l2[0], l2[1], l2[2], l2[3], h2[0], h2[1], h2[2], h2[3]}, o[d0], 0, 0, 0); \
        o[d0] = __builtin_amdgcn_mfma_f32_32x32x16_bf16(pa3, (bf16x8){l3[0], l3[1], l3[2], l3[3], h3[0], h3[1], h3[2], h3[3]}, o[d0], 0, 0, 0); } while (0)
    PV_D0(0); PV_D0(1); PV_D0(2); PV_D0(3);
#undef PV_D0
#undef TRRD
}

template <int NDS>
__device__ __forceinline__ void kread(bf16x8* kf, int kaddr_base, int r32, int hi, int coff) {
#pragma unroll
    for (int d0 = 0; d0 < NDS; ++d0) { const int a = kaddr_base + KSWZ(r32, ((d0 & 3) * 16 + hi * 8) * 2) + coff + (d0 >> 2) * 128;
        asm volatile("ds_read_b128 %0, %1" : "=&v"(kf[2 * d0]) : "v"(a) : "memory");
        asm volatile("ds_read_b128 %0, %1 offset:8192" : "=&v"(kf[2 * d0 + 1]) : "v"(a) : "memory"); }
}
template <int NDS>
__device__ __forceinline__ void kmma(f32x16& p0, f32x16& p1, const bf16x8* kf, const bf16x8* qr) {
#pragma unroll
    for (int d0 = 0; d0 < NDS; ++d0) { p0 = __builtin_amdgcn_mfma_f32_32x32x16_bf16(kf[2 * d0], qr[d0], p0, 0, 0, 0); p1 = __builtin_amdgcn_mfma_f32_32x32x16_bf16(kf[2 * d0 + 1], qr[d0], p1, 0, 0, 0); }
}

__device__ __forceinline__ void pv_tile_pf(f32x16* o, int vb0, bf16x8 pa0, bf16x8 pa1, bf16x8 pa2, bf16x8 pa3) {
#define TRRD(dst, off) asm volatile("ds_read_b64_tr_b16 %0, %1 offset:%2" : "=&v"(dst) : "v"(vb0), "i"(off) : "memory")
#define RD8(S, d0) do { constexpr int b_ = v_rd_off(d0, 0, 0); TRRD(S[0], b_); TRRD(S[1], b_ + 2048); TRRD(S[2], b_ + 4096); TRRD(S[3], b_ + 6144); \
        TRRD(S[4], b_ + 8192); TRRD(S[5], b_ + 10240); TRRD(S[6], b_ + 12288); TRRD(S[7], b_ + 14336); } while (0)
#define MMA4(d0, S) do { \
        o[d0] = __builtin_amdgcn_mfma_f32_32x32x16_bf16(pa0, (bf16x8){S[0][0], S[0][1], S[0][2], S[0][3], S[1][0], S[1][1], S[1][2], S[1][3]}, o[d0], 0, 0, 0); \
        o[d0] = __builtin_amdgcn_mfma_f32_32x32x16_bf16(pa1, (bf16x8){S[2][0], S[2][1], S[2][2], S[2][3], S[3][0], S[3][1], S[3][2], S[3][3]}, o[d0], 0, 0, 0); \
        o[d0] = __builtin_amdgcn_mfma_f32_32x32x16_bf16(pa2, (bf16x8){S[4][0], S[4][1], S[4][2], S[4][3], S[5][0], S[5][1], S[5][2], S[5][3]}, o[d0], 0, 0, 0); \
        o[d0] = __builtin_amdgcn_mfma_f32_32x32x16_bf16(pa3, (bf16x8){S[6][0], S[6][1], S[6][2], S[6][3], S[7][0], S[7][1], S[7][2], S[7][3]}, o[d0], 0, 0, 0); } while (0)
    s16x4 sa[8], sb[8];
    RD8(sa, 0); RD8(sb, 1);
    asm volatile("s_waitcnt lgkmcnt(8)" ::: "memory"); SBAR(); MMA4(0, sa); SBAR();
    RD8(sa, 2);
    asm volatile("s_waitcnt lgkmcnt(8)" ::: "memory"); SBAR(); MMA4(1, sb); SBAR();
    RD8(sb, 3);
    asm volatile("s_waitcnt lgkmcnt(8)" ::: "memory"); SBAR(); MMA4(2, sa); SBAR();
    asm volatile("s_waitcnt lgkmcnt(0)" ::: "memory"); SBAR(); MMA4(3, sb);
#undef MMA4
#undef RD8
#undef TRRD
}
constexpr float THR2 = 8.0f;
__device__ __forceinline__ void partial_sm(f32x16& p0, f32x16& p1, float sh, float& m_reg, float& alpha) {
    float pmax = p0[0];
#pragma unroll
    for (int r = 1; r < 16; ++r) pmax = fmaxf(pmax, p0[r]);
#pragma unroll
    for (int r = 0; r < 16; ++r) pmax = fmaxf(pmax, p1[r]);
    { auto rr = __builtin_amdgcn_permlane32_swap(__float_as_uint(pmax), __float_as_uint(pmax), false, false);
      pmax = fmaxf(__uint_as_float(rr[0]), __uint_as_float(rr[1])); }
    pmax += sh;
    float mn;
    if (__builtin_expect(__all((pmax - m_reg) <= THR2), 1)) { mn = m_reg; alpha = 1.f; }
    else { const bool upd = (pmax - m_reg) > THR2;
        mn = upd ? fmaxf(m_reg, pmax) : m_reg; alpha = upd ? __builtin_amdgcn_exp2f(m_reg - mn) : 1.f; m_reg = mn; }
    const float off = mn - sh;
#pragma unroll
    for (int r = 0; r < 16; ++r) p0[r] = __builtin_amdgcn_exp2f(p0[r] - off);
#pragma unroll
    for (int r = 0; r < 16; ++r) p1[r] = p1[r] - off;
}
__device__ __forceinline__ void finish_sm(f32x16& p0, f32x16& p1, float alpha, float& l_reg, bf16x8& pa0, bf16x8& pa1, bf16x8& pa2, bf16x8& pa3) {
#pragma unroll
    for (int r = 0; r < 16; ++r) p1[r] = __builtin_amdgcn_exp2f(p1[r]);
    float ps = 0.f;
#pragma unroll
    for (int r = 0; r < 16; ++r) ps += p0[r];
#pragma unroll
    for (int r = 0; r < 16; ++r) ps += p1[r];
    { auto rr = __builtin_amdgcn_permlane32_swap(__float_as_uint(ps), __float_as_uint(ps), false, false);
      ps = __uint_as_float(rr[0]) + __uint_as_float(rr[1]); }
    l_reg = l_reg * alpha + ps;
#define PK4(P, B_, OUT) do { unsigned a0 = cvtpk(P[B_+0], P[B_+1]), a1 = cvtpk(P[B_+2], P[B_+3]); \
        unsigned b0 = cvtpk(P[B_+4], P[B_+5]), b1 = cvtpk(P[B_+6], P[B_+7]); \
        auto r0 = __builtin_amdgcn_permlane32_swap(a0, b0, false, false); auto r1 = __builtin_amdgcn_permlane32_swap(a1, b1, false, false); \
        u32x4 w = {r0[0], r1[0], r0[1], r1[1]}; OUT = __builtin_bit_cast(bf16x8, w); } while (0)
    PK4(p0, 0, pa0); PK4(p0, 8, pa1); PK4(p1, 0, pa2); PK4(p1, 8, pa3);
#undef PK4
}
__device__ __forceinline__ void softmax_tile(f32x16& p0, f32x16& p1, float sh, float& m_reg, float& l_reg, float& alpha, bf16x8& pa0, bf16x8& pa1, bf16x8& pa2, bf16x8& pa3) {
    partial_sm(p0, p1, sh, m_reg, alpha); finish_sm(p0, p1, alpha, l_reg, pa0, pa1, pa2, pa3);
}
__device__ __forceinline__ void add_bias_lut(f32x16& p0, f32x16& p1, LAS const float* lut, int dq) {
    LAS const float* bp = lut + (RMAXL - dq);
#pragma unroll
    for (int r = 0; r < 16; ++r) { const int c = (r & 3) + 8 * (r >> 2); p0[r] += bp[c]; p1[r] += bp[c + 32]; if ((r & 3) == 3) asm volatile("" ::: "memory"); }
}
__device__ __forceinline__ void load_bias_lut(f32x16& p0, f32x16& p1, LAS const float* lut, int dq) {
    LAS const float* bp = lut + (RMAXL - dq);
#pragma unroll
    for (int r = 0; r < 16; ++r) { const int c = (r & 3) + 8 * (r >> 2); p0[r] = bp[c]; p1[r] = bp[c + 32]; }
}
__device__ __forceinline__ void causal_mask(f32x16& p0, f32x16& p1, int dq) {
    const float NEG = -__builtin_inff();
#pragma unroll
    for (int r = 0; r < 16; ++r) { const int c = (r & 3) + 8 * (r >> 2); if (dq - c < 0) p0[r] = NEG; if (dq - c - 32 < 0) p1[r] = NEG; }
}
struct DmaOff { unsigned k[2], v[2]; };
__device__ __forceinline__ DmaOff dma_offsets(int wid, int lane) {
    DmaOff d;
#pragma unroll
    for (int i = 0; i < 2; ++i) { const int p = wid * 2 + i;
        { const int row = 4 * p + (lane >> 4), c = (lane & 15) ^ (row & 7); d.k[i] = (unsigned)(row * PITCH * 2 + c * 16); }
        { const int sub = 2 * p + (lane >> 5), kkhi = sub >> 2, cblk = sub & 3, kklo = (lane & 31) >> 2, kk = kkhi * 8 + kklo;
          const int k = (kk & ~0xC) | ((kk & 4) << 1) | ((kk & 8) >> 1), c = cblk * 32 + (lane & 3) * 8; d.v[i] = (unsigned)(k * PITCH * 2 + c * 2); } }
    return d;
}
__device__ __forceinline__ void dma_tile(LAS char* lds, int bf, const bf16* Kc, const bf16* Vc, int k0, const DmaOff& d, int wid) {
    const char* kt = (const char*)Kc + (size_t)k0 * (PITCH * 2); const char* vt = (const char*)Vc + (size_t)k0 * (PITCH * 2);
#pragma unroll
    for (int i = 0; i < 2; ++i) {
        __builtin_amdgcn_global_load_lds((const unsigned*)(kt + d.k[i]), (LAS unsigned*)(lds + L_K + bf * SHM_K + (wid * 2 + i) * 1024), 16, 0, 0);
        __builtin_amdgcn_global_load_lds((const unsigned*)(vt + d.v[i]), (LAS unsigned*)(lds + L_V + bf * SHM_V + (wid * 2 + i) * 1024), 16, 0, 0); }
}
constexpr int L_CF = 142336, L_TAB = 146432, L_FOUND = 148544;
__device__ __forceinline__ void build_lut(LAS char* lds, const float* biasT, int h, int tid) {
    LAS float* lut = (LAS float*)(lds + L_LUT);
    for (int i = tid; i < LUTN; i += 512) lut[i] = biasT[h * LUTN + i];
}

typedef int i32x8v __attribute__((ext_vector_type(8)));
typedef int i32x4v __attribute__((ext_vector_type(4)));
constexpr int SHM_V8 = 8192;
constexpr float F8_SP = 256.0f, F8_SV = 8.0f;
__device__ __forceinline__ unsigned dma_v8_offset(int wid, int lane) { const int row = wid * 16 + (lane >> 2), c = (lane & 3) ^ ((row >> 2) & 3); return (unsigned)(row * M + c * 16); }
__device__ __forceinline__ void dma_tile_k_v8(LAS char* lds, int slot, const bf16* Kc, const unsigned char* V8c, int k0, const DmaOff& d, unsigned v8off, int wid) {
    const char* kt = (const char*)Kc + (size_t)k0 * (PITCH * 2);
#pragma unroll
    for (int i = 0; i < 2; ++i) __builtin_amdgcn_global_load_lds((const unsigned*)(kt + d.k[i]), (LAS unsigned*)(lds + L_K + slot * SHM_K + (wid * 2 + i) * 1024), 16, 0, 0);
    __builtin_amdgcn_global_load_lds((const unsigned*)(V8c + k0 + v8off), (LAS unsigned*)(lds + L_V + slot * SHM_V8 + wid * 1024), 16, 0, 0);
}
__device__ __forceinline__ void pv8(f32x16* o, f32x16& ol, int a0, int a1, const i32x8v& P8, const i32x8v& ONES8) {
    i32x4v lo0, lo1, lo2, lo3, h0, h1, h2, h3;
    asm volatile("ds_read_b128 %0, %1" : "=&v"(lo0) : "v"(a0) : "memory");            asm volatile("ds_read_b128 %0, %1" : "=&v"(h0) : "v"(a1) : "memory");
    asm volatile("ds_read_b128 %0, %1 offset:2048" : "=&v"(lo1) : "v"(a0) : "memory"); asm volatile("ds_read_b128 %0, %1 offset:2048" : "=&v"(h1) : "v"(a1) : "memory");
    asm volatile("ds_read_b128 %0, %1 offset:4096" : "=&v"(lo2) : "v"(a0) : "memory"); asm volatile("ds_read_b128 %0, %1 offset:4096" : "=&v"(h2) : "v"(a1) : "memory");
    asm volatile("ds_read_b128 %0, %1 offset:6144" : "=&v"(lo3) : "v"(a0) : "memory"); asm volatile("ds_read_b128 %0, %1 offset:6144" : "=&v"(h3) : "v"(a1) : "memory");
#define PV8_MMA(d0, L, H) do { const i32x8v b_ = {L[0], L[1], L[2], L[3], H[0], H[1], H[2], H[3]}; \
        asm volatile("v_mfma_f32_32x32x64_f8f6f4 %0, %1, %2, %0 cbsz:1" : "+v"(o[d0]) : "v"(P8), "v"(b_)); } while (0)
    asm volatile("v_mfma_f32_32x32x64_f8f6f4 %0, %1, %2, %0 cbsz:1" : "+v"(ol) : "v"(P8), "v"(ONES8));
    asm volatile("s_waitcnt lgkmcnt(6)" ::: "memory"); PV8_MMA(0, lo0, h0);
    asm volatile("s_waitcnt lgkmcnt(4)" ::: "memory"); PV8_MMA(1, lo1, h1);
    asm volatile("s_waitcnt lgkmcnt(2)" ::: "memory"); PV8_MMA(2, lo2, h2);
    asm volatile("s_waitcnt lgkmcnt(0)" ::: "memory"); PV8_MMA(3, lo3, h3);
#undef PV8_MMA
}
__device__ __forceinline__ void softmax_tile8(f32x16& p0, f32x16& p1, float sh, float& m_reg, float& alpha, i32x8v& P8) {
    float pmax = p0[0];
#pragma unroll
    for (int r = 1; r < 16; ++r) pmax = fmaxf(pmax, p0[r]);
#pragma unroll
    for (int r = 0; r < 16; ++r) pmax = fmaxf(pmax, p1[r]);
    { auto rr = __builtin_amdgcn_permlane32_swap(__float_as_uint(pmax), __float_as_uint(pmax), false, false);
      pmax = fmaxf(__uint_as_float(rr[0]), __uint_as_float(rr[1])); }
    pmax += sh;
    float mn;
    if (__builtin_expect(__all((pmax - m_reg) <= 6.0f), 1)) { mn = m_reg; alpha = 1.f; }
    else { const bool upd = (pmax - m_reg) > 6.0f; mn = upd ? fmaxf(m_reg, pmax) : m_reg; alpha = upd ? __builtin_amdgcn_exp2f(m_reg - mn) : 1.f; m_reg = mn; }
    const float off = mn - sh - 8.0f;
#pragma unroll
    for (int r = 0; r < 16; ++r) p0[r] = __builtin_amdgcn_exp2f(p0[r] - off);
#pragma unroll
    for (int r = 0; r < 16; ++r) p1[r] = __builtin_amdgcn_exp2f(p1[r] - off);
#pragma unroll
    for (int i = 0; i < 4; ++i) { int t_ = __builtin_amdgcn_cvt_pk_bf8_f32(p0[4 * i], p0[4 * i + 1], 0, false); P8[i] = __builtin_amdgcn_cvt_pk_bf8_f32(p0[4 * i + 2], p0[4 * i + 3], t_, true); }
#pragma unroll
    for (int i = 0; i < 4; ++i) { int t_ = __builtin_amdgcn_cvt_pk_bf8_f32(p1[4 * i], p1[4 * i + 1], 0, false); P8[4 + i] = __builtin_amdgcn_cvt_pk_bf8_f32(p1[4 * i + 2], p1[4 * i + 3], t_, true); }
}

template <int VAR> __device__ __forceinline__ void diff_unit(LAS char* lds, int b, int h, int qb, const bf16* Q, const bf16* K, const unsigned char* V8T, bf16* O, const float* relb, const float* biasT,
                                          float lam_full, const float* subg, int tid, int wid, int lane) {
    asm volatile("" : "+v"(lane), "+v"(tid));
    const int r32 = lane & 31, hi = lane >> 5, cm = wid >> 2, w4 = wid & 3;
    const size_t rowbase = (size_t)b * SEQ;
    const int q0 = qb * 128, qw0 = q0 + w4 * 32, qpos = qw0 + r32;
    const bf16* Kc = K + rowbase * PITCH + h * HD; const unsigned char* V8c = V8T + (size_t)(h * HD) * M + rowbase;
    const int NT = (q0 + 128) / 64;
    const DmaOff dmo = dma_offsets(wid, lane);
    const unsigned v8off = dma_v8_offset(wid, lane);
    const int va0 = (int)(unsigned)(uintptr_t)(lds + L_V) + r32 * 64 + (((2 * hi) ^ ((r32 >> 2) & 3)) << 4), va1 = va0 ^ 16;
    LAS float* ws = (LAS float*)(lds + L_WS) + wid * 64;
    LAS const float* lut = (LAS const float*)(lds + L_LUT);
    lcp K_lds = (lcp)(lds + L_K);
    const float b31 = relb[31 * 8 + h] * 1.4426950408889634f;
    build_lut(lds, biasT, h, tid);
    bf16x8 qr[4];
#pragma unroll
    for (int d0 = 0; d0 < 4; ++d0) qr[d0] = *(const bf16x8*)(Q + (rowbase + qpos) * PITCH + h * HD + cm * 64 + d0 * 16 + hi * 8);
    dma_tile_k_v8(lds, 0, Kc, V8c, 0, dmo, v8off, wid);
    dma_tile_k_v8(lds, 1, Kc, V8c, 64, dmo, v8off, wid);
    asm volatile("s_waitcnt vmcnt(0)" ::: "memory");
    WG_BAR();
    float m_reg = -1e30f; f32x16 o[4] = {};
    f32x16 p0, p1; i32x8v P8 = {0, 0, 0, 0, 0, 0, 0, 0}; f32x16 ol = {};
    i32x8v ONES8; { int one_ = 0x38383838; asm volatile("" : "+v"(one_)); ONES8 = (i32x8v){one_, one_, one_, one_, one_, one_, one_, one_}; }
    const bool halfB = cm != 0;
    const int kl0 = (int)(unsigned)(uintptr_t)(lds + L_K);
    if (halfB) WG_BAR();
    for (int t = 0; t < NT; ++t) {
        __builtin_amdgcn_s_setprio(2);
        if (VAR != 2 && VAR != 3 && VAR != 7 && VAR != 8) { bf16x8 kf[8];
            kread<4>(kf, kl0 + (t & 3) * SHM_K, r32, hi, cm * 128);
            if (qw0 - (t * 64 + 63) >= RFAR) { p0 = f32x16{}; p1 = f32x16{}; } else load_bias_lut(p0, p1, lut, qpos - t * 64 - 4 * hi);
            if (t > 0) pv8(o, ol, va0 + ((t - 1) & 3) * SHM_V8, va1 + ((t - 1) & 3) * SHM_V8, P8, ONES8);
            asm volatile("s_waitcnt lgkmcnt(0)" ::: "memory"); SBAR();
            kmma<4>(p0, p1, kf, qr); } else { p0 = f32x16{}; p1 = f32x16{}; asm volatile("" : "+v"(p0), "+v"(p1)); }
        __builtin_amdgcn_s_setprio(0);
        if (halfB) asm volatile("s_waitcnt vmcnt(0)" ::: "memory");
        WG_BAR();
        const bool issue = VAR != 4 && VAR != 7 && VAR != 8 && t + 2 < NT;
        if (issue) dma_tile_k_v8(lds, (t + 2) & 3, Kc, V8c, (t + 2) * 64, dmo, v8off, wid);
        { const int k0_ = t * 64; float sh_ = 0.f, alpha; const int dq_ = qpos - k0_ - 4 * hi;
          if (VAR != 8) { if (qw0 - (k0_ + 63) >= RFAR) sh_ = b31;
          if (k0_ + 63 > qw0) causal_mask(p0, p1, dq_); }
          softmax_tile8(p0, p1, sh_, m_reg, alpha, P8);
          if (__any(alpha < 1.f)) { if (hi == 0) ws[r32] = alpha; asm volatile("s_waitcnt lgkmcnt(0)" ::: "memory");
#pragma unroll
              for (int r = 0; r < 16; ++r) { const float a_ = ws[crow(r, hi)]; o[0][r] *= a_; o[1][r] *= a_; o[2][r] *= a_; o[3][r] *= a_; ol[r] *= a_; } } }
        if (!halfB) { if (issue) asm volatile("s_waitcnt vmcnt(3)" ::: "memory"); else asm volatile("s_waitcnt vmcnt(0)" ::: "memory"); }
        WG_BAR();
    }
    __builtin_amdgcn_s_setprio(2);
    pv8(o, ol, va0 + ((NT - 1) & 3) * SHM_V8, va1 + ((NT - 1) & 3) * SHM_V8, P8, ONES8);
    asm volatile("s_nop 15\n\ts_nop 15" ::: "memory");
    __builtin_amdgcn_s_setprio(0);
    if (!halfB) WG_BAR();
    WG_BAR();
#pragma unroll
    for (int r = 0; r < 16; ++r) { const float rl = __builtin_amdgcn_rcpf(ol[r] * F8_SV);
#pragma unroll
        for (int d0 = 0; d0 < 4; ++d0) o[d0][r] *= rl; }
    LAS float* xch = (LAS float*)lds + (size_t)w4 * 64 * 64;
    if (cm == 1) {
#pragma unroll
        for (int d0 = 0; d0 < 4; ++d0)
#pragma unroll
            for (int r = 0; r < 16; ++r) xch[(d0 * 16 + r) * 64 + lane] = o[d0][r];
    }
    WG_BAR();
    if (cm == 0) {
        float ss[16];
#pragma unroll
        for (int r = 0; r < 16; ++r) { float a = 0.f;
#pragma unroll
            for (int d0 = 0; d0 < 4; ++d0) { o[d0][r] -= lam_full * xch[(d0 * 16 + r) * 64 + lane]; a += o[d0][r] * o[d0][r]; }
            ss[r] = a; }
#pragma unroll
        for (int r = 0; r < 16; ++r) {
#pragma unroll
            for (int sft = 1; sft < 32; sft <<= 1) ss[r] += bperm_f(lane ^ sft, ss[r]); }
        float gg[4];
#pragma unroll
        for (int d0 = 0; d0 < 4; ++d0) gg[d0] = subg[d0 * 32 + r32] * (1.0f - LAMBDA_INIT);
        bf16* Ow = O + (rowbase + qw0) * PITCH + h * HD;
#pragma unroll
        for (int r = 0; r < 16; ++r) { const int orow = crow(r, hi); const float rs = 1.0f / sqrtf(ss[r] * (1.0f / HD) + RMS_EPS);
            u32x2 wo; wo.x = cvtpk(o[0][r] * rs * gg[0], o[1][r] * rs * gg[1]); wo.y = cvtpk(o[2][r] * rs * gg[2], o[3][r] * rs * gg[3]);
            *(u32x2*)(Ow + (size_t)orow * PITCH + r32 * 4) = wo; }
    }
    WG_BAR();
}


__device__ __forceinline__ void block_load(LAS char* lds, const bf16* Kc, const unsigned char* V8c, const DmaOff& d, unsigned v8off, int wid) {
#pragma unroll
    for (int t = 0; t < 4; ++t) dma_tile_k_v8(lds, t, Kc, V8c, t * 64, d, v8off, wid);
}
#define MOBA_TILE(t, CAUSAL) do { const int k0_ = kbase + (t) * 64; \
        if (!(CAUSAL) || k0_ <= qw0 + 31) { f32x16 p0, p1; float alpha; \
            const int dq_ = qpos - k0_ - 4 * hi; \
            if (CAUSAL) load_bias_lut(p0, p1, lut, dq_); \
            else load_bias_lut(p0, p1, lut, dq_ < RFAR + 63 ? dq_ : RFAR + 63);     \
            qkt<t, 8>(p0, p1, K_lds, r32, hi, 0, qr); \
            if ((CAUSAL) && k0_ + 63 > qw0) causal_mask(p0, p1, dq_); \
            softmax_tile8(p0, p1, 0.f, m_reg, alpha, P8); \
            if (__any(alpha < 1.f)) { if (hi == 0) ws[r32] = alpha; asm volatile("s_waitcnt lgkmcnt(0)" ::: "memory"); \
                _Pragma("unroll") for (int r = 0; r < 16; ++r) { const float a_ = ws[crow(r, hi)]; o[0][r] *= a_; o[1][r] *= a_; o[2][r] *= a_; o[3][r] *= a_; ol[r] *= a_; } } \
            pv8(o, ol, va0 + (t) * SHM_V8, va1 + (t) * SHM_V8, P8, ONES8); } } while (0)
#define MOBA_STATE() float m_reg = -1e30f; f32x16 o[4] = {}; f32x16 ol = {}; i32x8v P8 = {0, 0, 0, 0, 0, 0, 0, 0}; \
        i32x8v ONES8; { int one_ = 0x38383838; asm volatile("" : "+v"(one_)); ONES8 = (i32x8v){one_, one_, one_, one_, one_, one_, one_, one_}; } \
        const int va0 = (int)(unsigned)(uintptr_t)(lds + L_V) + r32 * 64 + (((2 * hi) ^ ((r32 >> 2) & 3)) << 4), va1 = va0 ^ 16
#define MOBA_LROW(lvar) asm volatile("s_nop 15\n\ts_nop 15" ::: "memory"); if (r32 == 0) { _Pragma("unroll") for (int r = 0; r < 16; ++r) ws[crow(r, hi)] = ol[r]; } \
        asm volatile("s_waitcnt lgkmcnt(0)" ::: "memory"); const float lvar = ws[r32] * (1.0f / F8_SP); asm volatile("s_waitcnt lgkmcnt(0)" ::: "memory")
__device__ __forceinline__ void moba_part_group(LAS char* lds, int bh, int j, int g, int cntj, const bf16* Q, const unsigned short* lists, const unsigned* sel,
                                                bf16* P0, bf16* P1, bf16* P2, f32x2* ml, float b31, int wid, int lane) {
    asm volatile("" : "+v"(lane));
    const int r32 = lane & 31, hi = lane >> 5, b = bh >> 3, h = bh & 7;
    const size_t rowbase = (size_t)b * SEQ;
    const int idx = g * 32 + r32; const bool valid = idx < cntj;
    const int qpos = (int)lists[((size_t)bh * 32 + j) * 8192 + (valid ? idx : cntj - 1)];
    const unsigned smask = sel[(size_t)bh * SEQ + qpos]; const int slot = __popc(smask & ((1u << j) - 1u));
    LAS float* ws = (LAS float*)(lds + L_WS) + wid * 64;
    LAS const float* lut = (LAS const float*)(lds + L_LUT);
    lcp K_lds = (lcp)(lds + L_K);
    bf16x8 qr[8];
#pragma unroll
    for (int d0 = 0; d0 < 8; ++d0) qr[d0] = *(const bf16x8*)(Q + (rowbase + qpos) * PITCH + h * HD + d0 * 16 + hi * 8);
    if (hi == 0) ((LAS int*)ws)[32 + r32] = valid ? (int)((unsigned)(rowbase + qpos) | ((unsigned)slot << 24)) : -1;
    MOBA_STATE();
    const int kbase = j * 256, qw0 = 0; (void)qw0;
    MOBA_TILE(0, false); MOBA_TILE(1, false); MOBA_TILE(2, false); MOBA_TILE(3, false);
    MOBA_LROW(l_row);
    if (hi == 0 && valid) ml[((size_t)slot * M + rowbase + qpos) * NH + h] = (f32x2){m_reg, l_row};
#pragma unroll
    for (int r = 0; r < 16; ++r) { const int orow = crow(r, hi); const float rl = __builtin_amdgcn_rcpf(ol[r] * F8_SV); const int info = ((LAS const int*)ws)[32 + orow];
        const int sl = info >> 24; bf16* Pb = sl == 0 ? P0 : (sl == 1 ? P1 : P2); bf16* Ow = Pb + (size_t)(info & 0xffffff) * PITCH + h * HD;
        u32x2 w; w.x = cvtpk(o[0][r] * rl, o[1][r] * rl); w.y = cvtpk(o[2][r] * rl, o[3][r] * rl);
        if (info >= 0) *(u32x2*)(Ow + r32 * 4) = w; }
    asm volatile("s_waitcnt lgkmcnt(0)" ::: "memory");
}
__device__ __forceinline__ void moba_own_rows(LAS char* lds, int b, int h, int qb, const bf16* Q, bf16* O, const bf16* P0, const bf16* P1, const bf16* P2, const f32x2* ml, int wid, int lane) {
    asm volatile("" : "+v"(lane));
    const int r32 = lane & 31, hi = lane >> 5;
    const size_t rowbase = (size_t)b * SEQ;
    const int q0 = qb * 256, qw0 = q0 + wid * 32, qpos = qw0 + r32, kbase = q0;
    LAS float* ws = (LAS float*)(lds + L_WS) + wid * 64;
    LAS const float* lut = (LAS const float*)(lds + L_LUT);
    lcp K_lds = (lcp)(lds + L_K);
    const float b31 = 0.f; (void)b31;
    bf16x8 qr[8];
#pragma unroll
    for (int d0 = 0; d0 < 8; ++d0) qr[d0] = *(const bf16x8*)(Q + (rowbase + qpos) * PITCH + h * HD + d0 * 16 + hi * 8);
    MOBA_STATE();
    MOBA_TILE(0, true); MOBA_TILE(1, true); MOBA_TILE(2, true); MOBA_TILE(3, true);
    const int nsel = qb < 3 ? qb : 3;
    MOBA_LROW(l_reg);
    {
        float ms[3], ls[3]; float mx = m_reg;
#pragma unroll
        for (int s_ = 0; s_ < 3; ++s_) { ms[s_] = -1e30f; ls[s_] = 0.f;
            if (s_ < nsel) { const f32x2 v = ml[((size_t)s_ * M + rowbase + qpos) * NH + h]; ms[s_] = v.x; ls[s_] = v.y; mx = fmaxf(mx, v.x); } }
        const float w0 = __builtin_amdgcn_exp2f(m_reg - mx);
        float wv[3]; float den = l_reg * w0;
#pragma unroll
        for (int s_ = 0; s_ < 3; ++s_) { wv[s_] = ls[s_] * __builtin_amdgcn_exp2f(ms[s_] - mx); den += wv[s_]; }
        const float rd = 1.0f / den;
        if (hi == 0) *(LAS f32x4*)(lds + L_CF + wid * 512 + r32 * 16) = (f32x4){w0 * rd * (1.0f / (F8_SP * F8_SV)), wv[0] * rd, wv[1] * rd, wv[2] * rd};
    }
    asm volatile("s_waitcnt lgkmcnt(0)" ::: "memory");
#pragma unroll
    for (int r = 0; r < 16; ++r) { const int orow = crow(r, hi); const f32x4 cf = *(LAS const f32x4*)(lds + L_CF + wid * 512 + orow * 16);
        const size_t ro = (rowbase + qw0 + orow) * PITCH + h * HD + r32 * 4;
        float v0 = o[0][r] * cf.x, v1 = o[1][r] * cf.x, v2 = o[2][r] * cf.x, v3 = o[3][r] * cf.x;
        if (nsel > 0) { const u32x2 w = *(const u32x2*)(P0 + ro); v0 += cf.y * bflo(w.x); v1 += cf.y * bfhi(w.x); v2 += cf.y * bflo(w.y); v3 += cf.y * bfhi(w.y); }
        if (nsel > 1) { const u32x2 w = *(const u32x2*)(P1 + ro); v0 += cf.z * bflo(w.x); v1 += cf.z * bfhi(w.x); v2 += cf.z * bflo(w.y); v3 += cf.z * bfhi(w.y); }
        if (nsel > 2) { const u32x2 w = *(const u32x2*)(P2 + ro); v0 += cf.w * bflo(w.x); v1 += cf.w * bfhi(w.x); v2 += cf.w * bflo(w.y); v3 += cf.w * bfhi(w.y); }
        u32x2 wo; wo.x = cvtpk(v0, v1); wo.y = cvtpk(v2, v3);
        *(u32x2*)(O + ro) = wo; }
    asm volatile("s_waitcnt lgkmcnt(0)" ::: "memory");
}
#undef MOBA_TILE
#undef MOBA_STATE
#undef MOBA_LROW
#undef KSWZ
#undef SBAR
#undef WG_BAR
}


template <int VAR> __device__ __forceinline__ void p_diff_attn_mfma(const Args& a, LAS unsigned char* lds, int vcu, int tid, int wave, int lane, size_t out_off) {
    const bf16* Qb = (const bf16*)(a.ws + WS_Q); const bf16* Kb = (const bf16*)(a.ws + WS_K); const unsigned char* Vb = a.ws + WS_V;
    bf16* Ob = (bf16*)(a.ws + out_off); const float* biasT = (const float*)(a.ws + WS_BIAST);
    float lam_full;
    { const float* lm = a.diff_lambda; const float p01 = wave_sum(lm[lane] * lm[64 + lane]), p23 = wave_sum(lm[128 + lane] * lm[192 + lane]); lam_full = __expf(p01) - __expf(p23) + LAMBDA_INIT; }
    const int G = gridDim.x;
    if (G == 256) {
#pragma unroll 1
        for (int k = 0; k < 4; ++k) {
            const int bh = 2 * (vcu >> 5) + (k >> 1), p = vcu & 31, qb = (k & 1) ? 63 - p : p;
            att::diff_unit<VAR>((LAS char*)lds, bh >> 3, bh & 7, qb, Qb, Kb, Vb, Ob, a.rel_bias, biasT, lam_full, a.diff_subln_g, tid, wave, lane);
        }
    } else {
        for (int pp = vcu; pp < 512; pp += G) {
#pragma unroll 1
            for (int k = 0; k < 2; ++k) {
                const int bh = pp >> 5, p = pp & 31, qb = k ? 63 - p : p;
                att::diff_unit<VAR>((LAS char*)lds, bh >> 3, bh & 7, qb, Qb, Kb, Vb, Ob, a.rel_bias, biasT, lam_full, a.diff_subln_g, tid, wave, lane);
            }
        }
    }
}


__device__ __forceinline__ void p_moba_part(const Args& a, LAS unsigned char* lds, int vcu, int tid, int wave, int lane) {
    const bf16* Qb = (const bf16*)(a.ws + WS_Q); const bf16* Kb = (const bf16*)(a.ws + WS_K); const unsigned char* V8T = a.ws + WS_V;
    const unsigned* cnt = (const unsigned*)(a.ws + WS_CTL) + CW_CNT; const unsigned short* lists = (const unsigned short*)(a.ws + WS_LIST); const unsigned* sel = (const unsigned*)(a.ws + WS_SEL);
    bf16* P0 = (bf16*)(a.ws + WS_H); bf16* P1 = (bf16*)(a.ws + WS_Y); bf16* P2 = (bf16*)a.out; f32x2* ml = (f32x2*)((unsigned char*)a.out + WS_ML);
    LAS int* pre = (LAS int*)(lds + att::L_TAB); LAS int* found = (LAS int*)(lds + att::L_FOUND);
    const int c = (int)cnt[tid], nch = (c + 255) >> 8;
    int incl = nch;
#pragma unroll
    for (int o = 1; o < 64; o <<= 1) { const int v = bperm_i(lane >= o ? lane - o : lane, incl); if (lane >= o) incl += v; }
    if (lane == 63) pre[513 + wave] = incl;
    __syncthreads();
    int woff = 0;
#pragma unroll
    for (int w8 = 0; w8 < 8; ++w8) woff += (w8 < wave) ? pre[513 + w8] : 0;
    pre[tid + 1] = woff + incl; if (tid == 0) pre[0] = 0;
    __syncthreads();
    const int T = pre[512], G = gridDim.x;
    const int lo = (int)(((long long)T * vcu) / G), hi_ = (int)(((long long)T * (vcu + 1)) / G);
    const att::DmaOff dmo = att::dma_offsets(wave, lane); const unsigned v8off = att::dma_v8_offset(wave, lane);
    int last_h = -1;
    for (int it = lo; it < hi_;) {
        if (pre[tid] <= it && it < pre[tid + 1]) found[0] = tid;
        __syncthreads();
        const int f = __builtin_amdgcn_readfirstlane(found[0]);
        const int bh = f >> 5, j = f & 31, c0 = it - pre[f];
        const int seg_end = pre[f + 1] < hi_ ? pre[f + 1] : hi_, c1 = seg_end - pre[f];
        const int cntj = (int)cnt[f];
        const size_t kvoff = ((size_t)(bh >> 3) * SEQ + j * 256) * D + (bh & 7) * HD;
        att::block_load((LAS char*)lds, Kb + kvoff, V8T + (size_t)((bh & 7) * HD) * M + (size_t)(bh >> 3) * SEQ + j * 256, dmo, v8off, wave);
        if ((bh & 7) != last_h) { last_h = bh & 7; att::build_lut((LAS char*)lds, (const float*)(a.ws + WS_BIAST), last_h, tid); }
        const float b31 = a.rel_bias[31 * 8 + (bh & 7)] * LOG2E;
        asm volatile("s_waitcnt vmcnt(0)" ::: "memory");
        __syncthreads();
        for (int g = c0 * 8 + wave; g < c1 * 8 && g * 32 < cntj; g += 8)
            att::moba_part_group((LAS char*)lds, bh, j, g, cntj, Qb, lists, sel, P0, P1, P2, ml, b31, wave, lane);
        it = seg_end;
    }
}
__device__ __forceinline__ void p_moba_own(const Args& a, LAS unsigned char* lds, int vcu, int tid, int wave, int lane) {
    const bf16* Qb = (const bf16*)(a.ws + WS_Q); const bf16* Kb = (const bf16*)(a.ws + WS_K); const unsigned char* V8T = a.ws + WS_V; bf16* Ob = (bf16*)(a.ws + WS_O);
    const bf16* P0 = (const bf16*)(a.ws + WS_H); const bf16* P1 = (const bf16*)(a.ws + WS_Y); const bf16* P2 = (const bf16*)a.out; const f32x2* ml = (const f32x2*)((const unsigned char*)a.out + WS_ML);
    const int G = gridDim.x;
    const att::DmaOff dmo = att::dma_offsets(wave, lane); const unsigned v8off = att::dma_v8_offset(wave, lane);
    for (int u0 = 2 * vcu; u0 < 512; u0 += 2 * G) {
#pragma unroll 1
        for (int k = 0; k < 2; ++k) { const int u = u0 + k; if (u >= 512) break; const int bh = u >> 5, qb = u & 31;
            __syncthreads();
            const size_t kvoff = ((size_t)(bh >> 3) * SEQ + qb * 256) * D + (bh & 7) * HD;
            att::block_load((LAS char*)lds, Kb + kvoff, V8T + (size_t)((bh & 7) * HD) * M + (size_t)(bh >> 3) * SEQ + qb * 256, dmo, v8off, wave);
            if (k == 0 || (u & 31) == 0) att::build_lut((LAS char*)lds, (const float*)(a.ws + WS_BIAST), bh & 7, tid);
            asm volatile("s_waitcnt vmcnt(0)" ::: "memory");
            __syncthreads();
            att::moba_own_rows((LAS char*)lds, bh >> 3, bh & 7, qb, Qb, Ob, P0, P1, P2, ml, wave, lane); }
    }
}

struct TI { int tid, lane, wave, gtid, gw; };
__device__ __forceinline__ TI mk_ti(int wave0) { const int l = lane_opaque(); const int t = wave0 * 64 + l; TI r; r.tid = t; r.lane = l; r.wave = wave0;
    r.gtid = blockIdx.x * NTHR + t; r.gw = blockIdx.x * NWAVES + r.wave; return r; }

typedef const __attribute__((address_space(4))) Args* CArgs;
__device__ __forceinline__ Args load_args() {
#if defined(__HIP_DEVICE_COMPILE__)
    auto p = __builtin_amdgcn_kernarg_segment_ptr(); asm volatile("" : "+s"(p));
    typedef const __attribute__((address_space(4))) unsigned long long* cu64; cu64 q = (cu64)p;
    Args r; r.x = (const float*)q[0]; r.c = (const float*)q[1]; r.rel_bias = (const float*)q[2]; r.ada_w = (const float*)q[3]; r.ada_b = (const float*)q[4]; r.norm_g = (const float*)q[5];
    r.moba_w_qkv = (const float*)q[6]; r.moba_w_o = (const float*)q[7]; r.diff_w_qkv = (const float*)q[8]; r.diff_w_o = (const float*)q[9];
    r.diff_lambda = (const float*)q[10]; r.diff_subln_g = (const float*)q[11]; r.ffn_w_in = (const float*)q[12]; r.ffn_w_out = (const float*)q[13];
    r.out = (float*)q[14]; r.ws = (unsigned char*)q[15]; return r;
#else
    return Args{};
#endif
}
#define WSP(T, off) ((T*)(a.ws + (off)))
#define GEMM_PHASE_F8(EPI, Aptr, Wptr, N_, K_, ...) do { const Args a = load_args(); const int G_ = gridDim.x; \
        pg8::Gemm g{Aptr, (const bf16*)(Wptr), M, N_, K_}; pg8::StaticOrder S; S.init(M, N_, G_, (int)blockIdx.x); \
        EPI E{__VA_ARGS__}; pg8::gemm_phase<EPI, pg8::StaticOrder, true, true, true>(lds, g, S, E, wave0); } while (0)
#define GEMM_PHASE(EPI, Aptr, Wptr, N_, K_, ...) do { const Args a = load_args(); const int G_ = gridDim.x; \
        pg8::Gemm g{Aptr, (const bf16*)(Wptr), M, N_, K_}; pg8::StaticOrder S; S.init(M, N_, G_, (int)blockIdx.x); \
        EPI E{__VA_ARGS__}; pg8::gemm_phase<EPI, pg8::StaticOrder, true, true>(lds, g, S, E, wave0); } while (0)
__global__ void __launch_bounds__(NTHR, 2) fwd(Args a_unused) {
    extern __shared__ __attribute__((aligned(16))) unsigned char lds_raw[];
    LAS unsigned char* lds = (LAS unsigned char*)lds_raw;
    volatile LAS unsigned* MISC = (volatile LAS unsigned*)(lds + MISC_OFF);
    const int wave0 = __builtin_amdgcn_readfirstlane((int)threadIdx.x >> 6);
    if (wave0 == 0) MISC[lane_opaque()] = 0u;
    __syncthreads();
    XcdBarrier bar;
    { const Args a = load_args(); bar = xcd_barrier_post(WSP(unsigned, WS_CTL) + CW_BAR, MISC + 8, wave0); }
#define VCU() ((gridDim.x % 8 == 0) ? (int)((blockIdx.x % 8) * (gridDim.x / 8) + blockIdx.x / 8) : (int)blockIdx.x)
#define NGW() ((int)gridDim.x * NWAVES)
#define NGT() ((int)gridDim.x * NTHR)
    constexpr float QS0 = 0.08838834764831845f * LOG2E, QS1 = 0.125f * LOG2E;
    constexpr size_t QKVS = (size_t)(WS_K - WS_Q) / 2;

    { const Args a = load_args(); const TI t = mk_ti(wave0); p_weights(a, lds, t.gw, NGW(), t.wave, t.lane); p_wo_perm(a, t.gtid, NGT()); __syncthreads(); p_mod(a, lds, (int)blockIdx.x, (int)gridDim.x, t.tid, t.wave, t.lane); }
    xcd_barrier(bar);
    { const Args a = load_args(); const TI t = mk_ti(wave0); const float* md = WSP(const float, WS_MOD); p_norm_in(a.x, a.norm_g, md, md + 1024, WSP(bf16, WS_H), t.gw, NGW(), t.lane); }
    xcd_barrier(bar);
    GEMM_PHASE(pg8::EpiQKV, WSP(bf16, WS_H), a.ws + WS_W + WO_QKV, 2 * D, D, WSP(bf16, WS_Q), D, QKVS, QS0, WSP(float, WS_KSUM));
    __syncthreads();
    { const Args a = load_args(); const int G_ = gridDim.x;
      pg8::Gemm g{(const bf16*)(a.ws + WS_W + WO_QKV) + (size_t)2 * D * D, WSP(bf16, WS_H), D, M, D}; pg8::StaticOrder S; S.init(D, M, G_, (int)blockIdx.x);
      pg8::EpiVT8 E{a.ws + WS_V, M, att::F8_SV}; pg8::gemm_phase<pg8::EpiVT8, pg8::StaticOrder, true, true>(lds, g, S, E, wave0); }
    xcd_barrier(bar);
    { const Args a = load_args(); const TI t = mk_ti(wave0); p_gate(WSP(bf16, WS_Q), WSP(const float, WS_KSUM), WSP(unsigned, WS_SEL), WSP(unsigned, WS_CTL) + CW_CNT, WSP(unsigned short, WS_LIST), lds, (int)blockIdx.x, (int)gridDim.x, t.tid, t.wave, t.lane); }
    xcd_barrier(bar);
    { const Args a = load_args(); const TI t = mk_ti(wave0); p_moba_part(a, lds, VCU(), t.tid, t.wave, t.lane); }
    xcd_barrier(bar);
    { const Args a = load_args(); const TI t = mk_ti(wave0); p_moba_own(a, lds, VCU(), t.tid, t.wave, t.lane); }
    xcd_barrier(bar);
    GEMM_PHASE(pg8::EpiBf16<0>, WSP(bf16, WS_O), a.ws + WS_W + WO_O, D, D, WSP(bf16, WS_Y), D, nullptr, 0, 0, 1.f);
    xcd_barrier(bar);
    { const Args a = load_args(); const TI t = mk_ti(wave0); const float* md = WSP(const float, WS_MOD); const float* ng = a.norm_g;
      p_post<false, true, true>(a.x, WSP(bf16, WS_Y), ng + D, md + 2048, a.out, ng + 2 * D, md + 3072, md + 4096, WSP(bf16, WS_H), t.gw, NGW(), t.lane); }
    xcd_barrier(bar);
    GEMM_PHASE_F8(pg8::EpiSwiglu, WSP(bf16, WS_H), a.ws + WS_W + WO_IN, 2 * DFF, D / 2, WSP(bf16, WS_HH), DFF, 1.0f / (F8_SA * F8_SB), F8_SH);
    xcd_barrier(bar);
    GEMM_PHASE_F8(pg8::EpiScaled, WSP(bf16, WS_HH), a.ws + WS_W + WO_OUT, D, DFF / 2, WSP(bf16, WS_Y), D, 1.0f / (F8_SH * F8_SB));
    xcd_barrier(bar);
    { const Args a = load_args(); const TI t = mk_ti(wave0); const float* md = WSP(const float, WS_MOD); const float* ng = a.norm_g; const float* md1 = md + 2 * 6144; const float* ng1 = ng + 4 * D;
      p_post<true, true, false>(a.out, WSP(bf16, WS_Y), ng + 3 * D, md + 5120, (unsigned char*)a.out + 32 * MiB, ng1, md1, md1 + 1024, WSP(bf16, WS_H), t.gw, NGW(), t.lane); }
    xcd_barrier(bar);
    GEMM_PHASE(pg8::EpiQKV, WSP(bf16, WS_H), a.ws + WS_W + WL_STRIDE + WO_QKV, 2 * D, D, WSP(bf16, WS_Q), D, QKVS, QS1, nullptr);
    __syncthreads();
    { const Args a = load_args(); const int G_ = gridDim.x;
      pg8::Gemm g{(const bf16*)(a.ws + WS_W + WL_STRIDE + WO_QKV) + (size_t)2 * D * D, WSP(bf16, WS_H), D, M, D}; pg8::StaticOrder S; S.init(D, M, G_, (int)blockIdx.x);
      pg8::EpiVT8 E{a.ws + WS_V, M, att::F8_SV}; pg8::gemm_phase<pg8::EpiVT8, pg8::StaticOrder, true, true>(lds, g, S, E, wave0); }
    xcd_barrier(bar);
    { const Args a = load_args(); const TI t = mk_ti(wave0); p_diff_attn_mfma<0>(a, lds, VCU(), t.tid, t.wave, t.lane, WS_O); }
#ifdef PROBE_VAR
    { const Args a = load_args(); const TI t = mk_ti(wave0); p_diff_attn_mfma<PROBE_VAR>(a, lds, VCU(), t.tid, t.wave, t.lane, WS_Y); }
#endif
    xcd_barrier(bar);
    GEMM_PHASE(pg8::EpiBf16<0>, WSP(bf16, WS_O), a.ws + WS_W + WL_STRIDE + WO_O, D, D, WSP(bf16, WS_Y), D, nullptr, 0, 0, 1.f);
    xcd_barrier(bar);
    { const Args a = load_args(); const TI t = mk_ti(wave0); const float* md = WSP(const float, WS_MOD) + 2 * 6144; const float* ng = a.norm_g + 4 * D;
      p_post<true, true, true>((unsigned char*)a.out + 32 * MiB, WSP(bf16, WS_Y), ng + D, md + 2048, WSP(bf16, WS_O), ng + 2 * D, md + 3072, md + 4096, WSP(bf16, WS_H), t.gw, NGW(), t.lane); }
    xcd_barrier(bar);
    GEMM_PHASE_F8(pg8::EpiSwiglu, WSP(bf16, WS_H), a.ws + WS_W + WL_STRIDE + WO_IN, 2 * DFF, D / 2, WSP(bf16, WS_HH), DFF, 1.0f / (F8_SA * F8_SB), F8_SH);
    xcd_barrier(bar);
    GEMM_PHASE_F8(pg8::EpiScaled, WSP(bf16, WS_HH), a.ws + WS_W + WL_STRIDE + WO_OUT, D, DFF / 2, WSP(bf16, WS_Y), D, 1.0f / (F8_SH * F8_SB));
    xcd_barrier(bar);
    { const Args a = load_args(); const TI t = mk_ti(wave0); const float* md = WSP(const float, WS_MOD) + 2 * 6144; const float* ng = a.norm_g + 4 * D;
      p_post<true, false, false>(WSP(bf16, WS_O), WSP(bf16, WS_Y), ng + 3 * D, md + 5120, a.out, nullptr, nullptr, nullptr, nullptr, t.gw, NGW(), t.lane); }
}

extern "C" void kernel_launch(void* const* d_in, const int* in_sizes, int n_in, void* d_out, int out_size, void* d_ws, size_t ws_size, hipStream_t stream) {
    static int grid = 0;
    if (grid == 0) {
        if (n_in != 14 || out_size != M * D || ws_size < WS_END) { fprintf(stderr, "kernel_launch: unexpected shapes n_in %d out %d ws %zu\n", n_in, out_size, ws_size); grid = -1; return; }
        int dev = 0, cus = 0;
        if (hipGetDevice(&dev) != hipSuccess || hipDeviceGetAttribute(&cus, hipDeviceAttributeMultiprocessorCount, dev) != hipSuccess) { grid = -1; return; }
        if (hipFuncSetAttribute((const void*)fwd, hipFuncAttributeMaxDynamicSharedMemorySize, LDS_BYTES) != hipSuccess) { fprintf(stderr, "hipFuncSetAttribute failed\n"); grid = -1; return; }
        grid = cus;
    }
    if (grid < 0) return;
    (void)hipMemsetAsync((char*)d_ws + WS_CTL, 0, CTL_ZERO_BYTES, stream);
    Args a{};
    a.x = (const float*)d_in[0]; a.c = (const float*)d_in[1]; a.rel_bias = (const float*)d_in[2]; a.ada_w = (const float*)d_in[3]; a.ada_b = (const float*)d_in[4];
    a.norm_g = (const float*)d_in[5]; a.moba_w_qkv = (const float*)d_in[6]; a.moba_w_o = (const float*)d_in[7]; a.diff_w_qkv = (const float*)d_in[8]; a.diff_w_o = (const float*)d_in[9];
    a.diff_lambda = (const float*)d_in[10]; a.diff_subln_g = (const float*)d_in[11]; a.ffn_w_in = (const float*)d_in[12]; a.ffn_w_out = (const float*)d_in[13];
    a.out = (float*)d_out; a.ws = (unsigned char*)d_ws;
    hipLaunchKernelGGL(fwd, dim3(grid), dim3(NTHR), LDS_BYTES, stream, a);
}
```
